# Optimizing an MI355X kernel written in HIP

```python
import math
import jax, jax.numpy as jnp
from jax import lax
import numpy as np

D_MODEL = 1024
BATCH = 2
SEQ = 8192
DEPTH = 1

N_HEADS_ATTN = 8
HEAD_DIM = 64
D_ATTN = N_HEADS_ATTN * HEAD_DIM
Q_BLOCK = 128
D_SSM = D_MODEL // 2
SSM_GROUP = 16
N_SSM_GROUPS = D_SSM // SSM_GROUP
SSM_STATE = 64
DT_MIN = 1e-3
DT_MAX = 1e-1
N_EXPERT_GROUPS = 4
EXPERTS_PER_GROUP = 8
N_EXPERTS = N_EXPERT_GROUPS * EXPERTS_PER_GROUP
TOP_K = 2
D_EXPERT = D_MODEL // 4
D_IN_PROJ = 3 * D_ATTN + N_HEADS_ATTN + D_SSM + 2 * D_MODEL
EPS = 1e-6
NEG_INF = -1e30

kernel_name = "hybrid_fox_s5_hier_moe_block"


def _rmsnorm(x, g):
    xf = x.astype(jnp.float32)
    y = xf * lax.rsqrt(jnp.mean(xf * xf, axis=-1, keepdims=True) + EPS)
    return (y * g.astype(jnp.float32)).astype(x.dtype)


def _forgetting_attention(q, k, v, f_logit):
    b, s, h, d = q.shape
    n_blk = s // Q_BLOCK
    log_f = jax.nn.log_sigmoid(f_logit.astype(jnp.float32))
    cum = jnp.cumsum(log_f, axis=1).transpose(0, 2, 1)
    qf = q.astype(jnp.float32).transpose(0, 2, 1, 3) * (d ** -0.5)
    kf = k.astype(jnp.float32).transpose(0, 2, 1, 3)
    vf = v.astype(jnp.float32).transpose(0, 2, 1, 3)
    q_blk = qf.reshape(b, h, n_blk, Q_BLOCK, d).transpose(2, 0, 1, 3, 4)
    c_blk = cum.reshape(b, h, n_blk, Q_BLOCK).transpose(2, 0, 1, 3)
    pos = jnp.arange(s, dtype=jnp.int32)
    p_blk = pos.reshape(n_blk, Q_BLOCK)

    def one_block(args):
        qb, cb, pb = args
        logits = jnp.einsum('bhqd,bhkd->bhqk', qb, kf) + cb[..., :, None] - cum[:, :, None, :]
        causal = pos[None, :] <= pb[:, None]
        logits = jnp.where(causal, logits, NEG_INF)
        p = jax.nn.softmax(logits, axis=-1)
        return jnp.einsum('bhqk,bhkd->bhqd', p, vf)

    o = lax.map(one_block, (q_blk, c_blk, p_blk))
    return o.transpose(1, 0, 3, 2, 4).reshape(b, s, h, d).astype(v.dtype)


def _linear_combine(a, b):
    a1, b1 = a
    a2, b2 = b
    return a2 * a1, a2 * b1 + b2


def _s5(u, A_re, A_im, log_dt, B_re, B_im, C_re, C_im, D_skip, w_glu):
    f32 = jnp.float32
    b, s, _ = u.shape
    uf = u.astype(f32).reshape(b, s, N_SSM_GROUPS, SSM_GROUP)
    A = lax.complex(A_re.astype(f32), A_im.astype(f32))
    dt = jnp.exp(log_dt.astype(f32))[:, None]
    A_bar = jnp.exp(A * dt)
    Bm = lax.complex(B_re.astype(f32), B_im.astype(f32))
    B_bar = ((A_bar - 1.0) / A)[..., None] * Bm
    Bu = jnp.einsum('bsgc,gpc->bsgp', uf.astype(jnp.complex64), B_bar)
    A_seq = jnp.broadcast_to(A_bar, Bu.shape)
    _, state = lax.associative_scan(_linear_combine, (A_seq, Bu), axis=1)
    Cm = lax.complex(C_re.astype(f32), C_im.astype(f32))
    y = jnp.real(jnp.einsum('gcp,bsgp->bsgc', Cm, state))
    y = y + D_skip.astype(f32).reshape(N_SSM_GROUPS, SSM_GROUP) * uf
    y = jax.nn.gelu(y.reshape(b, s, D_SSM))
    y = y * jax.nn.sigmoid(y @ w_glu.astype(f32))
    return y.astype(u.dtype)


def _hier_moe(x, w_rg, b_rg, w_re, b_re, w_gate, w_up, w_down):
    f32 = jnp.float32
    b, s, d = x.shape
    t = b * s
    xt = x.reshape(t, d)
    g_prob = jax.nn.softmax((xt @ w_rg).astype(f32) + b_rg.astype(f32), axis=-1)
    g_top, g_sel = lax.top_k(g_prob, 1)
    e_logits = ((xt @ w_re).astype(f32) + b_re.astype(f32)).reshape(t, N_EXPERT_GROUPS, EXPERTS_PER_GROUP)
    idx = jnp.broadcast_to(g_sel[:, :, None], (t, 1, EXPERTS_PER_GROUP))
    e_in = jnp.take_along_axis(e_logits, idx, axis=1)[:, 0]
    e_prob = jax.nn.softmax(e_in, axis=-1)
    e_top, e_idx = lax.top_k(e_prob, TOP_K)
    w = g_top * e_top / jnp.sum(e_top, axis=-1, keepdims=True)
    expert_id = g_sel * EXPERTS_PER_GROUP + e_idx
    combine = jnp.sum(jax.nn.one_hot(expert_id, N_EXPERTS, dtype=f32) * w[..., None], axis=1).astype(x.dtype)
    y = jnp.zeros_like(xt)
    for e in range(N_EXPERTS):
        h = jax.nn.silu(xt @ w_gate[e]) * (xt @ w_up[e])
        y = y + combine[:, e:e + 1] * (h @ w_down[e])
    return y.reshape(b, s, d)


def setup_inputs(seed: int = 0) -> dict:
    key = jax.random.key(seed)
    ks = jax.random.split(key, 32)
    f32 = jnp.float32
    nrm = lambda k, shape, scale: (jax.random.normal(k, shape, f32) * scale)
    L = DEPTH
    x = jax.random.normal(ks[0], (BATCH, SEQ, D_MODEL), f32)
    norm_mix_g = 1.0 + nrm(ks[1], (L, D_MODEL), 0.02)
    w_in = nrm(ks[2], (L, D_MODEL, D_IN_PROJ), D_MODEL ** -0.5)
    b_forget = jnp.broadcast_to(jnp.linspace(1.0, 6.0, N_HEADS_ATTN, dtype=f32), (L, N_HEADS_ATTN)) + nrm(ks[3], (L, N_HEADS_ATTN), 0.1)
    q_norm_g = 1.0 + nrm(ks[4], (L, HEAD_DIM), 0.02)
    k_norm_g = 1.0 + nrm(ks[5], (L, HEAD_DIM), 0.02)
    ssm_A_re = -0.5 + nrm(ks[6], (L, N_SSM_GROUPS, SSM_STATE), 0.01)
    ssm_A_im = jnp.pi * jnp.arange(SSM_STATE, dtype=f32)[None, None, :] + nrm(ks[7], (L, N_SSM_GROUPS, SSM_STATE), 0.01)
    ssm_log_dt = jax.random.uniform(ks[8], (L, N_SSM_GROUPS), f32, math.log(DT_MIN), math.log(DT_MAX))
    ssm_B_re = nrm(ks[9], (L, N_SSM_GROUPS, SSM_STATE, SSM_GROUP), (2 * SSM_GROUP) ** -0.5)
    ssm_B_im = nrm(ks[10], (L, N_SSM_GROUPS, SSM_STATE, SSM_GROUP), (2 * SSM_GROUP) ** -0.5)
    ssm_C_re = nrm(ks[11], (L, N_SSM_GROUPS, SSM_GROUP, SSM_STATE), (2 * SSM_STATE) ** -0.5)
    ssm_C_im = nrm(ks[12], (L, N_SSM_GROUPS, SSM_GROUP, SSM_STATE), (2 * SSM_STATE) ** -0.5)
    ssm_D = nrm(ks[13], (L, D_SSM), 1.0)
    w_glu = nrm(ks[14], (L, D_SSM, D_SSM), D_SSM ** -0.5)
    w_proj_attn = nrm(ks[15], (L, D_ATTN, D_MODEL), D_ATTN ** -0.5)
    w_proj_ssm = nrm(ks[16], (L, D_SSM, D_MODEL), D_SSM ** -0.5)
    w_out = nrm(ks[17], (L, D_MODEL, D_MODEL), D_MODEL ** -0.5)
    norm_ffn_g = 1.0 + nrm(ks[18], (L, D_MODEL), 0.02)
    w_router_group = nrm(ks[19], (L, D_MODEL, N_EXPERT_GROUPS), D_MODEL ** -0.5)
    b_router_group = nrm(ks[20], (L, N_EXPERT_GROUPS), 0.01)
    w_router_expert = nrm(ks[21], (L, D_MODEL, N_EXPERTS), D_MODEL ** -0.5)
    b_router_expert = nrm(ks[22], (L, N_EXPERTS), 0.01)
    w_expert_gate = nrm(ks[23], (L, N_EXPERTS, D_MODEL, D_EXPERT), D_MODEL ** -0.5)
    w_expert_up = nrm(ks[24], (L, N_EXPERTS, D_MODEL, D_EXPERT), D_MODEL ** -0.5)
    w_expert_down = nrm(ks[25], (L, N_EXPERTS, D_EXPERT, D_MODEL), D_EXPERT ** -0.5)
    return {"x": x, "norm_mix_g": norm_mix_g, "w_in": w_in, "b_forget": b_forget,
            "q_norm_g": q_norm_g, "k_norm_g": k_norm_g,
            "ssm_A_re": ssm_A_re, "ssm_A_im": ssm_A_im, "ssm_log_dt": ssm_log_dt,
            "ssm_B_re": ssm_B_re, "ssm_B_im": ssm_B_im, "ssm_C_re": ssm_C_re, "ssm_C_im": ssm_C_im,
            "ssm_D": ssm_D, "w_glu": w_glu, "w_proj_attn": w_proj_attn, "w_proj_ssm": w_proj_ssm,
            "w_out": w_out, "norm_ffn_g": norm_ffn_g,
            "w_router_group": w_router_group, "b_router_group": b_router_group,
            "w_router_expert": w_router_expert, "b_router_expert": b_router_expert,
            "w_expert_gate": w_expert_gate, "w_expert_up": w_expert_up, "w_expert_down": w_expert_down}


def reference(x, norm_mix_g, w_in, b_forget, q_norm_g, k_norm_g,
              ssm_A_re, ssm_A_im, ssm_log_dt, ssm_B_re, ssm_B_im, ssm_C_re, ssm_C_im,
              ssm_D, w_glu, w_proj_attn, w_proj_ssm, w_out, norm_ffn_g,
              w_router_group, b_router_group, w_router_expert, b_router_expert,
              w_expert_gate, w_expert_up, w_expert_down):
    b, s, _ = x.shape
    splits = np.cumsum([D_ATTN, D_ATTN, D_ATTN, N_HEADS_ATTN, D_SSM, D_MODEL]).tolist()
    for l in range(DEPTH):
        h = _rmsnorm(x, norm_mix_g[l])
        z = h @ w_in[l]
        q, k, v, f, u_ssm, g_attn, g_ssm = jnp.split(z, splits, axis=-1)
        q = _rmsnorm(q.reshape(b, s, N_HEADS_ATTN, HEAD_DIM), q_norm_g[l])
        k = _rmsnorm(k.reshape(b, s, N_HEADS_ATTN, HEAD_DIM), k_norm_g[l])
        v = v.reshape(b, s, N_HEADS_ATTN, HEAD_DIM)
        y_attn = _forgetting_attention(q, k, v, f + b_forget[l]).reshape(b, s, D_ATTN)
        y_ssm = _s5(u_ssm, ssm_A_re[l], ssm_A_im[l], ssm_log_dt[l], ssm_B_re[l], ssm_B_im[l],
                    ssm_C_re[l], ssm_C_im[l], ssm_D[l], w_glu[l])
        mixed = (jax.nn.sigmoid(g_attn) * (y_attn @ w_proj_attn[l])
                 + jax.nn.sigmoid(g_ssm) * (y_ssm @ w_proj_ssm[l]))
        x = x + mixed @ w_out[l]
        x = x + _hier_moe(_rmsnorm(x, norm_ffn_g[l]), w_router_group[l], b_router_group[l],
                          w_router_expert[l], b_router_expert[l],
                          w_expert_gate[l], w_expert_up[l], w_expert_down[l])
    return x
```

```cpp
#include <hip/hip_runtime.h>
#include <stdint.h>
#include <math.h>

typedef unsigned short bf16;
constexpr int T = 16384, D = 1024, SEQ = 8192, NBATCH = 2, NH = 8, HD = 64, DA = 512, DS = 512, NG = 32, GC = 16, NP = 64, NE = 32, DE = 256;
constexpr int DIN = 4104, OQ = 0, OK_ = 512, OV = 1024, OF = 1536, OU = 1544, OGA = 2056, OGS = 3080;
constexpr int LCH = 32, NCR = T / LCH;
constexpr float EPS = 1e-6f;
constexpr float C2 = 0.125f * 1.4426950408889634f;
constexpr float LOG2E = 1.4426950408889634f;
constexpr int YROWS = 40960;

constexpr size_t MiB = 1u << 20;
constexpr size_t WS_CTL = 0;
constexpr size_t WS_CUM = 1 * MiB;
constexpr size_t WS_RSTD = 2 * MiB;
constexpr size_t WS_ROUTE = 2 * MiB + 256 * 1024;
constexpr size_t WS_LIST = 3 * MiB;
constexpr size_t WS_WPOS = 5 * MiB;
constexpr size_t WS_XN = 8 * MiB;
constexpr size_t WS_K = 40 * MiB;
constexpr size_t WS_V = 56 * MiB;
constexpr size_t WS_TMP = 8 * MiB;
constexpr size_t WS_X2B = 8 * MiB;
constexpr size_t WS_Q = 72 * MiB;
constexpr size_t WS_U2 = 88 * MiB;
constexpr size_t WS_GA = 104 * MiB;
constexpr size_t WS_GS = 136 * MiB;
constexpr size_t WS_Y = 88 * MiB;
constexpr size_t WS_Y1 = 168 * MiB;
constexpr size_t WS_YS = 184 * MiB;
constexpr size_t WS_H = 168 * MiB;
constexpr size_t WS_MIX = 200 * MiB;

__device__ __forceinline__ bf16 f2bf(float f) { unsigned u = __builtin_bit_cast(unsigned, f); return (bf16)((u + 0x7fffu + ((u >> 16) & 1u)) >> 16); }
__device__ __forceinline__ float bf2f(bf16 b) { return __builtin_bit_cast(float, (unsigned)b << 16); }
__device__ __forceinline__ float sigmoidf_(float x) { return 1.f / (1.f + __expf(-x)); }
__device__ __forceinline__ float gelu_tanh(float x) { const float z = 0.7978845608028654f * (x + 0.044715f * x * x * x); const float e = __expf(2.f * z); return 0.5f * x * (1.f + (1.f - 2.f / (e + 1.f))); }
__device__ __forceinline__ float log_sigmoid(float x) { return -(fmaxf(-x, 0.f) + log1pf(__expf(-fabsf(x)))); }

__global__ void __launch_bounds__(256) s0_norm(const float* __restrict__ x, const float* __restrict__ g, const float* __restrict__ w_in, const float* __restrict__ b_forget, bf16* __restrict__ XN, float* __restrict__ LOGF) {
    __shared__ float red[256]; __shared__ float fr[8][256];
    const int t = blockIdx.x, tid = threadIdx.x;
    float v[4]; float ss = 0.f;
    for (int i = 0; i < 4; ++i) { v[i] = x[(size_t)t * D + tid + 256 * i]; ss += v[i] * v[i]; }
    red[tid] = ss; __syncthreads();
    for (int o = 128; o > 0; o >>= 1) { if (tid < o) red[tid] += red[tid + o]; __syncthreads(); }
    const float rstd = rsqrtf(red[0] / D + EPS);
    float f[8]; for (int h = 0; h < 8; ++h) f[h] = 0.f;
    for (int i = 0; i < 4; ++i) { const int k = tid + 256 * i; const float xn = v[i] * rstd * g[k]; XN[(size_t)t * D + k] = f2bf(xn);
        for (int h = 0; h < 8; ++h) f[h] += xn * w_in[(size_t)k * DIN + OF + h]; }
    for (int h = 0; h < 8; ++h) fr[h][tid] = f[h];
    __syncthreads();
    for (int o = 128; o > 0; o >>= 1) { if (tid < o) for (int h = 0; h < 8; ++h) fr[h][tid] += fr[h][tid + o]; __syncthreads(); }
    if (tid < 8) { const int b = t / SEQ, s = t % SEQ; LOGF[((size_t)b * NH + tid) * SEQ + s] = log_sigmoid(fr[tid][0] + b_forget[tid]); }
}
__global__ void s1c_cumsum(float* __restrict__ CUM) {
    const int i = blockIdx.x * blockDim.x + threadIdx.x; if (i >= NBATCH * NH) return;
    double a = 0.0; float* p = CUM + (size_t)i * SEQ;
    for (int s = 0; s < SEQ; ++s) { a += (double)p[s]; p[s] = (float)a; }
}

struct EpiArgs { int mode; bf16* o0; float* f0; const float* g; const bf16* a0; const bf16* a1; const float* x; float* out; const float* wpos; int e; };
__device__ __forceinline__ void epilogue(const EpiArgs& E, float (&acc)[4][4], int bm, int bn, int ty, int tx, float* red) {
    if (E.mode == 0 || E.mode == 1) {
        if (threadIdx.x < 64) red[threadIdx.x] = 0.f; __syncthreads();
        for (int i = 0; i < 4; ++i) { float s = 0.f; for (int j = 0; j < 4; ++j) s += acc[i][j] * acc[i][j]; atomicAdd(&red[ty * 4 + i], s); }
        __syncthreads();
        for (int i = 0; i < 4; ++i) { const float rstd = rsqrtf(red[ty * 4 + i] / 64.f + EPS);
            for (int j = 0; j < 4; ++j) { const int c = tx * 4 + j; float v = acc[i][j] * rstd * E.g[c]; if (E.mode == 0) v *= C2; E.o0[(size_t)(bm + ty * 4 + i) * DA + bn + c] = f2bf(v); } }
        return;
    }
    for (int i = 0; i < 4; ++i) for (int j = 0; j < 4; ++j) {
        const int r = bm + ty * 4 + i, c = bn + tx * 4 + j; const float a = acc[i][j];
        switch (E.mode) {
        case 2: E.o0[(size_t)r * DA + c] = f2bf(a); break;
        case 3: { const int gi = c / GC, ci = c % GC, cr = r / LCH, jj = r % LCH; E.o0[(((size_t)gi * NCR + cr) * LCH + jj) * GC + ci] = f2bf(a); } break;
        case 4: E.o0[(size_t)r * D + c] = f2bf(sigmoidf_(a)); break;
        case 5: E.o0[(size_t)r * DS + c] = f2bf(bf2f(E.a0[(size_t)r * DS + c]) * sigmoidf_(a)); break;
        case 6: E.f0[(size_t)r * D + c] = bf2f(E.a0[(size_t)r * D + c]) * a; break;
        case 7: E.o0[(size_t)r * D + c] = f2bf(E.f0[(size_t)r * D + c] + bf2f(E.a0[(size_t)r * D + c]) * a); break;
        case 8: { const float v = E.x[(size_t)r * D + c] + a; E.out[(size_t)r * D + c] = v; E.o0[(size_t)r * D + c] = f2bf(v); } break;
        }
    }
}
__global__ void __launch_bounds__(256) gemm_naive(const bf16* __restrict__ A, int lda, const float* __restrict__ W, int ldw, int K, EpiArgs E) {
    __shared__ float As[16][65], Ws[16][65], red[64];
    const int tid = threadIdx.x, tx = tid % 16, ty = tid / 16, bm = blockIdx.y * 64, bn = blockIdx.x * 64;
    float acc[4][4]; for (int i = 0; i < 4; ++i) for (int j = 0; j < 4; ++j) acc[i][j] = 0.f;
    for (int k0 = 0; k0 < K; k0 += 16) {
        for (int i = 0; i < 4; ++i) { const int idx = tid + 256 * i; { const int r = idx / 16, c = idx % 16; As[c][r] = bf2f(A[(size_t)(bm + r) * lda + k0 + c]); }
            { const int r = idx / 64, c = idx % 64; Ws[r][c] = W[(size_t)(k0 + r) * ldw + bn + c]; } }
        __syncthreads();
#pragma unroll
        for (int kk = 0; kk < 16; ++kk) { float a[4], b[4];
            for (int i = 0; i < 4; ++i) { a[i] = As[kk][ty * 4 + i]; b[i] = Ws[kk][tx * 4 + i]; }
            for (int i = 0; i < 4; ++i) for (int j = 0; j < 4; ++j) acc[i][j] += a[i] * b[j]; }
        __syncthreads();
    }
    epilogue(E, acc, bm, bn, ty, tx, red);
}

__global__ void __launch_bounds__(64) s2_attn(const bf16* __restrict__ Q, const bf16* __restrict__ K, const bf16* __restrict__ V, const float* __restrict__ CUM, bf16* __restrict__ O) {
    const int bh = blockIdx.y, b = bh / NH, h = bh % NH, t = (gridDim.x - 1 - blockIdx.x) * 64 + threadIdx.x;
    const size_t rb = (size_t)b * SEQ;
    float q[64], o[64];
#pragma unroll
    for (int d = 0; d < 64; ++d) { q[d] = bf2f(Q[(rb + t) * DA + h * HD + d]); o[d] = 0.f; }
    const float* cum = CUM + ((size_t)b * NH + h) * SEQ; const float ft = cum[t] * LOG2E;
    float m = -1e30f, l = 0.f;
    const int smax = (gridDim.x - 1 - blockIdx.x) * 64 + 63;
    for (int s = 0; s <= smax; ++s) {
        const bf16* kr = K + (rb + s) * DA + h * HD; const bf16* vr = V + (rb + s) * DA + h * HD;
        float a = 0.f;
#pragma unroll
        for (int d = 0; d < 64; ++d) a += q[d] * bf2f(kr[d]);
        a += ft - cum[s] * LOG2E;
        if (s <= t) {
            const float mn = fmaxf(m, a), sc = exp2f(m - mn), p = exp2f(a - mn);
            l = l * sc + p;
#pragma unroll
            for (int d = 0; d < 64; ++d) o[d] = o[d] * sc + p * bf2f(vr[d]);
            m = mn;
        }
    }
    const float inv = 1.f / l;
#pragma unroll
    for (int d = 0; d < 64; ++d) O[(rb + t) * DA + h * HD + d] = f2bf(o[d] * inv);
}

__global__ void __launch_bounds__(64) s3_ssm(const bf16* __restrict__ U2, const float* __restrict__ A_re, const float* __restrict__ A_im, const float* __restrict__ log_dt,
        const float* __restrict__ B_re, const float* __restrict__ B_im, const float* __restrict__ C_re, const float* __restrict__ C_im, const float* __restrict__ Dsk, bf16* __restrict__ Y1) {
    const int b = blockIdx.x / NG, g = blockIdx.x % NG, p = threadIdx.x;
    const double dt = exp((double)log_dt[g]); const double ar = A_re[g * NP + p], ai = A_im[g * NP + p];
    const double er = exp(ar * dt); const double abr = er * cos(ai * dt), abi = er * sin(ai * dt);
    const double nr = abr - 1.0, ni = abi, den = ar * ar + ai * ai; const double fr_ = (nr * ar + ni * ai) / den, fi_ = (ni * ar - nr * ai) / den;
    float bbr[16], bbi[16], cr_[16], ci_[16];
#pragma unroll
    for (int c = 0; c < 16; ++c) { const double br = B_re[(g * NP + p) * GC + c], bi = B_im[(g * NP + p) * GC + c]; bbr[c] = (float)(fr_ * br - fi_ * bi); bbi[c] = (float)(fr_ * bi + fi_ * br);
        cr_[c] = C_re[(g * GC + c) * NP + p]; ci_[c] = C_im[(g * GC + c) * NP + p]; }
    const float fabr = (float)abr, fabi = (float)abi;
    float sr = 0.f, si = 0.f;
    for (int s = 0; s < SEQ; ++s) {
        const int t = b * SEQ + s, cr = t / LCH, jj = t % LCH; const bf16* up = U2 + (((size_t)g * NCR + cr) * LCH + jj) * GC;
        float u[16]; float bur = 0.f, bui = 0.f;
#pragma unroll
        for (int c = 0; c < 16; ++c) { u[c] = bf2f(up[c]); bur += bbr[c] * u[c]; bui += bbi[c] * u[c]; }
        const float nsr = fabr * sr - fabi * si + bur, nsi = fabr * si + fabi * sr + bui; sr = nsr; si = nsi;
#pragma unroll
        for (int c = 0; c < 16; ++c) { float y = cr_[c] * sr - ci_[c] * si;
            for (int o = 32; o > 0; o >>= 1) y += __shfl_xor(y, o);
            if (p == c) { const float yy = y + Dsk[g * GC + c] * u[c]; Y1[(size_t)t * DS + g * GC + c] = f2bf(gelu_tanh(yy)); } }
    }
}

__global__ void __launch_bounds__(64) s7_router(const bf16* __restrict__ X2B, const float* __restrict__ gffn, const float* __restrict__ w_rg, const float* __restrict__ b_rg, const float* __restrict__ w_re, const float* __restrict__ b_re,
        float* __restrict__ RSTD, int* __restrict__ ROUTE, int* __restrict__ CNT, int* __restrict__ LIST, float* __restrict__ WPOS) {
    __shared__ float lg[36]; __shared__ float red[64];
    const int t = blockIdx.x, tid = threadIdx.x;
    float ss = 0.f; for (int k = tid; k < D; k += 64) { const float v = bf2f(X2B[(size_t)t * D + k]); ss += v * v; }
    red[tid] = ss; __syncthreads();
    for (int o = 32; o > 0; o >>= 1) { if (tid < o) red[tid] += red[tid + o]; __syncthreads(); }
    const float rstd = rsqrtf(red[0] / D + EPS);
    if (tid < 36) { float a = 0.f;
        for (int k = 0; k < D; ++k) { const float xv = bf2f(X2B[(size_t)t * D + k]) * gffn[k]; a += xv * (tid < 4 ? w_rg[k * 4 + tid] : w_re[k * NE + tid - 4]); }
        lg[tid] = a * rstd + (tid < 4 ? b_rg[tid] : b_re[tid - 4]); }
    __syncthreads();
    if (tid == 0) {
        RSTD[t] = rstd;
        int gs = 0; float gm = lg[0]; for (int i = 1; i < 4; ++i) if (lg[i] > gm) { gm = lg[i]; gs = i; }
        float gsum = 0.f; for (int i = 0; i < 4; ++i) gsum += __expf(lg[i] - gm); const float gtop = 1.f / gsum;
        const float* el = lg + 4 + gs * 8; int i0 = 0; for (int i = 1; i < 8; ++i) if (el[i] > el[i0]) i0 = i;
        int i1 = (i0 == 0) ? 1 : 0; for (int i = 0; i < 8; ++i) if (i != i0 && el[i] > el[i1]) i1 = i;
        const float p1 = __expf(el[i1] - el[i0]);
        const float w0 = gtop / (1.f + p1), w1 = gtop * p1 / (1.f + p1);
        const int e0 = gs * 8 + i0, e1 = gs * 8 + i1;
        const int r0 = atomicAdd(&CNT[e0], 1), r1 = atomicAdd(&CNT[e1], 1);
        ROUTE[t * 4 + 0] = e0; ROUTE[t * 4 + 1] = e1; ROUTE[t * 4 + 2] = r0; ROUTE[t * 4 + 3] = r1;
        LIST[e0 * T + r0] = t; LIST[e1 * T + r1] = t; WPOS[e0 * T + r0] = w0; WPOS[e1 * T + r1] = w1;
    }
}
__device__ __forceinline__ int offpad_of(const int* CNT, int e) { int o = 0; for (int i = 0; i < e; ++i) o += (CNT[i] + 255) & ~255; return o; }

__global__ void __launch_bounds__(256) s8_moe_gu(const bf16* __restrict__ X2B, const float* __restrict__ gffn, const float* __restrict__ RSTD, const int* __restrict__ CNT, const int* __restrict__ LIST,
        const float* __restrict__ Wg, const float* __restrict__ Wu, bf16* __restrict__ H) {
    __shared__ float As[16][65], Gs[16][65], Us[16][65]; __shared__ int rows[64];
    const int e = blockIdx.z, cnt = CNT[e], bm = blockIdx.y * 64, bn = blockIdx.x * 64; if (bm >= cnt) return;
    const int tid = threadIdx.x, tx = tid % 16, ty = tid / 16; const int off = offpad_of(CNT, e);
    if (tid < 64) rows[tid] = LIST[e * T + min(bm + tid, cnt - 1)];
    __syncthreads();
    const float* wg = Wg + (size_t)e * D * DE; const float* wu = Wu + (size_t)e * D * DE;
    float ag[4][4], au[4][4]; for (int i = 0; i < 4; ++i) for (int j = 0; j < 4; ++j) { ag[i][j] = 0.f; au[i][j] = 0.f; }
    for (int k0 = 0; k0 < D; k0 += 16) {
        for (int i = 0; i < 4; ++i) { const int idx = tid + 256 * i; { const int r = idx / 16, c = idx % 16; As[c][r] = bf2f(X2B[(size_t)rows[r] * D + k0 + c]) * gffn[k0 + c]; }
            { const int r = idx / 64, c = idx % 64; Gs[r][c] = wg[(size_t)(k0 + r) * DE + bn + c]; Us[r][c] = wu[(size_t)(k0 + r) * DE + bn + c]; } }
        __syncthreads();
#pragma unroll
        for (int kk = 0; kk < 16; ++kk) { float a[4], b[4], c[4];
            for (int i = 0; i < 4; ++i) { a[i] = As[kk][ty * 4 + i]; b[i] = Gs[kk][tx * 4 + i]; c[i] = Us[kk][tx * 4 + i]; }
            for (int i = 0; i < 4; ++i) for (int j = 0; j < 4; ++j) { ag[i][j] += a[i] * b[j]; au[i][j] += a[i] * c[j]; } }
        __syncthreads();
    }
    for (int i = 0; i < 4; ++i) { const int r = bm + ty * 4 + i; if (r >= cnt) continue; const float rs = RSTD[rows[ty * 4 + i]];
        for (int j = 0; j < 4; ++j) { const float gg = ag[i][j] * rs, uu = au[i][j] * rs; H[(size_t)(off + r) * DE + bn + tx * 4 + j] = f2bf(gg * sigmoidf_(gg) * uu); } }
}
__global__ void __launch_bounds__(256) s9_moe_down(const bf16* __restrict__ H, const int* __restrict__ CNT, const float* __restrict__ WPOS, const float* __restrict__ Wd, bf16* __restrict__ Y) {
    __shared__ float As[16][65], Ws[16][65];
    const int e = blockIdx.z, cnt = CNT[e], bm = blockIdx.y * 64, bn = blockIdx.x * 64; if (bm >= cnt) return;
    const int tid = threadIdx.x, tx = tid % 16, ty = tid / 16; const int off = offpad_of(CNT, e);
    const float* wd = Wd + (size_t)e * DE * D;
    float acc[4][4]; for (int i = 0; i < 4; ++i) for (int j = 0; j < 4; ++j) acc[i][j] = 0.f;
    for (int k0 = 0; k0 < DE; k0 += 16) {
        for (int i = 0; i < 4; ++i) { const int idx = tid + 256 * i; { const int r = idx / 16, c = idx % 16; As[c][r] = (bm + r < cnt) ? bf2f(H[(size_t)(off + bm + r) * DE + k0 + c]) : 0.f; }
            { const int r = idx / 64, c = idx % 64; Ws[r][c] = wd[(size_t)(k0 + r) * D + bn + c]; } }
        __syncthreads();
#pragma unroll
        for (int kk = 0; kk < 16; ++kk) { float a[4], b[4];
            for (int i = 0; i < 4; ++i) { a[i] = As[kk][ty * 4 + i]; b[i] = Ws[kk][tx * 4 + i]; }
            for (int i = 0; i < 4; ++i) for (int j = 0; j < 4; ++j) acc[i][j] += a[i] * b[j]; }
        __syncthreads();
    }
    for (int i = 0; i < 4; ++i) { const int r = bm + ty * 4 + i; if (r >= cnt) continue; const float w = WPOS[e * T + r];
        for (int j = 0; j < 4; ++j) Y[(size_t)(off + r) * D + bn + tx * 4 + j] = f2bf(w * acc[i][j]); }
}
__global__ void __launch_bounds__(256) s10_combine(float* __restrict__ out, const bf16* __restrict__ Y, const int* __restrict__ ROUTE, const int* __restrict__ CNT) {
    const int t = blockIdx.x, tid = threadIdx.x;
    const int e0 = ROUTE[t * 4], e1 = ROUTE[t * 4 + 1], r0 = ROUTE[t * 4 + 2], r1 = ROUTE[t * 4 + 3];
    const size_t p0 = (size_t)(offpad_of(CNT, e0) + r0) * D, p1 = (size_t)(offpad_of(CNT, e1) + r1) * D;
    for (int i = 0; i < 4; ++i) { const int c = tid + 256 * i; out[(size_t)t * D + c] += bf2f(Y[p0 + c]) + bf2f(Y[p1 + c]); }
}

extern "C" void kernel_launch(void* const* d_in, const int* in_sizes, int n_in, void* d_out, int out_size, void* d_ws, size_t ws_size, hipStream_t stream) {
    const float* x = (const float*)d_in[0]; const float* norm_mix_g = (const float*)d_in[1]; const float* w_in = (const float*)d_in[2]; const float* b_forget = (const float*)d_in[3];
    const float* q_norm_g = (const float*)d_in[4]; const float* k_norm_g = (const float*)d_in[5];
    const float* A_re = (const float*)d_in[6]; const float* A_im = (const float*)d_in[7]; const float* log_dt = (const float*)d_in[8];
    const float* B_re = (const float*)d_in[9]; const float* B_im = (const float*)d_in[10]; const float* C_re = (const float*)d_in[11]; const float* C_im = (const float*)d_in[12];
    const float* ssm_D = (const float*)d_in[13]; const float* w_glu = (const float*)d_in[14]; const float* w_pa = (const float*)d_in[15]; const float* w_ps = (const float*)d_in[16];
    const float* w_out = (const float*)d_in[17]; const float* norm_ffn_g = (const float*)d_in[18];
    const float* w_rg = (const float*)d_in[19]; const float* b_rg = (const float*)d_in[20]; const float* w_re = (const float*)d_in[21]; const float* b_re = (const float*)d_in[22];
    const float* w_eg = (const float*)d_in[23]; const float* w_eu = (const float*)d_in[24]; const float* w_ed = (const float*)d_in[25];
    float* out = (float*)d_out; char* ws = (char*)d_ws;
    int* CNT = (int*)(ws + WS_CTL); float* CUM = (float*)(ws + WS_CUM); float* RSTD = (float*)(ws + WS_RSTD); int* ROUTE = (int*)(ws + WS_ROUTE); int* LIST = (int*)(ws + WS_LIST); float* WPOS = (float*)(ws + WS_WPOS);
    bf16* XN = (bf16*)(ws + WS_XN); bf16* Kb = (bf16*)(ws + WS_K); bf16* Vb = (bf16*)(ws + WS_V); float* TMP = (float*)(ws + WS_TMP); bf16* X2B = (bf16*)(ws + WS_X2B);
    bf16* Qb = (bf16*)(ws + WS_Q); bf16* U2 = (bf16*)(ws + WS_U2); bf16* GA = (bf16*)(ws + WS_GA); bf16* GS = (bf16*)(ws + WS_GS); bf16* Yb = (bf16*)(ws + WS_Y);
    bf16* Y1 = (bf16*)(ws + WS_Y1); bf16* YS = (bf16*)(ws + WS_YS); bf16* Hb = (bf16*)(ws + WS_H); bf16* MIX = (bf16*)(ws + WS_MIX);
    hipMemsetAsync(ws + WS_CTL, 0, 4096, stream);
    s0_norm<<<T, 256, 0, stream>>>(x, norm_mix_g, w_in, b_forget, XN, CUM);
    s1c_cumsum<<<1, 64, 0, stream>>>(CUM);
    auto gemm = [&](const bf16* A, int lda, const float* W, int ldw, int M, int N, int K, EpiArgs E) { gemm_naive<<<dim3(N / 64, M / 64), 256, 0, stream>>>(A, lda, W, ldw, K, E); };
    { EpiArgs E{}; E.mode = 0; E.o0 = Qb; E.g = q_norm_g; gemm(XN, D, w_in + OQ, DIN, T, DA, D, E); }
    { EpiArgs E{}; E.mode = 1; E.o0 = Kb; E.g = k_norm_g; gemm(XN, D, w_in + OK_, DIN, T, DA, D, E); }
    { EpiArgs E{}; E.mode = 2; E.o0 = Vb; gemm(XN, D, w_in + OV, DIN, T, DA, D, E); }
    { EpiArgs E{}; E.mode = 3; E.o0 = U2; gemm(XN, D, w_in + OU, DIN, T, DS, D, E); }
    { EpiArgs E{}; E.mode = 4; E.o0 = GA; gemm(XN, D, w_in + OGA, DIN, T, D, D, E); }
    { EpiArgs E{}; E.mode = 4; E.o0 = GS; gemm(XN, D, w_in + OGS, DIN, T, D, D, E); }
    s2_attn<<<dim3(SEQ / 64, NBATCH * NH), 64, 0, stream>>>(Qb, Kb, Vb, CUM, Qb);
    s3_ssm<<<NBATCH * NG, 64, 0, stream>>>(U2, A_re, A_im, log_dt, B_re, B_im, C_re, C_im, ssm_D, Y1);
    { EpiArgs E{}; E.mode = 5; E.o0 = YS; E.a0 = Y1; gemm(Y1, DS, w_glu, DS, T, DS, DS, E); }
    { EpiArgs E{}; E.mode = 6; E.f0 = TMP; E.a0 = GA; gemm(Qb, DA, w_pa, D, T, D, DA, E); }
    { EpiArgs E{}; E.mode = 7; E.f0 = TMP; E.a0 = GS; E.o0 = MIX; gemm(YS, DS, w_ps, D, T, D, DS, E); }
    { EpiArgs E{}; E.mode = 8; E.x = x; E.out = out; E.o0 = X2B; gemm(MIX, D, w_out, D, T, D, D, E); }
    s7_router<<<T, 64, 0, stream>>>(X2B, norm_ffn_g, w_rg, b_rg, w_re, b_re, RSTD, ROUTE, CNT, LIST, WPOS);
    s8_moe_gu<<<dim3(DE / 64, T / 64, NE), 256, 0, stream>>>(X2B, norm_ffn_g, RSTD, CNT, LIST, w_eg, w_eu, Hb);
    s9_moe_down<<<dim3(D / 64, T / 64, NE), 256, 0, stream>>>(Hb, CNT, WPOS, w_ed, Yb);
    s10_combine<<<T, 256, 0, stream>>>(out, Yb, ROUTE, CNT);
}
```

```cpp
#include <hip/hip_runtime.h>
#include <stdint.h>
#include <math.h>

typedef unsigned short bf16;
constexpr int T = 16384, D = 1024, SEQ = 8192, NBATCH = 2, NH = 8, HD = 64, DA = 512, DS = 512, NG = 32, GC = 16, NP = 64, NE = 32, DE = 256;
constexpr int DIN = 4104, OQ = 0, OK_ = 512, OV = 1024, OF = 1536, OU = 1544, OGA = 2056, OGS = 3080;
constexpr int LCH = 32, NCR = T / LCH;
constexpr int U2P = 640;
constexpr float EPS = 1e-6f;
constexpr float C2 = 0.125f * 1.4426950408889634f;
constexpr float LOG2E = 1.4426950408889634f;
constexpr int YROWS = 40960;

constexpr size_t MiB = 1u << 20;
constexpr size_t WS_CTL = 0, CTL_ZERO_BYTES = 1 * MiB;
constexpr size_t WS_CUM = 1 * MiB;
constexpr size_t WS_AL = 1 * MiB + 512 * 1024;
constexpr size_t WS_RSTD = 2 * MiB;
constexpr size_t WS_ROUTE = 2 * MiB + 256 * 1024;
constexpr size_t WS_LIST = 3 * MiB;
constexpr size_t WS_WPOS = 5 * MiB;
constexpr size_t WS_SSP = 7 * MiB;
constexpr size_t WS_WIN = 8 * MiB;
constexpr size_t WS_SLOC = 8 * MiB;
constexpr size_t WS_WGLU = 16 * MiB, WS_WPA = 16 * MiB + 512 * 1024, WS_WPS = 17 * MiB + 512 * 1024, WS_WOUT = 18 * MiB + 512 * 1024, WS_WR = 20 * MiB + 512 * 1024;
constexpr size_t WS_M1T = 21 * MiB;
constexpr size_t WS_BTY = 29 * MiB;
constexpr size_t WS_XN = 49 * MiB;
constexpr size_t WS_WGU = 49 * MiB;
constexpr size_t WS_Q = 81 * MiB;
constexpr size_t WS_K = 97 * MiB;
constexpr size_t WS_V = 113 * MiB;
constexpr size_t WS_Y1 = 97 * MiB, WS_YS = 113 * MiB;
constexpr size_t WS_U2X = 129 * MiB;
constexpr size_t WS_GA = 149 * MiB;
constexpr size_t WS_GS = 181 * MiB;
constexpr size_t WS_X2B = 181 * MiB;
constexpr size_t WS_WD = 213 * MiB;
constexpr size_t WS_H = 229 * MiB;
constexpr size_t WS_RPOS = 249 * MiB;
constexpr size_t WS_Y = 81 * MiB;
static_assert(WS_H + (size_t)YROWS * DE * 2 <= WS_RPOS && WS_RPOS + 2 * MiB <= 256 * MiB && WS_Y + (size_t)YROWS * D * 2 <= WS_GS, "d_ws map");

__device__ __forceinline__ bf16 f2bf(float f) { unsigned u = __builtin_bit_cast(unsigned, f); return (bf16)((u + 0x7fffu + ((u >> 16) & 1u)) >> 16); }
__device__ __forceinline__ float bf2f(bf16 b) { return __builtin_bit_cast(float, (unsigned)b << 16); }
__device__ __forceinline__ float sigmoidf_(float x) { return 1.f / (1.f + __expf(-x)); }
__device__ __forceinline__ float gelu_tanh(float x) { const float z = 0.7978845608028654f * (x + 0.044715f * x * x * x); const float e = __expf(2.f * z); return 0.5f * x * (1.f + (1.f - 2.f / (e + 1.f))); }
__device__ __forceinline__ float log_sigmoid(float x) { return -(fmaxf(-x, 0.f) + log1pf(__expf(-fabsf(x)))); }
__device__ __forceinline__ size_t u2x_index(int g, int t, int c) { return ((size_t)g * NCR + (t / LCH)) * U2P + 128 + (t % LCH) * GC + c; }

#define LAS __attribute__((address_space(3)))
#define GAS __attribute__((address_space(1)))
typedef short bf16x8 __attribute__((ext_vector_type(8)));
typedef float f32x4 __attribute__((ext_vector_type(4)));
typedef float f32x2 __attribute__((ext_vector_type(2)));
typedef unsigned u32x4 __attribute__((ext_vector_type(4)));
typedef unsigned u32x2 __attribute__((ext_vector_type(2)));
namespace pg {
constexpr int BM = 256, BK = 64, HALF = 128, HTB = HALF * BK * 2, STAGE_BYTES = 8 * HTB, NXCD = 8, WGM = 8;
__host__ __device__ __forceinline__ int lds_byte(int r, int c) { const int st = (r >> 4) * 2 + (c >> 5), rr = r & 15, cc = c & 31, ob = rr * 64 + cc * 2; return st * 1024 + (ob ^ (((ob >> 9) & 1) << 5)); }
__host__ __device__ __forceinline__ void stage_rc(int b, int& R, int& C) { const int st = b / 1024, sb = b % 1024, swz = sb ^ (((sb >> 9) & 1) << 5); R = (st >> 1) * 16 + swz / 64; C = (st & 1) * 32 + (swz % 64) / 2; }
__host__ __device__ __forceinline__ int perm32(int rho) { const int n = rho >> 4, i = rho & 15; return 8 * (i >> 2) + 4 * n + (i & 3); }
typedef __bf16 bf16x2_t __attribute__((ext_vector_type(2)));
__device__ __forceinline__ unsigned cvt_pk_bf16(float lo, float hi) { const f32x2 v = {lo, hi}; const bf16x2_t b = __builtin_convertvector(v, bf16x2_t); return __builtin_bit_cast(unsigned, b); }
__device__ __forceinline__ u32x4 pack8(const f32x4& a, const f32x4& b) { u32x4 w; w.x = cvt_pk_bf16(a[0], a[1]); w.y = cvt_pk_bf16(a[2], a[3]); w.z = cvt_pk_bf16(b[0], b[1]); w.w = cvt_pk_bf16(b[2], b[3]); return w; }
__device__ __forceinline__ void unpack8(const u32x4& w, f32x4& a, f32x4& b) {
    a[0] = __builtin_bit_cast(float, w.x << 16); a[1] = __builtin_bit_cast(float, w.x & 0xffff0000u); a[2] = __builtin_bit_cast(float, w.y << 16); a[3] = __builtin_bit_cast(float, w.y & 0xffff0000u);
    b[0] = __builtin_bit_cast(float, w.z << 16); b[1] = __builtin_bit_cast(float, w.z & 0xffff0000u); b[2] = __builtin_bit_cast(float, w.w << 16); b[3] = __builtin_bit_cast(float, w.w & 0xffff0000u); }
__device__ __forceinline__ float fsigmoid(float x) { return __builtin_amdgcn_rcpf(1.f + __builtin_amdgcn_exp2f(-1.4426950408889634f * x)); }

struct Unit { const char* A; const char* B; int nt; int pm, pn, aux; };

struct StaticOrder {
    int nM, nN, nwg, G, c;
    __device__ void init(int nM_, int nN_, int G_, int c_) { nM = nM_; nN = nN_; nwg = nM * nN; G = G_; c = c_; }
    __device__ bool next(int i, int& pm, int& pn) const {
        const long L = (long)i * G + c; if (L >= nwg) return false;
        int wgid = (int)L; { const int q = nwg / NXCD, r = nwg % NXCD, xcd = wgid % NXCD, off = wgid / NXCD; wgid = (xcd < r ? xcd * (q + 1) : r * (q + 1) + (xcd - r) * q) + off; }
        const int nig = WGM * nN, gid = wgid / nig, fm = gid * WGM, gsz = (nM - fm) < WGM ? (nM - fm) : WGM;
        pm = fm + ((wgid % nig) % gsz); pn = (wgid % nig) / gsz; return true;
    }
};

template <class P>
__device__ __forceinline__ void gemm_phase(LAS unsigned char* lds, P& ph) {
    const int tid = threadIdx.x, wid = __builtin_amdgcn_readfirstlane(tid >> 6), lane = tid & 63, wr = wid >> 2, wc = wid & 3, fr = lane & 15, fq = lane >> 4;
    const unsigned lda = ph.lda, ldb = ph.ldb;
    int Rr[2], Cc[2]; unsigned voffB[2], vo[2][2], nvo[2][2];
#pragma unroll
    for (int i = 0; i < 2; ++i) { stage_rc(tid * 16 + i * 8192, Rr[i], Cc[i]); const int Rb = (Rr[i] & ~31) + perm32(Rr[i] & 31); voffB[i] = (unsigned)Rb * ldb + (unsigned)Cc[i] * 2u; }
    const size_t kstep = (size_t)(BK * 2);
    const size_t hstepB = (size_t)HALF * ldb;
    const unsigned ldsw = (unsigned)wid * 1024u;
    const int aoff = lds_byte(wr * 64 + fr, fq * 8), boff = lds_byte(wc * 32 + fr, fq * 8);
#define PG_SA(b, h) (((b) * 2 + (h)) * HTB)
#define PG_SB(b, h) ((4 + (b) * 2 + (h)) * HTB)
#define PG_STAGE_B(bufoff, gbase) do { _Pragma("unroll") for (int _i = 0; _i < 2; ++_i) \
        __builtin_amdgcn_global_load_lds((const unsigned*)((const char*)(gbase) + voffB[_i]), (LAS unsigned*)(lds + (bufoff) + ldsw + _i * 8192), 16, 0, 0); } while (0)
#define PG_STAGE_A(bufoff, gbase, VO, h) do { _Pragma("unroll") for (int _i = 0; _i < 2; ++_i) \
        __builtin_amdgcn_global_load_lds((const unsigned*)((const char*)(gbase) + (VO)[h][_i]), (LAS unsigned*)(lds + (bufoff) + ldsw + _i * 8192), 16, 0, 0); } while (0)
#define PG_LDA(dst, b, h) do { _Pragma("unroll") for (int m = 0; m < 4; ++m) _Pragma("unroll") for (int k = 0; k < 2; ++k) dst[m][k] = *(const LAS bf16x8*)(lds + PG_SA(b, h) + aoff + m * 2048 + k * 1024); } while (0)
#define PG_LDB(dst, b, h) do { _Pragma("unroll") for (int n = 0; n < 2; ++n) _Pragma("unroll") for (int k = 0; k < 2; ++k) dst[n][k] = *(const LAS bf16x8*)(lds + PG_SB(b, h) + boff + n * 2048 + k * 1024); } while (0)
#define PG_MMA(ai, bj, At, Bt) do { __builtin_amdgcn_s_setprio(1); _Pragma("unroll") for (int m = 0; m < 4; ++m) _Pragma("unroll") for (int n = 0; n < 2; ++n) _Pragma("unroll") for (int k = 0; k < 2; ++k) \
        acc[ai][bj][m][n] = __builtin_amdgcn_mfma_f32_16x16x32_bf16(Bt[n][k], At[m][k], acc[ai][bj][m][n], 0, 0, 0); __builtin_amdgcn_s_setprio(0); } while (0)
#define PG_WAIT_V(n) asm volatile("s_waitcnt vmcnt(" #n ")" ::: "memory")
#define PG_WAIT_L(n) asm volatile("s_waitcnt lgkmcnt(" #n ")" ::: "memory")
#define PG_BAR __builtin_amdgcn_s_barrier()
#define PG_SCHED __builtin_amdgcn_sched_barrier(0)
    Unit cur, nxt; int ui = 0;
    if (!ph.next(0, cur)) return;
    ph.offs(cur, Rr, Cc, vo);
    f32x4 acc[2][2][4][2];
#pragma unroll
    for (int a = 0; a < 2; ++a)
#pragma unroll
        for (int b = 0; b < 2; ++b)
#pragma unroll
            for (int m = 0; m < 4; ++m)
#pragma unroll
                for (int n = 0; n < 2; ++n) acc[a][b][m][n] = (f32x4){0.f, 0.f, 0.f, 0.f};
    bf16x8 At[4][2], B0[2][2], B1[2][2];
    const char* cA = cur.A; const char* cB = cur.B;
    PG_STAGE_B(PG_SB(0, 0), cB); PG_STAGE_B(PG_SB(0, 1), cB + hstepB); PG_STAGE_A(PG_SA(0, 0), cA, vo, 0); PG_STAGE_A(PG_SA(0, 1), cA, vo, 1);
    if (wr == 1) PG_BAR;
    PG_WAIT_V(2); PG_BAR;
    PG_STAGE_B(PG_SB(1, 0), cB + kstep); PG_STAGE_A(PG_SA(1, 0), cA + kstep, vo, 0); PG_STAGE_B(PG_SB(1, 1), cB + hstepB + kstep);
    PG_WAIT_V(6); PG_BAR;
    for (;;) {
        const bool has_next = ph.next(ui + 1, nxt);
        const int nt = cur.nt;
        const char* nA = has_next ? nxt.A : cA; const char* nB = has_next ? nxt.B : cB;
        if (P::GATHER) { if (has_next) ph.offs(nxt, Rr, Cc, nvo); else {
#pragma unroll
            for (int h = 0; h < 2; ++h)
#pragma unroll
                for (int i = 0; i < 2; ++i) nvo[h][i] = vo[h][i]; } }
#pragma unroll 1
        for (int t = 0; t < nt; t += 2) {
            const bool last = (t == nt - 2);
            const char* a1 = cA + (size_t)(t + 1) * kstep;
            const char* a2 = last ? nA : cA + (size_t)(t + 2) * kstep; const char* b2 = last ? nB : cB + (size_t)(t + 2) * kstep;
            const char* a3 = a2 + kstep; const char* b3 = b2 + kstep;
            unsigned v2[2][2];
#pragma unroll
            for (int h = 0; h < 2; ++h)
#pragma unroll
                for (int i = 0; i < 2; ++i) v2[h][i] = (P::GATHER && last) ? nvo[h][i] : vo[h][i];
            PG_LDB(B0, 0, 0); PG_LDB(B1, 0, 1); PG_SCHED; PG_LDA(At, 0, 0); PG_STAGE_A(PG_SA(1, 1), a1, vo, 1);
            PG_WAIT_V(8); PG_WAIT_L(0); PG_BAR; PG_MMA(0, 0, At, B0); PG_MMA(0, 1, At, B1); PG_BAR; PG_SCHED;
            PG_LDA(At, 0, 1); PG_STAGE_B(PG_SB(0, 0), b2); PG_STAGE_B(PG_SB(0, 1), b2 + hstepB); PG_STAGE_A(PG_SA(0, 0), a2, v2, 0);
            PG_WAIT_V(8); PG_WAIT_L(0); PG_BAR; PG_MMA(1, 0, At, B0); PG_MMA(1, 1, At, B1); PG_BAR; PG_SCHED;
            PG_LDB(B0, 1, 0); PG_LDB(B1, 1, 1); PG_SCHED; PG_LDA(At, 1, 0); PG_STAGE_A(PG_SA(0, 1), a2, v2, 1);
            PG_WAIT_V(8); PG_WAIT_L(0); PG_BAR; PG_MMA(0, 0, At, B0); PG_MMA(0, 1, At, B1); PG_BAR; PG_SCHED;
            PG_LDA(At, 1, 1); PG_STAGE_B(PG_SB(1, 0), b3); PG_STAGE_B(PG_SB(1, 1), b3 + hstepB); PG_STAGE_A(PG_SA(1, 0), a3, v2, 0);
            PG_WAIT_V(8); PG_WAIT_L(0); PG_BAR; PG_MMA(1, 0, At, B0); PG_MMA(1, 1, At, B1); PG_BAR; PG_SCHED;
        }
        if (wr == 0) PG_BAR;
        ph.epi(acc, cur, wr, wc, fr, fq);
        if (!has_next) break;
#pragma unroll
        for (int a = 0; a < 2; ++a)
#pragma unroll
            for (int b = 0; b < 2; ++b)
#pragma unroll
                for (int m = 0; m < 4; ++m)
#pragma unroll
                    for (int n = 0; n < 2; ++n) acc[a][b][m][n] = (f32x4){0.f, 0.f, 0.f, 0.f};
        cur = nxt; cA = nA; cB = nB; ++ui;
        if (P::GATHER) {
#pragma unroll
            for (int h = 0; h < 2; ++h)
#pragma unroll
                for (int i = 0; i < 2; ++i) vo[h][i] = nvo[h][i]; }
        if (wr == 1) PG_BAR;
    }
    PG_WAIT_V(0);
    PG_BAR;
#undef PG_SA
#undef PG_SB
#undef PG_STAGE_A
#undef PG_STAGE_B
#undef PG_LDA
#undef PG_LDB
#undef PG_MMA
#undef PG_WAIT_V
#undef PG_WAIT_L
#undef PG_BAR
#undef PG_SCHED
}
__device__ __forceinline__ void offs_plain(unsigned lda, const int (&R)[2], const int (&C)[2], unsigned (&vo)[2][2]) {
#pragma unroll
    for (int h = 0; h < 2; ++h)
#pragma unroll
        for (int i = 0; i < 2; ++i) vo[h][i] = (unsigned)(h * HALF + R[i]) * lda + (unsigned)C[i] * 2u;
}
}

namespace attn_body {
using bf16=unsigned short;
using bf16x8=__attribute__((ext_vector_type(8)))short;
using s16x4=__attribute__((ext_vector_type(4)))short;
using f32x16=__attribute__((ext_vector_type(16)))float;
using u32x4=__attribute__((ext_vector_type(4)))unsigned;
constexpr int BATCH=2,NHEAD=8,SEQ=8192,D=64,DM=NHEAD*D;
constexpr int NW=8,QBLK=32,QB=QBLK*NW,KVBLK=64,NQB=SEQ/QB;
constexpr int ATTN_PITCH=DM, ATTN_UNIT_ROWS=QB;
__device__ __forceinline__ int crow(int r,int hi){return (r&3)+8*(r>>2)+4*hi;}
__device__ __forceinline__ unsigned short f2bf_a(float f){unsigned u=__builtin_bit_cast(unsigned,f);return (unsigned short)((u+0x7fffu+((u>>16)&1u))>>16);}
#define SBAR() __builtin_amdgcn_sched_barrier(0)
__device__ __forceinline__ void cmask(f32x16&p0,f32x16&p1,int jb,int qrel,int hi){
  const float NEG=-INFINITY; int kb=64*jb+4*hi;
  #pragma unroll
  for(int r=0;r<16;++r){int kv=kb+(r&3)+8*(r>>2); if(kv>qrel)p0[r]=NEG; if(kv+32>qrel)p1[r]=NEG;}
}

constexpr int NSLOT=3, SLOTB=8192;
constexpr int LDS_K=0, LDS_V=NSLOT*SLOTB, LDS_WS=2*NSLOT*SLOTB, LDS_OST=LDS_WS+NW*64*4, LDS_FK=LDS_OST+NW*4096, LDS_BYTES=LDS_FK+SEQ*4+1024;
constexpr float C2=0.125f*1.4426950408889634f;
__device__ __forceinline__ void glds16(const void*gsrc,unsigned lds_dst){unsigned keep;
  asm volatile("s_mov_b32 %0, m0\n\ts_mov_b32 m0, %2\n\ts_nop 0\n\tglobal_load_lds_dwordx4 %1, off\n\ts_mov_b32 m0, %0":"=&s"(keep):"v"(gsrc),"s"(lds_dst):"memory");}
__device__ __forceinline__ float max3f(float a,float b,float c){float r;asm("v_max3_f32 %0, %1, %2, %3":"=v"(r):"v"(a),"v"(b),"v"(c));return r;}
__device__ __forceinline__ float max2f(float a,float b){float r;asm("v_max_f32_e32 %0, %1, %2":"=v"(r):"v"(a),"v"(b));return r;}
__device__ __forceinline__ float fadd_s(float a,float b){float r;asm("v_add_f32_e32 %0, %1, %2":"=v"(r):"v"(a),"v"(b));return r;}
__device__ __forceinline__ float fsub_s(float a,float b){float r;asm("v_sub_f32_e32 %0, %1, %2":"=v"(r):"v"(a),"v"(b));return r;}
typedef float f32x4_t __attribute__((ext_vector_type(4)));
typedef float f32x2_t __attribute__((ext_vector_type(2))); typedef __bf16 bf16x2_t __attribute__((ext_vector_type(2)));
__device__ __forceinline__ unsigned cvtpk_s(float lo,float hi){f32x2_t v={lo,hi};bf16x2_t b=__builtin_convertvector(v,bf16x2_t);return __builtin_bit_cast(unsigned,b);}
#define WAIT_BAR(N) asm volatile("s_waitcnt vmcnt(" #N ") lgkmcnt(0)\n\ts_barrier":::"memory")

__device__ __forceinline__ void qkt(f32x16&p0,f32x16&p1,const char*Kslot,const bf16x8*qr,int r32,int hi){
  const char*kb=Kslot+hi*1024+r32*16;
  #pragma unroll
  for(int d0=0;d0<4;++d0){
    const bf16x8 b0=*reinterpret_cast<const bf16x8*>(kb+d0*2048);
    const bf16x8 b1=*reinterpret_cast<const bf16x8*>(kb+d0*2048+512);
    p0=__builtin_amdgcn_mfma_f32_32x32x16_bf16(b0,qr[d0],p0,0,0,0);p1=__builtin_amdgcn_mfma_f32_32x32x16_bf16(b1,qr[d0],p1,0,0,0);}
}
typedef __attribute__((address_space(3))) const char* lds_cptr;
typedef short v4i16_t __attribute__((ext_vector_type(4)));
__device__ __forceinline__ void kload8(bf16x8*kf,lds_cptr kp){
  kf[0]=*(const __attribute__((address_space(3))) bf16x8*)(kp);      kf[1]=*(const __attribute__((address_space(3))) bf16x8*)(kp+512);
  kf[2]=*(const __attribute__((address_space(3))) bf16x8*)(kp+2048); kf[3]=*(const __attribute__((address_space(3))) bf16x8*)(kp+2560);
  kf[4]=*(const __attribute__((address_space(3))) bf16x8*)(kp+4096); kf[5]=*(const __attribute__((address_space(3))) bf16x8*)(kp+4608);
  kf[6]=*(const __attribute__((address_space(3))) bf16x8*)(kp+6144); kf[7]=*(const __attribute__((address_space(3))) bf16x8*)(kp+6656);
}
__device__ __forceinline__ void kload2(bf16x8*kf,lds_cptr kp,int j){ kf[2*j]=*(const __attribute__((address_space(3))) bf16x8*)(kp+j*2048); kf[2*j+1]=*(const __attribute__((address_space(3))) bf16x8*)(kp+j*2048+512); }
__device__ __forceinline__ s16x4 vtr(lds_cptr p){ return __builtin_bit_cast(s16x4,__builtin_amdgcn_ds_read_tr16_b64_v4i16((__attribute__((address_space(3))) v4i16_t*)p)); }
__device__ __forceinline__ float rowmax(const f32x16&p0,const f32x16&p1){
  float a=max3f(p0[0],p0[1],p1[0]),b=max3f(p0[2],p0[3],p1[1]);a=max3f(a,p1[2],p1[3]);
  #pragma unroll
  for(int r=4;r<16;r+=4){a=max3f(a,p0[r],p0[r+1]);b=max3f(b,p0[r+2],p0[r+3]);a=max3f(a,p1[r],p1[r+1]);b=max3f(b,p1[r+2],p1[r+3]);}
  const float m=max2f(a,b);
  auto rr=__builtin_amdgcn_permlane32_swap(__float_as_uint(m),__float_as_uint(m),false,false);
  return max2f(__uint_as_float(rr[0]),__uint_as_float(rr[1]));
}
__device__ __forceinline__ void pv(f32x16*o,int vb,bf16x8 pa0,bf16x8 pa1,bf16x8 pa2,bf16x8 pa3){
  #pragma unroll
  for(int d0=0;d0<2;++d0){s16x4 lo[4],hi[4];
    #pragma unroll
    for(int ks=0;ks<4;++ks){
      asm volatile("ds_read_b64_tr_b16 %0,%1 offset:%c2":"=&v"(lo[ks]):"v"(vb),"i"(d0*4096+ks*1024):"memory");
      asm volatile("ds_read_b64_tr_b16 %0,%1 offset:%c2":"=&v"(hi[ks]):"v"(vb),"i"(d0*4096+ks*1024+512):"memory");}
    asm volatile("s_waitcnt lgkmcnt(0)":::"memory");SBAR();
    #define PK(k) (bf16x8){lo[k][0],lo[k][1],lo[k][2],lo[k][3],hi[k][0],hi[k][1],hi[k][2],hi[k][3]}
    o[d0]=__builtin_amdgcn_mfma_f32_32x32x16_bf16(pa0,PK(0),o[d0],0,0,0);
    o[d0]=__builtin_amdgcn_mfma_f32_32x32x16_bf16(pa1,PK(1),o[d0],0,0,0);
    o[d0]=__builtin_amdgcn_mfma_f32_32x32x16_bf16(pa2,PK(2),o[d0],0,0,0);
    o[d0]=__builtin_amdgcn_mfma_f32_32x32x16_bf16(pa3,PK(3),o[d0],0,0,0);
    #undef PK
  }
}

#ifndef ATTN_STORE16
#define ATTN_STORE16(p,v) (*(u32x4*)(p)=(v))
#endif
template<int THRL> __device__ __forceinline__ void attn_unit(int b,int h,int qb,const bf16*Q,const bf16*__restrict__ K,const bf16*__restrict__ V,bf16*O,const float*__restrict__ CUM,char*shm){
  const int tid=threadIdx.x,lane=tid&63,r32=lane&31,hi=lane>>5; const int wid=__builtin_amdgcn_readfirstlane(tid>>6);
  const long rowbase=(long)b*SEQ; const int q0=qb*QB;
  const bf16*Qw=Q+(rowbase+q0+wid*QBLK)*DM+h*D;
  const bf16*Kh=K+rowbase*DM+h*D,*Vh=V+rowbase*DM+h*D; const float*Fh=CUM+((long)b*NHEAD+h)*SEQ;
  const unsigned lds0=(unsigned)(uintptr_t)shm;
  float*wsf=(float*)(shm+LDS_WS)+wid*64;
  const bf16*ksrc=Kh+(long)lane*DM+wid*8;
  const bf16*vsrc=Vh+(long)(16*(wid&3)+(lane>>2))*DM+(wid>>2)*32+(lane&3)*8;
  const unsigned kdst=lds0+LDS_K+wid*1024, vdst=lds0+LDS_V+wid*1024;
  #define DMA_K(t,slot) glds16(ksrc+(long)(t)*KVBLK*DM,(unsigned)__builtin_amdgcn_readfirstlane(kdst+(slot)))
  #define DMA_V(t,slot) glds16(vsrc+(long)(t)*KVBLK*DM,(unsigned)__builtin_amdgcn_readfirstlane(vdst+(slot)))
  const int vb0=(int)(lds0+LDS_V)+((lane>>4)&1)*32+(lane&3)*8+(4*hi+((lane&15)>>2))*64;
  const char*Kbase=shm+LDS_K; bf16x8 kf[8];
  const lds_cptr shm3=(lds_cptr)shm; const lds_cptr kp0=shm3+LDS_K+hi*1024+r32*16; const lds_cptr vp0=shm3+LDS_V+((lane>>4)&1)*32+(lane&3)*8+(4*hi+((lane&15)>>2))*64;
  const int NT=(q0+QB)/KVBLK;
  for(int p_=wid;p_<=qb;p_+=NW) glds16(Fh+p_*256+lane*4,(unsigned)__builtin_amdgcn_readfirstlane(lds0+LDS_FK+p_*1024));
  DMA_K(0,0);DMA_V(0,0);DMA_K(1,SLOTB);
  bf16x8 qr[4];
  #pragma unroll
  for(int d0=0;d0<4;++d0)qr[d0]=*reinterpret_cast<const bf16x8*>(&Qw[(long)r32*DM+d0*16+hi*8]);
  const float fq2=Fh[q0+wid*QBLK+r32];
  float mhat=0.f,l_reg=0.f;f32x16 o[2];o[0]=f32x16{};o[1]=f32x16{};float nb=fq2;
  const lds_cptr fkp=(lds_cptr)shm+LDS_FK+hi*16;
  const int qrel=wid*QBLK+r32;
  #define CMASK(P0,P1,t) do{int jb_=(t)-(NT-4); if(jb_>=0)cmask(P0,P1,jb_,qrel,hi);}while(0)
  bool resc=false;
  #define START(P0,P1) do{ const float rm=rowmax(P0,P1); resc=false; \
    { const float dl=rm; mhat=fadd_s(mhat,dl); \
      _Pragma("unroll") for(int r=0;r<16;++r){P0[r]=fsub_s(P0[r],dl);P1[r]=fsub_s(P1[r],dl);} \
      nb=fsub_s(fq2,mhat); } \
    _Pragma("unroll") for(int r=0;r<16;++r)P0[r]=__builtin_amdgcn_exp2f(P0[r]); }while(0)
  #define RESC() do{ if(resc){ asm volatile("s_waitcnt lgkmcnt(0)":::"memory"); \
      _Pragma("unroll") for(int d_=0;d_<2;++d_) _Pragma("unroll") for(int r=0;r<16;++r)o[d_][r]*=wsf[crow(r,hi)]; } }while(0)
  #define FILLC(C0_,C1_,tt) do{ const lds_cptr f_=fkp+(tt)*256; _Pragma("unroll") for(int a_=0;a_<4;++a_){ const f32x4_t x0_=*(const __attribute__((address_space(3))) f32x4_t*)(f_+32*a_); const f32x4_t x1_=*(const __attribute__((address_space(3))) f32x4_t*)(f_+128+32*a_); \
      _Pragma("unroll") for(int i_=0;i_<4;++i_){ C0_[4*a_+i_]=nb-x0_[i_]; C1_[4*a_+i_]=nb-x1_[i_]; } } }while(0)
  f32x16 pA0,pA1,pB0,pB1;
  int sl_prev=0,sl_cur=0,sl_next=SLOTB;
  #define ROT() do{sl_prev=sl_cur;sl_cur=sl_next;sl_next=(sl_next==(NSLOT-1)*SLOTB)?0:sl_next+SLOTB;}while(0)
  DMA_K(2,2*SLOTB);
  WAIT_BAR(3);
  FILLC(pA0,pA1,0);
  qkt(pA0,pA1,Kbase,qr,r32,hi);asm volatile("s_nop 15\n\ts_nop 7":"+v"(pA0),"+v"(pA1));CMASK(pA0,pA1,0);
  START(pA0,pA1);
  _Pragma("unroll") for(int r=0;r<16;++r)pA1[r]=__builtin_amdgcn_exp2f(pA1[r]);
  WAIT_BAR(0);
  DMA_K(3,0);DMA_V(1,SLOTB);
  ROT();
  FILLC(pB0,pB1,1);
  kload8(kf,kp0+sl_cur);
  WAIT_BAR(2);
  s16x4 vlo[8],vhi[8]; u32x4 pw0,pw1,pw2,pw3;
  #define PKW(P,B) cvtpk_s(P[B],P[B+1])
  #define PAF(k) __builtin_bit_cast(bf16x8,pw##k)
  #define VFR(i) (bf16x8){vlo[i][0],vlo[i][1],vlo[i][2],vlo[i][3],vhi[i][0],vhi[i][1],vhi[i][2],vhi[i][3]}
  #define PIN(x) asm volatile("":"+v"(x))
  #define MX3(a,b,c) __builtin_fmaxf(__builtin_fmaxf((a),(b)),(c))
  #define GAPA(MF,A0,A1,A2,A3,W0,W1,PW) do{ MF; sacc+=A0; sacc+=A1; sacc+=A2; sacc+=A3; PIN(sacc); W0; W1; PIN(PW); SBAR(); }while(0)
  #define EX(v) __builtin_amdgcn_exp2f(v)
  #define FLD(off) (*(const __attribute__((address_space(3))) f32x4_t*)(fk_+(off)))
  #define GAPB(MF,X,B,PF,FC,FN,NOFF) do{ MF; X[B]=EX(X[B]); X[B+1]=EX(X[B+1]); X[B+2]=EX(X[B+2]); X[B+3]=EX(X[B+3]); PF[B]=nb-FC[0]; PF[B+1]=nb-FC[1]; PF[B+2]=nb-FC[2]; PF[B+3]=nb-FC[3]; FN=FLD(NOFF); PIN(X); PIN(PF); SBAR(); }while(0)
  #define VRD(i) do{ vlo[i]=vtr(vp_+(((i)>>2)*4096+((i)&3)*1024)); vhi[i]=vtr(vp_+(((i)>>2)*4096+((i)&3)*1024+512)); }while(0)
  #define KRD(G,j) do{ if(G){ kload2(kf,kp0+sl_next,j); SBAR(); } }while(0)
  #define STEP(C0,C1,P0,P1,t,GK,GV,GL) do{ SBAR(); \
    const lds_cptr vp_=vp0+sl_prev; \
    VRD(0); SBAR(); float sacc=(P0[0]+P0[1]); \
    GAPA(C0=__builtin_amdgcn_mfma_f32_32x32x16_bf16(kf[0],qr[0],C0,0,0,0), P0[2],P0[3],P0[4],P0[5],     pw0[0]=PKW(P0,0), pw0[1]=PKW(P0,2), pw0); \
    VRD(4); SBAR(); GAPA(C1=__builtin_amdgcn_mfma_f32_32x32x16_bf16(kf[1],qr[0],C1,0,0,0), P0[6],P0[7],P0[8],P0[9],     pw0[2]=PKW(P0,4), pw0[3]=PKW(P0,6), pw0); \
    VRD(1); SBAR(); GAPA(C0=__builtin_amdgcn_mfma_f32_32x32x16_bf16(kf[2],qr[1],C0,0,0,0),   P0[10],P0[11],P0[12],P0[13], pw1[0]=PKW(P0,8), pw1[1]=PKW(P0,10), pw1); \
    VRD(5); SBAR(); GAPA(C1=__builtin_amdgcn_mfma_f32_32x32x16_bf16(kf[3],qr[1],C1,0,0,0),   P0[14],P0[15],P1[0],P1[1],   pw1[2]=PKW(P0,12),pw1[3]=PKW(P0,14), pw1); \
    VRD(2); SBAR(); GAPA(C0=__builtin_amdgcn_mfma_f32_32x32x16_bf16(kf[4],qr[2],C0,0,0,0),   P1[2],P1[3],P1[4],P1[5],     pw2[0]=PKW(P1,0), pw2[1]=PKW(P1,2), pw2); \
    VRD(6); SBAR(); GAPA(C1=__builtin_amdgcn_mfma_f32_32x32x16_bf16(kf[5],qr[2],C1,0,0,0),   P1[6],P1[7],P1[8],P1[9],     pw2[2]=PKW(P1,4), pw2[3]=PKW(P1,6), pw2); \
    VRD(3); SBAR(); GAPA(C0=__builtin_amdgcn_mfma_f32_32x32x16_bf16(kf[6],qr[3],C0,0,0,0),   P1[10],P1[11],P1[12],P1[13], pw3[0]=PKW(P1,8), pw3[1]=PKW(P1,10), pw3); \
    VRD(7); SBAR(); GAPA(C1=__builtin_amdgcn_mfma_f32_32x32x16_bf16(kf[7],qr[3],C1,0,0,0),   P1[14],P1[15],0.f,0.f,       pw3[2]=PKW(P1,12),pw3[3]=PKW(P1,14), pw3); \
    l_reg+=sacc; \
    if(GK){DMA_K((t)+3,sl_cur);} if(GV){DMA_V((t)+1,sl_next);} \
    CMASK(C0,C1,t); \
    { float a=MX3(C0[0],C0[1],C1[0]),b=MX3(C0[2],C0[3],C1[1]); a=MX3(a,C1[2],C1[3]); \
      _Pragma("unroll") for(int r=4;r<16;r+=4){a=MX3(a,C0[r],C0[r+1]);b=MX3(b,C0[r+2],C0[r+3]);a=MX3(a,C1[r],C1[r+1]);b=MX3(b,C1[r+2],C1[r+3]);} \
      float rm=__builtin_fmaxf(a,b); { auto rr=__builtin_amdgcn_permlane32_swap(__float_as_uint(rm),__float_as_uint(rm),false,false); rm=__builtin_fmaxf(__uint_as_float(rr[0]),__uint_as_float(rr[1])); } \
      resc=false; \
      if(__builtin_expect(__any(rm>(float)THRL),0)){ const float dl=__builtin_fmaxf(rm,0.f); mhat+=dl; \
        _Pragma("unroll") for(int r=0;r<16;++r){C0[r]-=dl;C1[r]-=dl;} \
        nb=fq2-mhat; \
        const float f=__builtin_amdgcn_exp2f(-dl); l_reg*=f; if(hi==0)wsf[r32]=f; resc=true; } } \
    SBAR(); \
    const lds_cptr fk_=fkp+((t)+1)*256; f32x4_t fa_=FLD(0),fb_; SBAR(); \
    GAPB(o[0]=__builtin_amdgcn_mfma_f32_32x32x16_bf16(PAF(0),VFR(0),o[0],0,0,0), C0,0, P0,fa_,fb_,32); \
    GAPB(o[1]=__builtin_amdgcn_mfma_f32_32x32x16_bf16(PAF(0),VFR(4),o[1],0,0,0), C0,4, P0,fb_,fa_,64); \
    KRD(GL,0); GAPB(o[0]=__builtin_amdgcn_mfma_f32_32x32x16_bf16(PAF(1),VFR(1),o[0],0,0,0), C0,8, P0,fa_,fb_,96); \
    KRD(GL,1); GAPB(o[1]=__builtin_amdgcn_mfma_f32_32x32x16_bf16(PAF(1),VFR(5),o[1],0,0,0), C0,12, P0,fb_,fa_,128); \
    KRD(GL,2); GAPB(o[0]=__builtin_amdgcn_mfma_f32_32x32x16_bf16(PAF(2),VFR(2),o[0],0,0,0), C1,0, P1,fa_,fb_,160); \
    KRD(GL,3); GAPB(o[1]=__builtin_amdgcn_mfma_f32_32x32x16_bf16(PAF(2),VFR(6),o[1],0,0,0), C1,4, P1,fb_,fa_,192); \
    GAPB(o[0]=__builtin_amdgcn_mfma_f32_32x32x16_bf16(PAF(3),VFR(3),o[0],0,0,0), C1,8, P1,fa_,fb_,224); \
    GAPB(o[1]=__builtin_amdgcn_mfma_f32_32x32x16_bf16(PAF(3),VFR(7),o[1],0,0,0), C1,12, P1,fb_,fa_,224); \
    }while(0)
  int t=1;
  #undef CMASK
  #define CMASK(P0,P1,t) do{}while(0)
  for(;t+5<NT;t+=2){
    STEP(pB0,pB1,pA0,pA1,t,true,true,true);     WAIT_BAR(2); RESC(); ROT();
    STEP(pA0,pA1,pB0,pB1,t+1,true,true,true);   WAIT_BAR(2); RESC(); ROT();
  }
  #undef CMASK
  #define CMASK(P0,P1,t) do{int jb_=(t)-(NT-4); if(jb_>=0)cmask(P0,P1,jb_,qrel,hi);}while(0)
  #define ENDW(tt) do{ if((tt)+3<NT){WAIT_BAR(2);} else if((tt)+2<NT){WAIT_BAR(1);} else {WAIT_BAR(0);} }while(0)
  for(;t+1<NT;t+=2){
    STEP(pB0,pB1,pA0,pA1,t,(t+3<NT),(t+1<NT),(t+1<NT));       ENDW(t);   RESC(); ROT();
    STEP(pA0,pA1,pB0,pB1,t+1,(t+4<NT),(t+2<NT),(t+2<NT));     ENDW(t+1); RESC(); ROT();
  }
  STEP(pB0,pB1,pA0,pA1,NT-1,false,false,false); RESC();
  { float sacc=pB0[0]+pB0[1]; _Pragma("unroll") for(int r=2;r<16;++r)sacc+=pB0[r]; _Pragma("unroll") for(int r=0;r<16;++r)sacc+=pB1[r]; l_reg+=sacc;
    pw0=(u32x4){PKW(pB0,0),PKW(pB0,2),PKW(pB0,4),PKW(pB0,6)};pw1=(u32x4){PKW(pB0,8),PKW(pB0,10),PKW(pB0,12),PKW(pB0,14)};pw2=(u32x4){PKW(pB1,0),PKW(pB1,2),PKW(pB1,4),PKW(pB1,6)};pw3=(u32x4){PKW(pB1,8),PKW(pB1,10),PKW(pB1,12),PKW(pB1,14)};
    SBAR(); pv(o,vb0+sl_cur,PAF(0),PAF(1),PAF(2),PAF(3)); }
  #undef PKW
  #undef PAF
  #undef VFR
  #undef PIN
  #undef MX3
  #undef GAPA
  #undef GAPB
  #undef FLD
  #undef FILLC
  #undef EX
  #undef VRD
  #undef KRD
  #undef STEP
  #undef ENDW
  {auto rr=__builtin_amdgcn_permlane32_swap(__float_as_uint(l_reg),__float_as_uint(l_reg),false,false);l_reg=__uint_as_float(rr[0])+__uint_as_float(rr[1]);}
  if(hi==0)wsf[32+r32]=l_reg;asm volatile("s_waitcnt lgkmcnt(0)":::"memory");
  float rli[16];
  #pragma unroll
  for(int r=0;r<16;++r)rli[r]=__builtin_amdgcn_rcpf(wsf[32+crow(r,hi)]);
  bf16*Ow=O+(rowbase+q0+wid*QBLK)*DM+h*D;
  { bf16*stg=(bf16*)(shm+LDS_OST)+wid*2048;
    #pragma unroll
    for(int r=0;r<16;++r){const int orow=crow(r,hi);
      #pragma unroll
      for(int d0=0;d0<2;++d0)stg[orow*64+d0*32+r32]=f2bf_a(o[d0][r]*rli[r]);}
    asm volatile("s_waitcnt lgkmcnt(0)":::"memory");
    #pragma unroll
    for(int i=0;i<4;++i){const int row=i*8+(lane>>3),ch=lane&7; const u32x4 v=*(const u32x4*)(stg+row*64+ch*8); ATTN_STORE16(Ow+(long)row*DM+ch*8,v);} }
  asm volatile("s_waitcnt lgkmcnt(0)\n\ts_barrier":::"memory");
  #undef DMA_K
  #undef DMA_V
  #undef CMASK
  #undef START
  #undef RESC
  #undef ROT
}
constexpr int ATTN_LDS_BYTES=LDS_BYTES;
struct AttnTensors { const bf16* Q; const bf16* K; const bf16* V; bf16* O; const float* CUM; };
struct AttnUnit { int bh; int qb; };
struct StaticOrder {
  int vcu;
  __device__ __forceinline__ explicit StaticOrder(int v):vcu(v){}
  __device__ __forceinline__ bool next(int i,AttnUnit&u)const{ if(i>=2)return false; const int s=vcu&15; u.bh=vcu>>4; u.qb=(i==0)?31-s:s; return true; }
};
template<class Sched,int THRL=8> __device__ __forceinline__ void attn_phase(char*lds,const AttnTensors&T,const Sched&S){
  AttnUnit u;
  for(int i=0;S.next(i,u);++i){ attn_unit<THRL>(u.bh/NHEAD,u.bh%NHEAD,u.qb,T.Q,T.K,T.V,T.O,T.CUM,lds); }
}
#undef SBAR
#undef WAIT_BAR
}

constexpr int NWAVES = 8;
constexpr int RING_OFF = 0, RING_BYTES = 131072;
constexpr int LDSCTL_OFF = RING_BYTES, MISC_OFF = LDSCTL_OFF + 320;
constexpr int LDS_BYTES = 147456;
typedef GAS unsigned gu32;
#define RLX_AGENT __ATOMIC_RELAXED, __HIP_MEMORY_SCOPE_AGENT
#define LDS_WAIT() asm volatile("s_waitcnt lgkmcnt(0)" ::: "memory")
#define VM_WAIT() asm volatile("s_waitcnt vmcnt(0)" ::: "memory")
constexpr int CW_TMO = 0, CW_CODE = 1, CW_CNT = 64  , CW_Q0 = 128  , CW_BAR = 4096;

#define XB_TMO      128
#define XB_XCNT(j)  (256  + 64 * (j))
#define XB_XSUB(j)  (1280 + 64 * (j))
#define XB_XGEN(j)  (2304 + 64 * (j))
#define XB_TOP      3328
#define XB_TOPGEN   3392
#define XCD_BAR_WORDS 3456
#define XB_SPIN_CAP (1u << 18)
__device__ __forceinline__ unsigned xb_ld(unsigned* p)              { return __hip_atomic_load(p, __ATOMIC_RELAXED, __HIP_MEMORY_SCOPE_AGENT); }
__device__ __forceinline__ unsigned xb_add(unsigned* p, unsigned v) { return __hip_atomic_fetch_add(p, v, __ATOMIC_RELAXED, __HIP_MEMORY_SCOPE_AGENT); }
__device__ __forceinline__ unsigned xb_xcc_id() { return (unsigned)__builtin_amdgcn_s_getreg((3 << 11) | 20) & 0xFu; }
#define XB_SPIN(cond, bar) do { unsigned _sp = 0; while (cond) { __builtin_amdgcn_s_sleep(1); \
    if ((++_sp & 255u) == 0u) { if (xb_ld(&(bar)[XB_TMO])) break; if (_sp > XB_SPIN_CAP) { atomicAdd(&(bar)[XB_TMO], 1u); break; } } } } while (0)
struct XcdBarrier { unsigned* bar; unsigned x; volatile LAS unsigned* st; };
__device__ __forceinline__ XcdBarrier xcd_barrier_post(unsigned* bar, volatile LAS unsigned* st) {
    XcdBarrier b; b.bar = bar; b.x = xb_xcc_id(); b.st = st;
    if (threadIdx.x == 0) (void)xb_add(&bar[XB_XCNT(b.x)], 1u);
    return b;
}
__device__ __forceinline__ void xcd_barrier_complete(unsigned* bar, unsigned x, unsigned& nloc, unsigned& nx) {
    const unsigned G = gridDim.x * gridDim.y * gridDim.z;
    unsigned sum, cnt, mine, sp = 0u;
    for (;;) {
        sum = 0u; cnt = 0u; mine = 0u;
#pragma unroll
        for (unsigned j = 0; j < 16; ++j) { const unsigned c = xb_ld(&bar[XB_XCNT(j)]); sum += c; cnt += (c > 0u) ? 1u : 0u; mine = (j == x) ? c : mine; }
        if (sum == G) break;
        __builtin_amdgcn_s_sleep(1);
        if ((++sp & 255u) == 0u) { if (xb_ld(&bar[XB_TMO])) break; if (sp > XB_SPIN_CAP) { atomicAdd(&bar[XB_TMO], 1u); break; } }
    }
    nloc = mine > 0u ? mine : 1u; nx = cnt > 0u ? cnt : 1u;
}
__device__ __forceinline__ void xcd_barrier(const XcdBarrier& b) {
    asm volatile("s_waitcnt vmcnt(0)" ::: "memory");
    __syncthreads();
    if (threadIdx.x == 0) {
        unsigned* bar = b.bar;
        __builtin_amdgcn_s_waitcnt(0);
        unsigned nloc = b.st[0], nx = b.st[1];
        if (nloc == 0u) { xcd_barrier_complete(bar, b.x, nloc, nx); b.st[0] = nloc; b.st[1] = nx; }
        const unsigned old = xb_add(&bar[XB_XSUB(b.x)], 1u);
        const unsigned gen = old / nloc;
        if (old + 1u == (gen + 1u) * nloc) {
            __builtin_amdgcn_fence(__ATOMIC_RELEASE, "agent");
            asm volatile("s_waitcnt vmcnt(0)" ::: "memory");
            const unsigned og = xb_add(&bar[XB_TOP], 1u);
            const unsigned tg = og / nx;
            if (og + 1u == (tg + 1u) * nx) xb_add(&bar[XB_TOPGEN], 1u);
            else XB_SPIN(xb_ld(&bar[XB_TOPGEN]) == tg, bar);
            __builtin_amdgcn_fence(__ATOMIC_ACQUIRE, "agent");
            xb_add(&bar[XB_XGEN(b.x)], 1u);
            asm volatile("s_waitcnt vmcnt(0)" ::: "memory");
        } else {
            XB_SPIN(xb_ld(&bar[XB_XGEN(b.x)]) == gen, bar);
            __builtin_amdgcn_fence(__ATOMIC_ACQUIRE, "agent");
            asm volatile("s_waitcnt vmcnt(0)" ::: "memory");
        }
    }
    __syncthreads();
}

struct Args { const float* in[26]; float* out; unsigned char* ws; int ph_lo, ph_hi; };
struct Frame {
    LAS unsigned char* lds; volatile LAS unsigned* MISC; gu32* ctl;
    int tid, lane, wave, vcu, G;
};
__device__ __forceinline__ float gelu_fast(float x) { const float z = 0.7978845608028654f * (x + 0.044715f * x * x * x); const float e = __builtin_amdgcn_exp2f(2.885390081777927f * z); return x - x * __builtin_amdgcn_rcpf(e + 1.f); }
__device__ __forceinline__ float wave_sum(float v) {
#pragma unroll
    for (int o = 1; o < 64; o <<= 1) v += __shfl_xor(v, o);
    return v;
}

__device__ __forceinline__ void conv_item(const float* W, int ldw, int k0, int scol, bf16* dst, int ldd, const float* kscale, LAS float* scr, int lane) {
#pragma unroll 8
    for (int i = 0; i < 32; ++i) { const int kk = 2 * i + (lane >> 5); float v = W[(size_t)(k0 + kk) * ldw + scol + (lane & 31)]; if (kscale) v *= kscale[k0 + kk]; scr[kk * 33 + (lane & 31)] = v; }
    LDS_WAIT(); asm volatile("" ::: "memory");
    const int c = lane & 7;
#pragma unroll
    for (int j = 0; j < 4; ++j) { const int n = (lane >> 3) + 8 * j; const LAS float* s = scr + (8 * c) * 33 + n;
        u32x4 o; o.x = pg::cvt_pk_bf16(s[0 * 33], s[1 * 33]); o.y = pg::cvt_pk_bf16(s[2 * 33], s[3 * 33]); o.z = pg::cvt_pk_bf16(s[4 * 33], s[5 * 33]); o.w = pg::cvt_pk_bf16(s[6 * 33], s[7 * 33]);
        *(GAS u32x4*)(dst + (size_t)n * ldd + k0 + 8 * c) = o; }
    LDS_WAIT(); asm volatile("" ::: "memory");
}
__device__ __forceinline__ int inproj_src_col(int cp) { return cp < 1536 ? cp : (cp < 2048 ? cp + (OU - 1536) : (cp < 3072 ? cp + (OGA - 2048) : cp + (OGS - 3072))); }
__device__ __forceinline__ int inproj_dst_row(int cp) { const int t = cp & ~255, c = cp & 255, wc = c >> 6, bj = (c >> 5) & 1, j = c & 31; return t + 128 * bj + 32 * wc + j; }

__device__ __forceinline__ void p0_prologue(Frame& F, const Args& a) {
    unsigned char* ws = a.ws;
    LAS float* scr = (LAS float*)(F.lds + F.wave * 8704);
    LAS float* wf = (LAS float*)(F.lds + 73728);
    const int gw = F.vcu * NWAVES + F.wave, NGW = F.G * NWAVES;
    const float* w_in = a.in[2];
    for (int i = F.tid; i < 8 * 1024; i += NWAVES * 64) { const int h = i >> 10, k = i & 1023; wf[i] = w_in[(size_t)k * DIN + OF + h]; }
    constexpr int I_IN = 16 * 128, I_GLU = 8 * 16, I_PA = 8 * 32, I_OUT = 16 * 32;
    constexpr int NITEMS = I_IN + I_GLU + 2 * I_PA + I_OUT;
    for (int it = gw; it < NITEMS; it += NGW) {
        int r = it;
        if (r < I_IN) { const int kb = r >> 7, nb = r & 127, cp = nb * 32; conv_item(w_in, DIN, kb * 64, inproj_src_col(cp), (bf16*)(ws + WS_WIN) + (size_t)inproj_dst_row(cp) * D, D, nullptr, scr, F.lane); continue; } r -= I_IN;
        if (r < I_GLU) { const int kb = r >> 4, nb = r & 15; conv_item(a.in[14], DS, kb * 64, nb * 32, (bf16*)(ws + WS_WGLU) + (size_t)(nb * 32) * DS, DS, nullptr, scr, F.lane); continue; } r -= I_GLU;
        if (r < I_PA) { const int kb = r >> 5, nb = r & 31; conv_item(a.in[15], D, kb * 64, nb * 32, (bf16*)(ws + WS_WPA) + (size_t)(nb * 32) * DA, DA, nullptr, scr, F.lane); continue; } r -= I_PA;
        if (r < I_PA) { const int kb = r >> 5, nb = r & 31; conv_item(a.in[16], D, kb * 64, nb * 32, (bf16*)(ws + WS_WPS) + (size_t)(nb * 32) * DS, DS, nullptr, scr, F.lane); continue; } r -= I_PA;
        { const int kb = r >> 5, nb = r & 31; conv_item(a.in[17], D, kb * 64, nb * 32, (bf16*)(ws + WS_WOUT) + (size_t)(nb * 32) * D, D, nullptr, scr, F.lane); }
    }
    if (blockIdx.x < 48) {
        const int r = blockIdx.x; const float* gf = a.in[18]; const float* wrg = a.in[19]; const float* wre = a.in[21]; bf16* WR = (bf16*)(ws + WS_WR) + (size_t)r * D;
        for (int k = F.tid; k < D; k += NWAVES * 64) { const float w = r < 4 ? wrg[k * 4 + r] : (r < 36 ? wre[k * NE + r - 4] : 0.f); WR[k] = f2bf(w * gf[k]); }
    }
    __syncthreads();
    const float* x = a.in[0]; const float* g = a.in[1]; const float* bfg = a.in[3];
    bf16* XN = (bf16*)(ws + WS_XN); float* LOGF = (float*)(ws + WS_CUM);
    for (int m = gw; m < T; m += NGW) {
        const GAS f32x4* xr = (const GAS f32x4*)(x + (size_t)m * D) + F.lane;
        f32x4 v[4]; float s = 0.f;
#pragma unroll
        for (int j = 0; j < 4; ++j) { v[j] = xr[64 * j]; s += (v[j].x * v[j].x + v[j].y * v[j].y) + (v[j].z * v[j].z + v[j].w * v[j].w); }
        const float rstd = rsqrtf(wave_sum(s) * (1.f / D) + EPS);
        float f[8];
#pragma unroll
        for (int h = 0; h < 8; ++h) f[h] = 0.f;
        GAS u32x2* o8 = (GAS u32x2*)(XN + (size_t)m * D) + F.lane;
#pragma unroll
        for (int j = 0; j < 4; ++j) { const f32x4 gg = *((const GAS f32x4*)g + 64 * j + F.lane); const f32x4 xn = v[j] * rstd * gg;
            u32x2 w; w.x = pg::cvt_pk_bf16(xn.x, xn.y); w.y = pg::cvt_pk_bf16(xn.z, xn.w); o8[64 * j] = w;
#pragma unroll
            for (int h = 0; h < 8; ++h) { const f32x4 ww = *((const LAS f32x4*)(wf + h * 1024) + 64 * j + F.lane); f[h] += (xn.x * ww.x + xn.y * ww.y) + (xn.z * ww.z + xn.w * ww.w); } }
#pragma unroll
        for (int h = 0; h < 8; ++h) f[h] = wave_sum(f[h]);
        float fs = f[0];
#pragma unroll
        for (int h = 1; h < 8; ++h) fs = (F.lane == h) ? f[h] : fs;
        if (F.lane < 8) { const int b = m / SEQ, sidx = m % SEQ; LOGF[((size_t)b * NH + F.lane) * SEQ + sidx] = log_sigmoid(fs + bfg[F.lane]); }
    }
    if (blockIdx.x >= 64 && blockIdx.x < 64 + NG) {
        __syncthreads();
        const int g = blockIdx.x - 64;
        LAS f32x2* PW = (LAS f32x2*)(F.lds);
        LAS f32x2* BB = (LAS f32x2*)(F.lds + 16896);
        LAS f32x2* CC = (LAS f32x2*)(F.lds + 16896 + 8192);
        LAS float* KT = (LAS float*)(F.lds + 16896 + 16384);
        const float* A_re = a.in[6]; const float* A_im = a.in[7]; const float* log_dt = a.in[8]; const float* B_re = a.in[9]; const float* B_im = a.in[10]; const float* C_re = a.in[11]; const float* C_im = a.in[12];
        if (F.tid < NP) { const int p = F.tid;
            const double dt = exp((double)log_dt[g]), ar = A_re[g * NP + p], ai = A_im[g * NP + p];
            const double er = exp(ar * dt), abr = er * cos(ai * dt), abi = er * sin(ai * dt);
            const double nr = abr - 1.0, ni = abi, den = ar * ar + ai * ai, fr_ = (nr * ar + ni * ai) / den, fi_ = (ni * ar - nr * ai) / den;
            double pr = 1.0, pi = 0.0;
            for (int tau = 0; tau <= LCH; ++tau) { PW[tau * NP + p] = (f32x2){(float)pr, (float)pi}; const double t2 = pr * abr - pi * abi; pi = pr * abi + pi * abr; pr = t2; }
            ((float*)(ws + WS_AL))[(g * NP + p) * 2] = PW[LCH * NP + p].x; ((float*)(ws + WS_AL))[(g * NP + p) * 2 + 1] = PW[LCH * NP + p].y;
            for (int c = 0; c < GC; ++c) { const double br = B_re[(g * NP + p) * GC + c], bi = B_im[(g * NP + p) * GC + c]; BB[p * GC + c] = (f32x2){(float)(fr_ * br - fi_ * bi), (float)(fr_ * bi + fi_ * br)}; } }
        for (int i = F.tid; i < GC * NP; i += NWAVES * 64) CC[i] = (f32x2){C_re[g * GC * NP + i], C_im[g * GC * NP + i]};
        __syncthreads();
        for (int i = F.tid; i < LCH * GC * GC; i += NWAVES * 64) { const int tau = i >> 8, co = (i >> 4) & 15, ci = i & 15; float acc = 0.f;
#pragma unroll 4
            for (int p = 0; p < NP; ++p) { const f32x2 w = PW[tau * NP + p], b = BB[p * GC + ci], c = CC[co * NP + p]; const float wr_ = w.x * b.x - w.y * b.y, wi_ = w.x * b.y + w.y * b.x; acc += c.x * wr_ - c.y * wi_; }
            KT[i] = acc; }
        __syncthreads();
        {
          const int n = F.tid, j = n >> 4, co = n & 15; bf16* row = (bf16*)(ws + WS_BTY) + ((size_t)g * 512 + n) * U2P;
          auto bval = [&](int k) -> float { float x;
              if (k < 128) { const int p = k & 63; const f32x2 w = PW[(j + 1) * NP + p], c = CC[co * NP + p]; x = k < 64 ? (c.x * w.x - c.y * w.y) : -(c.x * w.y + c.y * w.x); }
              else { const int sidx = (k - 128) >> 4, ci = (k - 128) & 15; x = sidx <= j ? KT[((j - sidx) * GC + co) * GC + ci] : 0.f; }
              return x; };
#pragma unroll 1
          for (int k8 = 0; k8 < U2P / 8; ++k8) { const int k = k8 * 8;
              u32x4 o; o.x = pg::cvt_pk_bf16(bval(k), bval(k + 1)); o.y = pg::cvt_pk_bf16(bval(k + 2), bval(k + 3)); o.z = pg::cvt_pk_bf16(bval(k + 4), bval(k + 5)); o.w = pg::cvt_pk_bf16(bval(k + 6), bval(k + 7)); *(GAS u32x4*)(row + k) = o; } }
        {
          const int n = F.tid >> 1, half = F.tid & 1; bf16* row = (bf16*)(ws + WS_M1T) + ((size_t)g * 256 + n) * 512 + half * 256;
          auto mval = [&](int k) -> float { const int j = k >> 4, ci = k & 15; float x = 0.f;
              if (n < 128) { const int p = n & 63; const f32x2 w = PW[(LCH - 1 - j) * NP + p], b = BB[p * GC + ci]; x = n < 64 ? (w.x * b.x - w.y * b.y) : (w.x * b.y + w.y * b.x); }
              return x; };
#pragma unroll 1
          for (int k8 = 0; k8 < 32; ++k8) { const int k = half * 256 + k8 * 8;
              u32x4 o; o.x = pg::cvt_pk_bf16(mval(k), mval(k + 1)); o.y = pg::cvt_pk_bf16(mval(k + 2), mval(k + 3)); o.z = pg::cvt_pk_bf16(mval(k + 4), mval(k + 5)); o.w = pg::cvt_pk_bf16(mval(k + 6), mval(k + 7)); *(GAS u32x4*)(row + k8 * 8) = o; } }
    }
}

__device__ __forceinline__ void p1_cumsum(Frame& F, float* CUM) {
    LAS double* part = (LAS double*)(F.lds);
    float* p = CUM + (size_t)blockIdx.x * SEQ + F.tid * 16;
    f32x4 v[4]; float run[16]; float a = 0.f;
#pragma unroll
    for (int j = 0; j < 4; ++j) v[j] = ((const GAS f32x4*)p)[j];
#pragma unroll
    for (int j = 0; j < 4; ++j) { a += v[j].x; run[4 * j] = a; a += v[j].y; run[4 * j + 1] = a; a += v[j].z; run[4 * j + 2] = a; a += v[j].w; run[4 * j + 3] = a; }
    part[F.tid] = (double)a;
    __syncthreads();
    if (F.tid < 64) { double loc[8]; double s = 0.0;
#pragma unroll
        for (int i = 0; i < 8; ++i) { loc[i] = s; s += part[F.tid * 8 + i]; }
        double incl = s;
#pragma unroll
        for (int o = 1; o < 64; o <<= 1) { const double t = __shfl_up(incl, o); if (F.lane >= o) incl += t; }
        const double excl = incl - s;
#pragma unroll
        for (int i = 0; i < 8; ++i) part[F.tid * 8 + i] = excl + loc[i]; }
    __syncthreads();
    const double base = part[F.tid];
#pragma unroll
    for (int j = 0; j < 4; ++j) { f32x4 o; o.x = (float)((base + (double)run[4 * j]) * 1.4426950408889634); o.y = (float)((base + (double)run[4 * j + 1]) * 1.4426950408889634);
        o.z = (float)((base + (double)run[4 * j + 2]) * 1.4426950408889634); o.w = (float)((base + (double)run[4 * j + 3]) * 1.4426950408889634); ((GAS f32x4*)p)[j] = o; }
    __syncthreads();
}
struct PhInProj {
    static constexpr bool GATHER = false;
    unsigned lda, ldb; const char* A; const char* B; pg::StaticOrder so;
    bf16 *Q, *K, *V, *U2X, *GA, *GS; const float *gq, *gk;
    __device__ __forceinline__ bool next(int i, pg::Unit& u) const { int pm, pn; if (!so.next(i, pm, pn)) return false; u.A = A + (size_t)pm * 256 * lda; u.B = B + (size_t)pn * 256 * ldb; u.nt = D / 64; u.pm = pm; u.pn = pn; u.aux = 0; return true; }
    __device__ __forceinline__ void offs(const pg::Unit&, const int (&R)[2], const int (&C)[2], unsigned (&vo)[2][2]) const { pg::offs_plain(lda, R, C, vo); }
    __device__ __forceinline__ void epi(const f32x4 (&acc)[2][2][4][2], const pg::Unit& u, int wr, int wc, int fr, int fq) const {
        const int pn = u.pn, row0 = u.pm * 256 + wr * 64 + fr;
        if (pn < 4) {
            const bool isq = pn < 2; const float* g = isq ? gq : gk; bf16* O = isq ? Q : K; const int cb = (pn & 1) * 256 + 64 * wc + 8 * fq; const float sc = isq ? C2 : 1.f;
            f32x4 gv[2][2];
#pragma unroll
            for (int bj = 0; bj < 2; ++bj)
#pragma unroll
                for (int n = 0; n < 2; ++n) gv[bj][n] = *(const f32x4*)(g + 32 * bj + 8 * fq + 4 * n) * sc;
#pragma unroll
            for (int ai = 0; ai < 2; ++ai)
#pragma unroll
                for (int m = 0; m < 4; ++m) { float ss = 0.f;
#pragma unroll
                    for (int bj = 0; bj < 2; ++bj)
#pragma unroll
                        for (int n = 0; n < 2; ++n) { const f32x4 v = acc[ai][bj][m][n]; ss += (v[0] * v[0] + v[1] * v[1]) + (v[2] * v[2] + v[3] * v[3]); }
                    ss += __shfl_xor(ss, 16); ss += __shfl_xor(ss, 32);
                    const float rstd = rsqrtf(ss * (1.f / 64.f) + EPS);
                    bf16* rowp = O + (size_t)(row0 + ai * 128 + m * 16) * DA + cb;
#pragma unroll
                    for (int bj = 0; bj < 2; ++bj) *(u32x4*)(rowp + 32 * bj) = pg::pack8(acc[ai][bj][m][0] * rstd * gv[bj][0], acc[ai][bj][m][1] * rstd * gv[bj][1]); }
        } else if (pn < 6) {
            const int cb = (pn - 4) * 256 + 64 * wc + 8 * fq;
#pragma unroll
            for (int ai = 0; ai < 2; ++ai)
#pragma unroll
                for (int m = 0; m < 4; ++m) { bf16* rowp = V + (size_t)(row0 + ai * 128 + m * 16) * DA + cb;
#pragma unroll
                    for (int bj = 0; bj < 2; ++bj) *(u32x4*)(rowp + 32 * bj) = pg::pack8(acc[ai][bj][m][0], acc[ai][bj][m][1]); }
        } else if (pn < 8) {
#pragma unroll
            for (int ai = 0; ai < 2; ++ai)
#pragma unroll
                for (int m = 0; m < 4; ++m) { const int row = row0 + ai * 128 + m * 16;
#pragma unroll
                    for (int bj = 0; bj < 2; ++bj) { const int cu = (pn - 6) * 256 + 64 * wc + 32 * bj + 8 * fq;
                        *(u32x4*)(U2X + u2x_index(cu >> 4, row, cu & 15)) = pg::pack8(acc[ai][bj][m][0], acc[ai][bj][m][1]); } }
        } else {
            bf16* G = pn < 12 ? GA : GS; const int cb = ((pn - 8) & 3) * 256 + 64 * wc + 8 * fq;
#pragma unroll
            for (int ai = 0; ai < 2; ++ai)
#pragma unroll
                for (int m = 0; m < 4; ++m) { bf16* rowp = G + (size_t)(row0 + ai * 128 + m * 16) * D + cb;
#pragma unroll
                    for (int bj = 0; bj < 2; ++bj) { f32x4 a = acc[ai][bj][m][0], b = acc[ai][bj][m][1];
#pragma unroll
                        for (int e = 0; e < 4; ++e) { a[e] = pg::fsigmoid(a[e]); b[e] = pg::fsigmoid(b[e]); }
                        *(u32x4*)(rowp + 32 * bj) = pg::pack8(a, b); } }
        }
    }
};

struct PhGlu {
    static constexpr bool GATHER = false;
    unsigned lda, ldb; const char* A; const char* B; pg::StaticOrder so; const bf16* Y1; bf16* YS;
    __device__ __forceinline__ bool next(int i, pg::Unit& u) const { int pm, pn; if (!so.next(i, pm, pn)) return false; u.A = A + (size_t)pm * 256 * lda; u.B = B + (size_t)pn * 256 * ldb; u.nt = DS / 64; u.pm = pm; u.pn = pn; u.aux = 0; return true; }
    __device__ __forceinline__ void offs(const pg::Unit&, const int (&R)[2], const int (&C)[2], unsigned (&vo)[2][2]) const { pg::offs_plain(lda, R, C, vo); }
    __device__ __forceinline__ void epi(const f32x4 (&acc)[2][2][4][2], const pg::Unit& u, int wr, int wc, int fr, int fq) const {
        const int row0 = u.pm * 256 + wr * 64 + fr, cb = u.pn * 256 + 32 * wc + 8 * fq;
#pragma unroll
        for (int ai = 0; ai < 2; ++ai)
#pragma unroll
            for (int m = 0; m < 4; ++m) { const size_t ro = (size_t)(row0 + ai * 128 + m * 16) * DS + cb;
#pragma unroll
                for (int bj = 0; bj < 2; ++bj) { const u32x4 yv = *(const u32x4*)(Y1 + ro + 128 * bj); f32x4 y0, y1; pg::unpack8(yv, y0, y1);
                    f32x4 a = acc[ai][bj][m][0], b = acc[ai][bj][m][1];
#pragma unroll
                    for (int e = 0; e < 4; ++e) { a[e] = y0[e] * pg::fsigmoid(a[e]); b[e] = y1[e] * pg::fsigmoid(b[e]); }
                    *(u32x4*)(YS + ro + 128 * bj) = pg::pack8(a, b); } }
    }
};
struct PhProj {
    static constexpr bool GATHER = false;
    unsigned lda, ldb; const char* O; const char* YSp; const char* WPA; const char* WPS; pg::StaticOrder so; bf16* GA; const bf16* GS;
    __device__ __forceinline__ bool next(int i, pg::Unit& u) const { int pm, pn; if (!so.next(i >> 1, pm, pn)) return false; const int sub = i & 1;
        u.A = (sub ? YSp : O) + (size_t)pm * 256 * lda; u.B = (sub ? WPS : WPA) + (size_t)pn * 256 * ldb; u.nt = DA / 64; u.pm = pm; u.pn = pn; u.aux = sub; return true; }
    __device__ __forceinline__ void offs(const pg::Unit&, const int (&R)[2], const int (&C)[2], unsigned (&vo)[2][2]) const { pg::offs_plain(lda, R, C, vo); }
    __device__ __forceinline__ void epi(const f32x4 (&acc)[2][2][4][2], const pg::Unit& u, int wr, int wc, int fr, int fq) const {
        const int row0 = u.pm * 256 + wr * 64 + fr, cb = u.pn * 256 + 32 * wc + 8 * fq; const bool sub = u.aux != 0;
#pragma unroll
        for (int ai = 0; ai < 2; ++ai)
#pragma unroll
            for (int m = 0; m < 4; ++m) { const size_t ro = (size_t)(row0 + ai * 128 + m * 16) * D + cb;
#pragma unroll
                for (int bj = 0; bj < 2; ++bj) { const u32x4 gv = *(const u32x4*)(GA + ro + 128 * bj); f32x4 g0, g1; pg::unpack8(gv, g0, g1);
                    f32x4 a = acc[ai][bj][m][0], b = acc[ai][bj][m][1];
                    if (!sub) { a = a * g0; b = b * g1; }
                    else { const u32x4 sv = *(const u32x4*)(GS + ro + 128 * bj); f32x4 s0, s1; pg::unpack8(sv, s0, s1); a = g0 + s0 * a; b = g1 + s1 * b; }
                    *(u32x4*)(GA + ro + 128 * bj) = pg::pack8(a, b); } }
    }
};
struct PhWout {
    static constexpr bool GATHER = false;
    unsigned lda, ldb; const char* A; const char* B; pg::StaticOrder so; const float* x; float* out; bf16* X2B; float* SSP;
    __device__ __forceinline__ bool next(int i, pg::Unit& u) const { int pm, pn; if (!so.next(i, pm, pn)) return false; u.A = A + (size_t)pm * 256 * lda; u.B = B + (size_t)pn * 256 * ldb; u.nt = D / 64; u.pm = pm; u.pn = pn; u.aux = 0; return true; }
    __device__ __forceinline__ void offs(const pg::Unit&, const int (&R)[2], const int (&C)[2], unsigned (&vo)[2][2]) const { pg::offs_plain(lda, R, C, vo); }
    __device__ __forceinline__ void epi(const f32x4 (&acc)[2][2][4][2], const pg::Unit& u, int wr, int wc, int fr, int fq) const {
        const int row0 = u.pm * 256 + wr * 64 + fr, cb = u.pn * 256 + 32 * wc + 8 * fq;
#pragma unroll
        for (int ai = 0; ai < 2; ++ai)
#pragma unroll
            for (int m = 0; m < 4; ++m) { const int row = row0 + ai * 128 + m * 16; const size_t ro = (size_t)row * D + cb; float ss = 0.f;
#pragma unroll
                for (int bj = 0; bj < 2; ++bj) { const f32x4 x0 = *(const f32x4*)(x + ro + 128 * bj), x1 = *(const f32x4*)(x + ro + 128 * bj + 4);
                    const f32x4 a = acc[ai][bj][m][0] + x0, b = acc[ai][bj][m][1] + x1;
                    *(f32x4*)(out + ro + 128 * bj) = a; *(f32x4*)(out + ro + 128 * bj + 4) = b; *(u32x4*)(X2B + ro + 128 * bj) = pg::pack8(a, b);
                    ss += (a[0] * a[0] + a[1] * a[1]) + (a[2] * a[2] + a[3] * a[3]) + (b[0] * b[0] + b[1] * b[1]) + (b[2] * b[2] + b[3] * b[3]); }
                ss += __shfl_xor(ss, 16); ss += __shfl_xor(ss, 32);
                if (fq == 0) SSP[(size_t)row * 16 + u.pn * 4 + wc] = ss;
                asm volatile("" ::: "memory"); }
    }
};

__device__ __forceinline__ void p2_expert_weights(Frame& F, const Args& a) {
    unsigned char* ws = a.ws; LAS float* scr = (LAS float*)(F.lds + F.wave * 8704);
    const int gw = F.vcu * NWAVES + F.wave, NGW = F.G * NWAVES;
    const float* gf = a.in[18]; const float* wg = a.in[23]; const float* wu = a.in[24]; const float* wd = a.in[25];
    constexpr int I_G = 16 * 8, I_D = 4 * 32;
    constexpr int NITEMS = NE * (2 * I_G + I_D);
    for (int it = gw; it < NITEMS; it += NGW) {
        const int e = it / (2 * I_G + I_D); int r = it % (2 * I_G + I_D);
        if (r < 2 * I_G) { const int up = r >= I_G; if (up) r -= I_G; const int kb = r >> 3, nb = r & 7, n0 = nb * 32;
            conv_item((up ? wu : wg) + (size_t)e * D * DE, DE, kb * 64, n0, (bf16*)(ws + WS_WGU) + ((size_t)e * 512 + 256 * (n0 >> 7) + 128 * up + (n0 & 127)) * D, D, gf, scr, F.lane); }
        else { r -= 2 * I_G; const int kb = r >> 5, nb = r & 31; conv_item(wd + (size_t)e * DE * D, D, kb * 64, nb * 32, (bf16*)(ws + WS_WD) + ((size_t)e * D + nb * 32) * DE, DE, nullptr, scr, F.lane); }
    }
}
__device__ __forceinline__ void p8_router(Frame& F, const Args& a) {
    unsigned char* ws = a.ws;
    constexpr int WPITCH = 2064;
    LAS unsigned char* wl = F.lds;
    LAS float* lg = (LAS float*)(F.lds + 48 * WPITCH) + F.wave * 16 * 48;
    { const GAS u32x4* src = (const GAS u32x4*)(ws + WS_WR);
      for (int i = F.tid; i < 48 * 128; i += NWAVES * 64) { const int r = i >> 7, c = i & 127; *(LAS u32x4*)(wl + r * WPITCH + c * 16) = src[i]; } }
    __syncthreads();
    const bf16* X2B = (const bf16*)(ws + WS_X2B); const float* SSP = (const float*)(ws + WS_SSP);
    const float* b_rg = a.in[20]; const float* b_re = a.in[22];
    float* RSTD = (float*)(ws + WS_RSTD); int* ROUTE = (int*)(ws + WS_ROUTE); int* CNT = (int*)(ws + WS_CTL) + CW_CNT; int* LIST = (int*)(ws + WS_LIST); float* WPOS = (float*)(ws + WS_WPOS); float* RPOS = (float*)(ws + WS_RPOS);
    const int fr = F.lane & 15, fq = F.lane >> 4;
    for (int tile = F.vcu * NWAVES + F.wave; tile < T / 16; tile += F.G * NWAVES) {
        const int tok = tile * 16 + fr;
        const GAS bf16x8* xa = (const GAS bf16x8*)(X2B + (size_t)tok * D + 8 * fq);
        f32x4 acc[3]; acc[0] = acc[1] = acc[2] = (f32x4){0.f, 0.f, 0.f, 0.f};
        bf16x8 xf[32];
#pragma unroll
        for (int ks = 0; ks < 32; ++ks) xf[ks] = xa[ks * 4];
#pragma unroll
        for (int ks = 0; ks < 32; ++ks) {
#pragma unroll
            for (int n = 0; n < 3; ++n) { const bf16x8 wfr = *(const LAS bf16x8*)(wl + (n * 16 + fr) * WPITCH + ks * 64 + fq * 16);
                acc[n] = __builtin_amdgcn_mfma_f32_16x16x32_bf16(wfr, xf[ks], acc[n], 0, 0, 0); } }
#pragma unroll
        for (int n = 0; n < 3; ++n) *(LAS f32x4*)(lg + fr * 48 + n * 16 + 4 * fq) = acc[n];
        LDS_WAIT(); asm volatile("" ::: "memory");
        if (F.lane < 16) {
            const int t = tile * 16 + F.lane; const LAS float* l = lg + F.lane * 48;
            float ss = 0.f; { const f32x4* sp = (const f32x4*)(SSP + (size_t)t * 16);
#pragma unroll
                for (int i = 0; i < 4; ++i) { const f32x4 v = sp[i]; ss += (v[0] + v[1]) + (v[2] + v[3]); } }
            const float rstd = rsqrtf(ss * (1.f / D) + EPS);
            float gl[4]; int gs = 0;
#pragma unroll
            for (int i = 0; i < 4; ++i) gl[i] = l[i] * rstd + b_rg[i];
            float gm = gl[0];
#pragma unroll
            for (int i = 1; i < 4; ++i) if (gl[i] > gm) { gm = gl[i]; gs = i; }
            float gsum = 0.f;
#pragma unroll
            for (int i = 0; i < 4; ++i) gsum += __expf(gl[i] - gm);
            const float gtop = 1.f / gsum;
            float el[8];
#pragma unroll
            for (int i = 0; i < 8; ++i) el[i] = l[4 + gs * 8 + i] * rstd + b_re[gs * 8 + i];
            int i0 = 0; float m0 = el[0];
#pragma unroll
            for (int i = 1; i < 8; ++i) if (el[i] > m0) { m0 = el[i]; i0 = i; }
            int i1 = -1; float m1 = -3.0e38f;
#pragma unroll
            for (int i = 0; i < 8; ++i) if (i != i0 && el[i] > m1) { m1 = el[i]; i1 = i; }
            const float p1 = __expf(m1 - m0); const float w0 = gtop / (1.f + p1), w1 = gtop * p1 / (1.f + p1);
            const int e0 = gs * 8 + i0, e1 = gs * 8 + i1;
            const int r0 = atomicAdd(&CNT[e0], 1), r1 = atomicAdd(&CNT[e1], 1);
            RSTD[t] = rstd; *(int4*)(ROUTE + t * 4) = make_int4(e0, e1, r0, r1);
            LIST[e0 * T + r0] = t; LIST[e1 * T + r1] = t; WPOS[e0 * T + r0] = w0; WPOS[e1 * T + r1] = w1; RPOS[e0 * T + r0] = rstd; RPOS[e1 * T + r1] = rstd;
        }
        LDS_WAIT(); asm volatile("" ::: "memory");
    }
}
__device__ __forceinline__ void moe_table(Frame& F, const int* CNT, LAS int* tb) {
    if (F.tid < 64) { const int e = F.lane; int c = 0; if (e < NE) c = (int)__hip_atomic_load((const unsigned*)CNT + e, __ATOMIC_RELAXED, __HIP_MEMORY_SCOPE_AGENT);
        const int tl = (c + 255) >> 8; int incl = tl;
#pragma unroll
        for (int o = 1; o < 32; o <<= 1) { const int v = __shfl_up(incl, o); if (e >= o) incl += v; }
        if (e < NE) { tb[e] = incl - tl; tb[64 + e] = c; } if (e == NE - 1) tb[32] = incl; }
    __syncthreads();
}
__device__ __forceinline__ int moe_find(const LAS int* tb, int mt) { int e = 0;
#pragma unroll 1
    for (int i = 1; i < NE; ++i) if (mt >= tb[i]) e = i; return e; }
struct PhMoeGU {
    static constexpr bool GATHER = true;
    unsigned lda, ldb; const char* X; const char* W; const LAS int* tb; const int* LIST; const float* RPOS; bf16* H; int G, c;
    __device__ __forceinline__ bool next(int i, pg::Unit& u) const { const int L = i * G + c; if (L >= 2 * tb[32]) return false; const int mt = L >> 1, n2 = L & 1, e = moe_find(tb, mt);
        u.A = X; u.B = W + ((size_t)e * 512 + n2 * 256) * ldb; u.nt = D / 64; u.pm = mt; u.pn = n2; u.aux = e; return true; }
    __device__ __forceinline__ void offs(const pg::Unit& u, const int (&R)[2], const int (&C)[2], unsigned (&vo)[2][2]) const {
        const int e = u.aux, cnt = tb[64 + e], r0 = (u.pm - tb[e]) * 256; const int* lp = LIST + (size_t)e * T;
#pragma unroll
        for (int h = 0; h < 2; ++h)
#pragma unroll
            for (int i = 0; i < 2; ++i) { int r = r0 + h * 128 + R[i]; r = r < cnt ? r : cnt - 1; vo[h][i] = (unsigned)lp[r] * lda + (unsigned)C[i] * 2u; }
    }
    __device__ __forceinline__ void epi(const f32x4 (&acc)[2][2][4][2], const pg::Unit& u, int wr, int wc, int fr, int fq) const {
        const int e = u.aux, r0 = (u.pm - tb[e]) * 256; const float* rp = RPOS + (size_t)e * T + r0;
#pragma unroll
        for (int ai = 0; ai < 2; ++ai)
#pragma unroll
            for (int m = 0; m < 4; ++m) { const int tr = ai * 128 + wr * 64 + m * 16 + fr; const float rs = rp[tr];
                f32x4 g0 = acc[ai][0][m][0] * rs, g1 = acc[ai][0][m][1] * rs; const f32x4 u0 = acc[ai][1][m][0] * rs, u1 = acc[ai][1][m][1] * rs;
#pragma unroll
                for (int q = 0; q < 4; ++q) { g0[q] = g0[q] * pg::fsigmoid(g0[q]) * u0[q]; g1[q] = g1[q] * pg::fsigmoid(g1[q]) * u1[q]; }
                *(u32x4*)(H + ((size_t)u.pm * 256 + tr) * DE + u.pn * 128 + 32 * wc + 8 * fq) = pg::pack8(g0, g1); }
    }
};
struct PhMoeDown {
    static constexpr bool GATHER = false;
    unsigned lda, ldb; const char* Hp; const char* W; const LAS int* tb; const float* WPOS; bf16* Y; int G, c;
    __device__ __forceinline__ bool next(int i, pg::Unit& u) const { const int L = i * G + c; if (L >= 4 * tb[32]) return false; const int mt = L >> 2, n4 = L & 3, e = moe_find(tb, mt);
        u.A = Hp + (size_t)mt * 256 * lda; u.B = W + ((size_t)e * D + n4 * 256) * ldb; u.nt = DE / 64; u.pm = mt; u.pn = n4; u.aux = e; return true; }
    __device__ __forceinline__ void offs(const pg::Unit&, const int (&R)[2], const int (&C)[2], unsigned (&vo)[2][2]) const { pg::offs_plain(lda, R, C, vo); }
    __device__ __forceinline__ void epi(const f32x4 (&acc)[2][2][4][2], const pg::Unit& u, int wr, int wc, int fr, int fq) const {
        const int e = u.aux, r0 = (u.pm - tb[e]) * 256; const float* wp = WPOS + (size_t)e * T + r0;
#pragma unroll
        for (int ai = 0; ai < 2; ++ai)
#pragma unroll
            for (int m = 0; m < 4; ++m) { const int tr = ai * 128 + wr * 64 + m * 16 + fr; const float w = wp[tr]; bf16* yp = Y + ((size_t)u.pm * 256 + tr) * D + u.pn * 256 + 32 * wc + 8 * fq;
#pragma unroll
                for (int bj = 0; bj < 2; ++bj) *(u32x4*)(yp + 128 * bj) = pg::pack8(acc[ai][bj][m][0] * w, acc[ai][bj][m][1] * w); }
    }
};
__device__ __forceinline__ void p11_combine(Frame& F, const Args& a, const LAS int* tb) {
    unsigned char* ws = a.ws; const int* ROUTE = (const int*)(ws + WS_ROUTE); const bf16* Y = (const bf16*)(ws + WS_Y); float* out = a.out;
    for (int t = F.vcu * NWAVES + F.wave; t < T; t += F.G * NWAVES) {
        const int4 rt = *(const int4*)(ROUTE + t * 4);
        const GAS u32x2* y0 = (const GAS u32x2*)(Y + ((size_t)tb[rt.x] * 256 + rt.z) * D) + F.lane; const GAS u32x2* y1 = (const GAS u32x2*)(Y + ((size_t)tb[rt.y] * 256 + rt.w) * D) + F.lane;
        GAS f32x4* o = (GAS f32x4*)(out + (size_t)t * D) + F.lane;
#pragma unroll
        for (int j = 0; j < 4; ++j) { const u32x2 a0 = y0[64 * j], a1 = y1[64 * j]; f32x4 v = o[64 * j];
            v[0] += __builtin_bit_cast(float, a0.x << 16) + __builtin_bit_cast(float, a1.x << 16); v[1] += __builtin_bit_cast(float, a0.x & 0xffff0000u) + __builtin_bit_cast(float, a1.x & 0xffff0000u);
            v[2] += __builtin_bit_cast(float, a0.y << 16) + __builtin_bit_cast(float, a1.y << 16); v[3] += __builtin_bit_cast(float, a0.y & 0xffff0000u) + __builtin_bit_cast(float, a1.y & 0xffff0000u);
            o[64 * j] = v; }
    }
}

struct PhSsmX {
    static constexpr bool GATHER = false;
    unsigned lda, ldb; const char* U2X; const char* M1T; float* SLOC; int g;
    __device__ __forceinline__ bool next(int i, pg::Unit& u) const { if (i >= 2) return false; u.A = U2X + ((size_t)(g * NCR + i * 256) * U2P + 128) * 2; u.B = M1T + (size_t)g * 256 * ldb; u.nt = 8; u.pm = i; u.pn = 0; u.aux = 0; return true; }
    __device__ __forceinline__ void offs(const pg::Unit&, const int (&R)[2], const int (&C)[2], unsigned (&vo)[2][2]) const { pg::offs_plain(lda, R, C, vo); }
    __device__ __forceinline__ void epi(const f32x4 (&acc)[2][2][4][2], const pg::Unit& u, int wr, int wc, int fr, int fq) const {
#pragma unroll
        for (int ai = 0; ai < 2; ++ai)
#pragma unroll
            for (int m = 0; m < 4; ++m) { float* p = SLOC + ((size_t)g * NCR + u.pm * 256 + ai * 128 + wr * 64 + m * 16 + fr) * 128 + 32 * wc + 8 * fq;
                *(f32x4*)p = acc[ai][0][m][0]; *(f32x4*)(p + 4) = acc[ai][0][m][1]; }
    }
};
__device__ __forceinline__ void ssm_scan(Frame& F, unsigned char* ws, int g) {
    if (F.tid < 128) { const int b = F.tid >> 6, p = F.tid & 63;
        const float alr = ((const float*)(ws + WS_AL))[(g * NP + p) * 2], ali = ((const float*)(ws + WS_AL))[(g * NP + p) * 2 + 1];
        const unsigned* sl = (const unsigned*)(ws + WS_SLOC) + ((size_t)g * NCR + b * 256) * 128; bf16* hp = (bf16*)(ws + WS_U2X) + ((size_t)g * NCR + b * 256) * U2P;
        float hr = 0.f, hi = 0.f;
#pragma unroll 8
        for (int n = 0; n < 256; ++n) { hp[(size_t)n * U2P + p] = f2bf(hr); hp[(size_t)n * U2P + 64 + p] = f2bf(hi);
            const float sr = __builtin_bit_cast(float, __hip_atomic_load(sl + (size_t)n * 128 + p, __ATOMIC_RELAXED, __HIP_MEMORY_SCOPE_AGENT)), si = __builtin_bit_cast(float, __hip_atomic_load(sl + (size_t)n * 128 + 64 + p, __ATOMIC_RELAXED, __HIP_MEMORY_SCOPE_AGENT));
            const float nr = alr * hr - ali * hi + sr, ni = alr * hi + ali * hr + si; hr = nr; hi = ni; } }
}
struct PhSsmY {
    static constexpr bool GATHER = false;
    unsigned lda, ldb; const char* U2Xp; const char* BTY; const bf16* U2X; const float* Dsk; bf16* Y1; int G, c;
    __device__ __forceinline__ bool next(int i, pg::Unit& u) const { const int L = i * G + c; if (L >= NG * 4) return false; const int g = L >> 2, mt = (L >> 1) & 1, nb = L & 1;
        u.A = U2Xp + (size_t)(g * NCR + mt * 256) * lda; u.B = BTY + (size_t)(g * 512 + nb * 256) * ldb; u.nt = nb ? 10 : 6; u.pm = mt; u.pn = nb; u.aux = g; return true; }
    __device__ __forceinline__ void offs(const pg::Unit&, const int (&R)[2], const int (&C)[2], unsigned (&vo)[2][2]) const { pg::offs_plain(lda, R, C, vo); }
    __device__ __forceinline__ void epi(const f32x4 (&acc)[2][2][4][2], const pg::Unit& u, int wr, int wc, int fr, int fq) const {
        const int g = u.aux;
#pragma unroll
        for (int bj = 0; bj < 2; ++bj) { const int n = u.pn * 256 + 128 * bj + 32 * wc + 8 * fq, j = n >> 4, c0 = n & 15;
            const f32x4 d0 = *(const f32x4*)(Dsk + g * GC + c0), d1 = *(const f32x4*)(Dsk + g * GC + c0 + 4);
#pragma unroll
            for (int ai = 0; ai < 2; ++ai)
#pragma unroll
                for (int m = 0; m < 4; ++m) { const int cr = u.pm * 256 + ai * 128 + wr * 64 + m * 16 + fr;
                    const u32x4 uv = *(const u32x4*)(U2X + ((size_t)g * NCR + cr) * U2P + 128 + j * GC + c0); f32x4 u0, u1; pg::unpack8(uv, u0, u1);
                    f32x4 a = acc[ai][bj][m][0] + d0 * u0, b = acc[ai][bj][m][1] + d1 * u1;
#pragma unroll
                    for (int q = 0; q < 4; ++q) { a[q] = gelu_fast(a[q]); b[q] = gelu_fast(b[q]); }
                    *(u32x4*)(Y1 + ((size_t)cr * LCH + j) * DS + g * GC + c0) = pg::pack8(a, b); } }
    }
};

__global__ void __launch_bounds__(NWAVES * 64, 2) mk_fwd(Args args) {
    extern __shared__ __attribute__((aligned(16))) unsigned char lds[];
    Frame F;
    F.lds = (LAS unsigned char*)lds; F.MISC = (volatile LAS unsigned*)(F.lds + MISC_OFF);
    F.tid = threadIdx.x; F.lane = F.tid & 63; F.wave = __builtin_amdgcn_readfirstlane(F.tid >> 6);
    F.G = gridDim.x; { const int bx = blockIdx.x; F.vcu = (F.G % 8 == 0) ? (bx % 8) * (F.G / 8) + bx / 8 : bx; }
    unsigned char* ws = args.ws; F.ctl = (gu32*)(ws + WS_CTL);
    for (int u = F.tid; u < (LDS_BYTES - LDSCTL_OFF) / 4; u += NWAVES * 64) ((LAS unsigned*)(F.lds + LDSCTL_OFF))[u] = 0u;
    __syncthreads();
    const int lo = args.ph_lo, hi = args.ph_hi;
    const bool multi = (hi - lo) > 1;
    XcdBarrier bar; bar.bar = (unsigned*)(F.ctl + CW_BAR); bar.x = 0; bar.st = nullptr;
    if (multi) bar = xcd_barrier_post((unsigned*)(F.ctl + CW_BAR), F.MISC + 8);
#define IN(k) (lo <= (k) && (k) < hi)
#define SEAM(k) do { if (IN(k) && IN((k) + 1)) xcd_barrier(bar); } while (0)
    if (IN(0)) { p0_prologue(F, args); SEAM(0); }
    if (IN(1)) {
        if (blockIdx.x < NBATCH * NH) p1_cumsum(F, (float*)(ws + WS_CUM));
        PhInProj ph; ph.lda = D * 2; ph.ldb = D * 2; ph.A = (const char*)(ws + WS_XN); ph.B = (const char*)(ws + WS_WIN); ph.so.init(T / 256, 4096 / 256, F.G, (int)blockIdx.x);
        ph.Q = (bf16*)(ws + WS_Q); ph.K = (bf16*)(ws + WS_K); ph.V = (bf16*)(ws + WS_V); ph.U2X = (bf16*)(ws + WS_U2X); ph.GA = (bf16*)(ws + WS_GA); ph.GS = (bf16*)(ws + WS_GS);
        ph.gq = args.in[4]; ph.gk = args.in[5];
        pg::gemm_phase(F.lds + RING_OFF, ph);
        SEAM(1);
    }
    if (IN(2)) {
        if (blockIdx.x < NG) {
            PhSsmX ph; ph.lda = U2P * 2; ph.ldb = 512 * 2; ph.U2X = (const char*)(ws + WS_U2X); ph.M1T = (const char*)(ws + WS_M1T); ph.SLOC = (float*)(ws + WS_SLOC); ph.g = (int)blockIdx.x;
            pg::gemm_phase(F.lds + RING_OFF, ph);
            ssm_scan(F, ws, (int)blockIdx.x);
            __syncthreads();
        }
        p2_expert_weights(F, args); SEAM(2);
    }
    if (IN(3)) {
        static_assert(attn_body::ATTN_LDS_BYTES <= RING_BYTES, "attention LDS");
        const attn_body::AttnTensors AT{(const attn_body::bf16*)(ws + WS_Q), (const attn_body::bf16*)(ws + WS_K), (const attn_body::bf16*)(ws + WS_V), (attn_body::bf16*)(ws + WS_Q), (const float*)(ws + WS_CUM)};
        const attn_body::StaticOrder S(F.vcu);
        attn_body::attn_phase<attn_body::StaticOrder>((char*)lds + RING_OFF, AT, S);
        SEAM(3);
    }
    if (IN(4)) {
        PhSsmY ph; ph.lda = U2P * 2; ph.ldb = U2P * 2; ph.U2Xp = (const char*)(ws + WS_U2X); ph.BTY = (const char*)(ws + WS_BTY); ph.U2X = (const bf16*)(ws + WS_U2X); ph.Dsk = args.in[13]; ph.Y1 = (bf16*)(ws + WS_Y1); ph.G = F.G; ph.c = F.vcu;
        pg::gemm_phase(F.lds + RING_OFF, ph);
        SEAM(4);
    }
    if (IN(5)) {
        PhGlu ph; ph.lda = DS * 2; ph.ldb = DS * 2; ph.A = (const char*)(ws + WS_Y1); ph.B = (const char*)(ws + WS_WGLU); ph.so.init(T / 256, DS / 256, F.G, (int)blockIdx.x); ph.Y1 = (const bf16*)(ws + WS_Y1); ph.YS = (bf16*)(ws + WS_YS);
        pg::gemm_phase(F.lds + RING_OFF, ph);
        SEAM(5);
    }
    if (IN(6)) {
        PhProj ph; ph.lda = DA * 2; ph.ldb = DA * 2; ph.O = (const char*)(ws + WS_Q); ph.YSp = (const char*)(ws + WS_YS); ph.WPA = (const char*)(ws + WS_WPA); ph.WPS = (const char*)(ws + WS_WPS);
        ph.so.init(T / 256, D / 256, F.G, (int)blockIdx.x); ph.GA = (bf16*)(ws + WS_GA); ph.GS = (const bf16*)(ws + WS_GS);
        pg::gemm_phase(F.lds + RING_OFF, ph);
        SEAM(6);
    }
    if (IN(7)) {
        PhWout ph; ph.lda = D * 2; ph.ldb = D * 2; ph.A = (const char*)(ws + WS_GA); ph.B = (const char*)(ws + WS_WOUT); ph.so.init(T / 256, D / 256, F.G, (int)blockIdx.x);
        ph.x = args.in[0]; ph.out = args.out; ph.X2B = (bf16*)(ws + WS_X2B); ph.SSP = (float*)(ws + WS_SSP);
        pg::gemm_phase(F.lds + RING_OFF, ph);
        SEAM(7);
    }
    if (IN(8)) { p8_router(F, args); SEAM(8); }
    LAS int* tb = (LAS int*)(F.lds + LDSCTL_OFF + 512);
    if (IN(9)) {
        moe_table(F, (const int*)(ws + WS_CTL) + CW_CNT, tb);
        PhMoeGU ph; ph.lda = D * 2; ph.ldb = D * 2; ph.X = (const char*)(ws + WS_X2B); ph.W = (const char*)(ws + WS_WGU); ph.tb = tb; ph.LIST = (const int*)(ws + WS_LIST); ph.RPOS = (const float*)(ws + WS_RPOS);
        ph.H = (bf16*)(ws + WS_H); ph.G = F.G; ph.c = F.vcu;
        pg::gemm_phase(F.lds + RING_OFF, ph);
        SEAM(9);
    }
    if (IN(10)) {
        if (!IN(9)) moe_table(F, (const int*)(ws + WS_CTL) + CW_CNT, tb);
        PhMoeDown ph; ph.lda = DE * 2; ph.ldb = DE * 2; ph.Hp = (const char*)(ws + WS_H); ph.W = (const char*)(ws + WS_WD); ph.tb = tb; ph.WPOS = (const float*)(ws + WS_WPOS); ph.Y = (bf16*)(ws + WS_Y); ph.G = F.G; ph.c = F.vcu;
        pg::gemm_phase(F.lds + RING_OFF, ph);
        SEAM(10);
    }
    if (IN(11)) {
        if (!IN(10)) moe_table(F, (const int*)(ws + WS_CTL) + CW_CNT, tb);
        p11_combine(F, args, tb);
    }
#undef IN
#undef SEAM
}

extern "C" void kernel_launch(void* const* d_in, const int* in_sizes, int n_in, void* d_out, int out_size, void* d_ws, size_t ws_size, hipStream_t stream) {
    static int grid = 0;
    if (grid == 0) {
        int dev = 0, cus = 0; (void)hipGetDevice(&dev); (void)hipDeviceGetAttribute(&cus, hipDeviceAttributeMultiprocessorCount, dev);
        (void)hipFuncSetAttribute((const void*)mk_fwd, hipFuncAttributeMaxDynamicSharedMemorySize, LDS_BYTES);
        grid = cus > 0 ? cus : 256;
    }
    (void)hipMemsetAsync((char*)d_ws + WS_CTL, 0, CTL_ZERO_BYTES, stream);
    Args a{}; for (int i = 0; i < 26; ++i) a.in[i] = (const float*)d_in[i]; a.out = (float*)d_out; a.ws = (unsigned char*)d_ws;
    a.ph_lo = 0; a.ph_hi = 12;
    hipLaunchKernelGGL(mk_fwd, dim3(grid), dim3(NWAVES * 64), LDS_BYTES, stream, a);
}
```

```cpp
#include <hip/hip_runtime.h>
#include <stdint.h>
#include <math.h>

typedef unsigned short bf16;
constexpr int T = 16384, D = 1024, SEQ = 8192, NBATCH = 2, NH = 8, HD = 64, DA = 512, DS = 512, NG = 32, GC = 16, NP = 64, NE = 32, DE = 256;
constexpr int DIN = 4104, OQ = 0, OK_ = 512, OV = 1024, OF = 1536, OU = 1544, OGA = 2056, OGS = 3080;
constexpr int LCH = 32, NCR = T / LCH;
constexpr int U2P = 640;
constexpr float EPS = 1e-6f;
constexpr float C2 = 0.125f * 1.4426950408889634f;
constexpr float LOG2E = 1.4426950408889634f;
constexpr int YROWS = 40960;

constexpr size_t MiB = 1u << 20;
constexpr size_t WS_CTL = 0, CTL_ZERO_BYTES = 1 * MiB;
constexpr size_t WS_CUM = 1 * MiB;
constexpr size_t WS_AL = 1 * MiB + 512 * 1024;
constexpr size_t WS_RSTD = 2 * MiB;
constexpr size_t WS_ROUTE = 2 * MiB + 256 * 1024;
constexpr size_t WS_LIST = 3 * MiB;
constexpr size_t WS_WPOS = 5 * MiB;
constexpr size_t WS_SSP = 7 * MiB;
constexpr size_t WS_WIN = 8 * MiB;
constexpr size_t WS_SLOC = 229 * MiB;
constexpr size_t WS_WGLU = 16 * MiB, WS_WPA = 16 * MiB + 512 * 1024, WS_WPS = 17 * MiB + 512 * 1024, WS_WOUT = 18 * MiB + 512 * 1024, WS_WR = 20 * MiB + 512 * 1024;
constexpr size_t WS_M1T = 21 * MiB;
constexpr size_t WS_BTY = 29 * MiB;
constexpr size_t WS_XN = 49 * MiB;
constexpr size_t WS_WGU = 49 * MiB;
constexpr size_t WS_Q = 81 * MiB;
constexpr size_t WS_K = 97 * MiB;
constexpr size_t WS_V = 113 * MiB;
constexpr size_t WS_Y1 = 97 * MiB, WS_YS = 113 * MiB;
constexpr size_t WS_U2X = 129 * MiB;
constexpr size_t WS_GA = 149 * MiB;
constexpr size_t WS_GS = 181 * MiB;
constexpr size_t WS_X2B = 181 * MiB;
constexpr size_t WS_WD = 213 * MiB;
constexpr size_t WS_H = 229 * MiB;
constexpr size_t WS_RPOS = 249 * MiB;
constexpr size_t WS_Y = 81 * MiB;
static_assert(WS_H + (size_t)YROWS * DE * 2 <= WS_RPOS && WS_RPOS + 2 * MiB <= 256 * MiB && WS_Y + (size_t)YROWS * D * 2 <= WS_GS, "d_ws map");

__device__ __forceinline__ bf16 f2bf(float f) { unsigned u = __builtin_bit_cast(unsigned, f); return (bf16)((u + 0x7fffu + ((u >> 16) & 1u)) >> 16); }
__device__ __forceinline__ float bf2f(bf16 b) { return __builtin_bit_cast(float, (unsigned)b << 16); }
__device__ __forceinline__ float sigmoidf_(float x) { return 1.f / (1.f + __expf(-x)); }
__device__ __forceinline__ float gelu_tanh(float x) { const float z = 0.7978845608028654f * (x + 0.044715f * x * x * x); const float e = __expf(2.f * z); return 0.5f * x * (1.f + (1.f - 2.f / (e + 1.f))); }
__device__ __forceinline__ float log_sigmoid(float x) { return -(fmaxf(-x, 0.f) + log1pf(__expf(-fabsf(x)))); }
__device__ __forceinline__ size_t u2x_index(int g, int t, int c) { return ((size_t)g * NCR + (t / LCH)) * U2P + 128 + (t % LCH) * GC + c; }

#define LAS __attribute__((address_space(3)))
#define GAS __attribute__((address_space(1)))
typedef short bf16x8 __attribute__((ext_vector_type(8)));
typedef float f32x4 __attribute__((ext_vector_type(4)));
typedef float f32x2 __attribute__((ext_vector_type(2)));
typedef unsigned u32x4 __attribute__((ext_vector_type(4)));
typedef unsigned u32x2 __attribute__((ext_vector_type(2)));
namespace pg {
constexpr int BM = 256, BK = 64, HALF = 128, HTB = HALF * BK * 2, STAGE_BYTES = 8 * HTB, NXCD = 8, WGM = 8;
__host__ __device__ __forceinline__ int lds_byte(int r, int c) { const int st = (r >> 4) * 2 + (c >> 5), rr = r & 15, cc = c & 31, ob = rr * 64 + cc * 2; return st * 1024 + (ob ^ (((ob >> 9) & 1) << 5)); }
__host__ __device__ __forceinline__ void stage_rc(int b, int& R, int& C) { const int st = b / 1024, sb = b % 1024, swz = sb ^ (((sb >> 9) & 1) << 5); R = (st >> 1) * 16 + swz / 64; C = (st & 1) * 32 + (swz % 64) / 2; }
__host__ __device__ __forceinline__ int perm32(int rho) { const int n = rho >> 4, i = rho & 15; return 8 * (i >> 2) + 4 * n + (i & 3); }
typedef __bf16 bf16x2_t __attribute__((ext_vector_type(2)));
__device__ __forceinline__ unsigned cvt_pk_bf16(float lo, float hi) { const f32x2 v = {lo, hi}; const bf16x2_t b = __builtin_convertvector(v, bf16x2_t); return __builtin_bit_cast(unsigned, b); }
__device__ __forceinline__ u32x4 pack8(const f32x4& a, const f32x4& b) { u32x4 w; w.x = cvt_pk_bf16(a[0], a[1]); w.y = cvt_pk_bf16(a[2], a[3]); w.z = cvt_pk_bf16(b[0], b[1]); w.w = cvt_pk_bf16(b[2], b[3]); return w; }
__device__ __forceinline__ void unpack8(const u32x4& w, f32x4& a, f32x4& b) {
    a[0] = __builtin_bit_cast(float, w.x << 16); a[1] = __builtin_bit_cast(float, w.x & 0xffff0000u); a[2] = __builtin_bit_cast(float, w.y << 16); a[3] = __builtin_bit_cast(float, w.y & 0xffff0000u);
    b[0] = __builtin_bit_cast(float, w.z << 16); b[1] = __builtin_bit_cast(float, w.z & 0xffff0000u); b[2] = __builtin_bit_cast(float, w.w << 16); b[3] = __builtin_bit_cast(float, w.w & 0xffff0000u); }
__device__ __forceinline__ float fsigmoid(float x) { return __builtin_amdgcn_rcpf(1.f + __builtin_amdgcn_exp2f(-1.4426950408889634f * x)); }

struct Unit { const char* A; const char* B; int nt; int pm, pn, aux; };

struct StaticOrder {
    int nM, nN, nwg, G, c;
    __device__ void init(int nM_, int nN_, int G_, int c_) { nM = nM_; nN = nN_; nwg = nM * nN; G = G_; c = c_; }
    __device__ bool next(int i, int& pm, int& pn) const {
        const long L = (long)i * G + c; if (L >= nwg) return false;
        int wgid = (int)L; { const int q = nwg / NXCD, r = nwg % NXCD, xcd = wgid % NXCD, off = wgid / NXCD; wgid = (xcd < r ? xcd * (q + 1) : r * (q + 1) + (xcd - r) * q) + off; }
        const int nig = WGM * nN, gid = wgid / nig, fm = gid * WGM, gsz = (nM - fm) < WGM ? (nM - fm) : WGM;
        pm = fm + ((wgid % nig) % gsz); pn = (wgid % nig) / gsz; return true;
    }
};

template <class P>
__device__ __forceinline__ void gemm_phase(LAS unsigned char* lds, P& ph) {
    const int tid = threadIdx.x, wid = __builtin_amdgcn_readfirstlane(tid >> 6), lane = tid & 63, wr = wid >> 2, wc = wid & 3, fr = lane & 15, fq = lane >> 4;
    const unsigned lda = ph.lda, ldb = ph.ldb;
    int Rr[2], Cc[2]; unsigned voffB[2], vo[2][2], nvo[2][2];
#pragma unroll
    for (int i = 0; i < 2; ++i) { stage_rc(tid * 16 + i * 8192, Rr[i], Cc[i]); const int Rb = (Rr[i] & ~31) + perm32(Rr[i] & 31); voffB[i] = (unsigned)Rb * ldb + (unsigned)Cc[i] * 2u; }
    const size_t kstep = (size_t)(BK * 2);
    const size_t hstepB = (size_t)HALF * ldb;
    const unsigned ldsw = (unsigned)wid * 1024u;
    const int aoff = lds_byte(wr * 64 + fr, fq * 8), boff = lds_byte(wc * 32 + fr, fq * 8);
#define PG_SA(b, h) (((b) * 2 + (h)) * HTB)
#define PG_SB(b, h) ((4 + (b) * 2 + (h)) * HTB)
#define PG_STAGE_B(bufoff, gbase) do { _Pragma("unroll") for (int _i = 0; _i < 2; ++_i) \
        __builtin_amdgcn_global_load_lds((const unsigned*)((const char*)(gbase) + voffB[_i]), (LAS unsigned*)(lds + (bufoff) + ldsw + _i * 8192), 16, 0, 0); } while (0)
#define PG_STAGE_A(bufoff, gbase, VO, h) do { _Pragma("unroll") for (int _i = 0; _i < 2; ++_i) \
        __builtin_amdgcn_global_load_lds((const unsigned*)((const char*)(gbase) + (VO)[h][_i]), (LAS unsigned*)(lds + (bufoff) + ldsw + _i * 8192), 16, 0, 0); } while (0)
#define PG_LDA(dst, b, h) do { _Pragma("unroll") for (int m = 0; m < 4; ++m) _Pragma("unroll") for (int k = 0; k < 2; ++k) dst[m][k] = *(const LAS bf16x8*)(lds + PG_SA(b, h) + aoff + m * 2048 + k * 1024); } while (0)
#define PG_LDB(dst, b, h) do { _Pragma("unroll") for (int n = 0; n < 2; ++n) _Pragma("unroll") for (int k = 0; k < 2; ++k) dst[n][k] = *(const LAS bf16x8*)(lds + PG_SB(b, h) + boff + n * 2048 + k * 1024); } while (0)
#define PG_MMA(ai, bj, At, Bt) do { __builtin_amdgcn_s_setprio(1); _Pragma("unroll") for (int m = 0; m < 4; ++m) _Pragma("unroll") for (int n = 0; n < 2; ++n) _Pragma("unroll") for (int k = 0; k < 2; ++k) \
        acc[ai][bj][m][n] = __builtin_amdgcn_mfma_f32_16x16x32_bf16(Bt[n][k], At[m][k], acc[ai][bj][m][n], 0, 0, 0); __builtin_amdgcn_s_setprio(0); } while (0)
#define PG_WAIT_V(n) asm volatile("s_waitcnt vmcnt(" #n ")" ::: "memory")
#define PG_WAIT_L(n) asm volatile("s_waitcnt lgkmcnt(" #n ")" ::: "memory")
#define PG_BAR __builtin_amdgcn_s_barrier()
#define PG_SCHED __builtin_amdgcn_sched_barrier(0)
    Unit cur, nxt; int ui = 0;
    if (!ph.next(0, cur)) return;
    ph.offs(cur, Rr, Cc, vo);
    f32x4 acc[2][2][4][2];
#pragma unroll
    for (int a = 0; a < 2; ++a)
#pragma unroll
        for (int b = 0; b < 2; ++b)
#pragma unroll
            for (int m = 0; m < 4; ++m)
#pragma unroll
                for (int n = 0; n < 2; ++n) acc[a][b][m][n] = (f32x4){0.f, 0.f, 0.f, 0.f};
    bf16x8 At[4][2], B0[2][2], B1[2][2];
    const char* cA = cur.A; const char* cB = cur.B;
    PG_STAGE_B(PG_SB(0, 0), cB); PG_STAGE_B(PG_SB(0, 1), cB + hstepB); PG_STAGE_A(PG_SA(0, 0), cA, vo, 0); PG_STAGE_A(PG_SA(0, 1), cA, vo, 1);
    if (wr == 1) PG_BAR;
    PG_WAIT_V(2); PG_BAR;
    PG_STAGE_B(PG_SB(1, 0), cB + kstep); PG_STAGE_A(PG_SA(1, 0), cA + kstep, vo, 0); PG_STAGE_B(PG_SB(1, 1), cB + hstepB + kstep);
    PG_WAIT_V(6); PG_BAR;
    for (;;) {
        const bool has_next = ph.next(ui + 1, nxt);
        const int nt = cur.nt;
        const char* nA = has_next ? nxt.A : cA; const char* nB = has_next ? nxt.B : cB;
        if (P::GATHER) { if (has_next) ph.offs(nxt, Rr, Cc, nvo); else {
#pragma unroll
            for (int h = 0; h < 2; ++h)
#pragma unroll
                for (int i = 0; i < 2; ++i) nvo[h][i] = vo[h][i]; } }
#pragma unroll 1
        for (int t = 0; t < nt; t += 2) {
            const bool last = (t == nt - 2);
            const char* a1 = cA + (size_t)(t + 1) * kstep;
            const char* a2 = last ? nA : cA + (size_t)(t + 2) * kstep; const char* b2 = last ? nB : cB + (size_t)(t + 2) * kstep;
            const char* a3 = a2 + kstep; const char* b3 = b2 + kstep;
            unsigned v2[2][2];
#pragma unroll
            for (int h = 0; h < 2; ++h)
#pragma unroll
                for (int i = 0; i < 2; ++i) v2[h][i] = (P::GATHER && last) ? nvo[h][i] : vo[h][i];
            PG_LDB(B0, 0, 0); PG_LDB(B1, 0, 1); PG_SCHED; PG_LDA(At, 0, 0); PG_STAGE_A(PG_SA(1, 1), a1, vo, 1);
            PG_WAIT_V(8); PG_WAIT_L(0); PG_BAR; PG_MMA(0, 0, At, B0); PG_MMA(0, 1, At, B1); PG_BAR; PG_SCHED;
            PG_LDA(At, 0, 1); PG_STAGE_B(PG_SB(0, 0), b2); PG_STAGE_B(PG_SB(0, 1), b2 + hstepB); PG_STAGE_A(PG_SA(0, 0), a2, v2, 0);
            PG_WAIT_V(8); PG_WAIT_L(0); PG_BAR; PG_MMA(1, 0, At, B0); PG_MMA(1, 1, At, B1); PG_BAR; PG_SCHED;
            PG_LDB(B0, 1, 0); PG_LDB(B1, 1, 1); PG_SCHED; PG_LDA(At, 1, 0); PG_STAGE_A(PG_SA(0, 1), a2, v2, 1);
            PG_WAIT_V(8); PG_WAIT_L(0); PG_BAR; PG_MMA(0, 0, At, B0); PG_MMA(0, 1, At, B1); PG_BAR; PG_SCHED;
            PG_LDA(At, 1, 1); PG_STAGE_B(PG_SB(1, 0), b3); PG_STAGE_B(PG_SB(1, 1), b3 + hstepB); PG_STAGE_A(PG_SA(1, 0), a3, v2, 0);
            PG_WAIT_V(8); PG_WAIT_L(0); PG_BAR; PG_MMA(1, 0, At, B0); PG_MMA(1, 1, At, B1); PG_BAR; PG_SCHED;
        }
        if (wr == 0) PG_BAR;
        ph.epi(acc, cur, wr, wc, fr, fq);
        if (!has_next) break;
#pragma unroll
        for (int a = 0; a < 2; ++a)
#pragma unroll
            for (int b = 0; b < 2; ++b)
#pragma unroll
                for (int m = 0; m < 4; ++m)
#pragma unroll
                    for (int n = 0; n < 2; ++n) acc[a][b][m][n] = (f32x4){0.f, 0.f, 0.f, 0.f};
        cur = nxt; cA = nA; cB = nB; ++ui;
        if (P::GATHER) {
#pragma unroll
            for (int h = 0; h < 2; ++h)
#pragma unroll
                for (int i = 0; i < 2; ++i) vo[h][i] = nvo[h][i]; }
        if (wr == 1) PG_BAR;
    }
    PG_WAIT_V(0);
    PG_BAR;
#undef PG_SA
#undef PG_SB
#undef PG_STAGE_A
#undef PG_STAGE_B
#undef PG_LDA
#undef PG_LDB
#undef PG_MMA
#undef PG_WAIT_V
#undef PG_WAIT_L
#undef PG_BAR
#undef PG_SCHED
}
__device__ __forceinline__ void offs_plain(unsigned lda, const int (&R)[2], const int (&C)[2], unsigned (&vo)[2][2]) {
#pragma unroll
    for (int h = 0; h < 2; ++h)
#pragma unroll
        for (int i = 0; i < 2; ++i) vo[h][i] = (unsigned)(h * HALF + R[i]) * lda + (unsigned)C[i] * 2u;
}
}

namespace attn_body {
using bf16=unsigned short;
using bf16x8=__attribute__((ext_vector_type(8)))short;
using s16x4=__attribute__((ext_vector_type(4)))short;
using f32x16=__attribute__((ext_vector_type(16)))float;
using u32x4=__attribute__((ext_vector_type(4)))unsigned;
constexpr int BATCH=2,NHEAD=8,SEQ=8192,D=64,DM=NHEAD*D;
constexpr int NW=8,QBLK=32,QB=QBLK*NW,KVBLK=64,NQB=SEQ/QB;
constexpr int ATTN_PITCH=DM, ATTN_UNIT_ROWS=QB;
__device__ __forceinline__ int crow(int r,int hi){return (r&3)+8*(r>>2)+4*hi;}
__device__ __forceinline__ unsigned short f2bf_a(float f){unsigned u=__builtin_bit_cast(unsigned,f);return (unsigned short)((u+0x7fffu+((u>>16)&1u))>>16);}
#define SBAR() __builtin_amdgcn_sched_barrier(0)
__device__ __forceinline__ void cmask(f32x16&p0,f32x16&p1,int jb,int qrel,int hi){
  const float NEG=-INFINITY; int kb=64*jb+4*hi;
  #pragma unroll
  for(int r=0;r<16;++r){int kv=kb+(r&3)+8*(r>>2); if(kv>qrel)p0[r]=NEG; if(kv+32>qrel)p1[r]=NEG;}
}

constexpr int NSLOT=3, SLOTB=8192;
constexpr int LDS_K=0, LDS_V=NSLOT*SLOTB, LDS_WS=2*NSLOT*SLOTB, LDS_OST=LDS_WS+NW*64*4, LDS_FK=LDS_OST+NW*4096, LDS_BYTES=LDS_FK+SEQ*4+1024;
constexpr float C2=0.125f*1.4426950408889634f;
__device__ __forceinline__ void glds16(const void*gsrc,unsigned lds_dst){unsigned keep;
  asm volatile("s_mov_b32 %0, m0\n\ts_mov_b32 m0, %2\n\ts_nop 0\n\tglobal_load_lds_dwordx4 %1, off\n\ts_mov_b32 m0, %0":"=&s"(keep):"v"(gsrc),"s"(lds_dst):"memory");}
__device__ __forceinline__ float max3f(float a,float b,float c){float r;asm("v_max3_f32 %0, %1, %2, %3":"=v"(r):"v"(a),"v"(b),"v"(c));return r;}
__device__ __forceinline__ float max2f(float a,float b){float r;asm("v_max_f32_e32 %0, %1, %2":"=v"(r):"v"(a),"v"(b));return r;}
__device__ __forceinline__ float fadd_s(float a,float b){float r;asm("v_add_f32_e32 %0, %1, %2":"=v"(r):"v"(a),"v"(b));return r;}
__device__ __forceinline__ float fsub_s(float a,float b){float r;asm("v_sub_f32_e32 %0, %1, %2":"=v"(r):"v"(a),"v"(b));return r;}
typedef float f32x4_t __attribute__((ext_vector_type(4)));
typedef float f32x2_t __attribute__((ext_vector_type(2))); typedef __bf16 bf16x2_t __attribute__((ext_vector_type(2)));
__device__ __forceinline__ unsigned cvtpk_s(float lo,float hi){f32x2_t v={lo,hi};bf16x2_t b=__builtin_convertvector(v,bf16x2_t);return __builtin_bit_cast(unsigned,b);}
#define WAIT_BAR(N) asm volatile("s_waitcnt vmcnt(" #N ") lgkmcnt(0)\n\ts_barrier":::"memory")

__device__ __forceinline__ void qkt(f32x16&p0,f32x16&p1,const char*Kslot,const bf16x8*qr,int r32,int hi){
  const char*kb=Kslot+hi*1024+r32*16;
  #pragma unroll
  for(int d0=0;d0<4;++d0){
    const bf16x8 b0=*reinterpret_cast<const bf16x8*>(kb+d0*2048);
    const bf16x8 b1=*reinterpret_cast<const bf16x8*>(kb+d0*2048+512);
    p0=__builtin_amdgcn_mfma_f32_32x32x16_bf16(b0,qr[d0],p0,0,0,0);p1=__builtin_amdgcn_mfma_f32_32x32x16_bf16(b1,qr[d0],p1,0,0,0);}
}
typedef __attribute__((address_space(3))) const char* lds_cptr;
typedef short v4i16_t __attribute__((ext_vector_type(4)));
__device__ __forceinline__ void kload8(bf16x8*kf,lds_cptr kp){
  kf[0]=*(const __attribute__((address_space(3))) bf16x8*)(kp);      kf[1]=*(const __attribute__((address_space(3))) bf16x8*)(kp+512);
  kf[2]=*(const __attribute__((address_space(3))) bf16x8*)(kp+2048); kf[3]=*(const __attribute__((address_space(3))) bf16x8*)(kp+2560);
  kf[4]=*(const __attribute__((address_space(3))) bf16x8*)(kp+4096); kf[5]=*(const __attribute__((address_space(3))) bf16x8*)(kp+4608);
  kf[6]=*(const __attribute__((address_space(3))) bf16x8*)(kp+6144); kf[7]=*(const __attribute__((address_space(3))) bf16x8*)(kp+6656);
}
__device__ __forceinline__ void kload2(bf16x8*kf,lds_cptr kp,int j){ kf[2*j]=*(const __attribute__((address_space(3))) bf16x8*)(kp+j*2048); kf[2*j+1]=*(const __attribute__((address_space(3))) bf16x8*)(kp+j*2048+512); }
__device__ __forceinline__ s16x4 vtr(lds_cptr p){ return __builtin_bit_cast(s16x4,__builtin_amdgcn_ds_read_tr16_b64_v4i16((__attribute__((address_space(3))) v4i16_t*)p)); }
__device__ __forceinline__ float rowmax(const f32x16&p0,const f32x16&p1){
  float a=max3f(p0[0],p0[1],p1[0]),b=max3f(p0[2],p0[3],p1[1]);a=max3f(a,p1[2],p1[3]);
  #pragma unroll
  for(int r=4;r<16;r+=4){a=max3f(a,p0[r],p0[r+1]);b=max3f(b,p0[r+2],p0[r+3]);a=max3f(a,p1[r],p1[r+1]);b=max3f(b,p1[r+2],p1[r+3]);}
  const float m=max2f(a,b);
  auto rr=__builtin_amdgcn_permlane32_swap(__float_as_uint(m),__float_as_uint(m),false,false);
  return max2f(__uint_as_float(rr[0]),__uint_as_float(rr[1]));
}
__device__ __forceinline__ void pv(f32x16*o,int vb,bf16x8 pa0,bf16x8 pa1,bf16x8 pa2,bf16x8 pa3){
  #pragma unroll
  for(int d0=0;d0<2;++d0){s16x4 lo[4],hi[4];
    #pragma unroll
    for(int ks=0;ks<4;++ks){
      asm volatile("ds_read_b64_tr_b16 %0,%1 offset:%c2":"=&v"(lo[ks]):"v"(vb),"i"(d0*4096+ks*1024):"memory");
      asm volatile("ds_read_b64_tr_b16 %0,%1 offset:%c2":"=&v"(hi[ks]):"v"(vb),"i"(d0*4096+ks*1024+512):"memory");}
    asm volatile("s_waitcnt lgkmcnt(0)":::"memory");SBAR();
    #define PK(k) (bf16x8){lo[k][0],lo[k][1],lo[k][2],lo[k][3],hi[k][0],hi[k][1],hi[k][2],hi[k][3]}
    o[d0]=__builtin_amdgcn_mfma_f32_32x32x16_bf16(pa0,PK(0),o[d0],0,0,0);
    o[d0]=__builtin_amdgcn_mfma_f32_32x32x16_bf16(pa1,PK(1),o[d0],0,0,0);
    o[d0]=__builtin_amdgcn_mfma_f32_32x32x16_bf16(pa2,PK(2),o[d0],0,0,0);
    o[d0]=__builtin_amdgcn_mfma_f32_32x32x16_bf16(pa3,PK(3),o[d0],0,0,0);
    #undef PK
  }
}

#ifndef ATTN_STORE16
#define ATTN_STORE16(p,v) (*(u32x4*)(p)=(v))
#endif
template<int THRL> __device__ __forceinline__ void attn_unit(int b,int h,int qb,const bf16*Q,const bf16*__restrict__ K,const bf16*__restrict__ V,bf16*O,const float*__restrict__ CUM,char*shm){
  const int tid=threadIdx.x,lane=tid&63,r32=lane&31,hi=lane>>5; const int wid=__builtin_amdgcn_readfirstlane(tid>>6);
  const long rowbase=(long)b*SEQ; const int q0=qb*QB;
  const bf16*Qw=Q+(rowbase+q0+wid*QBLK)*DM+h*D;
  const bf16*Kh=K+rowbase*DM+h*D,*Vh=V+rowbase*DM+h*D; const float*Fh=CUM+((long)b*NHEAD+h)*SEQ;
  const unsigned lds0=(unsigned)(uintptr_t)shm;
  float*wsf=(float*)(shm+LDS_WS)+wid*64;
  const bf16*ksrc=Kh+(long)lane*DM+wid*8;
  const bf16*vsrc=Vh+(long)(16*(wid&3)+(lane>>2))*DM+(wid>>2)*32+(lane&3)*8;
  const unsigned kdst=lds0+LDS_K+wid*1024, vdst=lds0+LDS_V+wid*1024;
  #define DMA_K(t,slot) glds16(ksrc+(long)(t)*KVBLK*DM,(unsigned)__builtin_amdgcn_readfirstlane(kdst+(slot)))
  #define DMA_V(t,slot) glds16(vsrc+(long)(t)*KVBLK*DM,(unsigned)__builtin_amdgcn_readfirstlane(vdst+(slot)))
  const int vb0=(int)(lds0+LDS_V)+((lane>>4)&1)*32+(lane&3)*8+(4*hi+((lane&15)>>2))*64;
  const char*Kbase=shm+LDS_K; bf16x8 kf[8];
  const lds_cptr shm3=(lds_cptr)shm; const lds_cptr kp0=shm3+LDS_K+hi*1024+r32*16; const lds_cptr vp0=shm3+LDS_V+((lane>>4)&1)*32+(lane&3)*8+(4*hi+((lane&15)>>2))*64;
  const int NT=(q0+QB)/KVBLK;
  for(int p_=wid;p_<=qb;p_+=NW) glds16(Fh+p_*256+lane*4,(unsigned)__builtin_amdgcn_readfirstlane(lds0+LDS_FK+p_*1024));
  DMA_K(0,0);DMA_V(0,0);DMA_K(1,SLOTB);
  bf16x8 qr[4];
  #pragma unroll
  for(int d0=0;d0<4;++d0)qr[d0]=*reinterpret_cast<const bf16x8*>(&Qw[(long)r32*DM+d0*16+hi*8]);
  const float fq2=Fh[q0+wid*QBLK+r32];
  float mhat=0.f,l_reg=0.f;f32x16 o[2];o[0]=f32x16{};o[1]=f32x16{};float nb=fq2;
  const lds_cptr fkp=(lds_cptr)shm+LDS_FK+hi*16;
  const int qrel=wid*QBLK+r32;
  #define CMASK(P0,P1,t) do{int jb_=(t)-(NT-4); if(jb_>=0)cmask(P0,P1,jb_,qrel,hi);}while(0)
  bool resc=false;
  #define START(P0,P1) do{ const float rm=rowmax(P0,P1); resc=false; \
    { const float dl=rm; mhat=fadd_s(mhat,dl); \
      _Pragma("unroll") for(int r=0;r<16;++r){P0[r]=fsub_s(P0[r],dl);P1[r]=fsub_s(P1[r],dl);} \
      nb=fsub_s(fq2,mhat); } \
    _Pragma("unroll") for(int r=0;r<16;++r)P0[r]=__builtin_amdgcn_exp2f(P0[r]); }while(0)
  #define RESC() do{ if(resc){ asm volatile("s_waitcnt lgkmcnt(0)":::"memory"); \
      _Pragma("unroll") for(int d_=0;d_<2;++d_) _Pragma("unroll") for(int r=0;r<16;++r)o[d_][r]*=wsf[crow(r,hi)]; } }while(0)
  #define FILLC(C0_,C1_,tt) do{ const lds_cptr f_=fkp+(tt)*256; _Pragma("unroll") for(int a_=0;a_<4;++a_){ const f32x4_t x0_=*(const __attribute__((address_space(3))) f32x4_t*)(f_+32*a_); const f32x4_t x1_=*(const __attribute__((address_space(3))) f32x4_t*)(f_+128+32*a_); \
      _Pragma("unroll") for(int i_=0;i_<4;++i_){ C0_[4*a_+i_]=nb-x0_[i_]; C1_[4*a_+i_]=nb-x1_[i_]; } } }while(0)
  f32x16 pA0,pA1,pB0,pB1;
  int sl_prev=0,sl_cur=0,sl_next=SLOTB;
  #define ROT() do{sl_prev=sl_cur;sl_cur=sl_next;sl_next=(sl_next==(NSLOT-1)*SLOTB)?0:sl_next+SLOTB;}while(0)
  DMA_K(2,2*SLOTB);
  WAIT_BAR(3);
  FILLC(pA0,pA1,0);
  qkt(pA0,pA1,Kbase,qr,r32,hi);asm volatile("s_nop 15\n\ts_nop 7":"+v"(pA0),"+v"(pA1));CMASK(pA0,pA1,0);
  START(pA0,pA1);
  _Pragma("unroll") for(int r=0;r<16;++r)pA1[r]=__builtin_amdgcn_exp2f(pA1[r]);
  WAIT_BAR(0);
  DMA_K(3,0);DMA_V(1,SLOTB);
  ROT();
  FILLC(pB0,pB1,1);
  kload8(kf,kp0+sl_cur);
  WAIT_BAR(2);
  s16x4 vlo[8],vhi[8]; u32x4 pw0,pw1,pw2,pw3;
  #define PKW(P,B) cvtpk_s(P[B],P[B+1])
  #define PAF(k) __builtin_bit_cast(bf16x8,pw##k)
  #define VFR(i) (bf16x8){vlo[i][0],vlo[i][1],vlo[i][2],vlo[i][3],vhi[i][0],vhi[i][1],vhi[i][2],vhi[i][3]}
  #define PIN(x) asm volatile("":"+v"(x))
  #define MX3(a,b,c) __builtin_fmaxf(__builtin_fmaxf((a),(b)),(c))
  #define GAPA(MF,A0,A1,A2,A3,W0,W1,PW) do{ MF; sacc+=A0; sacc+=A1; sacc+=A2; sacc+=A3; PIN(sacc); W0; W1; PIN(PW); SBAR(); }while(0)
  #define EX(v) __builtin_amdgcn_exp2f(v)
  #define FLD(off) (*(const __attribute__((address_space(3))) f32x4_t*)(fk_+(off)))
  #define GAPB(MF,X,B,PF,FC,FN,NOFF) do{ MF; X[B]=EX(X[B]); X[B+1]=EX(X[B+1]); X[B+2]=EX(X[B+2]); X[B+3]=EX(X[B+3]); PF[B]=nb-FC[0]; PF[B+1]=nb-FC[1]; PF[B+2]=nb-FC[2]; PF[B+3]=nb-FC[3]; FN=FLD(NOFF); PIN(X); PIN(PF); SBAR(); }while(0)
  #define VRD(i) do{ vlo[i]=vtr(vp_+(((i)>>2)*4096+((i)&3)*1024)); vhi[i]=vtr(vp_+(((i)>>2)*4096+((i)&3)*1024+512)); }while(0)
  #define KRD(G,j) do{ if(G){ kload2(kf,kp0+sl_next,j); SBAR(); } }while(0)
  #define STEP(C0,C1,P0,P1,t,GK,GV,GL) do{ SBAR(); \
    const lds_cptr vp_=vp0+sl_prev; \
    VRD(0); SBAR(); float sacc=(P0[0]+P0[1]); \
    GAPA(C0=__builtin_amdgcn_mfma_f32_32x32x16_bf16(kf[0],qr[0],C0,0,0,0), P0[2],P0[3],P0[4],P0[5],     pw0[0]=PKW(P0,0), pw0[1]=PKW(P0,2), pw0); \
    VRD(4); SBAR(); GAPA(C1=__builtin_amdgcn_mfma_f32_32x32x16_bf16(kf[1],qr[0],C1,0,0,0), P0[6],P0[7],P0[8],P0[9],     pw0[2]=PKW(P0,4), pw0[3]=PKW(P0,6), pw0); \
    VRD(1); SBAR(); GAPA(C0=__builtin_amdgcn_mfma_f32_32x32x16_bf16(kf[2],qr[1],C0,0,0,0),   P0[10],P0[11],P0[12],P0[13], pw1[0]=PKW(P0,8), pw1[1]=PKW(P0,10), pw1); \
    VRD(5); SBAR(); GAPA(C1=__builtin_amdgcn_mfma_f32_32x32x16_bf16(kf[3],qr[1],C1,0,0,0),   P0[14],P0[15],P1[0],P1[1],   pw1[2]=PKW(P0,12),pw1[3]=PKW(P0,14), pw1); \
    VRD(2); SBAR(); GAPA(C0=__builtin_amdgcn_mfma_f32_32x32x16_bf16(kf[4],qr[2],C0,0,0,0),   P1[2],P1[3],P1[4],P1[5],     pw2[0]=PKW(P1,0), pw2[1]=PKW(P1,2), pw2); \
    VRD(6); SBAR(); GAPA(C1=__builtin_amdgcn_mfma_f32_32x32x16_bf16(kf[5],qr[2],C1,0,0,0),   P1[6],P1[7],P1[8],P1[9],     pw2[2]=PKW(P1,4), pw2[3]=PKW(P1,6), pw2); \
    VRD(3); SBAR(); GAPA(C0=__builtin_amdgcn_mfma_f32_32x32x16_bf16(kf[6],qr[3],C0,0,0,0),   P1[10],P1[11],P1[12],P1[13], pw3[0]=PKW(P1,8), pw3[1]=PKW(P1,10), pw3); \
    VRD(7); SBAR(); GAPA(C1=__builtin_amdgcn_mfma_f32_32x32x16_bf16(kf[7],qr[3],C1,0,0,0),   P1[14],P1[15],0.f,0.f,       pw3[2]=PKW(P1,12),pw3[3]=PKW(P1,14), pw3); \
    l_reg+=sacc; \
    if(GK){DMA_K((t)+3,sl_cur);} if(GV){DMA_V((t)+1,sl_next);} \
    CMASK(C0,C1,t); \
    { float a=MX3(C0[0],C0[1],C1[0]),b=MX3(C0[2],C0[3],C1[1]); a=MX3(a,C1[2],C1[3]); \
      _Pragma("unroll") for(int r=4;r<16;r+=4){a=MX3(a,C0[r],C0[r+1]);b=MX3(b,C0[r+2],C0[r+3]);a=MX3(a,C1[r],C1[r+1]);b=MX3(b,C1[r+2],C1[r+3]);} \
      float rm=__builtin_fmaxf(a,b); { auto rr=__builtin_amdgcn_permlane32_swap(__float_as_uint(rm),__float_as_uint(rm),false,false); rm=__builtin_fmaxf(__uint_as_float(rr[0]),__uint_as_float(rr[1])); } \
      resc=false; \
      if(__builtin_expect(__any(rm>(float)THRL),0)){ const float dl=__builtin_fmaxf(rm,0.f); mhat+=dl; \
        _Pragma("unroll") for(int r=0;r<16;++r){C0[r]-=dl;C1[r]-=dl;} \
        nb=fq2-mhat; \
        const float f=__builtin_amdgcn_exp2f(-dl); l_reg*=f; if(hi==0)wsf[r32]=f; resc=true; } } \
    SBAR(); \
    const lds_cptr fk_=fkp+((t)+1)*256; f32x4_t fa_=FLD(0),fb_; SBAR(); \
    GAPB(o[0]=__builtin_amdgcn_mfma_f32_32x32x16_bf16(PAF(0),VFR(0),o[0],0,0,0), C0,0, P0,fa_,fb_,32); \
    GAPB(o[1]=__builtin_amdgcn_mfma_f32_32x32x16_bf16(PAF(0),VFR(4),o[1],0,0,0), C0,4, P0,fb_,fa_,64); \
    KRD(GL,0); GAPB(o[0]=__builtin_amdgcn_mfma_f32_32x32x16_bf16(PAF(1),VFR(1),o[0],0,0,0), C0,8, P0,fa_,fb_,96); \
    KRD(GL,1); GAPB(o[1]=__builtin_amdgcn_mfma_f32_32x32x16_bf16(PAF(1),VFR(5),o[1],0,0,0), C0,12, P0,fb_,fa_,128); \
    KRD(GL,2); GAPB(o[0]=__builtin_amdgcn_mfma_f32_32x32x16_bf16(PAF(2),VFR(2),o[0],0,0,0), C1,0, P1,fa_,fb_,160); \
    KRD(GL,3); GAPB(o[1]=__builtin_amdgcn_mfma_f32_32x32x16_bf16(PAF(2),VFR(6),o[1],0,0,0), C1,4, P1,fb_,fa_,192); \
    GAPB(o[0]=__builtin_amdgcn_mfma_f32_32x32x16_bf16(PAF(3),VFR(3),o[0],0,0,0), C1,8, P1,fa_,fb_,224); \
    GAPB(o[1]=__builtin_amdgcn_mfma_f32_32x32x16_bf16(PAF(3),VFR(7),o[1],0,0,0), C1,12, P1,fb_,fa_,224); \
    }while(0)
  int t=1;
  #undef CMASK
  #define CMASK(P0,P1,t) do{}while(0)
  for(;t+5<NT;t+=2){
    STEP(pB0,pB1,pA0,pA1,t,true,true,true);     WAIT_BAR(2); RESC(); ROT();
    STEP(pA0,pA1,pB0,pB1,t+1,true,true,true);   WAIT_BAR(2); RESC(); ROT();
  }
  #undef CMASK
  #define CMASK(P0,P1,t) do{int jb_=(t)-(NT-4); if(jb_>=0)cmask(P0,P1,jb_,qrel,hi);}while(0)
  #define ENDW(tt) do{ if((tt)+3<NT){WAIT_BAR(2);} else if((tt)+2<NT){WAIT_BAR(1);} else {WAIT_BAR(0);} }while(0)
  for(;t+1<NT;t+=2){
    STEP(pB0,pB1,pA0,pA1,t,(t+3<NT),(t+1<NT),(t+1<NT));       ENDW(t);   RESC(); ROT();
    STEP(pA0,pA1,pB0,pB1,t+1,(t+4<NT),(t+2<NT),(t+2<NT));     ENDW(t+1); RESC(); ROT();
  }
  STEP(pB0,pB1,pA0,pA1,NT-1,false,false,false); RESC();
  { float sacc=pB0[0]+pB0[1]; _Pragma("unroll") for(int r=2;r<16;++r)sacc+=pB0[r]; _Pragma("unroll") for(int r=0;r<16;++r)sacc+=pB1[r]; l_reg+=sacc;
    pw0=(u32x4){PKW(pB0,0),PKW(pB0,2),PKW(pB0,4),PKW(pB0,6)};pw1=(u32x4){PKW(pB0,8),PKW(pB0,10),PKW(pB0,12),PKW(pB0,14)};pw2=(u32x4){PKW(pB1,0),PKW(pB1,2),PKW(pB1,4),PKW(pB1,6)};pw3=(u32x4){PKW(pB1,8),PKW(pB1,10),PKW(pB1,12),PKW(pB1,14)};
    SBAR(); pv(o,vb0+sl_cur,PAF(0),PAF(1),PAF(2),PAF(3)); }
  #undef PKW
  #undef PAF
  #undef VFR
  #undef PIN
  #undef MX3
  #undef GAPA
  #undef GAPB
  #undef FLD
  #undef FILLC
  #undef EX
  #undef VRD
  #undef KRD
  #undef STEP
  #undef ENDW
  {auto rr=__builtin_amdgcn_permlane32_swap(__float_as_uint(l_reg),__float_as_uint(l_reg),false,false);l_reg=__uint_as_float(rr[0])+__uint_as_float(rr[1]);}
  if(hi==0)wsf[32+r32]=l_reg;asm volatile("s_waitcnt lgkmcnt(0)":::"memory");
  float rli[16];
  #pragma unroll
  for(int r=0;r<16;++r)rli[r]=__builtin_amdgcn_rcpf(wsf[32+crow(r,hi)]);
  bf16*Ow=O+(rowbase+q0+wid*QBLK)*DM+h*D;
  { bf16*stg=(bf16*)(shm+LDS_OST)+wid*2048;
    #pragma unroll
    for(int r=0;r<16;++r){const int orow=crow(r,hi);
      #pragma unroll
      for(int d0=0;d0<2;++d0)stg[orow*64+d0*32+r32]=f2bf_a(o[d0][r]*rli[r]);}
    asm volatile("s_waitcnt lgkmcnt(0)":::"memory");
    #pragma unroll
    for(int i=0;i<4;++i){const int row=i*8+(lane>>3),ch=lane&7; const u32x4 v=*(const u32x4*)(stg+row*64+ch*8); ATTN_STORE16(Ow+(long)row*DM+ch*8,v);} }
  asm volatile("s_waitcnt lgkmcnt(0)\n\ts_barrier":::"memory");
  #undef DMA_K
  #undef DMA_V
  #undef CMASK
  #undef START
  #undef RESC
  #undef ROT
}
constexpr int ATTN_LDS_BYTES=LDS_BYTES;
struct AttnTensors { const bf16* Q; const bf16* K; const bf16* V; bf16* O; const float* CUM; };
struct AttnUnit { int bh; int qb; };
struct StaticOrder {
  int vcu;
  __device__ __forceinline__ explicit StaticOrder(int v):vcu(v){}
  __device__ __forceinline__ bool next(int i,AttnUnit&u)const{ if(i>=2)return false; const int s=vcu&15; u.bh=vcu>>4; u.qb=(i==0)?31-s:s; return true; }
};
template<class Sched,int THRL=8> __device__ __forceinline__ void attn_phase(char*lds,const AttnTensors&T,const Sched&S){
  AttnUnit u;
  for(int i=0;S.next(i,u);++i){ attn_unit<THRL>(u.bh/NHEAD,u.bh%NHEAD,u.qb,T.Q,T.K,T.V,T.O,T.CUM,lds); }
}
#undef SBAR
#undef WAIT_BAR
}

constexpr int NWAVES = 8;
constexpr int RING_OFF = 0, RING_BYTES = 131072;
constexpr int LDSCTL_OFF = RING_BYTES, MISC_OFF = LDSCTL_OFF + 320;
constexpr int LDS_BYTES = 147456;
typedef GAS unsigned gu32;
#define RLX_AGENT __ATOMIC_RELAXED, __HIP_MEMORY_SCOPE_AGENT
#define LDS_WAIT() asm volatile("s_waitcnt lgkmcnt(0)" ::: "memory")
#define VM_WAIT() asm volatile("s_waitcnt vmcnt(0)" ::: "memory")
constexpr int CW_TMO = 0, CW_CODE = 1, CW_CNT = 64  , CW_Q0 = 128  , CW_BAR = 4096;

#define XB_TMO      128
#define XB_XCNT(j)  (256  + 64 * (j))
#define XB_XSUB(j)  (1280 + 64 * (j))
#define XB_XGEN(j)  (2304 + 64 * (j))
#define XB_TOP      3328
#define XB_TOPGEN   3392
#define XCD_BAR_WORDS 3456
#define XB_SPIN_CAP (1u << 18)
__device__ __forceinline__ unsigned xb_ld(unsigned* p)              { return __hip_atomic_load(p, __ATOMIC_RELAXED, __HIP_MEMORY_SCOPE_AGENT); }
__device__ __forceinline__ unsigned xb_add(unsigned* p, unsigned v) { return __hip_atomic_fetch_add(p, v, __ATOMIC_RELAXED, __HIP_MEMORY_SCOPE_AGENT); }
__device__ __forceinline__ unsigned xb_xcc_id() { return (unsigned)__builtin_amdgcn_s_getreg((3 << 11) | 20) & 0xFu; }
#define XB_SPIN(cond, bar) do { unsigned _sp = 0; while (cond) { __builtin_amdgcn_s_sleep(1); \
    if ((++_sp & 255u) == 0u) { if (xb_ld(&(bar)[XB_TMO])) break; if (_sp > XB_SPIN_CAP) { atomicAdd(&(bar)[XB_TMO], 1u); break; } } } } while (0)
struct XcdBarrier { unsigned* bar; unsigned x; volatile LAS unsigned* st; };
__device__ __forceinline__ XcdBarrier xcd_barrier_post(unsigned* bar, volatile LAS unsigned* st) {
    XcdBarrier b; b.bar = bar; b.x = xb_xcc_id(); b.st = st;
    if (threadIdx.x == 0) (void)xb_add(&bar[XB_XCNT(b.x)], 1u);
    return b;
}
__device__ __forceinline__ void xcd_barrier_complete(unsigned* bar, unsigned x, unsigned& nloc, unsigned& nx) {
    const unsigned G = gridDim.x * gridDim.y * gridDim.z;
    unsigned sum, cnt, mine, sp = 0u;
    for (;;) {
        sum = 0u; cnt = 0u; mine = 0u;
#pragma unroll
        for (unsigned j = 0; j < 16; ++j) { const unsigned c = xb_ld(&bar[XB_XCNT(j)]); sum += c; cnt += (c > 0u) ? 1u : 0u; mine = (j == x) ? c : mine; }
        if (sum == G) break;
        __builtin_amdgcn_s_sleep(1);
        if ((++sp & 255u) == 0u) { if (xb_ld(&bar[XB_TMO])) break; if (sp > XB_SPIN_CAP) { atomicAdd(&bar[XB_TMO], 1u); break; } }
    }
    nloc = mine > 0u ? mine : 1u; nx = cnt > 0u ? cnt : 1u;
}
__device__ __forceinline__ void xcd_barrier(const XcdBarrier& b) {
    asm volatile("s_waitcnt vmcnt(0)" ::: "memory");
    __syncthreads();
    if (threadIdx.x == 0) {
        unsigned* bar = b.bar;
        __builtin_amdgcn_s_waitcnt(0);
        unsigned nloc = b.st[0], nx = b.st[1];
        if (nloc == 0u) { xcd_barrier_complete(bar, b.x, nloc, nx); b.st[0] = nloc; b.st[1] = nx; }
        const unsigned old = xb_add(&bar[XB_XSUB(b.x)], 1u);
        const unsigned gen = old / nloc;
        if (old + 1u == (gen + 1u) * nloc) {
            __builtin_amdgcn_fence(__ATOMIC_RELEASE, "agent");
            asm volatile("s_waitcnt vmcnt(0)" ::: "memory");
            const unsigned og = xb_add(&bar[XB_TOP], 1u);
            const unsigned tg = og / nx;
            if (og + 1u == (tg + 1u) * nx) xb_add(&bar[XB_TOPGEN], 1u);
            else XB_SPIN(xb_ld(&bar[XB_TOPGEN]) == tg, bar);
            __builtin_amdgcn_fence(__ATOMIC_ACQUIRE, "agent");
            xb_add(&bar[XB_XGEN(b.x)], 1u);
            asm volatile("s_waitcnt vmcnt(0)" ::: "memory");
        } else {
            XB_SPIN(xb_ld(&bar[XB_XGEN(b.x)]) == gen, bar);
            __builtin_amdgcn_fence(__ATOMIC_ACQUIRE, "agent");
            asm volatile("s_waitcnt vmcnt(0)" ::: "memory");
        }
    }
    __syncthreads();
}

struct Args { const float* in[26]; float* out; unsigned char* ws; int ph_lo, ph_hi, sub, pad_; };
struct Frame {
    LAS unsigned char* lds; volatile LAS unsigned* MISC; gu32* ctl;
    int tid, lane, wave, vcu, G;
};
__device__ __forceinline__ float gelu_fast(float x) { const float z = 0.7978845608028654f * (x + 0.044715f * x * x * x); const float e = __builtin_amdgcn_exp2f(2.885390081777927f * z); return x - x * __builtin_amdgcn_rcpf(e + 1.f); }
__device__ __forceinline__ float wave_sum(float v) {
#pragma unroll
    for (int o = 1; o < 64; o <<= 1) v += __shfl_xor(v, o);
    return v;
}

__device__ __forceinline__ void conv_item(const float* W, int ldw, int k0, int scol, bf16* dst, int ldd, const float* kscale, LAS float* scr, int lane) {
    float v[32];
    const float* wp = W + (size_t)(k0 + (lane >> 5)) * ldw + scol + (lane & 31);
#pragma unroll
    for (int i = 0; i < 32; ++i) v[i] = wp[(size_t)(2 * i) * ldw];
    if (kscale) {
#pragma unroll
        for (int i = 0; i < 32; ++i) v[i] *= kscale[k0 + 2 * i + (lane >> 5)]; }
#pragma unroll
    for (int i = 0; i < 32; ++i) scr[(2 * i + (lane >> 5)) * 33 + (lane & 31)] = v[i];
    LDS_WAIT(); asm volatile("" ::: "memory");
    const int c = lane & 7;
#pragma unroll
    for (int j = 0; j < 4; ++j) { const int n = (lane >> 3) + 8 * j; const LAS float* s = scr + (8 * c) * 33 + n;
        u32x4 o; o.x = pg::cvt_pk_bf16(s[0 * 33], s[1 * 33]); o.y = pg::cvt_pk_bf16(s[2 * 33], s[3 * 33]); o.z = pg::cvt_pk_bf16(s[4 * 33], s[5 * 33]); o.w = pg::cvt_pk_bf16(s[6 * 33], s[7 * 33]);
        *(GAS u32x4*)(dst + (size_t)n * ldd + k0 + 8 * c) = o; }
    LDS_WAIT(); asm volatile("" ::: "memory");
}
__device__ __forceinline__ int inproj_src_col(int cp) { return cp < 1536 ? cp : (cp < 2048 ? cp + (OU - 1536) : (cp < 3072 ? cp + (OGA - 2048) : cp + (OGS - 3072))); }
__device__ __forceinline__ int inproj_dst_row(int cp) { const int t = cp & ~255, c = cp & 255, wc = c >> 6, bj = (c >> 5) & 1, j = c & 31; return t + 128 * bj + 32 * wc + j; }

__device__ __forceinline__ void p0_prologue(Frame& F, const Args& a) {
    unsigned char* ws = a.ws;
    LAS float* scr = (LAS float*)(F.lds + F.wave * 8704);
    LAS float* wf = (LAS float*)(F.lds + 73728);
    const int gw = F.vcu * NWAVES + F.wave, NGW = F.G * NWAVES;
    const float* w_in = a.in[2]; const int sub = a.sub;
    for (int i = F.tid; i < 8 * 1024; i += NWAVES * 64) { const int h = i >> 10, k = i & 1023; wf[i] = w_in[(size_t)k * DIN + OF + h]; }
    constexpr int I_IN = 16 * 128, I_GLU = 8 * 16, I_PA = 8 * 32, I_OUT = 16 * 32;
    constexpr int NITEMS = I_IN + I_GLU + 2 * I_PA + I_OUT;
    for (int it = (sub & 1) ? gw : NITEMS; it < NITEMS; it += NGW) {
        int r = it;
        if (r < I_IN) { const int kb = r >> 7, nb = r & 127, cp = nb * 32; conv_item(w_in, DIN, kb * 64, inproj_src_col(cp), (bf16*)(ws + WS_WIN) + (size_t)inproj_dst_row(cp) * D, D, nullptr, scr, F.lane); continue; } r -= I_IN;
        if (r < I_GLU) { const int kb = r >> 4, nb = r & 15; conv_item(a.in[14], DS, kb * 64, nb * 32, (bf16*)(ws + WS_WGLU) + (size_t)(nb * 32) * DS, DS, nullptr, scr, F.lane); continue; } r -= I_GLU;
        if (r < I_PA) { const int kb = r >> 5, nb = r & 31; conv_item(a.in[15], D, kb * 64, nb * 32, (bf16*)(ws + WS_WPA) + (size_t)(nb * 32) * DA, DA, nullptr, scr, F.lane); continue; } r -= I_PA;
        if (r < I_PA) { const int kb = r >> 5, nb = r & 31; conv_item(a.in[16], D, kb * 64, nb * 32, (bf16*)(ws + WS_WPS) + (size_t)(nb * 32) * DS, DS, nullptr, scr, F.lane); continue; } r -= I_PA;
        { const int kb = r >> 5, nb = r & 31; conv_item(a.in[17], D, kb * 64, nb * 32, (bf16*)(ws + WS_WOUT) + (size_t)(nb * 32) * D, D, nullptr, scr, F.lane); }
    }
    if (blockIdx.x < 48) {
        const int r = blockIdx.x; const float* gf = a.in[18]; const float* wrg = a.in[19]; const float* wre = a.in[21]; bf16* WR = (bf16*)(ws + WS_WR) + (size_t)r * D;
        for (int k = F.tid; k < D; k += NWAVES * 64) { const float w = r < 4 ? wrg[k * 4 + r] : (r < 36 ? wre[k * NE + r - 4] : 0.f); WR[k] = f2bf(w * gf[k]); }
    }
    __syncthreads();
    const float* x = a.in[0]; const float* g = a.in[1]; const float* bfg = a.in[3];
    bf16* XN = (bf16*)(ws + WS_XN); float* LOGF = (float*)(ws + WS_CUM);
    { int m = (sub & 2) ? gw : T; f32x4 v[4];
      if (m < T) { const GAS f32x4* xr = (const GAS f32x4*)(x + (size_t)m * D) + F.lane;
#pragma unroll
          for (int j = 0; j < 4; ++j) v[j] = xr[64 * j]; }
      while (m < T) {
        const int mn = m + NGW; f32x4 vn[4];
        if (mn < T) { const GAS f32x4* xr = (const GAS f32x4*)(x + (size_t)mn * D) + F.lane;
#pragma unroll
            for (int j = 0; j < 4; ++j) vn[j] = xr[64 * j]; }
        float s = 0.f;
#pragma unroll
        for (int j = 0; j < 4; ++j) s += (v[j].x * v[j].x + v[j].y * v[j].y) + (v[j].z * v[j].z + v[j].w * v[j].w);
        const float rstd = rsqrtf(wave_sum(s) * (1.f / D) + EPS);
        float f[8];
#pragma unroll
        for (int h = 0; h < 8; ++h) f[h] = 0.f;
        GAS u32x2* o8 = (GAS u32x2*)(XN + (size_t)m * D) + F.lane;
#pragma unroll
        for (int j = 0; j < 4; ++j) { const f32x4 gg = *((const GAS f32x4*)g + 64 * j + F.lane); const f32x4 xn = v[j] * rstd * gg;
            u32x2 w; w.x = pg::cvt_pk_bf16(xn.x, xn.y); w.y = pg::cvt_pk_bf16(xn.z, xn.w); o8[64 * j] = w;
#pragma unroll
            for (int h = 0; h < 8; ++h) { const f32x4 ww = *((const LAS f32x4*)(wf + h * 1024) + 64 * j + F.lane); f[h] += (xn.x * ww.x + xn.y * ww.y) + (xn.z * ww.z + xn.w * ww.w); } }
#pragma unroll
        for (int h = 0; h < 8; ++h) f[h] = wave_sum(f[h]);
        float fs = f[0];
#pragma unroll
        for (int h = 1; h < 8; ++h) fs = (F.lane == h) ? f[h] : fs;
        if (F.lane < 8) { const int b = m / SEQ, sidx = m % SEQ; LOGF[((size_t)b * NH + F.lane) * SEQ + sidx] = log_sigmoid(fs + bfg[F.lane]); }
#pragma unroll
        for (int j = 0; j < 4; ++j) v[j] = vn[j];
        m = mn;
      } }
    if ((sub & 4) && F.G == 256) {
        __syncthreads();
        const int g = F.vcu >> 3, q = F.vcu & 7;
        LAS f32x2* PW = (LAS f32x2*)(F.lds);
        LAS f32x2* BB = (LAS f32x2*)(F.lds + 16896);
        LAS f32x2* CT = (LAS f32x2*)(F.lds + 16896 + 8192);
        LAS float* KT = (LAS float*)(F.lds + 16896 + 16384);
        const float* A_re = a.in[6]; const float* A_im = a.in[7]; const float* log_dt = a.in[8]; const float* B_re = a.in[9]; const float* B_im = a.in[10]; const float* C_re = a.in[11]; const float* C_im = a.in[12];
        if (F.tid < NP) { const int p = F.tid;
            const double dt = exp((double)log_dt[g]), ar = A_re[g * NP + p], ai = A_im[g * NP + p];
            const double er = exp(ar * dt), abr = er * cos(ai * dt), abi = er * sin(ai * dt);
            const double nr = abr - 1.0, ni = abi, den = ar * ar + ai * ai, fr_ = (nr * ar + ni * ai) / den, fi_ = (ni * ar - nr * ai) / den;
            double pr = 1.0, pi = 0.0;
            for (int tau = 0; tau <= LCH; ++tau) { PW[tau * NP + p] = (f32x2){(float)pr, (float)pi}; const double t2 = pr * abr - pi * abi; pi = pr * abi + pi * abr; pr = t2; }
            if (q == 0) { ((float*)(ws + WS_AL))[(g * NP + p) * 2] = PW[LCH * NP + p].x; ((float*)(ws + WS_AL))[(g * NP + p) * 2 + 1] = PW[LCH * NP + p].y; }
            for (int c = 0; c < GC; ++c) { const double br = B_re[(g * NP + p) * GC + c], bi = B_im[(g * NP + p) * GC + c]; BB[p * GC + c] = (f32x2){(float)(fr_ * br - fi_ * bi), (float)(fr_ * bi + fi_ * br)}; } }
        for (int i = F.tid; i < GC * NP; i += NWAVES * 64) { const int c = i >> 6, p = i & 63; CT[p * GC + c] = (f32x2){C_re[g * GC * NP + i], C_im[g * GC * NP + i]}; }
        __syncthreads();
        for (int i = F.tid; i < (4 * q + 4) * GC * GC; i += NWAVES * 64) { const int tau = i >> 8, co = (i >> 4) & 15, ci = i & 15; float acc = 0.f;
#pragma unroll 4
            for (int p = 0; p < NP; ++p) { const f32x2 w = PW[tau * NP + p], b = BB[p * GC + ci], c = CT[p * GC + co]; const float wr_ = w.x * b.x - w.y * b.y, wi_ = w.x * b.y + w.y * b.x; acc += c.x * wr_ - c.y * wi_; }
            KT[i] = acc; }
        __syncthreads();
        {
          const int n = 64 * q + (F.tid >> 3), part = F.tid & 7, j = n >> 4, co = n & 15; bf16* row = (bf16*)(ws + WS_BTY) + ((size_t)g * 512 + n) * U2P;
          auto bval = [&](int k) -> float { float x;
              if (k < 128) { const int p = k & 63; const f32x2 w = PW[(j + 1) * NP + p], c = CT[p * GC + co]; x = k < 64 ? (c.x * w.x - c.y * w.y) : -(c.x * w.y + c.y * w.x); }
              else { const int sidx = (k - 128) >> 4, ci = (k - 128) & 15; x = sidx <= j ? KT[((j - sidx) * GC + co) * GC + ci] : 0.f; }
              return x; };
#pragma unroll 1
          for (int it = 0; it < U2P / 64; ++it) { const int k = (it * 8 + part) * 8;
              u32x4 o; o.x = pg::cvt_pk_bf16(bval(k), bval(k + 1)); o.y = pg::cvt_pk_bf16(bval(k + 2), bval(k + 3)); o.z = pg::cvt_pk_bf16(bval(k + 4), bval(k + 5)); o.w = pg::cvt_pk_bf16(bval(k + 6), bval(k + 7)); *(GAS u32x4*)(row + k) = o; } }
        {
          const int n = 32 * q + (F.tid >> 4), part = F.tid & 15; bf16* row = (bf16*)(ws + WS_M1T) + ((size_t)g * 256 + n) * 512;
          auto mval = [&](int k) -> float { const int j = k >> 4, ci = k & 15; float x = 0.f;
              if (n < 128) { const int p = n & 63; const f32x2 w = PW[(LCH - 1 - j) * NP + p], b = BB[p * GC + ci]; x = n < 64 ? (w.x * b.x - w.y * b.y) : (w.x * b.y + w.y * b.x); }
              return x; };
#pragma unroll 1
          for (int it = 0; it < 4; ++it) { const int k = (it * 16 + part) * 8;
              u32x4 o; o.x = pg::cvt_pk_bf16(mval(k), mval(k + 1)); o.y = pg::cvt_pk_bf16(mval(k + 2), mval(k + 3)); o.z = pg::cvt_pk_bf16(mval(k + 4), mval(k + 5)); o.w = pg::cvt_pk_bf16(mval(k + 6), mval(k + 7)); *(GAS u32x4*)(row + k) = o; } }
    }
}

__device__ __forceinline__ void p1_cumsum(Frame& F, float* CUM) {
    LAS double* part = (LAS double*)(F.lds);
    float* p = CUM + (size_t)blockIdx.x * SEQ + F.tid * 16;
    f32x4 v[4]; float run[16]; float a = 0.f;
#pragma unroll
    for (int j = 0; j < 4; ++j) v[j] = ((const GAS f32x4*)p)[j];
#pragma unroll
    for (int j = 0; j < 4; ++j) { a += v[j].x; run[4 * j] = a; a += v[j].y; run[4 * j + 1] = a; a += v[j].z; run[4 * j + 2] = a; a += v[j].w; run[4 * j + 3] = a; }
    part[F.tid] = (double)a;
    __syncthreads();
    if (F.tid < 64) { double loc[8]; double s = 0.0;
#pragma unroll
        for (int i = 0; i < 8; ++i) { loc[i] = s; s += part[F.tid * 8 + i]; }
        double incl = s;
#pragma unroll
        for (int o = 1; o < 64; o <<= 1) { const double t = __shfl_up(incl, o); if (F.lane >= o) incl += t; }
        const double excl = incl - s;
#pragma unroll
        for (int i = 0; i < 8; ++i) part[F.tid * 8 + i] = excl + loc[i]; }
    __syncthreads();
    const double base = part[F.tid];
#pragma unroll
    for (int j = 0; j < 4; ++j) { f32x4 o; o.x = (float)((base + (double)run[4 * j]) * 1.4426950408889634); o.y = (float)((base + (double)run[4 * j + 1]) * 1.4426950408889634);
        o.z = (float)((base + (double)run[4 * j + 2]) * 1.4426950408889634); o.w = (float)((base + (double)run[4 * j + 3]) * 1.4426950408889634); ((GAS f32x4*)p)[j] = o; }
    __syncthreads();
}
struct PhInProj {
    static constexpr bool GATHER = false;
    unsigned lda, ldb; const char* A; const char* B; pg::StaticOrder so;
    bf16 *Q, *K, *V, *U2X, *GA, *GS; const float *gq, *gk;
    __device__ __forceinline__ bool next(int i, pg::Unit& u) const { int pm, pn; if (!so.next(i, pm, pn)) return false; u.A = A + (size_t)pm * 256 * lda; u.B = B + (size_t)pn * 256 * ldb; u.nt = D / 64; u.pm = pm; u.pn = pn; u.aux = 0; return true; }
    __device__ __forceinline__ void offs(const pg::Unit&, const int (&R)[2], const int (&C)[2], unsigned (&vo)[2][2]) const { pg::offs_plain(lda, R, C, vo); }
    __device__ __forceinline__ void epi(const f32x4 (&acc)[2][2][4][2], const pg::Unit& u, int wr, int wc, int fr, int fq) const {
        const int pn = u.pn, row0 = u.pm * 256 + wr * 64 + fr;
        if (pn < 4) {
            const bool isq = pn < 2; const float* g = isq ? gq : gk; bf16* O = isq ? Q : K; const int cb = (pn & 1) * 256 + 64 * wc + 8 * fq; const float sc = isq ? C2 : 1.f;
            f32x4 gv[2][2];
#pragma unroll
            for (int bj = 0; bj < 2; ++bj)
#pragma unroll
                for (int n = 0; n < 2; ++n) gv[bj][n] = *(const f32x4*)(g + 32 * bj + 8 * fq + 4 * n) * sc;
#pragma unroll
            for (int ai = 0; ai < 2; ++ai)
#pragma unroll
                for (int m = 0; m < 4; ++m) { float ss = 0.f;
#pragma unroll
                    for (int bj = 0; bj < 2; ++bj)
#pragma unroll
                        for (int n = 0; n < 2; ++n) { const f32x4 v = acc[ai][bj][m][n]; ss += (v[0] * v[0] + v[1] * v[1]) + (v[2] * v[2] + v[3] * v[3]); }
                    ss += __shfl_xor(ss, 16); ss += __shfl_xor(ss, 32);
                    const float rstd = rsqrtf(ss * (1.f / 64.f) + EPS);
                    bf16* rowp = O + (size_t)(row0 + ai * 128 + m * 16) * DA + cb;
#pragma unroll
                    for (int bj = 0; bj < 2; ++bj) *(u32x4*)(rowp + 32 * bj) = pg::pack8(acc[ai][bj][m][0] * rstd * gv[bj][0], acc[ai][bj][m][1] * rstd * gv[bj][1]); }
        } else if (pn < 6) {
            const int cb = (pn - 4) * 256 + 64 * wc + 8 * fq;
#pragma unroll
            for (int ai = 0; ai < 2; ++ai)
#pragma unroll
                for (int m = 0; m < 4; ++m) { bf16* rowp = V + (size_t)(row0 + ai * 128 + m * 16) * DA + cb;
#pragma unroll
                    for (int bj = 0; bj < 2; ++bj) *(u32x4*)(rowp + 32 * bj) = pg::pack8(acc[ai][bj][m][0], acc[ai][bj][m][1]); }
        } else if (pn < 8) {
#pragma unroll
            for (int ai = 0; ai < 2; ++ai)
#pragma unroll
                for (int m = 0; m < 4; ++m) { const int row = row0 + ai * 128 + m * 16;
#pragma unroll
                    for (int bj = 0; bj < 2; ++bj) { const int cu = (pn - 6) * 256 + 64 * wc + 32 * bj + 8 * fq;
                        *(u32x4*)(U2X + u2x_index(cu >> 4, row, cu & 15)) = pg::pack8(acc[ai][bj][m][0], acc[ai][bj][m][1]); } }
        } else {
            bf16* G = pn < 12 ? GA : GS; const int cb = ((pn - 8) & 3) * 256 + 64 * wc + 8 * fq;
#pragma unroll
            for (int ai = 0; ai < 2; ++ai)
#pragma unroll
                for (int m = 0; m < 4; ++m) { bf16* rowp = G + (size_t)(row0 + ai * 128 + m * 16) * D + cb;
#pragma unroll
                    for (int bj = 0; bj < 2; ++bj) { f32x4 a = acc[ai][bj][m][0], b = acc[ai][bj][m][1];
#pragma unroll
                        for (int e = 0; e < 4; ++e) { a[e] = pg::fsigmoid(a[e]); b[e] = pg::fsigmoid(b[e]); }
                        *(u32x4*)(rowp + 32 * bj) = pg::pack8(a, b); } }
        }
    }
};

struct PhGlu {
    static constexpr bool GATHER = false;
    unsigned lda, ldb; const char* A; const char* B; pg::StaticOrder so; const bf16* Y1; bf16* YS;
    __device__ __forceinline__ bool next(int i, pg::Unit& u) const { int pm, pn; if (!so.next(i, pm, pn)) return false; u.A = A + (size_t)pm * 256 * lda; u.B = B + (size_t)pn * 256 * ldb; u.nt = DS / 64; u.pm = pm; u.pn = pn; u.aux = 0; return true; }
    __device__ __forceinline__ void offs(const pg::Unit&, const int (&R)[2], const int (&C)[2], unsigned (&vo)[2][2]) const { pg::offs_plain(lda, R, C, vo); }
    __device__ __forceinline__ void epi(const f32x4 (&acc)[2][2][4][2], const pg::Unit& u, int wr, int wc, int fr, int fq) const {
        const int row0 = u.pm * 256 + wr * 64 + fr, cb = u.pn * 256 + 32 * wc + 8 * fq;
#pragma unroll
        for (int ai = 0; ai < 2; ++ai)
#pragma unroll
            for (int m = 0; m < 4; ++m) { const size_t ro = (size_t)(row0 + ai * 128 + m * 16) * DS + cb;
#pragma unroll
                for (int bj = 0; bj < 2; ++bj) { const u32x4 yv = *(const u32x4*)(Y1 + ro + 128 * bj); f32x4 y0, y1; pg::unpack8(yv, y0, y1);
                    f32x4 a = acc[ai][bj][m][0], b = acc[ai][bj][m][1];
#pragma unroll
                    for (int e = 0; e < 4; ++e) { a[e] = y0[e] * pg::fsigmoid(a[e]); b[e] = y1[e] * pg::fsigmoid(b[e]); }
                    *(u32x4*)(YS + ro + 128 * bj) = pg::pack8(a, b); } }
    }
};
struct PhProj {
    static constexpr bool GATHER = false;
    unsigned lda, ldb; const char* O; const char* YSp; const char* WPA; const char* WPS; pg::StaticOrder so; bf16* GA; const bf16* GS;
    __device__ __forceinline__ bool next(int i, pg::Unit& u) const { int pm, pn; if (!so.next(i >> 1, pm, pn)) return false; const int sub = i & 1;
        u.A = (sub ? YSp : O) + (size_t)pm * 256 * lda; u.B = (sub ? WPS : WPA) + (size_t)pn * 256 * ldb; u.nt = DA / 64; u.pm = pm; u.pn = pn; u.aux = sub; return true; }
    __device__ __forceinline__ void offs(const pg::Unit&, const int (&R)[2], const int (&C)[2], unsigned (&vo)[2][2]) const { pg::offs_plain(lda, R, C, vo); }
    __device__ __forceinline__ void epi(const f32x4 (&acc)[2][2][4][2], const pg::Unit& u, int wr, int wc, int fr, int fq) const {
        const int row0 = u.pm * 256 + wr * 64 + fr, cb = u.pn * 256 + 32 * wc + 8 * fq; const bool sub = u.aux != 0;
#pragma unroll
        for (int ai = 0; ai < 2; ++ai)
#pragma unroll
            for (int m = 0; m < 4; ++m) { const size_t ro = (size_t)(row0 + ai * 128 + m * 16) * D + cb;
#pragma unroll
                for (int bj = 0; bj < 2; ++bj) { const u32x4 gv = *(const u32x4*)(GA + ro + 128 * bj); f32x4 g0, g1; pg::unpack8(gv, g0, g1);
                    f32x4 a = acc[ai][bj][m][0], b = acc[ai][bj][m][1];
                    if (!sub) { a = a * g0; b = b * g1; }
                    else { const u32x4 sv = *(const u32x4*)(GS + ro + 128 * bj); f32x4 s0, s1; pg::unpack8(sv, s0, s1); a = g0 + s0 * a; b = g1 + s1 * b; }
                    *(u32x4*)(GA + ro + 128 * bj) = pg::pack8(a, b); } }
    }
};
struct PhWout {
    static constexpr bool GATHER = false;
    unsigned lda, ldb; const char* A; const char* B; pg::StaticOrder so; const float* x; float* out; bf16* X2B; float* SSP;
    __device__ __forceinline__ bool next(int i, pg::Unit& u) const { int pm, pn; if (!so.next(i, pm, pn)) return false; u.A = A + (size_t)pm * 256 * lda; u.B = B + (size_t)pn * 256 * ldb; u.nt = D / 64; u.pm = pm; u.pn = pn; u.aux = 0; return true; }
    __device__ __forceinline__ void offs(const pg::Unit&, const int (&R)[2], const int (&C)[2], unsigned (&vo)[2][2]) const { pg::offs_plain(lda, R, C, vo); }
    __device__ __forceinline__ void epi(const f32x4 (&acc)[2][2][4][2], const pg::Unit& u, int wr, int wc, int fr, int fq) const {
        const int row0 = u.pm * 256 + wr * 64 + fr, cb = u.pn * 256 + 32 * wc + 8 * fq;
#pragma unroll
        for (int ai = 0; ai < 2; ++ai)
#pragma unroll
            for (int m = 0; m < 4; ++m) { const int row = row0 + ai * 128 + m * 16; const size_t ro = (size_t)row * D + cb; float ss = 0.f;
#pragma unroll
                for (int bj = 0; bj < 2; ++bj) { const f32x4 x0 = *(const f32x4*)(x + ro + 128 * bj), x1 = *(const f32x4*)(x + ro + 128 * bj + 4);
                    const f32x4 a = acc[ai][bj][m][0] + x0, b = acc[ai][bj][m][1] + x1;
                    *(f32x4*)(out + ro + 128 * bj) = a; *(f32x4*)(out + ro + 128 * bj + 4) = b; *(u32x4*)(X2B + ro + 128 * bj) = pg::pack8(a, b);
                    ss += (a[0] * a[0] + a[1] * a[1]) + (a[2] * a[2] + a[3] * a[3]) + (b[0] * b[0] + b[1] * b[1]) + (b[2] * b[2] + b[3] * b[3]); }
                ss += __shfl_xor(ss, 16); ss += __shfl_xor(ss, 32);
                if (fq == 0) SSP[(size_t)row * 16 + u.pn * 4 + wc] = ss;
                asm volatile("" ::: "memory"); }
    }
};

__device__ __forceinline__ void p2_expert_weights(Frame& F, const Args& a) {
    unsigned char* ws = a.ws; LAS float* scr = (LAS float*)(F.lds + F.wave * 8704);
    const int gw = F.vcu * NWAVES + F.wave, NGW = F.G * NWAVES;
    const float* gf = a.in[18]; const float* wg = a.in[23]; const float* wu = a.in[24]; const float* wd = a.in[25];
    constexpr int I_G = 16 * 8, I_D = 4 * 32;
    constexpr int NITEMS = NE * (2 * I_G + I_D);
    for (int it = (a.sub & 4) ? gw : NITEMS; it < NITEMS; it += NGW) {
        const int e = it / (2 * I_G + I_D); int r = it % (2 * I_G + I_D);
        if (r < 2 * I_G) { const int up = r >= I_G; if (up) r -= I_G; const int kb = r >> 3, nb = r & 7, n0 = nb * 32;
            conv_item((up ? wu : wg) + (size_t)e * D * DE, DE, kb * 64, n0, (bf16*)(ws + WS_WGU) + ((size_t)e * 512 + 256 * (n0 >> 7) + 128 * up + (n0 & 127)) * D, D, gf, scr, F.lane); }
        else { r -= 2 * I_G; const int kb = r >> 5, nb = r & 31; conv_item(wd + (size_t)e * DE * D, D, kb * 64, nb * 32, (bf16*)(ws + WS_WD) + ((size_t)e * D + nb * 32) * DE, DE, nullptr, scr, F.lane); }
    }
}
__device__ __forceinline__ void p8_router(Frame& F, const Args& a) {
    unsigned char* ws = a.ws;
    constexpr int WPITCH = 2064;
    LAS unsigned char* wl = F.lds;
    LAS float* lg = (LAS float*)(F.lds + 48 * WPITCH) + F.wave * 16 * 48;
    { const GAS u32x4* src = (const GAS u32x4*)(ws + WS_WR);
      for (int i = F.tid; i < 48 * 128; i += NWAVES * 64) { const int r = i >> 7, c = i & 127; *(LAS u32x4*)(wl + r * WPITCH + c * 16) = src[i]; } }
    __syncthreads();
    const bf16* X2B = (const bf16*)(ws + WS_X2B); const float* SSP = (const float*)(ws + WS_SSP);
    const float* b_rg = a.in[20]; const float* b_re = a.in[22];
    float* RSTD = (float*)(ws + WS_RSTD); int* ROUTE = (int*)(ws + WS_ROUTE); int* CNT = (int*)(ws + WS_CTL) + CW_CNT; int* LIST = (int*)(ws + WS_LIST); float* WPOS = (float*)(ws + WS_WPOS); float* RPOS = (float*)(ws + WS_RPOS);
    const int fr = F.lane & 15, fq = F.lane >> 4;
    LAS int* lcnt = (LAS int*)(F.lds + 48 * WPITCH + NWAVES * 16 * 48 * 4);
    LAS int* lbase = lcnt + 32;
    for (int t0 = F.vcu * 64; t0 < T; t0 += F.G * 64) {
        if (F.tid < 32) lcnt[F.tid] = 0;
        __syncthreads();
        int e0 = 0, e1 = 0, lr0 = 0, lr1 = 0; float w0 = 0.f, w1 = 0.f, rstd = 0.f;
        if (F.wave < 4) {
            const int tok = t0 + F.wave * 16 + fr;
            const GAS bf16x8* xa = (const GAS bf16x8*)(X2B + (size_t)tok * D + 8 * fq);
            f32x4 acc[3]; acc[0] = acc[1] = acc[2] = (f32x4){0.f, 0.f, 0.f, 0.f};
            bf16x8 xf[32];
#pragma unroll
            for (int ks = 0; ks < 32; ++ks) xf[ks] = xa[ks * 4];
#pragma unroll
            for (int ks = 0; ks < 32; ++ks) {
#pragma unroll
                for (int n = 0; n < 3; ++n) { const bf16x8 wfr = *(const LAS bf16x8*)(wl + (n * 16 + fr) * WPITCH + ks * 64 + fq * 16);
                    acc[n] = __builtin_amdgcn_mfma_f32_16x16x32_bf16(wfr, xf[ks], acc[n], 0, 0, 0); } }
#pragma unroll
            for (int n = 0; n < 3; ++n) *(LAS f32x4*)(lg + fr * 48 + n * 16 + 4 * fq) = acc[n];
            LDS_WAIT(); asm volatile("" ::: "memory");
            if (F.lane < 16) {
                const int t = t0 + F.wave * 16 + F.lane; const LAS float* l = lg + F.lane * 48;
                float ss = 0.f; { const f32x4* sp = (const f32x4*)(SSP + (size_t)t * 16);
#pragma unroll
                    for (int i = 0; i < 4; ++i) { const f32x4 v = sp[i]; ss += (v[0] + v[1]) + (v[2] + v[3]); } }
                rstd = rsqrtf(ss * (1.f / D) + EPS);
                float gl[4]; int gs = 0;
#pragma unroll
                for (int i = 0; i < 4; ++i) gl[i] = l[i] * rstd + b_rg[i];
                float gm = gl[0];
#pragma unroll
                for (int i = 1; i < 4; ++i) if (gl[i] > gm) { gm = gl[i]; gs = i; }
                float gsum = 0.f;
#pragma unroll
                for (int i = 0; i < 4; ++i) gsum += __expf(gl[i] - gm);
                const float gtop = 1.f / gsum;
                float el[8];
#pragma unroll
                for (int i = 0; i < 8; ++i) el[i] = l[4 + gs * 8 + i] * rstd + b_re[gs * 8 + i];
                int i0 = 0; float m0 = el[0];
#pragma unroll
                for (int i = 1; i < 8; ++i) if (el[i] > m0) { m0 = el[i]; i0 = i; }
                int i1 = -1; float m1 = -3.0e38f;
#pragma unroll
                for (int i = 0; i < 8; ++i) if (i != i0 && el[i] > m1) { m1 = el[i]; i1 = i; }
                const float p1 = __expf(m1 - m0); w0 = gtop / (1.f + p1); w1 = gtop * p1 / (1.f + p1);
                e0 = gs * 8 + i0; e1 = gs * 8 + i1;
                lr0 = __hip_atomic_fetch_add(&lcnt[e0], 1, __ATOMIC_RELAXED, __HIP_MEMORY_SCOPE_WORKGROUP); lr1 = __hip_atomic_fetch_add(&lcnt[e1], 1, __ATOMIC_RELAXED, __HIP_MEMORY_SCOPE_WORKGROUP);
            }
        }
        __syncthreads();
        if (F.tid < 32) { const int c = lcnt[F.tid]; lbase[F.tid] = c ? atomicAdd(&CNT[F.tid], c) : 0; }
        __syncthreads();
        if (F.wave < 4 && F.lane < 16) {
            const int t = t0 + F.wave * 16 + F.lane; const int r0 = lbase[e0] + lr0, r1 = lbase[e1] + lr1;
            RSTD[t] = rstd; *(int4*)(ROUTE + t * 4) = make_int4(e0, e1, r0, r1);
            LIST[e0 * T + r0] = t; LIST[e1 * T + r1] = t; WPOS[e0 * T + r0] = w0; WPOS[e1 * T + r1] = w1; RPOS[e0 * T + r0] = rstd; RPOS[e1 * T + r1] = rstd;
        }
        __syncthreads();
    }
}
__device__ __forceinline__ void moe_table(Frame& F, const int* CNT, LAS int* tb) {
    if (F.tid < 64) { const int e = F.lane; int c = 0; if (e < NE) c = (int)__hip_atomic_load((const unsigned*)CNT + e, __ATOMIC_RELAXED, __HIP_MEMORY_SCOPE_AGENT);
        const int tl = (c + 255) >> 8; int incl = tl;
#pragma unroll
        for (int o = 1; o < 32; o <<= 1) { const int v = __shfl_up(incl, o); if (e >= o) incl += v; }
        if (e < NE) { tb[e] = incl - tl; tb[64 + e] = c; } if (e == NE - 1) tb[32] = incl; }
    __syncthreads();
}
__device__ __forceinline__ int moe_find(const LAS int* tb, int mt) { int e = 0;
#pragma unroll 1
    for (int i = 1; i < NE; ++i) if (mt >= tb[i]) e = i; return e; }
struct PhMoeGU {
    static constexpr bool GATHER = true;
    unsigned lda, ldb; const char* X; const char* W; const LAS int* tb; const int* LIST; const float* RPOS; bf16* H; int G, c;
    __device__ __forceinline__ bool next(int i, pg::Unit& u) const { const int L = i * G + c; if (L >= 2 * tb[32]) return false; const int mt = L >> 1, n2 = L & 1, e = moe_find(tb, mt);
        u.A = X; u.B = W + ((size_t)e * 512 + n2 * 256) * ldb; u.nt = D / 64; u.pm = mt; u.pn = n2; u.aux = e; return true; }
    __device__ __forceinline__ void offs(const pg::Unit& u, const int (&R)[2], const int (&C)[2], unsigned (&vo)[2][2]) const {
        const int e = u.aux, cnt = tb[64 + e], r0 = (u.pm - tb[e]) * 256; const int* lp = LIST + (size_t)e * T;
#pragma unroll
        for (int h = 0; h < 2; ++h)
#pragma unroll
            for (int i = 0; i < 2; ++i) { int r = r0 + h * 128 + R[i]; r = r < cnt ? r : cnt - 1; vo[h][i] = (unsigned)lp[r] * lda + (unsigned)C[i] * 2u; }
    }
    __device__ __forceinline__ void epi(const f32x4 (&acc)[2][2][4][2], const pg::Unit& u, int wr, int wc, int fr, int fq) const {
        const int e = u.aux, r0 = (u.pm - tb[e]) * 256; const float* rp = RPOS + (size_t)e * T + r0;
#pragma unroll
        for (int ai = 0; ai < 2; ++ai)
#pragma unroll
            for (int m = 0; m < 4; ++m) { const int tr = ai * 128 + wr * 64 + m * 16 + fr; const float rs = rp[tr];
                f32x4 g0 = acc[ai][0][m][0] * rs, g1 = acc[ai][0][m][1] * rs; const f32x4 u0 = acc[ai][1][m][0] * rs, u1 = acc[ai][1][m][1] * rs;
#pragma unroll
                for (int q = 0; q < 4; ++q) { g0[q] = g0[q] * pg::fsigmoid(g0[q]) * u0[q]; g1[q] = g1[q] * pg::fsigmoid(g1[q]) * u1[q]; }
                *(u32x4*)(H + ((size_t)u.pm * 256 + tr) * DE + u.pn * 128 + 32 * wc + 8 * fq) = pg::pack8(g0, g1); }
    }
};
struct PhMoeDown {
    static constexpr bool GATHER = false;
    unsigned lda, ldb; const char* Hp; const char* W; const LAS int* tb; const float* WPOS; bf16* Y; int G, c;
    __device__ __forceinline__ bool next(int i, pg::Unit& u) const { const int L = i * G + c; if (L >= 4 * tb[32]) return false; const int mt = L >> 2, n4 = L & 3, e = moe_find(tb, mt);
        u.A = Hp + (size_t)mt * 256 * lda; u.B = W + ((size_t)e * D + n4 * 256) * ldb; u.nt = DE / 64; u.pm = mt; u.pn = n4; u.aux = e; return true; }
    __device__ __forceinline__ void offs(const pg::Unit&, const int (&R)[2], const int (&C)[2], unsigned (&vo)[2][2]) const { pg::offs_plain(lda, R, C, vo); }
    __device__ __forceinline__ void epi(const f32x4 (&acc)[2][2][4][2], const pg::Unit& u, int wr, int wc, int fr, int fq) const {
        const int e = u.aux, r0 = (u.pm - tb[e]) * 256; const float* wp = WPOS + (size_t)e * T + r0;
#pragma unroll
        for (int ai = 0; ai < 2; ++ai)
#pragma unroll
            for (int m = 0; m < 4; ++m) { const int tr = ai * 128 + wr * 64 + m * 16 + fr; const float w = wp[tr]; bf16* yp = Y + ((size_t)u.pm * 256 + tr) * D + u.pn * 256 + 32 * wc + 8 * fq;
#pragma unroll
                for (int bj = 0; bj < 2; ++bj) *(u32x4*)(yp + 128 * bj) = pg::pack8(acc[ai][bj][m][0] * w, acc[ai][bj][m][1] * w); }
    }
};
__device__ __forceinline__ void p11_combine(Frame& F, const Args& a, const LAS int* tb) {
    unsigned char* ws = a.ws; const int* ROUTE = (const int*)(ws + WS_ROUTE); const bf16* Y = (const bf16*)(ws + WS_Y); float* out = a.out;
    for (int t = F.vcu * NWAVES + F.wave; t < T; t += F.G * NWAVES) {
        const int4 rt = *(const int4*)(ROUTE + t * 4);
        const GAS u32x2* y0 = (const GAS u32x2*)(Y + ((size_t)tb[rt.x] * 256 + rt.z) * D) + F.lane; const GAS u32x2* y1 = (const GAS u32x2*)(Y + ((size_t)tb[rt.y] * 256 + rt.w) * D) + F.lane;
        GAS f32x4* o = (GAS f32x4*)(out + (size_t)t * D) + F.lane;
#pragma unroll
        for (int j = 0; j < 4; ++j) { const u32x2 a0 = y0[64 * j], a1 = y1[64 * j]; f32x4 v = o[64 * j];
            v[0] += __builtin_bit_cast(float, a0.x << 16) + __builtin_bit_cast(float, a1.x << 16); v[1] += __builtin_bit_cast(float, a0.x & 0xffff0000u) + __builtin_bit_cast(float, a1.x & 0xffff0000u);
            v[2] += __builtin_bit_cast(float, a0.y << 16) + __builtin_bit_cast(float, a1.y << 16); v[3] += __builtin_bit_cast(float, a0.y & 0xffff0000u) + __builtin_bit_cast(float, a1.y & 0xffff0000u);
            o[64 * j] = v; }
    }
}

struct PhSsmX {
    static constexpr bool GATHER = false;
    unsigned lda, ldb; const char* U2X; const char* M1T; float* SLOC; int g, b;
    __device__ __forceinline__ bool next(int i, pg::Unit& u) const { if (i >= 1) return false; u.A = U2X + ((size_t)(g * NCR + b * 256) * U2P + 128) * 2; u.B = M1T + (size_t)g * 256 * ldb; u.nt = 8; u.pm = b; u.pn = 0; u.aux = 0; return true; }
    __device__ __forceinline__ void offs(const pg::Unit&, const int (&R)[2], const int (&C)[2], unsigned (&vo)[2][2]) const { pg::offs_plain(lda, R, C, vo); }
    __device__ __forceinline__ void epi(const f32x4 (&acc)[2][2][4][2], const pg::Unit& u, int wr, int wc, int fr, int fq) const {
#pragma unroll
        for (int ai = 0; ai < 2; ++ai)
#pragma unroll
            for (int m = 0; m < 4; ++m) { float* p = SLOC + ((size_t)g * NCR + u.pm * 256 + ai * 128 + wr * 64 + m * 16 + fr) * 128 + 32 * wc + 8 * fq;
                *(f32x4*)p = acc[ai][0][m][0]; *(f32x4*)(p + 4) = acc[ai][0][m][1]; }
    }
};
__device__ __forceinline__ void ssm_scan(Frame& F, unsigned char* ws, int g, int b) {
    LAS f32x2* ends = (LAS f32x2*)F.lds;
    const int p = F.lane, w = F.wave;
    const float alr = ((const float*)(ws + WS_AL))[(g * NP + p) * 2], ali = ((const float*)(ws + WS_AL))[(g * NP + p) * 2 + 1];
    const float* sl = (const float*)(ws + WS_SLOC) + ((size_t)g * NCR + b * 256 + w * 32) * 128;
    float lr[32], li[32];
#pragma unroll
    for (int k = 0; k < 32; ++k) { lr[k] = sl[k * 128 + p]; li[k] = sl[k * 128 + 64 + p]; }
#pragma unroll
    for (int k = 1; k < 32; ++k) { const float nr = alr * lr[k - 1] - ali * li[k - 1] + lr[k], ni = alr * li[k - 1] + ali * lr[k - 1] + li[k]; lr[k] = nr; li[k] = ni; }
    ends[w * 64 + p] = (f32x2){lr[31], li[31]};
    float sr = alr, si = ali;
#pragma unroll
    for (int k = 0; k < 5; ++k) { const float t = sr * sr - si * si; si = 2.f * sr * si; sr = t; }
    __syncthreads();
    float cr = 0.f, ci = 0.f;
    for (int s2 = 0; s2 < w; ++s2) { const f32x2 e = ends[s2 * 64 + p]; const float t = sr * cr - si * ci + e.x; ci = sr * ci + si * cr + e.y; cr = t; }
    bf16* hp = (bf16*)(ws + WS_U2X) + ((size_t)g * NCR + b * 256 + w * 32) * U2P;
    float pr = cr, pi = ci;
#pragma unroll
    for (int k = 0; k < 32; ++k) { const float hr = (k ? lr[k - 1] : 0.f) + pr, hi = (k ? li[k - 1] : 0.f) + pi;
        hp[(size_t)k * U2P + p] = f2bf(hr); hp[(size_t)k * U2P + 64 + p] = f2bf(hi);
        const float t = alr * pr - ali * pi; pi = alr * pi + ali * pr; pr = t; }
    __syncthreads();
}
struct PhSsmY {
    static constexpr bool GATHER = false;
    unsigned lda, ldb; const char* U2Xp; const char* BTY; const bf16* U2X; const float* Dsk; bf16* Y1; int G, c;
    __device__ __forceinline__ bool next(int i, pg::Unit& u) const { const int L = i * G + c; if (L >= NG * 4) return false; const int g = L >> 2, mt = (L >> 1) & 1, nb = L & 1;
        u.A = U2Xp + (size_t)(g * NCR + mt * 256) * lda; u.B = BTY + (size_t)(g * 512 + nb * 256) * ldb; u.nt = nb ? 10 : 6; u.pm = mt; u.pn = nb; u.aux = g; return true; }
    __device__ __forceinline__ void offs(const pg::Unit&, const int (&R)[2], const int (&C)[2], unsigned (&vo)[2][2]) const { pg::offs_plain(lda, R, C, vo); }
    __device__ __forceinline__ void epi(const f32x4 (&acc)[2][2][4][2], const pg::Unit& u, int wr, int wc, int fr, int fq) const {
        const int g = u.aux;
#pragma unroll
        for (int bj = 0; bj < 2; ++bj) { const int n = u.pn * 256 + 128 * bj + 32 * wc + 8 * fq, j = n >> 4, c0 = n & 15;
            const f32x4 d0 = *(const f32x4*)(Dsk + g * GC + c0), d1 = *(const f32x4*)(Dsk + g * GC + c0 + 4);
#pragma unroll
            for (int ai = 0; ai < 2; ++ai)
#pragma unroll
                for (int m = 0; m < 4; ++m) { const int cr = u.pm * 256 + ai * 128 + wr * 64 + m * 16 + fr;
                    const u32x4 uv = *(const u32x4*)(U2X + ((size_t)g * NCR + cr) * U2P + 128 + j * GC + c0); f32x4 u0, u1; pg::unpack8(uv, u0, u1);
                    f32x4 a = acc[ai][bj][m][0] + d0 * u0, b = acc[ai][bj][m][1] + d1 * u1;
#pragma unroll
                    for (int q = 0; q < 4; ++q) { a[q] = gelu_fast(a[q]); b[q] = gelu_fast(b[q]); }
                    *(u32x4*)(Y1 + ((size_t)cr * LCH + j) * DS + g * GC + c0) = pg::pack8(a, b); } }
    }
};

__global__ void __launch_bounds__(NWAVES * 64, 2) mk_fwd(Args args) {
    extern __shared__ __attribute__((aligned(16))) unsigned char lds[];
    Frame F;
    F.lds = (LAS unsigned char*)lds; F.MISC = (volatile LAS unsigned*)(F.lds + MISC_OFF);
    F.tid = threadIdx.x; F.lane = F.tid & 63; F.wave = __builtin_amdgcn_readfirstlane(F.tid >> 6);
    F.G = gridDim.x; { const int bx = blockIdx.x; F.vcu = (F.G % 8 == 0) ? (bx % 8) * (F.G / 8) + bx / 8 : bx; }
    unsigned char* ws = args.ws; F.ctl = (gu32*)(ws + WS_CTL);
    for (int u = F.tid; u < (LDS_BYTES - LDSCTL_OFF) / 4; u += NWAVES * 64) ((LAS unsigned*)(F.lds + LDSCTL_OFF))[u] = 0u;
    __syncthreads();
    const int lo = args.ph_lo, hi = args.ph_hi;
    const bool multi = (hi - lo) > 1;
    XcdBarrier bar; bar.bar = (unsigned*)(F.ctl + CW_BAR); bar.x = 0; bar.st = nullptr;
    if (multi) bar = xcd_barrier_post((unsigned*)(F.ctl + CW_BAR), F.MISC + 8);
#define IN(k) (lo <= (k) && (k) < hi)
#define SEAM(k) do { if (IN(k) && IN((k) + 1)) xcd_barrier(bar); } while (0)
    if (IN(0)) { p0_prologue(F, args); SEAM(0); }
    if (IN(1)) {
        if (blockIdx.x < NBATCH * NH) p1_cumsum(F, (float*)(ws + WS_CUM));
        PhInProj ph; ph.lda = D * 2; ph.ldb = D * 2; ph.A = (const char*)(ws + WS_XN); ph.B = (const char*)(ws + WS_WIN); ph.so.init(T / 256, 4096 / 256, F.G, (int)blockIdx.x);
        ph.Q = (bf16*)(ws + WS_Q); ph.K = (bf16*)(ws + WS_K); ph.V = (bf16*)(ws + WS_V); ph.U2X = (bf16*)(ws + WS_U2X); ph.GA = (bf16*)(ws + WS_GA); ph.GS = (bf16*)(ws + WS_GS);
        ph.gq = args.in[4]; ph.gk = args.in[5];
        pg::gemm_phase(F.lds + RING_OFF, ph);
        SEAM(1);
    }
    if (IN(2)) {
        if (blockIdx.x < 2 * NG) {
            const int g = (int)blockIdx.x >> 1, b = (int)blockIdx.x & 1;
            PhSsmX ph; ph.lda = U2P * 2; ph.ldb = 512 * 2; ph.U2X = (const char*)(ws + WS_U2X); ph.M1T = (const char*)(ws + WS_M1T); ph.SLOC = (float*)(ws + WS_SLOC); ph.g = g; ph.b = b;
            if (args.sub & 1) pg::gemm_phase(F.lds + RING_OFF, ph);
            if (args.sub & 2) ssm_scan(F, ws, g, b);
            __syncthreads();
        }
        p2_expert_weights(F, args); SEAM(2);
    }
    if (IN(3)) {
        static_assert(attn_body::ATTN_LDS_BYTES <= RING_BYTES, "attention LDS");
        const attn_body::AttnTensors AT{(const attn_body::bf16*)(ws + WS_Q), (const attn_body::bf16*)(ws + WS_K), (const attn_body::bf16*)(ws + WS_V), (attn_body::bf16*)(ws + WS_Q), (const float*)(ws + WS_CUM)};
        const attn_body::StaticOrder S(F.vcu);
        attn_body::attn_phase<attn_body::StaticOrder>((char*)lds + RING_OFF, AT, S);
        SEAM(3);
    }
    if (IN(4)) {
        PhSsmY ph; ph.lda = U2P * 2; ph.ldb = U2P * 2; ph.U2Xp = (const char*)(ws + WS_U2X); ph.BTY = (const char*)(ws + WS_BTY); ph.U2X = (const bf16*)(ws + WS_U2X); ph.Dsk = args.in[13]; ph.Y1 = (bf16*)(ws + WS_Y1); ph.G = F.G; ph.c = F.vcu;
        pg::gemm_phase(F.lds + RING_OFF, ph);
        SEAM(4);
    }
    if (IN(5)) {
        PhGlu ph; ph.lda = DS * 2; ph.ldb = DS * 2; ph.A = (const char*)(ws + WS_Y1); ph.B = (const char*)(ws + WS_WGLU); ph.so.init(T / 256, DS / 256, F.G, (int)blockIdx.x); ph.Y1 = (const bf16*)(ws + WS_Y1); ph.YS = (bf16*)(ws + WS_YS);
        pg::gemm_phase(F.lds + RING_OFF, ph);
        SEAM(5);
    }
    if (IN(6)) {
        PhProj ph; ph.lda = DA * 2; ph.ldb = DA * 2; ph.O = (const char*)(ws + WS_Q); ph.YSp = (const char*)(ws + WS_YS); ph.WPA = (const char*)(ws + WS_WPA); ph.WPS = (const char*)(ws + WS_WPS);
        ph.so.init(T / 256, D / 256, F.G, (int)blockIdx.x); ph.GA = (bf16*)(ws + WS_GA); ph.GS = (const bf16*)(ws + WS_GS);
        pg::gemm_phase(F.lds + RING_OFF, ph);
        SEAM(6);
    }
    if (IN(7)) {
        PhWout ph; ph.lda = D * 2; ph.ldb = D * 2; ph.A = (const char*)(ws + WS_GA); ph.B = (const char*)(ws + WS_WOUT); ph.so.init(T / 256, D / 256, F.G, (int)blockIdx.x);
        ph.x = args.in[0]; ph.out = args.out; ph.X2B = (bf16*)(ws + WS_X2B); ph.SSP = (float*)(ws + WS_SSP);
        pg::gemm_phase(F.lds + RING_OFF, ph);
        SEAM(7);
    }
    if (IN(8)) { p8_router(F, args); SEAM(8); }
    LAS int* tb = (LAS int*)(F.lds + LDSCTL_OFF + 512);
    if (IN(9)) {
        moe_table(F, (const int*)(ws + WS_CTL) + CW_CNT, tb);
        PhMoeGU ph; ph.lda = D * 2; ph.ldb = D * 2; ph.X = (const char*)(ws + WS_X2B); ph.W = (const char*)(ws + WS_WGU); ph.tb = tb; ph.LIST = (const int*)(ws + WS_LIST); ph.RPOS = (const float*)(ws + WS_RPOS);
        ph.H = (bf16*)(ws + WS_H); ph.G = F.G; ph.c = F.vcu;
        pg::gemm_phase(F.lds + RING_OFF, ph);
        SEAM(9);
    }
    if (IN(10)) {
        if (!IN(9)) moe_table(F, (const int*)(ws + WS_CTL) + CW_CNT, tb);
        PhMoeDown ph; ph.lda = DE * 2; ph.ldb = DE * 2; ph.Hp = (const char*)(ws + WS_H); ph.W = (const char*)(ws + WS_WD); ph.tb = tb; ph.WPOS = (const float*)(ws + WS_WPOS); ph.Y = (bf16*)(ws + WS_Y); ph.G = F.G; ph.c = F.vcu;
        pg::gemm_phase(F.lds + RING_OFF, ph);
        SEAM(10);
    }
    if (IN(11)) {
        if (!IN(10)) moe_table(F, (const int*)(ws + WS_CTL) + CW_CNT, tb);
        p11_combine(F, args, tb);
    }
#undef IN
#undef SEAM
}

extern "C" void kernel_launch(void* const* d_in, const int* in_sizes, int n_in, void* d_out, int out_size, void* d_ws, size_t ws_size, hipStream_t stream) {
    static int grid = 0;
    if (grid == 0) {
        int dev = 0, cus = 0; (void)hipGetDevice(&dev); (void)hipDeviceGetAttribute(&cus, hipDeviceAttributeMultiprocessorCount, dev);
        (void)hipFuncSetAttribute((const void*)mk_fwd, hipFuncAttributeMaxDynamicSharedMemorySize, LDS_BYTES);
        grid = cus > 0 ? cus : 256;
    }
    (void)hipMemsetAsync((char*)d_ws + WS_CTL, 0, CTL_ZERO_BYTES, stream);
    Args a{}; for (int i = 0; i < 26; ++i) a.in[i] = (const float*)d_in[i]; a.out = (float*)d_out; a.ws = (unsigned char*)d_ws;
    a.ph_lo = 0; a.ph_hi = 12; a.sub = 7;
    hipLaunchKernelGGL(mk_fwd, dim3(grid), dim3(NWAVES * 64), LDS_BYTES, stream, a);
}
```

```cpp
#include <hip/hip_runtime.h>
#include <stdint.h>
#include <math.h>

typedef unsigned short bf16;
constexpr int T = 16384, D = 1024, SEQ = 8192, NBATCH = 2, NH = 8, HD = 64, DA = 512, DS = 512, NG = 32, GC = 16, NP = 64, NE = 32, DE = 256;
constexpr int DIN = 4104, OQ = 0, OK_ = 512, OV = 1024, OF = 1536, OU = 1544, OGA = 2056, OGS = 3080;
constexpr int LCH = 32, NCR = T / LCH;
constexpr int U2P = 640;
constexpr float EPS = 1e-6f;
constexpr float C2 = 0.125f * 1.4426950408889634f;
constexpr float LOG2E = 1.4426950408889634f;
constexpr int YROWS = 40960;

constexpr size_t MiB = 1u << 20;
constexpr size_t WS_CTL = 0, CTL_ZERO_BYTES = 1 * MiB;
constexpr size_t WS_CUM = 1 * MiB;
constexpr size_t WS_AL = 1 * MiB + 512 * 1024;
constexpr size_t WS_RSTD = 2 * MiB;
constexpr size_t WS_ROUTE = 2 * MiB + 256 * 1024;
constexpr size_t WS_LIST = 3 * MiB;
constexpr size_t WS_WPOS = 5 * MiB;
constexpr size_t WS_SSP = 7 * MiB;
constexpr size_t WS_WIN = 8 * MiB;
constexpr size_t WS_SLOC = 229 * MiB;
constexpr size_t WS_WGLU = 16 * MiB, WS_WPA = 16 * MiB + 512 * 1024, WS_WPS = 17 * MiB + 512 * 1024, WS_WOUT = 18 * MiB + 512 * 1024, WS_WR = 20 * MiB + 512 * 1024;
constexpr size_t WS_M1T = 21 * MiB;
constexpr size_t WS_BTY = 29 * MiB;
constexpr size_t WS_XN = 49 * MiB;
constexpr size_t WS_WGU = 49 * MiB;
constexpr size_t WS_Q = 81 * MiB;
constexpr size_t WS_K = 97 * MiB;
constexpr size_t WS_V = 113 * MiB;
constexpr size_t WS_Y1 = 97 * MiB, WS_YS = 113 * MiB;
constexpr size_t WS_U2X = 129 * MiB;
constexpr size_t WS_GA = 149 * MiB;
constexpr size_t WS_GS = 181 * MiB;
constexpr size_t WS_X2B = 181 * MiB;
constexpr size_t WS_WD = 213 * MiB;
constexpr size_t WS_H = 229 * MiB;
constexpr size_t WS_RPOS = 249 * MiB;
constexpr size_t WS_Y = 81 * MiB;
static_assert(WS_H + (size_t)YROWS * DE * 2 <= WS_RPOS && WS_RPOS + 2 * MiB <= 256 * MiB && WS_Y + (size_t)YROWS * D * 2 <= WS_GS, "d_ws map");

__device__ __forceinline__ bf16 f2bf(float f) { unsigned u = __builtin_bit_cast(unsigned, f); return (bf16)((u + 0x7fffu + ((u >> 16) & 1u)) >> 16); }
__device__ __forceinline__ float bf2f(bf16 b) { return __builtin_bit_cast(float, (unsigned)b << 16); }
__device__ __forceinline__ float sigmoidf_(float x) { return 1.f / (1.f + __expf(-x)); }
__device__ __forceinline__ float gelu_tanh(float x) { const float z = 0.7978845608028654f * (x + 0.044715f * x * x * x); const float e = __expf(2.f * z); return 0.5f * x * (1.f + (1.f - 2.f / (e + 1.f))); }
__device__ __forceinline__ float log_sigmoid(float x) { return -(fmaxf(-x, 0.f) + log1pf(__expf(-fabsf(x)))); }
__device__ __forceinline__ size_t u2x_index(int g, int t, int c) { return ((size_t)g * NCR + (t / LCH)) * U2P + 128 + (t % LCH) * GC + c; }

#define LAS __attribute__((address_space(3)))
#define GAS __attribute__((address_space(1)))
typedef short bf16x8 __attribute__((ext_vector_type(8)));
typedef float f32x4 __attribute__((ext_vector_type(4)));
typedef float f32x2 __attribute__((ext_vector_type(2)));
typedef unsigned u32x4 __attribute__((ext_vector_type(4)));
typedef unsigned u32x2 __attribute__((ext_vector_type(2)));
namespace pg {
constexpr int BM = 256, BK = 64, HALF = 128, HTB = HALF * BK * 2, STAGE_BYTES = 8 * HTB, NXCD = 8, WGM = 8;
__host__ __device__ __forceinline__ int lds_byte(int r, int c) { const int st = (r >> 4) * 2 + (c >> 5), rr = r & 15, cc = c & 31, ob = rr * 64 + cc * 2; return st * 1024 + (ob ^ (((ob >> 9) & 1) << 5)); }
__host__ __device__ __forceinline__ void stage_rc(int b, int& R, int& C) { const int st = b / 1024, sb = b % 1024, swz = sb ^ (((sb >> 9) & 1) << 5); R = (st >> 1) * 16 + swz / 64; C = (st & 1) * 32 + (swz % 64) / 2; }
__host__ __device__ __forceinline__ int perm32(int rho) { const int n = rho >> 4, i = rho & 15; return 8 * (i >> 2) + 4 * n + (i & 3); }
typedef __bf16 bf16x2_t __attribute__((ext_vector_type(2)));
__device__ __forceinline__ unsigned cvt_pk_bf16(float lo, float hi) { const f32x2 v = {lo, hi}; const bf16x2_t b = __builtin_convertvector(v, bf16x2_t); return __builtin_bit_cast(unsigned, b); }
__device__ __forceinline__ u32x4 pack8(const f32x4& a, const f32x4& b) { u32x4 w; w.x = cvt_pk_bf16(a[0], a[1]); w.y = cvt_pk_bf16(a[2], a[3]); w.z = cvt_pk_bf16(b[0], b[1]); w.w = cvt_pk_bf16(b[2], b[3]); return w; }
__device__ __forceinline__ void unpack8(const u32x4& w, f32x4& a, f32x4& b) {
    a[0] = __builtin_bit_cast(float, w.x << 16); a[1] = __builtin_bit_cast(float, w.x & 0xffff0000u); a[2] = __builtin_bit_cast(float, w.y << 16); a[3] = __builtin_bit_cast(float, w.y & 0xffff0000u);
    b[0] = __builtin_bit_cast(float, w.z << 16); b[1] = __builtin_bit_cast(float, w.z & 0xffff0000u); b[2] = __builtin_bit_cast(float, w.w << 16); b[3] = __builtin_bit_cast(float, w.w & 0xffff0000u); }
__device__ __forceinline__ float fsigmoid(float x) { return __builtin_amdgcn_rcpf(1.f + __builtin_amdgcn_exp2f(-1.4426950408889634f * x)); }

struct Unit { const char* A; const char* B; int nt; int pm, pn, aux; };

struct StaticOrder {
    int nM, nN, nwg, G, c;
    __device__ void init(int nM_, int nN_, int G_, int c_) { nM = nM_; nN = nN_; nwg = nM * nN; G = G_; c = c_; }
    __device__ bool next(int i, int& pm, int& pn) const {
        const long L = (long)i * G + c; if (L >= nwg) return false;
        int wgid = (int)L; { const int q = nwg / NXCD, r = nwg % NXCD, xcd = wgid % NXCD, off = wgid / NXCD; wgid = (xcd < r ? xcd * (q + 1) : r * (q + 1) + (xcd - r) * q) + off; }
        const int nig = WGM * nN, gid = wgid / nig, fm = gid * WGM, gsz = (nM - fm) < WGM ? (nM - fm) : WGM;
        pm = fm + ((wgid % nig) % gsz); pn = (wgid % nig) / gsz; return true;
    }
};

template <class P>
__device__ __forceinline__ void gemm_phase(LAS unsigned char* lds, P& ph) {
    const int tid = threadIdx.x, wid = __builtin_amdgcn_readfirstlane(tid >> 6), lane = tid & 63, wr = wid >> 2, wc = wid & 3, fr = lane & 15, fq = lane >> 4;
    const unsigned lda = ph.lda, ldb = ph.ldb;
    int Rr[2], Cc[2]; unsigned voffB[2], vo[2][2], nvo[2][2];
#pragma unroll
    for (int i = 0; i < 2; ++i) { stage_rc(tid * 16 + i * 8192, Rr[i], Cc[i]); const int Rb = (Rr[i] & ~31) + perm32(Rr[i] & 31); voffB[i] = (unsigned)Rb * ldb + (unsigned)Cc[i] * 2u; }
    const size_t kstep = (size_t)(BK * 2);
    const size_t hstepB = (size_t)HALF * ldb;
    const unsigned ldsw = (unsigned)wid * 1024u;
    const int aoff = lds_byte(wr * 64 + fr, fq * 8), boff = lds_byte(wc * 32 + fr, fq * 8);
#define PG_SA(b, h) (((b) * 2 + (h)) * HTB)
#define PG_SB(b, h) ((4 + (b) * 2 + (h)) * HTB)
#define PG_STAGE_B(bufoff, gbase) do { _Pragma("unroll") for (int _i = 0; _i < 2; ++_i) \
        __builtin_amdgcn_global_load_lds((const unsigned*)((const char*)(gbase) + voffB[_i]), (LAS unsigned*)(lds + (bufoff) + ldsw + _i * 8192), 16, 0, 0); } while (0)
#define PG_STAGE_A(bufoff, gbase, VO, h) do { _Pragma("unroll") for (int _i = 0; _i < 2; ++_i) \
        __builtin_amdgcn_global_load_lds((const unsigned*)((const char*)(gbase) + (VO)[h][_i]), (LAS unsigned*)(lds + (bufoff) + ldsw + _i * 8192), 16, 0, 0); } while (0)
#define PG_LDA(dst, b, h) do { _Pragma("unroll") for (int m = 0; m < 4; ++m) _Pragma("unroll") for (int k = 0; k < 2; ++k) dst[m][k] = *(const LAS bf16x8*)(lds + PG_SA(b, h) + aoff + m * 2048 + k * 1024); } while (0)
#define PG_LDB(dst, b, h) do { _Pragma("unroll") for (int n = 0; n < 2; ++n) _Pragma("unroll") for (int k = 0; k < 2; ++k) dst[n][k] = *(const LAS bf16x8*)(lds + PG_SB(b, h) + boff + n * 2048 + k * 1024); } while (0)
#define PG_MMA(ai, bj, At, Bt) do { __builtin_amdgcn_s_setprio(1); _Pragma("unroll") for (int m = 0; m < 4; ++m) _Pragma("unroll") for (int n = 0; n < 2; ++n) _Pragma("unroll") for (int k = 0; k < 2; ++k) \
        acc[ai][bj][m][n] = __builtin_amdgcn_mfma_f32_16x16x32_bf16(Bt[n][k], At[m][k], acc[ai][bj][m][n], 0, 0, 0); __builtin_amdgcn_s_setprio(0); } while (0)
#define PG_WAIT_V(n) asm volatile("s_waitcnt vmcnt(" #n ")" ::: "memory")
#define PG_WAIT_L(n) asm volatile("s_waitcnt lgkmcnt(" #n ")" ::: "memory")
#define PG_BAR __builtin_amdgcn_s_barrier()
#define PG_SCHED __builtin_amdgcn_sched_barrier(0)
    Unit cur, nxt; int ui = 0;
    if (!ph.next(0, cur)) return;
    ph.offs(cur, Rr, Cc, vo);
    f32x4 acc[2][2][4][2];
#pragma unroll
    for (int a = 0; a < 2; ++a)
#pragma unroll
        for (int b = 0; b < 2; ++b)
#pragma unroll
            for (int m = 0; m < 4; ++m)
#pragma unroll
                for (int n = 0; n < 2; ++n) acc[a][b][m][n] = (f32x4){0.f, 0.f, 0.f, 0.f};
    bf16x8 At[4][2], B0[2][2], B1[2][2];
    const char* cA = cur.A; const char* cB = cur.B;
    PG_STAGE_B(PG_SB(0, 0), cB); PG_STAGE_B(PG_SB(0, 1), cB + hstepB); PG_STAGE_A(PG_SA(0, 0), cA, vo, 0); PG_STAGE_A(PG_SA(0, 1), cA, vo, 1);
    if (wr == 1) PG_BAR;
    PG_WAIT_V(2); PG_BAR;
    PG_STAGE_B(PG_SB(1, 0), cB + kstep); PG_STAGE_A(PG_SA(1, 0), cA + kstep, vo, 0); PG_STAGE_B(PG_SB(1, 1), cB + hstepB + kstep);
    PG_WAIT_V(6); PG_BAR;
    for (;;) {
        const bool has_next = ph.next(ui + 1, nxt);
        const int nt = cur.nt;
        const char* nA = has_next ? nxt.A : cA; const char* nB = has_next ? nxt.B : cB;
        if (P::GATHER) { if (has_next) ph.offs(nxt, Rr, Cc, nvo); else {
#pragma unroll
            for (int h = 0; h < 2; ++h)
#pragma unroll
                for (int i = 0; i < 2; ++i) nvo[h][i] = vo[h][i]; } }
#pragma unroll 1
        for (int t = 0; t < nt; t += 2) {
            const bool last = (t == nt - 2);
            const char* a1 = cA + (size_t)(t + 1) * kstep;
            const char* a2 = last ? nA : cA + (size_t)(t + 2) * kstep; const char* b2 = last ? nB : cB + (size_t)(t + 2) * kstep;
            const char* a3 = a2 + kstep; const char* b3 = b2 + kstep;
            unsigned v2[2][2];
#pragma unroll
            for (int h = 0; h < 2; ++h)
#pragma unroll
                for (int i = 0; i < 2; ++i) v2[h][i] = (P::GATHER && last) ? nvo[h][i] : vo[h][i];
            PG_LDB(B0, 0, 0); PG_LDB(B1, 0, 1); PG_SCHED; PG_LDA(At, 0, 0); PG_STAGE_A(PG_SA(1, 1), a1, vo, 1);
            PG_WAIT_V(8); PG_WAIT_L(0); PG_BAR; PG_MMA(0, 0, At, B0); PG_MMA(0, 1, At, B1); PG_BAR; PG_SCHED;
            PG_LDA(At, 0, 1); PG_STAGE_B(PG_SB(0, 0), b2); PG_STAGE_B(PG_SB(0, 1), b2 + hstepB); PG_STAGE_A(PG_SA(0, 0), a2, v2, 0);
            PG_WAIT_V(8); PG_WAIT_L(0); PG_BAR; PG_MMA(1, 0, At, B0); PG_MMA(1, 1, At, B1); PG_BAR; PG_SCHED;
            PG_LDB(B0, 1, 0); PG_LDB(B1, 1, 1); PG_SCHED; PG_LDA(At, 1, 0); PG_STAGE_A(PG_SA(0, 1), a2, v2, 1);
            PG_WAIT_V(8); PG_WAIT_L(0); PG_BAR; PG_MMA(0, 0, At, B0); PG_MMA(0, 1, At, B1); PG_BAR; PG_SCHED;
            PG_LDA(At, 1, 1); PG_STAGE_B(PG_SB(1, 0), b3); PG_STAGE_B(PG_SB(1, 1), b3 + hstepB); PG_STAGE_A(PG_SA(1, 0), a3, v2, 0);
            PG_WAIT_V(8); PG_WAIT_L(0); PG_BAR; PG_MMA(1, 0, At, B0); PG_MMA(1, 1, At, B1); PG_BAR; PG_SCHED;
        }
        if (wr == 0) PG_BAR;
        ph.epi(acc, cur, wr, wc, fr, fq);
        if (!has_next) break;
#pragma unroll
        for (int a = 0; a < 2; ++a)
#pragma unroll
            for (int b = 0; b < 2; ++b)
#pragma unroll
                for (int m = 0; m < 4; ++m)
#pragma unroll
                    for (int n = 0; n < 2; ++n) acc[a][b][m][n] = (f32x4){0.f, 0.f, 0.f, 0.f};
        cur = nxt; cA = nA; cB = nB; ++ui;
        if (P::GATHER) {
#pragma unroll
            for (int h = 0; h < 2; ++h)
#pragma unroll
                for (int i = 0; i < 2; ++i) vo[h][i] = nvo[h][i]; }
        if (wr == 1) PG_BAR;
    }
    PG_WAIT_V(0);
    PG_BAR;
#undef PG_SA
#undef PG_SB
#undef PG_STAGE_A
#undef PG_STAGE_B
#undef PG_LDA
#undef PG_LDB
#undef PG_MMA
#undef PG_WAIT_V
#undef PG_WAIT_L
#undef PG_BAR
#undef PG_SCHED
}
__device__ __forceinline__ void offs_plain(unsigned lda, const int (&R)[2], const int (&C)[2], unsigned (&vo)[2][2]) {
#pragma unroll
    for (int h = 0; h < 2; ++h)
#pragma unroll
        for (int i = 0; i < 2; ++i) vo[h][i] = (unsigned)(h * HALF + R[i]) * lda + (unsigned)C[i] * 2u;
}
}

namespace attn_body {
using bf16=unsigned short;
using bf16x8=__attribute__((ext_vector_type(8)))short;
using s16x4=__attribute__((ext_vector_type(4)))short;
using f32x16=__attribute__((ext_vector_type(16)))float;
using u32x4=__attribute__((ext_vector_type(4)))unsigned;
constexpr int BATCH=2,NHEAD=8,SEQ=8192,D=64,DM=NHEAD*D;
constexpr int NW=8,QBLK=32,QB=QBLK*NW,KVBLK=64,NQB=SEQ/QB;
constexpr int ATTN_PITCH=DM, ATTN_UNIT_ROWS=QB;
__device__ __forceinline__ int crow(int r,int hi){return (r&3)+8*(r>>2)+4*hi;}
__device__ __forceinline__ unsigned short f2bf_a(float f){unsigned u=__builtin_bit_cast(unsigned,f);return (unsigned short)((u+0x7fffu+((u>>16)&1u))>>16);}
#define SBAR() __builtin_amdgcn_sched_barrier(0)
__device__ __forceinline__ void cmask(f32x16&p0,f32x16&p1,int jb,int qrel,int hi){
  const float NEG=-INFINITY; int kb=64*jb+4*hi;
  #pragma unroll
  for(int r=0;r<16;++r){int kv=kb+(r&3)+8*(r>>2); if(kv>qrel)p0[r]=NEG; if(kv+32>qrel)p1[r]=NEG;}
}

constexpr int NSLOT=3, SLOTB=8192;
constexpr int LDS_K=0, LDS_V=NSLOT*SLOTB, LDS_WS=2*NSLOT*SLOTB, LDS_OST=LDS_WS+NW*64*4, LDS_FK=LDS_OST+NW*4096, LDS_BYTES=LDS_FK+SEQ*4+1024;
constexpr float C2=0.125f*1.4426950408889634f;
__device__ __forceinline__ void glds16(const void*gsrc,unsigned lds_dst){unsigned keep;
  asm volatile("s_mov_b32 %0, m0\n\ts_mov_b32 m0, %2\n\ts_nop 0\n\tglobal_load_lds_dwordx4 %1, off\n\ts_mov_b32 m0, %0":"=&s"(keep):"v"(gsrc),"s"(lds_dst):"memory");}
__device__ __forceinline__ float max3f(float a,float b,float c){float r;asm("v_max3_f32 %0, %1, %2, %3":"=v"(r):"v"(a),"v"(b),"v"(c));return r;}
__device__ __forceinline__ float max2f(float a,float b){float r;asm("v_max_f32_e32 %0, %1, %2":"=v"(r):"v"(a),"v"(b));return r;}
__device__ __forceinline__ float fadd_s(float a,float b){float r;asm("v_add_f32_e32 %0, %1, %2":"=v"(r):"v"(a),"v"(b));return r;}
__device__ __forceinline__ float fsub_s(float a,float b){float r;asm("v_sub_f32_e32 %0, %1, %2":"=v"(r):"v"(a),"v"(b));return r;}
typedef float f32x4_t __attribute__((ext_vector_type(4)));
typedef float f32x2_t __attribute__((ext_vector_type(2))); typedef __bf16 bf16x2_t __attribute__((ext_vector_type(2)));
__device__ __forceinline__ unsigned cvtpk_s(float lo,float hi){f32x2_t v={lo,hi};bf16x2_t b=__builtin_convertvector(v,bf16x2_t);return __builtin_bit_cast(unsigned,b);}
#define WAIT_BAR(N) asm volatile("s_waitcnt vmcnt(" #N ") lgkmcnt(0)\n\ts_barrier":::"memory")

__device__ __forceinline__ void qkt(f32x16&p0,f32x16&p1,const char*Kslot,const bf16x8*qr,int r32,int hi){
  const char*kb=Kslot+hi*1024+r32*16;
  #pragma unroll
  for(int d0=0;d0<4;++d0){
    const bf16x8 b0=*reinterpret_cast<const bf16x8*>(kb+d0*2048);
    const bf16x8 b1=*reinterpret_cast<const bf16x8*>(kb+d0*2048+512);
    p0=__builtin_amdgcn_mfma_f32_32x32x16_bf16(b0,qr[d0],p0,0,0,0);p1=__builtin_amdgcn_mfma_f32_32x32x16_bf16(b1,qr[d0],p1,0,0,0);}
}
typedef __attribute__((address_space(3))) const char* lds_cptr;
typedef short v4i16_t __attribute__((ext_vector_type(4)));
__device__ __forceinline__ void kload8(bf16x8*kf,lds_cptr kp){
  kf[0]=*(const __attribute__((address_space(3))) bf16x8*)(kp);      kf[1]=*(const __attribute__((address_space(3))) bf16x8*)(kp+512);
  kf[2]=*(const __attribute__((address_space(3))) bf16x8*)(kp+2048); kf[3]=*(const __attribute__((address_space(3))) bf16x8*)(kp+2560);
  kf[4]=*(const __attribute__((address_space(3))) bf16x8*)(kp+4096); kf[5]=*(const __attribute__((address_space(3))) bf16x8*)(kp+4608);
  kf[6]=*(const __attribute__((address_space(3))) bf16x8*)(kp+6144); kf[7]=*(const __attribute__((address_space(3))) bf16x8*)(kp+6656);
}
__device__ __forceinline__ void kload2(bf16x8*kf,lds_cptr kp,int j){ kf[2*j]=*(const __attribute__((address_space(3))) bf16x8*)(kp+j*2048); kf[2*j+1]=*(const __attribute__((address_space(3))) bf16x8*)(kp+j*2048+512); }
__device__ __forceinline__ s16x4 vtr(lds_cptr p){ return __builtin_bit_cast(s16x4,__builtin_amdgcn_ds_read_tr16_b64_v4i16((__attribute__((address_space(3))) v4i16_t*)p)); }
__device__ __forceinline__ float rowmax(const f32x16&p0,const f32x16&p1){
  float a=max3f(p0[0],p0[1],p1[0]),b=max3f(p0[2],p0[3],p1[1]);a=max3f(a,p1[2],p1[3]);
  #pragma unroll
  for(int r=4;r<16;r+=4){a=max3f(a,p0[r],p0[r+1]);b=max3f(b,p0[r+2],p0[r+3]);a=max3f(a,p1[r],p1[r+1]);b=max3f(b,p1[r+2],p1[r+3]);}
  const float m=max2f(a,b);
  auto rr=__builtin_amdgcn_permlane32_swap(__float_as_uint(m),__float_as_uint(m),false,false);
  return max2f(__uint_as_float(rr[0]),__uint_as_float(rr[1]));
}
__device__ __forceinline__ void pv(f32x16*o,int vb,bf16x8 pa0,bf16x8 pa1,bf16x8 pa2,bf16x8 pa3){
  #pragma unroll
  for(int d0=0;d0<2;++d0){s16x4 lo[4],hi[4];
    #pragma unroll
    for(int ks=0;ks<4;++ks){
      asm volatile("ds_read_b64_tr_b16 %0,%1 offset:%c2":"=&v"(lo[ks]):"v"(vb),"i"(d0*4096+ks*1024):"memory");
      asm volatile("ds_read_b64_tr_b16 %0,%1 offset:%c2":"=&v"(hi[ks]):"v"(vb),"i"(d0*4096+ks*1024+512):"memory");}
    asm volatile("s_waitcnt lgkmcnt(0)":::"memory");SBAR();
    #define PK(k) (bf16x8){lo[k][0],lo[k][1],lo[k][2],lo[k][3],hi[k][0],hi[k][1],hi[k][2],hi[k][3]}
    o[d0]=__builtin_amdgcn_mfma_f32_32x32x16_bf16(pa0,PK(0),o[d0],0,0,0);
    o[d0]=__builtin_amdgcn_mfma_f32_32x32x16_bf16(pa1,PK(1),o[d0],0,0,0);
    o[d0]=__builtin_amdgcn_mfma_f32_32x32x16_bf16(pa2,PK(2),o[d0],0,0,0);
    o[d0]=__builtin_amdgcn_mfma_f32_32x32x16_bf16(pa3,PK(3),o[d0],0,0,0);
    #undef PK
  }
}

#ifndef ATTN_STORE16
#define ATTN_STORE16(p,v) (*(u32x4*)(p)=(v))
#endif
template<int THRL> __device__ __forceinline__ void attn_unit(int b,int h,int qb,const bf16*Q,const bf16*__restrict__ K,const bf16*__restrict__ V,bf16*O,const float*__restrict__ CUM,char*shm){
  const int tid=threadIdx.x,lane=tid&63,r32=lane&31,hi=lane>>5; const int wid=__builtin_amdgcn_readfirstlane(tid>>6);
  const long rowbase=(long)b*SEQ; const int q0=qb*QB;
  const bf16*Qw=Q+(rowbase+q0+wid*QBLK)*DM+h*D;
  const bf16*Kh=K+rowbase*DM+h*D,*Vh=V+rowbase*DM+h*D; const float*Fh=CUM+((long)b*NHEAD+h)*SEQ;
  const unsigned lds0=(unsigned)(uintptr_t)shm;
  float*wsf=(float*)(shm+LDS_WS)+wid*64;
  const bf16*ksrc=Kh+(long)lane*DM+wid*8;
  const bf16*vsrc=Vh+(long)(16*(wid&3)+(lane>>2))*DM+(wid>>2)*32+(lane&3)*8;
  const unsigned kdst=lds0+LDS_K+wid*1024, vdst=lds0+LDS_V+wid*1024;
  #define DMA_K(t,slot) glds16(ksrc+(long)(t)*KVBLK*DM,(unsigned)__builtin_amdgcn_readfirstlane(kdst+(slot)))
  #define DMA_V(t,slot) glds16(vsrc+(long)(t)*KVBLK*DM,(unsigned)__builtin_amdgcn_readfirstlane(vdst+(slot)))
  const int vb0=(int)(lds0+LDS_V)+((lane>>4)&1)*32+(lane&3)*8+(4*hi+((lane&15)>>2))*64;
  const char*Kbase=shm+LDS_K; bf16x8 kf[8];
  const lds_cptr shm3=(lds_cptr)shm; const lds_cptr kp0=shm3+LDS_K+hi*1024+r32*16; const lds_cptr vp0=shm3+LDS_V+((lane>>4)&1)*32+(lane&3)*8+(4*hi+((lane&15)>>2))*64;
  const int NT=(q0+QB)/KVBLK;
  for(int p_=wid;p_<=qb;p_+=NW) glds16(Fh+p_*256+lane*4,(unsigned)__builtin_amdgcn_readfirstlane(lds0+LDS_FK+p_*1024));
  DMA_K(0,0);DMA_V(0,0);DMA_K(1,SLOTB);
  bf16x8 qr[4];
  #pragma unroll
  for(int d0=0;d0<4;++d0)qr[d0]=*reinterpret_cast<const bf16x8*>(&Qw[(long)r32*DM+d0*16+hi*8]);
  const float fq2=Fh[q0+wid*QBLK+r32];
  float mhat=0.f,l_reg=0.f;f32x16 o[2];o[0]=f32x16{};o[1]=f32x16{};float nb=fq2;
  const lds_cptr fkp=(lds_cptr)shm+LDS_FK+hi*16;
  const int qrel=wid*QBLK+r32;
  #define CMASK(P0,P1,t) do{int jb_=(t)-(NT-4); if(jb_>=0)cmask(P0,P1,jb_,qrel,hi);}while(0)
  bool resc=false;
  #define START(P0,P1) do{ const float rm=rowmax(P0,P1); resc=false; \
    { const float dl=rm; mhat=fadd_s(mhat,dl); \
      _Pragma("unroll") for(int r=0;r<16;++r){P0[r]=fsub_s(P0[r],dl);P1[r]=fsub_s(P1[r],dl);} \
      nb=fsub_s(fq2,mhat); } \
    _Pragma("unroll") for(int r=0;r<16;++r)P0[r]=__builtin_amdgcn_exp2f(P0[r]); }while(0)
  #define RESC() do{ if(resc){ asm volatile("s_waitcnt lgkmcnt(0)":::"memory"); \
      _Pragma("unroll") for(int d_=0;d_<2;++d_) _Pragma("unroll") for(int r=0;r<16;++r)o[d_][r]*=wsf[crow(r,hi)]; } }while(0)
  #define FILLC(C0_,C1_,tt) do{ const lds_cptr f_=fkp+(tt)*256; _Pragma("unroll") for(int a_=0;a_<4;++a_){ const f32x4_t x0_=*(const __attribute__((address_space(3))) f32x4_t*)(f_+32*a_); const f32x4_t x1_=*(const __attribute__((address_space(3))) f32x4_t*)(f_+128+32*a_); \
      _Pragma("unroll") for(int i_=0;i_<4;++i_){ C0_[4*a_+i_]=nb-x0_[i_]; C1_[4*a_+i_]=nb-x1_[i_]; } } }while(0)
  f32x16 pA0,pA1,pB0,pB1;
  int sl_prev=0,sl_cur=0,sl_next=SLOTB;
  #define ROT() do{sl_prev=sl_cur;sl_cur=sl_next;sl_next=(sl_next==(NSLOT-1)*SLOTB)?0:sl_next+SLOTB;}while(0)
  DMA_K(2,2*SLOTB);
  WAIT_BAR(3);
  FILLC(pA0,pA1,0);
  qkt(pA0,pA1,Kbase,qr,r32,hi);asm volatile("s_nop 15\n\ts_nop 7":"+v"(pA0),"+v"(pA1));CMASK(pA0,pA1,0);
  START(pA0,pA1);
  _Pragma("unroll") for(int r=0;r<16;++r)pA1[r]=__builtin_amdgcn_exp2f(pA1[r]);
  WAIT_BAR(0);
  DMA_K(3,0);DMA_V(1,SLOTB);
  ROT();
  FILLC(pB0,pB1,1);
  kload8(kf,kp0+sl_cur);
  WAIT_BAR(2);
  s16x4 vlo[8],vhi[8]; u32x4 pw0,pw1,pw2,pw3;
  #define PKW(P,B) cvtpk_s(P[B],P[B+1])
  #define PAF(k) __builtin_bit_cast(bf16x8,pw##k)
  #define VFR(i) (bf16x8){vlo[i][0],vlo[i][1],vlo[i][2],vlo[i][3],vhi[i][0],vhi[i][1],vhi[i][2],vhi[i][3]}
  #define PIN(x) asm volatile("":"+v"(x))
  #define MX3(a,b,c) __builtin_fmaxf(__builtin_fmaxf((a),(b)),(c))
  #define GAPA(MF,A0,A1,A2,A3,W0,W1,PW) do{ MF; sacc+=A0; sacc+=A1; sacc+=A2; sacc+=A3; PIN(sacc); W0; W1; PIN(PW); SBAR(); }while(0)
  #define EX(v) __builtin_amdgcn_exp2f(v)
  #define FLD(off) (*(const __attribute__((address_space(3))) f32x4_t*)(fk_+(off)))
  #define GAPB(MF,X,B,PF,FC,FN,NOFF) do{ MF; X[B]=EX(X[B]); X[B+1]=EX(X[B+1]); X[B+2]=EX(X[B+2]); X[B+3]=EX(X[B+3]); PF[B]=nb-FC[0]; PF[B+1]=nb-FC[1]; PF[B+2]=nb-FC[2]; PF[B+3]=nb-FC[3]; FN=FLD(NOFF); PIN(X); PIN(PF); SBAR(); }while(0)
  #define VRD(i) do{ vlo[i]=vtr(vp_+(((i)>>2)*4096+((i)&3)*1024)); vhi[i]=vtr(vp_+(((i)>>2)*4096+((i)&3)*1024+512)); }while(0)
  #define KRD(G,j) do{ if(G){ kload2(kf,kp0+sl_next,j); SBAR(); } }while(0)
  #define STEP(C0,C1,P0,P1,t,GK,GV,GL) do{ SBAR(); \
    const lds_cptr vp_=vp0+sl_prev; \
    VRD(0); SBAR(); float sacc=(P0[0]+P0[1]); \
    GAPA(C0=__builtin_amdgcn_mfma_f32_32x32x16_bf16(kf[0],qr[0],C0,0,0,0), P0[2],P0[3],P0[4],P0[5],     pw0[0]=PKW(P0,0), pw0[1]=PKW(P0,2), pw0); \
    VRD(4); SBAR(); GAPA(C1=__builtin_amdgcn_mfma_f32_32x32x16_bf16(kf[1],qr[0],C1,0,0,0), P0[6],P0[7],P0[8],P0[9],     pw0[2]=PKW(P0,4), pw0[3]=PKW(P0,6), pw0); \
    VRD(1); SBAR(); GAPA(C0=__builtin_amdgcn_mfma_f32_32x32x16_bf16(kf[2],qr[1],C0,0,0,0),   P0[10],P0[11],P0[12],P0[13], pw1[0]=PKW(P0,8), pw1[1]=PKW(P0,10), pw1); \
    VRD(5); SBAR(); GAPA(C1=__builtin_amdgcn_mfma_f32_32x32x16_bf16(kf[3],qr[1],C1,0,0,0),   P0[14],P0[15],P1[0],P1[1],   pw1[2]=PKW(P0,12),pw1[3]=PKW(P0,14), pw1); \
    VRD(2); SBAR(); GAPA(C0=__builtin_amdgcn_mfma_f32_32x32x16_bf16(kf[4],qr[2],C0,0,0,0),   P1[2],P1[3],P1[4],P1[5],     pw2[0]=PKW(P1,0), pw2[1]=PKW(P1,2), pw2); \
    VRD(6); SBAR(); GAPA(C1=__builtin_amdgcn_mfma_f32_32x32x16_bf16(kf[5],qr[2],C1,0,0,0),   P1[6],P1[7],P1[8],P1[9],     pw2[2]=PKW(P1,4), pw2[3]=PKW(P1,6), pw2); \
    VRD(3); SBAR(); GAPA(C0=__builtin_amdgcn_mfma_f32_32x32x16_bf16(kf[6],qr[3],C0,0,0,0),   P1[10],P1[11],P1[12],P1[13], pw3[0]=PKW(P1,8), pw3[1]=PKW(P1,10), pw3); \
    VRD(7); SBAR(); GAPA(C1=__builtin_amdgcn_mfma_f32_32x32x16_bf16(kf[7],qr[3],C1,0,0,0),   P1[14],P1[15],0.f,0.f,       pw3[2]=PKW(P1,12),pw3[3]=PKW(P1,14), pw3); \
    l_reg+=sacc; \
    if(GK){DMA_K((t)+3,sl_cur);} if(GV){DMA_V((t)+1,sl_next);} \
    CMASK(C0,C1,t); \
    { float a=MX3(C0[0],C0[1],C1[0]),b=MX3(C0[2],C0[3],C1[1]); a=MX3(a,C1[2],C1[3]); \
      _Pragma("unroll") for(int r=4;r<16;r+=4){a=MX3(a,C0[r],C0[r+1]);b=MX3(b,C0[r+2],C0[r+3]);a=MX3(a,C1[r],C1[r+1]);b=MX3(b,C1[r+2],C1[r+3]);} \
      float rm=__builtin_fmaxf(a,b); { auto rr=__builtin_amdgcn_permlane32_swap(__float_as_uint(rm),__float_as_uint(rm),false,false); rm=__builtin_fmaxf(__uint_as_float(rr[0]),__uint_as_float(rr[1])); } \
      resc=false; \
      if(__builtin_expect(__any(rm>(float)THRL),0)){ const float dl=__builtin_fmaxf(rm,0.f); mhat+=dl; \
        _Pragma("unroll") for(int r=0;r<16;++r){C0[r]-=dl;C1[r]-=dl;} \
        nb=fq2-mhat; \
        const float f=__builtin_amdgcn_exp2f(-dl); l_reg*=f; if(hi==0)wsf[r32]=f; resc=true; } } \
    SBAR(); \
    const lds_cptr fk_=fkp+((t)+1)*256; f32x4_t fa_=FLD(0),fb_; SBAR(); \
    GAPB(o[0]=__builtin_amdgcn_mfma_f32_32x32x16_bf16(PAF(0),VFR(0),o[0],0,0,0), C0,0, P0,fa_,fb_,32); \
    GAPB(o[1]=__builtin_amdgcn_mfma_f32_32x32x16_bf16(PAF(0),VFR(4),o[1],0,0,0), C0,4, P0,fb_,fa_,64); \
    KRD(GL,0); GAPB(o[0]=__builtin_amdgcn_mfma_f32_32x32x16_bf16(PAF(1),VFR(1),o[0],0,0,0), C0,8, P0,fa_,fb_,96); \
    KRD(GL,1); GAPB(o[1]=__builtin_amdgcn_mfma_f32_32x32x16_bf16(PAF(1),VFR(5),o[1],0,0,0), C0,12, P0,fb_,fa_,128); \
    KRD(GL,2); GAPB(o[0]=__builtin_amdgcn_mfma_f32_32x32x16_bf16(PAF(2),VFR(2),o[0],0,0,0), C1,0, P1,fa_,fb_,160); \
    KRD(GL,3); GAPB(o[1]=__builtin_amdgcn_mfma_f32_32x32x16_bf16(PAF(2),VFR(6),o[1],0,0,0), C1,4, P1,fb_,fa_,192); \
    GAPB(o[0]=__builtin_amdgcn_mfma_f32_32x32x16_bf16(PAF(3),VFR(3),o[0],0,0,0), C1,8, P1,fa_,fb_,224); \
    GAPB(o[1]=__builtin_amdgcn_mfma_f32_32x32x16_bf16(PAF(3),VFR(7),o[1],0,0,0), C1,12, P1,fb_,fa_,224); \
    }while(0)
  int t=1;
  #undef CMASK
  #define CMASK(P0,P1,t) do{}while(0)
  for(;t+5<NT;t+=2){
    STEP(pB0,pB1,pA0,pA1,t,true,true,true);     WAIT_BAR(2); RESC(); ROT();
    STEP(pA0,pA1,pB0,pB1,t+1,true,true,true);   WAIT_BAR(2); RESC(); ROT();
  }
  #undef CMASK
  #define CMASK(P0,P1,t) do{int jb_=(t)-(NT-4); if(jb_>=0)cmask(P0,P1,jb_,qrel,hi);}while(0)
  #define ENDW(tt) do{ if((tt)+3<NT){WAIT_BAR(2);} else if((tt)+2<NT){WAIT_BAR(1);} else {WAIT_BAR(0);} }while(0)
  for(;t+1<NT;t+=2){
    STEP(pB0,pB1,pA0,pA1,t,(t+3<NT),(t+1<NT),(t+1<NT));       ENDW(t);   RESC(); ROT();
    STEP(pA0,pA1,pB0,pB1,t+1,(t+4<NT),(t+2<NT),(t+2<NT));     ENDW(t+1); RESC(); ROT();
  }
  STEP(pB0,pB1,pA0,pA1,NT-1,false,false,false); RESC();
  { float sacc=pB0[0]+pB0[1]; _Pragma("unroll") for(int r=2;r<16;++r)sacc+=pB0[r]; _Pragma("unroll") for(int r=0;r<16;++r)sacc+=pB1[r]; l_reg+=sacc;
    pw0=(u32x4){PKW(pB0,0),PKW(pB0,2),PKW(pB0,4),PKW(pB0,6)};pw1=(u32x4){PKW(pB0,8),PKW(pB0,10),PKW(pB0,12),PKW(pB0,14)};pw2=(u32x4){PKW(pB1,0),PKW(pB1,2),PKW(pB1,4),PKW(pB1,6)};pw3=(u32x4){PKW(pB1,8),PKW(pB1,10),PKW(pB1,12),PKW(pB1,14)};
    SBAR(); pv(o,vb0+sl_cur,PAF(0),PAF(1),PAF(2),PAF(3)); }
  #undef PKW
  #undef PAF
  #undef VFR
  #undef PIN
  #undef MX3
  #undef GAPA
  #undef GAPB
  #undef FLD
  #undef FILLC
  #undef EX
  #undef VRD
  #undef KRD
  #undef STEP
  #undef ENDW
  {auto rr=__builtin_amdgcn_permlane32_swap(__float_as_uint(l_reg),__float_as_uint(l_reg),false,false);l_reg=__uint_as_float(rr[0])+__uint_as_float(rr[1]);}
  if(hi==0)wsf[32+r32]=l_reg;asm volatile("s_waitcnt lgkmcnt(0)":::"memory");
  float rli[16];
  #pragma unroll
  for(int r=0;r<16;++r)rli[r]=__builtin_amdgcn_rcpf(wsf[32+crow(r,hi)]);
  bf16*Ow=O+(rowbase+q0+wid*QBLK)*DM+h*D;
  { bf16*stg=(bf16*)(shm+LDS_OST)+wid*2048;
    #pragma unroll
    for(int r=0;r<16;++r){const int orow=crow(r,hi);
      #pragma unroll
      for(int d0=0;d0<2;++d0)stg[orow*64+d0*32+r32]=f2bf_a(o[d0][r]*rli[r]);}
    asm volatile("s_waitcnt lgkmcnt(0)":::"memory");
    #pragma unroll
    for(int i=0;i<4;++i){const int row=i*8+(lane>>3),ch=lane&7; const u32x4 v=*(const u32x4*)(stg+row*64+ch*8); ATTN_STORE16(Ow+(long)row*DM+ch*8,v);} }
  asm volatile("s_waitcnt lgkmcnt(0)\n\ts_barrier":::"memory");
  #undef DMA_K
  #undef DMA_V
  #undef CMASK
  #undef START
  #undef RESC
  #undef ROT
}
constexpr int ATTN_LDS_BYTES=LDS_BYTES;
struct AttnTensors { const bf16* Q; const bf16* K; const bf16* V; bf16* O; const float* CUM; };
struct AttnUnit { int bh; int qb; };
struct StaticOrder {
  int vcu;
  __device__ __forceinline__ explicit StaticOrder(int v):vcu(v){}
  __device__ __forceinline__ bool next(int i,AttnUnit&u)const{ if(i>=2)return false; const int s=vcu&15; u.bh=vcu>>4; u.qb=(i==0)?31-s:s; return true; }
};
template<class Sched,int THRL=8> __device__ __forceinline__ void attn_phase(char*lds,const AttnTensors&T,const Sched&S){
  AttnUnit u;
  for(int i=0;S.next(i,u);++i){ attn_unit<THRL>(u.bh/NHEAD,u.bh%NHEAD,u.qb,T.Q,T.K,T.V,T.O,T.CUM,lds); }
}
#undef SBAR
#undef WAIT_BAR
}

constexpr int NWAVES = 8;
constexpr int RING_OFF = 0, RING_BYTES = 131072;
constexpr int LDSCTL_OFF = RING_BYTES, MISC_OFF = LDSCTL_OFF + 320;
constexpr int LDS_BYTES = 147456;
typedef GAS unsigned gu32;
#define RLX_AGENT __ATOMIC_RELAXED, __HIP_MEMORY_SCOPE_AGENT
#define LDS_WAIT() asm volatile("s_waitcnt lgkmcnt(0)" ::: "memory")
#define VM_WAIT() asm volatile("s_waitcnt vmcnt(0)" ::: "memory")
constexpr int CW_TMO = 0, CW_CODE = 1, CW_CNT = 64  , CW_Q0 = 128  , CW_BAR = 4096;

#define XB_TMO      128
#define XB_XCNT(j)  (256  + 64 * (j))
#define XB_XSUB(j)  (1280 + 64 * (j))
#define XB_XGEN(j)  (2304 + 64 * (j))
#define XB_TOP      3328
#define XB_TOPGEN   3392
#define XCD_BAR_WORDS 3456
#define XB_SPIN_CAP (1u << 18)
__device__ __forceinline__ unsigned xb_ld(unsigned* p)              { return __hip_atomic_load(p, __ATOMIC_RELAXED, __HIP_MEMORY_SCOPE_AGENT); }
__device__ __forceinline__ unsigned xb_add(unsigned* p, unsigned v) { return __hip_atomic_fetch_add(p, v, __ATOMIC_RELAXED, __HIP_MEMORY_SCOPE_AGENT); }
__device__ __forceinline__ unsigned xb_xcc_id() { return (unsigned)__builtin_amdgcn_s_getreg((3 << 11) | 20) & 0xFu; }
#define XB_SPIN(cond, bar) do { unsigned _sp = 0; while (cond) { __builtin_amdgcn_s_sleep(1); \
    if ((++_sp & 255u) == 0u) { if (xb_ld(&(bar)[XB_TMO])) break; if (_sp > XB_SPIN_CAP) { atomicAdd(&(bar)[XB_TMO], 1u); break; } } } } while (0)
struct XcdBarrier { unsigned* bar; unsigned x; volatile LAS unsigned* st; };
__device__ __forceinline__ XcdBarrier xcd_barrier_post(unsigned* bar, volatile LAS unsigned* st) {
    XcdBarrier b; b.bar = bar; b.x = xb_xcc_id(); b.st = st;
    if (threadIdx.x == 0) (void)xb_add(&bar[XB_XCNT(b.x)], 1u);
    return b;
}
__device__ __forceinline__ void xcd_barrier_complete(unsigned* bar, unsigned x, unsigned& nloc, unsigned& nx) {
    const unsigned G = gridDim.x * gridDim.y * gridDim.z;
    unsigned sum, cnt, mine, sp = 0u;
    for (;;) {
        sum = 0u; cnt = 0u; mine = 0u;
#pragma unroll
        for (unsigned j = 0; j < 16; ++j) { const unsigned c = xb_ld(&bar[XB_XCNT(j)]); sum += c; cnt += (c > 0u) ? 1u : 0u; mine = (j == x) ? c : mine; }
        if (sum == G) break;
        __builtin_amdgcn_s_sleep(1);
        if ((++sp & 255u) == 0u) { if (xb_ld(&bar[XB_TMO])) break; if (sp > XB_SPIN_CAP) { atomicAdd(&bar[XB_TMO], 1u); break; } }
    }
    nloc = mine > 0u ? mine : 1u; nx = cnt > 0u ? cnt : 1u;
}
__device__ __forceinline__ void xcd_barrier(const XcdBarrier& b) {
    asm volatile("s_waitcnt vmcnt(0)" ::: "memory");
    __syncthreads();
    if (threadIdx.x == 0) {
        unsigned* bar = b.bar;
        __builtin_amdgcn_s_waitcnt(0);
        unsigned nloc = b.st[0], nx = b.st[1];
        if (nloc == 0u) { xcd_barrier_complete(bar, b.x, nloc, nx); b.st[0] = nloc; b.st[1] = nx; }
        const unsigned old = xb_add(&bar[XB_XSUB(b.x)], 1u);
        const unsigned gen = old / nloc;
        if (old + 1u == (gen + 1u) * nloc) {
            __builtin_amdgcn_fence(__ATOMIC_RELEASE, "agent");
            asm volatile("s_waitcnt vmcnt(0)" ::: "memory");
            const unsigned og = xb_add(&bar[XB_TOP], 1u);
            const unsigned tg = og / nx;
            if (og + 1u == (tg + 1u) * nx) xb_add(&bar[XB_TOPGEN], 1u);
            else XB_SPIN(xb_ld(&bar[XB_TOPGEN]) == tg, bar);
            __builtin_amdgcn_fence(__ATOMIC_ACQUIRE, "agent");
            xb_add(&bar[XB_XGEN(b.x)], 1u);
            asm volatile("s_waitcnt vmcnt(0)" ::: "memory");
        } else {
            XB_SPIN(xb_ld(&bar[XB_XGEN(b.x)]) == gen, bar);
            __builtin_amdgcn_fence(__ATOMIC_ACQUIRE, "agent");
            asm volatile("s_waitcnt vmcnt(0)" ::: "memory");
        }
    }
    __syncthreads();
}

struct Args { const float* in[26]; float* out; unsigned char* ws; int ph_lo, ph_hi, sub, pad_; };
struct Frame {
    LAS unsigned char* lds; volatile LAS unsigned* MISC; gu32* ctl;
    int tid, lane, wave, vcu, G;
};
__device__ __forceinline__ float gelu_fast(float x) { const float z = 0.7978845608028654f * (x + 0.044715f * x * x * x); const float e = __builtin_amdgcn_exp2f(2.885390081777927f * z); return x - x * __builtin_amdgcn_rcpf(e + 1.f); }
__device__ __forceinline__ float wave_sum(float v) {
#pragma unroll
    for (int o = 1; o < 64; o <<= 1) v += __shfl_xor(v, o);
    return v;
}

__device__ __forceinline__ void conv_item(const float* W, int ldw, int k0, int scol, bf16* dst, int ldd, const float* kscale, LAS float* scr, int lane) {
    float v[32];
    const float* wp = W + (size_t)(k0 + (lane >> 5)) * ldw + scol + (lane & 31);
#pragma unroll
    for (int i = 0; i < 32; ++i) v[i] = wp[(size_t)(2 * i) * ldw];
    if (kscale) {
#pragma unroll
        for (int i = 0; i < 32; ++i) v[i] *= kscale[k0 + 2 * i + (lane >> 5)]; }
#pragma unroll
    for (int i = 0; i < 32; ++i) scr[(2 * i + (lane >> 5)) * 33 + (lane & 31)] = v[i];
    LDS_WAIT(); asm volatile("" ::: "memory");
    const int c = lane & 7;
#pragma unroll
    for (int j = 0; j < 4; ++j) { const int n = (lane >> 3) + 8 * j; const LAS float* s = scr + (8 * c) * 33 + n;
        u32x4 o; o.x = pg::cvt_pk_bf16(s[0 * 33], s[1 * 33]); o.y = pg::cvt_pk_bf16(s[2 * 33], s[3 * 33]); o.z = pg::cvt_pk_bf16(s[4 * 33], s[5 * 33]); o.w = pg::cvt_pk_bf16(s[6 * 33], s[7 * 33]);
        *(GAS u32x4*)(dst + (size_t)n * ldd + k0 + 8 * c) = o; }
    LDS_WAIT(); asm volatile("" ::: "memory");
}
__device__ __forceinline__ int inproj_src_col(int cp) { return cp < 1536 ? cp : (cp < 2048 ? cp + (OU - 1536) : (cp < 3072 ? cp + (OGA - 2048) : cp + (OGS - 3072))); }
__device__ __forceinline__ int inproj_dst_row(int cp) { const int t = cp & ~255, c = cp & 255, wc = c >> 6, bj = (c >> 5) & 1, j = c & 31; return t + 128 * bj + 32 * wc + j; }

__device__ __forceinline__ void p0_prologue(Frame& F, const Args& a) {
    unsigned char* ws = a.ws;
    LAS float* scr = (LAS float*)(F.lds + F.wave * 8704);
    LAS float* wf = (LAS float*)(F.lds + 73728);
    const int gw = F.vcu * NWAVES + F.wave, NGW = F.G * NWAVES;
    const float* w_in = a.in[2]; const int sub = a.sub;
    for (int i = F.tid; i < 8 * 1024; i += NWAVES * 64) { const int h = i >> 10, k = i & 1023; wf[i] = w_in[(size_t)k * DIN + OF + h]; }
    constexpr int I_IN = 16 * 128, I_GLU = 8 * 16, I_PA = 8 * 32, I_OUT = 16 * 32;
    constexpr int NITEMS = I_IN + I_GLU + 2 * I_PA + I_OUT;
    for (int it = (sub & 1) ? gw : NITEMS; it < NITEMS; it += NGW) {
        int r = it;
        if (r < I_IN) { const int kb = r >> 7, nb = r & 127, cp = nb * 32; conv_item(w_in, DIN, kb * 64, inproj_src_col(cp), (bf16*)(ws + WS_WIN) + (size_t)inproj_dst_row(cp) * D, D, nullptr, scr, F.lane); continue; } r -= I_IN;
        if (r < I_GLU) { const int kb = r >> 4, nb = r & 15; conv_item(a.in[14], DS, kb * 64, nb * 32, (bf16*)(ws + WS_WGLU) + (size_t)(nb * 32) * DS, DS, nullptr, scr, F.lane); continue; } r -= I_GLU;
        if (r < I_PA) { const int kb = r >> 5, nb = r & 31; conv_item(a.in[15], D, kb * 64, nb * 32, (bf16*)(ws + WS_WPA) + (size_t)(nb * 32) * DA, DA, nullptr, scr, F.lane); continue; } r -= I_PA;
        if (r < I_PA) { const int kb = r >> 5, nb = r & 31; conv_item(a.in[16], D, kb * 64, nb * 32, (bf16*)(ws + WS_WPS) + (size_t)(nb * 32) * DS, DS, nullptr, scr, F.lane); continue; } r -= I_PA;
        { const int kb = r >> 5, nb = r & 31; conv_item(a.in[17], D, kb * 64, nb * 32, (bf16*)(ws + WS_WOUT) + (size_t)(nb * 32) * D, D, nullptr, scr, F.lane); }
    }
    if (blockIdx.x < 48) {
        const int r = blockIdx.x; const float* gf = a.in[18]; const float* wrg = a.in[19]; const float* wre = a.in[21]; bf16* WR = (bf16*)(ws + WS_WR) + (size_t)r * D;
        for (int k = F.tid; k < D; k += NWAVES * 64) { const float w = r < 4 ? wrg[k * 4 + r] : (r < 36 ? wre[k * NE + r - 4] : 0.f); WR[k] = f2bf(w * gf[k]); }
    }
    __syncthreads();
    const float* x = a.in[0]; const float* g = a.in[1]; const float* bfg = a.in[3];
    bf16* XN = (bf16*)(ws + WS_XN); float* LOGF = (float*)(ws + WS_CUM);
    { int m = (sub & 2) ? gw : T; f32x4 v[4];
      if (m < T) { const GAS f32x4* xr = (const GAS f32x4*)(x + (size_t)m * D) + F.lane;
#pragma unroll
          for (int j = 0; j < 4; ++j) v[j] = xr[64 * j]; }
      while (m < T) {
        const int mn = m + NGW; f32x4 vn[4];
        if (mn < T) { const GAS f32x4* xr = (const GAS f32x4*)(x + (size_t)mn * D) + F.lane;
#pragma unroll
            for (int j = 0; j < 4; ++j) vn[j] = xr[64 * j]; }
        float s = 0.f;
#pragma unroll
        for (int j = 0; j < 4; ++j) s += (v[j].x * v[j].x + v[j].y * v[j].y) + (v[j].z * v[j].z + v[j].w * v[j].w);
        const float rstd = rsqrtf(wave_sum(s) * (1.f / D) + EPS);
        float f[8];
#pragma unroll
        for (int h = 0; h < 8; ++h) f[h] = 0.f;
        GAS u32x2* o8 = (GAS u32x2*)(XN + (size_t)m * D) + F.lane;
#pragma unroll
        for (int j = 0; j < 4; ++j) { const f32x4 gg = *((const GAS f32x4*)g + 64 * j + F.lane); const f32x4 xn = v[j] * rstd * gg;
            u32x2 w; w.x = pg::cvt_pk_bf16(xn.x, xn.y); w.y = pg::cvt_pk_bf16(xn.z, xn.w); o8[64 * j] = w;
#pragma unroll
            for (int h = 0; h < 8; ++h) { const f32x4 ww = *((const LAS f32x4*)(wf + h * 1024) + 64 * j + F.lane); f[h] += (xn.x * ww.x + xn.y * ww.y) + (xn.z * ww.z + xn.w * ww.w); } }
#pragma unroll
        for (int h = 0; h < 8; ++h) f[h] = wave_sum(f[h]);
        float fs = f[0];
#pragma unroll
        for (int h = 1; h < 8; ++h) fs = (F.lane == h) ? f[h] : fs;
        if (F.lane < 8) { const int b = m / SEQ, sidx = m % SEQ; LOGF[((size_t)b * NH + F.lane) * SEQ + sidx] = log_sigmoid(fs + bfg[F.lane]); }
#pragma unroll
        for (int j = 0; j < 4; ++j) v[j] = vn[j];
        m = mn;
      } }
    if ((sub & 4) && F.G == 256) {
        __syncthreads();
        const int g = F.vcu >> 3, q = F.vcu & 7;
        LAS f32x2* PW = (LAS f32x2*)(F.lds);
        LAS f32x2* BB = (LAS f32x2*)(F.lds + 16896);
        LAS f32x2* CT = (LAS f32x2*)(F.lds + 16896 + 8192);
        LAS float* KT = (LAS float*)(F.lds + 16896 + 16384);
        const float* A_re = a.in[6]; const float* A_im = a.in[7]; const float* log_dt = a.in[8]; const float* B_re = a.in[9]; const float* B_im = a.in[10]; const float* C_re = a.in[11]; const float* C_im = a.in[12];
        if (F.tid < NP) { const int p = F.tid;
            const double dt = exp((double)log_dt[g]), ar = A_re[g * NP + p], ai = A_im[g * NP + p];
            const double er = exp(ar * dt), abr = er * cos(ai * dt), abi = er * sin(ai * dt);
            const double nr = abr - 1.0, ni = abi, den = ar * ar + ai * ai, fr_ = (nr * ar + ni * ai) / den, fi_ = (ni * ar - nr * ai) / den;
            double pr = 1.0, pi = 0.0;
            for (int tau = 0; tau <= LCH; ++tau) { PW[tau * NP + p] = (f32x2){(float)pr, (float)pi}; const double t2 = pr * abr - pi * abi; pi = pr * abi + pi * abr; pr = t2; }
            if (q == 0) { ((float*)(ws + WS_AL))[(g * NP + p) * 2] = PW[LCH * NP + p].x; ((float*)(ws + WS_AL))[(g * NP + p) * 2 + 1] = PW[LCH * NP + p].y; }
            for (int c = 0; c < GC; ++c) { const double br = B_re[(g * NP + p) * GC + c], bi = B_im[(g * NP + p) * GC + c]; BB[p * GC + c] = (f32x2){(float)(fr_ * br - fi_ * bi), (float)(fr_ * bi + fi_ * br)}; } }
        for (int i = F.tid; i < GC * NP; i += NWAVES * 64) { const int c = i >> 6, p = i & 63; CT[p * GC + c] = (f32x2){C_re[g * GC * NP + i], C_im[g * GC * NP + i]}; }
        __syncthreads();
        for (int i = F.tid; i < (4 * q + 4) * GC * GC; i += NWAVES * 64) { const int tau = i >> 8, co = (i >> 4) & 15, ci = i & 15; float acc = 0.f;
#pragma unroll 4
            for (int p = 0; p < NP; ++p) { const f32x2 w = PW[tau * NP + p], b = BB[p * GC + ci], c = CT[p * GC + co]; const float wr_ = w.x * b.x - w.y * b.y, wi_ = w.x * b.y + w.y * b.x; acc += c.x * wr_ - c.y * wi_; }
            KT[i] = acc; }
        __syncthreads();
        {
          const int n = 64 * q + (F.tid >> 3), part = F.tid & 7, j = n >> 4, co = n & 15; bf16* row = (bf16*)(ws + WS_BTY) + ((size_t)g * 512 + n) * U2P;
          auto bval = [&](int k) -> float { float x;
              if (k < 128) { const int p = k & 63; const f32x2 w = PW[(j + 1) * NP + p], c = CT[p * GC + co]; x = k < 64 ? (c.x * w.x - c.y * w.y) : -(c.x * w.y + c.y * w.x); }
              else { const int sidx = (k - 128) >> 4, ci = (k - 128) & 15; x = sidx <= j ? KT[((j - sidx) * GC + co) * GC + ci] : 0.f; }
              return x; };
#pragma unroll 1
          for (int it = 0; it < U2P / 64; ++it) { const int k = (it * 8 + part) * 8;
              u32x4 o; o.x = pg::cvt_pk_bf16(bval(k), bval(k + 1)); o.y = pg::cvt_pk_bf16(bval(k + 2), bval(k + 3)); o.z = pg::cvt_pk_bf16(bval(k + 4), bval(k + 5)); o.w = pg::cvt_pk_bf16(bval(k + 6), bval(k + 7)); *(GAS u32x4*)(row + k) = o; } }
        {
          const int n = 32 * q + (F.tid >> 4), part = F.tid & 15; bf16* row = (bf16*)(ws + WS_M1T) + ((size_t)g * 256 + n) * 512;
          auto mval = [&](int k) -> float { const int j = k >> 4, ci = k & 15; float x = 0.f;
              if (n < 128) { const int p = n & 63; const f32x2 w = PW[(LCH - 1 - j) * NP + p], b = BB[p * GC + ci]; x = n < 64 ? (w.x * b.x - w.y * b.y) : (w.x * b.y + w.y * b.x); }
              return x; };
#pragma unroll 1
          for (int it = 0; it < 4; ++it) { const int k = (it * 16 + part) * 8;
              u32x4 o; o.x = pg::cvt_pk_bf16(mval(k), mval(k + 1)); o.y = pg::cvt_pk_bf16(mval(k + 2), mval(k + 3)); o.z = pg::cvt_pk_bf16(mval(k + 4), mval(k + 5)); o.w = pg::cvt_pk_bf16(mval(k + 6), mval(k + 7)); *(GAS u32x4*)(row + k) = o; } }
    }
}

__device__ __forceinline__ void p1_cumsum(Frame& F, float* CUM) {
    LAS double* part = (LAS double*)(F.lds);
    float* p = CUM + (size_t)blockIdx.x * SEQ + F.tid * 16;
    f32x4 v[4]; float run[16]; float a = 0.f;
#pragma unroll
    for (int j = 0; j < 4; ++j) v[j] = ((const GAS f32x4*)p)[j];
#pragma unroll
    for (int j = 0; j < 4; ++j) { a += v[j].x; run[4 * j] = a; a += v[j].y; run[4 * j + 1] = a; a += v[j].z; run[4 * j + 2] = a; a += v[j].w; run[4 * j + 3] = a; }
    part[F.tid] = (double)a;
    __syncthreads();
    if (F.tid < 64) { double loc[8]; double s = 0.0;
#pragma unroll
        for (int i = 0; i < 8; ++i) { loc[i] = s; s += part[F.tid * 8 + i]; }
        double incl = s;
#pragma unroll
        for (int o = 1; o < 64; o <<= 1) { const double t = __shfl_up(incl, o); if (F.lane >= o) incl += t; }
        const double excl = incl - s;
#pragma unroll
        for (int i = 0; i < 8; ++i) part[F.tid * 8 + i] = excl + loc[i]; }
    __syncthreads();
    const double base = part[F.tid];
#pragma unroll
    for (int j = 0; j < 4; ++j) { f32x4 o; o.x = (float)((base + (double)run[4 * j]) * 1.4426950408889634); o.y = (float)((base + (double)run[4 * j + 1]) * 1.4426950408889634);
        o.z = (float)((base + (double)run[4 * j + 2]) * 1.4426950408889634); o.w = (float)((base + (double)run[4 * j + 3]) * 1.4426950408889634); ((GAS f32x4*)p)[j] = o; }
    __syncthreads();
}
struct PhInProj {
    static constexpr bool GATHER = false;
    unsigned lda, ldb; const char* A; const char* B; pg::StaticOrder so;
    bf16 *Q, *K, *V, *U2X, *GA, *GS; const float *gq, *gk;
    __device__ __forceinline__ bool next(int i, pg::Unit& u) const { int pm, pn; if (!so.next(i, pm, pn)) return false; u.A = A + (size_t)pm * 256 * lda; u.B = B + (size_t)pn * 256 * ldb; u.nt = D / 64; u.pm = pm; u.pn = pn; u.aux = 0; return true; }
    __device__ __forceinline__ void offs(const pg::Unit&, const int (&R)[2], const int (&C)[2], unsigned (&vo)[2][2]) const { pg::offs_plain(lda, R, C, vo); }
    __device__ __forceinline__ void epi(const f32x4 (&acc)[2][2][4][2], const pg::Unit& u, int wr, int wc, int fr, int fq) const {
        const int pn = u.pn, row0 = u.pm * 256 + wr * 64 + fr;
        if (pn < 4) {
            const bool isq = pn < 2; const float* g = isq ? gq : gk; bf16* O = isq ? Q : K; const int cb = (pn & 1) * 256 + 64 * wc + 8 * fq; const float sc = isq ? C2 : 1.f;
            f32x4 gv[2][2];
#pragma unroll
            for (int bj = 0; bj < 2; ++bj)
#pragma unroll
                for (int n = 0; n < 2; ++n) gv[bj][n] = *(const f32x4*)(g + 32 * bj + 8 * fq + 4 * n) * sc;
#pragma unroll
            for (int ai = 0; ai < 2; ++ai)
#pragma unroll
                for (int m = 0; m < 4; ++m) { float ss = 0.f;
#pragma unroll
                    for (int bj = 0; bj < 2; ++bj)
#pragma unroll
                        for (int n = 0; n < 2; ++n) { const f32x4 v = acc[ai][bj][m][n]; ss += (v[0] * v[0] + v[1] * v[1]) + (v[2] * v[2] + v[3] * v[3]); }
                    ss += __shfl_xor(ss, 16); ss += __shfl_xor(ss, 32);
                    const float rstd = rsqrtf(ss * (1.f / 64.f) + EPS);
                    bf16* rowp = O + (size_t)(row0 + ai * 128 + m * 16) * DA + cb;
#pragma unroll
                    for (int bj = 0; bj < 2; ++bj) *(u32x4*)(rowp + 32 * bj) = pg::pack8(acc[ai][bj][m][0] * rstd * gv[bj][0], acc[ai][bj][m][1] * rstd * gv[bj][1]); }
        } else if (pn < 6) {
            const int cb = (pn - 4) * 256 + 64 * wc + 8 * fq;
#pragma unroll
            for (int ai = 0; ai < 2; ++ai)
#pragma unroll
                for (int m = 0; m < 4; ++m) { bf16* rowp = V + (size_t)(row0 + ai * 128 + m * 16) * DA + cb;
#pragma unroll
                    for (int bj = 0; bj < 2; ++bj) *(u32x4*)(rowp + 32 * bj) = pg::pack8(acc[ai][bj][m][0], acc[ai][bj][m][1]); }
        } else if (pn < 8) {
#pragma unroll
            for (int ai = 0; ai < 2; ++ai)
#pragma unroll
                for (int m = 0; m < 4; ++m) { const int row = row0 + ai * 128 + m * 16;
#pragma unroll
                    for (int bj = 0; bj < 2; ++bj) { const int cu = (pn - 6) * 256 + 64 * wc + 32 * bj + 8 * fq;
                        *(u32x4*)(U2X + u2x_index(cu >> 4, row, cu & 15)) = pg::pack8(acc[ai][bj][m][0], acc[ai][bj][m][1]); } }
        } else {
            bf16* G = pn < 12 ? GA : GS; const int cb = ((pn - 8) & 3) * 256 + 64 * wc + 8 * fq;
#pragma unroll
            for (int ai = 0; ai < 2; ++ai)
#pragma unroll
                for (int m = 0; m < 4; ++m) { bf16* rowp = G + (size_t)(row0 + ai * 128 + m * 16) * D + cb;
#pragma unroll
                    for (int bj = 0; bj < 2; ++bj) { f32x4 a = acc[ai][bj][m][0], b = acc[ai][bj][m][1];
#pragma unroll
                        for (int e = 0; e < 4; ++e) { a[e] = pg::fsigmoid(a[e]); b[e] = pg::fsigmoid(b[e]); }
                        *(u32x4*)(rowp + 32 * bj) = pg::pack8(a, b); } }
        }
    }
};

struct PhGlu {
    static constexpr bool GATHER = false;
    unsigned lda, ldb; const char* A; const char* B; pg::StaticOrder so; const bf16* Y1; bf16* YS;
    __device__ __forceinline__ bool next(int i, pg::Unit& u) const { int pm, pn; if (!so.next(i, pm, pn)) return false; u.A = A + (size_t)pm * 256 * lda; u.B = B + (size_t)pn * 256 * ldb; u.nt = DS / 64; u.pm = pm; u.pn = pn; u.aux = 0; return true; }
    __device__ __forceinline__ void offs(const pg::Unit&, const int (&R)[2], const int (&C)[2], unsigned (&vo)[2][2]) const { pg::offs_plain(lda, R, C, vo); }
    __device__ __forceinline__ void epi(const f32x4 (&acc)[2][2][4][2], const pg::Unit& u, int wr, int wc, int fr, int fq) const {
        const int row0 = u.pm * 256 + wr * 64 + fr, cb = u.pn * 256 + 32 * wc + 8 * fq;
#pragma unroll
        for (int ai = 0; ai < 2; ++ai)
#pragma unroll
            for (int m = 0; m < 4; ++m) { const size_t ro = (size_t)(row0 + ai * 128 + m * 16) * DS + cb;
#pragma unroll
                for (int bj = 0; bj < 2; ++bj) { const u32x4 yv = *(const u32x4*)(Y1 + ro + 128 * bj); f32x4 y0, y1; pg::unpack8(yv, y0, y1);
                    f32x4 a = acc[ai][bj][m][0], b = acc[ai][bj][m][1];
#pragma unroll
                    for (int e = 0; e < 4; ++e) { a[e] = y0[e] * pg::fsigmoid(a[e]); b[e] = y1[e] * pg::fsigmoid(b[e]); }
                    *(u32x4*)(YS + ro + 128 * bj) = pg::pack8(a, b); } }
    }
};
struct PhProj {
    static constexpr bool GATHER = false;
    unsigned lda, ldb; const char* O; const char* YSp; const char* WPA; const char* WPS; pg::StaticOrder so; bf16* GA; const bf16* GS;
    __device__ __forceinline__ bool next(int i, pg::Unit& u) const { int pm, pn; if (!so.next(i >> 1, pm, pn)) return false; const int sub = i & 1;
        u.A = (sub ? YSp : O) + (size_t)pm * 256 * lda; u.B = (sub ? WPS : WPA) + (size_t)pn * 256 * ldb; u.nt = DA / 64; u.pm = pm; u.pn = pn; u.aux = sub; return true; }
    __device__ __forceinline__ void offs(const pg::Unit&, const int (&R)[2], const int (&C)[2], unsigned (&vo)[2][2]) const { pg::offs_plain(lda, R, C, vo); }
    __device__ __forceinline__ void epi(const f32x4 (&acc)[2][2][4][2], const pg::Unit& u, int wr, int wc, int fr, int fq) const {
        const int row0 = u.pm * 256 + wr * 64 + fr, cb = u.pn * 256 + 32 * wc + 8 * fq; const bool sub = u.aux != 0;
#pragma unroll
        for (int ai = 0; ai < 2; ++ai)
#pragma unroll
            for (int m = 0; m < 4; ++m) { const size_t ro = (size_t)(row0 + ai * 128 + m * 16) * D + cb;
#pragma unroll
                for (int bj = 0; bj < 2; ++bj) { const u32x4 gv = *(const u32x4*)(GA + ro + 128 * bj); f32x4 g0, g1; pg::unpack8(gv, g0, g1);
                    f32x4 a = acc[ai][bj][m][0], b = acc[ai][bj][m][1];
                    if (!sub) { a = a * g0; b = b * g1; }
                    else { const u32x4 sv = *(const u32x4*)(GS + ro + 128 * bj); f32x4 s0, s1; pg::unpack8(sv, s0, s1); a = g0 + s0 * a; b = g1 + s1 * b; }
                    *(u32x4*)(GA + ro + 128 * bj) = pg::pack8(a, b); } }
    }
};
struct PhWout {
    static constexpr bool GATHER = false;
    unsigned lda, ldb; const char* A; const char* B; pg::StaticOrder so; const float* x; float* out; bf16* X2B; float* SSP;
    __device__ __forceinline__ bool next(int i, pg::Unit& u) const { int pm, pn; if (!so.next(i, pm, pn)) return false; u.A = A + (size_t)pm * 256 * lda; u.B = B + (size_t)pn * 256 * ldb; u.nt = D / 64; u.pm = pm; u.pn = pn; u.aux = 0; return true; }
    __device__ __forceinline__ void offs(const pg::Unit&, const int (&R)[2], const int (&C)[2], unsigned (&vo)[2][2]) const { pg::offs_plain(lda, R, C, vo); }
    __device__ __forceinline__ void epi(const f32x4 (&acc)[2][2][4][2], const pg::Unit& u, int wr, int wc, int fr, int fq) const {
        const int row0 = u.pm * 256 + wr * 64 + fr, cb = u.pn * 256 + 32 * wc + 8 * fq;
#pragma unroll
        for (int ai = 0; ai < 2; ++ai)
#pragma unroll
            for (int m = 0; m < 4; ++m) { const int row = row0 + ai * 128 + m * 16; const size_t ro = (size_t)row * D + cb; float ss = 0.f;
#pragma unroll
                for (int bj = 0; bj < 2; ++bj) { const f32x4 x0 = *(const f32x4*)(x + ro + 128 * bj), x1 = *(const f32x4*)(x + ro + 128 * bj + 4);
                    const f32x4 a = acc[ai][bj][m][0] + x0, b = acc[ai][bj][m][1] + x1;
                    *(u32x4*)(X2B + ro + 128 * bj) = pg::pack8(a, b);
                    ss += (a[0] * a[0] + a[1] * a[1]) + (a[2] * a[2] + a[3] * a[3]) + (b[0] * b[0] + b[1] * b[1]) + (b[2] * b[2] + b[3] * b[3]); }
                ss += __shfl_xor(ss, 16); ss += __shfl_xor(ss, 32);
                if (fq == 0) SSP[(size_t)row * 16 + u.pn * 4 + wc] = ss;
                asm volatile("" ::: "memory"); }
    }
};

__device__ __forceinline__ void p2_expert_weights(Frame& F, const Args& a) {
    unsigned char* ws = a.ws; LAS float* scr = (LAS float*)(F.lds + F.wave * 8704);
    const int gw = F.vcu * NWAVES + F.wave, NGW = F.G * NWAVES;
    const float* gf = a.in[18]; const float* wg = a.in[23]; const float* wu = a.in[24]; const float* wd = a.in[25];
    constexpr int I_G = 16 * 8, I_D = 4 * 32;
    constexpr int NITEMS = NE * (2 * I_G + I_D);
    for (int it = (a.sub & 4) ? gw : NITEMS; it < NITEMS; it += NGW) {
        const int e = it / (2 * I_G + I_D); int r = it % (2 * I_G + I_D);
        if (r < 2 * I_G) { const int up = r >= I_G; if (up) r -= I_G; const int kb = r >> 3, nb = r & 7, n0 = nb * 32;
            conv_item((up ? wu : wg) + (size_t)e * D * DE, DE, kb * 64, n0, (bf16*)(ws + WS_WGU) + ((size_t)e * 512 + 256 * (n0 >> 7) + 128 * up + (n0 & 127)) * D, D, gf, scr, F.lane); }
        else { r -= 2 * I_G; const int kb = r >> 5, nb = r & 31; conv_item(wd + (size_t)e * DE * D, D, kb * 64, nb * 32, (bf16*)(ws + WS_WD) + ((size_t)e * D + nb * 32) * DE, DE, nullptr, scr, F.lane); }
    }
}
__device__ __forceinline__ void p8_router(Frame& F, const Args& a) {
    unsigned char* ws = a.ws;
    constexpr int WPITCH = 2064;
    LAS unsigned char* wl = F.lds;
    LAS float* lg = (LAS float*)(F.lds + 48 * WPITCH) + F.wave * 16 * 48;
    { const GAS u32x4* src = (const GAS u32x4*)(ws + WS_WR);
      for (int i = F.tid; i < 48 * 128; i += NWAVES * 64) { const int r = i >> 7, c = i & 127; *(LAS u32x4*)(wl + r * WPITCH + c * 16) = src[i]; } }
    __syncthreads();
    const bf16* X2B = (const bf16*)(ws + WS_X2B); const float* SSP = (const float*)(ws + WS_SSP);
    const float* b_rg = a.in[20]; const float* b_re = a.in[22];
    float* RSTD = (float*)(ws + WS_RSTD); int* ROUTE = (int*)(ws + WS_ROUTE); int* CNT = (int*)(ws + WS_CTL) + CW_CNT; int* LIST = (int*)(ws + WS_LIST); float* WPOS = (float*)(ws + WS_WPOS); float* RPOS = (float*)(ws + WS_RPOS);
    const int fr = F.lane & 15, fq = F.lane >> 4;
    LAS int* lcnt = (LAS int*)(F.lds + 48 * WPITCH + NWAVES * 16 * 48 * 4);
    LAS int* lbase = lcnt + 32;
    for (int t0 = F.vcu * 64; t0 < T; t0 += F.G * 64) {
        if (F.tid < 32) lcnt[F.tid] = 0;
        __syncthreads();
        int e0 = 0, e1 = 0, lr0 = 0, lr1 = 0; float w0 = 0.f, w1 = 0.f, rstd = 0.f;
        if (F.wave < 4) {
            const int tok = t0 + F.wave * 16 + fr;
            const GAS bf16x8* xa = (const GAS bf16x8*)(X2B + (size_t)tok * D + 8 * fq);
            f32x4 acc[3]; acc[0] = acc[1] = acc[2] = (f32x4){0.f, 0.f, 0.f, 0.f};
            bf16x8 xf[32];
#pragma unroll
            for (int ks = 0; ks < 32; ++ks) xf[ks] = xa[ks * 4];
#pragma unroll
            for (int ks = 0; ks < 32; ++ks) {
#pragma unroll
                for (int n = 0; n < 3; ++n) { const bf16x8 wfr = *(const LAS bf16x8*)(wl + (n * 16 + fr) * WPITCH + ks * 64 + fq * 16);
                    acc[n] = __builtin_amdgcn_mfma_f32_16x16x32_bf16(wfr, xf[ks], acc[n], 0, 0, 0); } }
#pragma unroll
            for (int n = 0; n < 3; ++n) *(LAS f32x4*)(lg + fr * 48 + n * 16 + 4 * fq) = acc[n];
            LDS_WAIT(); asm volatile("" ::: "memory");
            if (F.lane < 16) {
                const int t = t0 + F.wave * 16 + F.lane; const LAS float* l = lg + F.lane * 48;
                float ss = 0.f; { const f32x4* sp = (const f32x4*)(SSP + (size_t)t * 16);
#pragma unroll
                    for (int i = 0; i < 4; ++i) { const f32x4 v = sp[i]; ss += (v[0] + v[1]) + (v[2] + v[3]); } }
                rstd = rsqrtf(ss * (1.f / D) + EPS);
                float gl[4]; int gs = 0;
#pragma unroll
                for (int i = 0; i < 4; ++i) gl[i] = l[i] * rstd + b_rg[i];
                float gm = gl[0];
#pragma unroll
                for (int i = 1; i < 4; ++i) if (gl[i] > gm) { gm = gl[i]; gs = i; }
                float gsum = 0.f;
#pragma unroll
                for (int i = 0; i < 4; ++i) gsum += __expf(gl[i] - gm);
                const float gtop = 1.f / gsum;
                float el[8];
#pragma unroll
                for (int i = 0; i < 8; ++i) el[i] = l[4 + gs * 8 + i] * rstd + b_re[gs * 8 + i];
                int i0 = 0; float m0 = el[0];
#pragma unroll
                for (int i = 1; i < 8; ++i) if (el[i] > m0) { m0 = el[i]; i0 = i; }
                int i1 = -1; float m1 = -3.0e38f;
#pragma unroll
                for (int i = 0; i < 8; ++i) if (i != i0 && el[i] > m1) { m1 = el[i]; i1 = i; }
                const float p1 = __expf(m1 - m0); w0 = gtop / (1.f + p1); w1 = gtop * p1 / (1.f + p1);
                e0 = gs * 8 + i0; e1 = gs * 8 + i1;
                lr0 = __hip_atomic_fetch_add(&lcnt[e0], 1, __ATOMIC_RELAXED, __HIP_MEMORY_SCOPE_WORKGROUP); lr1 = __hip_atomic_fetch_add(&lcnt[e1], 1, __ATOMIC_RELAXED, __HIP_MEMORY_SCOPE_WORKGROUP);
            }
        }
        __syncthreads();
        if (F.tid < 32) { const int c = lcnt[F.tid]; lbase[F.tid] = c ? atomicAdd(&CNT[F.tid], c) : 0; }
        __syncthreads();
        if (F.wave < 4 && F.lane < 16) {
            const int t = t0 + F.wave * 16 + F.lane; const int r0 = lbase[e0] + lr0, r1 = lbase[e1] + lr1;
            RSTD[t] = rstd; *(int4*)(ROUTE + t * 4) = make_int4(e0, e1, r0, r1);
            LIST[e0 * T + r0] = t; LIST[e1 * T + r1] = t; WPOS[e0 * T + r0] = w0; WPOS[e1 * T + r1] = w1; RPOS[e0 * T + r0] = rstd; RPOS[e1 * T + r1] = rstd;
        }
        __syncthreads();
    }
}
__device__ __forceinline__ void moe_table(Frame& F, const int* CNT, LAS int* tb) {
    if (F.tid < 64) { const int e = F.lane; int c = 0; if (e < NE) c = (int)__hip_atomic_load((const unsigned*)CNT + e, __ATOMIC_RELAXED, __HIP_MEMORY_SCOPE_AGENT);
        const int tl = (c + 255) >> 8; int incl = tl;
#pragma unroll
        for (int o = 1; o < 32; o <<= 1) { const int v = __shfl_up(incl, o); if (e >= o) incl += v; }
        if (e < NE) { tb[e] = incl - tl; tb[64 + e] = c; } if (e == NE - 1) tb[32] = incl; }
    __syncthreads();
}
__device__ __forceinline__ int moe_find(const LAS int* tb, int mt) { int e = 0;
#pragma unroll 1
    for (int i = 1; i < NE; ++i) if (mt >= tb[i]) e = i; return e; }
struct PhMoeGU {
    static constexpr bool GATHER = true;
    unsigned lda, ldb; const char* X; const char* W; const LAS int* tb; const int* LIST; const float* RPOS; bf16* H; int G, c;
    __device__ __forceinline__ bool next(int i, pg::Unit& u) const { const int L = i * G + c; if (L >= 2 * tb[32]) return false; const int mt = L >> 1, n2 = L & 1, e = moe_find(tb, mt);
        u.A = X; u.B = W + ((size_t)e * 512 + n2 * 256) * ldb; u.nt = D / 64; u.pm = mt; u.pn = n2; u.aux = e; return true; }
    __device__ __forceinline__ void offs(const pg::Unit& u, const int (&R)[2], const int (&C)[2], unsigned (&vo)[2][2]) const {
        const int e = u.aux, cnt = tb[64 + e], r0 = (u.pm - tb[e]) * 256; const int* lp = LIST + (size_t)e * T;
#pragma unroll
        for (int h = 0; h < 2; ++h)
#pragma unroll
            for (int i = 0; i < 2; ++i) { int r = r0 + h * 128 + R[i]; r = r < cnt ? r : cnt - 1; vo[h][i] = (unsigned)lp[r] * lda + (unsigned)C[i] * 2u; }
    }
    __device__ __forceinline__ void epi(const f32x4 (&acc)[2][2][4][2], const pg::Unit& u, int wr, int wc, int fr, int fq) const {
        const int e = u.aux, r0 = (u.pm - tb[e]) * 256; const float* rp = RPOS + (size_t)e * T + r0;
#pragma unroll
        for (int ai = 0; ai < 2; ++ai)
#pragma unroll
            for (int m = 0; m < 4; ++m) { const int tr = ai * 128 + wr * 64 + m * 16 + fr; const float rs = rp[tr];
                f32x4 g0 = acc[ai][0][m][0] * rs, g1 = acc[ai][0][m][1] * rs; const f32x4 u0 = acc[ai][1][m][0] * rs, u1 = acc[ai][1][m][1] * rs;
#pragma unroll
                for (int q = 0; q < 4; ++q) { g0[q] = g0[q] * pg::fsigmoid(g0[q]) * u0[q]; g1[q] = g1[q] * pg::fsigmoid(g1[q]) * u1[q]; }
                *(u32x4*)(H + ((size_t)u.pm * 256 + tr) * DE + u.pn * 128 + 32 * wc + 8 * fq) = pg::pack8(g0, g1); }
    }
};
struct PhMoeDown {
    static constexpr bool GATHER = false;
    unsigned lda, ldb; const char* Hp; const char* W; const LAS int* tb; const float* WPOS; bf16* Y; int G, c;
    __device__ __forceinline__ bool next(int i, pg::Unit& u) const { const int L = i * G + c; if (L >= 4 * tb[32]) return false; const int mt = L >> 2, n4 = L & 3, e = moe_find(tb, mt);
        u.A = Hp + (size_t)mt * 256 * lda; u.B = W + ((size_t)e * D + n4 * 256) * ldb; u.nt = DE / 64; u.pm = mt; u.pn = n4; u.aux = e; return true; }
    __device__ __forceinline__ void offs(const pg::Unit&, const int (&R)[2], const int (&C)[2], unsigned (&vo)[2][2]) const { pg::offs_plain(lda, R, C, vo); }
    __device__ __forceinline__ void epi(const f32x4 (&acc)[2][2][4][2], const pg::Unit& u, int wr, int wc, int fr, int fq) const {
        const int e = u.aux, r0 = (u.pm - tb[e]) * 256; const float* wp = WPOS + (size_t)e * T + r0;
#pragma unroll
        for (int ai = 0; ai < 2; ++ai)
#pragma unroll
            for (int m = 0; m < 4; ++m) { const int tr = ai * 128 + wr * 64 + m * 16 + fr; const float w = wp[tr]; bf16* yp = Y + ((size_t)u.pm * 256 + tr) * D + u.pn * 256 + 32 * wc + 8 * fq;
#pragma unroll
                for (int bj = 0; bj < 2; ++bj) *(u32x4*)(yp + 128 * bj) = pg::pack8(acc[ai][bj][m][0] * w, acc[ai][bj][m][1] * w); }
    }
};
__device__ __forceinline__ void p11_combine(Frame& F, const Args& a, const LAS int* tb) {
    unsigned char* ws = a.ws; const int* ROUTE = (const int*)(ws + WS_ROUTE); const bf16* Y = (const bf16*)(ws + WS_Y); const bf16* X2B = (const bf16*)(ws + WS_X2B); float* out = a.out;
    for (int t = F.vcu * NWAVES + F.wave; t < T; t += F.G * NWAVES) {
        const int4 rt = *(const int4*)(ROUTE + t * 4);
        const GAS u32x2* y0 = (const GAS u32x2*)(Y + ((size_t)tb[rt.x] * 256 + rt.z) * D) + F.lane; const GAS u32x2* y1 = (const GAS u32x2*)(Y + ((size_t)tb[rt.y] * 256 + rt.w) * D) + F.lane;
        const GAS u32x2* xb = (const GAS u32x2*)(X2B + (size_t)t * D) + F.lane;
        GAS f32x4* o = (GAS f32x4*)(out + (size_t)t * D) + F.lane;
#pragma unroll
        for (int j = 0; j < 4; ++j) { const u32x2 a0 = y0[64 * j], a1 = y1[64 * j], xv = xb[64 * j]; f32x4 v;
            v[0] = __builtin_bit_cast(float, xv.x << 16) + (__builtin_bit_cast(float, a0.x << 16) + __builtin_bit_cast(float, a1.x << 16)); v[1] = __builtin_bit_cast(float, xv.x & 0xffff0000u) + (__builtin_bit_cast(float, a0.x & 0xffff0000u) + __builtin_bit_cast(float, a1.x & 0xffff0000u));
            v[2] = __builtin_bit_cast(float, xv.y << 16) + (__builtin_bit_cast(float, a0.y << 16) + __builtin_bit_cast(float, a1.y << 16)); v[3] = __builtin_bit_cast(float, xv.y & 0xffff0000u) + (__builtin_bit_cast(float, a0.y & 0xffff0000u) + __builtin_bit_cast(float, a1.y & 0xffff0000u));
            o[64 * j] = v; }
    }
}

struct PhSsmX {
    static constexpr bool GATHER = false;
    unsigned lda, ldb; const char* U2X; const char* M1T; float* SLOC; int g, b;
    __device__ __forceinline__ bool next(int i, pg::Unit& u) const { if (i >= 1) return false; u.A = U2X + ((size_t)(g * NCR + b * 256) * U2P + 128) * 2; u.B = M1T + (size_t)g * 256 * ldb; u.nt = 8; u.pm = b; u.pn = 0; u.aux = 0; return true; }
    __device__ __forceinline__ void offs(const pg::Unit&, const int (&R)[2], const int (&C)[2], unsigned (&vo)[2][2]) const { pg::offs_plain(lda, R, C, vo); }
    __device__ __forceinline__ void epi(const f32x4 (&acc)[2][2][4][2], const pg::Unit& u, int wr, int wc, int fr, int fq) const {
#pragma unroll
        for (int ai = 0; ai < 2; ++ai)
#pragma unroll
            for (int m = 0; m < 4; ++m) { float* p = SLOC + ((size_t)g * NCR + u.pm * 256 + ai * 128 + wr * 64 + m * 16 + fr) * 128 + 32 * wc + 8 * fq;
                *(f32x4*)p = acc[ai][0][m][0]; *(f32x4*)(p + 4) = acc[ai][0][m][1]; }
    }
};
__device__ __forceinline__ void ssm_scan(Frame& F, unsigned char* ws, int g, int b) {
    LAS f32x2* ends = (LAS f32x2*)F.lds;
    const int p = F.lane, w = F.wave;
    const float alr = ((const float*)(ws + WS_AL))[(g * NP + p) * 2], ali = ((const float*)(ws + WS_AL))[(g * NP + p) * 2 + 1];
    const float* sl = (const float*)(ws + WS_SLOC) + ((size_t)g * NCR + b * 256 + w * 32) * 128;
    float lr[32], li[32];
#pragma unroll
    for (int k = 0; k < 32; ++k) { lr[k] = sl[k * 128 + p]; li[k] = sl[k * 128 + 64 + p]; }
#pragma unroll
    for (int k = 1; k < 32; ++k) { const float nr = alr * lr[k - 1] - ali * li[k - 1] + lr[k], ni = alr * li[k - 1] + ali * lr[k - 1] + li[k]; lr[k] = nr; li[k] = ni; }
    ends[w * 64 + p] = (f32x2){lr[31], li[31]};
    float sr = alr, si = ali;
#pragma unroll
    for (int k = 0; k < 5; ++k) { const float t = sr * sr - si * si; si = 2.f * sr * si; sr = t; }
    __syncthreads();
    float cr = 0.f, ci = 0.f;
    for (int s2 = 0; s2 < w; ++s2) { const f32x2 e = ends[s2 * 64 + p]; const float t = sr * cr - si * ci + e.x; ci = sr * ci + si * cr + e.y; cr = t; }
    bf16* hp = (bf16*)(ws + WS_U2X) + ((size_t)g * NCR + b * 256 + w * 32) * U2P;
    float pr = cr, pi = ci;
#pragma unroll
    for (int k = 0; k < 32; ++k) { const float hr = (k ? lr[k - 1] : 0.f) + pr, hi = (k ? li[k - 1] : 0.f) + pi;
        hp[(size_t)k * U2P + p] = f2bf(hr); hp[(size_t)k * U2P + 64 + p] = f2bf(hi);
        const float t = alr * pr - ali * pi; pi = alr * pi + ali * pr; pr = t; }
    __syncthreads();
}
struct PhSsmY {
    static constexpr bool GATHER = false;
    unsigned lda, ldb; const char* U2Xp; const char* BTY; const bf16* U2X; const float* Dsk; bf16* Y1; int G, c;
    __device__ __forceinline__ bool next(int i, pg::Unit& u) const { const int L = i * G + c; if (L >= NG * 4) return false; const int g = L >> 2, mt = (L >> 1) & 1, nb = L & 1;
        u.A = U2Xp + (size_t)(g * NCR + mt * 256) * lda; u.B = BTY + (size_t)(g * 512 + nb * 256) * ldb; u.nt = nb ? 10 : 6; u.pm = mt; u.pn = nb; u.aux = g; return true; }
    __device__ __forceinline__ void offs(const pg::Unit&, const int (&R)[2], const int (&C)[2], unsigned (&vo)[2][2]) const { pg::offs_plain(lda, R, C, vo); }
    __device__ __forceinline__ void epi(const f32x4 (&acc)[2][2][4][2], const pg::Unit& u, int wr, int wc, int fr, int fq) const {
        const int g = u.aux;
#pragma unroll
        for (int bj = 0; bj < 2; ++bj) { const int n = u.pn * 256 + 128 * bj + 32 * wc + 8 * fq, j = n >> 4, c0 = n & 15;
            const f32x4 d0 = *(const f32x4*)(Dsk + g * GC + c0), d1 = *(const f32x4*)(Dsk + g * GC + c0 + 4);
#pragma unroll
            for (int ai = 0; ai < 2; ++ai)
#pragma unroll
                for (int m = 0; m < 4; ++m) { const int cr = u.pm * 256 + ai * 128 + wr * 64 + m * 16 + fr;
                    const u32x4 uv = *(const u32x4*)(U2X + ((size_t)g * NCR + cr) * U2P + 128 + j * GC + c0); f32x4 u0, u1; pg::unpack8(uv, u0, u1);
                    f32x4 a = acc[ai][bj][m][0] + d0 * u0, b = acc[ai][bj][m][1] + d1 * u1;
#pragma unroll
                    for (int q = 0; q < 4; ++q) { a[q] = gelu_fast(a[q]); b[q] = gelu_fast(b[q]); }
                    *(u32x4*)(Y1 + ((size_t)cr * LCH + j) * DS + g * GC + c0) = pg::pack8(a, b); } }
    }
};

__global__ void __launch_bounds__(NWAVES * 64, 2) mk_fwd(Args args) {
    extern __shared__ __attribute__((aligned(16))) unsigned char lds[];
    Frame F;
    F.lds = (LAS unsigned char*)lds; F.MISC = (volatile LAS unsigned*)(F.lds + MISC_OFF);
    F.tid = threadIdx.x; F.lane = F.tid & 63; F.wave = __builtin_amdgcn_readfirstlane(F.tid >> 6);
    F.G = gridDim.x; { const int bx = blockIdx.x; F.vcu = (F.G % 8 == 0) ? (bx % 8) * (F.G / 8) + bx / 8 : bx; }
    unsigned char* ws = args.ws; F.ctl = (gu32*)(ws + WS_CTL);
    for (int u = F.tid; u < (LDS_BYTES - LDSCTL_OFF) / 4; u += NWAVES * 64) ((LAS unsigned*)(F.lds + LDSCTL_OFF))[u] = 0u;
    __syncthreads();
    const int lo = args.ph_lo, hi = args.ph_hi;
    const bool multi = (hi - lo) > 1;
    XcdBarrier bar; bar.bar = (unsigned*)(F.ctl + CW_BAR); bar.x = 0; bar.st = nullptr;
    if (multi) bar = xcd_barrier_post((unsigned*)(F.ctl + CW_BAR), F.MISC + 8);
#define IN(k) (lo <= (k) && (k) < hi)
#define SEAM(k) do { if (IN(k) && IN((k) + 1)) xcd_barrier(bar); } while (0)
    if (IN(0)) { p0_prologue(F, args); SEAM(0); }
    if (IN(1)) {
        if (blockIdx.x < NBATCH * NH) p1_cumsum(F, (float*)(ws + WS_CUM));
        PhInProj ph; ph.lda = D * 2; ph.ldb = D * 2; ph.A = (const char*)(ws + WS_XN); ph.B = (const char*)(ws + WS_WIN); ph.so.init(T / 256, 4096 / 256, F.G, (int)blockIdx.x);
        ph.Q = (bf16*)(ws + WS_Q); ph.K = (bf16*)(ws + WS_K); ph.V = (bf16*)(ws + WS_V); ph.U2X = (bf16*)(ws + WS_U2X); ph.GA = (bf16*)(ws + WS_GA); ph.GS = (bf16*)(ws + WS_GS);
        ph.gq = args.in[4]; ph.gk = args.in[5];
        pg::gemm_phase(F.lds + RING_OFF, ph);
        SEAM(1);
    }
    if (IN(2)) {
        if (blockIdx.x < 2 * NG) {
            const int g = (int)blockIdx.x >> 1, b = (int)blockIdx.x & 1;
            PhSsmX ph; ph.lda = U2P * 2; ph.ldb = 512 * 2; ph.U2X = (const char*)(ws + WS_U2X); ph.M1T = (const char*)(ws + WS_M1T); ph.SLOC = (float*)(ws + WS_SLOC); ph.g = g; ph.b = b;
            if (args.sub & 1) pg::gemm_phase(F.lds + RING_OFF, ph);
            if (args.sub & 2) ssm_scan(F, ws, g, b);
            __syncthreads();
        }
        p2_expert_weights(F, args); SEAM(2);
    }
    if (IN(3)) {
        static_assert(attn_body::ATTN_LDS_BYTES <= RING_BYTES, "attention LDS");
        const attn_body::AttnTensors AT{(const attn_body::bf16*)(ws + WS_Q), (const attn_body::bf16*)(ws + WS_K), (const attn_body::bf16*)(ws + WS_V), (attn_body::bf16*)(ws + WS_Q), (const float*)(ws + WS_CUM)};
        const attn_body::StaticOrder S(F.vcu);
        attn_body::attn_phase<attn_body::StaticOrder, 20>((char*)lds + RING_OFF, AT, S);
        SEAM(3);
    }
    if (IN(4)) {
        PhSsmY ph; ph.lda = U2P * 2; ph.ldb = U2P * 2; ph.U2Xp = (const char*)(ws + WS_U2X); ph.BTY = (const char*)(ws + WS_BTY); ph.U2X = (const bf16*)(ws + WS_U2X); ph.Dsk = args.in[13]; ph.Y1 = (bf16*)(ws + WS_Y1); ph.G = F.G; ph.c = F.vcu;
        pg::gemm_phase(F.lds + RING_OFF, ph);
        SEAM(4);
    }
    if (IN(5)) {
        PhGlu ph; ph.lda = DS * 2; ph.ldb = DS * 2; ph.A = (const char*)(ws + WS_Y1); ph.B = (const char*)(ws + WS_WGLU); ph.so.init(T / 256, DS / 256, F.G, (int)blockIdx.x); ph.Y1 = (const bf16*)(ws + WS_Y1); ph.YS = (bf16*)(ws + WS_YS);
        pg::gemm_phase(F.lds + RING_OFF, ph);
        SEAM(5);
    }
    if (IN(6)) {
        PhProj ph; ph.lda = DA * 2; ph.ldb = DA * 2; ph.O = (const char*)(ws + WS_Q); ph.YSp = (const char*)(ws + WS_YS); ph.WPA = (const char*)(ws + WS_WPA); ph.WPS = (const char*)(ws + WS_WPS);
        ph.so.init(T / 256, D / 256, F.G, (int)blockIdx.x); ph.GA = (bf16*)(ws + WS_GA); ph.GS = (const bf16*)(ws + WS_GS);
        pg::gemm_phase(F.lds + RING_OFF, ph);
        SEAM(6);
    }
    if (IN(7)) {
        PhWout ph; ph.lda = D * 2; ph.ldb = D * 2; ph.A = (const char*)(ws + WS_GA); ph.B = (const char*)(ws + WS_WOUT); ph.so.init(T / 256, D / 256, F.G, (int)blockIdx.x);
        ph.x = args.in[0]; ph.out = args.out; ph.X2B = (bf16*)(ws + WS_X2B); ph.SSP = (float*)(ws + WS_SSP);
        pg::gemm_phase(F.lds + RING_OFF, ph);
        SEAM(7);
    }
    if (IN(8)) { p8_router(F, args); SEAM(8); }
    LAS int* tb = (LAS int*)(F.lds + LDSCTL_OFF + 512);
    if (IN(9)) {
        moe_table(F, (const int*)(ws + WS_CTL) + CW_CNT, tb);
        PhMoeGU ph; ph.lda = D * 2; ph.ldb = D * 2; ph.X = (const char*)(ws + WS_X2B); ph.W = (const char*)(ws + WS_WGU); ph.tb = tb; ph.LIST = (const int*)(ws + WS_LIST); ph.RPOS = (const float*)(ws + WS_RPOS);
        ph.H = (bf16*)(ws + WS_H); ph.G = F.G; ph.c = F.vcu;
        pg::gemm_phase(F.lds + RING_OFF, ph);
        SEAM(9);
    }
    if (IN(10)) {
        if (!IN(9)) moe_table(F, (const int*)(ws + WS_CTL) + CW_CNT, tb);
        PhMoeDown ph; ph.lda = DE * 2; ph.ldb = DE * 2; ph.Hp = (const char*)(ws + WS_H); ph.W = (const char*)(ws + WS_WD); ph.tb = tb; ph.WPOS = (const float*)(ws + WS_WPOS); ph.Y = (bf16*)(ws + WS_Y); ph.G = F.G; ph.c = F.vcu;
        pg::gemm_phase(F.lds + RING_OFF, ph);
        SEAM(10);
    }
    if (IN(11)) {
        if (!IN(10)) moe_table(F, (const int*)(ws + WS_CTL) + CW_CNT, tb);
        p11_combine(F, args, tb);
    }
#undef IN
#undef SEAM
}

extern "C" void kernel_launch(void* const* d_in, const int* in_sizes, int n_in, void* d_out, int out_size, void* d_ws, size_t ws_size, hipStream_t stream) {
    static int grid = 0;
    if (grid == 0) {
        int dev = 0, cus = 0; (void)hipGetDevice(&dev); (void)hipDeviceGetAttribute(&cus, hipDeviceAttributeMultiprocessorCount, dev);
        (void)hipFuncSetAttribute((const void*)mk_fwd, hipFuncAttributeMaxDynamicSharedMemorySize, LDS_BYTES);
        grid = cus > 0 ? cus : 256;
    }
    (void)hipMemsetAsync((char*)d_ws + WS_CTL, 0, CTL_ZERO_BYTES, stream);
    Args a{}; for (int i = 0; i < 26; ++i) a.in[i] = (const float*)d_in[i]; a.out = (float*)d_out; a.ws = (unsigned char*)d_ws;
    a.ph_lo = 0; a.ph_hi = 12; a.sub = 7;
    hipLaunchKernelGGL(mk_fwd, dim3(grid), dim3(NWAVES * 64), LDS_BYTES, stream, a);
}
```

```cpp
#include <hip/hip_runtime.h>
#include <stdint.h>
#include <math.h>

typedef unsigned short bf16;
constexpr int T = 16384, D = 1024, SEQ = 8192, NBATCH = 2, NH = 8, HD = 64, DA = 512, DS = 512, NG = 32, GC = 16, NP = 64, NE = 32, DE = 256;
constexpr int DIN = 4104, OQ = 0, OK_ = 512, OV = 1024, OF = 1536, OU = 1544, OGA = 2056, OGS = 3080;
constexpr int LCH = 32, NCR = T / LCH;
constexpr int U2P = 640;
constexpr float EPS = 1e-6f;
constexpr float C2 = 0.125f * 1.4426950408889634f;
constexpr float LOG2E = 1.4426950408889634f;
constexpr int YROWS = 40960;

constexpr size_t MiB = 1u << 20;
constexpr size_t WS_CTL = 0, CTL_ZERO_BYTES = 1 * MiB;
constexpr size_t WS_CUM = 1 * MiB;
constexpr size_t WS_AL = 1 * MiB + 512 * 1024;
constexpr size_t WS_RSTD = 2 * MiB;
constexpr size_t WS_ROUTE = 2 * MiB + 256 * 1024;
constexpr size_t WS_LIST = 3 * MiB;
constexpr size_t WS_WPOS = 5 * MiB;
constexpr size_t WS_SSP = 7 * MiB;
constexpr size_t WS_WIN = 8 * MiB;
constexpr size_t WS_SLOC = 229 * MiB;
constexpr size_t WS_WGLU = 16 * MiB, WS_WPA = 16 * MiB + 512 * 1024, WS_WPS = 17 * MiB + 512 * 1024, WS_WOUT = 18 * MiB + 512 * 1024, WS_WR = 20 * MiB + 512 * 1024;
constexpr size_t WS_M1T = 21 * MiB;
constexpr size_t WS_BTY = 29 * MiB;
constexpr size_t WS_XN = 49 * MiB;
constexpr size_t WS_WGU = 49 * MiB;
constexpr size_t WS_Q = 81 * MiB;
constexpr size_t WS_K = 97 * MiB;
constexpr size_t WS_V = 113 * MiB;
constexpr size_t WS_Y1 = 97 * MiB, WS_YS = 113 * MiB;
constexpr size_t WS_U2X = 129 * MiB;
constexpr size_t WS_GA = 149 * MiB;
constexpr size_t WS_GS = 181 * MiB;
constexpr size_t WS_X2B = 181 * MiB;
constexpr size_t WS_WD = 213 * MiB;
constexpr size_t WS_H = 229 * MiB;
constexpr size_t WS_RPOS = 249 * MiB;
constexpr size_t WS_KTG = 251 * MiB;
constexpr size_t WS_Y = 81 * MiB;
static_assert(WS_H + (size_t)YROWS * DE * 2 <= WS_RPOS && WS_RPOS + 2 * MiB <= WS_KTG && WS_KTG + MiB <= 256 * MiB && WS_Y + (size_t)YROWS * D * 2 <= WS_GS, "d_ws map");

__device__ __forceinline__ bf16 f2bf(float f) { unsigned u = __builtin_bit_cast(unsigned, f); return (bf16)((u + 0x7fffu + ((u >> 16) & 1u)) >> 16); }
__device__ __forceinline__ float bf2f(bf16 b) { return __builtin_bit_cast(float, (unsigned)b << 16); }
__device__ __forceinline__ float sigmoidf_(float x) { return 1.f / (1.f + __expf(-x)); }
__device__ __forceinline__ float gelu_tanh(float x) { const float z = 0.7978845608028654f * (x + 0.044715f * x * x * x); const float e = __expf(2.f * z); return 0.5f * x * (1.f + (1.f - 2.f / (e + 1.f))); }
__device__ __forceinline__ float log_sigmoid(float x) { return -(fmaxf(-x, 0.f) + log1pf(__expf(-fabsf(x)))); }
__device__ __forceinline__ size_t u2x_index(int g, int t, int c) { return ((size_t)g * NCR + (t / LCH)) * U2P + 128 + (t % LCH) * GC + c; }

#define LAS __attribute__((address_space(3)))
#define GAS __attribute__((address_space(1)))
typedef short bf16x8 __attribute__((ext_vector_type(8)));
typedef float f32x4 __attribute__((ext_vector_type(4)));
typedef float f32x2 __attribute__((ext_vector_type(2)));
typedef unsigned u32x4 __attribute__((ext_vector_type(4)));
typedef unsigned u32x2 __attribute__((ext_vector_type(2)));
namespace pg {
constexpr int BM = 256, BK = 64, HALF = 128, HTB = HALF * BK * 2, STAGE_BYTES = 8 * HTB, NXCD = 8, WGM = 8;
__host__ __device__ __forceinline__ int lds_byte(int r, int c) { const int st = (r >> 4) * 2 + (c >> 5), rr = r & 15, cc = c & 31, ob = rr * 64 + cc * 2; return st * 1024 + (ob ^ (((ob >> 9) & 1) << 5)); }
__host__ __device__ __forceinline__ void stage_rc(int b, int& R, int& C) { const int st = b / 1024, sb = b % 1024, swz = sb ^ (((sb >> 9) & 1) << 5); R = (st >> 1) * 16 + swz / 64; C = (st & 1) * 32 + (swz % 64) / 2; }
__host__ __device__ __forceinline__ int perm32(int rho) { const int n = rho >> 4, i = rho & 15; return 8 * (i >> 2) + 4 * n + (i & 3); }
typedef __bf16 bf16x2_t __attribute__((ext_vector_type(2)));
__device__ __forceinline__ unsigned cvt_pk_bf16(float lo, float hi) { const f32x2 v = {lo, hi}; const bf16x2_t b = __builtin_convertvector(v, bf16x2_t); return __builtin_bit_cast(unsigned, b); }
__device__ __forceinline__ u32x4 pack8(const f32x4& a, const f32x4& b) { u32x4 w; w.x = cvt_pk_bf16(a[0], a[1]); w.y = cvt_pk_bf16(a[2], a[3]); w.z = cvt_pk_bf16(b[0], b[1]); w.w = cvt_pk_bf16(b[2], b[3]); return w; }
__device__ __forceinline__ void unpack8(const u32x4& w, f32x4& a, f32x4& b) {
    a[0] = __builtin_bit_cast(float, w.x << 16); a[1] = __builtin_bit_cast(float, w.x & 0xffff0000u); a[2] = __builtin_bit_cast(float, w.y << 16); a[3] = __builtin_bit_cast(float, w.y & 0xffff0000u);
    b[0] = __builtin_bit_cast(float, w.z << 16); b[1] = __builtin_bit_cast(float, w.z & 0xffff0000u); b[2] = __builtin_bit_cast(float, w.w << 16); b[3] = __builtin_bit_cast(float, w.w & 0xffff0000u); }
__device__ __forceinline__ float fsigmoid(float x) { return __builtin_amdgcn_rcpf(1.f + __builtin_amdgcn_exp2f(-1.4426950408889634f * x)); }

struct Unit { const char* A; const char* B; int nt; int pm, pn, aux; };

struct StaticOrder {
    int nM, nN, nwg, G, c;
    __device__ void init(int nM_, int nN_, int G_, int c_) { nM = nM_; nN = nN_; nwg = nM * nN; G = G_; c = c_; }
    __device__ bool next(int i, int& pm, int& pn) const {
        const long L = (long)i * G + c; if (L >= nwg) return false;
        int wgid = (int)L; { const int q = nwg / NXCD, r = nwg % NXCD, xcd = wgid % NXCD, off = wgid / NXCD; wgid = (xcd < r ? xcd * (q + 1) : r * (q + 1) + (xcd - r) * q) + off; }
        const int nig = WGM * nN, gid = wgid / nig, fm = gid * WGM, gsz = (nM - fm) < WGM ? (nM - fm) : WGM;
        pm = fm + ((wgid % nig) % gsz); pn = (wgid % nig) / gsz; return true;
    }
};

template <class P>
__device__ __forceinline__ void gemm_phase(LAS unsigned char* lds, P& ph) {
    const int tid = threadIdx.x, wid = __builtin_amdgcn_readfirstlane(tid >> 6), lane = tid & 63, wr = wid >> 2, wc = wid & 3, fr = lane & 15, fq = lane >> 4;
    const unsigned lda = ph.lda, ldb = ph.ldb;
    int Rr[2], Cc[2]; unsigned voffB[2], vo[2][2], nvo[2][2];
#pragma unroll
    for (int i = 0; i < 2; ++i) { stage_rc(tid * 16 + i * 8192, Rr[i], Cc[i]); const int Rb = (Rr[i] & ~31) + perm32(Rr[i] & 31); voffB[i] = (unsigned)Rb * ldb + (unsigned)Cc[i] * 2u; }
    const size_t kstep = (size_t)(BK * 2);
    const size_t hstepB = (size_t)HALF * ldb;
    const unsigned ldsw = (unsigned)wid * 1024u;
    const int aoff = lds_byte(wr * 64 + fr, fq * 8), boff = lds_byte(wc * 32 + fr, fq * 8);
#define PG_SA(b, h) (((b) * 2 + (h)) * HTB)
#define PG_SB(b, h) ((4 + (b) * 2 + (h)) * HTB)
#define PG_STAGE_B(bufoff, gbase) do { _Pragma("unroll") for (int _i = 0; _i < 2; ++_i) \
        __builtin_amdgcn_global_load_lds((const unsigned*)((const char*)(gbase) + voffB[_i]), (LAS unsigned*)(lds + (bufoff) + ldsw + _i * 8192), 16, 0, 0); } while (0)
#define PG_STAGE_A(bufoff, gbase, VO, h) do { _Pragma("unroll") for (int _i = 0; _i < 2; ++_i) \
        __builtin_amdgcn_global_load_lds((const unsigned*)((const char*)(gbase) + (VO)[h][_i]), (LAS unsigned*)(lds + (bufoff) + ldsw + _i * 8192), 16, 0, 0); } while (0)
#define PG_LDA(dst, b, h) do { _Pragma("unroll") for (int m = 0; m < 4; ++m) _Pragma("unroll") for (int k = 0; k < 2; ++k) dst[m][k] = *(const LAS bf16x8*)(lds + PG_SA(b, h) + aoff + m * 2048 + k * 1024); } while (0)
#define PG_LDB(dst, b, h) do { _Pragma("unroll") for (int n = 0; n < 2; ++n) _Pragma("unroll") for (int k = 0; k < 2; ++k) dst[n][k] = *(const LAS bf16x8*)(lds + PG_SB(b, h) + boff + n * 2048 + k * 1024); } while (0)
#define PG_MMA(ai, bj, At, Bt) do { __builtin_amdgcn_s_setprio(1); _Pragma("unroll") for (int m = 0; m < 4; ++m) _Pragma("unroll") for (int n = 0; n < 2; ++n) _Pragma("unroll") for (int k = 0; k < 2; ++k) \
        acc[ai][bj][m][n] = __builtin_amdgcn_mfma_f32_16x16x32_bf16(Bt[n][k], At[m][k], acc[ai][bj][m][n], 0, 0, 0); __builtin_amdgcn_s_setprio(0); } while (0)
#define PG_WAIT_V(n) asm volatile("s_waitcnt vmcnt(" #n ")" ::: "memory")
#define PG_WAIT_L(n) asm volatile("s_waitcnt lgkmcnt(" #n ")" ::: "memory")
#define PG_BAR __builtin_amdgcn_s_barrier()
#define PG_SCHED __builtin_amdgcn_sched_barrier(0)
    Unit cur, nxt; int ui = 0;
    if (!ph.next(0, cur)) return;
    ph.offs(cur, Rr, Cc, vo);
    f32x4 acc[2][2][4][2];
#pragma unroll
    for (int a = 0; a < 2; ++a)
#pragma unroll
        for (int b = 0; b < 2; ++b)
#pragma unroll
            for (int m = 0; m < 4; ++m)
#pragma unroll
                for (int n = 0; n < 2; ++n) acc[a][b][m][n] = (f32x4){0.f, 0.f, 0.f, 0.f};
    bf16x8 At[4][2], B0[2][2], B1[2][2];
    const char* cA = cur.A; const char* cB = cur.B;
    PG_STAGE_B(PG_SB(0, 0), cB); PG_STAGE_B(PG_SB(0, 1), cB + hstepB); PG_STAGE_A(PG_SA(0, 0), cA, vo, 0); PG_STAGE_A(PG_SA(0, 1), cA, vo, 1);
    if (wr == 1) PG_BAR;
    PG_WAIT_V(2); PG_BAR;
    PG_STAGE_B(PG_SB(1, 0), cB + kstep); PG_STAGE_A(PG_SA(1, 0), cA + kstep, vo, 0); PG_STAGE_B(PG_SB(1, 1), cB + hstepB + kstep);
    PG_WAIT_V(6); PG_BAR;
    for (;;) {
        const bool has_next = ph.next(ui + 1, nxt);
        const int nt = cur.nt;
        const char* nA = has_next ? nxt.A : cA; const char* nB = has_next ? nxt.B : cB;
        if (P::GATHER) { if (has_next) ph.offs(nxt, Rr, Cc, nvo); else {
#pragma unroll
            for (int h = 0; h < 2; ++h)
#pragma unroll
                for (int i = 0; i < 2; ++i) nvo[h][i] = vo[h][i]; } }
#pragma unroll 1
        for (int t = 0; t < nt; t += 2) {
            const bool last = (t == nt - 2);
            const char* a1 = cA + (size_t)(t + 1) * kstep;
            const char* a2 = last ? nA : cA + (size_t)(t + 2) * kstep; const char* b2 = last ? nB : cB + (size_t)(t + 2) * kstep;
            const char* a3 = a2 + kstep; const char* b3 = b2 + kstep;
            unsigned v2[2][2];
#pragma unroll
            for (int h = 0; h < 2; ++h)
#pragma unroll
                for (int i = 0; i < 2; ++i) v2[h][i] = (P::GATHER && last) ? nvo[h][i] : vo[h][i];
            PG_LDB(B0, 0, 0); PG_LDB(B1, 0, 1); PG_SCHED; PG_LDA(At, 0, 0); PG_STAGE_A(PG_SA(1, 1), a1, vo, 1);
            PG_WAIT_V(8); PG_WAIT_L(0); PG_BAR; PG_MMA(0, 0, At, B0); PG_MMA(0, 1, At, B1); PG_BAR; PG_SCHED;
            PG_LDA(At, 0, 1); PG_STAGE_B(PG_SB(0, 0), b2); PG_STAGE_B(PG_SB(0, 1), b2 + hstepB); PG_STAGE_A(PG_SA(0, 0), a2, v2, 0);
            PG_WAIT_V(8); PG_WAIT_L(0); PG_BAR; PG_MMA(1, 0, At, B0); PG_MMA(1, 1, At, B1); PG_BAR; PG_SCHED;
            PG_LDB(B0, 1, 0); PG_LDB(B1, 1, 1); PG_SCHED; PG_LDA(At, 1, 0); PG_STAGE_A(PG_SA(0, 1), a2, v2, 1);
            PG_WAIT_V(8); PG_WAIT_L(0); PG_BAR; PG_MMA(0, 0, At, B0); PG_MMA(0, 1, At, B1); PG_BAR; PG_SCHED;
            PG_LDA(At, 1, 1); PG_STAGE_B(PG_SB(1, 0), b3); PG_STAGE_B(PG_SB(1, 1), b3 + hstepB); PG_STAGE_A(PG_SA(1, 0), a3, v2, 0);
            PG_WAIT_V(8); PG_WAIT_L(0); PG_BAR; PG_MMA(1, 0, At, B0); PG_MMA(1, 1, At, B1); PG_BAR; PG_SCHED;
        }
        if (wr == 0) PG_BAR;
        ph.epi(acc, cur, wr, wc, fr, fq);
        if (!has_next) break;
#pragma unroll
        for (int a = 0; a < 2; ++a)
#pragma unroll
            for (int b = 0; b < 2; ++b)
#pragma unroll
                for (int m = 0; m < 4; ++m)
#pragma unroll
                    for (int n = 0; n < 2; ++n) acc[a][b][m][n] = (f32x4){0.f, 0.f, 0.f, 0.f};
        cur = nxt; cA = nA; cB = nB; ++ui;
        if (P::GATHER) {
#pragma unroll
            for (int h = 0; h < 2; ++h)
#pragma unroll
                for (int i = 0; i < 2; ++i) vo[h][i] = nvo[h][i]; }
        if (wr == 1) PG_BAR;
    }
    PG_WAIT_V(0);
    PG_BAR;
#undef PG_SA
#undef PG_SB
#undef PG_STAGE_A
#undef PG_STAGE_B
#undef PG_LDA
#undef PG_LDB
#undef PG_MMA
#undef PG_WAIT_V
#undef PG_WAIT_L
#undef PG_BAR
#undef PG_SCHED
}
__device__ __forceinline__ void offs_plain(unsigned lda, const int (&R)[2], const int (&C)[2], unsigned (&vo)[2][2]) {
#pragma unroll
    for (int h = 0; h < 2; ++h)
#pragma unroll
        for (int i = 0; i < 2; ++i) vo[h][i] = (unsigned)(h * HALF + R[i]) * lda + (unsigned)C[i] * 2u;
}
}

namespace attn_body {
using bf16=unsigned short;
using bf16x8=__attribute__((ext_vector_type(8)))short;
using s16x4=__attribute__((ext_vector_type(4)))short;
using f32x16=__attribute__((ext_vector_type(16)))float;
using u32x4=__attribute__((ext_vector_type(4)))unsigned;
constexpr int BATCH=2,NHEAD=8,SEQ=8192,D=64,DM=NHEAD*D;
constexpr int NW=8,QBLK=32,QB=QBLK*NW,KVBLK=64,NQB=SEQ/QB;
constexpr int ATTN_PITCH=DM, ATTN_UNIT_ROWS=QB;
__device__ __forceinline__ int crow(int r,int hi){return (r&3)+8*(r>>2)+4*hi;}
__device__ __forceinline__ unsigned short f2bf_a(float f){unsigned u=__builtin_bit_cast(unsigned,f);return (unsigned short)((u+0x7fffu+((u>>16)&1u))>>16);}
#define SBAR() __builtin_amdgcn_sched_barrier(0)
__device__ __forceinline__ void cmask(f32x16&p0,f32x16&p1,int jb,int qrel,int hi){
  const float NEG=-INFINITY; int kb=64*jb+4*hi;
  #pragma unroll
  for(int r=0;r<16;++r){int kv=kb+(r&3)+8*(r>>2); if(kv>qrel)p0[r]=NEG; if(kv+32>qrel)p1[r]=NEG;}
}

constexpr int NSLOT=3, SLOTB=8192;
constexpr int LDS_K=0, LDS_V=NSLOT*SLOTB, LDS_WS=2*NSLOT*SLOTB, LDS_OST=LDS_WS+NW*64*4, LDS_FK=LDS_OST+NW*4096, LDS_BYTES=LDS_FK+SEQ*4+1024;
constexpr float C2=0.125f*1.4426950408889634f;
__device__ __forceinline__ void glds16(const void*gsrc,unsigned lds_dst){unsigned keep;
  asm volatile("s_mov_b32 %0, m0\n\ts_mov_b32 m0, %2\n\ts_nop 0\n\tglobal_load_lds_dwordx4 %1, off\n\ts_mov_b32 m0, %0":"=&s"(keep):"v"(gsrc),"s"(lds_dst):"memory");}
__device__ __forceinline__ float max3f(float a,float b,float c){float r;asm("v_max3_f32 %0, %1, %2, %3":"=v"(r):"v"(a),"v"(b),"v"(c));return r;}
__device__ __forceinline__ float max2f(float a,float b){float r;asm("v_max_f32_e32 %0, %1, %2":"=v"(r):"v"(a),"v"(b));return r;}
__device__ __forceinline__ float fadd_s(float a,float b){float r;asm("v_add_f32_e32 %0, %1, %2":"=v"(r):"v"(a),"v"(b));return r;}
__device__ __forceinline__ float fsub_s(float a,float b){float r;asm("v_sub_f32_e32 %0, %1, %2":"=v"(r):"v"(a),"v"(b));return r;}
typedef float f32x4_t __attribute__((ext_vector_type(4)));
typedef float f32x2_t __attribute__((ext_vector_type(2))); typedef __bf16 bf16x2_t __attribute__((ext_vector_type(2)));
__device__ __forceinline__ unsigned cvtpk_s(float lo,float hi){f32x2_t v={lo,hi};bf16x2_t b=__builtin_convertvector(v,bf16x2_t);return __builtin_bit_cast(unsigned,b);}
#define WAIT_BAR(N) asm volatile("s_waitcnt vmcnt(" #N ") lgkmcnt(0)\n\ts_barrier":::"memory")

__device__ __forceinline__ void qkt(f32x16&p0,f32x16&p1,const char*Kslot,const bf16x8*qr,int r32,int hi){
  const char*kb=Kslot+hi*1024+r32*16;
  #pragma unroll
  for(int d0=0;d0<4;++d0){
    const bf16x8 b0=*reinterpret_cast<const bf16x8*>(kb+d0*2048);
    const bf16x8 b1=*reinterpret_cast<const bf16x8*>(kb+d0*2048+512);
    p0=__builtin_amdgcn_mfma_f32_32x32x16_bf16(b0,qr[d0],p0,0,0,0);p1=__builtin_amdgcn_mfma_f32_32x32x16_bf16(b1,qr[d0],p1,0,0,0);}
}
typedef __attribute__((address_space(3))) const char* lds_cptr;
typedef short v4i16_t __attribute__((ext_vector_type(4)));
__device__ __forceinline__ void kload8(bf16x8*kf,lds_cptr kp){
  kf[0]=*(const __attribute__((address_space(3))) bf16x8*)(kp);      kf[1]=*(const __attribute__((address_space(3))) bf16x8*)(kp+512);
  kf[2]=*(const __attribute__((address_space(3))) bf16x8*)(kp+2048); kf[3]=*(const __attribute__((address_space(3))) bf16x8*)(kp+2560);
  kf[4]=*(const __attribute__((address_space(3))) bf16x8*)(kp+4096); kf[5]=*(const __attribute__((address_space(3))) bf16x8*)(kp+4608);
  kf[6]=*(const __attribute__((address_space(3))) bf16x8*)(kp+6144); kf[7]=*(const __attribute__((address_space(3))) bf16x8*)(kp+6656);
}
__device__ __forceinline__ void kload2(bf16x8*kf,lds_cptr kp,int j){ kf[2*j]=*(const __attribute__((address_space(3))) bf16x8*)(kp+j*2048); kf[2*j+1]=*(const __attribute__((address_space(3))) bf16x8*)(kp+j*2048+512); }
__device__ __forceinline__ s16x4 vtr(lds_cptr p){ return __builtin_bit_cast(s16x4,__builtin_amdgcn_ds_read_tr16_b64_v4i16((__attribute__((address_space(3))) v4i16_t*)p)); }
__device__ __forceinline__ float rowmax(const f32x16&p0,const f32x16&p1){
  float a=max3f(p0[0],p0[1],p1[0]),b=max3f(p0[2],p0[3],p1[1]);a=max3f(a,p1[2],p1[3]);
  #pragma unroll
  for(int r=4;r<16;r+=4){a=max3f(a,p0[r],p0[r+1]);b=max3f(b,p0[r+2],p0[r+3]);a=max3f(a,p1[r],p1[r+1]);b=max3f(b,p1[r+2],p1[r+3]);}
  const float m=max2f(a,b);
  auto rr=__builtin_amdgcn_permlane32_swap(__float_as_uint(m),__float_as_uint(m),false,false);
  return max2f(__uint_as_float(rr[0]),__uint_as_float(rr[1]));
}
__device__ __forceinline__ void pv(f32x16*o,int vb,bf16x8 pa0,bf16x8 pa1,bf16x8 pa2,bf16x8 pa3){
  #pragma unroll
  for(int d0=0;d0<2;++d0){s16x4 lo[4],hi[4];
    #pragma unroll
    for(int ks=0;ks<4;++ks){
      asm volatile("ds_read_b64_tr_b16 %0,%1 offset:%c2":"=&v"(lo[ks]):"v"(vb),"i"(d0*4096+ks*1024):"memory");
      asm volatile("ds_read_b64_tr_b16 %0,%1 offset:%c2":"=&v"(hi[ks]):"v"(vb),"i"(d0*4096+ks*1024+512):"memory");}
    asm volatile("s_waitcnt lgkmcnt(0)":::"memory");SBAR();
    #define PK(k) (bf16x8){lo[k][0],lo[k][1],lo[k][2],lo[k][3],hi[k][0],hi[k][1],hi[k][2],hi[k][3]}
    o[d0]=__builtin_amdgcn_mfma_f32_32x32x16_bf16(pa0,PK(0),o[d0],0,0,0);
    o[d0]=__builtin_amdgcn_mfma_f32_32x32x16_bf16(pa1,PK(1),o[d0],0,0,0);
    o[d0]=__builtin_amdgcn_mfma_f32_32x32x16_bf16(pa2,PK(2),o[d0],0,0,0);
    o[d0]=__builtin_amdgcn_mfma_f32_32x32x16_bf16(pa3,PK(3),o[d0],0,0,0);
    #undef PK
  }
}

#ifndef ATTN_STORE16
#define ATTN_STORE16(p,v) (*(u32x4*)(p)=(v))
#endif
template<int THRL> __device__ __forceinline__ void attn_unit(int b,int h,int qb,const bf16*Q,const bf16*__restrict__ K,const bf16*__restrict__ V,bf16*O,const float*__restrict__ CUM,char*shm){
  const int tid=threadIdx.x,lane=tid&63,r32=lane&31,hi=lane>>5; const int wid=__builtin_amdgcn_readfirstlane(tid>>6);
  const long rowbase=(long)b*SEQ; const int q0=qb*QB;
  const bf16*Qw=Q+(rowbase+q0+wid*QBLK)*DM+h*D;
  const bf16*Kh=K+rowbase*DM+h*D,*Vh=V+rowbase*DM+h*D; const float*Fh=CUM+((long)b*NHEAD+h)*SEQ;
  const unsigned lds0=(unsigned)(uintptr_t)shm;
  float*wsf=(float*)(shm+LDS_WS)+wid*64;
  const bf16*ksrc=Kh+(long)lane*DM+wid*8;
  const bf16*vsrc=Vh+(long)(16*(wid&3)+(lane>>2))*DM+(wid>>2)*32+(lane&3)*8;
  const unsigned kdst=lds0+LDS_K+wid*1024, vdst=lds0+LDS_V+wid*1024;
  #define DMA_K(t,slot) glds16(ksrc+(long)(t)*KVBLK*DM,(unsigned)__builtin_amdgcn_readfirstlane(kdst+(slot)))
  #define DMA_V(t,slot) glds16(vsrc+(long)(t)*KVBLK*DM,(unsigned)__builtin_amdgcn_readfirstlane(vdst+(slot)))
  const int vb0=(int)(lds0+LDS_V)+((lane>>4)&1)*32+(lane&3)*8+(4*hi+((lane&15)>>2))*64;
  const char*Kbase=shm+LDS_K; bf16x8 kf[8];
  const lds_cptr shm3=(lds_cptr)shm; const lds_cptr kp0=shm3+LDS_K+hi*1024+r32*16; const lds_cptr vp0=shm3+LDS_V+((lane>>4)&1)*32+(lane&3)*8+(4*hi+((lane&15)>>2))*64;
  const int NT=(q0+QB)/KVBLK;
  for(int p_=wid;p_<=qb;p_+=NW) glds16(Fh+p_*256+lane*4,(unsigned)__builtin_amdgcn_readfirstlane(lds0+LDS_FK+p_*1024));
  DMA_K(0,0);DMA_V(0,0);DMA_K(1,SLOTB);
  bf16x8 qr[4];
  #pragma unroll
  for(int d0=0;d0<4;++d0)qr[d0]=*reinterpret_cast<const bf16x8*>(&Qw[(long)r32*DM+d0*16+hi*8]);
  const float fq2=Fh[q0+wid*QBLK+r32];
  float mhat=0.f,l_reg=0.f;f32x16 o[2];o[0]=f32x16{};o[1]=f32x16{};float nb=fq2;
  const lds_cptr fkp=(lds_cptr)shm+LDS_FK+hi*16;
  const int qrel=wid*QBLK+r32;
  #define CMASK(P0,P1,t) do{int jb_=(t)-(NT-4); if(jb_>=0)cmask(P0,P1,jb_,qrel,hi);}while(0)
  bool resc=false;
  #define START(P0,P1) do{ const float rm=rowmax(P0,P1); resc=false; \
    { const float dl=rm; mhat=fadd_s(mhat,dl); \
      _Pragma("unroll") for(int r=0;r<16;++r){P0[r]=fsub_s(P0[r],dl);P1[r]=fsub_s(P1[r],dl);} \
      nb=fsub_s(fq2,mhat); } \
    _Pragma("unroll") for(int r=0;r<16;++r)P0[r]=__builtin_amdgcn_exp2f(P0[r]); }while(0)
  #define RESC() do{ if(resc){ asm volatile("s_waitcnt lgkmcnt(0)":::"memory"); \
      _Pragma("unroll") for(int d_=0;d_<2;++d_) _Pragma("unroll") for(int r=0;r<16;++r)o[d_][r]*=wsf[crow(r,hi)]; } }while(0)
  #define FILLC(C0_,C1_,tt) do{ const lds_cptr f_=fkp+(tt)*256; _Pragma("unroll") for(int a_=0;a_<4;++a_){ const f32x4_t x0_=*(const __attribute__((address_space(3))) f32x4_t*)(f_+32*a_); const f32x4_t x1_=*(const __attribute__((address_space(3))) f32x4_t*)(f_+128+32*a_); \
      _Pragma("unroll") for(int i_=0;i_<4;++i_){ C0_[4*a_+i_]=nb-x0_[i_]; C1_[4*a_+i_]=nb-x1_[i_]; } } }while(0)
  f32x16 pA0,pA1,pB0,pB1;
  int sl_prev=0,sl_cur=0,sl_next=SLOTB;
  #define ROT() do{sl_prev=sl_cur;sl_cur=sl_next;sl_next=(sl_next==(NSLOT-1)*SLOTB)?0:sl_next+SLOTB;}while(0)
  DMA_K(2,2*SLOTB);
  WAIT_BAR(3);
  FILLC(pA0,pA1,0);
  qkt(pA0,pA1,Kbase,qr,r32,hi);asm volatile("s_nop 15\n\ts_nop 7":"+v"(pA0),"+v"(pA1));CMASK(pA0,pA1,0);
  START(pA0,pA1);
  _Pragma("unroll") for(int r=0;r<16;++r)pA1[r]=__builtin_amdgcn_exp2f(pA1[r]);
  WAIT_BAR(0);
  DMA_K(3,0);DMA_V(1,SLOTB);
  ROT();
  FILLC(pB0,pB1,1);
  kload8(kf,kp0+sl_cur);
  WAIT_BAR(2);
  s16x4 vlo[8],vhi[8]; u32x4 pw0,pw1,pw2,pw3;
  #define PKW(P,B) cvtpk_s(P[B],P[B+1])
  #define PAF(k) __builtin_bit_cast(bf16x8,pw##k)
  #define VFR(i) (bf16x8){vlo[i][0],vlo[i][1],vlo[i][2],vlo[i][3],vhi[i][0],vhi[i][1],vhi[i][2],vhi[i][3]}
  #define PIN(x) asm volatile("":"+v"(x))
  #define MX3(a,b,c) __builtin_fmaxf(__builtin_fmaxf((a),(b)),(c))
  #define GAPA(MF,A0,A1,A2,A3,W0,W1,PW) do{ MF; sacc+=A0; sacc+=A1; sacc+=A2; sacc+=A3; PIN(sacc); W0; W1; PIN(PW); SBAR(); }while(0)
  #define EX(v) __builtin_amdgcn_exp2f(v)
  #define FLD(off) (*(const __attribute__((address_space(3))) f32x4_t*)(fk_+(off)))
  #define GAPB(MF,X,B,PF,FC,FN,NOFF) do{ MF; X[B]=EX(X[B]); X[B+1]=EX(X[B+1]); X[B+2]=EX(X[B+2]); X[B+3]=EX(X[B+3]); PF[B]=nb-FC[0]; PF[B+1]=nb-FC[1]; PF[B+2]=nb-FC[2]; PF[B+3]=nb-FC[3]; FN=FLD(NOFF); PIN(X); PIN(PF); SBAR(); }while(0)
  #define VRD(i) do{ vlo[i]=vtr(vp_+(((i)>>2)*4096+((i)&3)*1024)); vhi[i]=vtr(vp_+(((i)>>2)*4096+((i)&3)*1024+512)); }while(0)
  #define KRD(G,j) do{ if(G){ kload2(kf,kp0+sl_next,j); SBAR(); } }while(0)
  #define STEP(C0,C1,P0,P1,t,GK,GV,GL) do{ SBAR(); \
    const lds_cptr vp_=vp0+sl_prev; \
    VRD(0); SBAR(); float sacc=(P0[0]+P0[1]); \
    GAPA(C0=__builtin_amdgcn_mfma_f32_32x32x16_bf16(kf[0],qr[0],C0,0,0,0), P0[2],P0[3],P0[4],P0[5],     pw0[0]=PKW(P0,0), pw0[1]=PKW(P0,2), pw0); \
    VRD(4); SBAR(); GAPA(C1=__builtin_amdgcn_mfma_f32_32x32x16_bf16(kf[1],qr[0],C1,0,0,0), P0[6],P0[7],P0[8],P0[9],     pw0[2]=PKW(P0,4), pw0[3]=PKW(P0,6), pw0); \
    VRD(1); SBAR(); GAPA(C0=__builtin_amdgcn_mfma_f32_32x32x16_bf16(kf[2],qr[1],C0,0,0,0),   P0[10],P0[11],P0[12],P0[13], pw1[0]=PKW(P0,8), pw1[1]=PKW(P0,10), pw1); \
    VRD(5); SBAR(); GAPA(C1=__builtin_amdgcn_mfma_f32_32x32x16_bf16(kf[3],qr[1],C1,0,0,0),   P0[14],P0[15],P1[0],P1[1],   pw1[2]=PKW(P0,12),pw1[3]=PKW(P0,14), pw1); \
    VRD(2); SBAR(); GAPA(C0=__builtin_amdgcn_mfma_f32_32x32x16_bf16(kf[4],qr[2],C0,0,0,0),   P1[2],P1[3],P1[4],P1[5],     pw2[0]=PKW(P1,0), pw2[1]=PKW(P1,2), pw2); \
    VRD(6); SBAR(); GAPA(C1=__builtin_amdgcn_mfma_f32_32x32x16_bf16(kf[5],qr[2],C1,0,0,0),   P1[6],P1[7],P1[8],P1[9],     pw2[2]=PKW(P1,4), pw2[3]=PKW(P1,6), pw2); \
    VRD(3); SBAR(); GAPA(C0=__builtin_amdgcn_mfma_f32_32x32x16_bf16(kf[6],qr[3],C0,0,0,0),   P1[10],P1[11],P1[12],P1[13], pw3[0]=PKW(P1,8), pw3[1]=PKW(P1,10), pw3); \
    VRD(7); SBAR(); GAPA(C1=__builtin_amdgcn_mfma_f32_32x32x16_bf16(kf[7],qr[3],C1,0,0,0),   P1[14],P1[15],0.f,0.f,       pw3[2]=PKW(P1,12),pw3[3]=PKW(P1,14), pw3); \
    l_reg+=sacc; \
    if(GK){DMA_K((t)+3,sl_cur);} if(GV){DMA_V((t)+1,sl_next);} \
    CMASK(C0,C1,t); \
    { float a=MX3(C0[0],C0[1],C1[0]),b=MX3(C0[2],C0[3],C1[1]); a=MX3(a,C1[2],C1[3]); \
      _Pragma("unroll") for(int r=4;r<16;r+=4){a=MX3(a,C0[r],C0[r+1]);b=MX3(b,C0[r+2],C0[r+3]);a=MX3(a,C1[r],C1[r+1]);b=MX3(b,C1[r+2],C1[r+3]);} \
      float rm=__builtin_fmaxf(a,b); { auto rr=__builtin_amdgcn_permlane32_swap(__float_as_uint(rm),__float_as_uint(rm),false,false); rm=__builtin_fmaxf(__uint_as_float(rr[0]),__uint_as_float(rr[1])); } \
      resc=false; \
      if(__builtin_expect(__any(rm>(float)THRL),0)){ const float dl=__builtin_fmaxf(rm,0.f); mhat+=dl; \
        _Pragma("unroll") for(int r=0;r<16;++r){C0[r]-=dl;C1[r]-=dl;} \
        nb=fq2-mhat; \
        const float f=__builtin_amdgcn_exp2f(-dl); l_reg*=f; if(hi==0)wsf[r32]=f; resc=true; } } \
    SBAR(); \
    const lds_cptr fk_=fkp+((t)+1)*256; f32x4_t fa_=FLD(0),fb_; SBAR(); \
    GAPB(o[0]=__builtin_amdgcn_mfma_f32_32x32x16_bf16(PAF(0),VFR(0),o[0],0,0,0), C0,0, P0,fa_,fb_,32); \
    GAPB(o[1]=__builtin_amdgcn_mfma_f32_32x32x16_bf16(PAF(0),VFR(4),o[1],0,0,0), C0,4, P0,fb_,fa_,64); \
    KRD(GL,0); GAPB(o[0]=__builtin_amdgcn_mfma_f32_32x32x16_bf16(PAF(1),VFR(1),o[0],0,0,0), C0,8, P0,fa_,fb_,96); \
    KRD(GL,1); GAPB(o[1]=__builtin_amdgcn_mfma_f32_32x32x16_bf16(PAF(1),VFR(5),o[1],0,0,0), C0,12, P0,fb_,fa_,128); \
    KRD(GL,2); GAPB(o[0]=__builtin_amdgcn_mfma_f32_32x32x16_bf16(PAF(2),VFR(2),o[0],0,0,0), C1,0, P1,fa_,fb_,160); \
    KRD(GL,3); GAPB(o[1]=__builtin_amdgcn_mfma_f32_32x32x16_bf16(PAF(2),VFR(6),o[1],0,0,0), C1,4, P1,fb_,fa_,192); \
    GAPB(o[0]=__builtin_amdgcn_mfma_f32_32x32x16_bf16(PAF(3),VFR(3),o[0],0,0,0), C1,8, P1,fa_,fb_,224); \
    GAPB(o[1]=__builtin_amdgcn_mfma_f32_32x32x16_bf16(PAF(3),VFR(7),o[1],0,0,0), C1,12, P1,fb_,fa_,224); \
    }while(0)
  int t=1;
  #undef CMASK
  #define CMASK(P0,P1,t) do{}while(0)
  for(;t+5<NT;t+=2){
    STEP(pB0,pB1,pA0,pA1,t,true,true,true);     WAIT_BAR(2); RESC(); ROT();
    STEP(pA0,pA1,pB0,pB1,t+1,true,true,true);   WAIT_BAR(2); RESC(); ROT();
  }
  #undef CMASK
  #define CMASK(P0,P1,t) do{int jb_=(t)-(NT-4); if(jb_>=0)cmask(P0,P1,jb_,qrel,hi);}while(0)
  #define ENDW(tt) do{ if((tt)+3<NT){WAIT_BAR(2);} else if((tt)+2<NT){WAIT_BAR(1);} else {WAIT_BAR(0);} }while(0)
  for(;t+1<NT;t+=2){
    STEP(pB0,pB1,pA0,pA1,t,(t+3<NT),(t+1<NT),(t+1<NT));       ENDW(t);   RESC(); ROT();
    STEP(pA0,pA1,pB0,pB1,t+1,(t+4<NT),(t+2<NT),(t+2<NT));     ENDW(t+1); RESC(); ROT();
  }
  STEP(pB0,pB1,pA0,pA1,NT-1,false,false,false); RESC();
  { float sacc=pB0[0]+pB0[1]; _Pragma("unroll") for(int r=2;r<16;++r)sacc+=pB0[r]; _Pragma("unroll") for(int r=0;r<16;++r)sacc+=pB1[r]; l_reg+=sacc;
    pw0=(u32x4){PKW(pB0,0),PKW(pB0,2),PKW(pB0,4),PKW(pB0,6)};pw1=(u32x4){PKW(pB0,8),PKW(pB0,10),PKW(pB0,12),PKW(pB0,14)};pw2=(u32x4){PKW(pB1,0),PKW(pB1,2),PKW(pB1,4),PKW(pB1,6)};pw3=(u32x4){PKW(pB1,8),PKW(pB1,10),PKW(pB1,12),PKW(pB1,14)};
    SBAR(); pv(o,vb0+sl_cur,PAF(0),PAF(1),PAF(2),PAF(3)); }
  #undef PKW
  #undef PAF
  #undef VFR
  #undef PIN
  #undef MX3
  #undef GAPA
  #undef GAPB
  #undef FLD
  #undef FILLC
  #undef EX
  #undef VRD
  #undef KRD
  #undef STEP
  #undef ENDW
  {auto rr=__builtin_amdgcn_permlane32_swap(__float_as_uint(l_reg),__float_as_uint(l_reg),false,false);l_reg=__uint_as_float(rr[0])+__uint_as_float(rr[1]);}
  if(hi==0)wsf[32+r32]=l_reg;asm volatile("s_waitcnt lgkmcnt(0)":::"memory");
  float rli[16];
  #pragma unroll
  for(int r=0;r<16;++r)rli[r]=__builtin_amdgcn_rcpf(wsf[32+crow(r,hi)]);
  bf16*Ow=O+(rowbase+q0+wid*QBLK)*DM+h*D;
  { bf16*stg=(bf16*)(shm+LDS_OST)+wid*2048;
    #pragma unroll
    for(int r=0;r<16;++r){const int orow=crow(r,hi);
      #pragma unroll
      for(int d0=0;d0<2;++d0)stg[orow*64+d0*32+r32]=f2bf_a(o[d0][r]*rli[r]);}
    asm volatile("s_waitcnt lgkmcnt(0)":::"memory");
    #pragma unroll
    for(int i=0;i<4;++i){const int row=i*8+(lane>>3),ch=lane&7; const u32x4 v=*(const u32x4*)(stg+row*64+ch*8); ATTN_STORE16(Ow+(long)row*DM+ch*8,v);} }
  asm volatile("s_waitcnt lgkmcnt(0)\n\ts_barrier":::"memory");
  #undef DMA_K
  #undef DMA_V
  #undef CMASK
  #undef START
  #undef RESC
  #undef ROT
}
constexpr int ATTN_LDS_BYTES=LDS_BYTES;
struct AttnTensors { const bf16* Q; const bf16* K; const bf16* V; bf16* O; const float* CUM; };
struct AttnUnit { int bh; int qb; };
struct StaticOrder {
  int vcu;
  __device__ __forceinline__ explicit StaticOrder(int v):vcu(v){}
  __device__ __forceinline__ bool next(int i,AttnUnit&u)const{ if(i>=2)return false; const int s=vcu&15; u.bh=vcu>>4; u.qb=(i==0)?31-s:s; return true; }
};
template<class Sched,int THRL=8> __device__ __forceinline__ void attn_phase(char*lds,const AttnTensors&T,const Sched&S){
  AttnUnit u;
  for(int i=0;S.next(i,u);++i){ attn_unit<THRL>(u.bh/NHEAD,u.bh%NHEAD,u.qb,T.Q,T.K,T.V,T.O,T.CUM,lds); }
}
#undef SBAR
#undef WAIT_BAR
}

constexpr int NWAVES = 8;
constexpr int RING_OFF = 0, RING_BYTES = 131072;
constexpr int LDSCTL_OFF = RING_BYTES, MISC_OFF = LDSCTL_OFF + 320;
constexpr int LDS_BYTES = 147456;
typedef GAS unsigned gu32;
#define RLX_AGENT __ATOMIC_RELAXED, __HIP_MEMORY_SCOPE_AGENT
#define LDS_WAIT() asm volatile("s_waitcnt lgkmcnt(0)" ::: "memory")
#define VM_WAIT() asm volatile("s_waitcnt vmcnt(0)" ::: "memory")
constexpr int CW_TMO = 0, CW_CODE = 1, CW_CNT = 64  , CW_Q0 = 128  , CW_BAR = 4096;

#define XB_TMO      128
#define XB_XCNT(j)  (256  + 64 * (j))
#define XB_XSUB(j)  (1280 + 64 * (j))
#define XB_XGEN(j)  (2304 + 64 * (j))
#define XB_TOP      3328
#define XB_TOPGEN   3392
#define XCD_BAR_WORDS 3456
#define XB_SPIN_CAP (1u << 18)
__device__ __forceinline__ unsigned xb_ld(unsigned* p)              { return __hip_atomic_load(p, __ATOMIC_RELAXED, __HIP_MEMORY_SCOPE_AGENT); }
__device__ __forceinline__ unsigned xb_add(unsigned* p, unsigned v) { return __hip_atomic_fetch_add(p, v, __ATOMIC_RELAXED, __HIP_MEMORY_SCOPE_AGENT); }
__device__ __forceinline__ unsigned xb_xcc_id() { return (unsigned)__builtin_amdgcn_s_getreg((3 << 11) | 20) & 0xFu; }
#define XB_SPIN(cond, bar) do { unsigned _sp = 0; while (cond) { __builtin_amdgcn_s_sleep(1); \
    if ((++_sp & 255u) == 0u) { if (xb_ld(&(bar)[XB_TMO])) break; if (_sp > XB_SPIN_CAP) { atomicAdd(&(bar)[XB_TMO], 1u); break; } } } } while (0)
struct XcdBarrier { unsigned* bar; unsigned x; volatile LAS unsigned* st; };
__device__ __forceinline__ XcdBarrier xcd_barrier_post(unsigned* bar, volatile LAS unsigned* st) {
    XcdBarrier b; b.bar = bar; b.x = xb_xcc_id(); b.st = st;
    if (threadIdx.x == 0) (void)xb_add(&bar[XB_XCNT(b.x)], 1u);
    return b;
}
__device__ __forceinline__ void xcd_barrier_complete(unsigned* bar, unsigned x, unsigned& nloc, unsigned& nx) {
    const unsigned G = gridDim.x * gridDim.y * gridDim.z;
    unsigned sum, cnt, mine, sp = 0u;
    for (;;) {
        sum = 0u; cnt = 0u; mine = 0u;
#pragma unroll
        for (unsigned j = 0; j < 16; ++j) { const unsigned c = xb_ld(&bar[XB_XCNT(j)]); sum += c; cnt += (c > 0u) ? 1u : 0u; mine = (j == x) ? c : mine; }
        if (sum == G) break;
        __builtin_amdgcn_s_sleep(1);
        if ((++sp & 255u) == 0u) { if (xb_ld(&bar[XB_TMO])) break; if (sp > XB_SPIN_CAP) { atomicAdd(&bar[XB_TMO], 1u); break; } }
    }
    nloc = mine > 0u ? mine : 1u; nx = cnt > 0u ? cnt : 1u;
}
__device__ __forceinline__ void xcd_barrier(const XcdBarrier& b) {
    asm volatile("s_waitcnt vmcnt(0)" ::: "memory");
    __syncthreads();
    if (threadIdx.x == 0) {
        unsigned* bar = b.bar;
        __builtin_amdgcn_s_waitcnt(0);
        unsigned nloc = b.st[0], nx = b.st[1];
        if (nloc == 0u) { xcd_barrier_complete(bar, b.x, nloc, nx); b.st[0] = nloc; b.st[1] = nx; }
        const unsigned old = xb_add(&bar[XB_XSUB(b.x)], 1u);
        const unsigned gen = old / nloc;
        if (old + 1u == (gen + 1u) * nloc) {
            __builtin_amdgcn_fence(__ATOMIC_RELEASE, "agent");
            asm volatile("s_waitcnt vmcnt(0)" ::: "memory");
            const unsigned og = xb_add(&bar[XB_TOP], 1u);
            const unsigned tg = og / nx;
            if (og + 1u == (tg + 1u) * nx) xb_add(&bar[XB_TOPGEN], 1u);
            else XB_SPIN(xb_ld(&bar[XB_TOPGEN]) == tg, bar);
            __builtin_amdgcn_fence(__ATOMIC_ACQUIRE, "agent");
            xb_add(&bar[XB_XGEN(b.x)], 1u);
            asm volatile("s_waitcnt vmcnt(0)" ::: "memory");
        } else {
            XB_SPIN(xb_ld(&bar[XB_XGEN(b.x)]) == gen, bar);
            __builtin_amdgcn_fence(__ATOMIC_ACQUIRE, "agent");
            asm volatile("s_waitcnt vmcnt(0)" ::: "memory");
        }
    }
    __syncthreads();
}

struct Args { const float* in[26]; float* out; unsigned char* ws; int ph_lo, ph_hi, sub, pad_; };
struct Frame {
    LAS unsigned char* lds; volatile LAS unsigned* MISC; gu32* ctl;
    int tid, lane, wave, vcu, G;
};
__device__ __forceinline__ float gelu_fast(float x) { const float z = 0.7978845608028654f * (x + 0.044715f * x * x * x); const float e = __builtin_amdgcn_exp2f(2.885390081777927f * z); return x - x * __builtin_amdgcn_rcpf(e + 1.f); }
__device__ __forceinline__ float wave_sum(float v) {
#pragma unroll
    for (int o = 1; o < 64; o <<= 1) v += __shfl_xor(v, o);
    return v;
}

struct ConvDesc { const float* W; int ldw, k0, scol; bf16* dst; int ldd; const float* kscale; };
__device__ __forceinline__ void conv_load(const ConvDesc& d, float (&v)[32], int lane) {
    const float* wp = d.W + (size_t)(d.k0 + (lane >> 5)) * d.ldw + d.scol + (lane & 31);
#pragma unroll
    for (int i = 0; i < 32; ++i) v[i] = wp[(size_t)(2 * i) * d.ldw];
}
__device__ __forceinline__ void conv_finish(const ConvDesc& d, float (&v)[32], LAS float* scr, int lane) {
    if (d.kscale) {
#pragma unroll
        for (int i = 0; i < 32; ++i) v[i] *= d.kscale[d.k0 + 2 * i + (lane >> 5)]; }
#pragma unroll
    for (int i = 0; i < 32; ++i) scr[(2 * i + (lane >> 5)) * 33 + (lane & 31)] = v[i];
    LDS_WAIT(); asm volatile("" ::: "memory");
    const int c = lane & 7;
#pragma unroll
    for (int j = 0; j < 4; ++j) { const int n = (lane >> 3) + 8 * j; const LAS float* s = scr + (8 * c) * 33 + n;
        u32x4 o; o.x = pg::cvt_pk_bf16(s[0 * 33], s[1 * 33]); o.y = pg::cvt_pk_bf16(s[2 * 33], s[3 * 33]); o.z = pg::cvt_pk_bf16(s[4 * 33], s[5 * 33]); o.w = pg::cvt_pk_bf16(s[6 * 33], s[7 * 33]);
        *(GAS u32x4*)(d.dst + (size_t)n * d.ldd + d.k0 + 8 * c) = o; }
    LDS_WAIT(); asm volatile("" ::: "memory");
}
__device__ __forceinline__ void conv_item(const float* W, int ldw, int k0, int scol, bf16* dst, int ldd, const float* kscale, LAS float* scr, int lane) {
    ConvDesc d{W, ldw, k0, scol, dst, ldd, kscale}; float v[32]; conv_load(d, v, lane); conv_finish(d, v, scr, lane);
}
__device__ __forceinline__ int inproj_src_col(int cp) { return cp < 1536 ? cp : (cp < 2048 ? cp + (OU - 1536) : (cp < 3072 ? cp + (OGA - 2048) : cp + (OGS - 3072))); }
__device__ __forceinline__ int inproj_dst_row(int cp) { const int t = cp & ~255, c = cp & 255, wc = c >> 6, bj = (c >> 5) & 1, j = c & 31; return t + 128 * bj + 32 * wc + j; }

__device__ __forceinline__ void p0_prologue(Frame& F, const Args& a) {
    unsigned char* ws = a.ws;
    LAS float* scr = (LAS float*)(F.lds + F.wave * 8704);
    LAS float* wf = (LAS float*)(F.lds + 73728);
    const int gw = F.vcu * NWAVES + F.wave, NGW = F.G * NWAVES;
    const float* w_in = a.in[2]; const int sub = a.sub;
    for (int i = F.tid; i < 8 * 1024; i += NWAVES * 64) { const int h = i >> 10, k = i & 1023; wf[i] = w_in[(size_t)k * DIN + OF + h]; }
    constexpr int I_IN = 16 * 128;
    for (int it = (sub & 1) ? gw : I_IN; it < I_IN; it += NGW) { const int kb = it >> 7, nb = it & 127, cp = nb * 32;
        conv_item(w_in, DIN, kb * 64, inproj_src_col(cp), (bf16*)(ws + WS_WIN) + (size_t)inproj_dst_row(cp) * D, D, nullptr, scr, F.lane); }
    __syncthreads();
    const float* x = a.in[0]; const float* g = a.in[1]; const float* bfg = a.in[3];
    bf16* XN = (bf16*)(ws + WS_XN); float* LOGF = (float*)(ws + WS_CUM);
    { int m = (sub & 2) ? gw : T; f32x4 v[4];
      if (m < T) { const GAS f32x4* xr = (const GAS f32x4*)(x + (size_t)m * D) + F.lane;
#pragma unroll
          for (int j = 0; j < 4; ++j) v[j] = xr[64 * j]; }
      while (m < T) {
        const int mn = m + NGW; f32x4 vn[4];
        if (mn < T) { const GAS f32x4* xr = (const GAS f32x4*)(x + (size_t)mn * D) + F.lane;
#pragma unroll
            for (int j = 0; j < 4; ++j) vn[j] = xr[64 * j]; }
        float s = 0.f;
#pragma unroll
        for (int j = 0; j < 4; ++j) s += (v[j].x * v[j].x + v[j].y * v[j].y) + (v[j].z * v[j].z + v[j].w * v[j].w);
        float f[8];
#pragma unroll
        for (int h = 0; h < 8; ++h) f[h] = 0.f;
        f32x4 xg[4];
#pragma unroll
        for (int j = 0; j < 4; ++j) { const f32x4 gg = *((const GAS f32x4*)g + 64 * j + F.lane); xg[j] = v[j] * gg;
#pragma unroll
            for (int h = 0; h < 8; ++h) { const f32x4 ww = *((const LAS f32x4*)(wf + h * 1024) + 64 * j + F.lane); f[h] += (xg[j].x * ww.x + xg[j].y * ww.y) + (xg[j].z * ww.z + xg[j].w * ww.w); } }
        const float rstd = rsqrtf(wave_sum(s) * (1.f / D) + EPS);
        float f4[4], f2[2], f1;
        { const bool up = F.lane >= 32;
#pragma unroll
          for (int i = 0; i < 4; ++i) { const float snd = up ? f[i] : f[4 + i], kp = up ? f[4 + i] : f[i]; f4[i] = kp + __shfl_xor(snd, 32); } }
        { const bool up = (F.lane & 16) != 0;
#pragma unroll
          for (int i = 0; i < 2; ++i) { const float snd = up ? f4[i] : f4[2 + i], kp = up ? f4[2 + i] : f4[i]; f2[i] = kp + __shfl_xor(snd, 16); } }
        { const bool up = (F.lane & 8) != 0; const float snd = up ? f2[0] : f2[1], kp = up ? f2[1] : f2[0]; f1 = kp + __shfl_xor(snd, 8); }
        f1 += __shfl_xor(f1, 4); f1 += __shfl_xor(f1, 2); f1 += __shfl_xor(f1, 1);
        GAS u32x2* o8 = (GAS u32x2*)(XN + (size_t)m * D) + F.lane;
#pragma unroll
        for (int j = 0; j < 4; ++j) { const f32x4 xn = xg[j] * rstd; u32x2 w; w.x = pg::cvt_pk_bf16(xn.x, xn.y); w.y = pg::cvt_pk_bf16(xn.z, xn.w); o8[64 * j] = w; }
        if ((F.lane & 7) == 0) { const int hh = F.lane >> 3, b = m / SEQ, sidx = m % SEQ; LOGF[((size_t)b * NH + hh) * SEQ + sidx] = log_sigmoid(f1 * rstd + bfg[hh]); }
#pragma unroll
        for (int j = 0; j < 4; ++j) v[j] = vn[j];
        m = mn;
      } }
    if ((sub & 4) && F.G == 256) {
        __syncthreads();
        const int g = F.vcu >> 3, q = F.vcu & 7;
        LAS f32x2* PW = (LAS f32x2*)(F.lds);
        LAS f32x2* BB = (LAS f32x2*)(F.lds + 16896);
        LAS f32x2* CT = (LAS f32x2*)(F.lds + 16896 + 8192);
        LAS float* KT = (LAS float*)(F.lds + 16896 + 16384);
        const float* A_re = a.in[6]; const float* A_im = a.in[7]; const float* log_dt = a.in[8]; const float* B_re = a.in[9]; const float* B_im = a.in[10]; const float* C_re = a.in[11]; const float* C_im = a.in[12];
        if (F.tid < NP) { const int p = F.tid;
            const double dt = exp((double)log_dt[g]), ar = A_re[g * NP + p], ai = A_im[g * NP + p];
            const double er = exp(ar * dt), abr = er * cos(ai * dt), abi = er * sin(ai * dt);
            const double nr = abr - 1.0, ni = abi, den = ar * ar + ai * ai, fr_ = (nr * ar + ni * ai) / den, fi_ = (ni * ar - nr * ai) / den;
            double pr = 1.0, pi = 0.0;
            for (int tau = 0; tau <= LCH; ++tau) { PW[tau * NP + p] = (f32x2){(float)pr, (float)pi}; const double t2 = pr * abr - pi * abi; pi = pr * abi + pi * abr; pr = t2; }
            if (q == 0) { ((float*)(ws + WS_AL))[(g * NP + p) * 2] = PW[LCH * NP + p].x; ((float*)(ws + WS_AL))[(g * NP + p) * 2 + 1] = PW[LCH * NP + p].y; }
            for (int c = 0; c < GC; ++c) { const double br = B_re[(g * NP + p) * GC + c], bi = B_im[(g * NP + p) * GC + c]; BB[p * GC + c] = (f32x2){(float)(fr_ * br - fi_ * bi), (float)(fr_ * bi + fi_ * br)}; } }
        for (int i = F.tid; i < GC * NP; i += NWAVES * 64) { const int c = i >> 6, p = i & 63; CT[p * GC + c] = (f32x2){C_re[g * GC * NP + i], C_im[g * GC * NP + i]}; }
        __syncthreads();
        { float* KTG = (float*)(ws + WS_KTG) + (size_t)g * LCH * GC * GC;
          for (int i = 4 * q * GC * GC + F.tid; i < (4 * q + 4) * GC * GC; i += NWAVES * 64) { const int tau = i >> 8, co = (i >> 4) & 15, ci = i & 15; float acc = 0.f;
#pragma unroll 4
              for (int p = 0; p < NP; ++p) { const f32x2 w = PW[tau * NP + p], b = BB[p * GC + ci], c = CT[p * GC + co]; const float wr_ = w.x * b.x - w.y * b.y, wi_ = w.x * b.y + w.y * b.x; acc += c.x * wr_ - c.y * wi_; }
              KTG[i] = acc; } }
        {
          const int n = 64 * q + (F.tid >> 3), part = F.tid & 7, j = n >> 4, co = n & 15; bf16* row = (bf16*)(ws + WS_BTY) + ((size_t)g * 512 + n) * U2P;
          auto bval = [&](int k) -> float { const int p = k & 63; const f32x2 w = PW[(j + 1) * NP + p], c = CT[p * GC + co]; return k < 64 ? (c.x * w.x - c.y * w.y) : -(c.x * w.y + c.y * w.x); };
#pragma unroll 1
          for (int it = 0; it < 2; ++it) { const int k = (it * 8 + part) * 8;
              u32x4 o; o.x = pg::cvt_pk_bf16(bval(k), bval(k + 1)); o.y = pg::cvt_pk_bf16(bval(k + 2), bval(k + 3)); o.z = pg::cvt_pk_bf16(bval(k + 4), bval(k + 5)); o.w = pg::cvt_pk_bf16(bval(k + 6), bval(k + 7)); *(GAS u32x4*)(row + k) = o; } }
        {
          const int n = 32 * q + (F.tid >> 4), part = F.tid & 15; bf16* row = (bf16*)(ws + WS_M1T) + ((size_t)g * 256 + n) * 512;
          auto mval = [&](int k) -> float { const int j = k >> 4, ci = k & 15; float x = 0.f;
              if (n < 128) { const int p = n & 63; const f32x2 w = PW[(LCH - 1 - j) * NP + p], b = BB[p * GC + ci]; x = n < 64 ? (w.x * b.x - w.y * b.y) : (w.x * b.y + w.y * b.x); }
              return x; };
#pragma unroll 1
          for (int it = 0; it < 4; ++it) { const int k = (it * 16 + part) * 8;
              u32x4 o; o.x = pg::cvt_pk_bf16(mval(k), mval(k + 1)); o.y = pg::cvt_pk_bf16(mval(k + 2), mval(k + 3)); o.z = pg::cvt_pk_bf16(mval(k + 4), mval(k + 5)); o.w = pg::cvt_pk_bf16(mval(k + 6), mval(k + 7)); *(GAS u32x4*)(row + k) = o; } }
    }
}

__device__ __forceinline__ void p1_cumsum(Frame& F, float* CUM) {
    LAS double* part = (LAS double*)(F.lds);
    float* p = CUM + (size_t)blockIdx.x * SEQ + F.tid * 16;
    f32x4 v[4]; float run[16]; float a = 0.f;
#pragma unroll
    for (int j = 0; j < 4; ++j) v[j] = ((const GAS f32x4*)p)[j];
#pragma unroll
    for (int j = 0; j < 4; ++j) { a += v[j].x; run[4 * j] = a; a += v[j].y; run[4 * j + 1] = a; a += v[j].z; run[4 * j + 2] = a; a += v[j].w; run[4 * j + 3] = a; }
    part[F.tid] = (double)a;
    __syncthreads();
    if (F.tid < 64) { double loc[8]; double s = 0.0;
#pragma unroll
        for (int i = 0; i < 8; ++i) { loc[i] = s; s += part[F.tid * 8 + i]; }
        double incl = s;
#pragma unroll
        for (int o = 1; o < 64; o <<= 1) { const double t = __shfl_up(incl, o); if (F.lane >= o) incl += t; }
        const double excl = incl - s;
#pragma unroll
        for (int i = 0; i < 8; ++i) part[F.tid * 8 + i] = excl + loc[i]; }
    __syncthreads();
    const double base = part[F.tid];
#pragma unroll
    for (int j = 0; j < 4; ++j) { f32x4 o; o.x = (float)((base + (double)run[4 * j]) * 1.4426950408889634); o.y = (float)((base + (double)run[4 * j + 1]) * 1.4426950408889634);
        o.z = (float)((base + (double)run[4 * j + 2]) * 1.4426950408889634); o.w = (float)((base + (double)run[4 * j + 3]) * 1.4426950408889634); ((GAS f32x4*)p)[j] = o; }
    __syncthreads();
}
struct PhInProj {
    static constexpr bool GATHER = false;
    unsigned lda, ldb; const char* A; const char* B; pg::StaticOrder so;
    bf16 *Q, *K, *V, *U2X, *GA, *GS; const float *gq, *gk;
    __device__ __forceinline__ bool next(int i, pg::Unit& u) const { int pm, pn; if (!so.next(i, pm, pn)) return false; u.A = A + (size_t)pm * 256 * lda; u.B = B + (size_t)pn * 256 * ldb; u.nt = D / 64; u.pm = pm; u.pn = pn; u.aux = 0; return true; }
    __device__ __forceinline__ void offs(const pg::Unit&, const int (&R)[2], const int (&C)[2], unsigned (&vo)[2][2]) const { pg::offs_plain(lda, R, C, vo); }
    __device__ __forceinline__ void epi(const f32x4 (&acc)[2][2][4][2], const pg::Unit& u, int wr, int wc, int fr, int fq) const {
        const int pn = u.pn, row0 = u.pm * 256 + wr * 64 + fr;
        if (pn < 4) {
            const bool isq = pn < 2; const float* g = isq ? gq : gk; bf16* O = isq ? Q : K; const int cb = (pn & 1) * 256 + 64 * wc + 8 * fq; const float sc = isq ? C2 : 1.f;
            f32x4 gv[2][2];
#pragma unroll
            for (int bj = 0; bj < 2; ++bj)
#pragma unroll
                for (int n = 0; n < 2; ++n) gv[bj][n] = *(const f32x4*)(g + 32 * bj + 8 * fq + 4 * n) * sc;
#pragma unroll
            for (int ai = 0; ai < 2; ++ai)
#pragma unroll
                for (int m = 0; m < 4; ++m) { float ss = 0.f;
#pragma unroll
                    for (int bj = 0; bj < 2; ++bj)
#pragma unroll
                        for (int n = 0; n < 2; ++n) { const f32x4 v = acc[ai][bj][m][n]; ss += (v[0] * v[0] + v[1] * v[1]) + (v[2] * v[2] + v[3] * v[3]); }
                    ss += __shfl_xor(ss, 16); ss += __shfl_xor(ss, 32);
                    const float rstd = rsqrtf(ss * (1.f / 64.f) + EPS);
                    bf16* rowp = O + (size_t)(row0 + ai * 128 + m * 16) * DA + cb;
#pragma unroll
                    for (int bj = 0; bj < 2; ++bj) *(u32x4*)(rowp + 32 * bj) = pg::pack8(acc[ai][bj][m][0] * rstd * gv[bj][0], acc[ai][bj][m][1] * rstd * gv[bj][1]); }
        } else if (pn < 6) {
            const int cb = (pn - 4) * 256 + 64 * wc + 8 * fq;
#pragma unroll
            for (int ai = 0; ai < 2; ++ai)
#pragma unroll
                for (int m = 0; m < 4; ++m) { bf16* rowp = V + (size_t)(row0 + ai * 128 + m * 16) * DA + cb;
#pragma unroll
                    for (int bj = 0; bj < 2; ++bj) *(u32x4*)(rowp + 32 * bj) = pg::pack8(acc[ai][bj][m][0], acc[ai][bj][m][1]); }
        } else if (pn < 8) {
#pragma unroll
            for (int ai = 0; ai < 2; ++ai)
#pragma unroll
                for (int m = 0; m < 4; ++m) { const int row = row0 + ai * 128 + m * 16;
#pragma unroll
                    for (int bj = 0; bj < 2; ++bj) { const int cu = (pn - 6) * 256 + 64 * wc + 32 * bj + 8 * fq;
                        *(u32x4*)(U2X + u2x_index(cu >> 4, row, cu & 15)) = pg::pack8(acc[ai][bj][m][0], acc[ai][bj][m][1]); } }
        } else {
            bf16* G = pn < 12 ? GA : GS; const int cb = ((pn - 8) & 3) * 256 + 64 * wc + 8 * fq;
#pragma unroll
            for (int ai = 0; ai < 2; ++ai)
#pragma unroll
                for (int m = 0; m < 4; ++m) { bf16* rowp = G + (size_t)(row0 + ai * 128 + m * 16) * D + cb;
#pragma unroll
                    for (int bj = 0; bj < 2; ++bj) { f32x4 a = acc[ai][bj][m][0], b = acc[ai][bj][m][1];
#pragma unroll
                        for (int e = 0; e < 4; ++e) { a[e] = pg::fsigmoid(a[e]); b[e] = pg::fsigmoid(b[e]); }
                        *(u32x4*)(rowp + 32 * bj) = pg::pack8(a, b); } }
        }
    }
};

struct PhGlu {
    static constexpr bool GATHER = false;
    unsigned lda, ldb; const char* A; const char* B; pg::StaticOrder so; const bf16* Y1; bf16* YS;
    __device__ __forceinline__ bool next(int i, pg::Unit& u) const { int pm, pn; if (!so.next(i, pm, pn)) return false; u.A = A + (size_t)pm * 256 * lda; u.B = B + (size_t)pn * 256 * ldb; u.nt = DS / 64; u.pm = pm; u.pn = pn; u.aux = 0; return true; }
    __device__ __forceinline__ void offs(const pg::Unit&, const int (&R)[2], const int (&C)[2], unsigned (&vo)[2][2]) const { pg::offs_plain(lda, R, C, vo); }
    __device__ __forceinline__ void epi(const f32x4 (&acc)[2][2][4][2], const pg::Unit& u, int wr, int wc, int fr, int fq) const {
        const int row0 = u.pm * 256 + wr * 64 + fr, cb = u.pn * 256 + 32 * wc + 8 * fq;
#pragma unroll
        for (int ai = 0; ai < 2; ++ai)
#pragma unroll
            for (int m = 0; m < 4; ++m) { const size_t ro = (size_t)(row0 + ai * 128 + m * 16) * DS + cb;
#pragma unroll
                for (int bj = 0; bj < 2; ++bj) { const u32x4 yv = *(const u32x4*)(Y1 + ro + 128 * bj); f32x4 y0, y1; pg::unpack8(yv, y0, y1);
                    f32x4 a = acc[ai][bj][m][0], b = acc[ai][bj][m][1];
#pragma unroll
                    for (int e = 0; e < 4; ++e) { a[e] = y0[e] * pg::fsigmoid(a[e]); b[e] = y1[e] * pg::fsigmoid(b[e]); }
                    *(u32x4*)(YS + ro + 128 * bj) = pg::pack8(a, b); } }
    }
};
struct PhProj {
    static constexpr bool GATHER = false;
    unsigned lda, ldb; const char* O; const char* YSp; const char* WPA; const char* WPS; pg::StaticOrder so; bf16* GA; const bf16* GS;
    __device__ __forceinline__ bool next(int i, pg::Unit& u) const { int pm, pn; if (!so.next(i >> 1, pm, pn)) return false; const int sub = i & 1;
        u.A = (sub ? YSp : O) + (size_t)pm * 256 * lda; u.B = (sub ? WPS : WPA) + (size_t)pn * 256 * ldb; u.nt = DA / 64; u.pm = pm; u.pn = pn; u.aux = sub; return true; }
    __device__ __forceinline__ void offs(const pg::Unit&, const int (&R)[2], const int (&C)[2], unsigned (&vo)[2][2]) const { pg::offs_plain(lda, R, C, vo); }
    __device__ __forceinline__ void epi(const f32x4 (&acc)[2][2][4][2], const pg::Unit& u, int wr, int wc, int fr, int fq) const {
        const int row0 = u.pm * 256 + wr * 64 + fr, cb = u.pn * 256 + 32 * wc + 8 * fq; const bool sub = u.aux != 0;
#pragma unroll
        for (int ai = 0; ai < 2; ++ai)
#pragma unroll
            for (int m = 0; m < 4; ++m) { const size_t ro = (size_t)(row0 + ai * 128 + m * 16) * D + cb;
#pragma unroll
                for (int bj = 0; bj < 2; ++bj) { const u32x4 gv = *(const u32x4*)(GA + ro + 128 * bj); f32x4 g0, g1; pg::unpack8(gv, g0, g1);
                    f32x4 a = acc[ai][bj][m][0], b = acc[ai][bj][m][1];
                    if (!sub) { a = a * g0; b = b * g1; }
                    else { const u32x4 sv = *(const u32x4*)(GS + ro + 128 * bj); f32x4 s0, s1; pg::unpack8(sv, s0, s1); a = g0 + s0 * a; b = g1 + s1 * b; }
                    *(u32x4*)(GA + ro + 128 * bj) = pg::pack8(a, b); } }
    }
};
struct PhWout {
    static constexpr bool GATHER = false;
    unsigned lda, ldb; const char* A; const char* B; pg::StaticOrder so; const float* x; float* out; bf16* X2B; float* SSP;
    __device__ __forceinline__ bool next(int i, pg::Unit& u) const { int pm, pn; if (!so.next(i, pm, pn)) return false; u.A = A + (size_t)pm * 256 * lda; u.B = B + (size_t)pn * 256 * ldb; u.nt = D / 64; u.pm = pm; u.pn = pn; u.aux = 0; return true; }
    __device__ __forceinline__ void offs(const pg::Unit&, const int (&R)[2], const int (&C)[2], unsigned (&vo)[2][2]) const { pg::offs_plain(lda, R, C, vo); }
    __device__ __forceinline__ void epi(const f32x4 (&acc)[2][2][4][2], const pg::Unit& u, int wr, int wc, int fr, int fq) const {
        const int row0 = u.pm * 256 + wr * 64 + fr, cb = u.pn * 256 + 32 * wc + 8 * fq;
#pragma unroll
        for (int ai = 0; ai < 2; ++ai)
#pragma unroll
            for (int m = 0; m < 4; ++m) { const int row = row0 + ai * 128 + m * 16; const size_t ro = (size_t)row * D + cb; float ss = 0.f;
#pragma unroll
                for (int bj = 0; bj < 2; ++bj) { const f32x4 x0 = *(const f32x4*)(x + ro + 128 * bj), x1 = *(const f32x4*)(x + ro + 128 * bj + 4);
                    const f32x4 a = acc[ai][bj][m][0] + x0, b = acc[ai][bj][m][1] + x1;
                    *(u32x4*)(X2B + ro + 128 * bj) = pg::pack8(a, b);
                    ss += (a[0] * a[0] + a[1] * a[1]) + (a[2] * a[2] + a[3] * a[3]) + (b[0] * b[0] + b[1] * b[1]) + (b[2] * b[2] + b[3] * b[3]); }
                ss += __shfl_xor(ss, 16); ss += __shfl_xor(ss, 32);
                if (fq == 0) SSP[(size_t)row * 16 + u.pn * 4 + wc] = ss;
                asm volatile("" ::: "memory"); }
    }
};

__device__ __forceinline__ void p2_side_work(Frame& F, const Args& a) {
    unsigned char* ws = a.ws; const int i0 = (int)blockIdx.x - 64;
    LAS float* KT = (LAS float*)F.lds;
    for (int sl = i0; sl < NG * 8; sl += 192) { const int g = sl >> 3, q = sl & 7;
        __syncthreads();
        { const GAS f32x4* src = (const GAS f32x4*)((const float*)(ws + WS_KTG) + (size_t)g * LCH * GC * GC);
          for (int i = F.tid; i < (4 * q + 4) * GC * GC / 4; i += NWAVES * 64) *(LAS f32x4*)(KT + 4 * i) = src[i]; }
        __syncthreads();
        const int n = 64 * q + (F.tid >> 3), part = F.tid & 7, j = n >> 4, co = n & 15; bf16* row = (bf16*)(ws + WS_BTY) + ((size_t)g * 512 + n) * U2P + 128;
#pragma unroll 1
        for (int it = 0; it < 8; ++it) { const int k = (it * 8 + part) * 8, sidx = k >> 4, ci = k & 15;
            u32x4 o = (u32x4){0u, 0u, 0u, 0u};
            if (sidx <= j) { const LAS float* kp = KT + ((j - sidx) * GC + co) * GC + ci; const f32x4 k0 = *(const LAS f32x4*)kp, k1 = *(const LAS f32x4*)(kp + 4); o = pg::pack8(k0, k1); }
            *(GAS u32x4*)(row + k) = o; } }
    __syncthreads();
    LAS float* scr = (LAS float*)(F.lds + F.wave * 8704);
    constexpr int I_GLU = 8 * 16, I_PA = 8 * 32, I_OUT = 16 * 32;
    for (int it = i0 * NWAVES + F.wave; it < I_GLU + 2 * I_PA + I_OUT; it += 192 * NWAVES) { int r = it;
        if (r < I_GLU) { const int kb = r >> 4, nb = r & 15; conv_item(a.in[14], DS, kb * 64, nb * 32, (bf16*)(ws + WS_WGLU) + (size_t)(nb * 32) * DS, DS, nullptr, scr, F.lane); continue; } r -= I_GLU;
        if (r < I_PA) { const int kb = r >> 5, nb = r & 31; conv_item(a.in[15], D, kb * 64, nb * 32, (bf16*)(ws + WS_WPA) + (size_t)(nb * 32) * DA, DA, nullptr, scr, F.lane); continue; } r -= I_PA;
        if (r < I_PA) { const int kb = r >> 5, nb = r & 31; conv_item(a.in[16], D, kb * 64, nb * 32, (bf16*)(ws + WS_WPS) + (size_t)(nb * 32) * DS, DS, nullptr, scr, F.lane); continue; } r -= I_PA;
        { const int kb = r >> 5, nb = r & 31; conv_item(a.in[17], D, kb * 64, nb * 32, (bf16*)(ws + WS_WOUT) + (size_t)(nb * 32) * D, D, nullptr, scr, F.lane); } }
    if (i0 < 48) { const int r = i0; const float* gf = a.in[18]; const float* wrg = a.in[19]; const float* wre = a.in[21]; bf16* WR = (bf16*)(ws + WS_WR) + (size_t)r * D;
        for (int k = F.tid; k < D; k += NWAVES * 64) { const float w = r < 4 ? wrg[k * 4 + r] : (r < 36 ? wre[k * NE + r - 4] : 0.f); WR[k] = f2bf(w * gf[k]); } }
    __syncthreads();
}
__device__ __forceinline__ void p2_expert_weights(Frame& F, const Args& a) {
    unsigned char* ws = a.ws; LAS float* scr = (LAS float*)(F.lds + F.wave * 8704);
    const int gw = F.vcu * NWAVES + F.wave, NGW = F.G * NWAVES;
    const float* gf = a.in[18]; const float* wg = a.in[23]; const float* wu = a.in[24]; const float* wd = a.in[25];
    constexpr int I_G = 16 * 8, I_D = 4 * 32;
    constexpr int NITEMS = NE * (2 * I_G + I_D);
    auto desc = [&](int it) -> ConvDesc { const int e = it / (2 * I_G + I_D); int r = it % (2 * I_G + I_D);
        if (r < 2 * I_G) { const int up = r >= I_G; if (up) r -= I_G; const int kb = r >> 3, nb = r & 7, n0 = nb * 32;
            return ConvDesc{(up ? wu : wg) + (size_t)e * D * DE, DE, kb * 64, n0, (bf16*)(ws + WS_WGU) + ((size_t)e * 512 + 256 * (n0 >> 7) + 128 * up + (n0 & 127)) * D, D, gf}; }
        r -= 2 * I_G; const int kb = r >> 5, nb = r & 31; return ConvDesc{wd + (size_t)e * DE * D, D, kb * 64, nb * 32, (bf16*)(ws + WS_WD) + ((size_t)e * D + nb * 32) * DE, DE, nullptr}; };
    int it = (a.sub & 4) ? gw : NITEMS;
    float v[32]; ConvDesc d{}; if (it < NITEMS) { d = desc(it); conv_load(d, v, F.lane); }
    while (it < NITEMS) {
        const int itn = it + NGW; float vn[32]; ConvDesc dn{}; if (itn < NITEMS) { dn = desc(itn); conv_load(dn, vn, F.lane); }
        conv_finish(d, v, scr, F.lane);
#pragma unroll
        for (int i = 0; i < 32; ++i) v[i] = vn[i];
        d = dn; it = itn;
    }
}
__device__ __forceinline__ void p8_router(Frame& F, const Args& a) {
    unsigned char* ws = a.ws;
    constexpr int WPITCH = 2064;
    LAS unsigned char* wl = F.lds;
    LAS float* lg = (LAS float*)(F.lds + 48 * WPITCH) + F.wave * 16 * 48;
    { const GAS u32x4* src = (const GAS u32x4*)(ws + WS_WR);
      for (int i = F.tid; i < 48 * 128; i += NWAVES * 64) { const int r = i >> 7, c = i & 127; *(LAS u32x4*)(wl + r * WPITCH + c * 16) = src[i]; } }
    __syncthreads();
    const bf16* X2B = (const bf16*)(ws + WS_X2B); const float* SSP = (const float*)(ws + WS_SSP);
    const float* b_rg = a.in[20]; const float* b_re = a.in[22];
    float* RSTD = (float*)(ws + WS_RSTD); int* ROUTE = (int*)(ws + WS_ROUTE); int* CNT = (int*)(ws + WS_CTL) + CW_CNT; int* LIST = (int*)(ws + WS_LIST); float* WPOS = (float*)(ws + WS_WPOS); float* RPOS = (float*)(ws + WS_RPOS);
    const int fr = F.lane & 15, fq = F.lane >> 4;
    LAS int* lcnt = (LAS int*)(F.lds + 48 * WPITCH + NWAVES * 16 * 48 * 4);
    LAS int* lbase = lcnt + 32;
    for (int t0 = F.vcu * 64; t0 < T; t0 += F.G * 64) {
        if (F.tid < 32) lcnt[F.tid] = 0;
        __syncthreads();
        int e0 = 0, e1 = 0, lr0 = 0, lr1 = 0; float w0 = 0.f, w1 = 0.f, rstd = 0.f;
        if (F.wave < 4) {
            const int tok = t0 + F.wave * 16 + fr;
            const GAS bf16x8* xa = (const GAS bf16x8*)(X2B + (size_t)tok * D + 8 * fq);
            f32x4 acc[3]; acc[0] = acc[1] = acc[2] = (f32x4){0.f, 0.f, 0.f, 0.f};
            bf16x8 xf[32];
#pragma unroll
            for (int ks = 0; ks < 32; ++ks) xf[ks] = xa[ks * 4];
#pragma unroll
            for (int ks = 0; ks < 32; ++ks) {
#pragma unroll
                for (int n = 0; n < 3; ++n) { const bf16x8 wfr = *(const LAS bf16x8*)(wl + (n * 16 + fr) * WPITCH + ks * 64 + fq * 16);
                    acc[n] = __builtin_amdgcn_mfma_f32_16x16x32_bf16(wfr, xf[ks], acc[n], 0, 0, 0); } }
#pragma unroll
            for (int n = 0; n < 3; ++n) *(LAS f32x4*)(lg + fr * 48 + n * 16 + 4 * fq) = acc[n];
            LDS_WAIT(); asm volatile("" ::: "memory");
            if (F.lane < 16) {
                const int t = t0 + F.wave * 16 + F.lane; const LAS float* l = lg + F.lane * 48;
                float ss = 0.f; { const f32x4* sp = (const f32x4*)(SSP + (size_t)t * 16);
#pragma unroll
                    for (int i = 0; i < 4; ++i) { const f32x4 v = sp[i]; ss += (v[0] + v[1]) + (v[2] + v[3]); } }
                rstd = rsqrtf(ss * (1.f / D) + EPS);
                float gl[4]; int gs = 0;
#pragma unroll
                for (int i = 0; i < 4; ++i) gl[i] = l[i] * rstd + b_rg[i];
                float gm = gl[0];
#pragma unroll
                for (int i = 1; i < 4; ++i) if (gl[i] > gm) { gm = gl[i]; gs = i; }
                float gsum = 0.f;
#pragma unroll
                for (int i = 0; i < 4; ++i) gsum += __expf(gl[i] - gm);
                const float gtop = 1.f / gsum;
                float el[8];
#pragma unroll
                for (int i = 0; i < 8; ++i) el[i] = l[4 + gs * 8 + i] * rstd + b_re[gs * 8 + i];
                int i0 = 0; float m0 = el[0];
#pragma unroll
                for (int i = 1; i < 8; ++i) if (el[i] > m0) { m0 = el[i]; i0 = i; }
                int i1 = -1; float m1 = -3.0e38f;
#pragma unroll
                for (int i = 0; i < 8; ++i) if (i != i0 && el[i] > m1) { m1 = el[i]; i1 = i; }
                const float p1 = __expf(m1 - m0); w0 = gtop / (1.f + p1); w1 = gtop * p1 / (1.f + p1);
                e0 = gs * 8 + i0; e1 = gs * 8 + i1;
                lr0 = __hip_atomic_fetch_add(&lcnt[e0], 1, __ATOMIC_RELAXED, __HIP_MEMORY_SCOPE_WORKGROUP); lr1 = __hip_atomic_fetch_add(&lcnt[e1], 1, __ATOMIC_RELAXED, __HIP_MEMORY_SCOPE_WORKGROUP);
            }
        }
        __syncthreads();
        if (F.tid < 32) { const int c = lcnt[F.tid]; lbase[F.tid] = c ? atomicAdd(&CNT[F.tid], c) : 0; }
        __syncthreads();
        if (F.wave < 4 && F.lane < 16) {
            const int t = t0 + F.wave * 16 + F.lane; const int r0 = lbase[e0] + lr0, r1 = lbase[e1] + lr1;
            RSTD[t] = rstd; *(int4*)(ROUTE + t * 4) = make_int4(e0, e1, r0, r1);
            LIST[e0 * T + r0] = t; LIST[e1 * T + r1] = t; WPOS[e0 * T + r0] = w0; WPOS[e1 * T + r1] = w1; RPOS[e0 * T + r0] = rstd; RPOS[e1 * T + r1] = rstd;
        }
        __syncthreads();
    }
}
__device__ __forceinline__ void moe_table(Frame& F, const int* CNT, LAS int* tb) {
    if (F.tid < 64) { const int e = F.lane; int c = 0; if (e < NE) c = (int)__hip_atomic_load((const unsigned*)CNT + e, __ATOMIC_RELAXED, __HIP_MEMORY_SCOPE_AGENT);
        const int tl = (c + 255) >> 8; int incl = tl;
#pragma unroll
        for (int o = 1; o < 32; o <<= 1) { const int v = __shfl_up(incl, o); if (e >= o) incl += v; }
        if (e < NE) { tb[e] = incl - tl; tb[64 + e] = c; } if (e == NE - 1) tb[32] = incl; }
    __syncthreads();
}
__device__ __forceinline__ int moe_find(const LAS int* tb, int mt) { int e = 0;
#pragma unroll 1
    for (int i = 1; i < NE; ++i) if (mt >= tb[i]) e = i; return e; }
struct PhMoeGU {
    static constexpr bool GATHER = true;
    unsigned lda, ldb; const char* X; const char* W; const LAS int* tb; const int* LIST; const float* RPOS; bf16* H; int G, c;
    __device__ __forceinline__ bool next(int i, pg::Unit& u) const { const int L = i * G + c; if (L >= 2 * tb[32]) return false; const int mt = L >> 1, n2 = L & 1, e = moe_find(tb, mt);
        u.A = X; u.B = W + ((size_t)e * 512 + n2 * 256) * ldb; u.nt = D / 64; u.pm = mt; u.pn = n2; u.aux = e; return true; }
    __device__ __forceinline__ void offs(const pg::Unit& u, const int (&R)[2], const int (&C)[2], unsigned (&vo)[2][2]) const {
        const int e = u.aux, cnt = tb[64 + e], r0 = (u.pm - tb[e]) * 256; const int* lp = LIST + (size_t)e * T;
#pragma unroll
        for (int h = 0; h < 2; ++h)
#pragma unroll
            for (int i = 0; i < 2; ++i) { int r = r0 + h * 128 + R[i]; r = r < cnt ? r : cnt - 1; vo[h][i] = (unsigned)lp[r] * lda + (unsigned)C[i] * 2u; }
    }
    __device__ __forceinline__ void epi(const f32x4 (&acc)[2][2][4][2], const pg::Unit& u, int wr, int wc, int fr, int fq) const {
        const int e = u.aux, r0 = (u.pm - tb[e]) * 256; const float* rp = RPOS + (size_t)e * T + r0;
#pragma unroll
        for (int ai = 0; ai < 2; ++ai)
#pragma unroll
            for (int m = 0; m < 4; ++m) { const int tr = ai * 128 + wr * 64 + m * 16 + fr; const float rs = rp[tr];
                f32x4 g0 = acc[ai][0][m][0] * rs, g1 = acc[ai][0][m][1] * rs; const f32x4 u0 = acc[ai][1][m][0] * rs, u1 = acc[ai][1][m][1] * rs;
#pragma unroll
                for (int q = 0; q < 4; ++q) { g0[q] = g0[q] * pg::fsigmoid(g0[q]) * u0[q]; g1[q] = g1[q] * pg::fsigmoid(g1[q]) * u1[q]; }
                *(u32x4*)(H + ((size_t)u.pm * 256 + tr) * DE + u.pn * 128 + 32 * wc + 8 * fq) = pg::pack8(g0, g1); }
    }
};
struct PhMoeDown {
    static constexpr bool GATHER = false;
    unsigned lda, ldb; const char* Hp; const char* W; const LAS int* tb; const float* WPOS; bf16* Y; int G, c;
    __device__ __forceinline__ bool next(int i, pg::Unit& u) const { const int L = i * G + c; if (L >= 4 * tb[32]) return false; const int mt = L >> 2, n4 = L & 3, e = moe_find(tb, mt);
        u.A = Hp + (size_t)mt * 256 * lda; u.B = W + ((size_t)e * D + n4 * 256) * ldb; u.nt = DE / 64; u.pm = mt; u.pn = n4; u.aux = e; return true; }
    __device__ __forceinline__ void offs(const pg::Unit&, const int (&R)[2], const int (&C)[2], unsigned (&vo)[2][2]) const { pg::offs_plain(lda, R, C, vo); }
    __device__ __forceinline__ void epi(const f32x4 (&acc)[2][2][4][2], const pg::Unit& u, int wr, int wc, int fr, int fq) const {
        const int e = u.aux, r0 = (u.pm - tb[e]) * 256; const float* wp = WPOS + (size_t)e * T + r0;
#pragma unroll
        for (int ai = 0; ai < 2; ++ai)
#pragma unroll
            for (int m = 0; m < 4; ++m) { const int tr = ai * 128 + wr * 64 + m * 16 + fr; const float w = wp[tr]; bf16* yp = Y + ((size_t)u.pm * 256 + tr) * D + u.pn * 256 + 32 * wc + 8 * fq;
#pragma unroll
                for (int bj = 0; bj < 2; ++bj) *(u32x4*)(yp + 128 * bj) = pg::pack8(acc[ai][bj][m][0] * w, acc[ai][bj][m][1] * w); }
    }
};
__device__ __forceinline__ void p11_combine(Frame& F, const Args& a, const LAS int* tb) {
    unsigned char* ws = a.ws; const int* ROUTE = (const int*)(ws + WS_ROUTE); const bf16* Y = (const bf16*)(ws + WS_Y); const bf16* X2B = (const bf16*)(ws + WS_X2B); float* out = a.out;
    for (int t = F.vcu * NWAVES + F.wave; t < T; t += F.G * NWAVES) {
        const int4 rt = *(const int4*)(ROUTE + t * 4);
        const GAS u32x2* y0 = (const GAS u32x2*)(Y + ((size_t)tb[rt.x] * 256 + rt.z) * D) + F.lane; const GAS u32x2* y1 = (const GAS u32x2*)(Y + ((size_t)tb[rt.y] * 256 + rt.w) * D) + F.lane;
        const GAS u32x2* xb = (const GAS u32x2*)(X2B + (size_t)t * D) + F.lane;
        GAS f32x4* o = (GAS f32x4*)(out + (size_t)t * D) + F.lane;
#pragma unroll
        for (int j = 0; j < 4; ++j) { const u32x2 a0 = y0[64 * j], a1 = y1[64 * j], xv = xb[64 * j]; f32x4 v;
            v[0] = __builtin_bit_cast(float, xv.x << 16) + (__builtin_bit_cast(float, a0.x << 16) + __builtin_bit_cast(float, a1.x << 16)); v[1] = __builtin_bit_cast(float, xv.x & 0xffff0000u) + (__builtin_bit_cast(float, a0.x & 0xffff0000u) + __builtin_bit_cast(float, a1.x & 0xffff0000u));
            v[2] = __builtin_bit_cast(float, xv.y << 16) + (__builtin_bit_cast(float, a0.y << 16) + __builtin_bit_cast(float, a1.y << 16)); v[3] = __builtin_bit_cast(float, xv.y & 0xffff0000u) + (__builtin_bit_cast(float, a0.y & 0xffff0000u) + __builtin_bit_cast(float, a1.y & 0xffff0000u));
            o[64 * j] = v; }
    }
}

struct PhSsmX {
    static constexpr bool GATHER = false;
    unsigned lda, ldb; const char* U2X; const char* M1T; float* SLOC; int g, b;
    __device__ __forceinline__ bool next(int i, pg::Unit& u) const { if (i >= 1) return false; u.A = U2X + ((size_t)(g * NCR + b * 256) * U2P + 128) * 2; u.B = M1T + (size_t)g * 256 * ldb; u.nt = 8; u.pm = b; u.pn = 0; u.aux = 0; return true; }
    __device__ __forceinline__ void offs(const pg::Unit&, const int (&R)[2], const int (&C)[2], unsigned (&vo)[2][2]) const { pg::offs_plain(lda, R, C, vo); }
    __device__ __forceinline__ void epi(const f32x4 (&acc)[2][2][4][2], const pg::Unit& u, int wr, int wc, int fr, int fq) const {
#pragma unroll
        for (int ai = 0; ai < 2; ++ai)
#pragma unroll
            for (int m = 0; m < 4; ++m) { float* p = SLOC + ((size_t)g * NCR + u.pm * 256 + ai * 128 + wr * 64 + m * 16 + fr) * 128 + 32 * wc + 8 * fq;
                *(f32x4*)p = acc[ai][0][m][0]; *(f32x4*)(p + 4) = acc[ai][0][m][1]; }
    }
};
__device__ __forceinline__ void ssm_scan(Frame& F, unsigned char* ws, int g, int b) {
    LAS f32x2* ends = (LAS f32x2*)F.lds;
    const int p = F.lane, w = F.wave;
    const float alr = ((const float*)(ws + WS_AL))[(g * NP + p) * 2], ali = ((const float*)(ws + WS_AL))[(g * NP + p) * 2 + 1];
    const float* sl = (const float*)(ws + WS_SLOC) + ((size_t)g * NCR + b * 256 + w * 32) * 128;
    float lr[32], li[32];
#pragma unroll
    for (int k = 0; k < 32; ++k) { lr[k] = sl[k * 128 + p]; li[k] = sl[k * 128 + 64 + p]; }
#pragma unroll
    for (int k = 1; k < 32; ++k) { const float nr = alr * lr[k - 1] - ali * li[k - 1] + lr[k], ni = alr * li[k - 1] + ali * lr[k - 1] + li[k]; lr[k] = nr; li[k] = ni; }
    ends[w * 64 + p] = (f32x2){lr[31], li[31]};
    float sr = alr, si = ali;
#pragma unroll
    for (int k = 0; k < 5; ++k) { const float t = sr * sr - si * si; si = 2.f * sr * si; sr = t; }
    __syncthreads();
    float cr = 0.f, ci = 0.f;
    for (int s2 = 0; s2 < w; ++s2) { const f32x2 e = ends[s2 * 64 + p]; const float t = sr * cr - si * ci + e.x; ci = sr * ci + si * cr + e.y; cr = t; }
    bf16* hp = (bf16*)(ws + WS_U2X) + ((size_t)g * NCR + b * 256 + w * 32) * U2P;
    float pr = cr, pi = ci;
#pragma unroll
    for (int k = 0; k < 32; ++k) { const float hr = (k ? lr[k - 1] : 0.f) + pr, hi = (k ? li[k - 1] : 0.f) + pi;
        hp[(size_t)k * U2P + p] = f2bf(hr); hp[(size_t)k * U2P + 64 + p] = f2bf(hi);
        const float t = alr * pr - ali * pi; pi = alr * pi + ali * pr; pr = t; }
    __syncthreads();
}
struct PhSsmY {
    static constexpr bool GATHER = false;
    unsigned lda, ldb; const char* U2Xp; const char* BTY; const bf16* U2X; const float* Dsk; bf16* Y1; int G, c;
    __device__ __forceinline__ bool next(int i, pg::Unit& u) const { const int L = i * G + c; if (L >= NG * 4) return false; const int g = L >> 2, mt = (L >> 1) & 1, nb = L & 1;
        u.A = U2Xp + (size_t)(g * NCR + mt * 256) * lda; u.B = BTY + (size_t)(g * 512 + nb * 256) * ldb; u.nt = nb ? 10 : 6; u.pm = mt; u.pn = nb; u.aux = g; return true; }
    __device__ __forceinline__ void offs(const pg::Unit&, const int (&R)[2], const int (&C)[2], unsigned (&vo)[2][2]) const { pg::offs_plain(lda, R, C, vo); }
    __device__ __forceinline__ void epi(const f32x4 (&acc)[2][2][4][2], const pg::Unit& u, int wr, int wc, int fr, int fq) const {
        const int g = u.aux;
#pragma unroll
        for (int bj = 0; bj < 2; ++bj) { const int n = u.pn * 256 + 128 * bj + 32 * wc + 8 * fq, j = n >> 4, c0 = n & 15;
            const f32x4 d0 = *(const f32x4*)(Dsk + g * GC + c0), d1 = *(const f32x4*)(Dsk + g * GC + c0 + 4);
#pragma unroll
            for (int ai = 0; ai < 2; ++ai)
#pragma unroll
                for (int m = 0; m < 4; ++m) { const int cr = u.pm * 256 + ai * 128 + wr * 64 + m * 16 + fr;
                    const u32x4 uv = *(const u32x4*)(U2X + ((size_t)g * NCR + cr) * U2P + 128 + j * GC + c0); f32x4 u0, u1; pg::unpack8(uv, u0, u1);
                    f32x4 a = acc[ai][bj][m][0] + d0 * u0, b = acc[ai][bj][m][1] + d1 * u1;
#pragma unroll
                    for (int q = 0; q < 4; ++q) { a[q] = gelu_fast(a[q]); b[q] = gelu_fast(b[q]); }
                    *(u32x4*)(Y1 + ((size_t)cr * LCH + j) * DS + g * GC + c0) = pg::pack8(a, b); } }
    }
};

__global__ void __launch_bounds__(NWAVES * 64, 2) mk_fwd(Args args) {
    extern __shared__ __attribute__((aligned(16))) unsigned char lds[];
    Frame F;
    F.lds = (LAS unsigned char*)lds; F.MISC = (volatile LAS unsigned*)(F.lds + MISC_OFF);
    F.tid = threadIdx.x; F.lane = F.tid & 63; F.wave = __builtin_amdgcn_readfirstlane(F.tid >> 6);
    F.G = gridDim.x; { const int bx = blockIdx.x; F.vcu = (F.G % 8 == 0) ? (bx % 8) * (F.G / 8) + bx / 8 : bx; }
    unsigned char* ws = args.ws; F.ctl = (gu32*)(ws + WS_CTL);
    for (int u = F.tid; u < (LDS_BYTES - LDSCTL_OFF) / 4; u += NWAVES * 64) ((LAS unsigned*)(F.lds + LDSCTL_OFF))[u] = 0u;
    __syncthreads();
    const int lo = args.ph_lo, hi = args.ph_hi;
    const bool multi = (hi - lo) > 1;
    XcdBarrier bar; bar.bar = (unsigned*)(F.ctl + CW_BAR); bar.x = 0; bar.st = nullptr;
    if (multi) bar = xcd_barrier_post((unsigned*)(F.ctl + CW_BAR), F.MISC + 8);
#define IN(k) (lo <= (k) && (k) < hi)
#define SEAM(k) do { if (IN(k) && IN((k) + 1)) xcd_barrier(bar); } while (0)
    if (IN(0)) { p0_prologue(F, args); SEAM(0); }
    if (IN(1)) {
        if (blockIdx.x < NBATCH * NH) p1_cumsum(F, (float*)(ws + WS_CUM));
        PhInProj ph; ph.lda = D * 2; ph.ldb = D * 2; ph.A = (const char*)(ws + WS_XN); ph.B = (const char*)(ws + WS_WIN); ph.so.init(T / 256, 4096 / 256, F.G, (int)blockIdx.x);
        ph.Q = (bf16*)(ws + WS_Q); ph.K = (bf16*)(ws + WS_K); ph.V = (bf16*)(ws + WS_V); ph.U2X = (bf16*)(ws + WS_U2X); ph.GA = (bf16*)(ws + WS_GA); ph.GS = (bf16*)(ws + WS_GS);
        ph.gq = args.in[4]; ph.gk = args.in[5];
        pg::gemm_phase(F.lds + RING_OFF, ph);
        SEAM(1);
    }
    if (IN(2)) {
        if (blockIdx.x < 2 * NG) {
            const int g = (int)blockIdx.x >> 1, b = (int)blockIdx.x & 1;
            PhSsmX ph; ph.lda = U2P * 2; ph.ldb = 512 * 2; ph.U2X = (const char*)(ws + WS_U2X); ph.M1T = (const char*)(ws + WS_M1T); ph.SLOC = (float*)(ws + WS_SLOC); ph.g = g; ph.b = b;
            if (args.sub & 1) pg::gemm_phase(F.lds + RING_OFF, ph);
            if (args.sub & 2) ssm_scan(F, ws, g, b);
            __syncthreads();
        } else if (F.G == 256) p2_side_work(F, args);
        p2_expert_weights(F, args); SEAM(2);
    }
    if (IN(3)) {
        static_assert(attn_body::ATTN_LDS_BYTES <= RING_BYTES, "attention LDS");
        const attn_body::AttnTensors AT{(const attn_body::bf16*)(ws + WS_Q), (const attn_body::bf16*)(ws + WS_K), (const attn_body::bf16*)(ws + WS_V), (attn_body::bf16*)(ws + WS_Q), (const float*)(ws + WS_CUM)};
        const attn_body::StaticOrder S(F.vcu);
        attn_body::attn_phase<attn_body::StaticOrder, 20>((char*)lds + RING_OFF, AT, S);
        SEAM(3);
    }
    if (IN(4)) {
        PhSsmY ph; ph.lda = U2P * 2; ph.ldb = U2P * 2; ph.U2Xp = (const char*)(ws + WS_U2X); ph.BTY = (const char*)(ws + WS_BTY); ph.U2X = (const bf16*)(ws + WS_U2X); ph.Dsk = args.in[13]; ph.Y1 = (bf16*)(ws + WS_Y1); ph.G = F.G; ph.c = F.vcu;
        pg::gemm_phase(F.lds + RING_OFF, ph);
        SEAM(4);
    }
    if (IN(5)) {
        PhGlu ph; ph.lda = DS * 2; ph.ldb = DS * 2; ph.A = (const char*)(ws + WS_Y1); ph.B = (const char*)(ws + WS_WGLU); ph.so.init(T / 256, DS / 256, F.G, (int)blockIdx.x); ph.Y1 = (const bf16*)(ws + WS_Y1); ph.YS = (bf16*)(ws + WS_YS);
        pg::gemm_phase(F.lds + RING_OFF, ph);
        SEAM(5);
    }
    if (IN(6)) {
        PhProj ph; ph.lda = DA * 2; ph.ldb = DA * 2; ph.O = (const char*)(ws + WS_Q); ph.YSp = (const char*)(ws + WS_YS); ph.WPA = (const char*)(ws + WS_WPA); ph.WPS = (const char*)(ws + WS_WPS);
        ph.so.init(T / 256, D / 256, F.G, (int)blockIdx.x); ph.GA = (bf16*)(ws + WS_GA); ph.GS = (const bf16*)(ws + WS_GS);
        pg::gemm_phase(F.lds + RING_OFF, ph);
        SEAM(6);
    }
    if (IN(7)) {
        PhWout ph; ph.lda = D * 2; ph.ldb = D * 2; ph.A = (const char*)(ws + WS_GA); ph.B = (const char*)(ws + WS_WOUT); ph.so.init(T / 256, D / 256, F.G, (int)blockIdx.x);
        ph.x = args.in[0]; ph.out = args.out; ph.X2B = (bf16*)(ws + WS_X2B); ph.SSP = (float*)(ws + WS_SSP);
        pg::gemm_phase(F.lds + RING_OFF, ph);
        SEAM(7);
    }
    if (IN(8)) { p8_router(F, args); SEAM(8); }
    LAS int* tb = (LAS int*)(F.lds + LDSCTL_OFF + 512);
    if (IN(9)) {
        moe_table(F, (const int*)(ws + WS_CTL) + CW_CNT, tb);
        PhMoeGU ph; ph.lda = D * 2; ph.ldb = D * 2; ph.X = (const char*)(ws + WS_X2B); ph.W = (const char*)(ws + WS_WGU); ph.tb = tb; ph.LIST = (const int*)(ws + WS_LIST); ph.RPOS = (const float*)(ws + WS_RPOS);
        ph.H = (bf16*)(ws + WS_H); ph.G = F.G; ph.c = F.vcu;
        pg::gemm_phase(F.lds + RING_OFF, ph);
        SEAM(9);
    }
    if (IN(10)) {
        if (!IN(9)) moe_table(F, (const int*)(ws + WS_CTL) + CW_CNT, tb);
        PhMoeDown ph; ph.lda = DE * 2; ph.ldb = DE * 2; ph.Hp = (const char*)(ws + WS_H); ph.W = (const char*)(ws + WS_WD); ph.tb = tb; ph.WPOS = (const float*)(ws + WS_WPOS); ph.Y = (bf16*)(ws + WS_Y); ph.G = F.G; ph.c = F.vcu;
        pg::gemm_phase(F.lds + RING_OFF, ph);
        SEAM(10);
    }
    if (IN(11)) {
        if (!IN(10)) moe_table(F, (const int*)(ws + WS_CTL) + CW_CNT, tb);
        p11_combine(F, args, tb);
    }
#undef IN
#undef SEAM
}

extern "C" void kernel_launch(void* const* d_in, const int* in_sizes, int n_in, void* d_out, int out_size, void* d_ws, size_t ws_size, hipStream_t stream) {
    static int grid = 0;
    if (grid == 0) {
        int dev = 0, cus = 0; (void)hipGetDevice(&dev); (void)hipDeviceGetAttribute(&cus, hipDeviceAttributeMultiprocessorCount, dev);
        (void)hipFuncSetAttribute((const void*)mk_fwd, hipFuncAttributeMaxDynamicSharedMemorySize, LDS_BYTES);
        grid = cus > 0 ? cus : 256;
    }
    (void)hipMemsetAsync((char*)d_ws + WS_CTL, 0, CTL_ZERO_BYTES, stream);
    Args a{}; for (int i = 0; i < 26; ++i) a.in[i] = (const float*)d_in[i]; a.out = (float*)d_out; a.ws = (unsigned char*)d_ws;
    a.ph_lo = 0; a.ph_hi = 12; a.sub = 7;
    hipLaunchKernelGGL(mk_fwd, dim3(grid), dim3(NWAVES * 64), LDS_BYTES, stream, a);
}
```

```cpp
#include <hip/hip_runtime.h>
#include <stdint.h>
#include <math.h>

typedef unsigned short bf16;
constexpr int T = 16384, D = 1024, SEQ = 8192, NBATCH = 2, NH = 8, HD = 64, DA = 512, DS = 512, NG = 32, GC = 16, NP = 64, NE = 32, DE = 256;
constexpr int DIN = 4104, OQ = 0, OK_ = 512, OV = 1024, OF = 1536, OU = 1544, OGA = 2056, OGS = 3080;
constexpr int LCH = 32, NCR = T / LCH;
constexpr int U2P = 640;
constexpr float EPS = 1e-6f;
constexpr float C2 = 0.125f * 1.4426950408889634f;
constexpr float LOG2E = 1.4426950408889634f;
constexpr int YROWS = 40960;

constexpr size_t MiB = 1u << 20;
constexpr size_t WS_CTL = 0, CTL_ZERO_BYTES = 1 * MiB;
constexpr size_t WS_CUM = 1 * MiB;
constexpr size_t WS_AL = 1 * MiB + 512 * 1024;
constexpr size_t WS_T0 = 1 * MiB + 768 * 1024;
constexpr size_t WS_PS = 8 * MiB;
constexpr size_t WS_PO = 229 * MiB;
constexpr size_t WS_RSTD = 2 * MiB;
constexpr size_t WS_ROUTE = 2 * MiB + 256 * 1024;
constexpr size_t WS_LIST = 3 * MiB;
constexpr size_t WS_WPOS = 5 * MiB;
constexpr size_t WS_SSP = 7 * MiB;
constexpr size_t WS_WIN = 8 * MiB;
constexpr size_t WS_SLOC = 229 * MiB;
constexpr size_t WS_WGLU = 16 * MiB, WS_WPA = 16 * MiB + 512 * 1024, WS_WPS = 17 * MiB + 512 * 1024, WS_WOUT = 18 * MiB + 512 * 1024, WS_WR = 20 * MiB + 512 * 1024;
constexpr size_t WS_M1T = 21 * MiB;
constexpr size_t WS_BTY = 29 * MiB;
constexpr size_t WS_XN = 49 * MiB;
constexpr size_t WS_WGU = 49 * MiB;
constexpr size_t WS_Q = 81 * MiB;
constexpr size_t WS_K = 97 * MiB;
constexpr size_t WS_V = 113 * MiB;
constexpr size_t WS_Y1 = 97 * MiB, WS_YS = 113 * MiB;
constexpr size_t WS_U2X = 129 * MiB;
constexpr size_t WS_GA = 149 * MiB;
constexpr size_t WS_GS = 181 * MiB;
constexpr size_t WS_X2B = 181 * MiB;
constexpr size_t WS_WD = 213 * MiB;
constexpr size_t WS_H = 229 * MiB;
constexpr size_t WS_RPOS = 249 * MiB;
constexpr size_t WS_KTG = 251 * MiB;
constexpr size_t WS_Y = 81 * MiB;
static_assert(WS_H + (size_t)YROWS * DE * 2 <= WS_RPOS && WS_RPOS + 2 * MiB <= WS_KTG && WS_KTG + MiB <= 256 * MiB && WS_Y + (size_t)YROWS * D * 2 <= WS_GS, "d_ws map");

__device__ __forceinline__ bf16 f2bf(float f) { unsigned u = __builtin_bit_cast(unsigned, f); return (bf16)((u + 0x7fffu + ((u >> 16) & 1u)) >> 16); }
__device__ __forceinline__ float bf2f(bf16 b) { return __builtin_bit_cast(float, (unsigned)b << 16); }
__device__ __forceinline__ float sigmoidf_(float x) { return 1.f / (1.f + __expf(-x)); }
__device__ __forceinline__ float gelu_tanh(float x) { const float z = 0.7978845608028654f * (x + 0.044715f * x * x * x); const float e = __expf(2.f * z); return 0.5f * x * (1.f + (1.f - 2.f / (e + 1.f))); }
__device__ __forceinline__ float log_sigmoid(float x) { return -(fmaxf(-x, 0.f) + log1pf(__expf(-fabsf(x)))); }
__device__ __forceinline__ size_t u2x_index(int g, int t, int c) { return ((size_t)g * NCR + (t / LCH)) * U2P + 128 + (t % LCH) * GC + c; }

#define LAS __attribute__((address_space(3)))
#define GAS __attribute__((address_space(1)))
typedef short bf16x8 __attribute__((ext_vector_type(8)));
typedef float f32x4 __attribute__((ext_vector_type(4)));
typedef float f32x2 __attribute__((ext_vector_type(2)));
typedef unsigned u32x4 __attribute__((ext_vector_type(4)));
typedef unsigned u32x2 __attribute__((ext_vector_type(2)));
namespace pg {
constexpr int BM = 256, BK = 64, HALF = 128, HTB = HALF * BK * 2, STAGE_BYTES = 8 * HTB, NXCD = 8, WGM = 8;
__host__ __device__ __forceinline__ int lds_byte(int r, int c) { const int st = (r >> 4) * 2 + (c >> 5), rr = r & 15, cc = c & 31, ob = rr * 64 + cc * 2; return st * 1024 + (ob ^ (((ob >> 9) & 1) << 5)); }
__host__ __device__ __forceinline__ void stage_rc(int b, int& R, int& C) { const int st = b / 1024, sb = b % 1024, swz = sb ^ (((sb >> 9) & 1) << 5); R = (st >> 1) * 16 + swz / 64; C = (st & 1) * 32 + (swz % 64) / 2; }
__host__ __device__ __forceinline__ int perm32(int rho) { const int n = rho >> 4, i = rho & 15; return 8 * (i >> 2) + 4 * n + (i & 3); }
typedef __bf16 bf16x2_t __attribute__((ext_vector_type(2)));
__device__ __forceinline__ unsigned cvt_pk_bf16(float lo, float hi) { const f32x2 v = {lo, hi}; const bf16x2_t b = __builtin_convertvector(v, bf16x2_t); return __builtin_bit_cast(unsigned, b); }
__device__ __forceinline__ u32x4 pack8(const f32x4& a, const f32x4& b) { u32x4 w; w.x = cvt_pk_bf16(a[0], a[1]); w.y = cvt_pk_bf16(a[2], a[3]); w.z = cvt_pk_bf16(b[0], b[1]); w.w = cvt_pk_bf16(b[2], b[3]); return w; }
__device__ __forceinline__ void unpack8(const u32x4& w, f32x4& a, f32x4& b) {
    a[0] = __builtin_bit_cast(float, w.x << 16); a[1] = __builtin_bit_cast(float, w.x & 0xffff0000u); a[2] = __builtin_bit_cast(float, w.y << 16); a[3] = __builtin_bit_cast(float, w.y & 0xffff0000u);
    b[0] = __builtin_bit_cast(float, w.z << 16); b[1] = __builtin_bit_cast(float, w.z & 0xffff0000u); b[2] = __builtin_bit_cast(float, w.w << 16); b[3] = __builtin_bit_cast(float, w.w & 0xffff0000u); }
__device__ __forceinline__ float fsigmoid(float x) { return __builtin_amdgcn_rcpf(1.f + __builtin_amdgcn_exp2f(-1.4426950408889634f * x)); }

struct Unit { const char* A; const char* B; int nt; int pm, pn, aux; };

struct StaticOrder {
    int nM, nN, nwg, G, c;
    __device__ void init(int nM_, int nN_, int G_, int c_) { nM = nM_; nN = nN_; nwg = nM * nN; G = G_; c = c_; }
    __device__ bool next(int i, int& pm, int& pn) const {
        const long L = (long)i * G + c; if (L >= nwg) return false;
        int wgid = (int)L; { const int q = nwg / NXCD, r = nwg % NXCD, xcd = wgid % NXCD, off = wgid / NXCD; wgid = (xcd < r ? xcd * (q + 1) : r * (q + 1) + (xcd - r) * q) + off; }
        const int nig = WGM * nN, gid = wgid / nig, fm = gid * WGM, gsz = (nM - fm) < WGM ? (nM - fm) : WGM;
        pm = fm + ((wgid % nig) % gsz); pn = (wgid % nig) / gsz; return true;
    }
};

template <class P>
__device__ __forceinline__ void gemm_phase(LAS unsigned char* lds, P& ph) {
    const int tid = threadIdx.x, wid = __builtin_amdgcn_readfirstlane(tid >> 6), lane = tid & 63, wr = wid >> 2, wc = wid & 3, fr = lane & 15, fq = lane >> 4;
    const unsigned lda = ph.lda, ldb = ph.ldb;
    int Rr[2], Cc[2]; unsigned voffB[2], vo[2][2], nvo[2][2];
#pragma unroll
    for (int i = 0; i < 2; ++i) { stage_rc(tid * 16 + i * 8192, Rr[i], Cc[i]); const int Rb = (Rr[i] & ~31) + perm32(Rr[i] & 31); voffB[i] = (unsigned)Rb * ldb + (unsigned)Cc[i] * 2u; }
    const size_t kstep = (size_t)(BK * 2);
    const size_t hstepB = (size_t)HALF * ldb;
    const unsigned ldsw = (unsigned)wid * 1024u;
    const int aoff = lds_byte(wr * 64 + fr, fq * 8), boff = lds_byte(wc * 32 + fr, fq * 8);
#define PG_SA(b, h) (((b) * 2 + (h)) * HTB)
#define PG_SB(b, h) ((4 + (b) * 2 + (h)) * HTB)
#define PG_STAGE_B(bufoff, gbase) do { _Pragma("unroll") for (int _i = 0; _i < 2; ++_i) \
        __builtin_amdgcn_global_load_lds((const unsigned*)((const char*)(gbase) + voffB[_i]), (LAS unsigned*)(lds + (bufoff) + ldsw + _i * 8192), 16, 0, 0); } while (0)
#define PG_STAGE_A(bufoff, gbase, VO, h) do { _Pragma("unroll") for (int _i = 0; _i < 2; ++_i) \
        __builtin_amdgcn_global_load_lds((const unsigned*)((const char*)(gbase) + (VO)[h][_i]), (LAS unsigned*)(lds + (bufoff) + ldsw + _i * 8192), 16, 0, 0); } while (0)
#define PG_LDA(dst, b, h) do { _Pragma("unroll") for (int m = 0; m < 4; ++m) _Pragma("unroll") for (int k = 0; k < 2; ++k) dst[m][k] = *(const LAS bf16x8*)(lds + PG_SA(b, h) + aoff + m * 2048 + k * 1024); } while (0)
#define PG_LDB(dst, b, h) do { _Pragma("unroll") for (int n = 0; n < 2; ++n) _Pragma("unroll") for (int k = 0; k < 2; ++k) dst[n][k] = *(const LAS bf16x8*)(lds + PG_SB(b, h) + boff + n * 2048 + k * 1024); } while (0)
#define PG_MMA(ai, bj, At, Bt) do { __builtin_amdgcn_s_setprio(1); _Pragma("unroll") for (int m = 0; m < 4; ++m) _Pragma("unroll") for (int n = 0; n < 2; ++n) _Pragma("unroll") for (int k = 0; k < 2; ++k) \
        acc[ai][bj][m][n] = __builtin_amdgcn_mfma_f32_16x16x32_bf16(Bt[n][k], At[m][k], acc[ai][bj][m][n], 0, 0, 0); __builtin_amdgcn_s_setprio(0); } while (0)
#define PG_WAIT_V(n) asm volatile("s_waitcnt vmcnt(" #n ")" ::: "memory")
#define PG_WAIT_L(n) asm volatile("s_waitcnt lgkmcnt(" #n ")" ::: "memory")
#define PG_BAR __builtin_amdgcn_s_barrier()
#define PG_SCHED __builtin_amdgcn_sched_barrier(0)
    Unit cur, nxt; int ui = 0;
    if (!ph.next(0, cur)) return;
    ph.offs(cur, Rr, Cc, vo);
    f32x4 acc[2][2][4][2];
#pragma unroll
    for (int a = 0; a < 2; ++a)
#pragma unroll
        for (int b = 0; b < 2; ++b)
#pragma unroll
            for (int m = 0; m < 4; ++m)
#pragma unroll
                for (int n = 0; n < 2; ++n) acc[a][b][m][n] = (f32x4){0.f, 0.f, 0.f, 0.f};
    bf16x8 At[4][2], B0[2][2], B1[2][2];
    const char* cA = cur.A; const char* cB = cur.B;
    PG_STAGE_B(PG_SB(0, 0), cB); PG_STAGE_B(PG_SB(0, 1), cB + hstepB); PG_STAGE_A(PG_SA(0, 0), cA, vo, 0); PG_STAGE_A(PG_SA(0, 1), cA, vo, 1);
    if (wr == 1) PG_BAR;
    PG_WAIT_V(2); PG_BAR;
    PG_STAGE_B(PG_SB(1, 0), cB + kstep); PG_STAGE_A(PG_SA(1, 0), cA + kstep, vo, 0); PG_STAGE_B(PG_SB(1, 1), cB + hstepB + kstep);
    PG_WAIT_V(6); PG_BAR;
    for (;;) {
        const bool has_next = ph.next(ui + 1, nxt);
        const int nt = cur.nt;
        const char* nA = has_next ? nxt.A : cA; const char* nB = has_next ? nxt.B : cB;
        if (P::GATHER) { if (has_next) ph.offs(nxt, Rr, Cc, nvo); else {
#pragma unroll
            for (int h = 0; h < 2; ++h)
#pragma unroll
                for (int i = 0; i < 2; ++i) nvo[h][i] = vo[h][i]; } }
#pragma unroll 1
        for (int t = 0; t < nt; t += 2) {
            const bool last = (t == nt - 2);
            const char* a1 = cA + (size_t)(t + 1) * kstep;
            const char* a2 = last ? nA : cA + (size_t)(t + 2) * kstep; const char* b2 = last ? nB : cB + (size_t)(t + 2) * kstep;
            const char* a3 = a2 + kstep; const char* b3 = b2 + kstep;
            unsigned v2[2][2];
#pragma unroll
            for (int h = 0; h < 2; ++h)
#pragma unroll
                for (int i = 0; i < 2; ++i) v2[h][i] = (P::GATHER && last) ? nvo[h][i] : vo[h][i];
            PG_LDB(B0, 0, 0); PG_LDB(B1, 0, 1); PG_SCHED; PG_LDA(At, 0, 0); PG_STAGE_A(PG_SA(1, 1), a1, vo, 1);
            PG_WAIT_V(8); PG_WAIT_L(0); PG_BAR; PG_MMA(0, 0, At, B0); PG_MMA(0, 1, At, B1); PG_BAR; PG_SCHED;
            PG_LDA(At, 0, 1); PG_STAGE_B(PG_SB(0, 0), b2); PG_STAGE_B(PG_SB(0, 1), b2 + hstepB); PG_STAGE_A(PG_SA(0, 0), a2, v2, 0);
            PG_WAIT_V(8); PG_WAIT_L(0); PG_BAR; PG_MMA(1, 0, At, B0); PG_MMA(1, 1, At, B1); PG_BAR; PG_SCHED;
            PG_LDB(B0, 1, 0); PG_LDB(B1, 1, 1); PG_SCHED; PG_LDA(At, 1, 0); PG_STAGE_A(PG_SA(0, 1), a2, v2, 1);
            PG_WAIT_V(8); PG_WAIT_L(0); PG_BAR; PG_MMA(0, 0, At, B0); PG_MMA(0, 1, At, B1); PG_BAR; PG_SCHED;
            PG_LDA(At, 1, 1); PG_STAGE_B(PG_SB(1, 0), b3); PG_STAGE_B(PG_SB(1, 1), b3 + hstepB); PG_STAGE_A(PG_SA(1, 0), a3, v2, 0);
            PG_WAIT_V(8); PG_WAIT_L(0); PG_BAR; PG_MMA(1, 0, At, B0); PG_MMA(1, 1, At, B1); PG_BAR; PG_SCHED;
        }
        if (wr == 0) PG_BAR;
        ph.epi(acc, cur, wr, wc, fr, fq);
        if (!has_next) break;
#pragma unroll
        for (int a = 0; a < 2; ++a)
#pragma unroll
            for (int b = 0; b < 2; ++b)
#pragma unroll
                for (int m = 0; m < 4; ++m)
#pragma unroll
                    for (int n = 0; n < 2; ++n) acc[a][b][m][n] = (f32x4){0.f, 0.f, 0.f, 0.f};
        cur = nxt; cA = nA; cB = nB; ++ui;
        if (P::GATHER) {
#pragma unroll
            for (int h = 0; h < 2; ++h)
#pragma unroll
                for (int i = 0; i < 2; ++i) vo[h][i] = nvo[h][i]; }
        if (wr == 1) PG_BAR;
    }
    PG_WAIT_V(0);
    PG_BAR;
#undef PG_SA
#undef PG_SB
#undef PG_STAGE_A
#undef PG_STAGE_B
#undef PG_LDA
#undef PG_LDB
#undef PG_MMA
#undef PG_WAIT_V
#undef PG_WAIT_L
#undef PG_BAR
#undef PG_SCHED
}
__device__ __forceinline__ void offs_plain(unsigned lda, const int (&R)[2], const int (&C)[2], unsigned (&vo)[2][2]) {
#pragma unroll
    for (int h = 0; h < 2; ++h)
#pragma unroll
        for (int i = 0; i < 2; ++i) vo[h][i] = (unsigned)(h * HALF + R[i]) * lda + (unsigned)C[i] * 2u;
}
}

namespace attn_body {
using bf16=unsigned short;
using bf16x8=__attribute__((ext_vector_type(8)))short;
using s16x4=__attribute__((ext_vector_type(4)))short;
using f32x16=__attribute__((ext_vector_type(16)))float;
using u32x4=__attribute__((ext_vector_type(4)))unsigned;
constexpr int BATCH=2,NHEAD=8,SEQ=8192,D=64,DM=NHEAD*D;
constexpr int NW=8,QBLK=32,QB=QBLK*NW,KVBLK=64,NQB=SEQ/QB;
constexpr int ATTN_PITCH=DM, ATTN_UNIT_ROWS=QB;
__device__ __forceinline__ int crow(int r,int hi){return (r&3)+8*(r>>2)+4*hi;}
__device__ __forceinline__ unsigned short f2bf_a(float f){unsigned u=__builtin_bit_cast(unsigned,f);return (unsigned short)((u+0x7fffu+((u>>16)&1u))>>16);}
#define SBAR() __builtin_amdgcn_sched_barrier(0)
__device__ __forceinline__ void cmask(f32x16&p0,f32x16&p1,int jb,int qrel,int hi){
  const float NEG=-INFINITY; int kb=64*jb+4*hi;
  #pragma unroll
  for(int r=0;r<16;++r){int kv=kb+(r&3)+8*(r>>2); if(kv>qrel)p0[r]=NEG; if(kv+32>qrel)p1[r]=NEG;}
}

constexpr int NSLOT=3, SLOTB=8192;
constexpr int LDS_K=0, LDS_V=NSLOT*SLOTB, LDS_WS=2*NSLOT*SLOTB, LDS_OST=LDS_WS+NW*64*4, LDS_FK=LDS_OST+NW*4096, LDS_BYTES=LDS_FK+SEQ*4+1024;
constexpr float C2=0.125f*1.4426950408889634f;
__device__ __forceinline__ void glds16(const void*gsrc,unsigned lds_dst){unsigned keep;
  asm volatile("s_mov_b32 %0, m0\n\ts_mov_b32 m0, %2\n\ts_nop 0\n\tglobal_load_lds_dwordx4 %1, off\n\ts_mov_b32 m0, %0":"=&s"(keep):"v"(gsrc),"s"(lds_dst):"memory");}
__device__ __forceinline__ float max3f(float a,float b,float c){float r;asm("v_max3_f32 %0, %1, %2, %3":"=v"(r):"v"(a),"v"(b),"v"(c));return r;}
__device__ __forceinline__ float max2f(float a,float b){float r;asm("v_max_f32_e32 %0, %1, %2":"=v"(r):"v"(a),"v"(b));return r;}
__device__ __forceinline__ float fadd_s(float a,float b){float r;asm("v_add_f32_e32 %0, %1, %2":"=v"(r):"v"(a),"v"(b));return r;}
__device__ __forceinline__ float fsub_s(float a,float b){float r;asm("v_sub_f32_e32 %0, %1, %2":"=v"(r):"v"(a),"v"(b));return r;}
typedef float f32x4_t __attribute__((ext_vector_type(4)));
typedef float f32x2_t __attribute__((ext_vector_type(2))); typedef __bf16 bf16x2_t __attribute__((ext_vector_type(2)));
__device__ __forceinline__ unsigned cvtpk_s(float lo,float hi){f32x2_t v={lo,hi};bf16x2_t b=__builtin_convertvector(v,bf16x2_t);return __builtin_bit_cast(unsigned,b);}
#define WAIT_BAR(N) asm volatile("s_waitcnt vmcnt(" #N ") lgkmcnt(0)\n\ts_barrier":::"memory")

__device__ __forceinline__ void qkt(f32x16&p0,f32x16&p1,const char*Kslot,const bf16x8*qr,int r32,int hi){
  const char*kb=Kslot+hi*1024+r32*16;
  #pragma unroll
  for(int d0=0;d0<4;++d0){
    const bf16x8 b0=*reinterpret_cast<const bf16x8*>(kb+d0*2048);
    const bf16x8 b1=*reinterpret_cast<const bf16x8*>(kb+d0*2048+512);
    p0=__builtin_amdgcn_mfma_f32_32x32x16_bf16(b0,qr[d0],p0,0,0,0);p1=__builtin_amdgcn_mfma_f32_32x32x16_bf16(b1,qr[d0],p1,0,0,0);}
}
typedef __attribute__((address_space(3))) const char* lds_cptr;
typedef short v4i16_t __attribute__((ext_vector_type(4)));
__device__ __forceinline__ void kload8(bf16x8*kf,lds_cptr kp){
  kf[0]=*(const __attribute__((address_space(3))) bf16x8*)(kp);      kf[1]=*(const __attribute__((address_space(3))) bf16x8*)(kp+512);
  kf[2]=*(const __attribute__((address_space(3))) bf16x8*)(kp+2048); kf[3]=*(const __attribute__((address_space(3))) bf16x8*)(kp+2560);
  kf[4]=*(const __attribute__((address_space(3))) bf16x8*)(kp+4096); kf[5]=*(const __attribute__((address_space(3))) bf16x8*)(kp+4608);
  kf[6]=*(const __attribute__((address_space(3))) bf16x8*)(kp+6144); kf[7]=*(const __attribute__((address_space(3))) bf16x8*)(kp+6656);
}
__device__ __forceinline__ void kload2(bf16x8*kf,lds_cptr kp,int j){ kf[2*j]=*(const __attribute__((address_space(3))) bf16x8*)(kp+j*2048); kf[2*j+1]=*(const __attribute__((address_space(3))) bf16x8*)(kp+j*2048+512); }
__device__ __forceinline__ s16x4 vtr(lds_cptr p){ return __builtin_bit_cast(s16x4,__builtin_amdgcn_ds_read_tr16_b64_v4i16((__attribute__((address_space(3))) v4i16_t*)p)); }
__device__ __forceinline__ float rowmax(const f32x16&p0,const f32x16&p1){
  float a=max3f(p0[0],p0[1],p1[0]),b=max3f(p0[2],p0[3],p1[1]);a=max3f(a,p1[2],p1[3]);
  #pragma unroll
  for(int r=4;r<16;r+=4){a=max3f(a,p0[r],p0[r+1]);b=max3f(b,p0[r+2],p0[r+3]);a=max3f(a,p1[r],p1[r+1]);b=max3f(b,p1[r+2],p1[r+3]);}
  const float m=max2f(a,b);
  auto rr=__builtin_amdgcn_permlane32_swap(__float_as_uint(m),__float_as_uint(m),false,false);
  return max2f(__uint_as_float(rr[0]),__uint_as_float(rr[1]));
}
__device__ __forceinline__ void pv(f32x16*o,int vb,bf16x8 pa0,bf16x8 pa1,bf16x8 pa2,bf16x8 pa3){
  #pragma unroll
  for(int d0=0;d0<2;++d0){s16x4 lo[4],hi[4];
    #pragma unroll
    for(int ks=0;ks<4;++ks){
      asm volatile("ds_read_b64_tr_b16 %0,%1 offset:%c2":"=&v"(lo[ks]):"v"(vb),"i"(d0*4096+ks*1024):"memory");
      asm volatile("ds_read_b64_tr_b16 %0,%1 offset:%c2":"=&v"(hi[ks]):"v"(vb),"i"(d0*4096+ks*1024+512):"memory");}
    asm volatile("s_waitcnt lgkmcnt(0)":::"memory");SBAR();
    #define PK(k) (bf16x8){lo[k][0],lo[k][1],lo[k][2],lo[k][3],hi[k][0],hi[k][1],hi[k][2],hi[k][3]}
    o[d0]=__builtin_amdgcn_mfma_f32_32x32x16_bf16(pa0,PK(0),o[d0],0,0,0);
    o[d0]=__builtin_amdgcn_mfma_f32_32x32x16_bf16(pa1,PK(1),o[d0],0,0,0);
    o[d0]=__builtin_amdgcn_mfma_f32_32x32x16_bf16(pa2,PK(2),o[d0],0,0,0);
    o[d0]=__builtin_amdgcn_mfma_f32_32x32x16_bf16(pa3,PK(3),o[d0],0,0,0);
    #undef PK
  }
}

#ifndef ATTN_STORE16
#define ATTN_STORE16(p,v) (*(u32x4*)(p)=(v))
#endif
template<int THRL> __device__ __forceinline__ void attn_unit(int b,int h,int qb,int TB,int TE,int NTM,const bf16*Q,const bf16*__restrict__ K,const bf16*__restrict__ V,bf16*O,const float*__restrict__ CUM,bf16*PO,float*PS,char*shm){
  const int tid=threadIdx.x,lane=tid&63,r32=lane&31,hi=lane>>5; const int wid=__builtin_amdgcn_readfirstlane(tid>>6);
  const long rowbase=(long)b*SEQ; const int q0=qb*QB;
  const bf16*Qw=Q+(rowbase+q0+wid*QBLK)*DM+h*D;
  const bf16*Kh=K+rowbase*DM+h*D,*Vh=V+rowbase*DM+h*D; const float*Fh=CUM+((long)b*NHEAD+h)*SEQ;
  const unsigned lds0=(unsigned)(uintptr_t)shm;
  float*wsf=(float*)(shm+LDS_WS)+wid*64;
  const bf16*ksrc=Kh+(long)lane*DM+wid*8;
  const bf16*vsrc=Vh+(long)(16*(wid&3)+(lane>>2))*DM+(wid>>2)*32+(lane&3)*8;
  const unsigned kdst=lds0+LDS_K+wid*1024, vdst=lds0+LDS_V+wid*1024;
  #define DMA_K(t,slot) glds16(ksrc+(long)(t)*KVBLK*DM,(unsigned)__builtin_amdgcn_readfirstlane(kdst+(slot)))
  #define DMA_V(t,slot) glds16(vsrc+(long)(t)*KVBLK*DM,(unsigned)__builtin_amdgcn_readfirstlane(vdst+(slot)))
  const int vb0=(int)(lds0+LDS_V)+((lane>>4)&1)*32+(lane&3)*8+(4*hi+((lane&15)>>2))*64;
  const char*Kbase=shm+LDS_K; bf16x8 kf[8];
  const lds_cptr shm3=(lds_cptr)shm; const lds_cptr kp0=shm3+LDS_K+hi*1024+r32*16; const lds_cptr vp0=shm3+LDS_V+((lane>>4)&1)*32+(lane&3)*8+(4*hi+((lane&15)>>2))*64;
  const int NT=TE;
  for(int p_=wid+(TB>>2);p_<=((TE*KVBLK-1)>>8);p_+=NW) glds16(Fh+p_*256+lane*4,(unsigned)__builtin_amdgcn_readfirstlane(lds0+LDS_FK+p_*1024));
  DMA_K(TB,0);DMA_V(TB,0);DMA_K(TB+1,SLOTB);
  bf16x8 qr[4];
  #pragma unroll
  for(int d0=0;d0<4;++d0)qr[d0]=*reinterpret_cast<const bf16x8*>(&Qw[(long)r32*DM+d0*16+hi*8]);
  const float fq2=Fh[q0+wid*QBLK+r32];
  float mhat=0.f,l_reg=0.f;f32x16 o[2];o[0]=f32x16{};o[1]=f32x16{};float nb=fq2;
  const lds_cptr fkp=(lds_cptr)shm+LDS_FK+hi*16;
  const int qrel=wid*QBLK+r32;
  #define CMASK(P0,P1,t) do{int jb_=(t)-(NTM-4); if(jb_>=0)cmask(P0,P1,jb_,qrel,hi);}while(0)
  bool resc=false;
  #define START(P0,P1) do{ const float rm=rowmax(P0,P1); resc=false; \
    { const float dl=rm; mhat=fadd_s(mhat,dl); \
      _Pragma("unroll") for(int r=0;r<16;++r){P0[r]=fsub_s(P0[r],dl);P1[r]=fsub_s(P1[r],dl);} \
      nb=fsub_s(fq2,mhat); } \
    _Pragma("unroll") for(int r=0;r<16;++r)P0[r]=__builtin_amdgcn_exp2f(P0[r]); }while(0)
  #define RESC() do{ if(resc){ asm volatile("s_waitcnt lgkmcnt(0)":::"memory"); \
      _Pragma("unroll") for(int d_=0;d_<2;++d_) _Pragma("unroll") for(int r=0;r<16;++r)o[d_][r]*=wsf[crow(r,hi)]; } }while(0)
  #define FILLC(C0_,C1_,tt) do{ const lds_cptr f_=fkp+(tt)*256; _Pragma("unroll") for(int a_=0;a_<4;++a_){ const f32x4_t x0_=*(const __attribute__((address_space(3))) f32x4_t*)(f_+32*a_); const f32x4_t x1_=*(const __attribute__((address_space(3))) f32x4_t*)(f_+128+32*a_); \
      _Pragma("unroll") for(int i_=0;i_<4;++i_){ C0_[4*a_+i_]=nb-x0_[i_]; C1_[4*a_+i_]=nb-x1_[i_]; } } }while(0)
  f32x16 pA0,pA1,pB0,pB1;
  int sl_prev=0,sl_cur=0,sl_next=SLOTB;
  #define ROT() do{sl_prev=sl_cur;sl_cur=sl_next;sl_next=(sl_next==(NSLOT-1)*SLOTB)?0:sl_next+SLOTB;}while(0)
  DMA_K(TB+2,2*SLOTB);
  WAIT_BAR(3);
  FILLC(pA0,pA1,TB);
  qkt(pA0,pA1,Kbase,qr,r32,hi);asm volatile("s_nop 15\n\ts_nop 7":"+v"(pA0),"+v"(pA1));CMASK(pA0,pA1,TB);
  START(pA0,pA1);
  _Pragma("unroll") for(int r=0;r<16;++r)pA1[r]=__builtin_amdgcn_exp2f(pA1[r]);
  WAIT_BAR(0);
  DMA_K(TB+3,0);DMA_V(TB+1,SLOTB);
  ROT();
  FILLC(pB0,pB1,TB+1);
  kload8(kf,kp0+sl_cur);
  WAIT_BAR(2);
  s16x4 vlo[8],vhi[8]; u32x4 pw0,pw1,pw2,pw3;
  #define PKW(P,B) cvtpk_s(P[B],P[B+1])
  #define PAF(k) __builtin_bit_cast(bf16x8,pw##k)
  #define VFR(i) (bf16x8){vlo[i][0],vlo[i][1],vlo[i][2],vlo[i][3],vhi[i][0],vhi[i][1],vhi[i][2],vhi[i][3]}
  #define PIN(x) asm volatile("":"+v"(x))
  #define MX3(a,b,c) __builtin_fmaxf(__builtin_fmaxf((a),(b)),(c))
  #define GAPA(MF,A0,A1,A2,A3,W0,W1,PW) do{ MF; sacc+=A0; sacc+=A1; sacc+=A2; sacc+=A3; PIN(sacc); W0; W1; PIN(PW); SBAR(); }while(0)
  #define EX(v) __builtin_amdgcn_exp2f(v)
  #define FLD(off) (*(const __attribute__((address_space(3))) f32x4_t*)(fk_+(off)))
  #define GAPB(MF,X,B,PF,FC,FN,NOFF) do{ MF; X[B]=EX(X[B]); X[B+1]=EX(X[B+1]); X[B+2]=EX(X[B+2]); X[B+3]=EX(X[B+3]); PF[B]=nb-FC[0]; PF[B+1]=nb-FC[1]; PF[B+2]=nb-FC[2]; PF[B+3]=nb-FC[3]; FN=FLD(NOFF); PIN(X); PIN(PF); SBAR(); }while(0)
  #define VRD(i) do{ vlo[i]=vtr(vp_+(((i)>>2)*4096+((i)&3)*1024)); vhi[i]=vtr(vp_+(((i)>>2)*4096+((i)&3)*1024+512)); }while(0)
  #define KRD(G,j) do{ if(G){ kload2(kf,kp0+sl_next,j); SBAR(); } }while(0)
  #define STEP(C0,C1,P0,P1,t,GK,GV,GL) do{ SBAR(); \
    const lds_cptr vp_=vp0+sl_prev; \
    VRD(0); SBAR(); float sacc=(P0[0]+P0[1]); \
    GAPA(C0=__builtin_amdgcn_mfma_f32_32x32x16_bf16(kf[0],qr[0],C0,0,0,0), P0[2],P0[3],P0[4],P0[5],     pw0[0]=PKW(P0,0), pw0[1]=PKW(P0,2), pw0); \
    VRD(4); SBAR(); GAPA(C1=__builtin_amdgcn_mfma_f32_32x32x16_bf16(kf[1],qr[0],C1,0,0,0), P0[6],P0[7],P0[8],P0[9],     pw0[2]=PKW(P0,4), pw0[3]=PKW(P0,6), pw0); \
    VRD(1); SBAR(); GAPA(C0=__builtin_amdgcn_mfma_f32_32x32x16_bf16(kf[2],qr[1],C0,0,0,0),   P0[10],P0[11],P0[12],P0[13], pw1[0]=PKW(P0,8), pw1[1]=PKW(P0,10), pw1); \
    VRD(5); SBAR(); GAPA(C1=__builtin_amdgcn_mfma_f32_32x32x16_bf16(kf[3],qr[1],C1,0,0,0),   P0[14],P0[15],P1[0],P1[1],   pw1[2]=PKW(P0,12),pw1[3]=PKW(P0,14), pw1); \
    VRD(2); SBAR(); GAPA(C0=__builtin_amdgcn_mfma_f32_32x32x16_bf16(kf[4],qr[2],C0,0,0,0),   P1[2],P1[3],P1[4],P1[5],     pw2[0]=PKW(P1,0), pw2[1]=PKW(P1,2), pw2); \
    VRD(6); SBAR(); GAPA(C1=__builtin_amdgcn_mfma_f32_32x32x16_bf16(kf[5],qr[2],C1,0,0,0),   P1[6],P1[7],P1[8],P1[9],     pw2[2]=PKW(P1,4), pw2[3]=PKW(P1,6), pw2); \
    VRD(3); SBAR(); GAPA(C0=__builtin_amdgcn_mfma_f32_32x32x16_bf16(kf[6],qr[3],C0,0,0,0),   P1[10],P1[11],P1[12],P1[13], pw3[0]=PKW(P1,8), pw3[1]=PKW(P1,10), pw3); \
    VRD(7); SBAR(); GAPA(C1=__builtin_amdgcn_mfma_f32_32x32x16_bf16(kf[7],qr[3],C1,0,0,0),   P1[14],P1[15],0.f,0.f,       pw3[2]=PKW(P1,12),pw3[3]=PKW(P1,14), pw3); \
    l_reg+=sacc; \
    if(GK){DMA_K((t)+3,sl_cur);} if(GV){DMA_V((t)+1,sl_next);} \
    CMASK(C0,C1,t); \
    { float a=MX3(C0[0],C0[1],C1[0]),b=MX3(C0[2],C0[3],C1[1]); a=MX3(a,C1[2],C1[3]); \
      _Pragma("unroll") for(int r=4;r<16;r+=4){a=MX3(a,C0[r],C0[r+1]);b=MX3(b,C0[r+2],C0[r+3]);a=MX3(a,C1[r],C1[r+1]);b=MX3(b,C1[r+2],C1[r+3]);} \
      float rm=__builtin_fmaxf(a,b); { auto rr=__builtin_amdgcn_permlane32_swap(__float_as_uint(rm),__float_as_uint(rm),false,false); rm=__builtin_fmaxf(__uint_as_float(rr[0]),__uint_as_float(rr[1])); } \
      resc=false; \
      if(__builtin_expect(__any(rm>(float)THRL),0)){ const float dl=__builtin_fmaxf(rm,0.f); mhat+=dl; \
        _Pragma("unroll") for(int r=0;r<16;++r){C0[r]-=dl;C1[r]-=dl;} \
        nb=fq2-mhat; \
        const float f=__builtin_amdgcn_exp2f(-dl); l_reg*=f; if(hi==0)wsf[r32]=f; resc=true; } } \
    SBAR(); \
    const lds_cptr fk_=fkp+((t)+1)*256; f32x4_t fa_=FLD(0),fb_; SBAR(); \
    GAPB(o[0]=__builtin_amdgcn_mfma_f32_32x32x16_bf16(PAF(0),VFR(0),o[0],0,0,0), C0,0, P0,fa_,fb_,32); \
    GAPB(o[1]=__builtin_amdgcn_mfma_f32_32x32x16_bf16(PAF(0),VFR(4),o[1],0,0,0), C0,4, P0,fb_,fa_,64); \
    KRD(GL,0); GAPB(o[0]=__builtin_amdgcn_mfma_f32_32x32x16_bf16(PAF(1),VFR(1),o[0],0,0,0), C0,8, P0,fa_,fb_,96); \
    KRD(GL,1); GAPB(o[1]=__builtin_amdgcn_mfma_f32_32x32x16_bf16(PAF(1),VFR(5),o[1],0,0,0), C0,12, P0,fb_,fa_,128); \
    KRD(GL,2); GAPB(o[0]=__builtin_amdgcn_mfma_f32_32x32x16_bf16(PAF(2),VFR(2),o[0],0,0,0), C1,0, P1,fa_,fb_,160); \
    KRD(GL,3); GAPB(o[1]=__builtin_amdgcn_mfma_f32_32x32x16_bf16(PAF(2),VFR(6),o[1],0,0,0), C1,4, P1,fb_,fa_,192); \
    GAPB(o[0]=__builtin_amdgcn_mfma_f32_32x32x16_bf16(PAF(3),VFR(3),o[0],0,0,0), C1,8, P1,fa_,fb_,224); \
    GAPB(o[1]=__builtin_amdgcn_mfma_f32_32x32x16_bf16(PAF(3),VFR(7),o[1],0,0,0), C1,12, P1,fb_,fa_,224); \
    }while(0)
  int t=TB+1;
  #undef CMASK
  #define CMASK(P0,P1,t) do{}while(0)
  for(;t+5<NT;t+=2){
    STEP(pB0,pB1,pA0,pA1,t,true,true,true);     WAIT_BAR(2); RESC(); ROT();
    STEP(pA0,pA1,pB0,pB1,t+1,true,true,true);   WAIT_BAR(2); RESC(); ROT();
  }
  #undef CMASK
  #define CMASK(P0,P1,t) do{int jb_=(t)-(NTM-4); if(jb_>=0)cmask(P0,P1,jb_,qrel,hi);}while(0)
  #define ENDW(tt) do{ if((tt)+3<NT){WAIT_BAR(2);} else if((tt)+2<NT){WAIT_BAR(1);} else {WAIT_BAR(0);} }while(0)
  for(;t+1<NT;t+=2){
    STEP(pB0,pB1,pA0,pA1,t,(t+3<NT),(t+1<NT),(t+1<NT));       ENDW(t);   RESC(); ROT();
    STEP(pA0,pA1,pB0,pB1,t+1,(t+4<NT),(t+2<NT),(t+2<NT));     ENDW(t+1); RESC(); ROT();
  }
  STEP(pB0,pB1,pA0,pA1,NT-1,false,false,false); RESC();
  { float sacc=pB0[0]+pB0[1]; _Pragma("unroll") for(int r=2;r<16;++r)sacc+=pB0[r]; _Pragma("unroll") for(int r=0;r<16;++r)sacc+=pB1[r]; l_reg+=sacc;
    pw0=(u32x4){PKW(pB0,0),PKW(pB0,2),PKW(pB0,4),PKW(pB0,6)};pw1=(u32x4){PKW(pB0,8),PKW(pB0,10),PKW(pB0,12),PKW(pB0,14)};pw2=(u32x4){PKW(pB1,0),PKW(pB1,2),PKW(pB1,4),PKW(pB1,6)};pw3=(u32x4){PKW(pB1,8),PKW(pB1,10),PKW(pB1,12),PKW(pB1,14)};
    SBAR(); pv(o,vb0+sl_cur,PAF(0),PAF(1),PAF(2),PAF(3)); }
  #undef PKW
  #undef PAF
  #undef VFR
  #undef PIN
  #undef MX3
  #undef GAPA
  #undef GAPB
  #undef FLD
  #undef FILLC
  #undef EX
  #undef VRD
  #undef KRD
  #undef STEP
  #undef ENDW
  {auto rr=__builtin_amdgcn_permlane32_swap(__float_as_uint(l_reg),__float_as_uint(l_reg),false,false);l_reg=__uint_as_float(rr[0])+__uint_as_float(rr[1]);}
  const bool part=(PO!=nullptr);
  if(hi==0){wsf[32+r32]=part?1.f:l_reg; if(part){PS[(wid*QBLK+r32)*2]=mhat;PS[(wid*QBLK+r32)*2+1]=l_reg;}}asm volatile("s_waitcnt lgkmcnt(0)":::"memory");
  float rli[16];
  #pragma unroll
  for(int r=0;r<16;++r)rli[r]=__builtin_amdgcn_rcpf(wsf[32+crow(r,hi)]);
  bf16*Ow=part?PO+(long)(wid*QBLK)*D:O+(rowbase+q0+wid*QBLK)*DM+h*D; const long opitch=part?D:DM;
  { bf16*stg=(bf16*)(shm+LDS_OST)+wid*2048;
    #pragma unroll
    for(int r=0;r<16;++r){const int orow=crow(r,hi);
      #pragma unroll
      for(int d0=0;d0<2;++d0)stg[orow*64+d0*32+r32]=f2bf_a(o[d0][r]*rli[r]);}
    asm volatile("s_waitcnt lgkmcnt(0)":::"memory");
    #pragma unroll
    for(int i=0;i<4;++i){const int row=i*8+(lane>>3),ch=lane&7; const u32x4 v=*(const u32x4*)(stg+row*64+ch*8); ATTN_STORE16(Ow+(long)row*opitch+ch*8,v);} }
  asm volatile("s_waitcnt lgkmcnt(0)\n\ts_barrier":::"memory");
  #undef DMA_K
  #undef DMA_V
  #undef CMASK
  #undef START
  #undef RESC
  #undef ROT
}
constexpr int ATTN_LDS_BYTES=LDS_BYTES;
struct AttnTensors { const bf16* Q; const bf16* K; const bf16* V; bf16* O; const float* CUM; const int* T0; bf16* PO; float* PS; unsigned* qctr; };
constexpr int MAX_ITEMS=1408, PO_SLOTS=640;
__device__ __forceinline__ void unit_split(int Lt,int SEG,int&nseg,int&len){ nseg=(Lt+SEG-1)/SEG; len=2*(((Lt>>1)+nseg-1)/nseg); }
__device__ __forceinline__ int build_worklist(const int*T0,unsigned*wl,unsigned*tmp,int*sc,int&SEGo){
  const int tid=threadIdx.x; const int qb=tid&31; const int t0=T0[tid]; const int Lt=4*qb+4-t0;
  __syncthreads();
  int SEG=40,nseg,len;
  for(int pass=0;pass<2;++pass){
    unit_split(Lt,SEG,nseg,len);
    sc[tid]=nseg; sc[512+tid]=nseg>1?nseg:0; __syncthreads();
    for(int o=1;o<512;o<<=1){ const int a=tid>=o?sc[tid-o]:0, c=tid>=o?sc[512+tid-o]:0; __syncthreads(); sc[tid]+=a; sc[512+tid]+=c; __syncthreads(); }
    if(sc[1023]<=PO_SLOTS&&sc[511]<=MAX_ITEMS)break;
    __syncthreads(); SEG=64;
  }
  SEGo=SEG;
  const int ioff=sc[tid]-nseg, poff=sc[512+tid]-(nseg>1?nseg:0), NI=sc[511];
  for(int sgi=0;sgi<nseg;++sgi){ const int lb=t0+sgi*len, le=min(lb+len,4*qb+4); tmp[ioff+sgi]=(unsigned)tid|((unsigned)sgi<<9)|((unsigned)((le-lb)>>1)<<12)|((unsigned)poff<<18)|((unsigned)nseg<<29); }
  __syncthreads();
  { const int lane=tid&63,w=tid>>6,nch=(NI+63)>>6; int*hist=sc;
    for(int c=w;c<nch;c+=8){ const int i=c*64+lane; const int key=i<NI?(int)((tmp[i]>>12)&63u):0;
      for(int k=1;k<=32;++k){ const unsigned long long mk=__ballot(key==k); if(lane==0)hist[c*33+k]=__popcll(mk); } }
    __syncthreads();
    if(tid>=1&&tid<=32){ int run=0; for(int c=0;c<nch;++c){ const int v=hist[c*33+tid]; hist[c*33+tid]=run; run+=v; } sc[840+tid]=run; }
    __syncthreads();
    if(tid==0){ int run=0; for(int k=32;k>=1;--k){ sc[800+k]=run; run+=sc[840+k]; } }
    __syncthreads();
    for(int c=w;c<nch;c+=8){ const int i=c*64+lane; const int key=i<NI?(int)((tmp[i]>>12)&63u):0; int myr=0;
      for(int k=1;k<=32;++k){ const unsigned long long mk=__ballot(key==k); if(key==k)myr=__popcll(mk&((1ull<<lane)-1ull)); }
      if(i<NI)wl[sc[800+key]+hist[c*33+key]+myr]=tmp[i]; }
  }
  __syncthreads();
  return NI;
}
template<int THRL=8> __device__ __forceinline__ void attn_phase(char*lds,const AttnTensors&T,int vcu,int G){
  unsigned*wl=(unsigned*)(lds+LDS_BYTES); unsigned*tmp=wl+MAX_ITEMS; int*sc=(int*)lds;
  int SEG; const int NI=build_worklist(T.T0,wl,tmp,sc,SEG);
  volatile int*nxt=(volatile int*)(tmp);
  int idx=vcu;
  while(idx<NI){
    const unsigned it=wl[idx]; const int u=it&511,sgi=(it>>9)&7,lenp=(it>>12)&63,poff=(it>>18)&2047,nseg=(it>>29)&7;
    const int bh=u>>5,qb=u&31,NTu=4*qb+4; const int t0=T.T0[u]; int ns2,len; unit_split(NTu-t0,SEG,ns2,len);
    const int TB=t0+sgi*len, TE=TB+2*lenp;
    bf16*po=nseg>1?T.PO+(long)(poff+sgi)*(256*D):nullptr; float*ps=nseg>1?T.PS+(long)(poff+sgi)*512:nullptr;
    attn_unit<THRL>(bh/NHEAD,bh%NHEAD,qb,TB,TE,NTu,T.Q,T.K,T.V,T.O,T.CUM,po,ps,lds);
    if(threadIdx.x==0)*nxt=G+(int)__hip_atomic_fetch_add(T.qctr,1u,__ATOMIC_RELAXED,__HIP_MEMORY_SCOPE_AGENT);
    __syncthreads(); idx=*nxt; __syncthreads();
  }
}
__device__ __forceinline__ void attn_combine(char*lds,const AttnTensors&T,int wg,int nwg){
  unsigned*wl=(unsigned*)(lds+LDS_BYTES); unsigned*tmp=wl+MAX_ITEMS; int*sc=(int*)lds;
  int SEG; const int NI=build_worklist(T.T0,wl,tmp,sc,SEG);
  const int tid=threadIdx.x,row=tid>>1,ch=tid&1; int k=0;
  for(int i=0;i<NI;++i){ const unsigned it=tmp[i]; const int nseg=(it>>29)&7; if(nseg<2||((it>>9)&7)!=0)continue;
    if((k++%nwg)!=wg)continue;
    const int u=it&511,poff=(it>>18)&2047,bh=u>>5,qb=u&31,b=bh/NHEAD,h=bh%NHEAD;
    float m[4],l[4]; float M=-3.0e38f;
    #pragma unroll
    for(int sgi=0;sgi<4;++sgi){ m[sgi]=-3.0e38f; l[sgi]=0.f; if(sgi<nseg){ m[sgi]=T.PS[(long)(poff+sgi)*512+row*2]; l[sgi]=T.PS[(long)(poff+sgi)*512+row*2+1]; } M=fmaxf(M,m[sgi]); }
    float acc[32]; float L=0.f;
    #pragma unroll
    for(int c=0;c<32;++c)acc[c]=0.f;
    #pragma unroll
    for(int sgi=0;sgi<4;++sgi){ if(sgi>=nseg)continue; const float w=__builtin_amdgcn_exp2f(m[sgi]-M); L+=w*l[sgi]; const u32x4*p=(const u32x4*)(T.PO+(long)(poff+sgi)*(256*D)+row*D+ch*32);
      #pragma unroll
      for(int q=0;q<4;++q){ const u32x4 v=p[q];
        acc[8*q+0]+=w*__builtin_bit_cast(float,v.x<<16); acc[8*q+1]+=w*__builtin_bit_cast(float,v.x&0xffff0000u); acc[8*q+2]+=w*__builtin_bit_cast(float,v.y<<16); acc[8*q+3]+=w*__builtin_bit_cast(float,v.y&0xffff0000u);
        acc[8*q+4]+=w*__builtin_bit_cast(float,v.z<<16); acc[8*q+5]+=w*__builtin_bit_cast(float,v.z&0xffff0000u); acc[8*q+6]+=w*__builtin_bit_cast(float,v.w<<16); acc[8*q+7]+=w*__builtin_bit_cast(float,v.w&0xffff0000u); } }
    const float rl=1.f/L; bf16*op=T.O+((long)b*SEQ+qb*QB+row)*DM+h*D+ch*32;
    #pragma unroll
    for(int q=0;q<4;++q){ u32x4 w; w.x=cvtpk_s(acc[8*q]*rl,acc[8*q+1]*rl); w.y=cvtpk_s(acc[8*q+2]*rl,acc[8*q+3]*rl); w.z=cvtpk_s(acc[8*q+4]*rl,acc[8*q+5]*rl); w.w=cvtpk_s(acc[8*q+6]*rl,acc[8*q+7]*rl); *(u32x4*)(op+8*q)=w; }
  }
  __syncthreads();
}
#undef SBAR
#undef WAIT_BAR
}

constexpr int NWAVES = 8;
constexpr int RING_OFF = 0, RING_BYTES = 131072;
constexpr int LDSCTL_OFF = RING_BYTES, MISC_OFF = LDSCTL_OFF + 320;
constexpr int LDS_BYTES = 147456;
typedef GAS unsigned gu32;
#define RLX_AGENT __ATOMIC_RELAXED, __HIP_MEMORY_SCOPE_AGENT
#define LDS_WAIT() asm volatile("s_waitcnt lgkmcnt(0)" ::: "memory")
#define VM_WAIT() asm volatile("s_waitcnt vmcnt(0)" ::: "memory")
constexpr int CW_TMO = 0, CW_CODE = 1, CW_CNT = 64  , CW_Q0 = 128  , CW_BAR = 4096;

#define XB_TMO      128
#define XB_XCNT(j)  (256  + 64 * (j))
#define XB_XSUB(j)  (1280 + 64 * (j))
#define XB_XGEN(j)  (2304 + 64 * (j))
#define XB_TOP      3328
#define XB_TOPGEN   3392
#define XCD_BAR_WORDS 3456
#define XB_SPIN_CAP (1u << 18)
__device__ __forceinline__ unsigned xb_ld(unsigned* p)              { return __hip_atomic_load(p, __ATOMIC_RELAXED, __HIP_MEMORY_SCOPE_AGENT); }
__device__ __forceinline__ unsigned xb_add(unsigned* p, unsigned v) { return __hip_atomic_fetch_add(p, v, __ATOMIC_RELAXED, __HIP_MEMORY_SCOPE_AGENT); }
__device__ __forceinline__ unsigned xb_xcc_id() { return (unsigned)__builtin_amdgcn_s_getreg((3 << 11) | 20) & 0xFu; }
#define XB_SPIN(cond, bar) do { unsigned _sp = 0; while (cond) { __builtin_amdgcn_s_sleep(1); \
    if ((++_sp & 255u) == 0u) { if (xb_ld(&(bar)[XB_TMO])) break; if (_sp > XB_SPIN_CAP) { atomicAdd(&(bar)[XB_TMO], 1u); break; } } } } while (0)
struct XcdBarrier { unsigned* bar; unsigned x; volatile LAS unsigned* st; };
__device__ __forceinline__ XcdBarrier xcd_barrier_post(unsigned* bar, volatile LAS unsigned* st) {
    XcdBarrier b; b.bar = bar; b.x = xb_xcc_id(); b.st = st;
    if (threadIdx.x == 0) (void)xb_add(&bar[XB_XCNT(b.x)], 1u);
    return b;
}
__device__ __forceinline__ void xcd_barrier_complete(unsigned* bar, unsigned x, unsigned& nloc, unsigned& nx) {
    const unsigned G = gridDim.x * gridDim.y * gridDim.z;
    unsigned sum, cnt, mine, sp = 0u;
    for (;;) {
        sum = 0u; cnt = 0u; mine = 0u;
#pragma unroll
        for (unsigned j = 0; j < 16; ++j) { const unsigned c = xb_ld(&bar[XB_XCNT(j)]); sum += c; cnt += (c > 0u) ? 1u : 0u; mine = (j == x) ? c : mine; }
        if (sum == G) break;
        __builtin_amdgcn_s_sleep(1);
        if ((++sp & 255u) == 0u) { if (xb_ld(&bar[XB_TMO])) break; if (sp > XB_SPIN_CAP) { atomicAdd(&bar[XB_TMO], 1u); break; } }
    }
    nloc = mine > 0u ? mine : 1u; nx = cnt > 0u ? cnt : 1u;
}
__device__ __forceinline__ void xcd_barrier(const XcdBarrier& b) {
    asm volatile("s_waitcnt vmcnt(0)" ::: "memory");
    __syncthreads();
    if (threadIdx.x == 0) {
        unsigned* bar = b.bar;
        __builtin_amdgcn_s_waitcnt(0);
        unsigned nloc = b.st[0], nx = b.st[1];
        if (nloc == 0u) { xcd_barrier_complete(bar, b.x, nloc, nx); b.st[0] = nloc; b.st[1] = nx; }
        const unsigned old = xb_add(&bar[XB_XSUB(b.x)], 1u);
        const unsigned gen = old / nloc;
        if (old + 1u == (gen + 1u) * nloc) {
            __builtin_amdgcn_fence(__ATOMIC_RELEASE, "agent");
            asm volatile("s_waitcnt vmcnt(0)" ::: "memory");
            const unsigned og = xb_add(&bar[XB_TOP], 1u);
            const unsigned tg = og / nx;
            if (og + 1u == (tg + 1u) * nx) xb_add(&bar[XB_TOPGEN], 1u);
            else XB_SPIN(xb_ld(&bar[XB_TOPGEN]) == tg, bar);
            __builtin_amdgcn_fence(__ATOMIC_ACQUIRE, "agent");
            xb_add(&bar[XB_XGEN(b.x)], 1u);
            asm volatile("s_waitcnt vmcnt(0)" ::: "memory");
        } else {
            XB_SPIN(xb_ld(&bar[XB_XGEN(b.x)]) == gen, bar);
            __builtin_amdgcn_fence(__ATOMIC_ACQUIRE, "agent");
            asm volatile("s_waitcnt vmcnt(0)" ::: "memory");
        }
    }
    __syncthreads();
}

struct Args { const float* in[26]; float* out; unsigned char* ws; int ph_lo, ph_hi, sub, pad_; };
struct Frame {
    LAS unsigned char* lds; volatile LAS unsigned* MISC; gu32* ctl;
    int tid, lane, wave, vcu, G;
};
__device__ __forceinline__ float gelu_fast(float x) { const float z = 0.7978845608028654f * (x + 0.044715f * x * x * x); const float e = __builtin_amdgcn_exp2f(2.885390081777927f * z); return x - x * __builtin_amdgcn_rcpf(e + 1.f); }
__device__ __forceinline__ float wave_sum(float v) {
#pragma unroll
    for (int o = 1; o < 64; o <<= 1) v += __shfl_xor(v, o);
    return v;
}

struct ConvDesc { const float* W; int ldw, k0, scol; bf16* dst; int ldd; const float* kscale; };
__device__ __forceinline__ void conv_load(const ConvDesc& d, float (&v)[32], int lane) {
    const float* wp = d.W + (size_t)(d.k0 + (lane >> 5)) * d.ldw + d.scol + (lane & 31);
#pragma unroll
    for (int i = 0; i < 32; ++i) v[i] = wp[(size_t)(2 * i) * d.ldw];
}
__device__ __forceinline__ void conv_finish(const ConvDesc& d, float (&v)[32], LAS float* scr, int lane) {
    if (d.kscale) {
#pragma unroll
        for (int i = 0; i < 32; ++i) v[i] *= d.kscale[d.k0 + 2 * i + (lane >> 5)]; }
#pragma unroll
    for (int i = 0; i < 32; ++i) scr[(2 * i + (lane >> 5)) * 33 + (lane & 31)] = v[i];
    LDS_WAIT(); asm volatile("" ::: "memory");
    const int c = lane & 7;
#pragma unroll
    for (int j = 0; j < 4; ++j) { const int n = (lane >> 3) + 8 * j; const LAS float* s = scr + (8 * c) * 33 + n;
        u32x4 o; o.x = pg::cvt_pk_bf16(s[0 * 33], s[1 * 33]); o.y = pg::cvt_pk_bf16(s[2 * 33], s[3 * 33]); o.z = pg::cvt_pk_bf16(s[4 * 33], s[5 * 33]); o.w = pg::cvt_pk_bf16(s[6 * 33], s[7 * 33]);
        *(GAS u32x4*)(d.dst + (size_t)n * d.ldd + d.k0 + 8 * c) = o; }
    LDS_WAIT(); asm volatile("" ::: "memory");
}
__device__ __forceinline__ void conv_item(const float* W, int ldw, int k0, int scol, bf16* dst, int ldd, const float* kscale, LAS float* scr, int lane) {
    ConvDesc d{W, ldw, k0, scol, dst, ldd, kscale}; float v[32]; conv_load(d, v, lane); conv_finish(d, v, scr, lane);
}
__device__ __forceinline__ int inproj_src_col(int cp) { return cp < 1536 ? cp : (cp < 2048 ? cp + (OU - 1536) : (cp < 3072 ? cp + (OGA - 2048) : cp + (OGS - 3072))); }
__device__ __forceinline__ int inproj_dst_row(int cp) { const int t = cp & ~255, c = cp & 255, wc = c >> 6, bj = (c >> 5) & 1, j = c & 31; return t + 128 * bj + 32 * wc + j; }

__device__ __forceinline__ void p0_prologue(Frame& F, const Args& a) {
    unsigned char* ws = a.ws;
    LAS float* scr = (LAS float*)(F.lds + F.wave * 8704);
    LAS float* wf = (LAS float*)(F.lds + 73728);
    const int gw = F.vcu * NWAVES + F.wave, NGW = F.G * NWAVES;
    const float* w_in = a.in[2]; const int sub = a.sub;
    for (int i = F.tid; i < 8 * 1024; i += NWAVES * 64) { const int h = i >> 10, k = i & 1023; wf[i] = w_in[(size_t)k * DIN + OF + h]; }
    constexpr int I_IN = 16 * 128;
    for (int it = (sub & 1) ? gw : I_IN; it < I_IN; it += NGW) { const int kb = it >> 7, nb = it & 127, cp = nb * 32;
        conv_item(w_in, DIN, kb * 64, inproj_src_col(cp), (bf16*)(ws + WS_WIN) + (size_t)inproj_dst_row(cp) * D, D, nullptr, scr, F.lane); }
    __syncthreads();
    const float* x = a.in[0]; const float* g = a.in[1]; const float* bfg = a.in[3];
    bf16* XN = (bf16*)(ws + WS_XN); float* LOGF = (float*)(ws + WS_CUM);
    { int m = (sub & 2) ? gw : T; f32x4 v[4];
      if (m < T) { const GAS f32x4* xr = (const GAS f32x4*)(x + (size_t)m * D) + F.lane;
#pragma unroll
          for (int j = 0; j < 4; ++j) v[j] = xr[64 * j]; }
      while (m < T) {
        const int mn = m + NGW; f32x4 vn[4];
        if (mn < T) { const GAS f32x4* xr = (const GAS f32x4*)(x + (size_t)mn * D) + F.lane;
#pragma unroll
            for (int j = 0; j < 4; ++j) vn[j] = xr[64 * j]; }
        float s = 0.f;
#pragma unroll
        for (int j = 0; j < 4; ++j) s += (v[j].x * v[j].x + v[j].y * v[j].y) + (v[j].z * v[j].z + v[j].w * v[j].w);
        float f[8];
#pragma unroll
        for (int h = 0; h < 8; ++h) f[h] = 0.f;
        f32x4 xg[4];
#pragma unroll
        for (int j = 0; j < 4; ++j) { const f32x4 gg = *((const GAS f32x4*)g + 64 * j + F.lane); xg[j] = v[j] * gg;
#pragma unroll
            for (int h = 0; h < 8; ++h) { const f32x4 ww = *((const LAS f32x4*)(wf + h * 1024) + 64 * j + F.lane); f[h] += (xg[j].x * ww.x + xg[j].y * ww.y) + (xg[j].z * ww.z + xg[j].w * ww.w); } }
        const float rstd = rsqrtf(wave_sum(s) * (1.f / D) + EPS);
        float f4[4], f2[2], f1;
        { const bool up = F.lane >= 32;
#pragma unroll
          for (int i = 0; i < 4; ++i) { const float snd = up ? f[i] : f[4 + i], kp = up ? f[4 + i] : f[i]; f4[i] = kp + __shfl_xor(snd, 32); } }
        { const bool up = (F.lane & 16) != 0;
#pragma unroll
          for (int i = 0; i < 2; ++i) { const float snd = up ? f4[i] : f4[2 + i], kp = up ? f4[2 + i] : f4[i]; f2[i] = kp + __shfl_xor(snd, 16); } }
        { const bool up = (F.lane & 8) != 0; const float snd = up ? f2[0] : f2[1], kp = up ? f2[1] : f2[0]; f1 = kp + __shfl_xor(snd, 8); }
        f1 += __shfl_xor(f1, 4); f1 += __shfl_xor(f1, 2); f1 += __shfl_xor(f1, 1);
        GAS u32x2* o8 = (GAS u32x2*)(XN + (size_t)m * D) + F.lane;
#pragma unroll
        for (int j = 0; j < 4; ++j) { const f32x4 xn = xg[j] * rstd; u32x2 w; w.x = pg::cvt_pk_bf16(xn.x, xn.y); w.y = pg::cvt_pk_bf16(xn.z, xn.w); o8[64 * j] = w; }
        if ((F.lane & 7) == 0) { const int hh = F.lane >> 3, b = m / SEQ, sidx = m % SEQ; LOGF[((size_t)b * NH + hh) * SEQ + sidx] = log_sigmoid(f1 * rstd + bfg[hh]); }
#pragma unroll
        for (int j = 0; j < 4; ++j) v[j] = vn[j];
        m = mn;
      } }
    if ((sub & 4) && F.G == 256) {
        __syncthreads();
        const int g = F.vcu >> 3, q = F.vcu & 7;
        LAS f32x2* PW = (LAS f32x2*)(F.lds);
        LAS f32x2* BB = (LAS f32x2*)(F.lds + 16896);
        LAS f32x2* CT = (LAS f32x2*)(F.lds + 16896 + 8192);
        LAS float* KT = (LAS float*)(F.lds + 16896 + 16384);
        const float* A_re = a.in[6]; const float* A_im = a.in[7]; const float* log_dt = a.in[8]; const float* B_re = a.in[9]; const float* B_im = a.in[10]; const float* C_re = a.in[11]; const float* C_im = a.in[12];
        if (F.tid < NP) { const int p = F.tid;
            const double dt = exp((double)log_dt[g]), ar = A_re[g * NP + p], ai = A_im[g * NP + p];
            const double er = exp(ar * dt), abr = er * cos(ai * dt), abi = er * sin(ai * dt);
            const double nr = abr - 1.0, ni = abi, den = ar * ar + ai * ai, fr_ = (nr * ar + ni * ai) / den, fi_ = (ni * ar - nr * ai) / den;
            double pr = 1.0, pi = 0.0;
            for (int tau = 0; tau <= LCH; ++tau) { PW[tau * NP + p] = (f32x2){(float)pr, (float)pi}; const double t2 = pr * abr - pi * abi; pi = pr * abi + pi * abr; pr = t2; }
            if (q == 0) { ((float*)(ws + WS_AL))[(g * NP + p) * 2] = PW[LCH * NP + p].x; ((float*)(ws + WS_AL))[(g * NP + p) * 2 + 1] = PW[LCH * NP + p].y; }
            for (int c = 0; c < GC; ++c) { const double br = B_re[(g * NP + p) * GC + c], bi = B_im[(g * NP + p) * GC + c]; BB[p * GC + c] = (f32x2){(float)(fr_ * br - fi_ * bi), (float)(fr_ * bi + fi_ * br)}; } }
        for (int i = F.tid; i < GC * NP; i += NWAVES * 64) { const int c = i >> 6, p = i & 63; CT[p * GC + c] = (f32x2){C_re[g * GC * NP + i], C_im[g * GC * NP + i]}; }
        __syncthreads();
        { float* KTG = (float*)(ws + WS_KTG) + (size_t)g * LCH * GC * GC;
          for (int i = 4 * q * GC * GC + F.tid; i < (4 * q + 4) * GC * GC; i += NWAVES * 64) { const int tau = i >> 8, co = (i >> 4) & 15, ci = i & 15; float acc = 0.f;
#pragma unroll 4
              for (int p = 0; p < NP; ++p) { const f32x2 w = PW[tau * NP + p], b = BB[p * GC + ci], c = CT[p * GC + co]; const float wr_ = w.x * b.x - w.y * b.y, wi_ = w.x * b.y + w.y * b.x; acc += c.x * wr_ - c.y * wi_; }
              KTG[i] = acc; } }
        {
          const int n = 64 * q + (F.tid >> 3), part = F.tid & 7, j = n >> 4, co = n & 15; bf16* row = (bf16*)(ws + WS_BTY) + ((size_t)g * 512 + n) * U2P;
          auto bval = [&](int k) -> float { const int p = k & 63; const f32x2 w = PW[(j + 1) * NP + p], c = CT[p * GC + co]; return k < 64 ? (c.x * w.x - c.y * w.y) : -(c.x * w.y + c.y * w.x); };
#pragma unroll 1
          for (int it = 0; it < 2; ++it) { const int k = (it * 8 + part) * 8;
              u32x4 o; o.x = pg::cvt_pk_bf16(bval(k), bval(k + 1)); o.y = pg::cvt_pk_bf16(bval(k + 2), bval(k + 3)); o.z = pg::cvt_pk_bf16(bval(k + 4), bval(k + 5)); o.w = pg::cvt_pk_bf16(bval(k + 6), bval(k + 7)); *(GAS u32x4*)(row + k) = o; } }
        {
          const int n = 32 * q + (F.tid >> 4), part = F.tid & 15; bf16* row = (bf16*)(ws + WS_M1T) + ((size_t)g * 256 + n) * 512;
          auto mval = [&](int k) -> float { const int j = k >> 4, ci = k & 15; float x = 0.f;
              if (n < 128) { const int p = n & 63; const f32x2 w = PW[(LCH - 1 - j) * NP + p], b = BB[p * GC + ci]; x = n < 64 ? (w.x * b.x - w.y * b.y) : (w.x * b.y + w.y * b.x); }
              return x; };
#pragma unroll 1
          for (int it = 0; it < 4; ++it) { const int k = (it * 16 + part) * 8;
              u32x4 o; o.x = pg::cvt_pk_bf16(mval(k), mval(k + 1)); o.y = pg::cvt_pk_bf16(mval(k + 2), mval(k + 3)); o.z = pg::cvt_pk_bf16(mval(k + 4), mval(k + 5)); o.w = pg::cvt_pk_bf16(mval(k + 6), mval(k + 7)); *(GAS u32x4*)(row + k) = o; } }
    }
}

__device__ __forceinline__ void p1_cumsum(Frame& F, float* CUM, int* T0, const float* gq, const float* gk) {
    LAS double* part = (LAS double*)(F.lds);
    float* p = CUM + (size_t)blockIdx.x * SEQ + F.tid * 16;
    f32x4 v[4]; float run[16]; float a = 0.f;
#pragma unroll
    for (int j = 0; j < 4; ++j) v[j] = ((const GAS f32x4*)p)[j];
#pragma unroll
    for (int j = 0; j < 4; ++j) { a += v[j].x; run[4 * j] = a; a += v[j].y; run[4 * j + 1] = a; a += v[j].z; run[4 * j + 2] = a; a += v[j].w; run[4 * j + 3] = a; }
    part[F.tid] = (double)a;
    __syncthreads();
    if (F.tid < 64) { double loc[8]; double s = 0.0;
#pragma unroll
        for (int i = 0; i < 8; ++i) { loc[i] = s; s += part[F.tid * 8 + i]; }
        double incl = s;
#pragma unroll
        for (int o = 1; o < 64; o <<= 1) { const double t = __shfl_up(incl, o); if (F.lane >= o) incl += t; }
        const double excl = incl - s;
#pragma unroll
        for (int i = 0; i < 8; ++i) part[F.tid * 8 + i] = excl + loc[i]; }
    __syncthreads();
    const double base = part[F.tid];
#pragma unroll
    for (int j = 0; j < 4; ++j) { f32x4 o; o.x = (float)((base + (double)run[4 * j]) * 1.4426950408889634); o.y = (float)((base + (double)run[4 * j + 1]) * 1.4426950408889634);
        o.z = (float)((base + (double)run[4 * j + 2]) * 1.4426950408889634); o.w = (float)((base + (double)run[4 * j + 3]) * 1.4426950408889634); ((GAS f32x4*)p)[j] = o; }
    __syncthreads();
    asm volatile("s_waitcnt vmcnt(0)" ::: "memory"); __syncthreads();
    if (F.tid < 32) { float gqm = 0.f, gkm = 0.f; for (int i = 0; i < HD; ++i) { gqm = fmaxf(gqm, fabsf(gq[i])); gkm = fmaxf(gkm, fabsf(gk[i])); }
        const float thr = 2.f * 64.f * C2 * gqm * gkm + 37.f; const int qb = F.tid, NTu = 4 * qb + 4;
        const unsigned* cu = (const unsigned*)(CUM + (size_t)blockIdx.x * SEQ);
        const float fq0 = __builtin_bit_cast(float, __hip_atomic_load(cu + qb * 256, __ATOMIC_RELAXED, __HIP_MEMORY_SCOPE_AGENT));
        int lo = 0, hi = NTu - 1;
        while (lo < hi) { const int mid = (lo + hi) >> 1; const float fk = __builtin_bit_cast(float, __hip_atomic_load(cu + 64 * mid + 63, __ATOMIC_RELAXED, __HIP_MEMORY_SCOPE_AGENT)); if (fq0 - fk >= -thr) hi = mid; else lo = mid + 1; }
        int t0 = lo & ~1; t0 = t0 > NTu - 4 ? NTu - 4 : t0; T0[blockIdx.x * 32 + qb] = t0; }
    __syncthreads();
}
struct PhInProj {
    static constexpr bool GATHER = false;
    unsigned lda, ldb; const char* A; const char* B; pg::StaticOrder so;
    bf16 *Q, *K, *V, *U2X, *GA, *GS; const float *gq, *gk;
    __device__ __forceinline__ bool next(int i, pg::Unit& u) const { int pm, pn; if (!so.next(i, pm, pn)) return false; u.A = A + (size_t)pm * 256 * lda; u.B = B + (size_t)pn * 256 * ldb; u.nt = D / 64; u.pm = pm; u.pn = pn; u.aux = 0; return true; }
    __device__ __forceinline__ void offs(const pg::Unit&, const int (&R)[2], const int (&C)[2], unsigned (&vo)[2][2]) const { pg::offs_plain(lda, R, C, vo); }
    __device__ __forceinline__ void epi(const f32x4 (&acc)[2][2][4][2], const pg::Unit& u, int wr, int wc, int fr, int fq) const {
        const int pn = u.pn, row0 = u.pm * 256 + wr * 64 + fr;
        if (pn < 4) {
            const bool isq = pn < 2; const float* g = isq ? gq : gk; bf16* O = isq ? Q : K; const int cb = (pn & 1) * 256 + 64 * wc + 8 * fq; const float sc = isq ? C2 : 1.f;
            f32x4 gv[2][2];
#pragma unroll
            for (int bj = 0; bj < 2; ++bj)
#pragma unroll
                for (int n = 0; n < 2; ++n) gv[bj][n] = *(const f32x4*)(g + 32 * bj + 8 * fq + 4 * n) * sc;
#pragma unroll
            for (int ai = 0; ai < 2; ++ai)
#pragma unroll
                for (int m = 0; m < 4; ++m) { float ss = 0.f;
#pragma unroll
                    for (int bj = 0; bj < 2; ++bj)
#pragma unroll
                        for (int n = 0; n < 2; ++n) { const f32x4 v = acc[ai][bj][m][n]; ss += (v[0] * v[0] + v[1] * v[1]) + (v[2] * v[2] + v[3] * v[3]); }
                    ss += __shfl_xor(ss, 16); ss += __shfl_xor(ss, 32);
                    const float rstd = rsqrtf(ss * (1.f / 64.f) + EPS);
                    bf16* rowp = O + (size_t)(row0 + ai * 128 + m * 16) * DA + cb;
#pragma unroll
                    for (int bj = 0; bj < 2; ++bj) *(u32x4*)(rowp + 32 * bj) = pg::pack8(acc[ai][bj][m][0] * rstd * gv[bj][0], acc[ai][bj][m][1] * rstd * gv[bj][1]); }
        } else if (pn < 6) {
            const int cb = (pn - 4) * 256 + 64 * wc + 8 * fq;
#pragma unroll
            for (int ai = 0; ai < 2; ++ai)
#pragma unroll
                for (int m = 0; m < 4; ++m) { bf16* rowp = V + (size_t)(row0 + ai * 128 + m * 16) * DA + cb;
#pragma unroll
                    for (int bj = 0; bj < 2; ++bj) *(u32x4*)(rowp + 32 * bj) = pg::pack8(acc[ai][bj][m][0], acc[ai][bj][m][1]); }
        } else if (pn < 8) {
#pragma unroll
            for (int ai = 0; ai < 2; ++ai)
#pragma unroll
                for (int m = 0; m < 4; ++m) { const int row = row0 + ai * 128 + m * 16;
#pragma unroll
                    for (int bj = 0; bj < 2; ++bj) { const int cu = (pn - 6) * 256 + 64 * wc + 32 * bj + 8 * fq;
                        *(u32x4*)(U2X + u2x_index(cu >> 4, row, cu & 15)) = pg::pack8(acc[ai][bj][m][0], acc[ai][bj][m][1]); } }
        } else {
            bf16* G = pn < 12 ? GA : GS; const int cb = ((pn - 8) & 3) * 256 + 64 * wc + 8 * fq;
#pragma unroll
            for (int ai = 0; ai < 2; ++ai)
#pragma unroll
                for (int m = 0; m < 4; ++m) { bf16* rowp = G + (size_t)(row0 + ai * 128 + m * 16) * D + cb;
#pragma unroll
                    for (int bj = 0; bj < 2; ++bj) { f32x4 a = acc[ai][bj][m][0], b = acc[ai][bj][m][1];
#pragma unroll
                        for (int e = 0; e < 4; ++e) { a[e] = pg::fsigmoid(a[e]); b[e] = pg::fsigmoid(b[e]); }
                        *(u32x4*)(rowp + 32 * bj) = pg::pack8(a, b); } }
        }
    }
};

struct PhGlu {
    static constexpr bool GATHER = false;
    unsigned lda, ldb; const char* A; const char* B; pg::StaticOrder so; const bf16* Y1; bf16* YS;
    __device__ __forceinline__ bool next(int i, pg::Unit& u) const { int pm, pn; if (!so.next(i, pm, pn)) return false; u.A = A + (size_t)pm * 256 * lda; u.B = B + (size_t)pn * 256 * ldb; u.nt = DS / 64; u.pm = pm; u.pn = pn; u.aux = 0; return true; }
    __device__ __forceinline__ void offs(const pg::Unit&, const int (&R)[2], const int (&C)[2], unsigned (&vo)[2][2]) const { pg::offs_plain(lda, R, C, vo); }
    __device__ __forceinline__ void epi(const f32x4 (&acc)[2][2][4][2], const pg::Unit& u, int wr, int wc, int fr, int fq) const {
        const int row0 = u.pm * 256 + wr * 64 + fr, cb = u.pn * 256 + 32 * wc + 8 * fq;
#pragma unroll
        for (int ai = 0; ai < 2; ++ai)
#pragma unroll
            for (int m = 0; m < 4; ++m) { const size_t ro = (size_t)(row0 + ai * 128 + m * 16) * DS + cb;
#pragma unroll
                for (int bj = 0; bj < 2; ++bj) { const u32x4 yv = *(const u32x4*)(Y1 + ro + 128 * bj); f32x4 y0, y1; pg::unpack8(yv, y0, y1);
                    f32x4 a = acc[ai][bj][m][0], b = acc[ai][bj][m][1];
#pragma unroll
                    for (int e = 0; e < 4; ++e) { a[e] = y0[e] * pg::fsigmoid(a[e]); b[e] = y1[e] * pg::fsigmoid(b[e]); }
                    *(u32x4*)(YS + ro + 128 * bj) = pg::pack8(a, b); } }
    }
};
struct PhProj {
    static constexpr bool GATHER = false;
    unsigned lda, ldb; const char* O; const char* YSp; const char* WPA; const char* WPS; pg::StaticOrder so; bf16* GA; const bf16* GS;
    __device__ __forceinline__ bool next(int i, pg::Unit& u) const { int pm, pn; if (!so.next(i >> 1, pm, pn)) return false; const int sub = i & 1;
        u.A = (sub ? YSp : O) + (size_t)pm * 256 * lda; u.B = (sub ? WPS : WPA) + (size_t)pn * 256 * ldb; u.nt = DA / 64; u.pm = pm; u.pn = pn; u.aux = sub; return true; }
    __device__ __forceinline__ void offs(const pg::Unit&, const int (&R)[2], const int (&C)[2], unsigned (&vo)[2][2]) const { pg::offs_plain(lda, R, C, vo); }
    __device__ __forceinline__ void epi(const f32x4 (&acc)[2][2][4][2], const pg::Unit& u, int wr, int wc, int fr, int fq) const {
        const int row0 = u.pm * 256 + wr * 64 + fr, cb = u.pn * 256 + 32 * wc + 8 * fq; const bool sub = u.aux != 0;
#pragma unroll
        for (int ai = 0; ai < 2; ++ai)
#pragma unroll
            for (int m = 0; m < 4; ++m) { const size_t ro = (size_t)(row0 + ai * 128 + m * 16) * D + cb;
#pragma unroll
                for (int bj = 0; bj < 2; ++bj) { const u32x4 gv = *(const u32x4*)(GA + ro + 128 * bj); f32x4 g0, g1; pg::unpack8(gv, g0, g1);
                    f32x4 a = acc[ai][bj][m][0], b = acc[ai][bj][m][1];
                    if (!sub) { a = a * g0; b = b * g1; }
                    else { const u32x4 sv = *(const u32x4*)(GS + ro + 128 * bj); f32x4 s0, s1; pg::unpack8(sv, s0, s1); a = g0 + s0 * a; b = g1 + s1 * b; }
                    *(u32x4*)(GA + ro + 128 * bj) = pg::pack8(a, b); } }
    }
};
struct PhWout {
    static constexpr bool GATHER = false;
    unsigned lda, ldb; const char* A; const char* B; pg::StaticOrder so; const float* x; float* out; bf16* X2B; float* SSP;
    __device__ __forceinline__ bool next(int i, pg::Unit& u) const { int pm, pn; if (!so.next(i, pm, pn)) return false; u.A = A + (size_t)pm * 256 * lda; u.B = B + (size_t)pn * 256 * ldb; u.nt = D / 64; u.pm = pm; u.pn = pn; u.aux = 0; return true; }
    __device__ __forceinline__ void offs(const pg::Unit&, const int (&R)[2], const int (&C)[2], unsigned (&vo)[2][2]) const { pg::offs_plain(lda, R, C, vo); }
    __device__ __forceinline__ void epi(const f32x4 (&acc)[2][2][4][2], const pg::Unit& u, int wr, int wc, int fr, int fq) const {
        const int row0 = u.pm * 256 + wr * 64 + fr, cb = u.pn * 256 + 32 * wc + 8 * fq;
#pragma unroll
        for (int ai = 0; ai < 2; ++ai)
#pragma unroll
            for (int m = 0; m < 4; ++m) { const int row = row0 + ai * 128 + m * 16; const size_t ro = (size_t)row * D + cb; float ss = 0.f;
#pragma unroll
                for (int bj = 0; bj < 2; ++bj) { const f32x4 x0 = *(const f32x4*)(x + ro + 128 * bj), x1 = *(const f32x4*)(x + ro + 128 * bj + 4);
                    const f32x4 a = acc[ai][bj][m][0] + x0, b = acc[ai][bj][m][1] + x1;
                    *(u32x4*)(X2B + ro + 128 * bj) = pg::pack8(a, b);
                    ss += (a[0] * a[0] + a[1] * a[1]) + (a[2] * a[2] + a[3] * a[3]) + (b[0] * b[0] + b[1] * b[1]) + (b[2] * b[2] + b[3] * b[3]); }
                ss += __shfl_xor(ss, 16); ss += __shfl_xor(ss, 32);
                if (fq == 0) SSP[(size_t)row * 16 + u.pn * 4 + wc] = ss;
                asm volatile("" ::: "memory"); }
    }
};

__device__ __forceinline__ void p2_side_work(Frame& F, const Args& a) {
    unsigned char* ws = a.ws; const int i0 = (int)blockIdx.x - 64;
    LAS float* KT = (LAS float*)F.lds;
    for (int sl = i0; sl < NG * 8; sl += 192) { const int g = sl >> 3, q = sl & 7;
        __syncthreads();
        { const GAS f32x4* src = (const GAS f32x4*)((const float*)(ws + WS_KTG) + (size_t)g * LCH * GC * GC);
          for (int i = F.tid; i < (4 * q + 4) * GC * GC / 4; i += NWAVES * 64) *(LAS f32x4*)(KT + 4 * i) = src[i]; }
        __syncthreads();
        const int n = 64 * q + (F.tid >> 3), part = F.tid & 7, j = n >> 4, co = n & 15; bf16* row = (bf16*)(ws + WS_BTY) + ((size_t)g * 512 + n) * U2P + 128;
#pragma unroll 1
        for (int it = 0; it < 8; ++it) { const int k = (it * 8 + part) * 8, sidx = k >> 4, ci = k & 15;
            u32x4 o = (u32x4){0u, 0u, 0u, 0u};
            if (sidx <= j) { const LAS float* kp = KT + ((j - sidx) * GC + co) * GC + ci; const f32x4 k0 = *(const LAS f32x4*)kp, k1 = *(const LAS f32x4*)(kp + 4); o = pg::pack8(k0, k1); }
            *(GAS u32x4*)(row + k) = o; } }
    __syncthreads();
    LAS float* scr = (LAS float*)(F.lds + F.wave * 8704);
    constexpr int I_GLU = 8 * 16, I_PA = 8 * 32, I_OUT = 16 * 32;
    for (int it = i0 * NWAVES + F.wave; it < I_GLU + 2 * I_PA + I_OUT; it += 192 * NWAVES) { int r = it;
        if (r < I_GLU) { const int kb = r >> 4, nb = r & 15; conv_item(a.in[14], DS, kb * 64, nb * 32, (bf16*)(ws + WS_WGLU) + (size_t)(nb * 32) * DS, DS, nullptr, scr, F.lane); continue; } r -= I_GLU;
        if (r < I_PA) { const int kb = r >> 5, nb = r & 31; conv_item(a.in[15], D, kb * 64, nb * 32, (bf16*)(ws + WS_WPA) + (size_t)(nb * 32) * DA, DA, nullptr, scr, F.lane); continue; } r -= I_PA;
        if (r < I_PA) { const int kb = r >> 5, nb = r & 31; conv_item(a.in[16], D, kb * 64, nb * 32, (bf16*)(ws + WS_WPS) + (size_t)(nb * 32) * DS, DS, nullptr, scr, F.lane); continue; } r -= I_PA;
        { const int kb = r >> 5, nb = r & 31; conv_item(a.in[17], D, kb * 64, nb * 32, (bf16*)(ws + WS_WOUT) + (size_t)(nb * 32) * D, D, nullptr, scr, F.lane); } }
    if (i0 < 48) { const int r = i0; const float* gf = a.in[18]; const float* wrg = a.in[19]; const float* wre = a.in[21]; bf16* WR = (bf16*)(ws + WS_WR) + (size_t)r * D;
        for (int k = F.tid; k < D; k += NWAVES * 64) { const float w = r < 4 ? wrg[k * 4 + r] : (r < 36 ? wre[k * NE + r - 4] : 0.f); WR[k] = f2bf(w * gf[k]); } }
    __syncthreads();
}
__device__ __forceinline__ void p2_expert_weights(Frame& F, const Args& a) {
    unsigned char* ws = a.ws; LAS float* scr = (LAS float*)(F.lds + F.wave * 8704);
    const int gw = F.vcu * NWAVES + F.wave, NGW = F.G * NWAVES;
    const float* gf = a.in[18]; const float* wg = a.in[23]; const float* wu = a.in[24]; const float* wd = a.in[25];
    constexpr int I_G = 16 * 8, I_D = 4 * 32;
    constexpr int NITEMS = NE * (2 * I_G + I_D);
    auto desc = [&](int it) -> ConvDesc { const int e = it / (2 * I_G + I_D); int r = it % (2 * I_G + I_D);
        if (r < 2 * I_G) { const int up = r >= I_G; if (up) r -= I_G; const int kb = r >> 3, nb = r & 7, n0 = nb * 32;
            return ConvDesc{(up ? wu : wg) + (size_t)e * D * DE, DE, kb * 64, n0, (bf16*)(ws + WS_WGU) + ((size_t)e * 512 + 256 * (n0 >> 7) + 128 * up + (n0 & 127)) * D, D, gf}; }
        r -= 2 * I_G; const int kb = r >> 5, nb = r & 31; return ConvDesc{wd + (size_t)e * DE * D, D, kb * 64, nb * 32, (bf16*)(ws + WS_WD) + ((size_t)e * D + nb * 32) * DE, DE, nullptr}; };
    int it = (a.sub & 4) ? gw : NITEMS;
    float v[32]; ConvDesc d{}; if (it < NITEMS) { d = desc(it); conv_load(d, v, F.lane); }
    while (it < NITEMS) {
        const int itn = it + NGW; float vn[32]; ConvDesc dn{}; if (itn < NITEMS) { dn = desc(itn); conv_load(dn, vn, F.lane); }
        conv_finish(d, v, scr, F.lane);
#pragma unroll
        for (int i = 0; i < 32; ++i) v[i] = vn[i];
        d = dn; it = itn;
    }
}
__device__ __forceinline__ void p8_router(Frame& F, const Args& a) {
    unsigned char* ws = a.ws;
    constexpr int WPITCH = 2064;
    LAS unsigned char* wl = F.lds;
    LAS float* lg = (LAS float*)(F.lds + 48 * WPITCH) + F.wave * 16 * 48;
    { const GAS u32x4* src = (const GAS u32x4*)(ws + WS_WR);
      for (int i = F.tid; i < 48 * 128; i += NWAVES * 64) { const int r = i >> 7, c = i & 127; *(LAS u32x4*)(wl + r * WPITCH + c * 16) = src[i]; } }
    __syncthreads();
    const bf16* X2B = (const bf16*)(ws + WS_X2B); const float* SSP = (const float*)(ws + WS_SSP);
    const float* b_rg = a.in[20]; const float* b_re = a.in[22];
    float* RSTD = (float*)(ws + WS_RSTD); int* ROUTE = (int*)(ws + WS_ROUTE); int* CNT = (int*)(ws + WS_CTL) + CW_CNT; int* LIST = (int*)(ws + WS_LIST); float* WPOS = (float*)(ws + WS_WPOS); float* RPOS = (float*)(ws + WS_RPOS);
    const int fr = F.lane & 15, fq = F.lane >> 4;
    LAS int* lcnt = (LAS int*)(F.lds + 48 * WPITCH + NWAVES * 16 * 48 * 4);
    LAS int* lbase = lcnt + 32;
    for (int t0 = F.vcu * 64; t0 < T; t0 += F.G * 64) {
        if (F.tid < 32) lcnt[F.tid] = 0;
        __syncthreads();
        int e0 = 0, e1 = 0, lr0 = 0, lr1 = 0; float w0 = 0.f, w1 = 0.f, rstd = 0.f;
        if (F.wave < 4) {
            const int tok = t0 + F.wave * 16 + fr;
            const GAS bf16x8* xa = (const GAS bf16x8*)(X2B + (size_t)tok * D + 8 * fq);
            f32x4 acc[3]; acc[0] = acc[1] = acc[2] = (f32x4){0.f, 0.f, 0.f, 0.f};
            bf16x8 xf[32];
#pragma unroll
            for (int ks = 0; ks < 32; ++ks) xf[ks] = xa[ks * 4];
#pragma unroll
            for (int ks = 0; ks < 32; ++ks) {
#pragma unroll
                for (int n = 0; n < 3; ++n) { const bf16x8 wfr = *(const LAS bf16x8*)(wl + (n * 16 + fr) * WPITCH + ks * 64 + fq * 16);
                    acc[n] = __builtin_amdgcn_mfma_f32_16x16x32_bf16(wfr, xf[ks], acc[n], 0, 0, 0); } }
#pragma unroll
            for (int n = 0; n < 3; ++n) *(LAS f32x4*)(lg + fr * 48 + n * 16 + 4 * fq) = acc[n];
            LDS_WAIT(); asm volatile("" ::: "memory");
            if (F.lane < 16) {
                const int t = t0 + F.wave * 16 + F.lane; const LAS float* l = lg + F.lane * 48;
                float ss = 0.f; { const f32x4* sp = (const f32x4*)(SSP + (size_t)t * 16);
#pragma unroll
                    for (int i = 0; i < 4; ++i) { const f32x4 v = sp[i]; ss += (v[0] + v[1]) + (v[2] + v[3]); } }
                rstd = rsqrtf(ss * (1.f / D) + EPS);
                float gl[4]; int gs = 0;
#pragma unroll
                for (int i = 0; i < 4; ++i) gl[i] = l[i] * rstd + b_rg[i];
                float gm = gl[0];
#pragma unroll
                for (int i = 1; i < 4; ++i) if (gl[i] > gm) { gm = gl[i]; gs = i; }
                float gsum = 0.f;
#pragma unroll
                for (int i = 0; i < 4; ++i) gsum += __expf(gl[i] - gm);
                const float gtop = 1.f / gsum;
                float el[8];
#pragma unroll
                for (int i = 0; i < 8; ++i) el[i] = l[4 + gs * 8 + i] * rstd + b_re[gs * 8 + i];
                int i0 = 0; float m0 = el[0];
#pragma unroll
                for (int i = 1; i < 8; ++i) if (el[i] > m0) { m0 = el[i]; i0 = i; }
                int i1 = -1; float m1 = -3.0e38f;
#pragma unroll
                for (int i = 0; i < 8; ++i) if (i != i0 && el[i] > m1) { m1 = el[i]; i1 = i; }
                const float p1 = __expf(m1 - m0); w0 = gtop / (1.f + p1); w1 = gtop * p1 / (1.f + p1);
                e0 = gs * 8 + i0; e1 = gs * 8 + i1;
                lr0 = __hip_atomic_fetch_add(&lcnt[e0], 1, __ATOMIC_RELAXED, __HIP_MEMORY_SCOPE_WORKGROUP); lr1 = __hip_atomic_fetch_add(&lcnt[e1], 1, __ATOMIC_RELAXED, __HIP_MEMORY_SCOPE_WORKGROUP);
            }
        }
        __syncthreads();
        if (F.tid < 32) { const int c = lcnt[F.tid]; lbase[F.tid] = c ? atomicAdd(&CNT[F.tid], c) : 0; }
        __syncthreads();
        if (F.wave < 4 && F.lane < 16) {
            const int t = t0 + F.wave * 16 + F.lane; const int r0 = lbase[e0] + lr0, r1 = lbase[e1] + lr1;
            RSTD[t] = rstd; *(int4*)(ROUTE + t * 4) = make_int4(e0, e1, r0, r1);
            LIST[e0 * T + r0] = t; LIST[e1 * T + r1] = t; WPOS[e0 * T + r0] = w0; WPOS[e1 * T + r1] = w1; RPOS[e0 * T + r0] = rstd; RPOS[e1 * T + r1] = rstd;
        }
        __syncthreads();
    }
}
__device__ __forceinline__ void moe_table(Frame& F, const int* CNT, LAS int* tb) {
    if (F.tid < 64) { const int e = F.lane; int c = 0; if (e < NE) c = (int)__hip_atomic_load((const unsigned*)CNT + e, __ATOMIC_RELAXED, __HIP_MEMORY_SCOPE_AGENT);
        const int tl = (c + 255) >> 8; int incl = tl;
#pragma unroll
        for (int o = 1; o < 32; o <<= 1) { const int v = __shfl_up(incl, o); if (e >= o) incl += v; }
        if (e < NE) { tb[e] = incl - tl; tb[64 + e] = c; } if (e == NE - 1) tb[32] = incl; }
    __syncthreads();
}
__device__ __forceinline__ int moe_find(const LAS int* tb, int mt) { int e = 0;
#pragma unroll 1
    for (int i = 1; i < NE; ++i) if (mt >= tb[i]) e = i; return e; }
struct PhMoeGU {
    static constexpr bool GATHER = true;
    unsigned lda, ldb; const char* X; const char* W; const LAS int* tb; const int* LIST; const float* RPOS; bf16* H; int G, c;
    __device__ __forceinline__ bool next(int i, pg::Unit& u) const { const int L = i * G + c; if (L >= 2 * tb[32]) return false; const int mt = L >> 1, n2 = L & 1, e = moe_find(tb, mt);
        u.A = X; u.B = W + ((size_t)e * 512 + n2 * 256) * ldb; u.nt = D / 64; u.pm = mt; u.pn = n2; u.aux = e; return true; }
    __device__ __forceinline__ void offs(const pg::Unit& u, const int (&R)[2], const int (&C)[2], unsigned (&vo)[2][2]) const {
        const int e = u.aux, cnt = tb[64 + e], r0 = (u.pm - tb[e]) * 256; const int* lp = LIST + (size_t)e * T;
#pragma unroll
        for (int h = 0; h < 2; ++h)
#pragma unroll
            for (int i = 0; i < 2; ++i) { int r = r0 + h * 128 + R[i]; r = r < cnt ? r : cnt - 1; vo[h][i] = (unsigned)lp[r] * lda + (unsigned)C[i] * 2u; }
    }
    __device__ __forceinline__ void epi(const f32x4 (&acc)[2][2][4][2], const pg::Unit& u, int wr, int wc, int fr, int fq) const {
        const int e = u.aux, r0 = (u.pm - tb[e]) * 256; const float* rp = RPOS + (size_t)e * T + r0;
#pragma unroll
        for (int ai = 0; ai < 2; ++ai)
#pragma unroll
            for (int m = 0; m < 4; ++m) { const int tr = ai * 128 + wr * 64 + m * 16 + fr; const float rs = rp[tr];
                f32x4 g0 = acc[ai][0][m][0] * rs, g1 = acc[ai][0][m][1] * rs; const f32x4 u0 = acc[ai][1][m][0] * rs, u1 = acc[ai][1][m][1] * rs;
#pragma unroll
                for (int q = 0; q < 4; ++q) { g0[q] = g0[q] * pg::fsigmoid(g0[q]) * u0[q]; g1[q] = g1[q] * pg::fsigmoid(g1[q]) * u1[q]; }
                *(u32x4*)(H + ((size_t)u.pm * 256 + tr) * DE + u.pn * 128 + 32 * wc + 8 * fq) = pg::pack8(g0, g1); }
    }
};
struct PhMoeDown {
    static constexpr bool GATHER = false;
    unsigned lda, ldb; const char* Hp; const char* W; const LAS int* tb; const float* WPOS; bf16* Y; int G, c;
    __device__ __forceinline__ bool next(int i, pg::Unit& u) const { const int L = i * G + c; if (L >= 4 * tb[32]) return false; const int mt = L >> 2, n4 = L & 3, e = moe_find(tb, mt);
        u.A = Hp + (size_t)mt * 256 * lda; u.B = W + ((size_t)e * D + n4 * 256) * ldb; u.nt = DE / 64; u.pm = mt; u.pn = n4; u.aux = e; return true; }
    __device__ __forceinline__ void offs(const pg::Unit&, const int (&R)[2], const int (&C)[2], unsigned (&vo)[2][2]) const { pg::offs_plain(lda, R, C, vo); }
    __device__ __forceinline__ void epi(const f32x4 (&acc)[2][2][4][2], const pg::Unit& u, int wr, int wc, int fr, int fq) const {
        const int e = u.aux, r0 = (u.pm - tb[e]) * 256; const float* wp = WPOS + (size_t)e * T + r0;
#pragma unroll
        for (int ai = 0; ai < 2; ++ai)
#pragma unroll
            for (int m = 0; m < 4; ++m) { const int tr = ai * 128 + wr * 64 + m * 16 + fr; const float w = wp[tr]; bf16* yp = Y + ((size_t)u.pm * 256 + tr) * D + u.pn * 256 + 32 * wc + 8 * fq;
#pragma unroll
                for (int bj = 0; bj < 2; ++bj) *(u32x4*)(yp + 128 * bj) = pg::pack8(acc[ai][bj][m][0] * w, acc[ai][bj][m][1] * w); }
    }
};
__device__ __forceinline__ void p11_combine(Frame& F, const Args& a, const LAS int* tb) {
    unsigned char* ws = a.ws; const int* ROUTE = (const int*)(ws + WS_ROUTE); const bf16* Y = (const bf16*)(ws + WS_Y); const bf16* X2B = (const bf16*)(ws + WS_X2B); float* out = a.out;
    for (int t = F.vcu * NWAVES + F.wave; t < T; t += F.G * NWAVES) {
        const int4 rt = *(const int4*)(ROUTE + t * 4);
        const GAS u32x2* y0 = (const GAS u32x2*)(Y + ((size_t)tb[rt.x] * 256 + rt.z) * D) + F.lane; const GAS u32x2* y1 = (const GAS u32x2*)(Y + ((size_t)tb[rt.y] * 256 + rt.w) * D) + F.lane;
        const GAS u32x2* xb = (const GAS u32x2*)(X2B + (size_t)t * D) + F.lane;
        GAS f32x4* o = (GAS f32x4*)(out + (size_t)t * D) + F.lane;
#pragma unroll
        for (int j = 0; j < 4; ++j) { const u32x2 a0 = y0[64 * j], a1 = y1[64 * j], xv = xb[64 * j]; f32x4 v;
            v[0] = __builtin_bit_cast(float, xv.x << 16) + (__builtin_bit_cast(float, a0.x << 16) + __builtin_bit_cast(float, a1.x << 16)); v[1] = __builtin_bit_cast(float, xv.x & 0xffff0000u) + (__builtin_bit_cast(float, a0.x & 0xffff0000u) + __builtin_bit_cast(float, a1.x & 0xffff0000u));
            v[2] = __builtin_bit_cast(float, xv.y << 16) + (__builtin_bit_cast(float, a0.y << 16) + __builtin_bit_cast(float, a1.y << 16)); v[3] = __builtin_bit_cast(float, xv.y & 0xffff0000u) + (__builtin_bit_cast(float, a0.y & 0xffff0000u) + __builtin_bit_cast(float, a1.y & 0xffff0000u));
            o[64 * j] = v; }
    }
}

struct PhSsmX {
    static constexpr bool GATHER = false;
    unsigned lda, ldb; const char* U2X; const char* M1T; float* SLOC; int g, b;
    __device__ __forceinline__ bool next(int i, pg::Unit& u) const { if (i >= 1) return false; u.A = U2X + ((size_t)(g * NCR + b * 256) * U2P + 128) * 2; u.B = M1T + (size_t)g * 256 * ldb; u.nt = 8; u.pm = b; u.pn = 0; u.aux = 0; return true; }
    __device__ __forceinline__ void offs(const pg::Unit&, const int (&R)[2], const int (&C)[2], unsigned (&vo)[2][2]) const { pg::offs_plain(lda, R, C, vo); }
    __device__ __forceinline__ void epi(const f32x4 (&acc)[2][2][4][2], const pg::Unit& u, int wr, int wc, int fr, int fq) const {
#pragma unroll
        for (int ai = 0; ai < 2; ++ai)
#pragma unroll
            for (int m = 0; m < 4; ++m) { float* p = SLOC + ((size_t)g * NCR + u.pm * 256 + ai * 128 + wr * 64 + m * 16 + fr) * 128 + 32 * wc + 8 * fq;
                *(f32x4*)p = acc[ai][0][m][0]; *(f32x4*)(p + 4) = acc[ai][0][m][1]; }
    }
};
__device__ __forceinline__ void ssm_scan(Frame& F, unsigned char* ws, int g, int b) {
    LAS f32x2* ends = (LAS f32x2*)F.lds;
    const int p = F.lane, w = F.wave;
    const float alr = ((const float*)(ws + WS_AL))[(g * NP + p) * 2], ali = ((const float*)(ws + WS_AL))[(g * NP + p) * 2 + 1];
    const float* sl = (const float*)(ws + WS_SLOC) + ((size_t)g * NCR + b * 256 + w * 32) * 128;
    float lr[32], li[32];
#pragma unroll
    for (int k = 0; k < 32; ++k) { lr[k] = sl[k * 128 + p]; li[k] = sl[k * 128 + 64 + p]; }
#pragma unroll
    for (int k = 1; k < 32; ++k) { const float nr = alr * lr[k - 1] - ali * li[k - 1] + lr[k], ni = alr * li[k - 1] + ali * lr[k - 1] + li[k]; lr[k] = nr; li[k] = ni; }
    ends[w * 64 + p] = (f32x2){lr[31], li[31]};
    float sr = alr, si = ali;
#pragma unroll
    for (int k = 0; k < 5; ++k) { const float t = sr * sr - si * si; si = 2.f * sr * si; sr = t; }
    __syncthreads();
    float cr = 0.f, ci = 0.f;
    for (int s2 = 0; s2 < w; ++s2) { const f32x2 e = ends[s2 * 64 + p]; const float t = sr * cr - si * ci + e.x; ci = sr * ci + si * cr + e.y; cr = t; }
    bf16* hp = (bf16*)(ws + WS_U2X) + ((size_t)g * NCR + b * 256 + w * 32) * U2P;
    float pr = cr, pi = ci;
#pragma unroll
    for (int k = 0; k < 32; ++k) { const float hr = (k ? lr[k - 1] : 0.f) + pr, hi = (k ? li[k - 1] : 0.f) + pi;
        hp[(size_t)k * U2P + p] = f2bf(hr); hp[(size_t)k * U2P + 64 + p] = f2bf(hi);
        const float t = alr * pr - ali * pi; pi = alr * pi + ali * pr; pr = t; }
    __syncthreads();
}
struct PhSsmY {
    static constexpr bool GATHER = false;
    unsigned lda, ldb; const char* U2Xp; const char* BTY; const bf16* U2X; const float* Dsk; bf16* Y1; int G, c;
    __device__ __forceinline__ bool next(int i, pg::Unit& u) const { const int L = i * G + c; if (L >= NG * 4) return false; const int g = L >> 2, mt = (L >> 1) & 1, nb = L & 1;
        u.A = U2Xp + (size_t)(g * NCR + mt * 256) * lda; u.B = BTY + (size_t)(g * 512 + nb * 256) * ldb; u.nt = nb ? 10 : 6; u.pm = mt; u.pn = nb; u.aux = g; return true; }
    __device__ __forceinline__ void offs(const pg::Unit&, const int (&R)[2], const int (&C)[2], unsigned (&vo)[2][2]) const { pg::offs_plain(lda, R, C, vo); }
    __device__ __forceinline__ void epi(const f32x4 (&acc)[2][2][4][2], const pg::Unit& u, int wr, int wc, int fr, int fq) const {
        const int g = u.aux;
#pragma unroll
        for (int bj = 0; bj < 2; ++bj) { const int n = u.pn * 256 + 128 * bj + 32 * wc + 8 * fq, j = n >> 4, c0 = n & 15;
            const f32x4 d0 = *(const f32x4*)(Dsk + g * GC + c0), d1 = *(const f32x4*)(Dsk + g * GC + c0 + 4);
#pragma unroll
            for (int ai = 0; ai < 2; ++ai)
#pragma unroll
                for (int m = 0; m < 4; ++m) { const int cr = u.pm * 256 + ai * 128 + wr * 64 + m * 16 + fr;
                    const u32x4 uv = *(const u32x4*)(U2X + ((size_t)g * NCR + cr) * U2P + 128 + j * GC + c0); f32x4 u0, u1; pg::unpack8(uv, u0, u1);
                    f32x4 a = acc[ai][bj][m][0] + d0 * u0, b = acc[ai][bj][m][1] + d1 * u1;
#pragma unroll
                    for (int q = 0; q < 4; ++q) { a[q] = gelu_fast(a[q]); b[q] = gelu_fast(b[q]); }
                    *(u32x4*)(Y1 + ((size_t)cr * LCH + j) * DS + g * GC + c0) = pg::pack8(a, b); } }
    }
};

__global__ void __launch_bounds__(NWAVES * 64, 2) mk_fwd(Args args) {
    extern __shared__ __attribute__((aligned(16))) unsigned char lds[];
    Frame F;
    F.lds = (LAS unsigned char*)lds; F.MISC = (volatile LAS unsigned*)(F.lds + MISC_OFF);
    F.tid = threadIdx.x; F.lane = F.tid & 63; F.wave = __builtin_amdgcn_readfirstlane(F.tid >> 6);
    F.G = gridDim.x; { const int bx = blockIdx.x; F.vcu = (F.G % 8 == 0) ? (bx % 8) * (F.G / 8) + bx / 8 : bx; }
    unsigned char* ws = args.ws; F.ctl = (gu32*)(ws + WS_CTL);
    for (int u = F.tid; u < (LDS_BYTES - LDSCTL_OFF) / 4; u += NWAVES * 64) ((LAS unsigned*)(F.lds + LDSCTL_OFF))[u] = 0u;
    __syncthreads();
    const int lo = args.ph_lo, hi = args.ph_hi;
    const bool multi = (hi - lo) > 1;
    XcdBarrier bar; bar.bar = (unsigned*)(F.ctl + CW_BAR); bar.x = 0; bar.st = nullptr;
    if (multi) bar = xcd_barrier_post((unsigned*)(F.ctl + CW_BAR), F.MISC + 8);
#define IN(k) (lo <= (k) && (k) < hi)
#define SEAM(k) do { if (IN(k) && IN((k) + 1)) xcd_barrier(bar); } while (0)
    if (IN(0)) { p0_prologue(F, args); SEAM(0); }
    if (IN(1)) {
        if (blockIdx.x < NBATCH * NH) p1_cumsum(F, (float*)(ws + WS_CUM), (int*)(ws + WS_T0), args.in[4], args.in[5]);
        PhInProj ph; ph.lda = D * 2; ph.ldb = D * 2; ph.A = (const char*)(ws + WS_XN); ph.B = (const char*)(ws + WS_WIN); ph.so.init(T / 256, 4096 / 256, F.G, (int)blockIdx.x);
        ph.Q = (bf16*)(ws + WS_Q); ph.K = (bf16*)(ws + WS_K); ph.V = (bf16*)(ws + WS_V); ph.U2X = (bf16*)(ws + WS_U2X); ph.GA = (bf16*)(ws + WS_GA); ph.GS = (bf16*)(ws + WS_GS);
        ph.gq = args.in[4]; ph.gk = args.in[5];
        pg::gemm_phase(F.lds + RING_OFF, ph);
        SEAM(1);
    }
    if (IN(2)) {
        if (blockIdx.x < 2 * NG) {
            const int g = (int)blockIdx.x >> 1, b = (int)blockIdx.x & 1;
            PhSsmX ph; ph.lda = U2P * 2; ph.ldb = 512 * 2; ph.U2X = (const char*)(ws + WS_U2X); ph.M1T = (const char*)(ws + WS_M1T); ph.SLOC = (float*)(ws + WS_SLOC); ph.g = g; ph.b = b;
            if (args.sub & 1) pg::gemm_phase(F.lds + RING_OFF, ph);
            if (args.sub & 2) ssm_scan(F, ws, g, b);
            __syncthreads();
        } else if (F.G == 256) p2_side_work(F, args);
        p2_expert_weights(F, args); SEAM(2);
    }
    if (IN(3)) {
        static_assert(attn_body::ATTN_LDS_BYTES + 2 * attn_body::MAX_ITEMS * 4 <= RING_BYTES, "attention LDS");
        const attn_body::AttnTensors AT{(const attn_body::bf16*)(ws + WS_Q), (const attn_body::bf16*)(ws + WS_K), (const attn_body::bf16*)(ws + WS_V), (attn_body::bf16*)(ws + WS_Q), (const float*)(ws + WS_CUM),
            (const int*)(ws + WS_T0), (attn_body::bf16*)(ws + WS_PO), (float*)(ws + WS_PS), (unsigned*)(F.ctl + CW_Q0)};
        attn_body::attn_phase<20>((char*)lds + RING_OFF, AT, F.vcu, F.G);
        SEAM(3);
    }
    if (IN(4)) {
        if (F.vcu >= 128) {
            const attn_body::AttnTensors AT{(const attn_body::bf16*)(ws + WS_Q), (const attn_body::bf16*)(ws + WS_K), (const attn_body::bf16*)(ws + WS_V), (attn_body::bf16*)(ws + WS_Q), (const float*)(ws + WS_CUM),
                (const int*)(ws + WS_T0), (attn_body::bf16*)(ws + WS_PO), (float*)(ws + WS_PS), (unsigned*)(F.ctl + CW_Q0)};
            attn_body::attn_combine((char*)lds + RING_OFF, AT, F.vcu - 128, F.G - 128);
        }
        PhSsmY ph; ph.lda = U2P * 2; ph.ldb = U2P * 2; ph.U2Xp = (const char*)(ws + WS_U2X); ph.BTY = (const char*)(ws + WS_BTY); ph.U2X = (const bf16*)(ws + WS_U2X); ph.Dsk = args.in[13]; ph.Y1 = (bf16*)(ws + WS_Y1); ph.G = F.G; ph.c = F.vcu;
        pg::gemm_phase(F.lds + RING_OFF, ph);
        SEAM(4);
    }
    if (IN(5)) {
        PhGlu ph; ph.lda = DS * 2; ph.ldb = DS * 2; ph.A = (const char*)(ws + WS_Y1); ph.B = (const char*)(ws + WS_WGLU); ph.so.init(T / 256, DS / 256, F.G, (int)blockIdx.x); ph.Y1 = (const bf16*)(ws + WS_Y1); ph.YS = (bf16*)(ws + WS_YS);
        pg::gemm_phase(F.lds + RING_OFF, ph);
        SEAM(5);
    }
    if (IN(6)) {
        PhProj ph; ph.lda = DA * 2; ph.ldb = DA * 2; ph.O = (const char*)(ws + WS_Q); ph.YSp = (const char*)(ws + WS_YS); ph.WPA = (const char*)(ws + WS_WPA); ph.WPS = (const char*)(ws + WS_WPS);
        ph.so.init(T / 256, D / 256, F.G, (int)blockIdx.x); ph.GA = (bf16*)(ws + WS_GA); ph.GS = (const bf16*)(ws + WS_GS);
        pg::gemm_phase(F.lds + RING_OFF, ph);
        SEAM(6);
    }
    if (IN(7)) {
        PhWout ph; ph.lda = D * 2; ph.ldb = D * 2; ph.A = (const char*)(ws + WS_GA); ph.B = (const char*)(ws + WS_WOUT); ph.so.init(T / 256, D / 256, F.G, (int)blockIdx.x);
        ph.x = args.in[0]; ph.out = args.out; ph.X2B = (bf16*)(ws + WS_X2B); ph.SSP = (float*)(ws + WS_SSP);
        pg::gemm_phase(F.lds + RING_OFF, ph);
        SEAM(7);
    }
    if (IN(8)) { p8_router(F, args); SEAM(8); }
    LAS int* tb = (LAS int*)(F.lds + LDSCTL_OFF + 512);
    if (IN(9)) {
        moe_table(F, (const int*)(ws + WS_CTL) + CW_CNT, tb);
        PhMoeGU ph; ph.lda = D * 2; ph.ldb = D * 2; ph.X = (const char*)(ws + WS_X2B); ph.W = (const char*)(ws + WS_WGU); ph.tb = tb; ph.LIST = (const int*)(ws + WS_LIST); ph.RPOS = (const float*)(ws + WS_RPOS);
        ph.H = (bf16*)(ws + WS_H); ph.G = F.G; ph.c = F.vcu;
        pg::gemm_phase(F.lds + RING_OFF, ph);
        SEAM(9);
    }
    if (IN(10)) {
        if (!IN(9)) moe_table(F, (const int*)(ws + WS_CTL) + CW_CNT, tb);
        PhMoeDown ph; ph.lda = DE * 2; ph.ldb = DE * 2; ph.Hp = (const char*)(ws + WS_H); ph.W = (const char*)(ws + WS_WD); ph.tb = tb; ph.WPOS = (const float*)(ws + WS_WPOS); ph.Y = (bf16*)(ws + WS_Y); ph.G = F.G; ph.c = F.vcu;
        pg::gemm_phase(F.lds + RING_OFF, ph);
        SEAM(10);
    }
    if (IN(11)) {
        if (!IN(10)) moe_table(F, (const int*)(ws + WS_CTL) + CW_CNT, tb);
        p11_combine(F, args, tb);
    }
#undef IN
#undef SEAM
}

extern "C" void kernel_launch(void* const* d_in, const int* in_sizes, int n_in, void* d_out, int out_size, void* d_ws, size_t ws_size, hipStream_t stream) {
    static int grid = 0;
    if (grid == 0) {
        int dev = 0, cus = 0; (void)hipGetDevice(&dev); (void)hipDeviceGetAttribute(&cus, hipDeviceAttributeMultiprocessorCount, dev);
        (void)hipFuncSetAttribute((const void*)mk_fwd, hipFuncAttributeMaxDynamicSharedMemorySize, LDS_BYTES);
        grid = cus > 0 ? cus : 256;
    }
    (void)hipMemsetAsync((char*)d_ws + WS_CTL, 0, CTL_ZERO_BYTES, stream);
    Args a{}; for (int i = 0; i < 26; ++i) a.in[i] = (const float*)d_in[i]; a.out = (float*)d_out; a.ws = (unsigned char*)d_ws;
    a.ph_lo = 0; a.ph_hi = 12; a.sub = 7;
    hipLaunchKernelGGL(mk_fwd, dim3(grid), dim3(NWAVES * 64), LDS_BYTES, stream, a);
}
```

```cpp
#include <hip/hip_runtime.h>
#include <stdint.h>
#include <math.h>

typedef unsigned short bf16;
constexpr int T = 16384, D = 1024, SEQ = 8192, NBATCH = 2, NH = 8, HD = 64, DA = 512, DS = 512, NG = 32, GC = 16, NP = 64, NE = 32, DE = 256;
constexpr int DIN = 4104, OQ = 0, OK_ = 512, OV = 1024, OF = 1536, OU = 1544, OGA = 2056, OGS = 3080;
constexpr int LCH = 32, NCR = T / LCH;
constexpr int U2P = 640;
constexpr float EPS = 1e-6f;
constexpr float C2 = 0.125f * 1.4426950408889634f;
constexpr float LOG2E = 1.4426950408889634f;
constexpr int YROWS = 40960;

constexpr size_t MiB = 1u << 20;
constexpr size_t WS_CTL = 0, CTL_ZERO_BYTES = 1 * MiB;
constexpr size_t WS_CUM = 1 * MiB;
constexpr size_t WS_AL = 1 * MiB + 512 * 1024;
constexpr size_t WS_T0 = 1 * MiB + 768 * 1024;
constexpr size_t WS_PS = 8 * MiB;
constexpr size_t WS_PO = 229 * MiB;
constexpr size_t WS_RSTD = 2 * MiB;
constexpr size_t WS_ROUTE = 2 * MiB + 256 * 1024;
constexpr size_t WS_LIST = 3 * MiB;
constexpr size_t WS_WPOS = 5 * MiB;
constexpr size_t WS_SSP = 7 * MiB;
constexpr size_t WS_WIN = 8 * MiB;
constexpr size_t WS_SLOC = 229 * MiB;
constexpr size_t WS_WGLU = 16 * MiB, WS_WPA = 16 * MiB + 512 * 1024, WS_WPS = 17 * MiB + 512 * 1024, WS_WOUT = 18 * MiB + 512 * 1024, WS_WR = 20 * MiB + 512 * 1024;
constexpr size_t WS_M1T = 21 * MiB;
constexpr size_t WS_BTY = 29 * MiB;
constexpr size_t WS_XN = 49 * MiB;
constexpr size_t WS_WGU = 49 * MiB;
constexpr size_t WS_Q = 81 * MiB;
constexpr size_t WS_K = 97 * MiB;
constexpr size_t WS_V = 113 * MiB;
constexpr size_t WS_Y1 = 97 * MiB, WS_YS = 113 * MiB;
constexpr size_t WS_U2X = 129 * MiB;
constexpr size_t WS_GA = 149 * MiB;
constexpr size_t WS_GS = 181 * MiB;
constexpr size_t WS_X2B = 181 * MiB;
constexpr size_t WS_WD = 213 * MiB;
constexpr size_t WS_H = 229 * MiB;
constexpr size_t WS_RPOS = 249 * MiB;
constexpr size_t WS_KTG = 251 * MiB;
constexpr size_t WS_Y = 81 * MiB;
static_assert(WS_H + (size_t)YROWS * DE * 2 <= WS_RPOS && WS_RPOS + 2 * MiB <= WS_KTG && WS_KTG + MiB <= 256 * MiB && WS_Y + (size_t)YROWS * D * 2 <= WS_GS, "d_ws map");

__device__ __forceinline__ bf16 f2bf(float f) { unsigned u = __builtin_bit_cast(unsigned, f); return (bf16)((u + 0x7fffu + ((u >> 16) & 1u)) >> 16); }
__device__ __forceinline__ float bf2f(bf16 b) { return __builtin_bit_cast(float, (unsigned)b << 16); }
__device__ __forceinline__ float sigmoidf_(float x) { return 1.f / (1.f + __expf(-x)); }
__device__ __forceinline__ float gelu_tanh(float x) { const float z = 0.7978845608028654f * (x + 0.044715f * x * x * x); const float e = __expf(2.f * z); return 0.5f * x * (1.f + (1.f - 2.f / (e + 1.f))); }
__device__ __forceinline__ float log_sigmoid(float x) { return -(fmaxf(-x, 0.f) + log1pf(__expf(-fabsf(x)))); }
__device__ __forceinline__ size_t u2x_index(int g, int t, int c) { return ((size_t)g * NCR + (t / LCH)) * U2P + 128 + (t % LCH) * GC + c; }

#define LAS __attribute__((address_space(3)))
#define GAS __attribute__((address_space(1)))
typedef short bf16x8 __attribute__((ext_vector_type(8)));
typedef float f32x4 __attribute__((ext_vector_type(4)));
typedef float f32x2 __attribute__((ext_vector_type(2)));
typedef unsigned u32x4 __attribute__((ext_vector_type(4)));
typedef unsigned u32x2 __attribute__((ext_vector_type(2)));
namespace pg {
constexpr int BM = 256, BK = 64, HALF = 128, HTB = HALF * BK * 2, STAGE_BYTES = 8 * HTB, NXCD = 8, WGM = 8;
__host__ __device__ __forceinline__ int lds_byte(int r, int c) { const int st = (r >> 4) * 2 + (c >> 5), rr = r & 15, cc = c & 31, ob = rr * 64 + cc * 2; return st * 1024 + (ob ^ (((ob >> 9) & 1) << 5)); }
__host__ __device__ __forceinline__ void stage_rc(int b, int& R, int& C) { const int st = b / 1024, sb = b % 1024, swz = sb ^ (((sb >> 9) & 1) << 5); R = (st >> 1) * 16 + swz / 64; C = (st & 1) * 32 + (swz % 64) / 2; }
__host__ __device__ __forceinline__ int perm32(int rho) { const int n = rho >> 4, i = rho & 15; return 8 * (i >> 2) + 4 * n + (i & 3); }
typedef __bf16 bf16x2_t __attribute__((ext_vector_type(2)));
__device__ __forceinline__ unsigned cvt_pk_bf16(float lo, float hi) { const f32x2 v = {lo, hi}; const bf16x2_t b = __builtin_convertvector(v, bf16x2_t); return __builtin_bit_cast(unsigned, b); }
__device__ __forceinline__ u32x4 pack8(const f32x4& a, const f32x4& b) { u32x4 w; w.x = cvt_pk_bf16(a[0], a[1]); w.y = cvt_pk_bf16(a[2], a[3]); w.z = cvt_pk_bf16(b[0], b[1]); w.w = cvt_pk_bf16(b[2], b[3]); return w; }
__device__ __forceinline__ void unpack8(const u32x4& w, f32x4& a, f32x4& b) {
    a[0] = __builtin_bit_cast(float, w.x << 16); a[1] = __builtin_bit_cast(float, w.x & 0xffff0000u); a[2] = __builtin_bit_cast(float, w.y << 16); a[3] = __builtin_bit_cast(float, w.y & 0xffff0000u);
    b[0] = __builtin_bit_cast(float, w.z << 16); b[1] = __builtin_bit_cast(float, w.z & 0xffff0000u); b[2] = __builtin_bit_cast(float, w.w << 16); b[3] = __builtin_bit_cast(float, w.w & 0xffff0000u); }
__device__ __forceinline__ float fsigmoid(float x) { return __builtin_amdgcn_rcpf(1.f + __builtin_amdgcn_exp2f(-1.4426950408889634f * x)); }

struct Unit { const char* A; const char* B; int nt; int pm, pn, aux; };

struct StaticOrder {
    int nM, nN, nwg, G, c;
    __device__ void init(int nM_, int nN_, int G_, int c_) { nM = nM_; nN = nN_; nwg = nM * nN; G = G_; c = c_; }
    __device__ bool next(int i, int& pm, int& pn) const {
        const long L = (long)i * G + c; if (L >= nwg) return false;
        int wgid = (int)L; { const int q = nwg / NXCD, r = nwg % NXCD, xcd = wgid % NXCD, off = wgid / NXCD; wgid = (xcd < r ? xcd * (q + 1) : r * (q + 1) + (xcd - r) * q) + off; }
        const int nig = WGM * nN, gid = wgid / nig, fm = gid * WGM, gsz = (nM - fm) < WGM ? (nM - fm) : WGM;
        pm = fm + ((wgid % nig) % gsz); pn = (wgid % nig) / gsz; return true;
    }
};

template <class P>
__device__ __forceinline__ void gemm_phase(LAS unsigned char* lds, P& ph) {
    const int tid = threadIdx.x, wid = __builtin_amdgcn_readfirstlane(tid >> 6), lane = tid & 63, wr = wid >> 2, wc = wid & 3, fr = lane & 15, fq = lane >> 4;
    const unsigned lda = ph.lda, ldb = ph.ldb;
    int Rr[2], Cc[2]; unsigned voffB[2], vo[2][2], nvo[2][2];
#pragma unroll
    for (int i = 0; i < 2; ++i) { stage_rc(tid * 16 + i * 8192, Rr[i], Cc[i]); const int Rb = (Rr[i] & ~31) + perm32(Rr[i] & 31); voffB[i] = (unsigned)Rb * ldb + (unsigned)Cc[i] * 2u; }
    const size_t kstep = (size_t)(BK * 2);
    const size_t hstepB = (size_t)HALF * ldb;
    const unsigned ldsw = (unsigned)wid * 1024u;
    const int aoff = lds_byte(wr * 64 + fr, fq * 8), boff = lds_byte(wc * 32 + fr, fq * 8);
#define PG_SA(b, h) (((b) * 2 + (h)) * HTB)
#define PG_SB(b, h) ((4 + (b) * 2 + (h)) * HTB)
#define PG_STAGE_B(bufoff, gbase) do { _Pragma("unroll") for (int _i = 0; _i < 2; ++_i) \
        __builtin_amdgcn_global_load_lds((const unsigned*)((const char*)(gbase) + voffB[_i]), (LAS unsigned*)(lds + (bufoff) + ldsw + _i * 8192), 16, 0, 0); } while (0)
#define PG_STAGE_A(bufoff, gbase, VO, h) do { _Pragma("unroll") for (int _i = 0; _i < 2; ++_i) \
        __builtin_amdgcn_global_load_lds((const unsigned*)((const char*)(gbase) + (VO)[h][_i]), (LAS unsigned*)(lds + (bufoff) + ldsw + _i * 8192), 16, 0, 0); } while (0)
#define PG_LDA(dst, b, h) do { _Pragma("unroll") for (int m = 0; m < 4; ++m) _Pragma("unroll") for (int k = 0; k < 2; ++k) dst[m][k] = *(const LAS bf16x8*)(lds + PG_SA(b, h) + aoff + m * 2048 + k * 1024); } while (0)
#define PG_LDB(dst, b, h) do { _Pragma("unroll") for (int n = 0; n < 2; ++n) _Pragma("unroll") for (int k = 0; k < 2; ++k) dst[n][k] = *(const LAS bf16x8*)(lds + PG_SB(b, h) + boff + n * 2048 + k * 1024); } while (0)
#define PG_MMA(ai, bj, At, Bt) do { __builtin_amdgcn_s_setprio(1); _Pragma("unroll") for (int m = 0; m < 4; ++m) _Pragma("unroll") for (int n = 0; n < 2; ++n) _Pragma("unroll") for (int k = 0; k < 2; ++k) \
        acc[ai][bj][m][n] = __builtin_amdgcn_mfma_f32_16x16x32_bf16(Bt[n][k], At[m][k], acc[ai][bj][m][n], 0, 0, 0); __builtin_amdgcn_s_setprio(0); } while (0)
#define PG_WAIT_V(n) asm volatile("s_waitcnt vmcnt(" #n ")" ::: "memory")
#define PG_WAIT_L(n) asm volatile("s_waitcnt lgkmcnt(" #n ")" ::: "memory")
#define PG_BAR __builtin_amdgcn_s_barrier()
#define PG_SCHED __builtin_amdgcn_sched_barrier(0)
    Unit cur, nxt; int ui = 0;
    if (!ph.next(0, cur)) return;
    ph.offs(cur, Rr, Cc, vo);
    f32x4 acc[2][2][4][2];
#pragma unroll
    for (int a = 0; a < 2; ++a)
#pragma unroll
        for (int b = 0; b < 2; ++b)
#pragma unroll
            for (int m = 0; m < 4; ++m)
#pragma unroll
                for (int n = 0; n < 2; ++n) acc[a][b][m][n] = (f32x4){0.f, 0.f, 0.f, 0.f};
    bf16x8 At[4][2], B0[2][2], B1[2][2];
    const char* cA = cur.A; const char* cB = cur.B;
    PG_STAGE_B(PG_SB(0, 0), cB); PG_STAGE_B(PG_SB(0, 1), cB + hstepB); PG_STAGE_A(PG_SA(0, 0), cA, vo, 0); PG_STAGE_A(PG_SA(0, 1), cA, vo, 1);
    if (wr == 1) PG_BAR;
    PG_WAIT_V(2); PG_BAR;
    PG_STAGE_B(PG_SB(1, 0), cB + kstep); PG_STAGE_A(PG_SA(1, 0), cA + kstep, vo, 0); PG_STAGE_B(PG_SB(1, 1), cB + hstepB + kstep);
    PG_WAIT_V(6); PG_BAR;
    for (;;) {
        const bool has_next = ph.next(ui + 1, nxt);
        const int nt = cur.nt;
        const char* nA = has_next ? nxt.A : cA; const char* nB = has_next ? nxt.B : cB;
        if (P::GATHER) { if (has_next) ph.offs(nxt, Rr, Cc, nvo); else {
#pragma unroll
            for (int h = 0; h < 2; ++h)
#pragma unroll
                for (int i = 0; i < 2; ++i) nvo[h][i] = vo[h][i]; } }
#pragma unroll 1
        for (int t = 0; t < nt; t += 2) {
            const bool last = (t == nt - 2);
            const char* a1 = cA + (size_t)(t + 1) * kstep;
            const char* a2 = last ? nA : cA + (size_t)(t + 2) * kstep; const char* b2 = last ? nB : cB + (size_t)(t + 2) * kstep;
            const char* a3 = a2 + kstep; const char* b3 = b2 + kstep;
            unsigned v2[2][2];
#pragma unroll
            for (int h = 0; h < 2; ++h)
#pragma unroll
                for (int i = 0; i < 2; ++i) v2[h][i] = (P::GATHER && last) ? nvo[h][i] : vo[h][i];
            PG_LDB(B0, 0, 0); PG_LDB(B1, 0, 1); PG_SCHED; PG_LDA(At, 0, 0); PG_STAGE_A(PG_SA(1, 1), a1, vo, 1);
            PG_WAIT_V(8); PG_WAIT_L(0); PG_BAR; PG_MMA(0, 0, At, B0); PG_MMA(0, 1, At, B1); PG_BAR; PG_SCHED;
            PG_LDA(At, 0, 1); PG_STAGE_B(PG_SB(0, 0), b2); PG_STAGE_B(PG_SB(0, 1), b2 + hstepB); PG_STAGE_A(PG_SA(0, 0), a2, v2, 0);
            PG_WAIT_V(8); PG_WAIT_L(0); PG_BAR; PG_MMA(1, 0, At, B0); PG_MMA(1, 1, At, B1); PG_BAR; PG_SCHED;
            PG_LDB(B0, 1, 0); PG_LDB(B1, 1, 1); PG_SCHED; PG_LDA(At, 1, 0); PG_STAGE_A(PG_SA(0, 1), a2, v2, 1);
            PG_WAIT_V(8); PG_WAIT_L(0); PG_BAR; PG_MMA(0, 0, At, B0); PG_MMA(0, 1, At, B1); PG_BAR; PG_SCHED;
            PG_LDA(At, 1, 1); PG_STAGE_B(PG_SB(1, 0), b3); PG_STAGE_B(PG_SB(1, 1), b3 + hstepB); PG_STAGE_A(PG_SA(1, 0), a3, v2, 0);
            PG_WAIT_V(8); PG_WAIT_L(0); PG_BAR; PG_MMA(1, 0, At, B0); PG_MMA(1, 1, At, B1); PG_BAR; PG_SCHED;
        }
        if (wr == 0) PG_BAR;
        ph.epi(acc, cur, wr, wc, fr, fq);
        if (!has_next) break;
#pragma unroll
        for (int a = 0; a < 2; ++a)
#pragma unroll
            for (int b = 0; b < 2; ++b)
#pragma unroll
                for (int m = 0; m < 4; ++m)
#pragma unroll
                    for (int n = 0; n < 2; ++n) acc[a][b][m][n] = (f32x4){0.f, 0.f, 0.f, 0.f};
        cur = nxt; cA = nA; cB = nB; ++ui;
        if (P::GATHER) {
#pragma unroll
            for (int h = 0; h < 2; ++h)
#pragma unroll
                for (int i = 0; i < 2; ++i) vo[h][i] = nvo[h][i]; }
        if (wr == 1) PG_BAR;
    }
    PG_WAIT_V(0);
    PG_BAR;
#undef PG_SA
#undef PG_SB
#undef PG_STAGE_A
#undef PG_STAGE_B
#undef PG_LDA
#undef PG_LDB
#undef PG_MMA
#undef PG_WAIT_V
#undef PG_WAIT_L
#undef PG_BAR
#undef PG_SCHED
}
__device__ __forceinline__ void offs_plain(unsigned lda, const int (&R)[2], const int (&C)[2], unsigned (&vo)[2][2]) {
#pragma unroll
    for (int h = 0; h < 2; ++h)
#pragma unroll
        for (int i = 0; i < 2; ++i) vo[h][i] = (unsigned)(h * HALF + R[i]) * lda + (unsigned)C[i] * 2u;
}
}

namespace attn_body {
using bf16=unsigned short;
using bf16x8=__attribute__((ext_vector_type(8)))short;
using s16x4=__attribute__((ext_vector_type(4)))short;
using f32x16=__attribute__((ext_vector_type(16)))float;
using u32x4=__attribute__((ext_vector_type(4)))unsigned;
constexpr int BATCH=2,NHEAD=8,SEQ=8192,D=64,DM=NHEAD*D;
constexpr int NW=8,QBLK=32,QB=QBLK*NW,KVBLK=64,NQB=SEQ/QB;
constexpr int ATTN_PITCH=DM, ATTN_UNIT_ROWS=QB;
__device__ __forceinline__ int crow(int r,int hi){return (r&3)+8*(r>>2)+4*hi;}
__device__ __forceinline__ unsigned short f2bf_a(float f){unsigned u=__builtin_bit_cast(unsigned,f);return (unsigned short)((u+0x7fffu+((u>>16)&1u))>>16);}
#define SBAR() __builtin_amdgcn_sched_barrier(0)
__device__ __forceinline__ void cmask(f32x16&p0,f32x16&p1,int jb,int qrel,int hi){
  const float NEG=-INFINITY; int kb=64*jb+4*hi;
  #pragma unroll
  for(int r=0;r<16;++r){int kv=kb+(r&3)+8*(r>>2); if(kv>qrel)p0[r]=NEG; if(kv+32>qrel)p1[r]=NEG;}
}

constexpr int NSLOT=3, SLOTB=8192;
constexpr int LDS_K=0, LDS_V=NSLOT*SLOTB, LDS_WS=2*NSLOT*SLOTB, LDS_OST=LDS_WS+NW*64*4, LDS_FK=LDS_OST+NW*4096, LDS_BYTES=LDS_FK+SEQ*4+1024;
constexpr float C2=0.125f*1.4426950408889634f;
__device__ __forceinline__ void glds16(const void*gsrc,unsigned lds_dst){unsigned keep;
  asm volatile("s_mov_b32 %0, m0\n\ts_mov_b32 m0, %2\n\ts_nop 0\n\tglobal_load_lds_dwordx4 %1, off\n\ts_mov_b32 m0, %0":"=&s"(keep):"v"(gsrc),"s"(lds_dst):"memory");}
__device__ __forceinline__ float max3f(float a,float b,float c){float r;asm("v_max3_f32 %0, %1, %2, %3":"=v"(r):"v"(a),"v"(b),"v"(c));return r;}
__device__ __forceinline__ float max2f(float a,float b){float r;asm("v_max_f32_e32 %0, %1, %2":"=v"(r):"v"(a),"v"(b));return r;}
__device__ __forceinline__ float fadd_s(float a,float b){float r;asm("v_add_f32_e32 %0, %1, %2":"=v"(r):"v"(a),"v"(b));return r;}
__device__ __forceinline__ float fsub_s(float a,float b){float r;asm("v_sub_f32_e32 %0, %1, %2":"=v"(r):"v"(a),"v"(b));return r;}
typedef float f32x4_t __attribute__((ext_vector_type(4)));
typedef float f32x2_t __attribute__((ext_vector_type(2))); typedef __bf16 bf16x2_t __attribute__((ext_vector_type(2)));
__device__ __forceinline__ unsigned cvtpk_s(float lo,float hi){f32x2_t v={lo,hi};bf16x2_t b=__builtin_convertvector(v,bf16x2_t);return __builtin_bit_cast(unsigned,b);}
#define WAIT_BAR(N) asm volatile("s_waitcnt vmcnt(" #N ") lgkmcnt(0)\n\ts_barrier":::"memory")

__device__ __forceinline__ void qkt(f32x16&p0,f32x16&p1,const char*Kslot,const bf16x8*qr,int r32,int hi){
  const char*kb=Kslot+hi*1024+r32*16;
  #pragma unroll
  for(int d0=0;d0<4;++d0){
    const bf16x8 b0=*reinterpret_cast<const bf16x8*>(kb+d0*2048);
    const bf16x8 b1=*reinterpret_cast<const bf16x8*>(kb+d0*2048+512);
    p0=__builtin_amdgcn_mfma_f32_32x32x16_bf16(b0,qr[d0],p0,0,0,0);p1=__builtin_amdgcn_mfma_f32_32x32x16_bf16(b1,qr[d0],p1,0,0,0);}
}
typedef __attribute__((address_space(3))) const char* lds_cptr;
typedef short v4i16_t __attribute__((ext_vector_type(4)));
__device__ __forceinline__ void kload8(bf16x8*kf,lds_cptr kp){
  kf[0]=*(const __attribute__((address_space(3))) bf16x8*)(kp);      kf[1]=*(const __attribute__((address_space(3))) bf16x8*)(kp+512);
  kf[2]=*(const __attribute__((address_space(3))) bf16x8*)(kp+2048); kf[3]=*(const __attribute__((address_space(3))) bf16x8*)(kp+2560);
  kf[4]=*(const __attribute__((address_space(3))) bf16x8*)(kp+4096); kf[5]=*(const __attribute__((address_space(3))) bf16x8*)(kp+4608);
  kf[6]=*(const __attribute__((address_space(3))) bf16x8*)(kp+6144); kf[7]=*(const __attribute__((address_space(3))) bf16x8*)(kp+6656);
}
__device__ __forceinline__ void kload2(bf16x8*kf,lds_cptr kp,int j){ kf[2*j]=*(const __attribute__((address_space(3))) bf16x8*)(kp+j*2048); kf[2*j+1]=*(const __attribute__((address_space(3))) bf16x8*)(kp+j*2048+512); }
__device__ __forceinline__ s16x4 vtr(lds_cptr p){ return __builtin_bit_cast(s16x4,__builtin_amdgcn_ds_read_tr16_b64_v4i16((__attribute__((address_space(3))) v4i16_t*)p)); }
__device__ __forceinline__ float rowmax(const f32x16&p0,const f32x16&p1){
  float a=max3f(p0[0],p0[1],p1[0]),b=max3f(p0[2],p0[3],p1[1]);a=max3f(a,p1[2],p1[3]);
  #pragma unroll
  for(int r=4;r<16;r+=4){a=max3f(a,p0[r],p0[r+1]);b=max3f(b,p0[r+2],p0[r+3]);a=max3f(a,p1[r],p1[r+1]);b=max3f(b,p1[r+2],p1[r+3]);}
  const float m=max2f(a,b);
  auto rr=__builtin_amdgcn_permlane32_swap(__float_as_uint(m),__float_as_uint(m),false,false);
  return max2f(__uint_as_float(rr[0]),__uint_as_float(rr[1]));
}
__device__ __forceinline__ void pv(f32x16*o,int vb,bf16x8 pa0,bf16x8 pa1,bf16x8 pa2,bf16x8 pa3){
  #pragma unroll
  for(int d0=0;d0<2;++d0){s16x4 lo[4],hi[4];
    #pragma unroll
    for(int ks=0;ks<4;++ks){
      asm volatile("ds_read_b64_tr_b16 %0,%1 offset:%c2":"=&v"(lo[ks]):"v"(vb),"i"(d0*4096+ks*1024):"memory");
      asm volatile("ds_read_b64_tr_b16 %0,%1 offset:%c2":"=&v"(hi[ks]):"v"(vb),"i"(d0*4096+ks*1024+512):"memory");}
    asm volatile("s_waitcnt lgkmcnt(0)":::"memory");SBAR();
    #define PK(k) (bf16x8){lo[k][0],lo[k][1],lo[k][2],lo[k][3],hi[k][0],hi[k][1],hi[k][2],hi[k][3]}
    o[d0]=__builtin_amdgcn_mfma_f32_32x32x16_bf16(pa0,PK(0),o[d0],0,0,0);
    o[d0]=__builtin_amdgcn_mfma_f32_32x32x16_bf16(pa1,PK(1),o[d0],0,0,0);
    o[d0]=__builtin_amdgcn_mfma_f32_32x32x16_bf16(pa2,PK(2),o[d0],0,0,0);
    o[d0]=__builtin_amdgcn_mfma_f32_32x32x16_bf16(pa3,PK(3),o[d0],0,0,0);
    #undef PK
  }
}

#ifndef ATTN_STORE16
#define ATTN_STORE16(p,v) (*(u32x4*)(p)=(v))
#endif
template<int THRL> __device__ __forceinline__ void attn_unit(int b,int h,int qb,int TB,int TE,int NTM,const bf16*Q,const bf16*__restrict__ K,const bf16*__restrict__ V,bf16*O,const float*__restrict__ CUM,bf16*PObase,float*PSbase,int slot,char*shm){
  const int tid=threadIdx.x,lane=tid&63,r32=lane&31,hi=lane>>5; const int wid=__builtin_amdgcn_readfirstlane(tid>>6);
  const long rowbase=(long)b*SEQ; const int q0=qb*QB;
  const bf16*Qw=Q+(rowbase+q0+wid*QBLK)*DM+h*D;
  const bf16*Kh=K+rowbase*DM+h*D,*Vh=V+rowbase*DM+h*D; const float*Fh=CUM+((long)b*NHEAD+h)*SEQ;
  const unsigned lds0=(unsigned)(uintptr_t)shm;
  float*wsf=(float*)(shm+LDS_WS)+wid*64;
  const unsigned koff=(unsigned)(lane*DM+wid*8)*2u;
  const unsigned voff=(unsigned)((16*(wid&3)+(lane>>2))*DM+(wid>>2)*32+(lane&3)*8)*2u;
  const unsigned kdst=lds0+LDS_K+wid*1024, vdst=lds0+LDS_V+wid*1024;
  #define DMA_K(t,slot) glds16((const char*)Kh+(long)(t)*(KVBLK*DM*2)+koff,(unsigned)__builtin_amdgcn_readfirstlane(kdst+(slot)))
  #define DMA_V(t,slot) glds16((const char*)Vh+(long)(t)*(KVBLK*DM*2)+voff,(unsigned)__builtin_amdgcn_readfirstlane(vdst+(slot)))
  const int vb0=(int)(lds0+LDS_V)+((lane>>4)&1)*32+(lane&3)*8+(4*hi+((lane&15)>>2))*64;
  const char*Kbase=shm+LDS_K; bf16x8 kf[8];
  const lds_cptr shm3=(lds_cptr)shm; const lds_cptr kp0=shm3+LDS_K+hi*1024+r32*16; const lds_cptr vp0=shm3+LDS_V+((lane>>4)&1)*32+(lane&3)*8+(4*hi+((lane&15)>>2))*64;
  const int NT=TE;
  for(int p_=wid+(TB>>2);p_<=((TE*KVBLK-1)>>8);p_+=NW) glds16(Fh+p_*256+lane*4,(unsigned)__builtin_amdgcn_readfirstlane(lds0+LDS_FK+p_*1024));
  DMA_K(TB,0);DMA_V(TB,0);DMA_K(TB+1,SLOTB);
  bf16x8 qr[4];
  #pragma unroll
  for(int d0=0;d0<4;++d0)qr[d0]=*reinterpret_cast<const bf16x8*>(&Qw[(long)r32*DM+d0*16+hi*8]);
  const float fq2=Fh[q0+wid*QBLK+r32];
  float mhat=0.f,l_reg=0.f;f32x16 o[2];o[0]=f32x16{};o[1]=f32x16{};float nb=fq2;
  const lds_cptr fkp=(lds_cptr)shm+LDS_FK+hi*16;
  const int qrel=wid*QBLK+r32;
  #define CMASK(P0,P1,t) do{int jb_=(t)-(NTM-4); if(jb_>=0)cmask(P0,P1,jb_,qrel,hi);}while(0)
  bool resc=false;
  #define START(P0,P1) do{ const float rm=rowmax(P0,P1); resc=false; \
    { const float dl=rm; mhat=fadd_s(mhat,dl); \
      _Pragma("unroll") for(int r=0;r<16;++r){P0[r]=fsub_s(P0[r],dl);P1[r]=fsub_s(P1[r],dl);} \
      nb=fsub_s(fq2,mhat); } \
    _Pragma("unroll") for(int r=0;r<16;++r)P0[r]=__builtin_amdgcn_exp2f(P0[r]); }while(0)
  #define RESC() do{ if(resc){ asm volatile("s_waitcnt lgkmcnt(0)":::"memory"); \
      _Pragma("unroll") for(int d_=0;d_<2;++d_) _Pragma("unroll") for(int r=0;r<16;++r)o[d_][r]*=wsf[crow(r,hi)]; } }while(0)
  #define FILLC(C0_,C1_,tt) do{ const lds_cptr f_=fkp+(tt)*256; _Pragma("unroll") for(int a_=0;a_<4;++a_){ const f32x4_t x0_=*(const __attribute__((address_space(3))) f32x4_t*)(f_+32*a_); const f32x4_t x1_=*(const __attribute__((address_space(3))) f32x4_t*)(f_+128+32*a_); \
      _Pragma("unroll") for(int i_=0;i_<4;++i_){ C0_[4*a_+i_]=nb-x0_[i_]; C1_[4*a_+i_]=nb-x1_[i_]; } } }while(0)
  f32x16 pA0,pA1,pB0,pB1;
  int sl_prev=0,sl_cur=0,sl_next=SLOTB;
  #define ROT() do{sl_prev=sl_cur;sl_cur=sl_next;sl_next=(sl_next==(NSLOT-1)*SLOTB)?0:sl_next+SLOTB;}while(0)
  DMA_K(TB+2,2*SLOTB);
  WAIT_BAR(3);
  FILLC(pA0,pA1,TB);
  qkt(pA0,pA1,Kbase,qr,r32,hi);asm volatile("s_nop 15\n\ts_nop 7":"+v"(pA0),"+v"(pA1));CMASK(pA0,pA1,TB);
  START(pA0,pA1);
  _Pragma("unroll") for(int r=0;r<16;++r)pA1[r]=__builtin_amdgcn_exp2f(pA1[r]);
  WAIT_BAR(0);
  DMA_K(TB+3,0);DMA_V(TB+1,SLOTB);
  ROT();
  FILLC(pB0,pB1,TB+1);
  kload8(kf,kp0+sl_cur);
  WAIT_BAR(2);
  s16x4 vlo[8],vhi[8]; u32x4 pw0,pw1,pw2,pw3;
  #define PKW(P,B) cvtpk_s(P[B],P[B+1])
  #define PAF(k) __builtin_bit_cast(bf16x8,pw##k)
  #define VFR(i) (bf16x8){vlo[i][0],vlo[i][1],vlo[i][2],vlo[i][3],vhi[i][0],vhi[i][1],vhi[i][2],vhi[i][3]}
  #define PIN(x) asm volatile("":"+v"(x))
  #define MX3(a,b,c) __builtin_fmaxf(__builtin_fmaxf((a),(b)),(c))
  #define GAPA(MF,A0,A1,A2,A3,W0,W1,PW) do{ MF; sacc+=A0; sacc+=A1; sacc+=A2; sacc+=A3; PIN(sacc); W0; W1; PIN(PW); SBAR(); }while(0)
  #define EX(v) __builtin_amdgcn_exp2f(v)
  #define FLD(off) (*(const __attribute__((address_space(3))) f32x4_t*)(fk_+(off)))
  #define GAPB(MF,X,B,PF,FC,FN,NOFF) do{ MF; X[B]=EX(X[B]); X[B+1]=EX(X[B+1]); X[B+2]=EX(X[B+2]); X[B+3]=EX(X[B+3]); PF[B]=nb-FC[0]; PF[B+1]=nb-FC[1]; PF[B+2]=nb-FC[2]; PF[B+3]=nb-FC[3]; FN=FLD(NOFF); PIN(X); PIN(PF); SBAR(); }while(0)
  #define VRD(i) do{ vlo[i]=vtr(vp_+(((i)>>2)*4096+((i)&3)*1024)); vhi[i]=vtr(vp_+(((i)>>2)*4096+((i)&3)*1024+512)); }while(0)
  #define KRD(G,j) do{ if(G){ kload2(kf,kp0+sl_next,j); SBAR(); } }while(0)
  #define STEP(C0,C1,P0,P1,t,GK,GV,GL) do{ SBAR(); \
    const lds_cptr vp_=vp0+sl_prev; \
    VRD(0); SBAR(); float sacc=(P0[0]+P0[1]); \
    GAPA(C0=__builtin_amdgcn_mfma_f32_32x32x16_bf16(kf[0],qr[0],C0,0,0,0), P0[2],P0[3],P0[4],P0[5],     pw0[0]=PKW(P0,0), pw0[1]=PKW(P0,2), pw0); \
    VRD(4); SBAR(); GAPA(C1=__builtin_amdgcn_mfma_f32_32x32x16_bf16(kf[1],qr[0],C1,0,0,0), P0[6],P0[7],P0[8],P0[9],     pw0[2]=PKW(P0,4), pw0[3]=PKW(P0,6), pw0); \
    VRD(1); SBAR(); GAPA(C0=__builtin_amdgcn_mfma_f32_32x32x16_bf16(kf[2],qr[1],C0,0,0,0),   P0[10],P0[11],P0[12],P0[13], pw1[0]=PKW(P0,8), pw1[1]=PKW(P0,10), pw1); \
    VRD(5); SBAR(); GAPA(C1=__builtin_amdgcn_mfma_f32_32x32x16_bf16(kf[3],qr[1],C1,0,0,0),   P0[14],P0[15],P1[0],P1[1],   pw1[2]=PKW(P0,12),pw1[3]=PKW(P0,14), pw1); \
    VRD(2); SBAR(); GAPA(C0=__builtin_amdgcn_mfma_f32_32x32x16_bf16(kf[4],qr[2],C0,0,0,0),   P1[2],P1[3],P1[4],P1[5],     pw2[0]=PKW(P1,0), pw2[1]=PKW(P1,2), pw2); \
    VRD(6); SBAR(); GAPA(C1=__builtin_amdgcn_mfma_f32_32x32x16_bf16(kf[5],qr[2],C1,0,0,0),   P1[6],P1[7],P1[8],P1[9],     pw2[2]=PKW(P1,4), pw2[3]=PKW(P1,6), pw2); \
    VRD(3); SBAR(); GAPA(C0=__builtin_amdgcn_mfma_f32_32x32x16_bf16(kf[6],qr[3],C0,0,0,0),   P1[10],P1[11],P1[12],P1[13], pw3[0]=PKW(P1,8), pw3[1]=PKW(P1,10), pw3); \
    VRD(7); SBAR(); GAPA(C1=__builtin_amdgcn_mfma_f32_32x32x16_bf16(kf[7],qr[3],C1,0,0,0),   P1[14],P1[15],0.f,0.f,       pw3[2]=PKW(P1,12),pw3[3]=PKW(P1,14), pw3); \
    l_reg+=sacc; \
    if(GK){DMA_K((t)+3,sl_cur);} if(GV){DMA_V((t)+1,sl_next);} \
    CMASK(C0,C1,t); \
    { float a=MX3(C0[0],C0[1],C1[0]),b=MX3(C0[2],C0[3],C1[1]); a=MX3(a,C1[2],C1[3]); \
      _Pragma("unroll") for(int r=4;r<16;r+=4){a=MX3(a,C0[r],C0[r+1]);b=MX3(b,C0[r+2],C0[r+3]);a=MX3(a,C1[r],C1[r+1]);b=MX3(b,C1[r+2],C1[r+3]);} \
      float rm=__builtin_fmaxf(a,b); { auto rr=__builtin_amdgcn_permlane32_swap(__float_as_uint(rm),__float_as_uint(rm),false,false); rm=__builtin_fmaxf(__uint_as_float(rr[0]),__uint_as_float(rr[1])); } \
      resc=false; \
      if(__builtin_expect(__any(rm>(float)THRL),0)){ const float dl=__builtin_fmaxf(rm,0.f); mhat+=dl; \
        _Pragma("unroll") for(int r=0;r<16;++r){C0[r]-=dl;C1[r]-=dl;} \
        nb=fq2-mhat; \
        const float f=__builtin_amdgcn_exp2f(-dl); l_reg*=f; if(hi==0)wsf[r32]=f; resc=true; } } \
    SBAR(); \
    const lds_cptr fk_=fkp+((t)+1)*256; f32x4_t fa_=FLD(0); SBAR(); \
    GAPB(o[0]=__builtin_amdgcn_mfma_f32_32x32x16_bf16(PAF(0),VFR(0),o[0],0,0,0), C0,0, P0,fa_,fa_,32); \
    GAPB(o[1]=__builtin_amdgcn_mfma_f32_32x32x16_bf16(PAF(0),VFR(4),o[1],0,0,0), C0,4, P0,fa_,fa_,64); \
    KRD(GL,0); GAPB(o[0]=__builtin_amdgcn_mfma_f32_32x32x16_bf16(PAF(1),VFR(1),o[0],0,0,0), C0,8, P0,fa_,fa_,96); \
    KRD(GL,1); GAPB(o[1]=__builtin_amdgcn_mfma_f32_32x32x16_bf16(PAF(1),VFR(5),o[1],0,0,0), C0,12, P0,fa_,fa_,128); \
    KRD(GL,2); GAPB(o[0]=__builtin_amdgcn_mfma_f32_32x32x16_bf16(PAF(2),VFR(2),o[0],0,0,0), C1,0, P1,fa_,fa_,160); \
    KRD(GL,3); GAPB(o[1]=__builtin_amdgcn_mfma_f32_32x32x16_bf16(PAF(2),VFR(6),o[1],0,0,0), C1,4, P1,fa_,fa_,192); \
    GAPB(o[0]=__builtin_amdgcn_mfma_f32_32x32x16_bf16(PAF(3),VFR(3),o[0],0,0,0), C1,8, P1,fa_,fa_,224); \
    GAPB(o[1]=__builtin_amdgcn_mfma_f32_32x32x16_bf16(PAF(3),VFR(7),o[1],0,0,0), C1,12, P1,fa_,fa_,224); \
    }while(0)
  int t=TB+1;
  #undef CMASK
  #define CMASK(P0,P1,t) do{}while(0)
  for(;t+5<NT;t+=2){
    STEP(pB0,pB1,pA0,pA1,t,true,true,true);     WAIT_BAR(2); RESC(); ROT();
    STEP(pA0,pA1,pB0,pB1,t+1,true,true,true);   WAIT_BAR(2); RESC(); ROT();
  }
  #undef CMASK
  #define CMASK(P0,P1,t) do{int jb_=(t)-(NTM-4); if(jb_>=0)cmask(P0,P1,jb_,qrel,hi);}while(0)
  #define ENDW(tt) do{ if((tt)+3<NT){WAIT_BAR(2);} else if((tt)+2<NT){WAIT_BAR(1);} else {WAIT_BAR(0);} }while(0)
  for(;t+1<NT;t+=2){
    STEP(pB0,pB1,pA0,pA1,t,(t+3<NT),(t+1<NT),(t+1<NT));       ENDW(t);   RESC(); ROT();
    STEP(pA0,pA1,pB0,pB1,t+1,(t+4<NT),(t+2<NT),(t+2<NT));     ENDW(t+1); RESC(); ROT();
  }
  STEP(pB0,pB1,pA0,pA1,NT-1,false,false,false); RESC();
  { float sacc=pB0[0]+pB0[1]; _Pragma("unroll") for(int r=2;r<16;++r)sacc+=pB0[r]; _Pragma("unroll") for(int r=0;r<16;++r)sacc+=pB1[r]; l_reg+=sacc;
    pw0=(u32x4){PKW(pB0,0),PKW(pB0,2),PKW(pB0,4),PKW(pB0,6)};pw1=(u32x4){PKW(pB0,8),PKW(pB0,10),PKW(pB0,12),PKW(pB0,14)};pw2=(u32x4){PKW(pB1,0),PKW(pB1,2),PKW(pB1,4),PKW(pB1,6)};pw3=(u32x4){PKW(pB1,8),PKW(pB1,10),PKW(pB1,12),PKW(pB1,14)};
    SBAR(); pv(o,vb0+sl_cur,PAF(0),PAF(1),PAF(2),PAF(3)); }
  #undef PKW
  #undef PAF
  #undef VFR
  #undef PIN
  #undef MX3
  #undef GAPA
  #undef GAPB
  #undef FLD
  #undef FILLC
  #undef EX
  #undef VRD
  #undef KRD
  #undef STEP
  #undef ENDW
  {auto rr=__builtin_amdgcn_permlane32_swap(__float_as_uint(l_reg),__float_as_uint(l_reg),false,false);l_reg=__uint_as_float(rr[0])+__uint_as_float(rr[1]);}
  const bool part=(slot!=1023); bf16*PO=PObase+(long)slot*(256*D); float*PS=PSbase+(long)slot*512;
  if(hi==0){wsf[32+r32]=part?1.f:l_reg; if(part){PS[(wid*QBLK+r32)*2]=mhat;PS[(wid*QBLK+r32)*2+1]=l_reg;}}asm volatile("s_waitcnt lgkmcnt(0)":::"memory");
  float rli[16];
  #pragma unroll
  for(int r=0;r<16;++r)rli[r]=__builtin_amdgcn_rcpf(wsf[32+crow(r,hi)]);
  bf16*Ow=part?PO+(long)(wid*QBLK)*D:O+(rowbase+q0+wid*QBLK)*DM+h*D; const long opitch=part?D:DM;
  { bf16*stg=(bf16*)(shm+LDS_OST)+wid*2048;
    #pragma unroll
    for(int r=0;r<16;++r){const int orow=crow(r,hi);
      #pragma unroll
      for(int d0=0;d0<2;++d0)stg[orow*64+d0*32+r32]=f2bf_a(o[d0][r]*rli[r]);}
    asm volatile("s_waitcnt lgkmcnt(0)":::"memory");
    #pragma unroll
    for(int i=0;i<4;++i){const int row=i*8+(lane>>3),ch=lane&7; const u32x4 v=*(const u32x4*)(stg+row*64+ch*8); ATTN_STORE16(Ow+(long)row*opitch+ch*8,v);} }
  asm volatile("s_waitcnt lgkmcnt(0)\n\ts_barrier":::"memory");
  #undef DMA_K
  #undef DMA_V
  #undef CMASK
  #undef START
  #undef RESC
  #undef ROT
}
constexpr int ATTN_LDS_BYTES=LDS_BYTES;
struct AttnTensors { const bf16* Q; const bf16* K; const bf16* V; bf16* O; const float* CUM; const int* T0; bf16* PO; float* PS; unsigned* qctr; };
constexpr int MAX_ITEMS=1408, PO_SLOTS=640;
__device__ __forceinline__ void unit_split(int Lt,int SEG,int&nseg,int&len){ nseg=(Lt+SEG-1)/SEG; len=2*(((Lt>>1)+nseg-1)/nseg); }
template<bool COMBINE> __device__ __forceinline__ int build_worklist(const int*T0,unsigned*wl,unsigned*tmp,int*sc){
  const int tid=threadIdx.x; const int qb=tid&31; const int t0=T0[tid]; const int Lt=4*qb+4-t0;
  __syncthreads();
  int SEG=40,nseg,len;
  for(int pass=0;pass<2;++pass){
    unit_split(Lt,SEG,nseg,len);
    sc[tid]=nseg; sc[512+tid]=nseg>1?nseg:0; sc[1024+tid]=nseg>1?1:0; __syncthreads();
    for(int o=1;o<512;o<<=1){ const int a=tid>=o?sc[tid-o]:0, c=tid>=o?sc[512+tid-o]:0, e=tid>=o?sc[1024+tid-o]:0; __syncthreads(); sc[tid]+=a; sc[512+tid]+=c; sc[1024+tid]+=e; __syncthreads(); }
    if(sc[1023]<=PO_SLOTS&&sc[511]<=MAX_ITEMS)break;
    __syncthreads(); SEG=64;
  }
  const int ioff=sc[tid]-nseg, poff=sc[512+tid]-(nseg>1?nseg:0), NI=sc[511], NS=sc[1535], sord=sc[1024+tid]-1;
  __syncthreads();
  if(COMBINE){ if(nseg>1)wl[sord]=(unsigned)tid|((unsigned)nseg<<9)|((unsigned)poff<<12); __syncthreads(); return NS; }
  for(int sgi=0;sgi<nseg;++sgi){ const int lb=t0+sgi*len, le=min(lb+len,4*qb+4); tmp[ioff+sgi]=(unsigned)tid|((unsigned)lb<<9)|((unsigned)((le-lb)>>1)<<16)|((unsigned)(nseg>1?poff+sgi:1023)<<22); }
  __syncthreads();
  { const int lane=tid&63,w=tid>>6,nch=(NI+63)>>6; int*hist=sc;
    for(int c=w;c<nch;c+=8){ const int i=c*64+lane; const int key=i<NI?(int)((tmp[i]>>16)&63u):0;
      for(int k=1;k<=32;++k){ const unsigned long long mk=__ballot(key==k); if(lane==0)hist[c*33+k]=__popcll(mk); } }
    __syncthreads();
    if(tid>=1&&tid<=32){ int run=0; for(int c=0;c<nch;++c){ const int v=hist[c*33+tid]; hist[c*33+tid]=run; run+=v; } sc[840+tid]=run; }
    __syncthreads();
    if(tid==0){ int run=0; for(int k=32;k>=1;--k){ sc[800+k]=run; run+=sc[840+k]; } }
    __syncthreads();
    for(int c=w;c<nch;c+=8){ const int i=c*64+lane; const int key=i<NI?(int)((tmp[i]>>16)&63u):0; int myr=0;
      for(int k=1;k<=32;++k){ const unsigned long long mk=__ballot(key==k); if(key==k)myr=__popcll(mk&((1ull<<lane)-1ull)); }
      if(i<NI)wl[sc[800+key]+hist[c*33+key]+myr]=tmp[i]; }
  }
  __syncthreads();
  return NI;
}
template<int THRL=8> __device__ __forceinline__ void attn_phase(char*lds,const AttnTensors&T,int vcu,int G){
  unsigned*wl=(unsigned*)(lds+LDS_BYTES); unsigned*tmp=wl+MAX_ITEMS; int*sc=(int*)lds;
  const int NI=build_worklist<false>(T.T0,wl,tmp,sc);
  volatile int*nxt=(volatile int*)(tmp);
  int idx=vcu;
  while(idx<NI){
    const unsigned it=wl[idx]; const int u=it&511,TB=(it>>9)&127,lenp=(it>>16)&63,slot=(it>>22)&1023;
    const int bh=u>>5,qb=u&31;
    attn_unit<THRL>(bh/NHEAD,bh%NHEAD,qb,TB,TB+2*lenp,4*qb+4,T.Q,T.K,T.V,T.O,T.CUM,T.PO,T.PS,slot,lds);
    if(threadIdx.x==0)*nxt=G+(int)__hip_atomic_fetch_add(T.qctr,1u,__ATOMIC_RELAXED,__HIP_MEMORY_SCOPE_AGENT);
    __syncthreads(); idx=*nxt; __syncthreads();
  }
}
__device__ __forceinline__ void attn_combine(char*lds,const AttnTensors&T,int wg,int nwg){
  unsigned*wl=(unsigned*)(lds+LDS_BYTES); unsigned*tmp=wl+MAX_ITEMS; int*sc=(int*)lds;
  const int NS=build_worklist<true>(T.T0,wl,tmp,sc);
  const int tid=threadIdx.x,row=tid>>1,ch=tid&1;
  for(int k=wg;k<NS;k+=nwg){ const unsigned it=wl[k]; const int u=it&511,nseg=(it>>9)&7,poff=(it>>12)&1023,bh=u>>5,qb=u&31,b=bh/NHEAD,h=bh%NHEAD;
    float m[4],l[4]; float M=-3.0e38f; u32x4 pv[4][4];
    #pragma unroll
    for(int sgi=0;sgi<4;++sgi){ m[sgi]=-3.0e38f; l[sgi]=0.f; const int sg=sgi<nseg?sgi:0;
      const float2 ml=*(const float2*)(T.PS+(long)(poff+sg)*512+row*2); if(sgi<nseg){m[sgi]=ml.x;l[sgi]=ml.y;} M=fmaxf(M,m[sgi]);
      const u32x4*p=(const u32x4*)(T.PO+(long)(poff+sg)*(256*D)+row*D+ch*32);
      #pragma unroll
      for(int q=0;q<4;++q)pv[sgi][q]=p[q]; }
    float acc[32]; float L=0.f;
    #pragma unroll
    for(int c=0;c<32;++c)acc[c]=0.f;
    #pragma unroll
    for(int sgi=0;sgi<4;++sgi){ const float w=sgi<nseg?__builtin_amdgcn_exp2f(m[sgi]-M):0.f; L+=w*l[sgi];
      #pragma unroll
      for(int q=0;q<4;++q){ const u32x4 v=pv[sgi][q];
        acc[8*q+0]+=w*__builtin_bit_cast(float,v.x<<16); acc[8*q+1]+=w*__builtin_bit_cast(float,v.x&0xffff0000u); acc[8*q+2]+=w*__builtin_bit_cast(float,v.y<<16); acc[8*q+3]+=w*__builtin_bit_cast(float,v.y&0xffff0000u);
        acc[8*q+4]+=w*__builtin_bit_cast(float,v.z<<16); acc[8*q+5]+=w*__builtin_bit_cast(float,v.z&0xffff0000u); acc[8*q+6]+=w*__builtin_bit_cast(float,v.w<<16); acc[8*q+7]+=w*__builtin_bit_cast(float,v.w&0xffff0000u); } }
    const float rl=1.f/L; bf16*op=T.O+((long)b*SEQ+qb*QB+row)*DM+h*D+ch*32;
    #pragma unroll
    for(int q=0;q<4;++q){ u32x4 w; w.x=cvtpk_s(acc[8*q]*rl,acc[8*q+1]*rl); w.y=cvtpk_s(acc[8*q+2]*rl,acc[8*q+3]*rl); w.z=cvtpk_s(acc[8*q+4]*rl,acc[8*q+5]*rl); w.w=cvtpk_s(acc[8*q+6]*rl,acc[8*q+7]*rl); *(u32x4*)(op+8*q)=w; }
  }
  __syncthreads();
}
#undef SBAR
#undef WAIT_BAR
}

constexpr int NWAVES = 8;
constexpr int RING_OFF = 0, RING_BYTES = 131072;
constexpr int LDSCTL_OFF = RING_BYTES, MISC_OFF = LDSCTL_OFF + 320;
constexpr int LDS_BYTES = 147456;
typedef GAS unsigned gu32;
#define RLX_AGENT __ATOMIC_RELAXED, __HIP_MEMORY_SCOPE_AGENT
#define LDS_WAIT() asm volatile("s_waitcnt lgkmcnt(0)" ::: "memory")
#define VM_WAIT() asm volatile("s_waitcnt vmcnt(0)" ::: "memory")
constexpr int CW_TMO = 0, CW_CODE = 1, CW_CNT = 64  , CW_Q0 = 128  , CW_BAR = 4096;

#define XB_TMO      128
#define XB_XCNT(j)  (256  + 64 * (j))
#define XB_XSUB(j)  (1280 + 64 * (j))
#define XB_XGEN(j)  (2304 + 64 * (j))
#define XB_TOP      3328
#define XB_TOPGEN   3392
#define XCD_BAR_WORDS 3456
#define XB_SPIN_CAP (1u << 18)
__device__ __forceinline__ unsigned xb_ld(unsigned* p)              { return __hip_atomic_load(p, __ATOMIC_RELAXED, __HIP_MEMORY_SCOPE_AGENT); }
__device__ __forceinline__ unsigned xb_add(unsigned* p, unsigned v) { return __hip_atomic_fetch_add(p, v, __ATOMIC_RELAXED, __HIP_MEMORY_SCOPE_AGENT); }
__device__ __forceinline__ unsigned xb_xcc_id() { return (unsigned)__builtin_amdgcn_s_getreg((3 << 11) | 20) & 0xFu; }
#define XB_SPIN(cond, bar) do { unsigned _sp = 0; while (cond) { __builtin_amdgcn_s_sleep(1); \
    if ((++_sp & 255u) == 0u) { if (xb_ld(&(bar)[XB_TMO])) break; if (_sp > XB_SPIN_CAP) { atomicAdd(&(bar)[XB_TMO], 1u); break; } } } } while (0)
struct XcdBarrier { unsigned* bar; unsigned x; volatile LAS unsigned* st; };
__device__ __forceinline__ XcdBarrier xcd_barrier_post(unsigned* bar, volatile LAS unsigned* st) {
    XcdBarrier b; b.bar = bar; b.x = xb_xcc_id(); b.st = st;
    if (threadIdx.x == 0) (void)xb_add(&bar[XB_XCNT(b.x)], 1u);
    return b;
}
__device__ __forceinline__ void xcd_barrier_complete(unsigned* bar, unsigned x, unsigned& nloc, unsigned& nx) {
    const unsigned G = gridDim.x * gridDim.y * gridDim.z;
    unsigned sum, cnt, mine, sp = 0u;
    for (;;) {
        sum = 0u; cnt = 0u; mine = 0u;
#pragma unroll
        for (unsigned j = 0; j < 16; ++j) { const unsigned c = xb_ld(&bar[XB_XCNT(j)]); sum += c; cnt += (c > 0u) ? 1u : 0u; mine = (j == x) ? c : mine; }
        if (sum == G) break;
        __builtin_amdgcn_s_sleep(1);
        if ((++sp & 255u) == 0u) { if (xb_ld(&bar[XB_TMO])) break; if (sp > XB_SPIN_CAP) { atomicAdd(&bar[XB_TMO], 1u); break; } }
    }
    nloc = mine > 0u ? mine : 1u; nx = cnt > 0u ? cnt : 1u;
}
__device__ __forceinline__ void xcd_barrier(const XcdBarrier& b) {
    asm volatile("s_waitcnt vmcnt(0)" ::: "memory");
    __syncthreads();
    if (threadIdx.x == 0) {
        unsigned* bar = b.bar;
        __builtin_amdgcn_s_waitcnt(0);
        unsigned nloc = b.st[0], nx = b.st[1];
        if (nloc == 0u) { xcd_barrier_complete(bar, b.x, nloc, nx); b.st[0] = nloc; b.st[1] = nx; }
        const unsigned old = xb_add(&bar[XB_XSUB(b.x)], 1u);
        const unsigned gen = old / nloc;
        if (old + 1u == (gen + 1u) * nloc) {
            __builtin_amdgcn_fence(__ATOMIC_RELEASE, "agent");
            asm volatile("s_waitcnt vmcnt(0)" ::: "memory");
            const unsigned og = xb_add(&bar[XB_TOP], 1u);
            const unsigned tg = og / nx;
            if (og + 1u == (tg + 1u) * nx) xb_add(&bar[XB_TOPGEN], 1u);
            else XB_SPIN(xb_ld(&bar[XB_TOPGEN]) == tg, bar);
            __builtin_amdgcn_fence(__ATOMIC_ACQUIRE, "agent");
            xb_add(&bar[XB_XGEN(b.x)], 1u);
            asm volatile("s_waitcnt vmcnt(0)" ::: "memory");
        } else {
            XB_SPIN(xb_ld(&bar[XB_XGEN(b.x)]) == gen, bar);
            __builtin_amdgcn_fence(__ATOMIC_ACQUIRE, "agent");
            asm volatile("s_waitcnt vmcnt(0)" ::: "memory");
        }
    }
    __syncthreads();
}

struct Args { const float* in[26]; float* out; unsigned char* ws; int ph_lo, ph_hi, sub, pad_; };
struct Frame {
    LAS unsigned char* lds; volatile LAS unsigned* MISC; gu32* ctl;
    int tid, lane, wave, vcu, G;
};
__device__ __forceinline__ float gelu_fast(float x) { const float z = 0.7978845608028654f * (x + 0.044715f * x * x * x); const float e = __builtin_amdgcn_exp2f(2.885390081777927f * z); return x - x * __builtin_amdgcn_rcpf(e + 1.f); }
__device__ __forceinline__ float wave_sum(float v) {
#pragma unroll
    for (int o = 1; o < 64; o <<= 1) v += __shfl_xor(v, o);
    return v;
}

struct ConvDesc { const float* W; int ldw, k0, scol; bf16* dst; int ldd; const float* kscale; };
__device__ __forceinline__ void conv_load(const ConvDesc& d, float (&v)[32], int lane) {
    const float* wp = d.W + (size_t)(d.k0 + (lane >> 5)) * d.ldw + d.scol + (lane & 31);
#pragma unroll
    for (int i = 0; i < 32; ++i) v[i] = wp[(size_t)(2 * i) * d.ldw];
}
__device__ __forceinline__ void conv_finish(const ConvDesc& d, float (&v)[32], LAS float* scr, int lane) {
    if (d.kscale) {
#pragma unroll
        for (int i = 0; i < 32; ++i) v[i] *= d.kscale[d.k0 + 2 * i + (lane >> 5)]; }
#pragma unroll
    for (int i = 0; i < 32; ++i) scr[(2 * i + (lane >> 5)) * 33 + (lane & 31)] = v[i];
    LDS_WAIT(); asm volatile("" ::: "memory");
    const int c = lane & 7;
#pragma unroll
    for (int j = 0; j < 4; ++j) { const int n = (lane >> 3) + 8 * j; const LAS float* s = scr + (8 * c) * 33 + n;
        u32x4 o; o.x = pg::cvt_pk_bf16(s[0 * 33], s[1 * 33]); o.y = pg::cvt_pk_bf16(s[2 * 33], s[3 * 33]); o.z = pg::cvt_pk_bf16(s[4 * 33], s[5 * 33]); o.w = pg::cvt_pk_bf16(s[6 * 33], s[7 * 33]);
        *(GAS u32x4*)(d.dst + (size_t)n * d.ldd + d.k0 + 8 * c) = o; }
    LDS_WAIT(); asm volatile("" ::: "memory");
}
__device__ __forceinline__ void conv_item(const float* W, int ldw, int k0, int scol, bf16* dst, int ldd, const float* kscale, LAS float* scr, int lane) {
    ConvDesc d{W, ldw, k0, scol, dst, ldd, kscale}; float v[32]; conv_load(d, v, lane); conv_finish(d, v, scr, lane);
}
__device__ __forceinline__ int inproj_src_col(int cp) { return cp < 1536 ? cp : (cp < 2048 ? cp + (OU - 1536) : (cp < 3072 ? cp + (OGA - 2048) : cp + (OGS - 3072))); }
__device__ __forceinline__ int inproj_dst_row(int cp) { const int t = cp & ~255, c = cp & 255, wc = c >> 6, bj = (c >> 5) & 1, j = c & 31; return t + 128 * bj + 32 * wc + j; }

__device__ __forceinline__ void p0_prologue(Frame& F, const Args& a) {
    unsigned char* ws = a.ws;
    LAS float* scr = (LAS float*)(F.lds + F.wave * 8704);
    LAS float* wf = (LAS float*)(F.lds + 73728);
    const int gw = F.vcu * NWAVES + F.wave, NGW = F.G * NWAVES;
    const float* w_in = a.in[2]; const int sub = a.sub;
    for (int i = F.tid; i < 8 * 1024; i += NWAVES * 64) { const int h = i >> 10, k = i & 1023; wf[i] = w_in[(size_t)k * DIN + OF + h]; }
    constexpr int I_IN = 16 * 128;
    for (int it = (sub & 1) ? gw : I_IN; it < I_IN; it += NGW) { const int kb = it >> 7, nb = it & 127, cp = nb * 32;
        conv_item(w_in, DIN, kb * 64, inproj_src_col(cp), (bf16*)(ws + WS_WIN) + (size_t)inproj_dst_row(cp) * D, D, nullptr, scr, F.lane); }
    __syncthreads();
    const float* x = a.in[0]; const float* g = a.in[1]; const float* bfg = a.in[3];
    bf16* XN = (bf16*)(ws + WS_XN); float* LOGF = (float*)(ws + WS_CUM);
    { int m = (sub & 2) ? gw : T; f32x4 v[4];
      if (m < T) { const GAS f32x4* xr = (const GAS f32x4*)(x + (size_t)m * D) + F.lane;
#pragma unroll
          for (int j = 0; j < 4; ++j) v[j] = xr[64 * j]; }
      while (m < T) {
        const int mn = m + NGW; f32x4 vn[4];
        if (mn < T) { const GAS f32x4* xr = (const GAS f32x4*)(x + (size_t)mn * D) + F.lane;
#pragma unroll
            for (int j = 0; j < 4; ++j) vn[j] = xr[64 * j]; }
        float s = 0.f;
#pragma unroll
        for (int j = 0; j < 4; ++j) s += (v[j].x * v[j].x + v[j].y * v[j].y) + (v[j].z * v[j].z + v[j].w * v[j].w);
        float f[8];
#pragma unroll
        for (int h = 0; h < 8; ++h) f[h] = 0.f;
        f32x4 xg[4];
#pragma unroll
        for (int j = 0; j < 4; ++j) { const f32x4 gg = *((const GAS f32x4*)g + 64 * j + F.lane); xg[j] = v[j] * gg;
#pragma unroll
            for (int h = 0; h < 8; ++h) { const f32x4 ww = *((const LAS f32x4*)(wf + h * 1024) + 64 * j + F.lane); f[h] += (xg[j].x * ww.x + xg[j].y * ww.y) + (xg[j].z * ww.z + xg[j].w * ww.w); } }
        const float rstd = rsqrtf(wave_sum(s) * (1.f / D) + EPS);
        float f4[4], f2[2], f1;
        { const bool up = F.lane >= 32;
#pragma unroll
          for (int i = 0; i < 4; ++i) { const float snd = up ? f[i] : f[4 + i], kp = up ? f[4 + i] : f[i]; f4[i] = kp + __shfl_xor(snd, 32); } }
        { const bool up = (F.lane & 16) != 0;
#pragma unroll
          for (int i = 0; i < 2; ++i) { const float snd = up ? f4[i] : f4[2 + i], kp = up ? f4[2 + i] : f4[i]; f2[i] = kp + __shfl_xor(snd, 16); } }
        { const bool up = (F.lane & 8) != 0; const float snd = up ? f2[0] : f2[1], kp = up ? f2[1] : f2[0]; f1 = kp + __shfl_xor(snd, 8); }
        f1 += __shfl_xor(f1, 4); f1 += __shfl_xor(f1, 2); f1 += __shfl_xor(f1, 1);
        GAS u32x2* o8 = (GAS u32x2*)(XN + (size_t)m * D) + F.lane;
#pragma unroll
        for (int j = 0; j < 4; ++j) { const f32x4 xn = xg[j] * rstd; u32x2 w; w.x = pg::cvt_pk_bf16(xn.x, xn.y); w.y = pg::cvt_pk_bf16(xn.z, xn.w); o8[64 * j] = w; }
        if ((F.lane & 7) == 0) { const int hh = F.lane >> 3, b = m / SEQ, sidx = m % SEQ; LOGF[((size_t)b * NH + hh) * SEQ + sidx] = log_sigmoid(f1 * rstd + bfg[hh]); }
#pragma unroll
        for (int j = 0; j < 4; ++j) v[j] = vn[j];
        m = mn;
      } }
    if ((sub & 4) && F.G == 256) {
        __syncthreads();
        const int g = F.vcu >> 3, q = F.vcu & 7;
        LAS f32x2* PW = (LAS f32x2*)(F.lds);
        LAS f32x2* BB = (LAS f32x2*)(F.lds + 16896);
        LAS f32x2* CT = (LAS f32x2*)(F.lds + 16896 + 8192);
        LAS float* KT = (LAS float*)(F.lds + 16896 + 16384);
        const float* A_re = a.in[6]; const float* A_im = a.in[7]; const float* log_dt = a.in[8]; const float* B_re = a.in[9]; const float* B_im = a.in[10]; const float* C_re = a.in[11]; const float* C_im = a.in[12];
        if (F.tid < NP) { const int p = F.tid;
            const double dt = exp((double)log_dt[g]), ar = A_re[g * NP + p], ai = A_im[g * NP + p];
            const double er = exp(ar * dt), abr = er * cos(ai * dt), abi = er * sin(ai * dt);
            const double nr = abr - 1.0, ni = abi, den = ar * ar + ai * ai, fr_ = (nr * ar + ni * ai) / den, fi_ = (ni * ar - nr * ai) / den;
            double pr = 1.0, pi = 0.0;
            for (int tau = 0; tau <= LCH; ++tau) { PW[tau * NP + p] = (f32x2){(float)pr, (float)pi}; const double t2 = pr * abr - pi * abi; pi = pr * abi + pi * abr; pr = t2; }
            if (q == 0) { ((float*)(ws + WS_AL))[(g * NP + p) * 2] = PW[LCH * NP + p].x; ((float*)(ws + WS_AL))[(g * NP + p) * 2 + 1] = PW[LCH * NP + p].y; }
            for (int c = 0; c < GC; ++c) { const double br = B_re[(g * NP + p) * GC + c], bi = B_im[(g * NP + p) * GC + c]; BB[p * GC + c] = (f32x2){(float)(fr_ * br - fi_ * bi), (float)(fr_ * bi + fi_ * br)}; } }
        for (int i = F.tid; i < GC * NP; i += NWAVES * 64) { const int c = i >> 6, p = i & 63; CT[p * GC + c] = (f32x2){C_re[g * GC * NP + i], C_im[g * GC * NP + i]}; }
        __syncthreads();
        { float* KTG = (float*)(ws + WS_KTG) + (size_t)g * LCH * GC * GC;
          for (int i = 4 * q * GC * GC + F.tid; i < (4 * q + 4) * GC * GC; i += NWAVES * 64) { const int tau = i >> 8, co = (i >> 4) & 15, ci = i & 15; float acc = 0.f;
#pragma unroll 4
              for (int p = 0; p < NP; ++p) { const f32x2 w = PW[tau * NP + p], b = BB[p * GC + ci], c = CT[p * GC + co]; const float wr_ = w.x * b.x - w.y * b.y, wi_ = w.x * b.y + w.y * b.x; acc += c.x * wr_ - c.y * wi_; }
              KTG[i] = acc; } }
        {
          const int n = 64 * q + (F.tid >> 3), part = F.tid & 7, j = n >> 4, co = n & 15; bf16* row = (bf16*)(ws + WS_BTY) + ((size_t)g * 512 + n) * U2P;
          auto bval = [&](int k) -> float { const int p = k & 63; const f32x2 w = PW[(j + 1) * NP + p], c = CT[p * GC + co]; return k < 64 ? (c.x * w.x - c.y * w.y) : -(c.x * w.y + c.y * w.x); };
#pragma unroll 1
          for (int it = 0; it < 2; ++it) { const int k = (it * 8 + part) * 8;
              u32x4 o; o.x = pg::cvt_pk_bf16(bval(k), bval(k + 1)); o.y = pg::cvt_pk_bf16(bval(k + 2), bval(k + 3)); o.z = pg::cvt_pk_bf16(bval(k + 4), bval(k + 5)); o.w = pg::cvt_pk_bf16(bval(k + 6), bval(k + 7)); *(GAS u32x4*)(row + k) = o; } }
        {
          const int n = 32 * q + (F.tid >> 4), part = F.tid & 15; bf16* row = (bf16*)(ws + WS_M1T) + ((size_t)g * 256 + n) * 512;
          auto mval = [&](int k) -> float { const int j = k >> 4, ci = k & 15; float x = 0.f;
              if (n < 128) { const int p = n & 63; const f32x2 w = PW[(LCH - 1 - j) * NP + p], b = BB[p * GC + ci]; x = n < 64 ? (w.x * b.x - w.y * b.y) : (w.x * b.y + w.y * b.x); }
              return x; };
#pragma unroll 1
          for (int it = 0; it < 4; ++it) { const int k = (it * 16 + part) * 8;
              u32x4 o; o.x = pg::cvt_pk_bf16(mval(k), mval(k + 1)); o.y = pg::cvt_pk_bf16(mval(k + 2), mval(k + 3)); o.z = pg::cvt_pk_bf16(mval(k + 4), mval(k + 5)); o.w = pg::cvt_pk_bf16(mval(k + 6), mval(k + 7)); *(GAS u32x4*)(row + k) = o; } }
    }
}

__device__ __forceinline__ void p1_cumsum(Frame& F, float* CUM, int* T0, const float* gq, const float* gk) {
    LAS double* part = (LAS double*)(F.lds);
    float* p = CUM + (size_t)blockIdx.x * SEQ + F.tid * 16;
    f32x4 v[4]; float run[16]; float a = 0.f;
#pragma unroll
    for (int j = 0; j < 4; ++j) v[j] = ((const GAS f32x4*)p)[j];
#pragma unroll
    for (int j = 0; j < 4; ++j) { a += v[j].x; run[4 * j] = a; a += v[j].y; run[4 * j + 1] = a; a += v[j].z; run[4 * j + 2] = a; a += v[j].w; run[4 * j + 3] = a; }
    part[F.tid] = (double)a;
    __syncthreads();
    if (F.tid < 64) { double loc[8]; double s = 0.0;
#pragma unroll
        for (int i = 0; i < 8; ++i) { loc[i] = s; s += part[F.tid * 8 + i]; }
        double incl = s;
#pragma unroll
        for (int o = 1; o < 64; o <<= 1) { const double t = __shfl_up(incl, o); if (F.lane >= o) incl += t; }
        const double excl = incl - s;
#pragma unroll
        for (int i = 0; i < 8; ++i) part[F.tid * 8 + i] = excl + loc[i]; }
    __syncthreads();
    const double base = part[F.tid];
#pragma unroll
    for (int j = 0; j < 4; ++j) { f32x4 o; o.x = (float)((base + (double)run[4 * j]) * 1.4426950408889634); o.y = (float)((base + (double)run[4 * j + 1]) * 1.4426950408889634);
        o.z = (float)((base + (double)run[4 * j + 2]) * 1.4426950408889634); o.w = (float)((base + (double)run[4 * j + 3]) * 1.4426950408889634); ((GAS f32x4*)p)[j] = o; }
    __syncthreads();
    asm volatile("s_waitcnt vmcnt(0)" ::: "memory"); __syncthreads();
    if (F.tid < 32) { float gqm = 0.f, gkm = 0.f; for (int i = 0; i < HD; ++i) { gqm = fmaxf(gqm, fabsf(gq[i])); gkm = fmaxf(gkm, fabsf(gk[i])); }
        const float thr = 2.f * 64.f * C2 * gqm * gkm + 37.f; const int qb = F.tid, NTu = 4 * qb + 4;
        const unsigned* cu = (const unsigned*)(CUM + (size_t)blockIdx.x * SEQ);
        const float fq0 = __builtin_bit_cast(float, __hip_atomic_load(cu + qb * 256, __ATOMIC_RELAXED, __HIP_MEMORY_SCOPE_AGENT));
        int lo = 0, hi = NTu - 1;
        while (lo < hi) { const int mid = (lo + hi) >> 1; const float fk = __builtin_bit_cast(float, __hip_atomic_load(cu + 64 * mid + 63, __ATOMIC_RELAXED, __HIP_MEMORY_SCOPE_AGENT)); if (fq0 - fk >= -thr) hi = mid; else lo = mid + 1; }
        int t0 = lo & ~1; t0 = t0 > NTu - 4 ? NTu - 4 : t0; T0[blockIdx.x * 32 + qb] = t0; }
    __syncthreads();
}
struct PhInProj {
    static constexpr bool GATHER = false;
    unsigned lda, ldb; const char* A; const char* B; pg::StaticOrder so;
    bf16 *Q, *K, *V, *U2X, *GA, *GS; const float *gq, *gk;
    __device__ __forceinline__ bool next(int i, pg::Unit& u) const { int pm, pn; if (!so.next(i, pm, pn)) return false; u.A = A + (size_t)pm * 256 * lda; u.B = B + (size_t)pn * 256 * ldb; u.nt = D / 64; u.pm = pm; u.pn = pn; u.aux = 0; return true; }
    __device__ __forceinline__ void offs(const pg::Unit&, const int (&R)[2], const int (&C)[2], unsigned (&vo)[2][2]) const { pg::offs_plain(lda, R, C, vo); }
    __device__ __forceinline__ void epi(const f32x4 (&acc)[2][2][4][2], const pg::Unit& u, int wr, int wc, int fr, int fq) const {
        const int pn = u.pn, row0 = u.pm * 256 + wr * 64 + fr;
        if (pn < 4) {
            const bool isq = pn < 2; const float* g = isq ? gq : gk; bf16* O = isq ? Q : K; const int cb = (pn & 1) * 256 + 64 * wc + 8 * fq; const float sc = isq ? C2 : 1.f;
            f32x4 gv[2][2];
#pragma unroll
            for (int bj = 0; bj < 2; ++bj)
#pragma unroll
                for (int n = 0; n < 2; ++n) gv[bj][n] = *(const f32x4*)(g + 32 * bj + 8 * fq + 4 * n) * sc;
#pragma unroll
            for (int ai = 0; ai < 2; ++ai)
#pragma unroll
                for (int m = 0; m < 4; ++m) { float ss = 0.f;
#pragma unroll
                    for (int bj = 0; bj < 2; ++bj)
#pragma unroll
                        for (int n = 0; n < 2; ++n) { const f32x4 v = acc[ai][bj][m][n]; ss += (v[0] * v[0] + v[1] * v[1]) + (v[2] * v[2] + v[3] * v[3]); }
                    ss += __shfl_xor(ss, 16); ss += __shfl_xor(ss, 32);
                    const float rstd = rsqrtf(ss * (1.f / 64.f) + EPS);
                    bf16* rowp = O + (size_t)(row0 + ai * 128 + m * 16) * DA + cb;
#pragma unroll
                    for (int bj = 0; bj < 2; ++bj) *(u32x4*)(rowp + 32 * bj) = pg::pack8(acc[ai][bj][m][0] * rstd * gv[bj][0], acc[ai][bj][m][1] * rstd * gv[bj][1]); }
        } else if (pn < 6) {
            const int cb = (pn - 4) * 256 + 64 * wc + 8 * fq;
#pragma unroll
            for (int ai = 0; ai < 2; ++ai)
#pragma unroll
                for (int m = 0; m < 4; ++m) { bf16* rowp = V + (size_t)(row0 + ai * 128 + m * 16) * DA + cb;
#pragma unroll
                    for (int bj = 0; bj < 2; ++bj) *(u32x4*)(rowp + 32 * bj) = pg::pack8(acc[ai][bj][m][0], acc[ai][bj][m][1]); }
        } else if (pn < 8) {
#pragma unroll
            for (int ai = 0; ai < 2; ++ai)
#pragma unroll
                for (int m = 0; m < 4; ++m) { const int row = row0 + ai * 128 + m * 16;
#pragma unroll
                    for (int bj = 0; bj < 2; ++bj) { const int cu = (pn - 6) * 256 + 64 * wc + 32 * bj + 8 * fq;
                        *(u32x4*)(U2X + u2x_index(cu >> 4, row, cu & 15)) = pg::pack8(acc[ai][bj][m][0], acc[ai][bj][m][1]); } }
        } else {
            bf16* G = pn < 12 ? GA : GS; const int cb = ((pn - 8) & 3) * 256 + 64 * wc + 8 * fq;
#pragma unroll
            for (int ai = 0; ai < 2; ++ai)
#pragma unroll
                for (int m = 0; m < 4; ++m) { bf16* rowp = G + (size_t)(row0 + ai * 128 + m * 16) * D + cb;
#pragma unroll
                    for (int bj = 0; bj < 2; ++bj) { f32x4 a = acc[ai][bj][m][0], b = acc[ai][bj][m][1];
#pragma unroll
                        for (int e = 0; e < 4; ++e) { a[e] = pg::fsigmoid(a[e]); b[e] = pg::fsigmoid(b[e]); }
                        *(u32x4*)(rowp + 32 * bj) = pg::pack8(a, b); } }
        }
    }
};

struct PhGlu {
    static constexpr bool GATHER = false;
    unsigned lda, ldb; const char* A; const char* B; pg::StaticOrder so; const bf16* Y1; bf16* YS;
    __device__ __forceinline__ bool next(int i, pg::Unit& u) const { int pm, pn; if (!so.next(i, pm, pn)) return false; u.A = A + (size_t)pm * 256 * lda; u.B = B + (size_t)pn * 256 * ldb; u.nt = DS / 64; u.pm = pm; u.pn = pn; u.aux = 0; return true; }
    __device__ __forceinline__ void offs(const pg::Unit&, const int (&R)[2], const int (&C)[2], unsigned (&vo)[2][2]) const { pg::offs_plain(lda, R, C, vo); }
    __device__ __forceinline__ void epi(const f32x4 (&acc)[2][2][4][2], const pg::Unit& u, int wr, int wc, int fr, int fq) const {
        const int row0 = u.pm * 256 + wr * 64 + fr, cb = u.pn * 256 + 32 * wc + 8 * fq;
#pragma unroll
        for (int ai = 0; ai < 2; ++ai)
#pragma unroll
            for (int m = 0; m < 4; ++m) { const size_t ro = (size_t)(row0 + ai * 128 + m * 16) * DS + cb;
#pragma unroll
                for (int bj = 0; bj < 2; ++bj) { const u32x4 yv = *(const u32x4*)(Y1 + ro + 128 * bj); f32x4 y0, y1; pg::unpack8(yv, y0, y1);
                    f32x4 a = acc[ai][bj][m][0], b = acc[ai][bj][m][1];
#pragma unroll
                    for (int e = 0; e < 4; ++e) { a[e] = y0[e] * pg::fsigmoid(a[e]); b[e] = y1[e] * pg::fsigmoid(b[e]); }
                    *(u32x4*)(YS + ro + 128 * bj) = pg::pack8(a, b); } }
    }
};
struct PhProj {
    static constexpr bool GATHER = false;
    unsigned lda, ldb; const char* O; const char* YSp; const char* WPA; const char* WPS; pg::StaticOrder so; bf16* GA; const bf16* GS;
    __device__ __forceinline__ bool next(int i, pg::Unit& u) const { int pm, pn; if (!so.next(i >> 1, pm, pn)) return false; const int sub = i & 1;
        u.A = (sub ? YSp : O) + (size_t)pm * 256 * lda; u.B = (sub ? WPS : WPA) + (size_t)pn * 256 * ldb; u.nt = DA / 64; u.pm = pm; u.pn = pn; u.aux = sub; return true; }
    __device__ __forceinline__ void offs(const pg::Unit&, const int (&R)[2], const int (&C)[2], unsigned (&vo)[2][2]) const { pg::offs_plain(lda, R, C, vo); }
    __device__ __forceinline__ void epi(const f32x4 (&acc)[2][2][4][2], const pg::Unit& u, int wr, int wc, int fr, int fq) const {
        const int row0 = u.pm * 256 + wr * 64 + fr, cb = u.pn * 256 + 32 * wc + 8 * fq; const bool sub = u.aux != 0;
#pragma unroll
        for (int ai = 0; ai < 2; ++ai)
#pragma unroll
            for (int m = 0; m < 4; ++m) { const size_t ro = (size_t)(row0 + ai * 128 + m * 16) * D + cb;
#pragma unroll
                for (int bj = 0; bj < 2; ++bj) { const u32x4 gv = *(const u32x4*)(GA + ro + 128 * bj); f32x4 g0, g1; pg::unpack8(gv, g0, g1);
                    f32x4 a = acc[ai][bj][m][0], b = acc[ai][bj][m][1];
                    if (!sub) { a = a * g0; b = b * g1; }
                    else { const u32x4 sv = *(const u32x4*)(GS + ro + 128 * bj); f32x4 s0, s1; pg::unpack8(sv, s0, s1); a = g0 + s0 * a; b = g1 + s1 * b; }
                    *(u32x4*)(GA + ro + 128 * bj) = pg::pack8(a, b); } }
    }
};
struct PhWout {
    static constexpr bool GATHER = false;
    unsigned lda, ldb; const char* A; const char* B; pg::StaticOrder so; const float* x; float* out; bf16* X2B; float* SSP;
    __device__ __forceinline__ bool next(int i, pg::Unit& u) const { int pm, pn; if (!so.next(i, pm, pn)) return false; u.A = A + (size_t)pm * 256 * lda; u.B = B + (size_t)pn * 256 * ldb; u.nt = D / 64; u.pm = pm; u.pn = pn; u.aux = 0; return true; }
    __device__ __forceinline__ void offs(const pg::Unit&, const int (&R)[2], const int (&C)[2], unsigned (&vo)[2][2]) const { pg::offs_plain(lda, R, C, vo); }
    __device__ __forceinline__ void epi(const f32x4 (&acc)[2][2][4][2], const pg::Unit& u, int wr, int wc, int fr, int fq) const {
        const int row0 = u.pm * 256 + wr * 64 + fr, cb = u.pn * 256 + 32 * wc + 8 * fq;
#pragma unroll
        for (int ai = 0; ai < 2; ++ai)
#pragma unroll
            for (int m = 0; m < 4; ++m) { const int row = row0 + ai * 128 + m * 16; const size_t ro = (size_t)row * D + cb; float ss = 0.f;
#pragma unroll
                for (int bj = 0; bj < 2; ++bj) { const f32x4 x0 = *(const f32x4*)(x + ro + 128 * bj), x1 = *(const f32x4*)(x + ro + 128 * bj + 4);
                    const f32x4 a = acc[ai][bj][m][0] + x0, b = acc[ai][bj][m][1] + x1;
                    *(u32x4*)(X2B + ro + 128 * bj) = pg::pack8(a, b);
                    ss += (a[0] * a[0] + a[1] * a[1]) + (a[2] * a[2] + a[3] * a[3]) + (b[0] * b[0] + b[1] * b[1]) + (b[2] * b[2] + b[3] * b[3]); }
                ss += __shfl_xor(ss, 16); ss += __shfl_xor(ss, 32);
                if (fq == 0) SSP[(size_t)row * 16 + u.pn * 4 + wc] = ss;
                asm volatile("" ::: "memory"); }
    }
};

__device__ __forceinline__ void p2_side_work(Frame& F, const Args& a) {
    unsigned char* ws = a.ws; const int i0 = (int)blockIdx.x - 64;
    LAS float* KT = (LAS float*)F.lds;
    for (int sl = i0; sl < NG * 8; sl += 192) { const int g = sl >> 3, q = sl & 7;
        __syncthreads();
        { const GAS f32x4* src = (const GAS f32x4*)((const float*)(ws + WS_KTG) + (size_t)g * LCH * GC * GC);
          for (int i = F.tid; i < (4 * q + 4) * GC * GC / 4; i += NWAVES * 64) *(LAS f32x4*)(KT + 4 * i) = src[i]; }
        __syncthreads();
        const int n = 64 * q + (F.tid >> 3), part = F.tid & 7, j = n >> 4, co = n & 15; bf16* row = (bf16*)(ws + WS_BTY) + ((size_t)g * 512 + n) * U2P + 128;
#pragma unroll 1
        for (int it = 0; it < 8; ++it) { const int k = (it * 8 + part) * 8, sidx = k >> 4, ci = k & 15;
            u32x4 o = (u32x4){0u, 0u, 0u, 0u};
            if (sidx <= j) { const LAS float* kp = KT + ((j - sidx) * GC + co) * GC + ci; const f32x4 k0 = *(const LAS f32x4*)kp, k1 = *(const LAS f32x4*)(kp + 4); o = pg::pack8(k0, k1); }
            *(GAS u32x4*)(row + k) = o; } }
    __syncthreads();
    LAS float* scr = (LAS float*)(F.lds + F.wave * 8704);
    constexpr int I_GLU = 8 * 16, I_PA = 8 * 32, I_OUT = 16 * 32;
    for (int it = i0 * NWAVES + F.wave; it < I_GLU + 2 * I_PA + I_OUT; it += 192 * NWAVES) { int r = it;
        if (r < I_GLU) { const int kb = r >> 4, nb = r & 15; conv_item(a.in[14], DS, kb * 64, nb * 32, (bf16*)(ws + WS_WGLU) + (size_t)(nb * 32) * DS, DS, nullptr, scr, F.lane); continue; } r -= I_GLU;
        if (r < I_PA) { const int kb = r >> 5, nb = r & 31; conv_item(a.in[15], D, kb * 64, nb * 32, (bf16*)(ws + WS_WPA) + (size_t)(nb * 32) * DA, DA, nullptr, scr, F.lane); continue; } r -= I_PA;
        if (r < I_PA) { const int kb = r >> 5, nb = r & 31; conv_item(a.in[16], D, kb * 64, nb * 32, (bf16*)(ws + WS_WPS) + (size_t)(nb * 32) * DS, DS, nullptr, scr, F.lane); continue; } r -= I_PA;
        { const int kb = r >> 5, nb = r & 31; conv_item(a.in[17], D, kb * 64, nb * 32, (bf16*)(ws + WS_WOUT) + (size_t)(nb * 32) * D, D, nullptr, scr, F.lane); } }
    if (i0 < 48) { const int r = i0; const float* gf = a.in[18]; const float* wrg = a.in[19]; const float* wre = a.in[21]; bf16* WR = (bf16*)(ws + WS_WR) + (size_t)r * D;
        for (int k = F.tid; k < D; k += NWAVES * 64) { const float w = r < 4 ? wrg[k * 4 + r] : (r < 36 ? wre[k * NE + r - 4] : 0.f); WR[k] = f2bf(w * gf[k]); } }
    __syncthreads();
}
__device__ __forceinline__ void p2_expert_weights(Frame& F, const Args& a) {
    unsigned char* ws = a.ws; LAS float* scr = (LAS float*)(F.lds + F.wave * 8704);
    const int gw = F.vcu * NWAVES + F.wave, NGW = F.G * NWAVES;
    const float* gf = a.in[18]; const float* wg = a.in[23]; const float* wu = a.in[24]; const float* wd = a.in[25];
    constexpr int I_G = 16 * 8, I_D = 4 * 32;
    constexpr int NITEMS = NE * (2 * I_G + I_D);
    auto desc = [&](int it) -> ConvDesc { const int e = it / (2 * I_G + I_D); int r = it % (2 * I_G + I_D);
        if (r < 2 * I_G) { const int up = r >= I_G; if (up) r -= I_G; const int kb = r >> 3, nb = r & 7, n0 = nb * 32;
            return ConvDesc{(up ? wu : wg) + (size_t)e * D * DE, DE, kb * 64, n0, (bf16*)(ws + WS_WGU) + ((size_t)e * 512 + 256 * (n0 >> 7) + 128 * up + (n0 & 127)) * D, D, gf}; }
        r -= 2 * I_G; const int kb = r >> 5, nb = r & 31; return ConvDesc{wd + (size_t)e * DE * D, D, kb * 64, nb * 32, (bf16*)(ws + WS_WD) + ((size_t)e * D + nb * 32) * DE, DE, nullptr}; };
    int it = (a.sub & 4) ? gw : NITEMS;
    float v[32]; ConvDesc d{}; if (it < NITEMS) { d = desc(it); conv_load(d, v, F.lane); }
    while (it < NITEMS) {
        const int itn = it + NGW; float vn[32]; ConvDesc dn{}; if (itn < NITEMS) { dn = desc(itn); conv_load(dn, vn, F.lane); }
        conv_finish(d, v, scr, F.lane);
#pragma unroll
        for (int i = 0; i < 32; ++i) v[i] = vn[i];
        d = dn; it = itn;
    }
}
__device__ __forceinline__ void p8_router(Frame& F, const Args& a) {
    unsigned char* ws = a.ws;
    constexpr int WPITCH = 2064;
    LAS unsigned char* wl = F.lds;
    LAS float* lg = (LAS float*)(F.lds + 48 * WPITCH) + F.wave * 16 * 48;
    { const GAS u32x4* src = (const GAS u32x4*)(ws + WS_WR);
      for (int i = F.tid; i < 48 * 128; i += NWAVES * 64) { const int r = i >> 7, c = i & 127; *(LAS u32x4*)(wl + r * WPITCH + c * 16) = src[i]; } }
    __syncthreads();
    const bf16* X2B = (const bf16*)(ws + WS_X2B); const float* SSP = (const float*)(ws + WS_SSP);
    const float* b_rg = a.in[20]; const float* b_re = a.in[22];
    float* RSTD = (float*)(ws + WS_RSTD); int* ROUTE = (int*)(ws + WS_ROUTE); int* CNT = (int*)(ws + WS_CTL) + CW_CNT; int* LIST = (int*)(ws + WS_LIST); float* WPOS = (float*)(ws + WS_WPOS); float* RPOS = (float*)(ws + WS_RPOS);
    const int fr = F.lane & 15, fq = F.lane >> 4;
    LAS int* lcnt = (LAS int*)(F.lds + 48 * WPITCH + NWAVES * 16 * 48 * 4);
    LAS int* lbase = lcnt + 32;
    for (int t0 = F.vcu * 64; t0 < T; t0 += F.G * 64) {
        if (F.tid < 32) lcnt[F.tid] = 0;
        __syncthreads();
        int e0 = 0, e1 = 0, lr0 = 0, lr1 = 0; float w0 = 0.f, w1 = 0.f, rstd = 0.f;
        if (F.wave < 4) {
            const int tok = t0 + F.wave * 16 + fr;
            const GAS bf16x8* xa = (const GAS bf16x8*)(X2B + (size_t)tok * D + 8 * fq);
            f32x4 acc[3]; acc[0] = acc[1] = acc[2] = (f32x4){0.f, 0.f, 0.f, 0.f};
            bf16x8 xf[32];
#pragma unroll
            for (int ks = 0; ks < 32; ++ks) xf[ks] = xa[ks * 4];
#pragma unroll
            for (int ks = 0; ks < 32; ++ks) {
#pragma unroll
                for (int n = 0; n < 3; ++n) { const bf16x8 wfr = *(const LAS bf16x8*)(wl + (n * 16 + fr) * WPITCH + ks * 64 + fq * 16);
                    acc[n] = __builtin_amdgcn_mfma_f32_16x16x32_bf16(wfr, xf[ks], acc[n], 0, 0, 0); } }
#pragma unroll
            for (int n = 0; n < 3; ++n) *(LAS f32x4*)(lg + fr * 48 + n * 16 + 4 * fq) = acc[n];
            LDS_WAIT(); asm volatile("" ::: "memory");
            if (F.lane < 16) {
                const int t = t0 + F.wave * 16 + F.lane; const LAS float* l = lg + F.lane * 48;
                float ss = 0.f; { const f32x4* sp = (const f32x4*)(SSP + (size_t)t * 16);
#pragma unroll
                    for (int i = 0; i < 4; ++i) { const f32x4 v = sp[i]; ss += (v[0] + v[1]) + (v[2] + v[3]); } }
                rstd = rsqrtf(ss * (1.f / D) + EPS);
                float gl[4]; int gs = 0;
#pragma unroll
                for (int i = 0; i < 4; ++i) gl[i] = l[i] * rstd + b_rg[i];
                float gm = gl[0];
#pragma unroll
                for (int i = 1; i < 4; ++i) if (gl[i] > gm) { gm = gl[i]; gs = i; }
                float gsum = 0.f;
#pragma unroll
                for (int i = 0; i < 4; ++i) gsum += __expf(gl[i] - gm);
                const float gtop = 1.f / gsum;
                float el[8];
#pragma unroll
                for (int i = 0; i < 8; ++i) el[i] = l[4 + gs * 8 + i] * rstd + b_re[gs * 8 + i];
                int i0 = 0; float m0 = el[0];
#pragma unroll
                for (int i = 1; i < 8; ++i) if (el[i] > m0) { m0 = el[i]; i0 = i; }
                int i1 = -1; float m1 = -3.0e38f;
#pragma unroll
                for (int i = 0; i < 8; ++i) if (i != i0 && el[i] > m1) { m1 = el[i]; i1 = i; }
                const float p1 = __expf(m1 - m0); w0 = gtop / (1.f + p1); w1 = gtop * p1 / (1.f + p1);
                e0 = gs * 8 + i0; e1 = gs * 8 + i1;
                lr0 = __hip_atomic_fetch_add(&lcnt[e0], 1, __ATOMIC_RELAXED, __HIP_MEMORY_SCOPE_WORKGROUP); lr1 = __hip_atomic_fetch_add(&lcnt[e1], 1, __ATOMIC_RELAXED, __HIP_MEMORY_SCOPE_WORKGROUP);
            }
        }
        __syncthreads();
        if (F.tid < 32) { const int c = lcnt[F.tid]; lbase[F.tid] = c ? atomicAdd(&CNT[F.tid], c) : 0; }
        __syncthreads();
        if (F.wave < 4 && F.lane < 16) {
            const int t = t0 + F.wave * 16 + F.lane; const int r0 = lbase[e0] + lr0, r1 = lbase[e1] + lr1;
            RSTD[t] = rstd; *(int4*)(ROUTE + t * 4) = make_int4(e0, e1, r0, r1);
            LIST[e0 * T + r0] = t; LIST[e1 * T + r1] = t; WPOS[e0 * T + r0] = w0; WPOS[e1 * T + r1] = w1; RPOS[e0 * T + r0] = rstd; RPOS[e1 * T + r1] = rstd;
        }
        __syncthreads();
    }
}
__device__ __forceinline__ void moe_table(Frame& F, const int* CNT, LAS int* tb) {
    if (F.tid < 64) { const int e = F.lane; int c = 0; if (e < NE) c = (int)__hip_atomic_load((const unsigned*)CNT + e, __ATOMIC_RELAXED, __HIP_MEMORY_SCOPE_AGENT);
        const int tl = (c + 255) >> 8; int incl = tl;
#pragma unroll
        for (int o = 1; o < 32; o <<= 1) { const int v = __shfl_up(incl, o); if (e >= o) incl += v; }
        if (e < NE) { tb[e] = incl - tl; tb[64 + e] = c; } if (e == NE - 1) tb[32] = incl; }
    __syncthreads();
}
__device__ __forceinline__ int moe_find(const LAS int* tb, int mt) { int e = 0;
#pragma unroll 1
    for (int i = 1; i < NE; ++i) if (mt >= tb[i]) e = i; return e; }
struct PhMoeGU {
    static constexpr bool GATHER = true;
    unsigned lda, ldb; const char* X; const char* W; const LAS int* tb; const int* LIST; const float* RPOS; bf16* H; int G, c;
    __device__ __forceinline__ bool next(int i, pg::Unit& u) const { const int L = i * G + c; if (L >= 2 * tb[32]) return false; const int mt = L >> 1, n2 = L & 1, e = moe_find(tb, mt);
        u.A = X; u.B = W + ((size_t)e * 512 + n2 * 256) * ldb; u.nt = D / 64; u.pm = mt; u.pn = n2; u.aux = e; return true; }
    __device__ __forceinline__ void offs(const pg::Unit& u, const int (&R)[2], const int (&C)[2], unsigned (&vo)[2][2]) const {
        const int e = u.aux, cnt = tb[64 + e], r0 = (u.pm - tb[e]) * 256; const int* lp = LIST + (size_t)e * T;
#pragma unroll
        for (int h = 0; h < 2; ++h)
#pragma unroll
            for (int i = 0; i < 2; ++i) { int r = r0 + h * 128 + R[i]; r = r < cnt ? r : cnt - 1; vo[h][i] = (unsigned)lp[r] * lda + (unsigned)C[i] * 2u; }
    }
    __device__ __forceinline__ void epi(const f32x4 (&acc)[2][2][4][2], const pg::Unit& u, int wr, int wc, int fr, int fq) const {
        const int e = u.aux, r0 = (u.pm - tb[e]) * 256; const float* rp = RPOS + (size_t)e * T + r0;
#pragma unroll
        for (int ai = 0; ai < 2; ++ai)
#pragma unroll
            for (int m = 0; m < 4; ++m) { const int tr = ai * 128 + wr * 64 + m * 16 + fr; const float rs = rp[tr];
                f32x4 g0 = acc[ai][0][m][0] * rs, g1 = acc[ai][0][m][1] * rs; const f32x4 u0 = acc[ai][1][m][0] * rs, u1 = acc[ai][1][m][1] * rs;
#pragma unroll
                for (int q = 0; q < 4; ++q) { g0[q] = g0[q] * pg::fsigmoid(g0[q]) * u0[q]; g1[q] = g1[q] * pg::fsigmoid(g1[q]) * u1[q]; }
                *(u32x4*)(H + ((size_t)u.pm * 256 + tr) * DE + u.pn * 128 + 32 * wc + 8 * fq) = pg::pack8(g0, g1); }
    }
};
struct PhMoeDown {
    static constexpr bool GATHER = false;
    unsigned lda, ldb; const char* Hp; const char* W; const LAS int* tb; const float* WPOS; bf16* Y; int G, c;
    __device__ __forceinline__ bool next(int i, pg::Unit& u) const { const int L = i * G + c; if (L >= 4 * tb[32]) return false; const int mt = L >> 2, n4 = L & 3, e = moe_find(tb, mt);
        u.A = Hp + (size_t)mt * 256 * lda; u.B = W + ((size_t)e * D + n4 * 256) * ldb; u.nt = DE / 64; u.pm = mt; u.pn = n4; u.aux = e; return true; }
    __device__ __forceinline__ void offs(const pg::Unit&, const int (&R)[2], const int (&C)[2], unsigned (&vo)[2][2]) const { pg::offs_plain(lda, R, C, vo); }
    __device__ __forceinline__ void epi(const f32x4 (&acc)[2][2][4][2], const pg::Unit& u, int wr, int wc, int fr, int fq) const {
        const int e = u.aux, r0 = (u.pm - tb[e]) * 256; const float* wp = WPOS + (size_t)e * T + r0;
#pragma unroll
        for (int ai = 0; ai < 2; ++ai)
#pragma unroll
            for (int m = 0; m < 4; ++m) { const int tr = ai * 128 + wr * 64 + m * 16 + fr; const float w = wp[tr]; bf16* yp = Y + ((size_t)u.pm * 256 + tr) * D + u.pn * 256 + 32 * wc + 8 * fq;
#pragma unroll
                for (int bj = 0; bj < 2; ++bj) *(u32x4*)(yp + 128 * bj) = pg::pack8(acc[ai][bj][m][0] * w, acc[ai][bj][m][1] * w); }
    }
};
__device__ __forceinline__ void p11_combine(Frame& F, const Args& a, const LAS int* tb) {
    unsigned char* ws = a.ws; const int* ROUTE = (const int*)(ws + WS_ROUTE); const bf16* Y = (const bf16*)(ws + WS_Y); const bf16* X2B = (const bf16*)(ws + WS_X2B); float* out = a.out;
    for (int t = F.vcu * NWAVES + F.wave; t < T; t += F.G * NWAVES) {
        const int4 rt = *(const int4*)(ROUTE + t * 4);
        const GAS u32x2* y0 = (const GAS u32x2*)(Y + ((size_t)tb[rt.x] * 256 + rt.z) * D) + F.lane; const GAS u32x2* y1 = (const GAS u32x2*)(Y + ((size_t)tb[rt.y] * 256 + rt.w) * D) + F.lane;
        const GAS u32x2* xb = (const GAS u32x2*)(X2B + (size_t)t * D) + F.lane;
        GAS f32x4* o = (GAS f32x4*)(out + (size_t)t * D) + F.lane;
#pragma unroll
        for (int j = 0; j < 4; ++j) { const u32x2 a0 = y0[64 * j], a1 = y1[64 * j], xv = xb[64 * j]; f32x4 v;
            v[0] = __builtin_bit_cast(float, xv.x << 16) + (__builtin_bit_cast(float, a0.x << 16) + __builtin_bit_cast(float, a1.x << 16)); v[1] = __builtin_bit_cast(float, xv.x & 0xffff0000u) + (__builtin_bit_cast(float, a0.x & 0xffff0000u) + __builtin_bit_cast(float, a1.x & 0xffff0000u));
            v[2] = __builtin_bit_cast(float, xv.y << 16) + (__builtin_bit_cast(float, a0.y << 16) + __builtin_bit_cast(float, a1.y << 16)); v[3] = __builtin_bit_cast(float, xv.y & 0xffff0000u) + (__builtin_bit_cast(float, a0.y & 0xffff0000u) + __builtin_bit_cast(float, a1.y & 0xffff0000u));
            o[64 * j] = v; }
    }
}

struct PhSsmX {
    static constexpr bool GATHER = false;
    unsigned lda, ldb; const char* U2X; const char* M1T; float* SLOC; int g, b;
    __device__ __forceinline__ bool next(int i, pg::Unit& u) const { if (i >= 1) return false; u.A = U2X + ((size_t)(g * NCR + b * 256) * U2P + 128) * 2; u.B = M1T + (size_t)g * 256 * ldb; u.nt = 8; u.pm = b; u.pn = 0; u.aux = 0; return true; }
    __device__ __forceinline__ void offs(const pg::Unit&, const int (&R)[2], const int (&C)[2], unsigned (&vo)[2][2]) const { pg::offs_plain(lda, R, C, vo); }
    __device__ __forceinline__ void epi(const f32x4 (&acc)[2][2][4][2], const pg::Unit& u, int wr, int wc, int fr, int fq) const {
#pragma unroll
        for (int ai = 0; ai < 2; ++ai)
#pragma unroll
            for (int m = 0; m < 4; ++m) { float* p = SLOC + ((size_t)g * NCR + u.pm * 256 + ai * 128 + wr * 64 + m * 16 + fr) * 128 + 32 * wc + 8 * fq;
                *(f32x4*)p = acc[ai][0][m][0]; *(f32x4*)(p + 4) = acc[ai][0][m][1]; }
    }
};
__device__ __forceinline__ void ssm_scan(Frame& F, unsigned char* ws, int g, int b) {
    LAS f32x2* ends = (LAS f32x2*)F.lds;
    const int p = F.lane, w = F.wave;
    const float alr = ((const float*)(ws + WS_AL))[(g * NP + p) * 2], ali = ((const float*)(ws + WS_AL))[(g * NP + p) * 2 + 1];
    const float* sl = (const float*)(ws + WS_SLOC) + ((size_t)g * NCR + b * 256 + w * 32) * 128;
    float lr[32], li[32];
#pragma unroll
    for (int k = 0; k < 32; ++k) { lr[k] = sl[k * 128 + p]; li[k] = sl[k * 128 + 64 + p]; }
#pragma unroll
    for (int k = 1; k < 32; ++k) { const float nr = alr * lr[k - 1] - ali * li[k - 1] + lr[k], ni = alr * li[k - 1] + ali * lr[k - 1] + li[k]; lr[k] = nr; li[k] = ni; }
    ends[w * 64 + p] = (f32x2){lr[31], li[31]};
    float sr = alr, si = ali;
#pragma unroll
    for (int k = 0; k < 5; ++k) { const float t = sr * sr - si * si; si = 2.f * sr * si; sr = t; }
    __syncthreads();
    float cr = 0.f, ci = 0.f;
    for (int s2 = 0; s2 < w; ++s2) { const f32x2 e = ends[s2 * 64 + p]; const float t = sr * cr - si * ci + e.x; ci = sr * ci + si * cr + e.y; cr = t; }
    bf16* hp = (bf16*)(ws + WS_U2X) + ((size_t)g * NCR + b * 256 + w * 32) * U2P;
    float pr = cr, pi = ci;
#pragma unroll
    for (int k = 0; k < 32; ++k) { const float hr = (k ? lr[k - 1] : 0.f) + pr, hi = (k ? li[k - 1] : 0.f) + pi;
        hp[(size_t)k * U2P + p] = f2bf(hr); hp[(size_t)k * U2P + 64 + p] = f2bf(hi);
        const float t = alr * pr - ali * pi; pi = alr * pi + ali * pr; pr = t; }
    __syncthreads();
}
struct PhSsmY {
    static constexpr bool GATHER = false;
    unsigned lda, ldb; const char* U2Xp; const char* BTY; const bf16* U2X; const float* Dsk; bf16* Y1; int G, c;
    __device__ __forceinline__ bool next(int i, pg::Unit& u) const { const int L = i * G + c; if (L >= NG * 4) return false; const int g = L >> 2, mt = (L >> 1) & 1, nb = L & 1;
        u.A = U2Xp + (size_t)(g * NCR + mt * 256) * lda; u.B = BTY + (size_t)(g * 512 + nb * 256) * ldb; u.nt = nb ? 10 : 6; u.pm = mt; u.pn = nb; u.aux = g; return true; }
    __device__ __forceinline__ void offs(const pg::Unit&, const int (&R)[2], const int (&C)[2], unsigned (&vo)[2][2]) const { pg::offs_plain(lda, R, C, vo); }
    __device__ __forceinline__ void epi(const f32x4 (&acc)[2][2][4][2], const pg::Unit& u, int wr, int wc, int fr, int fq) const {
        const int g = u.aux;
#pragma unroll
        for (int bj = 0; bj < 2; ++bj) { const int n = u.pn * 256 + 128 * bj + 32 * wc + 8 * fq, j = n >> 4, c0 = n & 15;
            const f32x4 d0 = *(const f32x4*)(Dsk + g * GC + c0), d1 = *(const f32x4*)(Dsk + g * GC + c0 + 4);
#pragma unroll
            for (int ai = 0; ai < 2; ++ai)
#pragma unroll
                for (int m = 0; m < 4; ++m) { const int cr = u.pm * 256 + ai * 128 + wr * 64 + m * 16 + fr;
                    const u32x4 uv = *(const u32x4*)(U2X + ((size_t)g * NCR + cr) * U2P + 128 + j * GC + c0); f32x4 u0, u1; pg::unpack8(uv, u0, u1);
                    f32x4 a = acc[ai][bj][m][0] + d0 * u0, b = acc[ai][bj][m][1] + d1 * u1;
#pragma unroll
                    for (int q = 0; q < 4; ++q) { a[q] = gelu_fast(a[q]); b[q] = gelu_fast(b[q]); }
                    *(u32x4*)(Y1 + ((size_t)cr * LCH + j) * DS + g * GC + c0) = pg::pack8(a, b); } }
    }
};

__global__ void __launch_bounds__(NWAVES * 64, 2) mk_fwd(Args args) {
    extern __shared__ __attribute__((aligned(16))) unsigned char lds[];
    Frame F;
    F.lds = (LAS unsigned char*)lds; F.MISC = (volatile LAS unsigned*)(F.lds + MISC_OFF);
    F.tid = threadIdx.x; F.lane = F.tid & 63; F.wave = __builtin_amdgcn_readfirstlane(F.tid >> 6);
    F.G = gridDim.x; { const int bx = blockIdx.x; F.vcu = (F.G % 8 == 0) ? (bx % 8) * (F.G / 8) + bx / 8 : bx; }
    unsigned char* ws = args.ws; F.ctl = (gu32*)(ws + WS_CTL);
    for (int u = F.tid; u < (LDS_BYTES - LDSCTL_OFF) / 4; u += NWAVES * 64) ((LAS unsigned*)(F.lds + LDSCTL_OFF))[u] = 0u;
    __syncthreads();
    const int lo = args.ph_lo, hi = args.ph_hi;
    const bool multi = (hi - lo) > 1;
    XcdBarrier bar; bar.bar = (unsigned*)(F.ctl + CW_BAR); bar.x = 0; bar.st = nullptr;
    if (multi) bar = xcd_barrier_post((unsigned*)(F.ctl + CW_BAR), F.MISC + 8);
#define IN(k) (lo <= (k) && (k) < hi)
#define SEAM(k) do { if (IN(k) && IN((k) + 1)) xcd_barrier(bar); } while (0)
    if (IN(0)) { p0_prologue(F, args); SEAM(0); }
    if (IN(1)) {
        if (blockIdx.x < NBATCH * NH) p1_cumsum(F, (float*)(ws + WS_CUM), (int*)(ws + WS_T0), args.in[4], args.in[5]);
        PhInProj ph; ph.lda = D * 2; ph.ldb = D * 2; ph.A = (const char*)(ws + WS_XN); ph.B = (const char*)(ws + WS_WIN); ph.so.init(T / 256, 4096 / 256, F.G, (int)blockIdx.x);
        ph.Q = (bf16*)(ws + WS_Q); ph.K = (bf16*)(ws + WS_K); ph.V = (bf16*)(ws + WS_V); ph.U2X = (bf16*)(ws + WS_U2X); ph.GA = (bf16*)(ws + WS_GA); ph.GS = (bf16*)(ws + WS_GS);
        ph.gq = args.in[4]; ph.gk = args.in[5];
        pg::gemm_phase(F.lds + RING_OFF, ph);
        SEAM(1);
    }
    if (IN(2)) {
        if (blockIdx.x < 2 * NG) {
            const int g = (int)blockIdx.x >> 1, b = (int)blockIdx.x & 1;
            PhSsmX ph; ph.lda = U2P * 2; ph.ldb = 512 * 2; ph.U2X = (const char*)(ws + WS_U2X); ph.M1T = (const char*)(ws + WS_M1T); ph.SLOC = (float*)(ws + WS_SLOC); ph.g = g; ph.b = b;
            if (args.sub & 1) pg::gemm_phase(F.lds + RING_OFF, ph);
            if (args.sub & 2) ssm_scan(F, ws, g, b);
            __syncthreads();
        } else if (F.G == 256) p2_side_work(F, args);
        p2_expert_weights(F, args); SEAM(2);
    }
    if (IN(3)) {
        static_assert(attn_body::ATTN_LDS_BYTES + 2 * attn_body::MAX_ITEMS * 4 <= RING_BYTES, "attention LDS");
        const attn_body::AttnTensors AT{(const attn_body::bf16*)(ws + WS_Q), (const attn_body::bf16*)(ws + WS_K), (const attn_body::bf16*)(ws + WS_V), (attn_body::bf16*)(ws + WS_Q), (const float*)(ws + WS_CUM),
            (const int*)(ws + WS_T0), (attn_body::bf16*)(ws + WS_PO), (float*)(ws + WS_PS), (unsigned*)(F.ctl + CW_Q0)};
        attn_body::attn_phase<20>((char*)lds + RING_OFF, AT, F.vcu, F.G);
        SEAM(3);
    }
    if (IN(4)) {
        if (F.vcu >= 128) {
            const attn_body::AttnTensors AT{(const attn_body::bf16*)(ws + WS_Q), (const attn_body::bf16*)(ws + WS_K), (const attn_body::bf16*)(ws + WS_V), (attn_body::bf16*)(ws + WS_Q), (const float*)(ws + WS_CUM),
                (const int*)(ws + WS_T0), (attn_body::bf16*)(ws + WS_PO), (float*)(ws + WS_PS), (unsigned*)(F.ctl + CW_Q0)};
            attn_body::attn_combine((char*)lds + RING_OFF, AT, F.vcu - 128, F.G - 128);
        }
        PhSsmY ph; ph.lda = U2P * 2; ph.ldb = U2P * 2; ph.U2Xp = (const char*)(ws + WS_U2X); ph.BTY = (const char*)(ws + WS_BTY); ph.U2X = (const bf16*)(ws + WS_U2X); ph.Dsk = args.in[13]; ph.Y1 = (bf16*)(ws + WS_Y1); ph.G = F.G; ph.c = F.vcu;
        pg::gemm_phase(F.lds + RING_OFF, ph);
        SEAM(4);
    }
    if (IN(5)) {
        PhGlu ph; ph.lda = DS * 2; ph.ldb = DS * 2; ph.A = (const char*)(ws + WS_Y1); ph.B = (const char*)(ws + WS_WGLU); ph.so.init(T / 256, DS / 256, F.G, (int)blockIdx.x); ph.Y1 = (const bf16*)(ws + WS_Y1); ph.YS = (bf16*)(ws + WS_YS);
        pg::gemm_phase(F.lds + RING_OFF, ph);
        SEAM(5);
    }
    if (IN(6)) {
        PhProj ph; ph.lda = DA * 2; ph.ldb = DA * 2; ph.O = (const char*)(ws + WS_Q); ph.YSp = (const char*)(ws + WS_YS); ph.WPA = (const char*)(ws + WS_WPA); ph.WPS = (const char*)(ws + WS_WPS);
        ph.so.init(T / 256, D / 256, F.G, (int)blockIdx.x); ph.GA = (bf16*)(ws + WS_GA); ph.GS = (const bf16*)(ws + WS_GS);
        pg::gemm_phase(F.lds + RING_OFF, ph);
        SEAM(6);
    }
    if (IN(7)) {
        PhWout ph; ph.lda = D * 2; ph.ldb = D * 2; ph.A = (const char*)(ws + WS_GA); ph.B = (const char*)(ws + WS_WOUT); ph.so.init(T / 256, D / 256, F.G, (int)blockIdx.x);
        ph.x = args.in[0]; ph.out = args.out; ph.X2B = (bf16*)(ws + WS_X2B); ph.SSP = (float*)(ws + WS_SSP);
        pg::gemm_phase(F.lds + RING_OFF, ph);
        SEAM(7);
    }
    if (IN(8)) { p8_router(F, args); SEAM(8); }
    LAS int* tb = (LAS int*)(F.lds + LDSCTL_OFF + 512);
    if (IN(9)) {
        moe_table(F, (const int*)(ws + WS_CTL) + CW_CNT, tb);
        PhMoeGU ph; ph.lda = D * 2; ph.ldb = D * 2; ph.X = (const char*)(ws + WS_X2B); ph.W = (const char*)(ws + WS_WGU); ph.tb = tb; ph.LIST = (const int*)(ws + WS_LIST); ph.RPOS = (const float*)(ws + WS_RPOS);
        ph.H = (bf16*)(ws + WS_H); ph.G = F.G; ph.c = F.vcu;
        pg::gemm_phase(F.lds + RING_OFF, ph);
        SEAM(9);
    }
    if (IN(10)) {
        if (!IN(9)) moe_table(F, (const int*)(ws + WS_CTL) + CW_CNT, tb);
        PhMoeDown ph; ph.lda = DE * 2; ph.ldb = DE * 2; ph.Hp = (const char*)(ws + WS_H); ph.W = (const char*)(ws + WS_WD); ph.tb = tb; ph.WPOS = (const float*)(ws + WS_WPOS); ph.Y = (bf16*)(ws + WS_Y); ph.G = F.G; ph.c = F.vcu;
        pg::gemm_phase(F.lds + RING_OFF, ph);
        SEAM(10);
    }
    if (IN(11)) {
        if (!IN(10)) moe_table(F, (const int*)(ws + WS_CTL) + CW_CNT, tb);
        p11_combine(F, args, tb);
    }
#undef IN
#undef SEAM
}

extern "C" void kernel_launch(void* const* d_in, const int* in_sizes, int n_in, void* d_out, int out_size, void* d_ws, size_t ws_size, hipStream_t stream) {
    static int grid = 0;
    if (grid == 0) {
        int dev = 0, cus = 0; (void)hipGetDevice(&dev); (void)hipDeviceGetAttribute(&cus, hipDeviceAttributeMultiprocessorCount, dev);
        (void)hipFuncSetAttribute((const void*)mk_fwd, hipFuncAttributeMaxDynamicSharedMemorySize, LDS_BYTES);
        grid = cus > 0 ? cus : 256;
    }
    (void)hipMemsetAsync((char*)d_ws + WS_CTL, 0, CTL_ZERO_BYTES, stream);
    Args a{}; for (int i = 0; i < 26; ++i) a.in[i] = (const float*)d_in[i]; a.out = (float*)d_out; a.ws = (unsigned char*)d_ws;
    a.ph_lo = 0; a.ph_hi = 12; a.sub = 7;
    hipLaunchKernelGGL(mk_fwd, dim3(grid), dim3(NWAVES * 64), LDS_BYTES, stream, a);
}
```

```cpp
#include <hip/hip_runtime.h>
#include <stdint.h>
#include <math.h>

typedef unsigned short bf16;
constexpr int T = 16384, D = 1024, SEQ = 8192, NBATCH = 2, NH = 8, HD = 64, DA = 512, DS = 512, NG = 32, GC = 16, NP = 64, NE = 32, DE = 256;
constexpr int DIN = 4104, OQ = 0, OK_ = 512, OV = 1024, OF = 1536, OU = 1544, OGA = 2056, OGS = 3080;
constexpr int LCH = 32, NCR = T / LCH;
constexpr int U2P = 640;
constexpr float EPS = 1e-6f;
constexpr float C2 = 0.125f * 1.4426950408889634f;
constexpr float LOG2E = 1.4426950408889634f;
constexpr int YROWS = 40960;

constexpr size_t MiB = 1u << 20;
constexpr size_t WS_CTL = 0, CTL_ZERO_BYTES = 1 * MiB;
constexpr size_t WS_CUM = 1 * MiB;
constexpr size_t WS_AL = 1 * MiB + 512 * 1024;
constexpr size_t WS_T0 = 1 * MiB + 768 * 1024;
constexpr size_t WS_PS = 252 * MiB;
constexpr size_t WS_PO = 229 * MiB;
constexpr size_t WS_RSTD = 2 * MiB;
constexpr size_t WS_ROUTE = 2 * MiB + 256 * 1024;
constexpr size_t WS_LIST = 3 * MiB;
constexpr size_t WS_WPOS = 5 * MiB;
constexpr size_t WS_SSP = 7 * MiB;
constexpr size_t WS_WIN = 8 * MiB;
constexpr size_t WS_SLOC = 8 * MiB;
constexpr size_t WS_WGLU = 16 * MiB, WS_WPA = 16 * MiB + 512 * 1024, WS_WPS = 17 * MiB + 512 * 1024, WS_WOUT = 18 * MiB + 512 * 1024, WS_WR = 20 * MiB + 512 * 1024;
constexpr size_t WS_M1T = 21 * MiB;
constexpr size_t WS_BTY = 29 * MiB;
constexpr size_t WS_XN = 49 * MiB;
constexpr size_t WS_WGU = 49 * MiB;
constexpr size_t WS_Q = 81 * MiB;
constexpr size_t WS_K = 97 * MiB;
constexpr size_t WS_V = 113 * MiB;
constexpr size_t WS_Y1 = 97 * MiB, WS_YS = 113 * MiB;
constexpr size_t WS_U2X = 129 * MiB;
constexpr size_t WS_GA = 149 * MiB;
constexpr size_t WS_GS = 181 * MiB;
constexpr size_t WS_X2B = 181 * MiB;
constexpr size_t WS_WD = 213 * MiB;
constexpr size_t WS_H = 229 * MiB;
constexpr size_t WS_RPOS = 249 * MiB;
constexpr size_t WS_KTG = 251 * MiB;
constexpr size_t WS_Y = 81 * MiB;
static_assert(WS_H + (size_t)YROWS * DE * 2 <= WS_RPOS && WS_RPOS + 2 * MiB <= WS_KTG && WS_KTG + MiB <= 256 * MiB && WS_Y + (size_t)YROWS * D * 2 <= WS_GS, "d_ws map");

__device__ __forceinline__ bf16 f2bf(float f) { unsigned u = __builtin_bit_cast(unsigned, f); return (bf16)((u + 0x7fffu + ((u >> 16) & 1u)) >> 16); }
__device__ __forceinline__ float bf2f(bf16 b) { return __builtin_bit_cast(float, (unsigned)b << 16); }
__device__ __forceinline__ float sigmoidf_(float x) { return 1.f / (1.f + __expf(-x)); }
__device__ __forceinline__ float gelu_tanh(float x) { const float z = 0.7978845608028654f * (x + 0.044715f * x * x * x); const float e = __expf(2.f * z); return 0.5f * x * (1.f + (1.f - 2.f / (e + 1.f))); }
__device__ __forceinline__ float log_sigmoid(float x) { return -(fmaxf(-x, 0.f) + log1pf(__expf(-fabsf(x)))); }
__device__ __forceinline__ size_t u2x_index(int g, int t, int c) { return ((size_t)g * NCR + (t / LCH)) * U2P + 128 + (t % LCH) * GC + c; }

#define LAS __attribute__((address_space(3)))
#define GAS __attribute__((address_space(1)))
typedef short bf16x8 __attribute__((ext_vector_type(8)));
typedef float f32x4 __attribute__((ext_vector_type(4)));
typedef float f32x2 __attribute__((ext_vector_type(2)));
typedef unsigned u32x4 __attribute__((ext_vector_type(4)));
typedef unsigned u32x2 __attribute__((ext_vector_type(2)));
namespace pg {
constexpr int BM = 256, BK = 64, HALF = 128, HTB = HALF * BK * 2, STAGE_BYTES = 8 * HTB, NXCD = 8, WGM = 8;
__host__ __device__ __forceinline__ int lds_byte(int r, int c) { const int st = (r >> 4) * 2 + (c >> 5), rr = r & 15, cc = c & 31, ob = rr * 64 + cc * 2; return st * 1024 + (ob ^ (((ob >> 9) & 1) << 5)); }
__host__ __device__ __forceinline__ void stage_rc(int b, int& R, int& C) { const int st = b / 1024, sb = b % 1024, swz = sb ^ (((sb >> 9) & 1) << 5); R = (st >> 1) * 16 + swz / 64; C = (st & 1) * 32 + (swz % 64) / 2; }
__host__ __device__ __forceinline__ int perm32(int rho) { const int n = rho >> 4, i = rho & 15; return 8 * (i >> 2) + 4 * n + (i & 3); }
typedef __bf16 bf16x2_t __attribute__((ext_vector_type(2)));
__device__ __forceinline__ unsigned cvt_pk_bf16(float lo, float hi) { const f32x2 v = {lo, hi}; const bf16x2_t b = __builtin_convertvector(v, bf16x2_t); return __builtin_bit_cast(unsigned, b); }
__device__ __forceinline__ u32x4 pack8(const f32x4& a, const f32x4& b) { u32x4 w; w.x = cvt_pk_bf16(a[0], a[1]); w.y = cvt_pk_bf16(a[2], a[3]); w.z = cvt_pk_bf16(b[0], b[1]); w.w = cvt_pk_bf16(b[2], b[3]); return w; }
__device__ __forceinline__ void unpack8(const u32x4& w, f32x4& a, f32x4& b) {
    a[0] = __builtin_bit_cast(float, w.x << 16); a[1] = __builtin_bit_cast(float, w.x & 0xffff0000u); a[2] = __builtin_bit_cast(float, w.y << 16); a[3] = __builtin_bit_cast(float, w.y & 0xffff0000u);
    b[0] = __builtin_bit_cast(float, w.z << 16); b[1] = __builtin_bit_cast(float, w.z & 0xffff0000u); b[2] = __builtin_bit_cast(float, w.w << 16); b[3] = __builtin_bit_cast(float, w.w & 0xffff0000u); }
__device__ __forceinline__ float fsigmoid(float x) { return __builtin_amdgcn_rcpf(1.f + __builtin_amdgcn_exp2f(-1.4426950408889634f * x)); }

struct Unit { const char* A; const char* B; int nt; int pm, pn, aux; };

struct StaticOrder {
    int nM, nN, nwg, G, c;
    __device__ void init(int nM_, int nN_, int G_, int c_) { nM = nM_; nN = nN_; nwg = nM * nN; G = G_; c = c_; }
    __device__ bool next(int i, int& pm, int& pn) const {
        const long L = (long)i * G + c; if (L >= nwg) return false;
        int wgid = (int)L; { const int q = nwg / NXCD, r = nwg % NXCD, xcd = wgid % NXCD, off = wgid / NXCD; wgid = (xcd < r ? xcd * (q + 1) : r * (q + 1) + (xcd - r) * q) + off; }
        const int nig = WGM * nN, gid = wgid / nig, fm = gid * WGM, gsz = (nM - fm) < WGM ? (nM - fm) : WGM;
        pm = fm + ((wgid % nig) % gsz); pn = (wgid % nig) / gsz; return true;
    }
};

template <class P>
__device__ __forceinline__ void gemm_phase(LAS unsigned char* lds, P& ph) {
    const int tid = threadIdx.x, wid = __builtin_amdgcn_readfirstlane(tid >> 6), lane = tid & 63, wr = wid >> 2, wc = wid & 3, fr = lane & 15, fq = lane >> 4;
    const unsigned lda = ph.lda, ldb = ph.ldb;
    int Rr[2], Cc[2]; unsigned voffB[2], vo[2][2], nvo[2][2];
#pragma unroll
    for (int i = 0; i < 2; ++i) { stage_rc(tid * 16 + i * 8192, Rr[i], Cc[i]); const int Rb = (Rr[i] & ~31) + perm32(Rr[i] & 31); voffB[i] = (unsigned)Rb * ldb + (unsigned)Cc[i] * 2u; }
    const size_t kstep = (size_t)(BK * 2);
    const size_t hstepB = (size_t)HALF * ldb;
    const unsigned ldsw = (unsigned)wid * 1024u;
    const int aoff = lds_byte(wr * 64 + fr, fq * 8), boff = lds_byte(wc * 32 + fr, fq * 8);
#define PG_SA(b, h) (((b) * 2 + (h)) * HTB)
#define PG_SB(b, h) ((4 + (b) * 2 + (h)) * HTB)
#define PG_STAGE_B(bufoff, gbase) do { _Pragma("unroll") for (int _i = 0; _i < 2; ++_i) \
        __builtin_amdgcn_global_load_lds((const unsigned*)((const char*)(gbase) + voffB[_i]), (LAS unsigned*)(lds + (bufoff) + ldsw + _i * 8192), 16, 0, 0); } while (0)
#define PG_STAGE_A(bufoff, gbase, VO, h) do { _Pragma("unroll") for (int _i = 0; _i < 2; ++_i) \
        __builtin_amdgcn_global_load_lds((const unsigned*)((const char*)(gbase) + (VO)[h][_i]), (LAS unsigned*)(lds + (bufoff) + ldsw + _i * 8192), 16, 0, 0); } while (0)
#define PG_LDA(dst, b, h) do { _Pragma("unroll") for (int m = 0; m < 4; ++m) _Pragma("unroll") for (int k = 0; k < 2; ++k) dst[m][k] = *(const LAS bf16x8*)(lds + PG_SA(b, h) + aoff + m * 2048 + k * 1024); } while (0)
#define PG_LDB(dst, b, h) do { _Pragma("unroll") for (int n = 0; n < 2; ++n) _Pragma("unroll") for (int k = 0; k < 2; ++k) dst[n][k] = *(const LAS bf16x8*)(lds + PG_SB(b, h) + boff + n * 2048 + k * 1024); } while (0)
#define PG_MMA(ai, bj, At, Bt) do { __builtin_amdgcn_s_setprio(1); _Pragma("unroll") for (int m = 0; m < 4; ++m) _Pragma("unroll") for (int n = 0; n < 2; ++n) _Pragma("unroll") for (int k = 0; k < 2; ++k) \
        acc[ai][bj][m][n] = __builtin_amdgcn_mfma_f32_16x16x32_bf16(Bt[n][k], At[m][k], acc[ai][bj][m][n], 0, 0, 0); __builtin_amdgcn_s_setprio(0); } while (0)
#define PG_WAIT_V(n) asm volatile("s_waitcnt vmcnt(" #n ")" ::: "memory")
#define PG_WAIT_L(n) asm volatile("s_waitcnt lgkmcnt(" #n ")" ::: "memory")
#define PG_BAR __builtin_amdgcn_s_barrier()
#define PG_SCHED __builtin_amdgcn_sched_barrier(0)
    Unit cur, nxt; int ui = 0;
    if (!ph.next(0, cur)) return;
    ph.offs(cur, Rr, Cc, vo);
    f32x4 acc[2][2][4][2];
#pragma unroll
    for (int a = 0; a < 2; ++a)
#pragma unroll
        for (int b = 0; b < 2; ++b)
#pragma unroll
            for (int m = 0; m < 4; ++m)
#pragma unroll
                for (int n = 0; n < 2; ++n) acc[a][b][m][n] = (f32x4){0.f, 0.f, 0.f, 0.f};
    bf16x8 At[4][2], B0[2][2], B1[2][2];
    const char* cA = cur.A; const char* cB = cur.B;
    PG_STAGE_B(PG_SB(0, 0), cB); PG_STAGE_B(PG_SB(0, 1), cB + hstepB); PG_STAGE_A(PG_SA(0, 0), cA, vo, 0); PG_STAGE_A(PG_SA(0, 1), cA, vo, 1);
    if (wr == 1) PG_BAR;
    PG_WAIT_V(2); PG_BAR;
    PG_STAGE_B(PG_SB(1, 0), cB + kstep); PG_STAGE_A(PG_SA(1, 0), cA + kstep, vo, 0); PG_STAGE_B(PG_SB(1, 1), cB + hstepB + kstep);
    PG_WAIT_V(6); PG_BAR;
    for (;;) {
        const bool has_next = ph.next(ui + 1, nxt);
        const int nt = cur.nt;
        const char* nA = has_next ? nxt.A : cA; const char* nB = has_next ? nxt.B : cB;
        if (P::GATHER) { if (has_next) ph.offs(nxt, Rr, Cc, nvo); else {
#pragma unroll
            for (int h = 0; h < 2; ++h)
#pragma unroll
                for (int i = 0; i < 2; ++i) nvo[h][i] = vo[h][i]; } }
#pragma unroll 1
        for (int t = 0; t < nt; t += 2) {
            const bool last = (t == nt - 2);
            const char* a1 = cA + (size_t)(t + 1) * kstep;
            const char* a2 = last ? nA : cA + (size_t)(t + 2) * kstep; const char* b2 = last ? nB : cB + (size_t)(t + 2) * kstep;
            const char* a3 = a2 + kstep; const char* b3 = b2 + kstep;
            unsigned v2[2][2];
#pragma unroll
            for (int h = 0; h < 2; ++h)
#pragma unroll
                for (int i = 0; i < 2; ++i) v2[h][i] = (P::GATHER && last) ? nvo[h][i] : vo[h][i];
            PG_LDB(B0, 0, 0); PG_LDB(B1, 0, 1); PG_SCHED; PG_LDA(At, 0, 0); PG_STAGE_A(PG_SA(1, 1), a1, vo, 1);
            PG_WAIT_V(8); PG_WAIT_L(0); PG_BAR; PG_MMA(0, 0, At, B0); PG_MMA(0, 1, At, B1); PG_BAR; PG_SCHED;
            PG_LDA(At, 0, 1); PG_STAGE_B(PG_SB(0, 0), b2); PG_STAGE_B(PG_SB(0, 1), b2 + hstepB); PG_STAGE_A(PG_SA(0, 0), a2, v2, 0);
            PG_WAIT_V(8); PG_WAIT_L(0); PG_BAR; PG_MMA(1, 0, At, B0); PG_MMA(1, 1, At, B1); PG_BAR; PG_SCHED;
            PG_LDB(B0, 1, 0); PG_LDB(B1, 1, 1); PG_SCHED; PG_LDA(At, 1, 0); PG_STAGE_A(PG_SA(0, 1), a2, v2, 1);
            PG_WAIT_V(8); PG_WAIT_L(0); PG_BAR; PG_MMA(0, 0, At, B0); PG_MMA(0, 1, At, B1); PG_BAR; PG_SCHED;
            PG_LDA(At, 1, 1); PG_STAGE_B(PG_SB(1, 0), b3); PG_STAGE_B(PG_SB(1, 1), b3 + hstepB); PG_STAGE_A(PG_SA(1, 0), a3, v2, 0);
            PG_WAIT_V(8); PG_WAIT_L(0); PG_BAR; PG_MMA(1, 0, At, B0); PG_MMA(1, 1, At, B1); PG_BAR; PG_SCHED;
        }
        if (wr == 0) PG_BAR;
        ph.epi(acc, cur, wr, wc, fr, fq);
        if (!has_next) break;
#pragma unroll
        for (int a = 0; a < 2; ++a)
#pragma unroll
            for (int b = 0; b < 2; ++b)
#pragma unroll
                for (int m = 0; m < 4; ++m)
#pragma unroll
                    for (int n = 0; n < 2; ++n) acc[a][b][m][n] = (f32x4){0.f, 0.f, 0.f, 0.f};
        cur = nxt; cA = nA; cB = nB; ++ui;
        if (P::GATHER) {
#pragma unroll
            for (int h = 0; h < 2; ++h)
#pragma unroll
                for (int i = 0; i < 2; ++i) vo[h][i] = nvo[h][i]; }
        if (wr == 1) PG_BAR;
    }
    PG_WAIT_V(0);
    PG_BAR;
#undef PG_SA
#undef PG_SB
#undef PG_STAGE_A
#undef PG_STAGE_B
#undef PG_LDA
#undef PG_LDB
#undef PG_MMA
#undef PG_WAIT_V
#undef PG_WAIT_L
#undef PG_BAR
#undef PG_SCHED
}
__device__ __forceinline__ void offs_plain(unsigned lda, const int (&R)[2], const int (&C)[2], unsigned (&vo)[2][2]) {
#pragma unroll
    for (int h = 0; h < 2; ++h)
#pragma unroll
        for (int i = 0; i < 2; ++i) vo[h][i] = (unsigned)(h * HALF + R[i]) * lda + (unsigned)C[i] * 2u;
}
}

namespace attn_body {
using bf16=unsigned short;
using bf16x8=__attribute__((ext_vector_type(8)))short;
using s16x4=__attribute__((ext_vector_type(4)))short;
using f32x16=__attribute__((ext_vector_type(16)))float;
using u32x4=__attribute__((ext_vector_type(4)))unsigned;
constexpr int BATCH=2,NHEAD=8,SEQ=8192,D=64,DM=NHEAD*D;
constexpr int NW=8,QBLK=32,QB=QBLK*NW,KVBLK=64,NQB=SEQ/QB;
constexpr int ATTN_PITCH=DM, ATTN_UNIT_ROWS=QB;
__device__ __forceinline__ int crow(int r,int hi){return (r&3)+8*(r>>2)+4*hi;}
__device__ __forceinline__ unsigned short f2bf_a(float f){unsigned u=__builtin_bit_cast(unsigned,f);return (unsigned short)((u+0x7fffu+((u>>16)&1u))>>16);}
#define SBAR() __builtin_amdgcn_sched_barrier(0)
__device__ __forceinline__ void cmask(f32x16&p0,f32x16&p1,int jb,int qrel,int hi){
  const float NEG=-INFINITY; int kb=64*jb+4*hi;
  #pragma unroll
  for(int r=0;r<16;++r){int kv=kb+(r&3)+8*(r>>2); if(kv>qrel)p0[r]=NEG; if(kv+32>qrel)p1[r]=NEG;}
}

constexpr int NSLOT=3, SLOTB=8192;
constexpr int LDS_K=0, LDS_V=NSLOT*SLOTB, LDS_WS=2*NSLOT*SLOTB, LDS_OST=LDS_WS+NW*64*4, LDS_FK=LDS_OST+NW*4096, LDS_BYTES=LDS_FK+SEQ*4+1024;
constexpr float C2=0.125f*1.4426950408889634f;
__device__ __forceinline__ void glds16(const void*gsrc,unsigned lds_dst){unsigned keep;
  asm volatile("s_mov_b32 %0, m0\n\ts_mov_b32 m0, %2\n\ts_nop 0\n\tglobal_load_lds_dwordx4 %1, off\n\ts_mov_b32 m0, %0":"=&s"(keep):"v"(gsrc),"s"(lds_dst):"memory");}
__device__ __forceinline__ float max3f(float a,float b,float c){float r;asm("v_max3_f32 %0, %1, %2, %3":"=v"(r):"v"(a),"v"(b),"v"(c));return r;}
__device__ __forceinline__ float max2f(float a,float b){float r;asm("v_max_f32_e32 %0, %1, %2":"=v"(r):"v"(a),"v"(b));return r;}
__device__ __forceinline__ float fadd_s(float a,float b){float r;asm("v_add_f32_e32 %0, %1, %2":"=v"(r):"v"(a),"v"(b));return r;}
__device__ __forceinline__ float fsub_s(float a,float b){float r;asm("v_sub_f32_e32 %0, %1, %2":"=v"(r):"v"(a),"v"(b));return r;}
typedef float f32x4_t __attribute__((ext_vector_type(4)));
typedef float f32x2_t __attribute__((ext_vector_type(2))); typedef __bf16 bf16x2_t __attribute__((ext_vector_type(2)));
__device__ __forceinline__ unsigned cvtpk_s(float lo,float hi){f32x2_t v={lo,hi};bf16x2_t b=__builtin_convertvector(v,bf16x2_t);return __builtin_bit_cast(unsigned,b);}
#define WAIT_BAR(N) asm volatile("s_waitcnt vmcnt(" #N ") lgkmcnt(0)\n\ts_barrier":::"memory")

__device__ __forceinline__ void qkt(f32x16&p0,f32x16&p1,const char*Kslot,const bf16x8*qr,int r32,int hi){
  const char*kb=Kslot+hi*1024+r32*16;
  #pragma unroll
  for(int d0=0;d0<4;++d0){
    const bf16x8 b0=*reinterpret_cast<const bf16x8*>(kb+d0*2048);
    const bf16x8 b1=*reinterpret_cast<const bf16x8*>(kb+d0*2048+512);
    p0=__builtin_amdgcn_mfma_f32_32x32x16_bf16(b0,qr[d0],p0,0,0,0);p1=__builtin_amdgcn_mfma_f32_32x32x16_bf16(b1,qr[d0],p1,0,0,0);}
}
typedef __attribute__((address_space(3))) const char* lds_cptr;
typedef short v4i16_t __attribute__((ext_vector_type(4)));
__device__ __forceinline__ void kload8(bf16x8*kf,lds_cptr kp){
  kf[0]=*(const __attribute__((address_space(3))) bf16x8*)(kp);      kf[1]=*(const __attribute__((address_space(3))) bf16x8*)(kp+512);
  kf[2]=*(const __attribute__((address_space(3))) bf16x8*)(kp+2048); kf[3]=*(const __attribute__((address_space(3))) bf16x8*)(kp+2560);
  kf[4]=*(const __attribute__((address_space(3))) bf16x8*)(kp+4096); kf[5]=*(const __attribute__((address_space(3))) bf16x8*)(kp+4608);
  kf[6]=*(const __attribute__((address_space(3))) bf16x8*)(kp+6144); kf[7]=*(const __attribute__((address_space(3))) bf16x8*)(kp+6656);
}
__device__ __forceinline__ void kload2(bf16x8*kf,lds_cptr kp,int j){ kf[2*j]=*(const __attribute__((address_space(3))) bf16x8*)(kp+j*2048); kf[2*j+1]=*(const __attribute__((address_space(3))) bf16x8*)(kp+j*2048+512); }
__device__ __forceinline__ s16x4 vtr(lds_cptr p){ return __builtin_bit_cast(s16x4,__builtin_amdgcn_ds_read_tr16_b64_v4i16((__attribute__((address_space(3))) v4i16_t*)p)); }
__device__ __forceinline__ float rowmax(const f32x16&p0,const f32x16&p1){
  float a=max3f(p0[0],p0[1],p1[0]),b=max3f(p0[2],p0[3],p1[1]);a=max3f(a,p1[2],p1[3]);
  #pragma unroll
  for(int r=4;r<16;r+=4){a=max3f(a,p0[r],p0[r+1]);b=max3f(b,p0[r+2],p0[r+3]);a=max3f(a,p1[r],p1[r+1]);b=max3f(b,p1[r+2],p1[r+3]);}
  const float m=max2f(a,b);
  auto rr=__builtin_amdgcn_permlane32_swap(__float_as_uint(m),__float_as_uint(m),false,false);
  return max2f(__uint_as_float(rr[0]),__uint_as_float(rr[1]));
}
__device__ __forceinline__ void pv(f32x16*o,int vb,bf16x8 pa0,bf16x8 pa1,bf16x8 pa2,bf16x8 pa3){
  #pragma unroll
  for(int d0=0;d0<2;++d0){s16x4 lo[4],hi[4];
    #pragma unroll
    for(int ks=0;ks<4;++ks){
      asm volatile("ds_read_b64_tr_b16 %0,%1 offset:%c2":"=&v"(lo[ks]):"v"(vb),"i"(d0*4096+ks*1024):"memory");
      asm volatile("ds_read_b64_tr_b16 %0,%1 offset:%c2":"=&v"(hi[ks]):"v"(vb),"i"(d0*4096+ks*1024+512):"memory");}
    asm volatile("s_waitcnt lgkmcnt(0)":::"memory");SBAR();
    #define PK(k) (bf16x8){lo[k][0],lo[k][1],lo[k][2],lo[k][3],hi[k][0],hi[k][1],hi[k][2],hi[k][3]}
    o[d0]=__builtin_amdgcn_mfma_f32_32x32x16_bf16(pa0,PK(0),o[d0],0,0,0);
    o[d0]=__builtin_amdgcn_mfma_f32_32x32x16_bf16(pa1,PK(1),o[d0],0,0,0);
    o[d0]=__builtin_amdgcn_mfma_f32_32x32x16_bf16(pa2,PK(2),o[d0],0,0,0);
    o[d0]=__builtin_amdgcn_mfma_f32_32x32x16_bf16(pa3,PK(3),o[d0],0,0,0);
    #undef PK
  }
}

#ifndef ATTN_STORE16
#define ATTN_STORE16(p,v) (*(u32x4*)(p)=(v))
#endif
template<int THRL> __device__ __forceinline__ void attn_unit(int b,int h,int qb,int TB,int TE,int NTM,const bf16*Q,const bf16*__restrict__ K,const bf16*__restrict__ V,bf16*O,const float*__restrict__ CUM,bf16*PObase,float*PSbase,int slot,char*shm){
  const int tid=threadIdx.x,lane=tid&63,r32=lane&31,hi=lane>>5; const int wid=__builtin_amdgcn_readfirstlane(tid>>6);
  const long rowbase=(long)b*SEQ; const int q0=qb*QB;
  const bf16*Qw=Q+(rowbase+q0+wid*QBLK)*DM+h*D;
  const bf16*Kh=K+rowbase*DM+h*D,*Vh=V+rowbase*DM+h*D; const float*Fh=CUM+((long)b*NHEAD+h)*SEQ;
  const unsigned lds0=(unsigned)(uintptr_t)shm;
  float*wsf=(float*)(shm+LDS_WS)+wid*64;
  const unsigned koff=(unsigned)(lane*DM+wid*8)*2u;
  const unsigned voff=(unsigned)((16*(wid&3)+(lane>>2))*DM+(wid>>2)*32+(lane&3)*8)*2u;
  const unsigned kdst=lds0+LDS_K+wid*1024, vdst=lds0+LDS_V+wid*1024;
  #define DMA_K(t,slot) glds16((const char*)Kh+(long)(t)*(KVBLK*DM*2)+koff,(unsigned)__builtin_amdgcn_readfirstlane(kdst+(slot)))
  #define DMA_V(t,slot) glds16((const char*)Vh+(long)(t)*(KVBLK*DM*2)+voff,(unsigned)__builtin_amdgcn_readfirstlane(vdst+(slot)))
  const int vb0=(int)(lds0+LDS_V)+((lane>>4)&1)*32+(lane&3)*8+(4*hi+((lane&15)>>2))*64;
  const char*Kbase=shm+LDS_K; bf16x8 kf[8];
  const lds_cptr shm3=(lds_cptr)shm; const lds_cptr kp0=shm3+LDS_K+hi*1024+r32*16; const lds_cptr vp0=shm3+LDS_V+((lane>>4)&1)*32+(lane&3)*8+(4*hi+((lane&15)>>2))*64;
  const int NT=TE;
  for(int p_=wid+(TB>>2);p_<=((TE*KVBLK-1)>>8);p_+=NW) glds16(Fh+p_*256+lane*4,(unsigned)__builtin_amdgcn_readfirstlane(lds0+LDS_FK+p_*1024));
  DMA_K(TB,0);DMA_V(TB,0);DMA_K(TB+1,SLOTB);
  bf16x8 qr[4];
  #pragma unroll
  for(int d0=0;d0<4;++d0)qr[d0]=*reinterpret_cast<const bf16x8*>(&Qw[(long)r32*DM+d0*16+hi*8]);
  const float fq2=Fh[q0+wid*QBLK+r32];
  float mhat=0.f,l_reg=0.f;f32x16 o[2];o[0]=f32x16{};o[1]=f32x16{};float nb=fq2;
  const lds_cptr fkp=(lds_cptr)shm+LDS_FK+hi*16;
  const int qrel=wid*QBLK+r32;
  #define CMASK(P0,P1,t) do{int jb_=(t)-(NTM-4); if(jb_>=0)cmask(P0,P1,jb_,qrel,hi);}while(0)
  bool resc=false;
  #define START(P0,P1) do{ const float rm=rowmax(P0,P1); resc=false; \
    { const float dl=rm; mhat=fadd_s(mhat,dl); \
      _Pragma("unroll") for(int r=0;r<16;++r){P0[r]=fsub_s(P0[r],dl);P1[r]=fsub_s(P1[r],dl);} \
      nb=fsub_s(fq2,mhat); } \
    _Pragma("unroll") for(int r=0;r<16;++r)P0[r]=__builtin_amdgcn_exp2f(P0[r]); }while(0)
  #define RESC() do{ if(resc){ asm volatile("s_waitcnt lgkmcnt(0)":::"memory"); \
      _Pragma("unroll") for(int d_=0;d_<2;++d_) _Pragma("unroll") for(int r=0;r<16;++r)o[d_][r]*=wsf[crow(r,hi)]; } }while(0)
  #define FILLC(C0_,C1_,tt) do{ const lds_cptr f_=fkp+(tt)*256; _Pragma("unroll") for(int a_=0;a_<4;++a_){ const f32x4_t x0_=*(const __attribute__((address_space(3))) f32x4_t*)(f_+32*a_); const f32x4_t x1_=*(const __attribute__((address_space(3))) f32x4_t*)(f_+128+32*a_); \
      _Pragma("unroll") for(int i_=0;i_<4;++i_){ C0_[4*a_+i_]=nb-x0_[i_]; C1_[4*a_+i_]=nb-x1_[i_]; } } }while(0)
  f32x16 pA0,pA1,pB0,pB1;
  int sl_prev=0,sl_cur=0,sl_next=SLOTB;
  #define ROT() do{sl_prev=sl_cur;sl_cur=sl_next;sl_next=(sl_next==(NSLOT-1)*SLOTB)?0:sl_next+SLOTB;}while(0)
  DMA_K(TB+2,2*SLOTB);
  WAIT_BAR(3);
  FILLC(pA0,pA1,TB);
  qkt(pA0,pA1,Kbase,qr,r32,hi);asm volatile("s_nop 15\n\ts_nop 7":"+v"(pA0),"+v"(pA1));CMASK(pA0,pA1,TB);
  START(pA0,pA1);
  _Pragma("unroll") for(int r=0;r<16;++r)pA1[r]=__builtin_amdgcn_exp2f(pA1[r]);
  WAIT_BAR(0);
  DMA_K(TB+3,0);DMA_V(TB+1,SLOTB);
  ROT();
  FILLC(pB0,pB1,TB+1);
  kload8(kf,kp0+sl_cur);
  WAIT_BAR(2);
  s16x4 vlo[8],vhi[8]; u32x4 pw0,pw1,pw2,pw3;
  #define PKW(P,B) cvtpk_s(P[B],P[B+1])
  #define PAF(k) __builtin_bit_cast(bf16x8,pw##k)
  #define VFR(i) (bf16x8){vlo[i][0],vlo[i][1],vlo[i][2],vlo[i][3],vhi[i][0],vhi[i][1],vhi[i][2],vhi[i][3]}
  #define PIN(x) asm volatile("":"+v"(x))
  #define MX3(a,b,c) __builtin_fmaxf(__builtin_fmaxf((a),(b)),(c))
  #define GAPA(MF,A0,A1,A2,A3,W0,W1,PW) do{ MF; sacc+=A0; sacc+=A1; sacc+=A2; sacc+=A3; PIN(sacc); W0; W1; PIN(PW); SBAR(); }while(0)
  #define EX(v) __builtin_amdgcn_exp2f(v)
  #define FLD(off) (*(const __attribute__((address_space(3))) f32x4_t*)(fk_+(off)))
  #define GAPB(MF,X,B,PF,FC,FN,NOFF) do{ MF; X[B]=EX(X[B]); X[B+1]=EX(X[B+1]); X[B+2]=EX(X[B+2]); X[B+3]=EX(X[B+3]); PF[B]=nb-FC[0]; PF[B+1]=nb-FC[1]; PF[B+2]=nb-FC[2]; PF[B+3]=nb-FC[3]; FN=FLD(NOFF); PIN(X); PIN(PF); SBAR(); }while(0)
  #define VRD(i) do{ vlo[i]=vtr(vp_+(((i)>>2)*4096+((i)&3)*1024)); vhi[i]=vtr(vp_+(((i)>>2)*4096+((i)&3)*1024+512)); }while(0)
  #define KRD(G,j) do{ if(G){ kload2(kf,kp0+sl_next,j); SBAR(); } }while(0)
  #define STEP(C0,C1,P0,P1,t,GK,GV,GL) do{ SBAR(); \
    const lds_cptr vp_=vp0+sl_prev; \
    VRD(0); SBAR(); float sacc=(P0[0]+P0[1]); \
    GAPA(C0=__builtin_amdgcn_mfma_f32_32x32x16_bf16(kf[0],qr[0],C0,0,0,0), P0[2],P0[3],P0[4],P0[5],     pw0[0]=PKW(P0,0), pw0[1]=PKW(P0,2), pw0); \
    VRD(4); SBAR(); GAPA(C1=__builtin_amdgcn_mfma_f32_32x32x16_bf16(kf[1],qr[0],C1,0,0,0), P0[6],P0[7],P0[8],P0[9],     pw0[2]=PKW(P0,4), pw0[3]=PKW(P0,6), pw0); \
    VRD(1); SBAR(); GAPA(C0=__builtin_amdgcn_mfma_f32_32x32x16_bf16(kf[2],qr[1],C0,0,0,0),   P0[10],P0[11],P0[12],P0[13], pw1[0]=PKW(P0,8), pw1[1]=PKW(P0,10), pw1); \
    VRD(5); SBAR(); GAPA(C1=__builtin_amdgcn_mfma_f32_32x32x16_bf16(kf[3],qr[1],C1,0,0,0),   P0[14],P0[15],P1[0],P1[1],   pw1[2]=PKW(P0,12),pw1[3]=PKW(P0,14), pw1); \
    VRD(2); SBAR(); GAPA(C0=__builtin_amdgcn_mfma_f32_32x32x16_bf16(kf[4],qr[2],C0,0,0,0),   P1[2],P1[3],P1[4],P1[5],     pw2[0]=PKW(P1,0), pw2[1]=PKW(P1,2), pw2); \
    VRD(6); SBAR(); GAPA(C1=__builtin_amdgcn_mfma_f32_32x32x16_bf16(kf[5],qr[2],C1,0,0,0),   P1[6],P1[7],P1[8],P1[9],     pw2[2]=PKW(P1,4), pw2[3]=PKW(P1,6), pw2); \
    VRD(3); SBAR(); GAPA(C0=__builtin_amdgcn_mfma_f32_32x32x16_bf16(kf[6],qr[3],C0,0,0,0),   P1[10],P1[11],P1[12],P1[13], pw3[0]=PKW(P1,8), pw3[1]=PKW(P1,10), pw3); \
    VRD(7); SBAR(); GAPA(C1=__builtin_amdgcn_mfma_f32_32x32x16_bf16(kf[7],qr[3],C1,0,0,0),   P1[14],P1[15],0.f,0.f,       pw3[2]=PKW(P1,12),pw3[3]=PKW(P1,14), pw3); \
    l_reg+=sacc; \
    if(GK){DMA_K((t)+3,sl_cur);} if(GV){DMA_V((t)+1,sl_next);} \
    CMASK(C0,C1,t); \
    { float a=MX3(C0[0],C0[1],C1[0]),b=MX3(C0[2],C0[3],C1[1]); a=MX3(a,C1[2],C1[3]); \
      _Pragma("unroll") for(int r=4;r<16;r+=4){a=MX3(a,C0[r],C0[r+1]);b=MX3(b,C0[r+2],C0[r+3]);a=MX3(a,C1[r],C1[r+1]);b=MX3(b,C1[r+2],C1[r+3]);} \
      float rm=__builtin_fmaxf(a,b); { auto rr=__builtin_amdgcn_permlane32_swap(__float_as_uint(rm),__float_as_uint(rm),false,false); rm=__builtin_fmaxf(__uint_as_float(rr[0]),__uint_as_float(rr[1])); } \
      resc=false; \
      if(__builtin_expect(__any(rm>(float)THRL),0)){ const float dl=__builtin_fmaxf(rm,0.f); mhat+=dl; \
        _Pragma("unroll") for(int r=0;r<16;++r){C0[r]-=dl;C1[r]-=dl;} \
        nb=fq2-mhat; \
        const float f=__builtin_amdgcn_exp2f(-dl); l_reg*=f; if(hi==0)wsf[r32]=f; resc=true; } } \
    SBAR(); \
    const lds_cptr fk_=fkp+((t)+1)*256; f32x4_t fa_=FLD(0); SBAR(); \
    GAPB(o[0]=__builtin_amdgcn_mfma_f32_32x32x16_bf16(PAF(0),VFR(0),o[0],0,0,0), C0,0, P0,fa_,fa_,32); \
    GAPB(o[1]=__builtin_amdgcn_mfma_f32_32x32x16_bf16(PAF(0),VFR(4),o[1],0,0,0), C0,4, P0,fa_,fa_,64); \
    KRD(GL,0); GAPB(o[0]=__builtin_amdgcn_mfma_f32_32x32x16_bf16(PAF(1),VFR(1),o[0],0,0,0), C0,8, P0,fa_,fa_,96); \
    KRD(GL,1); GAPB(o[1]=__builtin_amdgcn_mfma_f32_32x32x16_bf16(PAF(1),VFR(5),o[1],0,0,0), C0,12, P0,fa_,fa_,128); \
    KRD(GL,2); GAPB(o[0]=__builtin_amdgcn_mfma_f32_32x32x16_bf16(PAF(2),VFR(2),o[0],0,0,0), C1,0, P1,fa_,fa_,160); \
    KRD(GL,3); GAPB(o[1]=__builtin_amdgcn_mfma_f32_32x32x16_bf16(PAF(2),VFR(6),o[1],0,0,0), C1,4, P1,fa_,fa_,192); \
    GAPB(o[0]=__builtin_amdgcn_mfma_f32_32x32x16_bf16(PAF(3),VFR(3),o[0],0,0,0), C1,8, P1,fa_,fa_,224); \
    GAPB(o[1]=__builtin_amdgcn_mfma_f32_32x32x16_bf16(PAF(3),VFR(7),o[1],0,0,0), C1,12, P1,fa_,fa_,224); \
    }while(0)
  int t=TB+1;
  #undef CMASK
  #define CMASK(P0,P1,t) do{}while(0)
  for(;t+5<NT;t+=2){
    STEP(pB0,pB1,pA0,pA1,t,true,true,true);     WAIT_BAR(2); RESC(); ROT();
    STEP(pA0,pA1,pB0,pB1,t+1,true,true,true);   WAIT_BAR(2); RESC(); ROT();
  }
  #undef CMASK
  #define CMASK(P0,P1,t) do{int jb_=(t)-(NTM-4); if(jb_>=0)cmask(P0,P1,jb_,qrel,hi);}while(0)
  #define ENDW(tt) do{ if((tt)+3<NT){WAIT_BAR(2);} else if((tt)+2<NT){WAIT_BAR(1);} else {WAIT_BAR(0);} }while(0)
  for(;t+1<NT;t+=2){
    STEP(pB0,pB1,pA0,pA1,t,(t+3<NT),(t+1<NT),(t+1<NT));       ENDW(t);   RESC(); ROT();
    STEP(pA0,pA1,pB0,pB1,t+1,(t+4<NT),(t+2<NT),(t+2<NT));     ENDW(t+1); RESC(); ROT();
  }
  STEP(pB0,pB1,pA0,pA1,NT-1,false,false,false); RESC();
  { float sacc=pB0[0]+pB0[1]; _Pragma("unroll") for(int r=2;r<16;++r)sacc+=pB0[r]; _Pragma("unroll") for(int r=0;r<16;++r)sacc+=pB1[r]; l_reg+=sacc;
    pw0=(u32x4){PKW(pB0,0),PKW(pB0,2),PKW(pB0,4),PKW(pB0,6)};pw1=(u32x4){PKW(pB0,8),PKW(pB0,10),PKW(pB0,12),PKW(pB0,14)};pw2=(u32x4){PKW(pB1,0),PKW(pB1,2),PKW(pB1,4),PKW(pB1,6)};pw3=(u32x4){PKW(pB1,8),PKW(pB1,10),PKW(pB1,12),PKW(pB1,14)};
    SBAR(); pv(o,vb0+sl_cur,PAF(0),PAF(1),PAF(2),PAF(3)); }
  #undef PKW
  #undef PAF
  #undef VFR
  #undef PIN
  #undef MX3
  #undef GAPA
  #undef GAPB
  #undef FLD
  #undef FILLC
  #undef EX
  #undef VRD
  #undef KRD
  #undef STEP
  #undef ENDW
  {auto rr=__builtin_amdgcn_permlane32_swap(__float_as_uint(l_reg),__float_as_uint(l_reg),false,false);l_reg=__uint_as_float(rr[0])+__uint_as_float(rr[1]);}
  const bool part=(slot!=1023); bf16*PO=PObase+(long)slot*(256*D); float*PS=PSbase+(long)slot*512;
  if(hi==0){wsf[32+r32]=part?1.f:l_reg; if(part){PS[(wid*QBLK+r32)*2]=mhat;PS[(wid*QBLK+r32)*2+1]=l_reg;}}asm volatile("s_waitcnt lgkmcnt(0)":::"memory");
  float rli[16];
  #pragma unroll
  for(int r=0;r<16;++r)rli[r]=__builtin_amdgcn_rcpf(wsf[32+crow(r,hi)]);
  bf16*Ow=part?PO+(long)(wid*QBLK)*D:O+(rowbase+q0+wid*QBLK)*DM+h*D; const long opitch=part?D:DM;
  { bf16*stg=(bf16*)(shm+LDS_OST)+wid*2048;
    #pragma unroll
    for(int r=0;r<16;++r){const int orow=crow(r,hi);
      #pragma unroll
      for(int d0=0;d0<2;++d0)stg[orow*64+d0*32+r32]=f2bf_a(o[d0][r]*rli[r]);}
    asm volatile("s_waitcnt lgkmcnt(0)":::"memory");
    #pragma unroll
    for(int i=0;i<4;++i){const int row=i*8+(lane>>3),ch=lane&7; const u32x4 v=*(const u32x4*)(stg+row*64+ch*8); ATTN_STORE16(Ow+(long)row*opitch+ch*8,v);} }
  asm volatile("s_waitcnt lgkmcnt(0)\n\ts_barrier":::"memory");
  #undef DMA_K
  #undef DMA_V
  #undef CMASK
  #undef START
  #undef RESC
  #undef ROT
}
constexpr int ATTN_LDS_BYTES=LDS_BYTES;
struct AttnTensors { const bf16* Q; const bf16* K; const bf16* V; bf16* O; const float* CUM; const int* T0; bf16* PO; float* PS; unsigned* qctr; };
constexpr int MAX_ITEMS=1408, PO_SLOTS=640;
__device__ __forceinline__ void unit_split(int Lt,int SEG,int&nseg,int&len){ nseg=(Lt+SEG-1)/SEG; len=2*(((Lt>>1)+nseg-1)/nseg); }
template<bool COMBINE> __device__ __forceinline__ int build_worklist(const int*T0,unsigned*wl,unsigned*tmp,int*sc){
  const int tid=threadIdx.x; const int qb=tid&31; const int t0=T0[tid]; const int Lt=4*qb+4-t0;
  __syncthreads();
  int SEG=40,nseg,len;
  for(int pass=0;pass<2;++pass){
    unit_split(Lt,SEG,nseg,len);
    sc[tid]=nseg; sc[512+tid]=nseg>1?nseg:0; sc[1024+tid]=nseg>1?1:0; __syncthreads();
    for(int o=1;o<512;o<<=1){ const int a=tid>=o?sc[tid-o]:0, c=tid>=o?sc[512+tid-o]:0, e=tid>=o?sc[1024+tid-o]:0; __syncthreads(); sc[tid]+=a; sc[512+tid]+=c; sc[1024+tid]+=e; __syncthreads(); }
    if(sc[1023]<=PO_SLOTS&&sc[511]<=MAX_ITEMS)break;
    __syncthreads(); SEG=64;
  }
  const int ioff=sc[tid]-nseg, poff=sc[512+tid]-(nseg>1?nseg:0), NI=sc[511], NS=sc[1535], sord=sc[1024+tid]-1;
  __syncthreads();
  if(COMBINE){ if(nseg>1)wl[sord]=(unsigned)tid|((unsigned)nseg<<9)|((unsigned)poff<<12); __syncthreads(); return NS; }
  for(int sgi=0;sgi<nseg;++sgi){ const int lb=t0+sgi*len, le=min(lb+len,4*qb+4); tmp[ioff+sgi]=(unsigned)tid|((unsigned)lb<<9)|((unsigned)((le-lb)>>1)<<16)|((unsigned)(nseg>1?poff+sgi:1023)<<22); }
  __syncthreads();
  { const int lane=tid&63,w=tid>>6,nch=(NI+63)>>6; int*hist=sc;
    for(int c=w;c<nch;c+=8){ const int i=c*64+lane; const int key=i<NI?(int)((tmp[i]>>16)&63u):0;
      for(int k=1;k<=32;++k){ const unsigned long long mk=__ballot(key==k); if(lane==0)hist[c*33+k]=__popcll(mk); } }
    __syncthreads();
    if(tid>=1&&tid<=32){ int run=0; for(int c=0;c<nch;++c){ const int v=hist[c*33+tid]; hist[c*33+tid]=run; run+=v; } sc[840+tid]=run; }
    __syncthreads();
    if(tid==0){ int run=0; for(int k=32;k>=1;--k){ sc[800+k]=run; run+=sc[840+k]; } }
    __syncthreads();
    for(int c=w;c<nch;c+=8){ const int i=c*64+lane; const int key=i<NI?(int)((tmp[i]>>16)&63u):0; int myr=0;
      for(int k=1;k<=32;++k){ const unsigned long long mk=__ballot(key==k); if(key==k)myr=__popcll(mk&((1ull<<lane)-1ull)); }
      if(i<NI)wl[sc[800+key]+hist[c*33+key]+myr]=tmp[i]; }
  }
  __syncthreads();
  return NI;
}
template<int THRL=8> __device__ __forceinline__ void attn_phase(char*lds,const AttnTensors&T,int vcu,int G){
  unsigned*wl=(unsigned*)(lds+LDS_BYTES); unsigned*tmp=wl+MAX_ITEMS; int*sc=(int*)lds;
  const int NI=build_worklist<false>(T.T0,wl,tmp,sc);
  volatile int*nxt=(volatile int*)(tmp);
  int idx=vcu;
  while(idx<NI){
    const unsigned it=wl[idx]; const int u=it&511,TB=(it>>9)&127,lenp=(it>>16)&63,slot=(it>>22)&1023;
    const int bh=u>>5,qb=u&31;
    attn_unit<THRL>(bh/NHEAD,bh%NHEAD,qb,TB,TB+2*lenp,4*qb+4,T.Q,T.K,T.V,T.O,T.CUM,T.PO,T.PS,slot,lds);
    if(threadIdx.x==0)*nxt=G+(int)__hip_atomic_fetch_add(T.qctr,1u,__ATOMIC_RELAXED,__HIP_MEMORY_SCOPE_AGENT);
    __syncthreads(); idx=*nxt; __syncthreads();
  }
}
__device__ __forceinline__ void attn_combine(char*lds,const AttnTensors&T,int wg,int nwg){
  unsigned*wl=(unsigned*)(lds+LDS_BYTES); unsigned*tmp=wl+MAX_ITEMS; int*sc=(int*)lds;
  const int NS=build_worklist<true>(T.T0,wl,tmp,sc);
  const int tid=threadIdx.x,row=tid>>1,ch=tid&1;
  for(int k=wg;k<NS;k+=nwg){ const unsigned it=wl[k]; const int u=it&511,nseg=(it>>9)&7,poff=(it>>12)&1023,bh=u>>5,qb=u&31,b=bh/NHEAD,h=bh%NHEAD;
    float m[4],l[4]; float M=-3.0e38f; u32x4 pv[4][4];
    #pragma unroll
    for(int sgi=0;sgi<4;++sgi){ m[sgi]=-3.0e38f; l[sgi]=0.f; const int sg=sgi<nseg?sgi:0;
      const float2 ml=*(const float2*)(T.PS+(long)(poff+sg)*512+row*2); if(sgi<nseg){m[sgi]=ml.x;l[sgi]=ml.y;} M=fmaxf(M,m[sgi]);
      const u32x4*p=(const u32x4*)(T.PO+(long)(poff+sg)*(256*D)+row*D+ch*32);
      #pragma unroll
      for(int q=0;q<4;++q)pv[sgi][q]=p[q]; }
    float acc[32]; float L=0.f;
    #pragma unroll
    for(int c=0;c<32;++c)acc[c]=0.f;
    #pragma unroll
    for(int sgi=0;sgi<4;++sgi){ const float w=sgi<nseg?__builtin_amdgcn_exp2f(m[sgi]-M):0.f; L+=w*l[sgi];
      #pragma unroll
      for(int q=0;q<4;++q){ const u32x4 v=pv[sgi][q];
        acc[8*q+0]+=w*__builtin_bit_cast(float,v.x<<16); acc[8*q+1]+=w*__builtin_bit_cast(float,v.x&0xffff0000u); acc[8*q+2]+=w*__builtin_bit_cast(float,v.y<<16); acc[8*q+3]+=w*__builtin_bit_cast(float,v.y&0xffff0000u);
        acc[8*q+4]+=w*__builtin_bit_cast(float,v.z<<16); acc[8*q+5]+=w*__builtin_bit_cast(float,v.z&0xffff0000u); acc[8*q+6]+=w*__builtin_bit_cast(float,v.w<<16); acc[8*q+7]+=w*__builtin_bit_cast(float,v.w&0xffff0000u); } }
    const float rl=1.f/L; bf16*op=T.O+((long)b*SEQ+qb*QB+row)*DM+h*D+ch*32;
    #pragma unroll
    for(int q=0;q<4;++q){ u32x4 w; w.x=cvtpk_s(acc[8*q]*rl,acc[8*q+1]*rl); w.y=cvtpk_s(acc[8*q+2]*rl,acc[8*q+3]*rl); w.z=cvtpk_s(acc[8*q+4]*rl,acc[8*q+5]*rl); w.w=cvtpk_s(acc[8*q+6]*rl,acc[8*q+7]*rl); *(u32x4*)(op+8*q)=w; }
  }
  __syncthreads();
}
#undef SBAR
#undef WAIT_BAR
}

constexpr int NWAVES = 8;
constexpr int RING_OFF = 0, RING_BYTES = 131072;
constexpr int LDSCTL_OFF = RING_BYTES, MISC_OFF = LDSCTL_OFF + 320;
constexpr int LDS_BYTES = 147456;
typedef GAS unsigned gu32;
#define RLX_AGENT __ATOMIC_RELAXED, __HIP_MEMORY_SCOPE_AGENT
#define LDS_WAIT() asm volatile("s_waitcnt lgkmcnt(0)" ::: "memory")
#define VM_WAIT() asm volatile("s_waitcnt vmcnt(0)" ::: "memory")
constexpr int CW_TMO = 0, CW_CODE = 1, CW_CNT = 64  , CW_Q0 = 128  , CW_BAR = 4096;

#define XB_TMO      128
#define XB_XCNT(j)  (256  + 64 * (j))
#define XB_XSUB(j)  (1280 + 64 * (j))
#define XB_XGEN(j)  (2304 + 64 * (j))
#define XB_TOP      3328
#define XB_TOPGEN   3392
#define XCD_BAR_WORDS 3456
#define XB_SPIN_CAP (1u << 18)
__device__ __forceinline__ unsigned xb_ld(unsigned* p)              { return __hip_atomic_load(p, __ATOMIC_RELAXED, __HIP_MEMORY_SCOPE_AGENT); }
__device__ __forceinline__ unsigned xb_add(unsigned* p, unsigned v) { return __hip_atomic_fetch_add(p, v, __ATOMIC_RELAXED, __HIP_MEMORY_SCOPE_AGENT); }
__device__ __forceinline__ unsigned xb_xcc_id() { return (unsigned)__builtin_amdgcn_s_getreg((3 << 11) | 20) & 0xFu; }
#define XB_SPIN(cond, bar) do { unsigned _sp = 0; while (cond) { __builtin_amdgcn_s_sleep(1); \
    if ((++_sp & 255u) == 0u) { if (xb_ld(&(bar)[XB_TMO])) break; if (_sp > XB_SPIN_CAP) { atomicAdd(&(bar)[XB_TMO], 1u); break; } } } } while (0)
struct XcdBarrier { unsigned* bar; unsigned x; volatile LAS unsigned* st; };
__device__ __forceinline__ XcdBarrier xcd_barrier_post(unsigned* bar, volatile LAS unsigned* st) {
    XcdBarrier b; b.bar = bar; b.x = xb_xcc_id(); b.st = st;
    if (threadIdx.x == 0) (void)xb_add(&bar[XB_XCNT(b.x)], 1u);
    return b;
}
__device__ __forceinline__ void xcd_barrier_complete(unsigned* bar, unsigned x, unsigned& nloc, unsigned& nx) {
    const unsigned G = gridDim.x * gridDim.y * gridDim.z;
    unsigned sum, cnt, mine, sp = 0u;
    for (;;) {
        sum = 0u; cnt = 0u; mine = 0u;
#pragma unroll
        for (unsigned j = 0; j < 16; ++j) { const unsigned c = xb_ld(&bar[XB_XCNT(j)]); sum += c; cnt += (c > 0u) ? 1u : 0u; mine = (j == x) ? c : mine; }
        if (sum == G) break;
        __builtin_amdgcn_s_sleep(1);
        if ((++sp & 255u) == 0u) { if (xb_ld(&bar[XB_TMO])) break; if (sp > XB_SPIN_CAP) { atomicAdd(&bar[XB_TMO], 1u); break; } }
    }
    nloc = mine > 0u ? mine : 1u; nx = cnt > 0u ? cnt : 1u;
}
__device__ __forceinline__ void xcd_barrier(const XcdBarrier& b) {
    asm volatile("s_waitcnt vmcnt(0)" ::: "memory");
    __syncthreads();
    if (threadIdx.x == 0) {
        unsigned* bar = b.bar;
        __builtin_amdgcn_s_waitcnt(0);
        unsigned nloc = b.st[0], nx = b.st[1];
        if (nloc == 0u) { xcd_barrier_complete(bar, b.x, nloc, nx); b.st[0] = nloc; b.st[1] = nx; }
        const unsigned old = xb_add(&bar[XB_XSUB(b.x)], 1u);
        const unsigned gen = old / nloc;
        if (old + 1u == (gen + 1u) * nloc) {
            __builtin_amdgcn_fence(__ATOMIC_RELEASE, "agent");
            asm volatile("s_waitcnt vmcnt(0)" ::: "memory");
            const unsigned og = xb_add(&bar[XB_TOP], 1u);
            const unsigned tg = og / nx;
            if (og + 1u == (tg + 1u) * nx) xb_add(&bar[XB_TOPGEN], 1u);
            else XB_SPIN(xb_ld(&bar[XB_TOPGEN]) == tg, bar);
            __builtin_amdgcn_fence(__ATOMIC_ACQUIRE, "agent");
            xb_add(&bar[XB_XGEN(b.x)], 1u);
            asm volatile("s_waitcnt vmcnt(0)" ::: "memory");
        } else {
            XB_SPIN(xb_ld(&bar[XB_XGEN(b.x)]) == gen, bar);
            __builtin_amdgcn_fence(__ATOMIC_ACQUIRE, "agent");
            asm volatile("s_waitcnt vmcnt(0)" ::: "memory");
        }
    }
    __syncthreads();
}

struct Args { const float* in[26]; float* out; unsigned char* ws; int ph_lo, ph_hi, sub, pad_; };
struct Frame {
    LAS unsigned char* lds; volatile LAS unsigned* MISC; gu32* ctl;
    int tid, lane, wave, vcu, G;
};
__device__ __forceinline__ float gelu_fast(float x) { const float z = 0.7978845608028654f * (x + 0.044715f * x * x * x); const float e = __builtin_amdgcn_exp2f(2.885390081777927f * z); return x - x * __builtin_amdgcn_rcpf(e + 1.f); }
__device__ __forceinline__ float wave_sum(float v) {
#pragma unroll
    for (int o = 1; o < 64; o <<= 1) v += __shfl_xor(v, o);
    return v;
}

struct ConvDesc { const float* W; int ldw, k0, scol; bf16* dst; int ldd; const float* kscale; };
__device__ __forceinline__ void conv_load(const ConvDesc& d, float (&v)[32], int lane) {
    const float* wp = d.W + (size_t)(d.k0 + (lane >> 5)) * d.ldw + d.scol + (lane & 31);
#pragma unroll
    for (int i = 0; i < 32; ++i) v[i] = wp[(size_t)(2 * i) * d.ldw];
}
__device__ __forceinline__ void conv_finish(const ConvDesc& d, float (&v)[32], LAS float* scr, int lane) {
    if (d.kscale) {
#pragma unroll
        for (int i = 0; i < 32; ++i) v[i] *= d.kscale[d.k0 + 2 * i + (lane >> 5)]; }
#pragma unroll
    for (int i = 0; i < 32; ++i) scr[(2 * i + (lane >> 5)) * 33 + (lane & 31)] = v[i];
    LDS_WAIT(); asm volatile("" ::: "memory");
    const int c = lane & 7;
#pragma unroll
    for (int j = 0; j < 4; ++j) { const int n = (lane >> 3) + 8 * j; const LAS float* s = scr + (8 * c) * 33 + n;
        u32x4 o; o.x = pg::cvt_pk_bf16(s[0 * 33], s[1 * 33]); o.y = pg::cvt_pk_bf16(s[2 * 33], s[3 * 33]); o.z = pg::cvt_pk_bf16(s[4 * 33], s[5 * 33]); o.w = pg::cvt_pk_bf16(s[6 * 33], s[7 * 33]);
        *(GAS u32x4*)(d.dst + (size_t)n * d.ldd + d.k0 + 8 * c) = o; }
    LDS_WAIT(); asm volatile("" ::: "memory");
}
__device__ __forceinline__ void conv_item(const float* W, int ldw, int k0, int scol, bf16* dst, int ldd, const float* kscale, LAS float* scr, int lane) {
    ConvDesc d{W, ldw, k0, scol, dst, ldd, kscale}; float v[32]; conv_load(d, v, lane); conv_finish(d, v, scr, lane);
}
__device__ __forceinline__ int inproj_src_col(int cp) { return cp < 1536 ? cp : (cp < 2048 ? cp + (OU - 1536) : (cp < 3072 ? cp + (OGA - 2048) : cp + (OGS - 3072))); }
__device__ __forceinline__ int inproj_dst_row(int cp) { const int t = cp & ~255, c = cp & 255, wc = c >> 6, bj = (c >> 5) & 1, j = c & 31; return t + 128 * bj + 32 * wc + j; }

__device__ __forceinline__ void p0_prologue(Frame& F, const Args& a) {
    unsigned char* ws = a.ws;
    LAS float* scr = (LAS float*)(F.lds + F.wave * 8704);
    LAS float* wf = (LAS float*)(F.lds + 73728);
    const int gw = F.vcu * NWAVES + F.wave, NGW = F.G * NWAVES;
    const float* w_in = a.in[2]; const int sub = a.sub;
    for (int i = F.tid; i < 8 * 1024; i += NWAVES * 64) { const int h = i >> 10, k = i & 1023; wf[i] = w_in[(size_t)k * DIN + OF + h]; }
    constexpr int I_IN = 16 * 128;
    for (int it = (sub & 1) ? gw : I_IN; it < I_IN; it += NGW) { const int kb = it >> 7, nb = it & 127, cp = nb * 32;
        conv_item(w_in, DIN, kb * 64, inproj_src_col(cp), (bf16*)(ws + WS_WIN) + (size_t)inproj_dst_row(cp) * D, D, nullptr, scr, F.lane); }
    __syncthreads();
    const float* x = a.in[0]; const float* g = a.in[1]; const float* bfg = a.in[3];
    bf16* XN = (bf16*)(ws + WS_XN); float* LOGF = (float*)(ws + WS_CUM);
    { int m = (sub & 2) ? gw : T; f32x4 v[4];
      if (m < T) { const GAS f32x4* xr = (const GAS f32x4*)(x + (size_t)m * D) + F.lane;
#pragma unroll
          for (int j = 0; j < 4; ++j) v[j] = xr[64 * j]; }
      while (m < T) {
        const int mn = m + NGW; f32x4 vn[4];
        if (mn < T) { const GAS f32x4* xr = (const GAS f32x4*)(x + (size_t)mn * D) + F.lane;
#pragma unroll
            for (int j = 0; j < 4; ++j) vn[j] = xr[64 * j]; }
        float s = 0.f;
#pragma unroll
        for (int j = 0; j < 4; ++j) s += (v[j].x * v[j].x + v[j].y * v[j].y) + (v[j].z * v[j].z + v[j].w * v[j].w);
        float f[8];
#pragma unroll
        for (int h = 0; h < 8; ++h) f[h] = 0.f;
        f32x4 xg[4];
#pragma unroll
        for (int j = 0; j < 4; ++j) { const f32x4 gg = *((const GAS f32x4*)g + 64 * j + F.lane); xg[j] = v[j] * gg;
#pragma unroll
            for (int h = 0; h < 8; ++h) { const f32x4 ww = *((const LAS f32x4*)(wf + h * 1024) + 64 * j + F.lane); f[h] += (xg[j].x * ww.x + xg[j].y * ww.y) + (xg[j].z * ww.z + xg[j].w * ww.w); } }
        const float rstd = rsqrtf(wave_sum(s) * (1.f / D) + EPS);
        float f4[4], f2[2], f1;
        { const bool up = F.lane >= 32;
#pragma unroll
          for (int i = 0; i < 4; ++i) { const float snd = up ? f[i] : f[4 + i], kp = up ? f[4 + i] : f[i]; f4[i] = kp + __shfl_xor(snd, 32); } }
        { const bool up = (F.lane & 16) != 0;
#pragma unroll
          for (int i = 0; i < 2; ++i) { const float snd = up ? f4[i] : f4[2 + i], kp = up ? f4[2 + i] : f4[i]; f2[i] = kp + __shfl_xor(snd, 16); } }
        { const bool up = (F.lane & 8) != 0; const float snd = up ? f2[0] : f2[1], kp = up ? f2[1] : f2[0]; f1 = kp + __shfl_xor(snd, 8); }
        f1 += __shfl_xor(f1, 4); f1 += __shfl_xor(f1, 2); f1 += __shfl_xor(f1, 1);
        GAS u32x2* o8 = (GAS u32x2*)(XN + (size_t)m * D) + F.lane;
#pragma unroll
        for (int j = 0; j < 4; ++j) { const f32x4 xn = xg[j] * rstd; u32x2 w; w.x = pg::cvt_pk_bf16(xn.x, xn.y); w.y = pg::cvt_pk_bf16(xn.z, xn.w); o8[64 * j] = w; }
        if ((F.lane & 7) == 0) { const int hh = F.lane >> 3, b = m / SEQ, sidx = m % SEQ; LOGF[((size_t)b * NH + hh) * SEQ + sidx] = log_sigmoid(f1 * rstd + bfg[hh]); }
#pragma unroll
        for (int j = 0; j < 4; ++j) v[j] = vn[j];
        m = mn;
      } }
    if ((sub & 4) && F.G == 256) {
        __syncthreads();
        const int g = F.vcu >> 3, q = F.vcu & 7;
        LAS f32x2* PW = (LAS f32x2*)(F.lds);
        LAS f32x2* BB = (LAS f32x2*)(F.lds + 16896);
        LAS f32x2* CT = (LAS f32x2*)(F.lds + 16896 + 8192);
        LAS float* KT = (LAS float*)(F.lds + 16896 + 16384);
        const float* A_re = a.in[6]; const float* A_im = a.in[7]; const float* log_dt = a.in[8]; const float* B_re = a.in[9]; const float* B_im = a.in[10]; const float* C_re = a.in[11]; const float* C_im = a.in[12];
        if (F.tid < NP) { const int p = F.tid;
            const double dt = exp((double)log_dt[g]), ar = A_re[g * NP + p], ai = A_im[g * NP + p];
            const double er = exp(ar * dt), abr = er * cos(ai * dt), abi = er * sin(ai * dt);
            const double nr = abr - 1.0, ni = abi, den = ar * ar + ai * ai, fr_ = (nr * ar + ni * ai) / den, fi_ = (ni * ar - nr * ai) / den;
            double pr = 1.0, pi = 0.0;
            for (int tau = 0; tau <= LCH; ++tau) { PW[tau * NP + p] = (f32x2){(float)pr, (float)pi}; const double t2 = pr * abr - pi * abi; pi = pr * abi + pi * abr; pr = t2; }
            if (q == 0) { ((float*)(ws + WS_AL))[(g * NP + p) * 2] = PW[LCH * NP + p].x; ((float*)(ws + WS_AL))[(g * NP + p) * 2 + 1] = PW[LCH * NP + p].y; }
            for (int c = 0; c < GC; ++c) { const double br = B_re[(g * NP + p) * GC + c], bi = B_im[(g * NP + p) * GC + c]; BB[p * GC + c] = (f32x2){(float)(fr_ * br - fi_ * bi), (float)(fr_ * bi + fi_ * br)}; } }
        for (int i = F.tid; i < GC * NP; i += NWAVES * 64) { const int c = i >> 6, p = i & 63; CT[p * GC + c] = (f32x2){C_re[g * GC * NP + i], C_im[g * GC * NP + i]}; }
        __syncthreads();
        { float* KTG = (float*)(ws + WS_KTG) + (size_t)g * LCH * GC * GC;
          for (int i = 4 * q * GC * GC + F.tid; i < (4 * q + 4) * GC * GC; i += NWAVES * 64) { const int tau = i >> 8, co = (i >> 4) & 15, ci = i & 15; float acc = 0.f;
#pragma unroll 4
              for (int p = 0; p < NP; ++p) { const f32x2 w = PW[tau * NP + p], b = BB[p * GC + ci], c = CT[p * GC + co]; const float wr_ = w.x * b.x - w.y * b.y, wi_ = w.x * b.y + w.y * b.x; acc += c.x * wr_ - c.y * wi_; }
              KTG[i] = acc; } }
        {
          const int n = 64 * q + (F.tid >> 3), part = F.tid & 7, j = n >> 4, co = n & 15; bf16* row = (bf16*)(ws + WS_BTY) + ((size_t)g * 512 + n) * U2P;
          auto bval = [&](int k) -> float { const int p = k & 63; const f32x2 w = PW[(j + 1) * NP + p], c = CT[p * GC + co]; return k < 64 ? (c.x * w.x - c.y * w.y) : -(c.x * w.y + c.y * w.x); };
#pragma unroll 1
          for (int it = 0; it < 2; ++it) { const int k = (it * 8 + part) * 8;
              u32x4 o; o.x = pg::cvt_pk_bf16(bval(k), bval(k + 1)); o.y = pg::cvt_pk_bf16(bval(k + 2), bval(k + 3)); o.z = pg::cvt_pk_bf16(bval(k + 4), bval(k + 5)); o.w = pg::cvt_pk_bf16(bval(k + 6), bval(k + 7)); *(GAS u32x4*)(row + k) = o; } }
        {
          const int n = 32 * q + (F.tid >> 4), part = F.tid & 15; bf16* row = (bf16*)(ws + WS_M1T) + ((size_t)g * 256 + n) * 512;
          auto mval = [&](int k) -> float { const int j = k >> 4, ci = k & 15; float x = 0.f;
              if (n < 128) { const int p = n & 63; const f32x2 w = PW[(LCH - 1 - j) * NP + p], b = BB[p * GC + ci]; x = n < 64 ? (w.x * b.x - w.y * b.y) : (w.x * b.y + w.y * b.x); }
              return x; };
#pragma unroll 1
          for (int it = 0; it < 4; ++it) { const int k = (it * 16 + part) * 8;
              u32x4 o; o.x = pg::cvt_pk_bf16(mval(k), mval(k + 1)); o.y = pg::cvt_pk_bf16(mval(k + 2), mval(k + 3)); o.z = pg::cvt_pk_bf16(mval(k + 4), mval(k + 5)); o.w = pg::cvt_pk_bf16(mval(k + 6), mval(k + 7)); *(GAS u32x4*)(row + k) = o; } }
    }
}

__device__ __forceinline__ void p1_cumsum(Frame& F, float* CUM, int* T0, const float* gq, const float* gk) {
    LAS double* part = (LAS double*)(F.lds);
    float* p = CUM + (size_t)blockIdx.x * SEQ + F.tid * 16;
    f32x4 v[4]; float run[16]; float a = 0.f;
#pragma unroll
    for (int j = 0; j < 4; ++j) v[j] = ((const GAS f32x4*)p)[j];
#pragma unroll
    for (int j = 0; j < 4; ++j) { a += v[j].x; run[4 * j] = a; a += v[j].y; run[4 * j + 1] = a; a += v[j].z; run[4 * j + 2] = a; a += v[j].w; run[4 * j + 3] = a; }
    part[F.tid] = (double)a;
    __syncthreads();
    if (F.tid < 64) { double loc[8]; double s = 0.0;
#pragma unroll
        for (int i = 0; i < 8; ++i) { loc[i] = s; s += part[F.tid * 8 + i]; }
        double incl = s;
#pragma unroll
        for (int o = 1; o < 64; o <<= 1) { const double t = __shfl_up(incl, o); if (F.lane >= o) incl += t; }
        const double excl = incl - s;
#pragma unroll
        for (int i = 0; i < 8; ++i) part[F.tid * 8 + i] = excl + loc[i]; }
    __syncthreads();
    const double base = part[F.tid];
#pragma unroll
    for (int j = 0; j < 4; ++j) { f32x4 o; o.x = (float)((base + (double)run[4 * j]) * 1.4426950408889634); o.y = (float)((base + (double)run[4 * j + 1]) * 1.4426950408889634);
        o.z = (float)((base + (double)run[4 * j + 2]) * 1.4426950408889634); o.w = (float)((base + (double)run[4 * j + 3]) * 1.4426950408889634); ((GAS f32x4*)p)[j] = o; }
    __syncthreads();
    asm volatile("s_waitcnt vmcnt(0)" ::: "memory"); __syncthreads();
    if (F.tid < 32) { float gqm = 0.f, gkm = 0.f; for (int i = 0; i < HD; ++i) { gqm = fmaxf(gqm, fabsf(gq[i])); gkm = fmaxf(gkm, fabsf(gk[i])); }
        const float thr = 2.f * 64.f * C2 * gqm * gkm + 37.f; const int qb = F.tid, NTu = 4 * qb + 4;
        const unsigned* cu = (const unsigned*)(CUM + (size_t)blockIdx.x * SEQ);
        const float fq0 = __builtin_bit_cast(float, __hip_atomic_load(cu + qb * 256, __ATOMIC_RELAXED, __HIP_MEMORY_SCOPE_AGENT));
        int lo = 0, hi = NTu - 1;
        while (lo < hi) { const int mid = (lo + hi) >> 1; const float fk = __builtin_bit_cast(float, __hip_atomic_load(cu + 64 * mid + 63, __ATOMIC_RELAXED, __HIP_MEMORY_SCOPE_AGENT)); if (fq0 - fk >= -thr) hi = mid; else lo = mid + 1; }
        int t0 = lo & ~1; t0 = t0 > NTu - 4 ? NTu - 4 : t0; T0[blockIdx.x * 32 + qb] = t0; }
    __syncthreads();
}
struct PhInProj {
    static constexpr bool GATHER = false;
    unsigned lda, ldb; const char* A; const char* B; pg::StaticOrder so;
    bf16 *Q, *K, *V, *U2X, *GA, *GS; const float *gq, *gk;
    __device__ __forceinline__ bool next(int i, pg::Unit& u) const { int pm, pn; if (!so.next(i, pm, pn)) return false; u.A = A + (size_t)pm * 256 * lda; u.B = B + (size_t)pn * 256 * ldb; u.nt = D / 64; u.pm = pm; u.pn = pn; u.aux = 0; return true; }
    __device__ __forceinline__ void offs(const pg::Unit&, const int (&R)[2], const int (&C)[2], unsigned (&vo)[2][2]) const { pg::offs_plain(lda, R, C, vo); }
    __device__ __forceinline__ void epi(const f32x4 (&acc)[2][2][4][2], const pg::Unit& u, int wr, int wc, int fr, int fq) const {
        const int pn = u.pn, row0 = u.pm * 256 + wr * 64 + fr;
        if (pn < 4) {
            const bool isq = pn < 2; const float* g = isq ? gq : gk; bf16* O = isq ? Q : K; const int cb = (pn & 1) * 256 + 64 * wc + 8 * fq; const float sc = isq ? C2 : 1.f;
            f32x4 gv[2][2];
#pragma unroll
            for (int bj = 0; bj < 2; ++bj)
#pragma unroll
                for (int n = 0; n < 2; ++n) gv[bj][n] = *(const f32x4*)(g + 32 * bj + 8 * fq + 4 * n) * sc;
#pragma unroll
            for (int ai = 0; ai < 2; ++ai)
#pragma unroll
                for (int m = 0; m < 4; ++m) { float ss = 0.f;
#pragma unroll
                    for (int bj = 0; bj < 2; ++bj)
#pragma unroll
                        for (int n = 0; n < 2; ++n) { const f32x4 v = acc[ai][bj][m][n]; ss += (v[0] * v[0] + v[1] * v[1]) + (v[2] * v[2] + v[3] * v[3]); }
                    ss += __shfl_xor(ss, 16); ss += __shfl_xor(ss, 32);
                    const float rstd = rsqrtf(ss * (1.f / 64.f) + EPS);
                    bf16* rowp = O + (size_t)(row0 + ai * 128 + m * 16) * DA + cb;
#pragma unroll
                    for (int bj = 0; bj < 2; ++bj) *(u32x4*)(rowp + 32 * bj) = pg::pack8(acc[ai][bj][m][0] * rstd * gv[bj][0], acc[ai][bj][m][1] * rstd * gv[bj][1]); }
        } else if (pn < 6) {
            const int cb = (pn - 4) * 256 + 64 * wc + 8 * fq;
#pragma unroll
            for (int ai = 0; ai < 2; ++ai)
#pragma unroll
                for (int m = 0; m < 4; ++m) { bf16* rowp = V + (size_t)(row0 + ai * 128 + m * 16) * DA + cb;
#pragma unroll
                    for (int bj = 0; bj < 2; ++bj) *(u32x4*)(rowp + 32 * bj) = pg::pack8(acc[ai][bj][m][0], acc[ai][bj][m][1]); }
        } else if (pn < 8) {
#pragma unroll
            for (int ai = 0; ai < 2; ++ai)
#pragma unroll
                for (int m = 0; m < 4; ++m) { const int row = row0 + ai * 128 + m * 16;
#pragma unroll
                    for (int bj = 0; bj < 2; ++bj) { const int cu = (pn - 6) * 256 + 64 * wc + 32 * bj + 8 * fq;
                        *(u32x4*)(U2X + u2x_index(cu >> 4, row, cu & 15)) = pg::pack8(acc[ai][bj][m][0], acc[ai][bj][m][1]); } }
        } else {
            bf16* G = pn < 12 ? GA : GS; const int cb = ((pn - 8) & 3) * 256 + 64 * wc + 8 * fq;
#pragma unroll
            for (int ai = 0; ai < 2; ++ai)
#pragma unroll
                for (int m = 0; m < 4; ++m) { bf16* rowp = G + (size_t)(row0 + ai * 128 + m * 16) * D + cb;
#pragma unroll
                    for (int bj = 0; bj < 2; ++bj) { f32x4 a = acc[ai][bj][m][0], b = acc[ai][bj][m][1];
#pragma unroll
                        for (int e = 0; e < 4; ++e) { a[e] = pg::fsigmoid(a[e]); b[e] = pg::fsigmoid(b[e]); }
                        *(u32x4*)(rowp + 32 * bj) = pg::pack8(a, b); } }
        }
    }
};

struct PhGlu {
    static constexpr bool GATHER = false;
    unsigned lda, ldb; const char* A; const char* B; pg::StaticOrder so; const bf16* Y1; bf16* YS;
    __device__ __forceinline__ bool next(int i, pg::Unit& u) const { int pm, pn; if (!so.next(i, pm, pn)) return false; u.A = A + (size_t)pm * 256 * lda; u.B = B + (size_t)pn * 256 * ldb; u.nt = DS / 64; u.pm = pm; u.pn = pn; u.aux = 0; return true; }
    __device__ __forceinline__ void offs(const pg::Unit&, const int (&R)[2], const int (&C)[2], unsigned (&vo)[2][2]) const { pg::offs_plain(lda, R, C, vo); }
    __device__ __forceinline__ void epi(const f32x4 (&acc)[2][2][4][2], const pg::Unit& u, int wr, int wc, int fr, int fq) const {
        const int row0 = u.pm * 256 + wr * 64 + fr, cb = u.pn * 256 + 32 * wc + 8 * fq;
#pragma unroll
        for (int ai = 0; ai < 2; ++ai)
#pragma unroll
            for (int m = 0; m < 4; ++m) { const size_t ro = (size_t)(row0 + ai * 128 + m * 16) * DS + cb;
#pragma unroll
                for (int bj = 0; bj < 2; ++bj) { const u32x4 yv = *(const u32x4*)(Y1 + ro + 128 * bj); f32x4 y0, y1; pg::unpack8(yv, y0, y1);
                    f32x4 a = acc[ai][bj][m][0], b = acc[ai][bj][m][1];
#pragma unroll
                    for (int e = 0; e < 4; ++e) { a[e] = y0[e] * pg::fsigmoid(a[e]); b[e] = y1[e] * pg::fsigmoid(b[e]); }
                    *(u32x4*)(YS + ro + 128 * bj) = pg::pack8(a, b); } }
    }
};
struct PhProj {
    static constexpr bool GATHER = false;
    unsigned lda, ldb; const char* O; const char* YSp; const char* WPA; const char* WPS; pg::StaticOrder so; bf16* GA; const bf16* GS;
    __device__ __forceinline__ bool next(int i, pg::Unit& u) const { int pm, pn; if (!so.next(i >> 1, pm, pn)) return false; const int sub = i & 1;
        u.A = (sub ? YSp : O) + (size_t)pm * 256 * lda; u.B = (sub ? WPS : WPA) + (size_t)pn * 256 * ldb; u.nt = DA / 64; u.pm = pm; u.pn = pn; u.aux = sub; return true; }
    __device__ __forceinline__ void offs(const pg::Unit&, const int (&R)[2], const int (&C)[2], unsigned (&vo)[2][2]) const { pg::offs_plain(lda, R, C, vo); }
    __device__ __forceinline__ void epi(const f32x4 (&acc)[2][2][4][2], const pg::Unit& u, int wr, int wc, int fr, int fq) const {
        const int row0 = u.pm * 256 + wr * 64 + fr, cb = u.pn * 256 + 32 * wc + 8 * fq; const bool sub = u.aux != 0;
#pragma unroll
        for (int ai = 0; ai < 2; ++ai)
#pragma unroll
            for (int m = 0; m < 4; ++m) { const size_t ro = (size_t)(row0 + ai * 128 + m * 16) * D + cb;
#pragma unroll
                for (int bj = 0; bj < 2; ++bj) { const u32x4 gv = *(const u32x4*)(GA + ro + 128 * bj); f32x4 g0, g1; pg::unpack8(gv, g0, g1);
                    f32x4 a = acc[ai][bj][m][0], b = acc[ai][bj][m][1];
                    if (!sub) { a = a * g0; b = b * g1; }
                    else { const u32x4 sv = *(const u32x4*)(GS + ro + 128 * bj); f32x4 s0, s1; pg::unpack8(sv, s0, s1); a = g0 + s0 * a; b = g1 + s1 * b; }
                    *(u32x4*)(GA + ro + 128 * bj) = pg::pack8(a, b); } }
    }
};
struct PhWout {
    static constexpr bool GATHER = false;
    unsigned lda, ldb; const char* A; const char* B; pg::StaticOrder so; const float* x; float* out; bf16* X2B; float* SSP;
    __device__ __forceinline__ bool next(int i, pg::Unit& u) const { int pm, pn; if (!so.next(i, pm, pn)) return false; u.A = A + (size_t)pm * 256 * lda; u.B = B + (size_t)pn * 256 * ldb; u.nt = D / 64; u.pm = pm; u.pn = pn; u.aux = 0; return true; }
    __device__ __forceinline__ void offs(const pg::Unit&, const int (&R)[2], const int (&C)[2], unsigned (&vo)[2][2]) const { pg::offs_plain(lda, R, C, vo); }
    __device__ __forceinline__ void epi(const f32x4 (&acc)[2][2][4][2], const pg::Unit& u, int wr, int wc, int fr, int fq) const {
        const int row0 = u.pm * 256 + wr * 64 + fr, cb = u.pn * 256 + 32 * wc + 8 * fq;
#pragma unroll
        for (int ai = 0; ai < 2; ++ai)
#pragma unroll
            for (int m = 0; m < 4; ++m) { const int row = row0 + ai * 128 + m * 16; const size_t ro = (size_t)row * D + cb; float ss = 0.f;
#pragma unroll
                for (int bj = 0; bj < 2; ++bj) { const f32x4 x0 = *(const f32x4*)(x + ro + 128 * bj), x1 = *(const f32x4*)(x + ro + 128 * bj + 4);
                    const f32x4 a = acc[ai][bj][m][0] + x0, b = acc[ai][bj][m][1] + x1;
                    *(u32x4*)(X2B + ro + 128 * bj) = pg::pack8(a, b);
                    ss += (a[0] * a[0] + a[1] * a[1]) + (a[2] * a[2] + a[3] * a[3]) + (b[0] * b[0] + b[1] * b[1]) + (b[2] * b[2] + b[3] * b[3]); }
                ss += __shfl_xor(ss, 16); ss += __shfl_xor(ss, 32);
                if (fq == 0) SSP[(size_t)row * 16 + u.pn * 4 + wc] = ss;
                asm volatile("" ::: "memory"); }
    }
};

__device__ __forceinline__ void p2_side_work(Frame& F, const Args& a) {
    unsigned char* ws = a.ws; const int i0 = (int)blockIdx.x - 64;
    LAS float* KT = (LAS float*)F.lds;
    for (int sl = i0; sl < NG * 8; sl += 192) { const int g = sl >> 3, q = sl & 7;
        __syncthreads();
        { const GAS f32x4* src = (const GAS f32x4*)((const float*)(ws + WS_KTG) + (size_t)g * LCH * GC * GC);
          for (int i = F.tid; i < (4 * q + 4) * GC * GC / 4; i += NWAVES * 64) *(LAS f32x4*)(KT + 4 * i) = src[i]; }
        __syncthreads();
        const int n = 64 * q + (F.tid >> 3), part = F.tid & 7, j = n >> 4, co = n & 15; bf16* row = (bf16*)(ws + WS_BTY) + ((size_t)g * 512 + n) * U2P + 128;
#pragma unroll 1
        for (int it = 0; it < 8; ++it) { const int k = (it * 8 + part) * 8, sidx = k >> 4, ci = k & 15;
            u32x4 o = (u32x4){0u, 0u, 0u, 0u};
            if (sidx <= j) { const LAS float* kp = KT + ((j - sidx) * GC + co) * GC + ci; const f32x4 k0 = *(const LAS f32x4*)kp, k1 = *(const LAS f32x4*)(kp + 4); o = pg::pack8(k0, k1); }
            *(GAS u32x4*)(row + k) = o; } }
    __syncthreads();
    LAS float* scr = (LAS float*)(F.lds + F.wave * 8704);
    constexpr int I_GLU = 8 * 16, I_PA = 8 * 32, I_OUT = 16 * 32;
    for (int it = i0 * NWAVES + F.wave; it < I_GLU + 2 * I_PA + I_OUT; it += 192 * NWAVES) { int r = it;
        if (r < I_GLU) { const int kb = r >> 4, nb = r & 15; conv_item(a.in[14], DS, kb * 64, nb * 32, (bf16*)(ws + WS_WGLU) + (size_t)(nb * 32) * DS, DS, nullptr, scr, F.lane); continue; } r -= I_GLU;
        if (r < I_PA) { const int kb = r >> 5, nb = r & 31; conv_item(a.in[15], D, kb * 64, nb * 32, (bf16*)(ws + WS_WPA) + (size_t)(nb * 32) * DA, DA, nullptr, scr, F.lane); continue; } r -= I_PA;
        if (r < I_PA) { const int kb = r >> 5, nb = r & 31; conv_item(a.in[16], D, kb * 64, nb * 32, (bf16*)(ws + WS_WPS) + (size_t)(nb * 32) * DS, DS, nullptr, scr, F.lane); continue; } r -= I_PA;
        { const int kb = r >> 5, nb = r & 31; conv_item(a.in[17], D, kb * 64, nb * 32, (bf16*)(ws + WS_WOUT) + (size_t)(nb * 32) * D, D, nullptr, scr, F.lane); } }
    if (i0 < 48) { const int r = i0; const float* gf = a.in[18]; const float* wrg = a.in[19]; const float* wre = a.in[21]; bf16* WR = (bf16*)(ws + WS_WR) + (size_t)r * D;
        for (int k = F.tid; k < D; k += NWAVES * 64) { const float w = r < 4 ? wrg[k * 4 + r] : (r < 36 ? wre[k * NE + r - 4] : 0.f); WR[k] = f2bf(w * gf[k]); } }
    __syncthreads();
}
__device__ __forceinline__ void p2_expert_weights(Frame& F, const Args& a) {
    unsigned char* ws = a.ws; LAS float* scr = (LAS float*)(F.lds + F.wave * 8704);
    const int gw = F.vcu * NWAVES + F.wave, NGW = F.G * NWAVES;
    const float* gf = a.in[18]; const float* wg = a.in[23]; const float* wu = a.in[24]; const float* wd = a.in[25];
    constexpr int I_G = 16 * 8, I_D = 4 * 32;
    constexpr int NITEMS = NE * (2 * I_G + I_D);
    auto desc = [&](int it) -> ConvDesc { const int e = it / (2 * I_G + I_D); int r = it % (2 * I_G + I_D);
        if (r < 2 * I_G) { const int up = r >= I_G; if (up) r -= I_G; const int kb = r >> 3, nb = r & 7, n0 = nb * 32;
            return ConvDesc{(up ? wu : wg) + (size_t)e * D * DE, DE, kb * 64, n0, (bf16*)(ws + WS_WGU) + ((size_t)e * 512 + 256 * (n0 >> 7) + 128 * up + (n0 & 127)) * D, D, gf}; }
        r -= 2 * I_G; const int kb = r >> 5, nb = r & 31; return ConvDesc{wd + (size_t)e * DE * D, D, kb * 64, nb * 32, (bf16*)(ws + WS_WD) + ((size_t)e * D + nb * 32) * DE, DE, nullptr}; };
    int it = (a.sub & 4) ? gw : NITEMS;
    float v[32]; ConvDesc d{}; if (it < NITEMS) { d = desc(it); conv_load(d, v, F.lane); }
    while (it < NITEMS) {
        const int itn = it + NGW; float vn[32]; ConvDesc dn{}; if (itn < NITEMS) { dn = desc(itn); conv_load(dn, vn, F.lane); }
        conv_finish(d, v, scr, F.lane);
#pragma unroll
        for (int i = 0; i < 32; ++i) v[i] = vn[i];
        d = dn; it = itn;
    }
}
__device__ __forceinline__ void p8_router(Frame& F, const Args& a) {
    unsigned char* ws = a.ws;
    constexpr int WPITCH = 2064;
    LAS unsigned char* wl = F.lds;
    LAS float* lg = (LAS float*)(F.lds + 48 * WPITCH) + F.wave * 16 * 48;
    { const GAS u32x4* src = (const GAS u32x4*)(ws + WS_WR);
      for (int i = F.tid; i < 48 * 128; i += NWAVES * 64) { const int r = i >> 7, c = i & 127; *(LAS u32x4*)(wl + r * WPITCH + c * 16) = src[i]; } }
    __syncthreads();
    const bf16* X2B = (const bf16*)(ws + WS_X2B); const float* SSP = (const float*)(ws + WS_SSP);
    const float* b_rg = a.in[20]; const float* b_re = a.in[22];
    float* RSTD = (float*)(ws + WS_RSTD); int* ROUTE = (int*)(ws + WS_ROUTE); int* CNT = (int*)(ws + WS_CTL) + CW_CNT; int* LIST = (int*)(ws + WS_LIST); float* WPOS = (float*)(ws + WS_WPOS); float* RPOS = (float*)(ws + WS_RPOS);
    const int fr = F.lane & 15, fq = F.lane >> 4;
    LAS int* lcnt = (LAS int*)(F.lds + 48 * WPITCH + NWAVES * 16 * 48 * 4);
    LAS int* lbase = lcnt + 32;
    for (int t0 = F.vcu * 64; t0 < T; t0 += F.G * 64) {
        if (F.tid < 32) lcnt[F.tid] = 0;
        __syncthreads();
        int e0 = 0, e1 = 0, lr0 = 0, lr1 = 0; float w0 = 0.f, w1 = 0.f, rstd = 0.f;
        if (F.wave < 4) {
            const int tok = t0 + F.wave * 16 + fr;
            const GAS bf16x8* xa = (const GAS bf16x8*)(X2B + (size_t)tok * D + 8 * fq);
            f32x4 acc[3]; acc[0] = acc[1] = acc[2] = (f32x4){0.f, 0.f, 0.f, 0.f};
            bf16x8 xf[32];
#pragma unroll
            for (int ks = 0; ks < 32; ++ks) xf[ks] = xa[ks * 4];
#pragma unroll
            for (int ks = 0; ks < 32; ++ks) {
#pragma unroll
                for (int n = 0; n < 3; ++n) { const bf16x8 wfr = *(const LAS bf16x8*)(wl + (n * 16 + fr) * WPITCH + ks * 64 + fq * 16);
                    acc[n] = __builtin_amdgcn_mfma_f32_16x16x32_bf16(wfr, xf[ks], acc[n], 0, 0, 0); } }
#pragma unroll
            for (int n = 0; n < 3; ++n) *(LAS f32x4*)(lg + fr * 48 + n * 16 + 4 * fq) = acc[n];
            LDS_WAIT(); asm volatile("" ::: "memory");
            if (F.lane < 16) {
                const int t = t0 + F.wave * 16 + F.lane; const LAS float* l = lg + F.lane * 48;
                float ss = 0.f; { const f32x4* sp = (const f32x4*)(SSP + (size_t)t * 16);
#pragma unroll
                    for (int i = 0; i < 4; ++i) { const f32x4 v = sp[i]; ss += (v[0] + v[1]) + (v[2] + v[3]); } }
                rstd = rsqrtf(ss * (1.f / D) + EPS);
                float gl[4]; int gs = 0;
#pragma unroll
                for (int i = 0; i < 4; ++i) gl[i] = l[i] * rstd + b_rg[i];
                float gm = gl[0];
#pragma unroll
                for (int i = 1; i < 4; ++i) if (gl[i] > gm) { gm = gl[i]; gs = i; }
                float gsum = 0.f;
#pragma unroll
                for (int i = 0; i < 4; ++i) gsum += __expf(gl[i] - gm);
                const float gtop = 1.f / gsum;
                float el[8];
#pragma unroll
                for (int i = 0; i < 8; ++i) el[i] = l[4 + gs * 8 + i] * rstd + b_re[gs * 8 + i];
                int i0 = 0; float m0 = el[0];
#pragma unroll
                for (int i = 1; i < 8; ++i) if (el[i] > m0) { m0 = el[i]; i0 = i; }
                int i1 = -1; float m1 = -3.0e38f;
#pragma unroll
                for (int i = 0; i < 8; ++i) if (i != i0 && el[i] > m1) { m1 = el[i]; i1 = i; }
                const float p1 = __expf(m1 - m0); w0 = gtop / (1.f + p1); w1 = gtop * p1 / (1.f + p1);
                e0 = gs * 8 + i0; e1 = gs * 8 + i1;
                lr0 = __hip_atomic_fetch_add(&lcnt[e0], 1, __ATOMIC_RELAXED, __HIP_MEMORY_SCOPE_WORKGROUP); lr1 = __hip_atomic_fetch_add(&lcnt[e1], 1, __ATOMIC_RELAXED, __HIP_MEMORY_SCOPE_WORKGROUP);
            }
        }
        __syncthreads();
        if (F.tid < 32) { const int c = lcnt[F.tid]; lbase[F.tid] = c ? atomicAdd(&CNT[F.tid], c) : 0; }
        __syncthreads();
        if (F.wave < 4 && F.lane < 16) {
            const int t = t0 + F.wave * 16 + F.lane; const int r0 = lbase[e0] + lr0, r1 = lbase[e1] + lr1;
            RSTD[t] = rstd; *(int4*)(ROUTE + t * 4) = make_int4(e0, e1, r0, r1);
            LIST[e0 * T + r0] = t; LIST[e1 * T + r1] = t; WPOS[e0 * T + r0] = w0; WPOS[e1 * T + r1] = w1; RPOS[e0 * T + r0] = rstd; RPOS[e1 * T + r1] = rstd;
        }
        __syncthreads();
    }
}
__device__ __forceinline__ void moe_table(Frame& F, const int* CNT, LAS int* tb) {
    if (F.tid < 64) { const int e = F.lane; int c = 0; if (e < NE) c = (int)__hip_atomic_load((const unsigned*)CNT + e, __ATOMIC_RELAXED, __HIP_MEMORY_SCOPE_AGENT);
        const int tl = (c + 255) >> 8; int incl = tl;
#pragma unroll
        for (int o = 1; o < 32; o <<= 1) { const int v = __shfl_up(incl, o); if (e >= o) incl += v; }
        if (e < NE) { tb[e] = incl - tl; tb[64 + e] = c; } if (e == NE - 1) tb[32] = incl; }
    __syncthreads();
}
__device__ __forceinline__ int moe_find(const LAS int* tb, int mt) { int e = 0;
#pragma unroll 1
    for (int i = 1; i < NE; ++i) if (mt >= tb[i]) e = i; return e; }
struct PhMoeGU {
    static constexpr bool GATHER = true;
    unsigned lda, ldb; const char* X; const char* W; const LAS int* tb; const int* LIST; const float* RPOS; bf16* H; int G, c;
    __device__ __forceinline__ bool next(int i, pg::Unit& u) const { const int L = i * G + c; if (L >= 2 * tb[32]) return false; const int mt = L >> 1, n2 = L & 1, e = moe_find(tb, mt);
        u.A = X; u.B = W + ((size_t)e * 512 + n2 * 256) * ldb; u.nt = D / 64; u.pm = mt; u.pn = n2; u.aux = e; return true; }
    __device__ __forceinline__ void offs(const pg::Unit& u, const int (&R)[2], const int (&C)[2], unsigned (&vo)[2][2]) const {
        const int e = u.aux, cnt = tb[64 + e], r0 = (u.pm - tb[e]) * 256; const int* lp = LIST + (size_t)e * T;
#pragma unroll
        for (int h = 0; h < 2; ++h)
#pragma unroll
            for (int i = 0; i < 2; ++i) { int r = r0 + h * 128 + R[i]; r = r < cnt ? r : cnt - 1; vo[h][i] = (unsigned)lp[r] * lda + (unsigned)C[i] * 2u; }
    }
    __device__ __forceinline__ void epi(const f32x4 (&acc)[2][2][4][2], const pg::Unit& u, int wr, int wc, int fr, int fq) const {
        const int e = u.aux, r0 = (u.pm - tb[e]) * 256; const float* rp = RPOS + (size_t)e * T + r0;
#pragma unroll
        for (int ai = 0; ai < 2; ++ai)
#pragma unroll
            for (int m = 0; m < 4; ++m) { const int tr = ai * 128 + wr * 64 + m * 16 + fr; const float rs = rp[tr];
                f32x4 g0 = acc[ai][0][m][0] * rs, g1 = acc[ai][0][m][1] * rs; const f32x4 u0 = acc[ai][1][m][0] * rs, u1 = acc[ai][1][m][1] * rs;
#pragma unroll
                for (int q = 0; q < 4; ++q) { g0[q] = g0[q] * pg::fsigmoid(g0[q]) * u0[q]; g1[q] = g1[q] * pg::fsigmoid(g1[q]) * u1[q]; }
                *(u32x4*)(H + ((size_t)u.pm * 256 + tr) * DE + u.pn * 128 + 32 * wc + 8 * fq) = pg::pack8(g0, g1); }
    }
};
struct PhMoeDown {
    static constexpr bool GATHER = false;
    unsigned lda, ldb; const char* Hp; const char* W; const LAS int* tb; const float* WPOS; bf16* Y; int G, c;
    __device__ __forceinline__ bool next(int i, pg::Unit& u) const { const int L = i * G + c; if (L >= 4 * tb[32]) return false; const int mt = L >> 2, n4 = L & 3, e = moe_find(tb, mt);
        u.A = Hp + (size_t)mt * 256 * lda; u.B = W + ((size_t)e * D + n4 * 256) * ldb; u.nt = DE / 64; u.pm = mt; u.pn = n4; u.aux = e; return true; }
    __device__ __forceinline__ void offs(const pg::Unit&, const int (&R)[2], const int (&C)[2], unsigned (&vo)[2][2]) const { pg::offs_plain(lda, R, C, vo); }
    __device__ __forceinline__ void epi(const f32x4 (&acc)[2][2][4][2], const pg::Unit& u, int wr, int wc, int fr, int fq) const {
        const int e = u.aux, r0 = (u.pm - tb[e]) * 256; const float* wp = WPOS + (size_t)e * T + r0;
#pragma unroll
        for (int ai = 0; ai < 2; ++ai)
#pragma unroll
            for (int m = 0; m < 4; ++m) { const int tr = ai * 128 + wr * 64 + m * 16 + fr; const float w = wp[tr]; bf16* yp = Y + ((size_t)u.pm * 256 + tr) * D + u.pn * 256 + 32 * wc + 8 * fq;
#pragma unroll
                for (int bj = 0; bj < 2; ++bj) *(u32x4*)(yp + 128 * bj) = pg::pack8(acc[ai][bj][m][0] * w, acc[ai][bj][m][1] * w); }
    }
};
__device__ __forceinline__ void p11_combine(Frame& F, const Args& a, const LAS int* tb) {
    unsigned char* ws = a.ws; const int* ROUTE = (const int*)(ws + WS_ROUTE); const bf16* Y = (const bf16*)(ws + WS_Y); const bf16* X2B = (const bf16*)(ws + WS_X2B); float* out = a.out;
    for (int t = F.vcu * NWAVES + F.wave; t < T; t += F.G * NWAVES) {
        const int4 rt = *(const int4*)(ROUTE + t * 4);
        const GAS u32x2* y0 = (const GAS u32x2*)(Y + ((size_t)tb[rt.x] * 256 + rt.z) * D) + F.lane; const GAS u32x2* y1 = (const GAS u32x2*)(Y + ((size_t)tb[rt.y] * 256 + rt.w) * D) + F.lane;
        const GAS u32x2* xb = (const GAS u32x2*)(X2B + (size_t)t * D) + F.lane;
        GAS f32x4* o = (GAS f32x4*)(out + (size_t)t * D) + F.lane;
#pragma unroll
        for (int j = 0; j < 4; ++j) { const u32x2 a0 = y0[64 * j], a1 = y1[64 * j], xv = xb[64 * j]; f32x4 v;
            v[0] = __builtin_bit_cast(float, xv.x << 16) + (__builtin_bit_cast(float, a0.x << 16) + __builtin_bit_cast(float, a1.x << 16)); v[1] = __builtin_bit_cast(float, xv.x & 0xffff0000u) + (__builtin_bit_cast(float, a0.x & 0xffff0000u) + __builtin_bit_cast(float, a1.x & 0xffff0000u));
            v[2] = __builtin_bit_cast(float, xv.y << 16) + (__builtin_bit_cast(float, a0.y << 16) + __builtin_bit_cast(float, a1.y << 16)); v[3] = __builtin_bit_cast(float, xv.y & 0xffff0000u) + (__builtin_bit_cast(float, a0.y & 0xffff0000u) + __builtin_bit_cast(float, a1.y & 0xffff0000u));
            o[64 * j] = v; }
    }
}

struct PhSsmX {
    static constexpr bool GATHER = false;
    unsigned lda, ldb; const char* U2X; const char* M1T; float* SLOC; int g, b;
    __device__ __forceinline__ bool next(int i, pg::Unit& u) const { if (i >= 1) return false; u.A = U2X + ((size_t)(g * NCR + b * 256) * U2P + 128) * 2; u.B = M1T + (size_t)g * 256 * ldb; u.nt = 8; u.pm = b; u.pn = 0; u.aux = 0; return true; }
    __device__ __forceinline__ void offs(const pg::Unit&, const int (&R)[2], const int (&C)[2], unsigned (&vo)[2][2]) const { pg::offs_plain(lda, R, C, vo); }
    __device__ __forceinline__ void epi(const f32x4 (&acc)[2][2][4][2], const pg::Unit& u, int wr, int wc, int fr, int fq) const {
#pragma unroll
        for (int ai = 0; ai < 2; ++ai)
#pragma unroll
            for (int m = 0; m < 4; ++m) { float* p = SLOC + ((size_t)g * NCR + u.pm * 256 + ai * 128 + wr * 64 + m * 16 + fr) * 128 + 32 * wc + 8 * fq;
                *(f32x4*)p = acc[ai][0][m][0]; *(f32x4*)(p + 4) = acc[ai][0][m][1]; }
    }
};
__device__ __forceinline__ void ssm_scan(Frame& F, unsigned char* ws, int g, int b) {
    LAS f32x2* ends = (LAS f32x2*)F.lds;
    const int p = F.lane, w = F.wave;
    const float alr = ((const float*)(ws + WS_AL))[(g * NP + p) * 2], ali = ((const float*)(ws + WS_AL))[(g * NP + p) * 2 + 1];
    const float* sl = (const float*)(ws + WS_SLOC) + ((size_t)g * NCR + b * 256 + w * 32) * 128;
    float lr[32], li[32];
#pragma unroll
    for (int k = 0; k < 32; ++k) { lr[k] = __builtin_bit_cast(float, __hip_atomic_load((const unsigned*)sl + k * 128 + p, __ATOMIC_RELAXED, __HIP_MEMORY_SCOPE_AGENT)); li[k] = __builtin_bit_cast(float, __hip_atomic_load((const unsigned*)sl + k * 128 + 64 + p, __ATOMIC_RELAXED, __HIP_MEMORY_SCOPE_AGENT)); }
#pragma unroll
    for (int k = 1; k < 32; ++k) { const float nr = alr * lr[k - 1] - ali * li[k - 1] + lr[k], ni = alr * li[k - 1] + ali * lr[k - 1] + li[k]; lr[k] = nr; li[k] = ni; }
    ends[w * 64 + p] = (f32x2){lr[31], li[31]};
    float sr = alr, si = ali;
#pragma unroll
    for (int k = 0; k < 5; ++k) { const float t = sr * sr - si * si; si = 2.f * sr * si; sr = t; }
    __syncthreads();
    float cr = 0.f, ci = 0.f;
    for (int s2 = 0; s2 < w; ++s2) { const f32x2 e = ends[s2 * 64 + p]; const float t = sr * cr - si * ci + e.x; ci = sr * ci + si * cr + e.y; cr = t; }
    bf16* hp = (bf16*)(ws + WS_U2X) + ((size_t)g * NCR + b * 256 + w * 32) * U2P;
    float pr = cr, pi = ci;
#pragma unroll
    for (int k = 0; k < 32; ++k) { const float hr = (k ? lr[k - 1] : 0.f) + pr, hi = (k ? li[k - 1] : 0.f) + pi;
        hp[(size_t)k * U2P + p] = f2bf(hr); hp[(size_t)k * U2P + 64 + p] = f2bf(hi);
        const float t = alr * pr - ali * pi; pi = alr * pi + ali * pr; pr = t; }
    __syncthreads();
}
struct PhSsmY {
    static constexpr bool GATHER = false;
    unsigned lda, ldb; const char* U2Xp; const char* BTY; const bf16* U2X; const float* Dsk; bf16* Y1; int G, c;
    __device__ __forceinline__ bool next(int i, pg::Unit& u) const { const int L = i * G + c; if (L >= NG * 4) return false; const int g = L >> 2, mt = (L >> 1) & 1, nb = L & 1;
        u.A = U2Xp + (size_t)(g * NCR + mt * 256) * lda; u.B = BTY + (size_t)(g * 512 + nb * 256) * ldb; u.nt = nb ? 10 : 6; u.pm = mt; u.pn = nb; u.aux = g; return true; }
    __device__ __forceinline__ void offs(const pg::Unit&, const int (&R)[2], const int (&C)[2], unsigned (&vo)[2][2]) const { pg::offs_plain(lda, R, C, vo); }
    __device__ __forceinline__ void epi(const f32x4 (&acc)[2][2][4][2], const pg::Unit& u, int wr, int wc, int fr, int fq) const {
        const int g = u.aux;
#pragma unroll
        for (int bj = 0; bj < 2; ++bj) { const int n = u.pn * 256 + 128 * bj + 32 * wc + 8 * fq, j = n >> 4, c0 = n & 15;
            const f32x4 d0 = *(const f32x4*)(Dsk + g * GC + c0), d1 = *(const f32x4*)(Dsk + g * GC + c0 + 4);
#pragma unroll
            for (int ai = 0; ai < 2; ++ai)
#pragma unroll
                for (int m = 0; m < 4; ++m) { const int cr = u.pm * 256 + ai * 128 + wr * 64 + m * 16 + fr;
                    const u32x4 uv = *(const u32x4*)(U2X + ((size_t)g * NCR + cr) * U2P + 128 + j * GC + c0); f32x4 u0, u1; pg::unpack8(uv, u0, u1);
                    f32x4 a = acc[ai][bj][m][0] + d0 * u0, b = acc[ai][bj][m][1] + d1 * u1;
#pragma unroll
                    for (int q = 0; q < 4; ++q) { a[q] = gelu_fast(a[q]); b[q] = gelu_fast(b[q]); }
                    *(u32x4*)(Y1 + ((size_t)cr * LCH + j) * DS + g * GC + c0) = pg::pack8(a, b); } }
    }
};

__global__ void __launch_bounds__(NWAVES * 64, 2) mk_fwd(Args args) {
    extern __shared__ __attribute__((aligned(16))) unsigned char lds[];
    Frame F;
    F.lds = (LAS unsigned char*)lds; F.MISC = (volatile LAS unsigned*)(F.lds + MISC_OFF);
    F.tid = threadIdx.x; F.lane = F.tid & 63; F.wave = __builtin_amdgcn_readfirstlane(F.tid >> 6);
    F.G = gridDim.x; { const int bx = blockIdx.x; F.vcu = (F.G % 8 == 0) ? (bx % 8) * (F.G / 8) + bx / 8 : bx; }
    unsigned char* ws = args.ws; F.ctl = (gu32*)(ws + WS_CTL);
    for (int u = F.tid; u < (LDS_BYTES - LDSCTL_OFF) / 4; u += NWAVES * 64) ((LAS unsigned*)(F.lds + LDSCTL_OFF))[u] = 0u;
    __syncthreads();
    const int lo = args.ph_lo, hi = args.ph_hi;
    const bool multi = (hi - lo) > 1;
    XcdBarrier bar; bar.bar = (unsigned*)(F.ctl + CW_BAR); bar.x = 0; bar.st = nullptr;
    if (multi) bar = xcd_barrier_post((unsigned*)(F.ctl + CW_BAR), F.MISC + 8);
#define IN(k) (lo <= (k) && (k) < hi)
#define SEAM(k) do { if (IN(k) && IN((k) + 1)) xcd_barrier(bar); } while (0)
    if (IN(0)) { p0_prologue(F, args); SEAM(0); }
    if (IN(1)) {
        if (blockIdx.x < NBATCH * NH) p1_cumsum(F, (float*)(ws + WS_CUM), (int*)(ws + WS_T0), args.in[4], args.in[5]);
        PhInProj ph; ph.lda = D * 2; ph.ldb = D * 2; ph.A = (const char*)(ws + WS_XN); ph.B = (const char*)(ws + WS_WIN); ph.so.init(T / 256, 4096 / 256, F.G, (int)blockIdx.x);
        ph.Q = (bf16*)(ws + WS_Q); ph.K = (bf16*)(ws + WS_K); ph.V = (bf16*)(ws + WS_V); ph.U2X = (bf16*)(ws + WS_U2X); ph.GA = (bf16*)(ws + WS_GA); ph.GS = (bf16*)(ws + WS_GS);
        ph.gq = args.in[4]; ph.gk = args.in[5];
        pg::gemm_phase(F.lds + RING_OFF, ph);
        SEAM(1);
    }
    if (IN(2)) {
        if (blockIdx.x < 2 * NG) {
            const int g = (int)blockIdx.x >> 1, b = (int)blockIdx.x & 1;
            PhSsmX ph; ph.lda = U2P * 2; ph.ldb = 512 * 2; ph.U2X = (const char*)(ws + WS_U2X); ph.M1T = (const char*)(ws + WS_M1T); ph.SLOC = (float*)(ws + WS_SLOC); ph.g = g; ph.b = b;
            if (args.sub & 1) pg::gemm_phase(F.lds + RING_OFF, ph);
            if (args.sub & 2) ssm_scan(F, ws, g, b);
            __syncthreads();
        } else if (F.G == 256) p2_side_work(F, args);
        p2_expert_weights(F, args); __syncthreads();
        if (IN(2) && !IN(3)) {}
    }
    if (IN(3)) {
        static_assert(attn_body::ATTN_LDS_BYTES + 2 * attn_body::MAX_ITEMS * 4 <= RING_BYTES, "attention LDS");
        const attn_body::AttnTensors AT{(const attn_body::bf16*)(ws + WS_Q), (const attn_body::bf16*)(ws + WS_K), (const attn_body::bf16*)(ws + WS_V), (attn_body::bf16*)(ws + WS_Q), (const float*)(ws + WS_CUM),
            (const int*)(ws + WS_T0), (attn_body::bf16*)(ws + WS_PO), (float*)(ws + WS_PS), (unsigned*)(F.ctl + CW_Q0)};
        attn_body::attn_phase<20>((char*)lds + RING_OFF, AT, F.vcu, F.G);
        SEAM(3);
    }
    if (IN(4)) {
        if (F.vcu >= 128) {
            const attn_body::AttnTensors AT{(const attn_body::bf16*)(ws + WS_Q), (const attn_body::bf16*)(ws + WS_K), (const attn_body::bf16*)(ws + WS_V), (attn_body::bf16*)(ws + WS_Q), (const float*)(ws + WS_CUM),
                (const int*)(ws + WS_T0), (attn_body::bf16*)(ws + WS_PO), (float*)(ws + WS_PS), (unsigned*)(F.ctl + CW_Q0)};
            attn_body::attn_combine((char*)lds + RING_OFF, AT, F.vcu - 128, F.G - 128);
        }
        PhSsmY ph; ph.lda = U2P * 2; ph.ldb = U2P * 2; ph.U2Xp = (const char*)(ws + WS_U2X); ph.BTY = (const char*)(ws + WS_BTY); ph.U2X = (const bf16*)(ws + WS_U2X); ph.Dsk = args.in[13]; ph.Y1 = (bf16*)(ws + WS_Y1); ph.G = F.G; ph.c = F.vcu;
        pg::gemm_phase(F.lds + RING_OFF, ph);
        SEAM(4);
    }
    if (IN(5)) {
        PhGlu ph; ph.lda = DS * 2; ph.ldb = DS * 2; ph.A = (const char*)(ws + WS_Y1); ph.B = (const char*)(ws + WS_WGLU); ph.so.init(T / 256, DS / 256, F.G, (int)blockIdx.x); ph.Y1 = (const bf16*)(ws + WS_Y1); ph.YS = (bf16*)(ws + WS_YS);
        pg::gemm_phase(F.lds + RING_OFF, ph);
        SEAM(5);
    }
    if (IN(6)) {
        PhProj ph; ph.lda = DA * 2; ph.ldb = DA * 2; ph.O = (const char*)(ws + WS_Q); ph.YSp = (const char*)(ws + WS_YS); ph.WPA = (const char*)(ws + WS_WPA); ph.WPS = (const char*)(ws + WS_WPS);
        ph.so.init(T / 256, D / 256, F.G, (int)blockIdx.x); ph.GA = (bf16*)(ws + WS_GA); ph.GS = (const bf16*)(ws + WS_GS);
        pg::gemm_phase(F.lds + RING_OFF, ph);
        SEAM(6);
    }
    if (IN(7)) {
        PhWout ph; ph.lda = D * 2; ph.ldb = D * 2; ph.A = (const char*)(ws + WS_GA); ph.B = (const char*)(ws + WS_WOUT); ph.so.init(T / 256, D / 256, F.G, (int)blockIdx.x);
        ph.x = args.in[0]; ph.out = args.out; ph.X2B = (bf16*)(ws + WS_X2B); ph.SSP = (float*)(ws + WS_SSP);
        pg::gemm_phase(F.lds + RING_OFF, ph);
        SEAM(7);
    }
    if (IN(8)) { p8_router(F, args); SEAM(8); }
    LAS int* tb = (LAS int*)(F.lds + LDSCTL_OFF + 512);
    if (IN(9)) {
        moe_table(F, (const int*)(ws + WS_CTL) + CW_CNT, tb);
        PhMoeGU ph; ph.lda = D * 2; ph.ldb = D * 2; ph.X = (const char*)(ws + WS_X2B); ph.W = (const char*)(ws + WS_WGU); ph.tb = tb; ph.LIST = (const int*)(ws + WS_LIST); ph.RPOS = (const float*)(ws + WS_RPOS);
        ph.H = (bf16*)(ws + WS_H); ph.G = F.G; ph.c = F.vcu;
        pg::gemm_phase(F.lds + RING_OFF, ph);
        SEAM(9);
    }
    if (IN(10)) {
        if (!IN(9)) moe_table(F, (const int*)(ws + WS_CTL) + CW_CNT, tb);
        PhMoeDown ph; ph.lda = DE * 2; ph.ldb = DE * 2; ph.Hp = (const char*)(ws + WS_H); ph.W = (const char*)(ws + WS_WD); ph.tb = tb; ph.WPOS = (const float*)(ws + WS_WPOS); ph.Y = (bf16*)(ws + WS_Y); ph.G = F.G; ph.c = F.vcu;
        pg::gemm_phase(F.lds + RING_OFF, ph);
        SEAM(10);
    }
    if (IN(11)) {
        if (!IN(10)) moe_table(F, (const int*)(ws + WS_CTL) + CW_CNT, tb);
        p11_combine(F, args, tb);
    }
#undef IN
#undef SEAM
}

extern "C" void kernel_launch(void* const* d_in, const int* in_sizes, int n_in, void* d_out, int out_size, void* d_ws, size_t ws_size, hipStream_t stream) {
    static int grid = 0;
    if (grid == 0) {
        int dev = 0, cus = 0; (void)hipGetDevice(&dev); (void)hipDeviceGetAttribute(&cus, hipDeviceAttributeMultiprocessorCount, dev);
        (void)hipFuncSetAttribute((const void*)mk_fwd, hipFuncAttributeMaxDynamicSharedMemorySize, LDS_BYTES);
        grid = cus > 0 ? cus : 256;
    }
    (void)hipMemsetAsync((char*)d_ws + WS_CTL, 0, CTL_ZERO_BYTES, stream);
    Args a{}; for (int i = 0; i < 26; ++i) a.in[i] = (const float*)d_in[i]; a.out = (float*)d_out; a.ws = (unsigned char*)d_ws;
    a.ph_lo = 0; a.ph_hi = 12; a.sub = 7;
    hipLaunchKernelGGL(mk_fwd, dim3(grid), dim3(NWAVES * 64), LDS_BYTES, stream, a);
}
```

```cpp
#include <hip/hip_runtime.h>
#include <stdint.h>
#include <math.h>

typedef unsigned short bf16;
constexpr int T = 16384, D = 1024, SEQ = 8192, NBATCH = 2, NH = 8, HD = 64, DA = 512, DS = 512, NG = 32, GC = 16, NP = 64, NE = 32, DE = 256;
constexpr int DIN = 4104, OQ = 0, OK_ = 512, OV = 1024, OF = 1536, OU = 1544, OGA = 2056, OGS = 3080;
constexpr int LCH = 32, NCR = T / LCH;
constexpr int U2P = 640;
constexpr float EPS = 1e-6f;
constexpr float C2 = 0.125f * 1.4426950408889634f;
constexpr float LOG2E = 1.4426950408889634f;
constexpr int YROWS = 40960;

constexpr size_t MiB = 1u << 20;
constexpr size_t WS_CTL = 0, CTL_ZERO_BYTES = 1 * MiB;
constexpr size_t WS_CUM = 1 * MiB;
constexpr size_t WS_AL = 1 * MiB + 512 * 1024;
constexpr size_t WS_T0 = 1 * MiB + 768 * 1024;
constexpr size_t WS_PS = 252 * MiB;
constexpr size_t WS_PO = 229 * MiB;
constexpr size_t WS_RSTD = 2 * MiB;
constexpr size_t WS_ROUTE = 2 * MiB + 256 * 1024;
constexpr size_t WS_LIST = 3 * MiB;
constexpr size_t WS_WPOS = 5 * MiB;
constexpr size_t WS_SSP = 7 * MiB;
constexpr size_t WS_WIN = 8 * MiB;
constexpr size_t WS_SLOC = 8 * MiB;
constexpr size_t WS_WGLU = 16 * MiB, WS_WPA = 16 * MiB + 512 * 1024, WS_WPS = 17 * MiB + 512 * 1024, WS_WOUT = 18 * MiB + 512 * 1024, WS_WR = 20 * MiB + 512 * 1024;
constexpr size_t WS_M1T = 21 * MiB;
constexpr size_t WS_BTY = 29 * MiB;
constexpr size_t WS_XN = 49 * MiB;
constexpr size_t WS_WGU = 49 * MiB;
constexpr size_t WS_Q = 81 * MiB;
constexpr size_t WS_K = 97 * MiB;
constexpr size_t WS_V = 113 * MiB;
constexpr size_t WS_Y1 = 97 * MiB, WS_YS = 113 * MiB;
constexpr size_t WS_U2X = 129 * MiB;
constexpr size_t WS_GA = 149 * MiB;
constexpr size_t WS_GS = 181 * MiB;
constexpr size_t WS_X2B = 181 * MiB;
constexpr size_t WS_WD = 213 * MiB;
constexpr size_t WS_H = 229 * MiB;
constexpr size_t WS_RPOS = 249 * MiB;
constexpr size_t WS_KTG = 251 * MiB;
constexpr size_t WS_Y = 81 * MiB;
static_assert(WS_H + (size_t)YROWS * DE * 2 <= WS_RPOS && WS_RPOS + 2 * MiB <= WS_KTG && WS_KTG + MiB <= 256 * MiB && WS_Y + (size_t)YROWS * D * 2 <= WS_GS, "d_ws map");

__device__ __forceinline__ bf16 f2bf(float f) { unsigned u = __builtin_bit_cast(unsigned, f); return (bf16)((u + 0x7fffu + ((u >> 16) & 1u)) >> 16); }
__device__ __forceinline__ float bf2f(bf16 b) { return __builtin_bit_cast(float, (unsigned)b << 16); }
__device__ __forceinline__ float sigmoidf_(float x) { return 1.f / (1.f + __expf(-x)); }
__device__ __forceinline__ float gelu_tanh(float x) { const float z = 0.7978845608028654f * (x + 0.044715f * x * x * x); const float e = __expf(2.f * z); return 0.5f * x * (1.f + (1.f - 2.f / (e + 1.f))); }
__device__ __forceinline__ float log_sigmoid(float x) { return -(fmaxf(-x, 0.f) + log1pf(__expf(-fabsf(x)))); }
__device__ __forceinline__ size_t u2x_index(int g, int t, int c) { return ((size_t)g * NCR + (t / LCH)) * U2P + 128 + (t % LCH) * GC + c; }

#define LAS __attribute__((address_space(3)))
#define GAS __attribute__((address_space(1)))
typedef short bf16x8 __attribute__((ext_vector_type(8)));
typedef float f32x4 __attribute__((ext_vector_type(4)));
typedef float f32x2 __attribute__((ext_vector_type(2)));
typedef unsigned u32x4 __attribute__((ext_vector_type(4)));
typedef unsigned u32x2 __attribute__((ext_vector_type(2)));
namespace pg {
constexpr int BM = 256, BK = 64, HALF = 128, HTB = HALF * BK * 2, STAGE_BYTES = 8 * HTB, NXCD = 8, WGM = 8;
__host__ __device__ __forceinline__ int lds_byte(int r, int c) { const int st = (r >> 4) * 2 + (c >> 5), rr = r & 15, cc = c & 31, ob = rr * 64 + cc * 2; return st * 1024 + (ob ^ (((ob >> 9) & 1) << 5)); }
__host__ __device__ __forceinline__ void stage_rc(int b, int& R, int& C) { const int st = b / 1024, sb = b % 1024, swz = sb ^ (((sb >> 9) & 1) << 5); R = (st >> 1) * 16 + swz / 64; C = (st & 1) * 32 + (swz % 64) / 2; }
__host__ __device__ __forceinline__ int perm32(int rho) { const int n = rho >> 4, i = rho & 15; return 8 * (i >> 2) + 4 * n + (i & 3); }
typedef __bf16 bf16x2_t __attribute__((ext_vector_type(2)));
__device__ __forceinline__ unsigned cvt_pk_bf16(float lo, float hi) { const f32x2 v = {lo, hi}; const bf16x2_t b = __builtin_convertvector(v, bf16x2_t); return __builtin_bit_cast(unsigned, b); }
__device__ __forceinline__ u32x4 pack8(const f32x4& a, const f32x4& b) { u32x4 w; w.x = cvt_pk_bf16(a[0], a[1]); w.y = cvt_pk_bf16(a[2], a[3]); w.z = cvt_pk_bf16(b[0], b[1]); w.w = cvt_pk_bf16(b[2], b[3]); return w; }
__device__ __forceinline__ void unpack8(const u32x4& w, f32x4& a, f32x4& b) {
    a[0] = __builtin_bit_cast(float, w.x << 16); a[1] = __builtin_bit_cast(float, w.x & 0xffff0000u); a[2] = __builtin_bit_cast(float, w.y << 16); a[3] = __builtin_bit_cast(float, w.y & 0xffff0000u);
    b[0] = __builtin_bit_cast(float, w.z << 16); b[1] = __builtin_bit_cast(float, w.z & 0xffff0000u); b[2] = __builtin_bit_cast(float, w.w << 16); b[3] = __builtin_bit_cast(float, w.w & 0xffff0000u); }
__device__ __forceinline__ float fsigmoid(float x) { return __builtin_amdgcn_rcpf(1.f + __builtin_amdgcn_exp2f(-1.4426950408889634f * x)); }

__device__ __forceinline__ void store16_wt(void* p, const u32x4& v) {
    __hip_atomic_store((unsigned long long*)p, ((unsigned long long)v.y << 32) | v.x, __ATOMIC_RELAXED, __HIP_MEMORY_SCOPE_AGENT);
    __hip_atomic_store((unsigned long long*)p + 1, ((unsigned long long)v.w << 32) | v.z, __ATOMIC_RELAXED, __HIP_MEMORY_SCOPE_AGENT); }
struct Unit { const char* A; const char* B; int nt; int pm, pn, aux; };

struct StaticOrder {
    int nM, nN, nwg, G, c;
    __device__ void init(int nM_, int nN_, int G_, int c_) { nM = nM_; nN = nN_; nwg = nM * nN; G = G_; c = c_; }
    __device__ bool next(int i, int& pm, int& pn) const {
        const long L = (long)i * G + c; if (L >= nwg) return false;
        int wgid = (int)L; { const int q = nwg / NXCD, r = nwg % NXCD, xcd = wgid % NXCD, off = wgid / NXCD; wgid = (xcd < r ? xcd * (q + 1) : r * (q + 1) + (xcd - r) * q) + off; }
        const int nig = WGM * nN, gid = wgid / nig, fm = gid * WGM, gsz = (nM - fm) < WGM ? (nM - fm) : WGM;
        pm = fm + ((wgid % nig) % gsz); pn = (wgid % nig) / gsz; return true;
    }
};

template <class P>
__device__ __forceinline__ void gemm_phase(LAS unsigned char* lds, P& ph) {
    const int tid = threadIdx.x, wid = __builtin_amdgcn_readfirstlane(tid >> 6), lane = tid & 63, wr = wid >> 2, wc = wid & 3, fr = lane & 15, fq = lane >> 4;
    const unsigned lda = ph.lda, ldb = ph.ldb;
    int Rr[2], Cc[2]; unsigned voffB[2], vo[2][2], nvo[2][2];
#pragma unroll
    for (int i = 0; i < 2; ++i) { stage_rc(tid * 16 + i * 8192, Rr[i], Cc[i]); const int Rb = (Rr[i] & ~31) + perm32(Rr[i] & 31); voffB[i] = (unsigned)Rb * ldb + (unsigned)Cc[i] * 2u; }
    const size_t kstep = (size_t)(BK * 2);
    const size_t hstepB = (size_t)HALF * ldb;
    const unsigned ldsw = (unsigned)wid * 1024u;
    const int aoff = lds_byte(wr * 64 + fr, fq * 8), boff = lds_byte(wc * 32 + fr, fq * 8);
#define PG_SA(b, h) (((b) * 2 + (h)) * HTB)
#define PG_SB(b, h) ((4 + (b) * 2 + (h)) * HTB)
#define PG_STAGE_B(bufoff, gbase) do { _Pragma("unroll") for (int _i = 0; _i < 2; ++_i) \
        __builtin_amdgcn_global_load_lds((const unsigned*)((const char*)(gbase) + voffB[_i]), (LAS unsigned*)(lds + (bufoff) + ldsw + _i * 8192), 16, 0, 0); } while (0)
#define PG_STAGE_A(bufoff, gbase, VO, h) do { _Pragma("unroll") for (int _i = 0; _i < 2; ++_i) \
        __builtin_amdgcn_global_load_lds((const unsigned*)((const char*)(gbase) + (VO)[h][_i]), (LAS unsigned*)(lds + (bufoff) + ldsw + _i * 8192), 16, 0, 0); } while (0)
#define PG_LDA(dst, b, h) do { _Pragma("unroll") for (int m = 0; m < 4; ++m) _Pragma("unroll") for (int k = 0; k < 2; ++k) dst[m][k] = *(const LAS bf16x8*)(lds + PG_SA(b, h) + aoff + m * 2048 + k * 1024); } while (0)
#define PG_LDB(dst, b, h) do { _Pragma("unroll") for (int n = 0; n < 2; ++n) _Pragma("unroll") for (int k = 0; k < 2; ++k) dst[n][k] = *(const LAS bf16x8*)(lds + PG_SB(b, h) + boff + n * 2048 + k * 1024); } while (0)
#define PG_MMA(ai, bj, At, Bt) do { __builtin_amdgcn_s_setprio(1); _Pragma("unroll") for (int m = 0; m < 4; ++m) _Pragma("unroll") for (int n = 0; n < 2; ++n) _Pragma("unroll") for (int k = 0; k < 2; ++k) \
        acc[ai][bj][m][n] = __builtin_amdgcn_mfma_f32_16x16x32_bf16(Bt[n][k], At[m][k], acc[ai][bj][m][n], 0, 0, 0); __builtin_amdgcn_s_setprio(0); } while (0)
#define PG_WAIT_V(n) asm volatile("s_waitcnt vmcnt(" #n ")" ::: "memory")
#define PG_WAIT_L(n) asm volatile("s_waitcnt lgkmcnt(" #n ")" ::: "memory")
#define PG_BAR __builtin_amdgcn_s_barrier()
#define PG_SCHED __builtin_amdgcn_sched_barrier(0)
    Unit cur, nxt; int ui = 0;
    if (!ph.next(0, cur)) return;
    ph.offs(cur, Rr, Cc, vo);
    f32x4 acc[2][2][4][2];
#pragma unroll
    for (int a = 0; a < 2; ++a)
#pragma unroll
        for (int b = 0; b < 2; ++b)
#pragma unroll
            for (int m = 0; m < 4; ++m)
#pragma unroll
                for (int n = 0; n < 2; ++n) acc[a][b][m][n] = (f32x4){0.f, 0.f, 0.f, 0.f};
    bf16x8 At[4][2], B0[2][2], B1[2][2];
    const char* cA = cur.A; const char* cB = cur.B;
    if constexpr (P::HOOKS) ph.a_ready(cur);
    PG_STAGE_B(PG_SB(0, 0), cB); PG_STAGE_B(PG_SB(0, 1), cB + hstepB); PG_STAGE_A(PG_SA(0, 0), cA, vo, 0); PG_STAGE_A(PG_SA(0, 1), cA, vo, 1);
    if (wr == 1) PG_BAR;
    PG_WAIT_V(2); PG_BAR;
    PG_STAGE_B(PG_SB(1, 0), cB + kstep); PG_STAGE_A(PG_SA(1, 0), cA + kstep, vo, 0); PG_STAGE_B(PG_SB(1, 1), cB + hstepB + kstep);
    PG_WAIT_V(6); PG_BAR;
    for (;;) {
        const bool has_next = ph.next(ui + 1, nxt);
        if constexpr (P::HOOKS) { if (has_next) ph.a_ready(nxt); }
        const int nt = cur.nt;
        const char* nA = has_next ? nxt.A : cA; const char* nB = has_next ? nxt.B : cB;
        if (P::GATHER) { if (has_next) ph.offs(nxt, Rr, Cc, nvo); else {
#pragma unroll
            for (int h = 0; h < 2; ++h)
#pragma unroll
                for (int i = 0; i < 2; ++i) nvo[h][i] = vo[h][i]; } }
#pragma unroll 1
        for (int t = 0; t < nt; t += 2) {
            const bool last = (t == nt - 2);
            const char* a1 = cA + (size_t)(t + 1) * kstep;
            const char* a2 = last ? nA : cA + (size_t)(t + 2) * kstep; const char* b2 = last ? nB : cB + (size_t)(t + 2) * kstep;
            const char* a3 = a2 + kstep; const char* b3 = b2 + kstep;
            unsigned v2[2][2];
#pragma unroll
            for (int h = 0; h < 2; ++h)
#pragma unroll
                for (int i = 0; i < 2; ++i) v2[h][i] = (P::GATHER && last) ? nvo[h][i] : vo[h][i];
            PG_LDB(B0, 0, 0); PG_LDB(B1, 0, 1); PG_SCHED; PG_LDA(At, 0, 0); PG_STAGE_A(PG_SA(1, 1), a1, vo, 1);
            PG_WAIT_V(8); PG_WAIT_L(0); PG_BAR; PG_MMA(0, 0, At, B0); PG_MMA(0, 1, At, B1); PG_BAR; PG_SCHED;
            PG_LDA(At, 0, 1); PG_STAGE_B(PG_SB(0, 0), b2); PG_STAGE_B(PG_SB(0, 1), b2 + hstepB); PG_STAGE_A(PG_SA(0, 0), a2, v2, 0);
            PG_WAIT_V(8); PG_WAIT_L(0); PG_BAR; PG_MMA(1, 0, At, B0); PG_MMA(1, 1, At, B1); PG_BAR; PG_SCHED;
            PG_LDB(B0, 1, 0); PG_LDB(B1, 1, 1); PG_SCHED; PG_LDA(At, 1, 0); PG_STAGE_A(PG_SA(0, 1), a2, v2, 1);
            PG_WAIT_V(8); PG_WAIT_L(0); PG_BAR; PG_MMA(0, 0, At, B0); PG_MMA(0, 1, At, B1); PG_BAR; PG_SCHED;
            PG_LDA(At, 1, 1); PG_STAGE_B(PG_SB(1, 0), b3); PG_STAGE_B(PG_SB(1, 1), b3 + hstepB); PG_STAGE_A(PG_SA(1, 0), a3, v2, 0);
            PG_WAIT_V(8); PG_WAIT_L(0); PG_BAR; PG_MMA(1, 0, At, B0); PG_MMA(1, 1, At, B1); PG_BAR; PG_SCHED;
        }
        if (wr == 0) PG_BAR;
        ph.epi(acc, cur, wr, wc, fr, fq);
        if constexpr (P::HOOKS) ph.done(cur);
        if (!has_next) break;
#pragma unroll
        for (int a = 0; a < 2; ++a)
#pragma unroll
            for (int b = 0; b < 2; ++b)
#pragma unroll
                for (int m = 0; m < 4; ++m)
#pragma unroll
                    for (int n = 0; n < 2; ++n) acc[a][b][m][n] = (f32x4){0.f, 0.f, 0.f, 0.f};
        cur = nxt; cA = nA; cB = nB; ++ui;
        if (P::GATHER) {
#pragma unroll
            for (int h = 0; h < 2; ++h)
#pragma unroll
                for (int i = 0; i < 2; ++i) vo[h][i] = nvo[h][i]; }
        if (wr == 1) PG_BAR;
    }
    PG_WAIT_V(0);
    PG_BAR;
#undef PG_SA
#undef PG_SB
#undef PG_STAGE_A
#undef PG_STAGE_B
#undef PG_LDA
#undef PG_LDB
#undef PG_MMA
#undef PG_WAIT_V
#undef PG_WAIT_L
#undef PG_BAR
#undef PG_SCHED
}
__device__ __forceinline__ void offs_plain(unsigned lda, const int (&R)[2], const int (&C)[2], unsigned (&vo)[2][2]) {
#pragma unroll
    for (int h = 0; h < 2; ++h)
#pragma unroll
        for (int i = 0; i < 2; ++i) vo[h][i] = (unsigned)(h * HALF + R[i]) * lda + (unsigned)C[i] * 2u;
}
}

namespace attn_body {
using bf16=unsigned short;
using bf16x8=__attribute__((ext_vector_type(8)))short;
using s16x4=__attribute__((ext_vector_type(4)))short;
using f32x16=__attribute__((ext_vector_type(16)))float;
using u32x4=__attribute__((ext_vector_type(4)))unsigned;
constexpr int BATCH=2,NHEAD=8,SEQ=8192,D=64,DM=NHEAD*D;
constexpr int NW=8,QBLK=32,QB=QBLK*NW,KVBLK=64,NQB=SEQ/QB;
constexpr int ATTN_PITCH=DM, ATTN_UNIT_ROWS=QB;
__device__ __forceinline__ int crow(int r,int hi){return (r&3)+8*(r>>2)+4*hi;}
__device__ __forceinline__ unsigned short f2bf_a(float f){unsigned u=__builtin_bit_cast(unsigned,f);return (unsigned short)((u+0x7fffu+((u>>16)&1u))>>16);}
#define SBAR() __builtin_amdgcn_sched_barrier(0)
__device__ __forceinline__ void cmask(f32x16&p0,f32x16&p1,int jb,int qrel,int hi){
  const float NEG=-INFINITY; int kb=64*jb+4*hi;
  #pragma unroll
  for(int r=0;r<16;++r){int kv=kb+(r&3)+8*(r>>2); if(kv>qrel)p0[r]=NEG; if(kv+32>qrel)p1[r]=NEG;}
}

constexpr int NSLOT=3, SLOTB=8192;
constexpr int LDS_K=0, LDS_V=NSLOT*SLOTB, LDS_WS=2*NSLOT*SLOTB, LDS_OST=LDS_WS+NW*64*4, LDS_FK=LDS_OST+NW*4096, LDS_BYTES=LDS_FK+SEQ*4+1024;
constexpr float C2=0.125f*1.4426950408889634f;
__device__ __forceinline__ void glds16(const void*gsrc,unsigned lds_dst){unsigned keep;
  asm volatile("s_mov_b32 %0, m0\n\ts_mov_b32 m0, %2\n\ts_nop 0\n\tglobal_load_lds_dwordx4 %1, off\n\ts_mov_b32 m0, %0":"=&s"(keep):"v"(gsrc),"s"(lds_dst):"memory");}
__device__ __forceinline__ float max3f(float a,float b,float c){float r;asm("v_max3_f32 %0, %1, %2, %3":"=v"(r):"v"(a),"v"(b),"v"(c));return r;}
__device__ __forceinline__ float max2f(float a,float b){float r;asm("v_max_f32_e32 %0, %1, %2":"=v"(r):"v"(a),"v"(b));return r;}
__device__ __forceinline__ float fadd_s(float a,float b){float r;asm("v_add_f32_e32 %0, %1, %2":"=v"(r):"v"(a),"v"(b));return r;}
__device__ __forceinline__ float fsub_s(float a,float b){float r;asm("v_sub_f32_e32 %0, %1, %2":"=v"(r):"v"(a),"v"(b));return r;}
typedef float f32x4_t __attribute__((ext_vector_type(4)));
typedef float f32x2_t __attribute__((ext_vector_type(2))); typedef __bf16 bf16x2_t __attribute__((ext_vector_type(2)));
__device__ __forceinline__ unsigned cvtpk_s(float lo,float hi){f32x2_t v={lo,hi};bf16x2_t b=__builtin_convertvector(v,bf16x2_t);return __builtin_bit_cast(unsigned,b);}
#define WAIT_BAR(N) asm volatile("s_waitcnt vmcnt(" #N ") lgkmcnt(0)\n\ts_barrier":::"memory")

__device__ __forceinline__ void qkt(f32x16&p0,f32x16&p1,const char*Kslot,const bf16x8*qr,int r32,int hi){
  const char*kb=Kslot+hi*1024+r32*16;
  #pragma unroll
  for(int d0=0;d0<4;++d0){
    const bf16x8 b0=*reinterpret_cast<const bf16x8*>(kb+d0*2048);
    const bf16x8 b1=*reinterpret_cast<const bf16x8*>(kb+d0*2048+512);
    p0=__builtin_amdgcn_mfma_f32_32x32x16_bf16(b0,qr[d0],p0,0,0,0);p1=__builtin_amdgcn_mfma_f32_32x32x16_bf16(b1,qr[d0],p1,0,0,0);}
}
typedef __attribute__((address_space(3))) const char* lds_cptr;
typedef short v4i16_t __attribute__((ext_vector_type(4)));
__device__ __forceinline__ void kload8(bf16x8*kf,lds_cptr kp){
  kf[0]=*(const __attribute__((address_space(3))) bf16x8*)(kp);      kf[1]=*(const __attribute__((address_space(3))) bf16x8*)(kp+512);
  kf[2]=*(const __attribute__((address_space(3))) bf16x8*)(kp+2048); kf[3]=*(const __attribute__((address_space(3))) bf16x8*)(kp+2560);
  kf[4]=*(const __attribute__((address_space(3))) bf16x8*)(kp+4096); kf[5]=*(const __attribute__((address_space(3))) bf16x8*)(kp+4608);
  kf[6]=*(const __attribute__((address_space(3))) bf16x8*)(kp+6144); kf[7]=*(const __attribute__((address_space(3))) bf16x8*)(kp+6656);
}
__device__ __forceinline__ void kload2(bf16x8*kf,lds_cptr kp,int j){ kf[2*j]=*(const __attribute__((address_space(3))) bf16x8*)(kp+j*2048); kf[2*j+1]=*(const __attribute__((address_space(3))) bf16x8*)(kp+j*2048+512); }
__device__ __forceinline__ s16x4 vtr(lds_cptr p){ return __builtin_bit_cast(s16x4,__builtin_amdgcn_ds_read_tr16_b64_v4i16((__attribute__((address_space(3))) v4i16_t*)p)); }
__device__ __forceinline__ float rowmax(const f32x16&p0,const f32x16&p1){
  float a=max3f(p0[0],p0[1],p1[0]),b=max3f(p0[2],p0[3],p1[1]);a=max3f(a,p1[2],p1[3]);
  #pragma unroll
  for(int r=4;r<16;r+=4){a=max3f(a,p0[r],p0[r+1]);b=max3f(b,p0[r+2],p0[r+3]);a=max3f(a,p1[r],p1[r+1]);b=max3f(b,p1[r+2],p1[r+3]);}
  const float m=max2f(a,b);
  auto rr=__builtin_amdgcn_permlane32_swap(__float_as_uint(m),__float_as_uint(m),false,false);
  return max2f(__uint_as_float(rr[0]),__uint_as_float(rr[1]));
}
__device__ __forceinline__ void pv(f32x16*o,int vb,bf16x8 pa0,bf16x8 pa1,bf16x8 pa2,bf16x8 pa3){
  #pragma unroll
  for(int d0=0;d0<2;++d0){s16x4 lo[4],hi[4];
    #pragma unroll
    for(int ks=0;ks<4;++ks){
      asm volatile("ds_read_b64_tr_b16 %0,%1 offset:%c2":"=&v"(lo[ks]):"v"(vb),"i"(d0*4096+ks*1024):"memory");
      asm volatile("ds_read_b64_tr_b16 %0,%1 offset:%c2":"=&v"(hi[ks]):"v"(vb),"i"(d0*4096+ks*1024+512):"memory");}
    asm volatile("s_waitcnt lgkmcnt(0)":::"memory");SBAR();
    #define PK(k) (bf16x8){lo[k][0],lo[k][1],lo[k][2],lo[k][3],hi[k][0],hi[k][1],hi[k][2],hi[k][3]}
    o[d0]=__builtin_amdgcn_mfma_f32_32x32x16_bf16(pa0,PK(0),o[d0],0,0,0);
    o[d0]=__builtin_amdgcn_mfma_f32_32x32x16_bf16(pa1,PK(1),o[d0],0,0,0);
    o[d0]=__builtin_amdgcn_mfma_f32_32x32x16_bf16(pa2,PK(2),o[d0],0,0,0);
    o[d0]=__builtin_amdgcn_mfma_f32_32x32x16_bf16(pa3,PK(3),o[d0],0,0,0);
    #undef PK
  }
}

#ifndef ATTN_STORE16
#define ATTN_STORE16(p,v) (*(u32x4*)(p)=(v))
#endif
template<int THRL> __device__ __forceinline__ void attn_unit(int b,int h,int qb,int TB,int TE,int NTM,const bf16*Q,const bf16*__restrict__ K,const bf16*__restrict__ V,bf16*O,const float*__restrict__ CUM,bf16*PObase,float*PSbase,int slot,char*shm){
  const int tid=threadIdx.x,lane=tid&63,r32=lane&31,hi=lane>>5; const int wid=__builtin_amdgcn_readfirstlane(tid>>6);
  const long rowbase=(long)b*SEQ; const int q0=qb*QB;
  const bf16*Qw=Q+(rowbase+q0+wid*QBLK)*DM+h*D;
  const bf16*Kh=K+rowbase*DM+h*D,*Vh=V+rowbase*DM+h*D; const float*Fh=CUM+((long)b*NHEAD+h)*SEQ;
  const unsigned lds0=(unsigned)(uintptr_t)shm;
  float*wsf=(float*)(shm+LDS_WS)+wid*64;
  const unsigned koff=(unsigned)(lane*DM+wid*8)*2u;
  const unsigned voff=(unsigned)((16*(wid&3)+(lane>>2))*DM+(wid>>2)*32+(lane&3)*8)*2u;
  const unsigned kdst=lds0+LDS_K+wid*1024, vdst=lds0+LDS_V+wid*1024;
  #define DMA_K(t,slot) glds16((const char*)Kh+(long)(t)*(KVBLK*DM*2)+koff,(unsigned)__builtin_amdgcn_readfirstlane(kdst+(slot)))
  #define DMA_V(t,slot) glds16((const char*)Vh+(long)(t)*(KVBLK*DM*2)+voff,(unsigned)__builtin_amdgcn_readfirstlane(vdst+(slot)))
  const int vb0=(int)(lds0+LDS_V)+((lane>>4)&1)*32+(lane&3)*8+(4*hi+((lane&15)>>2))*64;
  const char*Kbase=shm+LDS_K; bf16x8 kf[8];
  const lds_cptr shm3=(lds_cptr)shm; const lds_cptr kp0=shm3+LDS_K+hi*1024+r32*16; const lds_cptr vp0=shm3+LDS_V+((lane>>4)&1)*32+(lane&3)*8+(4*hi+((lane&15)>>2))*64;
  const int NT=TE;
  for(int p_=wid+(TB>>2);p_<=((TE*KVBLK-1)>>8);p_+=NW) glds16(Fh+p_*256+lane*4,(unsigned)__builtin_amdgcn_readfirstlane(lds0+LDS_FK+p_*1024));
  DMA_K(TB,0);DMA_V(TB,0);DMA_K(TB+1,SLOTB);
  bf16x8 qr[4];
  #pragma unroll
  for(int d0=0;d0<4;++d0)qr[d0]=*reinterpret_cast<const bf16x8*>(&Qw[(long)r32*DM+d0*16+hi*8]);
  const float fq2=Fh[q0+wid*QBLK+r32];
  float mhat=0.f,l_reg=0.f;f32x16 o[2];o[0]=f32x16{};o[1]=f32x16{};float nb=fq2;
  const lds_cptr fkp=(lds_cptr)shm+LDS_FK+hi*16;
  const int qrel=wid*QBLK+r32;
  #define CMASK(P0,P1,t) do{int jb_=(t)-(NTM-4); if(jb_>=0)cmask(P0,P1,jb_,qrel,hi);}while(0)
  bool resc=false;
  #define START(P0,P1) do{ const float rm=rowmax(P0,P1); resc=false; \
    { const float dl=rm; mhat=fadd_s(mhat,dl); \
      _Pragma("unroll") for(int r=0;r<16;++r){P0[r]=fsub_s(P0[r],dl);P1[r]=fsub_s(P1[r],dl);} \
      nb=fsub_s(fq2,mhat); } \
    _Pragma("unroll") for(int r=0;r<16;++r)P0[r]=__builtin_amdgcn_exp2f(P0[r]); }while(0)
  #define RESC() do{ if(resc){ asm volatile("s_waitcnt lgkmcnt(0)":::"memory"); \
      _Pragma("unroll") for(int d_=0;d_<2;++d_) _Pragma("unroll") for(int r=0;r<16;++r)o[d_][r]*=wsf[crow(r,hi)]; } }while(0)
  #define FILLC(C0_,C1_,tt) do{ const lds_cptr f_=fkp+(tt)*256; _Pragma("unroll") for(int a_=0;a_<4;++a_){ const f32x4_t x0_=*(const __attribute__((address_space(3))) f32x4_t*)(f_+32*a_); const f32x4_t x1_=*(const __attribute__((address_space(3))) f32x4_t*)(f_+128+32*a_); \
      _Pragma("unroll") for(int i_=0;i_<4;++i_){ C0_[4*a_+i_]=nb-x0_[i_]; C1_[4*a_+i_]=nb-x1_[i_]; } } }while(0)
  f32x16 pA0,pA1,pB0,pB1;
  int sl_prev=0,sl_cur=0,sl_next=SLOTB;
  #define ROT() do{sl_prev=sl_cur;sl_cur=sl_next;sl_next=(sl_next==(NSLOT-1)*SLOTB)?0:sl_next+SLOTB;}while(0)
  DMA_K(TB+2,2*SLOTB);
  WAIT_BAR(3);
  FILLC(pA0,pA1,TB);
  qkt(pA0,pA1,Kbase,qr,r32,hi);asm volatile("s_nop 15\n\ts_nop 7":"+v"(pA0),"+v"(pA1));CMASK(pA0,pA1,TB);
  START(pA0,pA1);
  _Pragma("unroll") for(int r=0;r<16;++r)pA1[r]=__builtin_amdgcn_exp2f(pA1[r]);
  WAIT_BAR(0);
  DMA_K(TB+3,0);DMA_V(TB+1,SLOTB);
  ROT();
  FILLC(pB0,pB1,TB+1);
  kload8(kf,kp0+sl_cur);
  WAIT_BAR(2);
  s16x4 vlo[8],vhi[8]; u32x4 pw0,pw1,pw2,pw3;
  #define PKW(P,B) cvtpk_s(P[B],P[B+1])
  #define PAF(k) __builtin_bit_cast(bf16x8,pw##k)
  #define VFR(i) (bf16x8){vlo[i][0],vlo[i][1],vlo[i][2],vlo[i][3],vhi[i][0],vhi[i][1],vhi[i][2],vhi[i][3]}
  #define PIN(x) asm volatile("":"+v"(x))
  #define MX3(a,b,c) __builtin_fmaxf(__builtin_fmaxf((a),(b)),(c))
  #define GAPA(MF,A0,A1,A2,A3,W0,W1,PW) do{ MF; sacc+=A0; sacc+=A1; sacc+=A2; sacc+=A3; PIN(sacc); W0; W1; PIN(PW); SBAR(); }while(0)
  #define EX(v) __builtin_amdgcn_exp2f(v)
  #define FLD(off) (*(const __attribute__((address_space(3))) f32x4_t*)(fk_+(off)))
  #define GAPB(MF,X,B,PF,FC,FN,NOFF) do{ MF; X[B]=EX(X[B]); X[B+1]=EX(X[B+1]); X[B+2]=EX(X[B+2]); X[B+3]=EX(X[B+3]); PF[B]=nb-FC[0]; PF[B+1]=nb-FC[1]; PF[B+2]=nb-FC[2]; PF[B+3]=nb-FC[3]; FN=FLD(NOFF); PIN(X); PIN(PF); SBAR(); }while(0)
  #define VRD(i) do{ vlo[i]=vtr(vp_+(((i)>>2)*4096+((i)&3)*1024)); vhi[i]=vtr(vp_+(((i)>>2)*4096+((i)&3)*1024+512)); }while(0)
  #define KRD(G,j) do{ if(G){ kload2(kf,kp0+sl_next,j); SBAR(); } }while(0)
  #define STEP(C0,C1,P0,P1,t,GK,GV,GL) do{ SBAR(); \
    const lds_cptr vp_=vp0+sl_prev; \
    VRD(0); SBAR(); float sacc=(P0[0]+P0[1]); \
    GAPA(C0=__builtin_amdgcn_mfma_f32_32x32x16_bf16(kf[0],qr[0],C0,0,0,0), P0[2],P0[3],P0[4],P0[5],     pw0[0]=PKW(P0,0), pw0[1]=PKW(P0,2), pw0); \
    VRD(4); SBAR(); GAPA(C1=__builtin_amdgcn_mfma_f32_32x32x16_bf16(kf[1],qr[0],C1,0,0,0), P0[6],P0[7],P0[8],P0[9],     pw0[2]=PKW(P0,4), pw0[3]=PKW(P0,6), pw0); \
    VRD(1); SBAR(); GAPA(C0=__builtin_amdgcn_mfma_f32_32x32x16_bf16(kf[2],qr[1],C0,0,0,0),   P0[10],P0[11],P0[12],P0[13], pw1[0]=PKW(P0,8), pw1[1]=PKW(P0,10), pw1); \
    VRD(5); SBAR(); GAPA(C1=__builtin_amdgcn_mfma_f32_32x32x16_bf16(kf[3],qr[1],C1,0,0,0),   P0[14],P0[15],P1[0],P1[1],   pw1[2]=PKW(P0,12),pw1[3]=PKW(P0,14), pw1); \
    VRD(2); SBAR(); GAPA(C0=__builtin_amdgcn_mfma_f32_32x32x16_bf16(kf[4],qr[2],C0,0,0,0),   P1[2],P1[3],P1[4],P1[5],     pw2[0]=PKW(P1,0), pw2[1]=PKW(P1,2), pw2); \
    VRD(6); SBAR(); GAPA(C1=__builtin_amdgcn_mfma_f32_32x32x16_bf16(kf[5],qr[2],C1,0,0,0),   P1[6],P1[7],P1[8],P1[9],     pw2[2]=PKW(P1,4), pw2[3]=PKW(P1,6), pw2); \
    VRD(3); SBAR(); GAPA(C0=__builtin_amdgcn_mfma_f32_32x32x16_bf16(kf[6],qr[3],C0,0,0,0),   P1[10],P1[11],P1[12],P1[13], pw3[0]=PKW(P1,8), pw3[1]=PKW(P1,10), pw3); \
    VRD(7); SBAR(); GAPA(C1=__builtin_amdgcn_mfma_f32_32x32x16_bf16(kf[7],qr[3],C1,0,0,0),   P1[14],P1[15],0.f,0.f,       pw3[2]=PKW(P1,12),pw3[3]=PKW(P1,14), pw3); \
    l_reg+=sacc; \
    if(GK){DMA_K((t)+3,sl_cur);} if(GV){DMA_V((t)+1,sl_next);} \
    CMASK(C0,C1,t); \
    { float a=MX3(C0[0],C0[1],C1[0]),b=MX3(C0[2],C0[3],C1[1]); a=MX3(a,C1[2],C1[3]); \
      _Pragma("unroll") for(int r=4;r<16;r+=4){a=MX3(a,C0[r],C0[r+1]);b=MX3(b,C0[r+2],C0[r+3]);a=MX3(a,C1[r],C1[r+1]);b=MX3(b,C1[r+2],C1[r+3]);} \
      float rm=__builtin_fmaxf(a,b); { auto rr=__builtin_amdgcn_permlane32_swap(__float_as_uint(rm),__float_as_uint(rm),false,false); rm=__builtin_fmaxf(__uint_as_float(rr[0]),__uint_as_float(rr[1])); } \
      resc=false; \
      if(__builtin_expect(__any(rm>(float)THRL),0)){ const float dl=__builtin_fmaxf(rm,0.f); mhat+=dl; \
        _Pragma("unroll") for(int r=0;r<16;++r){C0[r]-=dl;C1[r]-=dl;} \
        nb=fq2-mhat; \
        const float f=__builtin_amdgcn_exp2f(-dl); l_reg*=f; if(hi==0)wsf[r32]=f; resc=true; } } \
    SBAR(); \
    const lds_cptr fk_=fkp+((t)+1)*256; f32x4_t fa_=FLD(0); SBAR(); \
    GAPB(o[0]=__builtin_amdgcn_mfma_f32_32x32x16_bf16(PAF(0),VFR(0),o[0],0,0,0), C0,0, P0,fa_,fa_,32); \
    GAPB(o[1]=__builtin_amdgcn_mfma_f32_32x32x16_bf16(PAF(0),VFR(4),o[1],0,0,0), C0,4, P0,fa_,fa_,64); \
    KRD(GL,0); GAPB(o[0]=__builtin_amdgcn_mfma_f32_32x32x16_bf16(PAF(1),VFR(1),o[0],0,0,0), C0,8, P0,fa_,fa_,96); \
    KRD(GL,1); GAPB(o[1]=__builtin_amdgcn_mfma_f32_32x32x16_bf16(PAF(1),VFR(5),o[1],0,0,0), C0,12, P0,fa_,fa_,128); \
    KRD(GL,2); GAPB(o[0]=__builtin_amdgcn_mfma_f32_32x32x16_bf16(PAF(2),VFR(2),o[0],0,0,0), C1,0, P1,fa_,fa_,160); \
    KRD(GL,3); GAPB(o[1]=__builtin_amdgcn_mfma_f32_32x32x16_bf16(PAF(2),VFR(6),o[1],0,0,0), C1,4, P1,fa_,fa_,192); \
    GAPB(o[0]=__builtin_amdgcn_mfma_f32_32x32x16_bf16(PAF(3),VFR(3),o[0],0,0,0), C1,8, P1,fa_,fa_,224); \
    GAPB(o[1]=__builtin_amdgcn_mfma_f32_32x32x16_bf16(PAF(3),VFR(7),o[1],0,0,0), C1,12, P1,fa_,fa_,224); \
    }while(0)
  int t=TB+1;
  #undef CMASK
  #define CMASK(P0,P1,t) do{}while(0)
  for(;t+5<NT;t+=2){
    STEP(pB0,pB1,pA0,pA1,t,true,true,true);     WAIT_BAR(2); RESC(); ROT();
    STEP(pA0,pA1,pB0,pB1,t+1,true,true,true);   WAIT_BAR(2); RESC(); ROT();
  }
  #undef CMASK
  #define CMASK(P0,P1,t) do{int jb_=(t)-(NTM-4); if(jb_>=0)cmask(P0,P1,jb_,qrel,hi);}while(0)
  #define ENDW(tt) do{ if((tt)+3<NT){WAIT_BAR(2);} else if((tt)+2<NT){WAIT_BAR(1);} else {WAIT_BAR(0);} }while(0)
  for(;t+1<NT;t+=2){
    STEP(pB0,pB1,pA0,pA1,t,(t+3<NT),(t+1<NT),(t+1<NT));       ENDW(t);   RESC(); ROT();
    STEP(pA0,pA1,pB0,pB1,t+1,(t+4<NT),(t+2<NT),(t+2<NT));     ENDW(t+1); RESC(); ROT();
  }
  STEP(pB0,pB1,pA0,pA1,NT-1,false,false,false); RESC();
  { float sacc=pB0[0]+pB0[1]; _Pragma("unroll") for(int r=2;r<16;++r)sacc+=pB0[r]; _Pragma("unroll") for(int r=0;r<16;++r)sacc+=pB1[r]; l_reg+=sacc;
    pw0=(u32x4){PKW(pB0,0),PKW(pB0,2),PKW(pB0,4),PKW(pB0,6)};pw1=(u32x4){PKW(pB0,8),PKW(pB0,10),PKW(pB0,12),PKW(pB0,14)};pw2=(u32x4){PKW(pB1,0),PKW(pB1,2),PKW(pB1,4),PKW(pB1,6)};pw3=(u32x4){PKW(pB1,8),PKW(pB1,10),PKW(pB1,12),PKW(pB1,14)};
    SBAR(); pv(o,vb0+sl_cur,PAF(0),PAF(1),PAF(2),PAF(3)); }
  #undef PKW
  #undef PAF
  #undef VFR
  #undef PIN
  #undef MX3
  #undef GAPA
  #undef GAPB
  #undef FLD
  #undef FILLC
  #undef EX
  #undef VRD
  #undef KRD
  #undef STEP
  #undef ENDW
  {auto rr=__builtin_amdgcn_permlane32_swap(__float_as_uint(l_reg),__float_as_uint(l_reg),false,false);l_reg=__uint_as_float(rr[0])+__uint_as_float(rr[1]);}
  const bool part=(slot!=1023); bf16*PO=PObase+(long)slot*(256*D); float*PS=PSbase+(long)slot*512;
  if(hi==0){wsf[32+r32]=part?1.f:l_reg; if(part){PS[(wid*QBLK+r32)*2]=mhat;PS[(wid*QBLK+r32)*2+1]=l_reg;}}asm volatile("s_waitcnt lgkmcnt(0)":::"memory");
  float rli[16];
  #pragma unroll
  for(int r=0;r<16;++r)rli[r]=__builtin_amdgcn_rcpf(wsf[32+crow(r,hi)]);
  bf16*Ow=part?PO+(long)(wid*QBLK)*D:O+(rowbase+q0+wid*QBLK)*DM+h*D; const long opitch=part?D:DM;
  { bf16*stg=(bf16*)(shm+LDS_OST)+wid*2048;
    #pragma unroll
    for(int r=0;r<16;++r){const int orow=crow(r,hi);
      #pragma unroll
      for(int d0=0;d0<2;++d0)stg[orow*64+d0*32+r32]=f2bf_a(o[d0][r]*rli[r]);}
    asm volatile("s_waitcnt lgkmcnt(0)":::"memory");
    #pragma unroll
    for(int i=0;i<4;++i){const int row=i*8+(lane>>3),ch=lane&7; const u32x4 v=*(const u32x4*)(stg+row*64+ch*8); ATTN_STORE16(Ow+(long)row*opitch+ch*8,v);} }
  asm volatile("s_waitcnt lgkmcnt(0)\n\ts_barrier":::"memory");
  #undef DMA_K
  #undef DMA_V
  #undef CMASK
  #undef START
  #undef RESC
  #undef ROT
}
constexpr int ATTN_LDS_BYTES=LDS_BYTES;
struct AttnTensors { const bf16* Q; const bf16* K; const bf16* V; bf16* O; const float* CUM; const int* T0; bf16* PO; float* PS; unsigned* qctr; };
constexpr int MAX_ITEMS=1408, PO_SLOTS=640;
__device__ __forceinline__ void unit_split(int Lt,int SEG,int&nseg,int&len){ nseg=(Lt+SEG-1)/SEG; len=2*(((Lt>>1)+nseg-1)/nseg); }
template<bool COMBINE> __device__ __forceinline__ int build_worklist(const int*T0,unsigned*wl,unsigned*tmp,int*sc){
  const int tid=threadIdx.x; const int qb=tid&31; const int t0=T0[tid]; const int Lt=4*qb+4-t0;
  __syncthreads();
  int SEG=40,nseg,len;
  for(int pass=0;pass<2;++pass){
    unit_split(Lt,SEG,nseg,len);
    sc[tid]=nseg; sc[512+tid]=nseg>1?nseg:0; sc[1024+tid]=nseg>1?1:0; __syncthreads();
    for(int o=1;o<512;o<<=1){ const int a=tid>=o?sc[tid-o]:0, c=tid>=o?sc[512+tid-o]:0, e=tid>=o?sc[1024+tid-o]:0; __syncthreads(); sc[tid]+=a; sc[512+tid]+=c; sc[1024+tid]+=e; __syncthreads(); }
    if(sc[1023]<=PO_SLOTS&&sc[511]<=MAX_ITEMS)break;
    __syncthreads(); SEG=64;
  }
  const int ioff=sc[tid]-nseg, poff=sc[512+tid]-(nseg>1?nseg:0), NI=sc[511], NS=sc[1535], sord=sc[1024+tid]-1;
  __syncthreads();
  if(COMBINE){ if(nseg>1)wl[sord]=(unsigned)tid|((unsigned)nseg<<9)|((unsigned)poff<<12); __syncthreads(); return NS; }
  for(int sgi=0;sgi<nseg;++sgi){ const int lb=t0+sgi*len, le=min(lb+len,4*qb+4); tmp[ioff+sgi]=(unsigned)tid|((unsigned)lb<<9)|((unsigned)((le-lb)>>1)<<16)|((unsigned)(nseg>1?poff+sgi:1023)<<22); }
  __syncthreads();
  { const int lane=tid&63,w=tid>>6,nch=(NI+63)>>6; int*hist=sc;
    for(int c=w;c<nch;c+=8){ const int i=c*64+lane; const int key=i<NI?(int)((tmp[i]>>16)&63u):0;
      for(int k=1;k<=32;++k){ const unsigned long long mk=__ballot(key==k); if(lane==0)hist[c*33+k]=__popcll(mk); } }
    __syncthreads();
    if(tid>=1&&tid<=32){ int run=0; for(int c=0;c<nch;++c){ const int v=hist[c*33+tid]; hist[c*33+tid]=run; run+=v; } sc[840+tid]=run; }
    __syncthreads();
    if(tid==0){ int run=0; for(int k=32;k>=1;--k){ sc[800+k]=run; run+=sc[840+k]; } }
    __syncthreads();
    for(int c=w;c<nch;c+=8){ const int i=c*64+lane; const int key=i<NI?(int)((tmp[i]>>16)&63u):0; int myr=0;
      for(int k=1;k<=32;++k){ const unsigned long long mk=__ballot(key==k); if(key==k)myr=__popcll(mk&((1ull<<lane)-1ull)); }
      if(i<NI)wl[sc[800+key]+hist[c*33+key]+myr]=tmp[i]; }
  }
  __syncthreads();
  return NI;
}
template<int THRL=8> __device__ __forceinline__ void attn_phase(char*lds,const AttnTensors&T,int vcu,int G){
  unsigned*wl=(unsigned*)(lds+LDS_BYTES); unsigned*tmp=wl+MAX_ITEMS; int*sc=(int*)lds;
  const int NI=build_worklist<false>(T.T0,wl,tmp,sc);
  volatile int*nxt=(volatile int*)(tmp);
  int idx=vcu;
  while(idx<NI){
    const unsigned it=wl[idx]; const int u=it&511,TB=(it>>9)&127,lenp=(it>>16)&63,slot=(it>>22)&1023;
    const int bh=u>>5,qb=u&31;
    attn_unit<THRL>(bh/NHEAD,bh%NHEAD,qb,TB,TB+2*lenp,4*qb+4,T.Q,T.K,T.V,T.O,T.CUM,T.PO,T.PS,slot,lds);
    if(threadIdx.x==0)*nxt=G+(int)__hip_atomic_fetch_add(T.qctr,1u,__ATOMIC_RELAXED,__HIP_MEMORY_SCOPE_AGENT);
    __syncthreads(); idx=*nxt; __syncthreads();
  }
}
__device__ __forceinline__ void attn_combine(char*lds,const AttnTensors&T,int wg,int nwg){
  unsigned*wl=(unsigned*)(lds+LDS_BYTES); unsigned*tmp=wl+MAX_ITEMS; int*sc=(int*)lds;
  const int NS=build_worklist<true>(T.T0,wl,tmp,sc);
  const int tid=threadIdx.x,row=tid>>1,ch=tid&1;
  for(int k=wg;k<NS;k+=nwg){ const unsigned it=wl[k]; const int u=it&511,nseg=(it>>9)&7,poff=(it>>12)&1023,bh=u>>5,qb=u&31,b=bh/NHEAD,h=bh%NHEAD;
    float m[4],l[4]; float M=-3.0e38f; u32x4 pv[4][4];
    #pragma unroll
    for(int sgi=0;sgi<4;++sgi){ m[sgi]=-3.0e38f; l[sgi]=0.f; const int sg=sgi<nseg?sgi:0;
      const float2 ml=*(const float2*)(T.PS+(long)(poff+sg)*512+row*2); if(sgi<nseg){m[sgi]=ml.x;l[sgi]=ml.y;} M=fmaxf(M,m[sgi]);
      const u32x4*p=(const u32x4*)(T.PO+(long)(poff+sg)*(256*D)+row*D+ch*32);
      #pragma unroll
      for(int q=0;q<4;++q)pv[sgi][q]=p[q]; }
    float acc[32]; float L=0.f;
    #pragma unroll
    for(int c=0;c<32;++c)acc[c]=0.f;
    #pragma unroll
    for(int sgi=0;sgi<4;++sgi){ const float w=sgi<nseg?__builtin_amdgcn_exp2f(m[sgi]-M):0.f; L+=w*l[sgi];
      #pragma unroll
      for(int q=0;q<4;++q){ const u32x4 v=pv[sgi][q];
        acc[8*q+0]+=w*__builtin_bit_cast(float,v.x<<16); acc[8*q+1]+=w*__builtin_bit_cast(float,v.x&0xffff0000u); acc[8*q+2]+=w*__builtin_bit_cast(float,v.y<<16); acc[8*q+3]+=w*__builtin_bit_cast(float,v.y&0xffff0000u);
        acc[8*q+4]+=w*__builtin_bit_cast(float,v.z<<16); acc[8*q+5]+=w*__builtin_bit_cast(float,v.z&0xffff0000u); acc[8*q+6]+=w*__builtin_bit_cast(float,v.w<<16); acc[8*q+7]+=w*__builtin_bit_cast(float,v.w&0xffff0000u); } }
    const float rl=1.f/L; bf16*op=T.O+((long)b*SEQ+qb*QB+row)*DM+h*D+ch*32;
    #pragma unroll
    for(int q=0;q<4;++q){ u32x4 w; w.x=cvtpk_s(acc[8*q]*rl,acc[8*q+1]*rl); w.y=cvtpk_s(acc[8*q+2]*rl,acc[8*q+3]*rl); w.z=cvtpk_s(acc[8*q+4]*rl,acc[8*q+5]*rl); w.w=cvtpk_s(acc[8*q+6]*rl,acc[8*q+7]*rl); *(u32x4*)(op+8*q)=w; }
  }
  __syncthreads();
}
#undef SBAR
#undef WAIT_BAR
}

constexpr int NWAVES = 8;
constexpr int RING_OFF = 0, RING_BYTES = 131072;
constexpr int LDSCTL_OFF = RING_BYTES, MISC_OFF = LDSCTL_OFF + 320;
constexpr int LDS_BYTES = 147456;
typedef GAS unsigned gu32;
#define RLX_AGENT __ATOMIC_RELAXED, __HIP_MEMORY_SCOPE_AGENT
#define LDS_WAIT() asm volatile("s_waitcnt lgkmcnt(0)" ::: "memory")
#define VM_WAIT() asm volatile("s_waitcnt vmcnt(0)" ::: "memory")
constexpr int CW_TMO = 0, CW_CODE = 1, CW_CNT = 64  , CW_Q0 = 128  , CW_BAR = 4096, CW_HCNT = 8192  ;

#define XB_TMO      128
#define XB_XCNT(j)  (256  + 64 * (j))
#define XB_XSUB(j)  (1280 + 64 * (j))
#define XB_XGEN(j)  (2304 + 64 * (j))
#define XB_TOP      3328
#define XB_TOPGEN   3392
#define XCD_BAR_WORDS 3456
#define XB_SPIN_CAP (1u << 18)
__device__ __forceinline__ unsigned xb_ld(unsigned* p)              { return __hip_atomic_load(p, __ATOMIC_RELAXED, __HIP_MEMORY_SCOPE_AGENT); }
__device__ __forceinline__ unsigned xb_add(unsigned* p, unsigned v) { return __hip_atomic_fetch_add(p, v, __ATOMIC_RELAXED, __HIP_MEMORY_SCOPE_AGENT); }
__device__ __forceinline__ unsigned xb_xcc_id() { return (unsigned)__builtin_amdgcn_s_getreg((3 << 11) | 20) & 0xFu; }
#define XB_SPIN(cond, bar) do { unsigned _sp = 0; while (cond) { __builtin_amdgcn_s_sleep(1); \
    if ((++_sp & 255u) == 0u) { if (xb_ld(&(bar)[XB_TMO])) break; if (_sp > XB_SPIN_CAP) { atomicAdd(&(bar)[XB_TMO], 1u); break; } } } } while (0)
struct XcdBarrier { unsigned* bar; unsigned x; volatile LAS unsigned* st; };
__device__ __forceinline__ XcdBarrier xcd_barrier_post(unsigned* bar, volatile LAS unsigned* st) {
    XcdBarrier b; b.bar = bar; b.x = xb_xcc_id(); b.st = st;
    if (threadIdx.x == 0) (void)xb_add(&bar[XB_XCNT(b.x)], 1u);
    return b;
}
__device__ __forceinline__ void xcd_barrier_complete(unsigned* bar, unsigned x, unsigned& nloc, unsigned& nx) {
    const unsigned G = gridDim.x * gridDim.y * gridDim.z;
    unsigned sum, cnt, mine, sp = 0u;
    for (;;) {
        sum = 0u; cnt = 0u; mine = 0u;
#pragma unroll
        for (unsigned j = 0; j < 16; ++j) { const unsigned c = xb_ld(&bar[XB_XCNT(j)]); sum += c; cnt += (c > 0u) ? 1u : 0u; mine = (j == x) ? c : mine; }
        if (sum == G) break;
        __builtin_amdgcn_s_sleep(1);
        if ((++sp & 255u) == 0u) { if (xb_ld(&bar[XB_TMO])) break; if (sp > XB_SPIN_CAP) { atomicAdd(&bar[XB_TMO], 1u); break; } }
    }
    nloc = mine > 0u ? mine : 1u; nx = cnt > 0u ? cnt : 1u;
}
__device__ __forceinline__ void xcd_barrier(const XcdBarrier& b) {
    asm volatile("s_waitcnt vmcnt(0)" ::: "memory");
    __syncthreads();
    if (threadIdx.x == 0) {
        unsigned* bar = b.bar;
        __builtin_amdgcn_s_waitcnt(0);
        unsigned nloc = b.st[0], nx = b.st[1];
        if (nloc == 0u) { xcd_barrier_complete(bar, b.x, nloc, nx); b.st[0] = nloc; b.st[1] = nx; }
        const unsigned old = xb_add(&bar[XB_XSUB(b.x)], 1u);
        const unsigned gen = old / nloc;
        if (old + 1u == (gen + 1u) * nloc) {
            __builtin_amdgcn_fence(__ATOMIC_RELEASE, "agent");
            asm volatile("s_waitcnt vmcnt(0)" ::: "memory");
            const unsigned og = xb_add(&bar[XB_TOP], 1u);
            const unsigned tg = og / nx;
            if (og + 1u == (tg + 1u) * nx) xb_add(&bar[XB_TOPGEN], 1u);
            else XB_SPIN(xb_ld(&bar[XB_TOPGEN]) == tg, bar);
            __builtin_amdgcn_fence(__ATOMIC_ACQUIRE, "agent");
            xb_add(&bar[XB_XGEN(b.x)], 1u);
            asm volatile("s_waitcnt vmcnt(0)" ::: "memory");
        } else {
            XB_SPIN(xb_ld(&bar[XB_XGEN(b.x)]) == gen, bar);
            __builtin_amdgcn_fence(__ATOMIC_ACQUIRE, "agent");
            asm volatile("s_waitcnt vmcnt(0)" ::: "memory");
        }
    }
    __syncthreads();
}

struct Args { const float* in[26]; float* out; unsigned char* ws; int ph_lo, ph_hi, sub, pad_; };
struct Frame {
    LAS unsigned char* lds; volatile LAS unsigned* MISC; gu32* ctl;
    int tid, lane, wave, vcu, G;
};
__device__ __forceinline__ float gelu_fast(float x) { const float z = 0.7978845608028654f * (x + 0.044715f * x * x * x); const float e = __builtin_amdgcn_exp2f(2.885390081777927f * z); return x - x * __builtin_amdgcn_rcpf(e + 1.f); }
__device__ __forceinline__ float wave_sum(float v) {
#pragma unroll
    for (int o = 1; o < 64; o <<= 1) v += __shfl_xor(v, o);
    return v;
}

struct ConvDesc { const float* W; int ldw, k0, scol; bf16* dst; int ldd; const float* kscale; };
__device__ __forceinline__ void conv_load(const ConvDesc& d, float (&v)[32], int lane) {
    const float* wp = d.W + (size_t)(d.k0 + (lane >> 5)) * d.ldw + d.scol + (lane & 31);
#pragma unroll
    for (int i = 0; i < 32; ++i) v[i] = wp[(size_t)(2 * i) * d.ldw];
}
__device__ __forceinline__ void conv_finish(const ConvDesc& d, float (&v)[32], LAS float* scr, int lane) {
    if (d.kscale) {
#pragma unroll
        for (int i = 0; i < 32; ++i) v[i] *= d.kscale[d.k0 + 2 * i + (lane >> 5)]; }
#pragma unroll
    for (int i = 0; i < 32; ++i) scr[(2 * i + (lane >> 5)) * 33 + (lane & 31)] = v[i];
    LDS_WAIT(); asm volatile("" ::: "memory");
    const int c = lane & 7;
#pragma unroll
    for (int j = 0; j < 4; ++j) { const int n = (lane >> 3) + 8 * j; const LAS float* s = scr + (8 * c) * 33 + n;
        u32x4 o; o.x = pg::cvt_pk_bf16(s[0 * 33], s[1 * 33]); o.y = pg::cvt_pk_bf16(s[2 * 33], s[3 * 33]); o.z = pg::cvt_pk_bf16(s[4 * 33], s[5 * 33]); o.w = pg::cvt_pk_bf16(s[6 * 33], s[7 * 33]);
        *(GAS u32x4*)(d.dst + (size_t)n * d.ldd + d.k0 + 8 * c) = o; }
    LDS_WAIT(); asm volatile("" ::: "memory");
}
__device__ __forceinline__ void conv_item(const float* W, int ldw, int k0, int scol, bf16* dst, int ldd, const float* kscale, LAS float* scr, int lane) {
    ConvDesc d{W, ldw, k0, scol, dst, ldd, kscale}; float v[32]; conv_load(d, v, lane); conv_finish(d, v, scr, lane);
}
__device__ __forceinline__ int inproj_src_col(int cp) { return cp < 1536 ? cp : (cp < 2048 ? cp + (OU - 1536) : (cp < 3072 ? cp + (OGA - 2048) : cp + (OGS - 3072))); }
__device__ __forceinline__ int inproj_dst_row(int cp) { const int t = cp & ~255, c = cp & 255, wc = c >> 6, bj = (c >> 5) & 1, j = c & 31; return t + 128 * bj + 32 * wc + j; }

__device__ __forceinline__ void p0_prologue(Frame& F, const Args& a) {
    unsigned char* ws = a.ws;
    LAS float* scr = (LAS float*)(F.lds + F.wave * 8704);
    LAS float* wf = (LAS float*)(F.lds + 73728);
    const int gw = F.vcu * NWAVES + F.wave, NGW = F.G * NWAVES;
    const float* w_in = a.in[2]; const int sub = a.sub;
    for (int i = F.tid; i < 8 * 1024; i += NWAVES * 64) { const int h = i >> 10, k = i & 1023; wf[i] = w_in[(size_t)k * DIN + OF + h]; }
    constexpr int I_IN = 16 * 128;
    for (int it = (sub & 1) ? gw : I_IN; it < I_IN; it += NGW) { const int kb = it >> 7, nb = it & 127, cp = nb * 32;
        conv_item(w_in, DIN, kb * 64, inproj_src_col(cp), (bf16*)(ws + WS_WIN) + (size_t)inproj_dst_row(cp) * D, D, nullptr, scr, F.lane); }
    __syncthreads();
    const float* x = a.in[0]; const float* g = a.in[1]; const float* bfg = a.in[3];
    bf16* XN = (bf16*)(ws + WS_XN); float* LOGF = (float*)(ws + WS_CUM);
    { int m = (sub & 2) ? gw : T; f32x4 v[4];
      if (m < T) { const GAS f32x4* xr = (const GAS f32x4*)(x + (size_t)m * D) + F.lane;
#pragma unroll
          for (int j = 0; j < 4; ++j) v[j] = xr[64 * j]; }
      while (m < T) {
        const int mn = m + NGW; f32x4 vn[4];
        if (mn < T) { const GAS f32x4* xr = (const GAS f32x4*)(x + (size_t)mn * D) + F.lane;
#pragma unroll
            for (int j = 0; j < 4; ++j) vn[j] = xr[64 * j]; }
        float s = 0.f;
#pragma unroll
        for (int j = 0; j < 4; ++j) s += (v[j].x * v[j].x + v[j].y * v[j].y) + (v[j].z * v[j].z + v[j].w * v[j].w);
        float f[8];
#pragma unroll
        for (int h = 0; h < 8; ++h) f[h] = 0.f;
        f32x4 xg[4];
#pragma unroll
        for (int j = 0; j < 4; ++j) { const f32x4 gg = *((const GAS f32x4*)g + 64 * j + F.lane); xg[j] = v[j] * gg;
#pragma unroll
            for (int h = 0; h < 8; ++h) { const f32x4 ww = *((const LAS f32x4*)(wf + h * 1024) + 64 * j + F.lane); f[h] += (xg[j].x * ww.x + xg[j].y * ww.y) + (xg[j].z * ww.z + xg[j].w * ww.w); } }
        const float rstd = rsqrtf(wave_sum(s) * (1.f / D) + EPS);
        float f4[4], f2[2], f1;
        { const bool up = F.lane >= 32;
#pragma unroll
          for (int i = 0; i < 4; ++i) { const float snd = up ? f[i] : f[4 + i], kp = up ? f[4 + i] : f[i]; f4[i] = kp + __shfl_xor(snd, 32); } }
        { const bool up = (F.lane & 16) != 0;
#pragma unroll
          for (int i = 0; i < 2; ++i) { const float snd = up ? f4[i] : f4[2 + i], kp = up ? f4[2 + i] : f4[i]; f2[i] = kp + __shfl_xor(snd, 16); } }
        { const bool up = (F.lane & 8) != 0; const float snd = up ? f2[0] : f2[1], kp = up ? f2[1] : f2[0]; f1 = kp + __shfl_xor(snd, 8); }
        f1 += __shfl_xor(f1, 4); f1 += __shfl_xor(f1, 2); f1 += __shfl_xor(f1, 1);
        GAS u32x2* o8 = (GAS u32x2*)(XN + (size_t)m * D) + F.lane;
#pragma unroll
        for (int j = 0; j < 4; ++j) { const f32x4 xn = xg[j] * rstd; u32x2 w; w.x = pg::cvt_pk_bf16(xn.x, xn.y); w.y = pg::cvt_pk_bf16(xn.z, xn.w); o8[64 * j] = w; }
        if ((F.lane & 7) == 0) { const int hh = F.lane >> 3, b = m / SEQ, sidx = m % SEQ; LOGF[((size_t)b * NH + hh) * SEQ + sidx] = log_sigmoid(f1 * rstd + bfg[hh]); }
#pragma unroll
        for (int j = 0; j < 4; ++j) v[j] = vn[j];
        m = mn;
      } }
    if ((sub & 4) && F.G == 256) {
        __syncthreads();
        const int g = F.vcu >> 3, q = F.vcu & 7;
        LAS f32x2* PW = (LAS f32x2*)(F.lds);
        LAS f32x2* BB = (LAS f32x2*)(F.lds + 16896);
        LAS f32x2* CT = (LAS f32x2*)(F.lds + 16896 + 8192);
        LAS float* KT = (LAS float*)(F.lds + 16896 + 16384);
        const float* A_re = a.in[6]; const float* A_im = a.in[7]; const float* log_dt = a.in[8]; const float* B_re = a.in[9]; const float* B_im = a.in[10]; const float* C_re = a.in[11]; const float* C_im = a.in[12];
        if (F.tid < NP) { const int p = F.tid;
            const double dt = exp((double)log_dt[g]), ar = A_re[g * NP + p], ai = A_im[g * NP + p];
            const double er = exp(ar * dt), abr = er * cos(ai * dt), abi = er * sin(ai * dt);
            const double nr = abr - 1.0, ni = abi, den = ar * ar + ai * ai, fr_ = (nr * ar + ni * ai) / den, fi_ = (ni * ar - nr * ai) / den;
            double pr = 1.0, pi = 0.0;
            for (int tau = 0; tau <= LCH; ++tau) { PW[tau * NP + p] = (f32x2){(float)pr, (float)pi}; const double t2 = pr * abr - pi * abi; pi = pr * abi + pi * abr; pr = t2; }
            if (q == 0) { ((float*)(ws + WS_AL))[(g * NP + p) * 2] = PW[LCH * NP + p].x; ((float*)(ws + WS_AL))[(g * NP + p) * 2 + 1] = PW[LCH * NP + p].y; }
            for (int c = 0; c < GC; ++c) { const double br = B_re[(g * NP + p) * GC + c], bi = B_im[(g * NP + p) * GC + c]; BB[p * GC + c] = (f32x2){(float)(fr_ * br - fi_ * bi), (float)(fr_ * bi + fi_ * br)}; } }
        for (int i = F.tid; i < GC * NP; i += NWAVES * 64) { const int c = i >> 6, p = i & 63; CT[p * GC + c] = (f32x2){C_re[g * GC * NP + i], C_im[g * GC * NP + i]}; }
        __syncthreads();
        { float* KTG = (float*)(ws + WS_KTG) + (size_t)g * LCH * GC * GC;
          for (int i = 4 * q * GC * GC + F.tid; i < (4 * q + 4) * GC * GC; i += NWAVES * 64) { const int tau = i >> 8, co = (i >> 4) & 15, ci = i & 15; float acc = 0.f;
#pragma unroll 4
              for (int p = 0; p < NP; ++p) { const f32x2 w = PW[tau * NP + p], b = BB[p * GC + ci], c = CT[p * GC + co]; const float wr_ = w.x * b.x - w.y * b.y, wi_ = w.x * b.y + w.y * b.x; acc += c.x * wr_ - c.y * wi_; }
              KTG[i] = acc; } }
        {
          const int n = 64 * q + (F.tid >> 3), part = F.tid & 7, j = n >> 4, co = n & 15; bf16* row = (bf16*)(ws + WS_BTY) + ((size_t)g * 512 + n) * U2P;
          auto bval = [&](int k) -> float { const int p = k & 63; const f32x2 w = PW[(j + 1) * NP + p], c = CT[p * GC + co]; return k < 64 ? (c.x * w.x - c.y * w.y) : -(c.x * w.y + c.y * w.x); };
#pragma unroll 1
          for (int it = 0; it < 2; ++it) { const int k = (it * 8 + part) * 8;
              u32x4 o; o.x = pg::cvt_pk_bf16(bval(k), bval(k + 1)); o.y = pg::cvt_pk_bf16(bval(k + 2), bval(k + 3)); o.z = pg::cvt_pk_bf16(bval(k + 4), bval(k + 5)); o.w = pg::cvt_pk_bf16(bval(k + 6), bval(k + 7)); *(GAS u32x4*)(row + k) = o; } }
        {
          const int n = 32 * q + (F.tid >> 4), part = F.tid & 15; bf16* row = (bf16*)(ws + WS_M1T) + ((size_t)g * 256 + n) * 512;
          auto mval = [&](int k) -> float { const int j = k >> 4, ci = k & 15; float x = 0.f;
              if (n < 128) { const int p = n & 63; const f32x2 w = PW[(LCH - 1 - j) * NP + p], b = BB[p * GC + ci]; x = n < 64 ? (w.x * b.x - w.y * b.y) : (w.x * b.y + w.y * b.x); }
              return x; };
#pragma unroll 1
          for (int it = 0; it < 4; ++it) { const int k = (it * 16 + part) * 8;
              u32x4 o; o.x = pg::cvt_pk_bf16(mval(k), mval(k + 1)); o.y = pg::cvt_pk_bf16(mval(k + 2), mval(k + 3)); o.z = pg::cvt_pk_bf16(mval(k + 4), mval(k + 5)); o.w = pg::cvt_pk_bf16(mval(k + 6), mval(k + 7)); *(GAS u32x4*)(row + k) = o; } }
    }
}

__device__ __forceinline__ void p1_cumsum(Frame& F, float* CUM, int* T0, const float* gq, const float* gk) {
    LAS double* part = (LAS double*)(F.lds);
    float* p = CUM + (size_t)blockIdx.x * SEQ + F.tid * 16;
    f32x4 v[4]; float run[16]; float a = 0.f;
#pragma unroll
    for (int j = 0; j < 4; ++j) v[j] = ((const GAS f32x4*)p)[j];
#pragma unroll
    for (int j = 0; j < 4; ++j) { a += v[j].x; run[4 * j] = a; a += v[j].y; run[4 * j + 1] = a; a += v[j].z; run[4 * j + 2] = a; a += v[j].w; run[4 * j + 3] = a; }
    part[F.tid] = (double)a;
    __syncthreads();
    if (F.tid < 64) { double loc[8]; double s = 0.0;
#pragma unroll
        for (int i = 0; i < 8; ++i) { loc[i] = s; s += part[F.tid * 8 + i]; }
        double incl = s;
#pragma unroll
        for (int o = 1; o < 64; o <<= 1) { const double t = __shfl_up(incl, o); if (F.lane >= o) incl += t; }
        const double excl = incl - s;
#pragma unroll
        for (int i = 0; i < 8; ++i) part[F.tid * 8 + i] = excl + loc[i]; }
    __syncthreads();
    const double base = part[F.tid];
#pragma unroll
    for (int j = 0; j < 4; ++j) { f32x4 o; o.x = (float)((base + (double)run[4 * j]) * 1.4426950408889634); o.y = (float)((base + (double)run[4 * j + 1]) * 1.4426950408889634);
        o.z = (float)((base + (double)run[4 * j + 2]) * 1.4426950408889634); o.w = (float)((base + (double)run[4 * j + 3]) * 1.4426950408889634); ((GAS f32x4*)p)[j] = o; }
    __syncthreads();
    asm volatile("s_waitcnt vmcnt(0)" ::: "memory"); __syncthreads();
    if (F.tid < 32) { float gqm = 0.f, gkm = 0.f; for (int i = 0; i < HD; ++i) { gqm = fmaxf(gqm, fabsf(gq[i])); gkm = fmaxf(gkm, fabsf(gk[i])); }
        const float thr = 2.f * 64.f * C2 * gqm * gkm + 37.f; const int qb = F.tid, NTu = 4 * qb + 4;
        const unsigned* cu = (const unsigned*)(CUM + (size_t)blockIdx.x * SEQ);
        const float fq0 = __builtin_bit_cast(float, __hip_atomic_load(cu + qb * 256, __ATOMIC_RELAXED, __HIP_MEMORY_SCOPE_AGENT));
        int lo = 0, hi = NTu - 1;
        while (lo < hi) { const int mid = (lo + hi) >> 1; const float fk = __builtin_bit_cast(float, __hip_atomic_load(cu + 64 * mid + 63, __ATOMIC_RELAXED, __HIP_MEMORY_SCOPE_AGENT)); if (fq0 - fk >= -thr) hi = mid; else lo = mid + 1; }
        int t0 = lo & ~1; t0 = t0 > NTu - 4 ? NTu - 4 : t0; T0[blockIdx.x * 32 + qb] = t0; }
    __syncthreads();
}
struct PhInProj {
    static constexpr bool GATHER = false, HOOKS = false;
    unsigned lda, ldb; const char* A; const char* B; pg::StaticOrder so;
    bf16 *Q, *K, *V, *U2X, *GA, *GS; const float *gq, *gk;
    __device__ __forceinline__ bool next(int i, pg::Unit& u) const { int pm, pn; if (!so.next(i, pm, pn)) return false; u.A = A + (size_t)pm * 256 * lda; u.B = B + (size_t)pn * 256 * ldb; u.nt = D / 64; u.pm = pm; u.pn = pn; u.aux = 0; return true; }
    __device__ __forceinline__ void offs(const pg::Unit&, const int (&R)[2], const int (&C)[2], unsigned (&vo)[2][2]) const { pg::offs_plain(lda, R, C, vo); }
    __device__ __forceinline__ void epi(const f32x4 (&acc)[2][2][4][2], const pg::Unit& u, int wr, int wc, int fr, int fq) const {
        const int pn = u.pn, row0 = u.pm * 256 + wr * 64 + fr;
        if (pn < 4) {
            const bool isq = pn < 2; const float* g = isq ? gq : gk; bf16* O = isq ? Q : K; const int cb = (pn & 1) * 256 + 64 * wc + 8 * fq; const float sc = isq ? C2 : 1.f;
            f32x4 gv[2][2];
#pragma unroll
            for (int bj = 0; bj < 2; ++bj)
#pragma unroll
                for (int n = 0; n < 2; ++n) gv[bj][n] = *(const f32x4*)(g + 32 * bj + 8 * fq + 4 * n) * sc;
#pragma unroll
            for (int ai = 0; ai < 2; ++ai)
#pragma unroll
                for (int m = 0; m < 4; ++m) { float ss = 0.f;
#pragma unroll
                    for (int bj = 0; bj < 2; ++bj)
#pragma unroll
                        for (int n = 0; n < 2; ++n) { const f32x4 v = acc[ai][bj][m][n]; ss += (v[0] * v[0] + v[1] * v[1]) + (v[2] * v[2] + v[3] * v[3]); }
                    ss += __shfl_xor(ss, 16); ss += __shfl_xor(ss, 32);
                    const float rstd = rsqrtf(ss * (1.f / 64.f) + EPS);
                    bf16* rowp = O + (size_t)(row0 + ai * 128 + m * 16) * DA + cb;
#pragma unroll
                    for (int bj = 0; bj < 2; ++bj) *(u32x4*)(rowp + 32 * bj) = pg::pack8(acc[ai][bj][m][0] * rstd * gv[bj][0], acc[ai][bj][m][1] * rstd * gv[bj][1]); }
        } else if (pn < 6) {
            const int cb = (pn - 4) * 256 + 64 * wc + 8 * fq;
#pragma unroll
            for (int ai = 0; ai < 2; ++ai)
#pragma unroll
                for (int m = 0; m < 4; ++m) { bf16* rowp = V + (size_t)(row0 + ai * 128 + m * 16) * DA + cb;
#pragma unroll
                    for (int bj = 0; bj < 2; ++bj) *(u32x4*)(rowp + 32 * bj) = pg::pack8(acc[ai][bj][m][0], acc[ai][bj][m][1]); }
        } else if (pn < 8) {
#pragma unroll
            for (int ai = 0; ai < 2; ++ai)
#pragma unroll
                for (int m = 0; m < 4; ++m) { const int row = row0 + ai * 128 + m * 16;
#pragma unroll
                    for (int bj = 0; bj < 2; ++bj) { const int cu = (pn - 6) * 256 + 64 * wc + 32 * bj + 8 * fq;
                        *(u32x4*)(U2X + u2x_index(cu >> 4, row, cu & 15)) = pg::pack8(acc[ai][bj][m][0], acc[ai][bj][m][1]); } }
        } else {
            bf16* G = pn < 12 ? GA : GS; const int cb = ((pn - 8) & 3) * 256 + 64 * wc + 8 * fq;
#pragma unroll
            for (int ai = 0; ai < 2; ++ai)
#pragma unroll
                for (int m = 0; m < 4; ++m) { bf16* rowp = G + (size_t)(row0 + ai * 128 + m * 16) * D + cb;
#pragma unroll
                    for (int bj = 0; bj < 2; ++bj) { f32x4 a = acc[ai][bj][m][0], b = acc[ai][bj][m][1];
#pragma unroll
                        for (int e = 0; e < 4; ++e) { a[e] = pg::fsigmoid(a[e]); b[e] = pg::fsigmoid(b[e]); }
                        *(u32x4*)(rowp + 32 * bj) = pg::pack8(a, b); } }
        }
    }
};

struct PhGlu {
    static constexpr bool GATHER = false, HOOKS = false;
    unsigned lda, ldb; const char* A; const char* B; pg::StaticOrder so; const bf16* Y1; bf16* YS;
    __device__ __forceinline__ bool next(int i, pg::Unit& u) const { int pm, pn; if (!so.next(i, pm, pn)) return false; u.A = A + (size_t)pm * 256 * lda; u.B = B + (size_t)pn * 256 * ldb; u.nt = DS / 64; u.pm = pm; u.pn = pn; u.aux = 0; return true; }
    __device__ __forceinline__ void offs(const pg::Unit&, const int (&R)[2], const int (&C)[2], unsigned (&vo)[2][2]) const { pg::offs_plain(lda, R, C, vo); }
    __device__ __forceinline__ void epi(const f32x4 (&acc)[2][2][4][2], const pg::Unit& u, int wr, int wc, int fr, int fq) const {
        const int row0 = u.pm * 256 + wr * 64 + fr, cb = u.pn * 256 + 32 * wc + 8 * fq;
#pragma unroll
        for (int ai = 0; ai < 2; ++ai)
#pragma unroll
            for (int m = 0; m < 4; ++m) { const size_t ro = (size_t)(row0 + ai * 128 + m * 16) * DS + cb;
#pragma unroll
                for (int bj = 0; bj < 2; ++bj) { const u32x4 yv = *(const u32x4*)(Y1 + ro + 128 * bj); f32x4 y0, y1; pg::unpack8(yv, y0, y1);
                    f32x4 a = acc[ai][bj][m][0], b = acc[ai][bj][m][1];
#pragma unroll
                    for (int e = 0; e < 4; ++e) { a[e] = y0[e] * pg::fsigmoid(a[e]); b[e] = y1[e] * pg::fsigmoid(b[e]); }
                    *(u32x4*)(YS + ro + 128 * bj) = pg::pack8(a, b); } }
    }
};
struct PhProj {
    static constexpr bool GATHER = false, HOOKS = false;
    unsigned lda, ldb; const char* O; const char* YSp; const char* WPA; const char* WPS; pg::StaticOrder so; bf16* GA; const bf16* GS;
    __device__ __forceinline__ bool next(int i, pg::Unit& u) const { int pm, pn; if (!so.next(i >> 1, pm, pn)) return false; const int sub = i & 1;
        u.A = (sub ? YSp : O) + (size_t)pm * 256 * lda; u.B = (sub ? WPS : WPA) + (size_t)pn * 256 * ldb; u.nt = DA / 64; u.pm = pm; u.pn = pn; u.aux = sub; return true; }
    __device__ __forceinline__ void offs(const pg::Unit&, const int (&R)[2], const int (&C)[2], unsigned (&vo)[2][2]) const { pg::offs_plain(lda, R, C, vo); }
    __device__ __forceinline__ void epi(const f32x4 (&acc)[2][2][4][2], const pg::Unit& u, int wr, int wc, int fr, int fq) const {
        const int row0 = u.pm * 256 + wr * 64 + fr, cb = u.pn * 256 + 32 * wc + 8 * fq; const bool sub = u.aux != 0;
#pragma unroll
        for (int ai = 0; ai < 2; ++ai)
#pragma unroll
            for (int m = 0; m < 4; ++m) { const size_t ro = (size_t)(row0 + ai * 128 + m * 16) * D + cb;
#pragma unroll
                for (int bj = 0; bj < 2; ++bj) { const u32x4 gv = *(const u32x4*)(GA + ro + 128 * bj); f32x4 g0, g1; pg::unpack8(gv, g0, g1);
                    f32x4 a = acc[ai][bj][m][0], b = acc[ai][bj][m][1];
                    if (!sub) { a = a * g0; b = b * g1; }
                    else { const u32x4 sv = *(const u32x4*)(GS + ro + 128 * bj); f32x4 s0, s1; pg::unpack8(sv, s0, s1); a = g0 + s0 * a; b = g1 + s1 * b; }
                    *(u32x4*)(GA + ro + 128 * bj) = pg::pack8(a, b); } }
    }
};
struct PhWout {
    static constexpr bool GATHER = false, HOOKS = false;
    unsigned lda, ldb; const char* A; const char* B; pg::StaticOrder so; const float* x; float* out; bf16* X2B; float* SSP;
    __device__ __forceinline__ bool next(int i, pg::Unit& u) const { int pm, pn; if (!so.next(i, pm, pn)) return false; u.A = A + (size_t)pm * 256 * lda; u.B = B + (size_t)pn * 256 * ldb; u.nt = D / 64; u.pm = pm; u.pn = pn; u.aux = 0; return true; }
    __device__ __forceinline__ void offs(const pg::Unit&, const int (&R)[2], const int (&C)[2], unsigned (&vo)[2][2]) const { pg::offs_plain(lda, R, C, vo); }
    __device__ __forceinline__ void epi(const f32x4 (&acc)[2][2][4][2], const pg::Unit& u, int wr, int wc, int fr, int fq) const {
        const int row0 = u.pm * 256 + wr * 64 + fr, cb = u.pn * 256 + 32 * wc + 8 * fq;
#pragma unroll
        for (int ai = 0; ai < 2; ++ai)
#pragma unroll
            for (int m = 0; m < 4; ++m) { const int row = row0 + ai * 128 + m * 16; const size_t ro = (size_t)row * D + cb; float ss = 0.f;
#pragma unroll
                for (int bj = 0; bj < 2; ++bj) { const f32x4 x0 = *(const f32x4*)(x + ro + 128 * bj), x1 = *(const f32x4*)(x + ro + 128 * bj + 4);
                    const f32x4 a = acc[ai][bj][m][0] + x0, b = acc[ai][bj][m][1] + x1;
                    *(u32x4*)(X2B + ro + 128 * bj) = pg::pack8(a, b);
                    ss += (a[0] * a[0] + a[1] * a[1]) + (a[2] * a[2] + a[3] * a[3]) + (b[0] * b[0] + b[1] * b[1]) + (b[2] * b[2] + b[3] * b[3]); }
                ss += __shfl_xor(ss, 16); ss += __shfl_xor(ss, 32);
                if (fq == 0) SSP[(size_t)row * 16 + u.pn * 4 + wc] = ss;
                asm volatile("" ::: "memory"); }
    }
};

__device__ __forceinline__ void p2_side_work(Frame& F, const Args& a) {
    unsigned char* ws = a.ws; const int i0 = (int)blockIdx.x - 64;
    LAS float* KT = (LAS float*)F.lds;
    for (int sl = i0; sl < NG * 8; sl += 192) { const int g = sl >> 3, q = sl & 7;
        __syncthreads();
        { const GAS f32x4* src = (const GAS f32x4*)((const float*)(ws + WS_KTG) + (size_t)g * LCH * GC * GC);
          for (int i = F.tid; i < (4 * q + 4) * GC * GC / 4; i += NWAVES * 64) *(LAS f32x4*)(KT + 4 * i) = src[i]; }
        __syncthreads();
        const int n = 64 * q + (F.tid >> 3), part = F.tid & 7, j = n >> 4, co = n & 15; bf16* row = (bf16*)(ws + WS_BTY) + ((size_t)g * 512 + n) * U2P + 128;
#pragma unroll 1
        for (int it = 0; it < 8; ++it) { const int k = (it * 8 + part) * 8, sidx = k >> 4, ci = k & 15;
            u32x4 o = (u32x4){0u, 0u, 0u, 0u};
            if (sidx <= j) { const LAS float* kp = KT + ((j - sidx) * GC + co) * GC + ci; const f32x4 k0 = *(const LAS f32x4*)kp, k1 = *(const LAS f32x4*)(kp + 4); o = pg::pack8(k0, k1); }
            *(GAS u32x4*)(row + k) = o; } }
    __syncthreads();
    LAS float* scr = (LAS float*)(F.lds + F.wave * 8704);
    constexpr int I_GLU = 8 * 16, I_PA = 8 * 32, I_OUT = 16 * 32;
    for (int it = i0 * NWAVES + F.wave; it < I_GLU + 2 * I_PA + I_OUT; it += 192 * NWAVES) { int r = it;
        if (r < I_GLU) { const int kb = r >> 4, nb = r & 15; conv_item(a.in[14], DS, kb * 64, nb * 32, (bf16*)(ws + WS_WGLU) + (size_t)(nb * 32) * DS, DS, nullptr, scr, F.lane); continue; } r -= I_GLU;
        if (r < I_PA) { const int kb = r >> 5, nb = r & 31; conv_item(a.in[15], D, kb * 64, nb * 32, (bf16*)(ws + WS_WPA) + (size_t)(nb * 32) * DA, DA, nullptr, scr, F.lane); continue; } r -= I_PA;
        if (r < I_PA) { const int kb = r >> 5, nb = r & 31; conv_item(a.in[16], D, kb * 64, nb * 32, (bf16*)(ws + WS_WPS) + (size_t)(nb * 32) * DS, DS, nullptr, scr, F.lane); continue; } r -= I_PA;
        { const int kb = r >> 5, nb = r & 31; conv_item(a.in[17], D, kb * 64, nb * 32, (bf16*)(ws + WS_WOUT) + (size_t)(nb * 32) * D, D, nullptr, scr, F.lane); } }
    if (i0 < 48) { const int r = i0; const float* gf = a.in[18]; const float* wrg = a.in[19]; const float* wre = a.in[21]; bf16* WR = (bf16*)(ws + WS_WR) + (size_t)r * D;
        for (int k = F.tid; k < D; k += NWAVES * 64) { const float w = r < 4 ? wrg[k * 4 + r] : (r < 36 ? wre[k * NE + r - 4] : 0.f); WR[k] = f2bf(w * gf[k]); } }
    __syncthreads();
}
__device__ __forceinline__ void p2_expert_weights(Frame& F, const Args& a) {
    unsigned char* ws = a.ws; LAS float* scr = (LAS float*)(F.lds + F.wave * 8704);
    const int gw = F.vcu * NWAVES + F.wave, NGW = F.G * NWAVES;
    const float* gf = a.in[18]; const float* wg = a.in[23]; const float* wu = a.in[24]; const float* wd = a.in[25];
    constexpr int I_G = 16 * 8, I_D = 4 * 32;
    constexpr int NITEMS = NE * (2 * I_G + I_D);
    auto desc = [&](int it) -> ConvDesc { const int e = it / (2 * I_G + I_D); int r = it % (2 * I_G + I_D);
        if (r < 2 * I_G) { const int up = r >= I_G; if (up) r -= I_G; const int kb = r >> 3, nb = r & 7, n0 = nb * 32;
            return ConvDesc{(up ? wu : wg) + (size_t)e * D * DE, DE, kb * 64, n0, (bf16*)(ws + WS_WGU) + ((size_t)e * 512 + 256 * (n0 >> 7) + 128 * up + (n0 & 127)) * D, D, gf}; }
        r -= 2 * I_G; const int kb = r >> 5, nb = r & 31; return ConvDesc{wd + (size_t)e * DE * D, D, kb * 64, nb * 32, (bf16*)(ws + WS_WD) + ((size_t)e * D + nb * 32) * DE, DE, nullptr}; };
    int it = (a.sub & 4) ? gw : NITEMS;
    float v[32]; ConvDesc d{}; if (it < NITEMS) { d = desc(it); conv_load(d, v, F.lane); }
    while (it < NITEMS) {
        const int itn = it + NGW; float vn[32]; ConvDesc dn{}; if (itn < NITEMS) { dn = desc(itn); conv_load(dn, vn, F.lane); }
        conv_finish(d, v, scr, F.lane);
#pragma unroll
        for (int i = 0; i < 32; ++i) v[i] = vn[i];
        d = dn; it = itn;
    }
}
__device__ __forceinline__ void p8_router(Frame& F, const Args& a) {
    unsigned char* ws = a.ws;
    constexpr int WPITCH = 2064;
    LAS unsigned char* wl = F.lds;
    LAS float* lg = (LAS float*)(F.lds + 48 * WPITCH) + F.wave * 16 * 48;
    { const GAS u32x4* src = (const GAS u32x4*)(ws + WS_WR);
      for (int i = F.tid; i < 48 * 128; i += NWAVES * 64) { const int r = i >> 7, c = i & 127; *(LAS u32x4*)(wl + r * WPITCH + c * 16) = src[i]; } }
    __syncthreads();
    const bf16* X2B = (const bf16*)(ws + WS_X2B); const float* SSP = (const float*)(ws + WS_SSP);
    const float* b_rg = a.in[20]; const float* b_re = a.in[22];
    float* RSTD = (float*)(ws + WS_RSTD); int* ROUTE = (int*)(ws + WS_ROUTE); int* CNT = (int*)(ws + WS_CTL) + CW_CNT; int* LIST = (int*)(ws + WS_LIST); float* WPOS = (float*)(ws + WS_WPOS); float* RPOS = (float*)(ws + WS_RPOS);
    const int fr = F.lane & 15, fq = F.lane >> 4;
    LAS int* lcnt = (LAS int*)(F.lds + 48 * WPITCH + NWAVES * 16 * 48 * 4);
    LAS int* lbase = lcnt + 32;
    for (int t0 = F.vcu * 64; t0 < T; t0 += F.G * 64) {
        if (F.tid < 32) lcnt[F.tid] = 0;
        __syncthreads();
        int e0 = 0, e1 = 0, lr0 = 0, lr1 = 0; float w0 = 0.f, w1 = 0.f, rstd = 0.f;
        if (F.wave < 4) {
            const int tok = t0 + F.wave * 16 + fr;
            const GAS bf16x8* xa = (const GAS bf16x8*)(X2B + (size_t)tok * D + 8 * fq);
            f32x4 acc[3]; acc[0] = acc[1] = acc[2] = (f32x4){0.f, 0.f, 0.f, 0.f};
            bf16x8 xf[32];
#pragma unroll
            for (int ks = 0; ks < 32; ++ks) xf[ks] = xa[ks * 4];
#pragma unroll
            for (int ks = 0; ks < 32; ++ks) {
#pragma unroll
                for (int n = 0; n < 3; ++n) { const bf16x8 wfr = *(const LAS bf16x8*)(wl + (n * 16 + fr) * WPITCH + ks * 64 + fq * 16);
                    acc[n] = __builtin_amdgcn_mfma_f32_16x16x32_bf16(wfr, xf[ks], acc[n], 0, 0, 0); } }
#pragma unroll
            for (int n = 0; n < 3; ++n) *(LAS f32x4*)(lg + fr * 48 + n * 16 + 4 * fq) = acc[n];
            LDS_WAIT(); asm volatile("" ::: "memory");
            if (F.lane < 16) {
                const int t = t0 + F.wave * 16 + F.lane; const LAS float* l = lg + F.lane * 48;
                float ss = 0.f; { const f32x4* sp = (const f32x4*)(SSP + (size_t)t * 16);
#pragma unroll
                    for (int i = 0; i < 4; ++i) { const f32x4 v = sp[i]; ss += (v[0] + v[1]) + (v[2] + v[3]); } }
                rstd = rsqrtf(ss * (1.f / D) + EPS);
                float gl[4]; int gs = 0;
#pragma unroll
                for (int i = 0; i < 4; ++i) gl[i] = l[i] * rstd + b_rg[i];
                float gm = gl[0];
#pragma unroll
                for (int i = 1; i < 4; ++i) if (gl[i] > gm) { gm = gl[i]; gs = i; }
                float gsum = 0.f;
#pragma unroll
                for (int i = 0; i < 4; ++i) gsum += __expf(gl[i] - gm);
                const float gtop = 1.f / gsum;
                float el[8];
#pragma unroll
                for (int i = 0; i < 8; ++i) el[i] = l[4 + gs * 8 + i] * rstd + b_re[gs * 8 + i];
                int i0 = 0; float m0 = el[0];
#pragma unroll
                for (int i = 1; i < 8; ++i) if (el[i] > m0) { m0 = el[i]; i0 = i; }
                int i1 = -1; float m1 = -3.0e38f;
#pragma unroll
                for (int i = 0; i < 8; ++i) if (i != i0 && el[i] > m1) { m1 = el[i]; i1 = i; }
                const float p1 = __expf(m1 - m0); w0 = gtop / (1.f + p1); w1 = gtop * p1 / (1.f + p1);
                e0 = gs * 8 + i0; e1 = gs * 8 + i1;
                lr0 = __hip_atomic_fetch_add(&lcnt[e0], 1, __ATOMIC_RELAXED, __HIP_MEMORY_SCOPE_WORKGROUP); lr1 = __hip_atomic_fetch_add(&lcnt[e1], 1, __ATOMIC_RELAXED, __HIP_MEMORY_SCOPE_WORKGROUP);
            }
        }
        __syncthreads();
        if (F.tid < 32) { const int c = lcnt[F.tid]; lbase[F.tid] = c ? atomicAdd(&CNT[F.tid], c) : 0; }
        __syncthreads();
        if (F.wave < 4 && F.lane < 16) {
            const int t = t0 + F.wave * 16 + F.lane; const int r0 = lbase[e0] + lr0, r1 = lbase[e1] + lr1;
            RSTD[t] = rstd; *(int4*)(ROUTE + t * 4) = make_int4(e0, e1, r0, r1);
            LIST[e0 * T + r0] = t; LIST[e1 * T + r1] = t; WPOS[e0 * T + r0] = w0; WPOS[e1 * T + r1] = w1; RPOS[e0 * T + r0] = rstd; RPOS[e1 * T + r1] = rstd;
        }
        __syncthreads();
    }
}
__device__ __forceinline__ void moe_table(Frame& F, const int* CNT, LAS int* tb) {
    if (F.tid < 64) { const int e = F.lane; int c = 0; if (e < NE) c = (int)__hip_atomic_load((const unsigned*)CNT + e, __ATOMIC_RELAXED, __HIP_MEMORY_SCOPE_AGENT);
        const int tl = (c + 255) >> 8; int incl = tl;
#pragma unroll
        for (int o = 1; o < 32; o <<= 1) { const int v = __shfl_up(incl, o); if (e >= o) incl += v; }
        if (e < NE) { tb[e] = incl - tl; tb[64 + e] = c; } if (e == NE - 1) tb[32] = incl; }
    __syncthreads();
}
__device__ __forceinline__ int moe_find(const LAS int* tb, int mt) { int e = 0;
#pragma unroll 1
    for (int i = 1; i < NE; ++i) if (mt >= tb[i]) e = i; return e; }
struct PhMoeGU {
    static constexpr bool GATHER = true, HOOKS = true;
    unsigned lda, ldb; const char* X; const char* W; const LAS int* tb; const int* LIST; const float* RPOS; bf16* H; int G, c; unsigned* hcnt;
    __device__ __forceinline__ void a_ready(const pg::Unit&) const {}
    __device__ __forceinline__ void done(const pg::Unit& u) const {
        asm volatile("s_waitcnt vmcnt(0)" ::: "memory");
        if ((threadIdx.x & 63) == 0) __hip_atomic_fetch_add(hcnt + 16 * u.pm, 1u, __ATOMIC_RELAXED, __HIP_MEMORY_SCOPE_AGENT); }
    __device__ __forceinline__ bool next(int i, pg::Unit& u) const { const int L = i * G + c; if (L >= 2 * tb[32]) return false; const int mt = L >> 1, n2 = L & 1, e = moe_find(tb, mt);
        u.A = X; u.B = W + ((size_t)e * 512 + n2 * 256) * ldb; u.nt = D / 64; u.pm = mt; u.pn = n2; u.aux = e; return true; }
    __device__ __forceinline__ void offs(const pg::Unit& u, const int (&R)[2], const int (&C)[2], unsigned (&vo)[2][2]) const {
        const int e = u.aux, cnt = tb[64 + e], r0 = (u.pm - tb[e]) * 256; const int* lp = LIST + (size_t)e * T;
#pragma unroll
        for (int h = 0; h < 2; ++h)
#pragma unroll
            for (int i = 0; i < 2; ++i) { int r = r0 + h * 128 + R[i]; r = r < cnt ? r : cnt - 1; vo[h][i] = (unsigned)lp[r] * lda + (unsigned)C[i] * 2u; }
    }
    __device__ __forceinline__ void epi(const f32x4 (&acc)[2][2][4][2], const pg::Unit& u, int wr, int wc, int fr, int fq) const {
        const int e = u.aux, r0 = (u.pm - tb[e]) * 256; const float* rp = RPOS + (size_t)e * T + r0;
#pragma unroll
        for (int ai = 0; ai < 2; ++ai)
#pragma unroll
            for (int m = 0; m < 4; ++m) { const int tr = ai * 128 + wr * 64 + m * 16 + fr; const float rs = rp[tr];
                f32x4 g0 = acc[ai][0][m][0] * rs, g1 = acc[ai][0][m][1] * rs; const f32x4 u0 = acc[ai][1][m][0] * rs, u1 = acc[ai][1][m][1] * rs;
#pragma unroll
                for (int q = 0; q < 4; ++q) { g0[q] = g0[q] * pg::fsigmoid(g0[q]) * u0[q]; g1[q] = g1[q] * pg::fsigmoid(g1[q]) * u1[q]; }
                pg::store16_wt(H + ((size_t)u.pm * 256 + tr) * DE + u.pn * 128 + 32 * wc + 8 * fq, pg::pack8(g0, g1)); }
    }
};
struct PhMoeDown {
    static constexpr bool GATHER = false, HOOKS = true;
    unsigned lda, ldb; const char* Hp; const char* W; const LAS int* tb; const float* WPOS; bf16* Y; unsigned* hcnt; unsigned* qctr; volatile LAS int* slot;
    __device__ __forceinline__ bool next(int i, pg::Unit& u) const {
        if (threadIdx.x == 0) slot[i & 1] = (int)__hip_atomic_fetch_add(qctr, 1u, __ATOMIC_RELAXED, __HIP_MEMORY_SCOPE_AGENT);
        asm volatile("s_waitcnt vmcnt(0) lgkmcnt(0)" ::: "memory"); __builtin_amdgcn_s_barrier(); asm volatile("" ::: "memory");
        const int L = slot[i & 1]; if (L >= 4 * tb[32]) return false; const int mt = L >> 2, n4 = L & 3, e = moe_find(tb, mt);
        u.A = Hp + (size_t)mt * 256 * lda; u.B = W + ((size_t)e * D + n4 * 256) * ldb; u.nt = DE / 64; u.pm = mt; u.pn = n4; u.aux = e; return true; }
    __device__ __forceinline__ void offs(const pg::Unit&, const int (&R)[2], const int (&C)[2], unsigned (&vo)[2][2]) const { pg::offs_plain(lda, R, C, vo); }
    __device__ __forceinline__ void a_ready(const pg::Unit& u) const {
        if (threadIdx.x < 64) { unsigned sp = 0;
            while ((unsigned)__builtin_amdgcn_readfirstlane(__hip_atomic_load(hcnt + 16 * u.pm, __ATOMIC_RELAXED, __HIP_MEMORY_SCOPE_AGENT)) < 16u) { __builtin_amdgcn_s_sleep(2); if (++sp > (1u << 22)) break; }
            __builtin_amdgcn_fence(__ATOMIC_ACQUIRE, "agent");
            asm volatile("s_waitcnt vmcnt(0)" ::: "memory"); }
        asm volatile("" ::: "memory"); __builtin_amdgcn_s_barrier(); asm volatile("" ::: "memory");
    }
    __device__ __forceinline__ void done(const pg::Unit&) const {}
    __device__ __forceinline__ void epi(const f32x4 (&acc)[2][2][4][2], const pg::Unit& u, int wr, int wc, int fr, int fq) const {
        const int e = u.aux, r0 = (u.pm - tb[e]) * 256; const float* wp = WPOS + (size_t)e * T + r0;
#pragma unroll
        for (int ai = 0; ai < 2; ++ai)
#pragma unroll
            for (int m = 0; m < 4; ++m) { int tr = ai * 128 + wr * 64 + m * 16 + fr; asm volatile("" : "+v"(tr));
                const float w = wp[tr]; bf16* yp = Y + (unsigned)((u.pm * 256 + tr) * D + u.pn * 256 + 32 * wc + 8 * fq);
#pragma unroll
                for (int bj = 0; bj < 2; ++bj) *(u32x4*)(yp + 128 * bj) = pg::pack8(acc[ai][bj][m][0] * w, acc[ai][bj][m][1] * w); }
    }
};
__device__ __forceinline__ void p11_combine(Frame& F, const Args& a, const LAS int* tb) {
    unsigned char* ws = a.ws; const int* ROUTE = (const int*)(ws + WS_ROUTE); const bf16* Y = (const bf16*)(ws + WS_Y); const bf16* X2B = (const bf16*)(ws + WS_X2B); float* out = a.out;
    for (int t = F.vcu * NWAVES + F.wave; t < T; t += F.G * NWAVES) {
        const int4 rt = *(const int4*)(ROUTE + t * 4);
        const GAS u32x2* y0 = (const GAS u32x2*)(Y + ((size_t)tb[rt.x] * 256 + rt.z) * D) + F.lane; const GAS u32x2* y1 = (const GAS u32x2*)(Y + ((size_t)tb[rt.y] * 256 + rt.w) * D) + F.lane;
        const GAS u32x2* xb = (const GAS u32x2*)(X2B + (size_t)t * D) + F.lane;
        GAS f32x4* o = (GAS f32x4*)(out + (size_t)t * D) + F.lane;
#pragma unroll
        for (int j = 0; j < 4; ++j) { const u32x2 a0 = y0[64 * j], a1 = y1[64 * j], xv = xb[64 * j]; f32x4 v;
            v[0] = __builtin_bit_cast(float, xv.x << 16) + (__builtin_bit_cast(float, a0.x << 16) + __builtin_bit_cast(float, a1.x << 16)); v[1] = __builtin_bit_cast(float, xv.x & 0xffff0000u) + (__builtin_bit_cast(float, a0.x & 0xffff0000u) + __builtin_bit_cast(float, a1.x & 0xffff0000u));
            v[2] = __builtin_bit_cast(float, xv.y << 16) + (__builtin_bit_cast(float, a0.y << 16) + __builtin_bit_cast(float, a1.y << 16)); v[3] = __builtin_bit_cast(float, xv.y & 0xffff0000u) + (__builtin_bit_cast(float, a0.y & 0xffff0000u) + __builtin_bit_cast(float, a1.y & 0xffff0000u));
            o[64 * j] = v; }
    }
}

struct PhSsmX {
    static constexpr bool GATHER = false, HOOKS = false;
    unsigned lda, ldb; const char* U2X; const char* M1T; float* SLOC; int g, b;
    __device__ __forceinline__ bool next(int i, pg::Unit& u) const { if (i >= 1) return false; u.A = U2X + ((size_t)(g * NCR + b * 256) * U2P + 128) * 2; u.B = M1T + (size_t)g * 256 * ldb; u.nt = 8; u.pm = b; u.pn = 0; u.aux = 0; return true; }
    __device__ __forceinline__ void offs(const pg::Unit&, const int (&R)[2], const int (&C)[2], unsigned (&vo)[2][2]) const { pg::offs_plain(lda, R, C, vo); }
    __device__ __forceinline__ void epi(const f32x4 (&acc)[2][2][4][2], const pg::Unit& u, int wr, int wc, int fr, int fq) const {
#pragma unroll
        for (int ai = 0; ai < 2; ++ai)
#pragma unroll
            for (int m = 0; m < 4; ++m) { float* p = SLOC + ((size_t)g * NCR + u.pm * 256 + ai * 128 + wr * 64 + m * 16 + fr) * 128 + 32 * wc + 8 * fq;
                *(f32x4*)p = acc[ai][0][m][0]; *(f32x4*)(p + 4) = acc[ai][0][m][1]; }
    }
};
__device__ __forceinline__ void ssm_scan(Frame& F, unsigned char* ws, int g, int b) {
    LAS f32x2* ends = (LAS f32x2*)F.lds;
    const int p = F.lane, w = F.wave;
    const float alr = ((const float*)(ws + WS_AL))[(g * NP + p) * 2], ali = ((const float*)(ws + WS_AL))[(g * NP + p) * 2 + 1];
    const float* sl = (const float*)(ws + WS_SLOC) + ((size_t)g * NCR + b * 256 + w * 32) * 128;
    float lr[32], li[32];
#pragma unroll
    for (int k = 0; k < 32; ++k) { lr[k] = __builtin_bit_cast(float, __hip_atomic_load((const unsigned*)sl + k * 128 + p, __ATOMIC_RELAXED, __HIP_MEMORY_SCOPE_AGENT)); li[k] = __builtin_bit_cast(float, __hip_atomic_load((const unsigned*)sl + k * 128 + 64 + p, __ATOMIC_RELAXED, __HIP_MEMORY_SCOPE_AGENT)); }
#pragma unroll
    for (int k = 1; k < 32; ++k) { const float nr = alr * lr[k - 1] - ali * li[k - 1] + lr[k], ni = alr * li[k - 1] + ali * lr[k - 1] + li[k]; lr[k] = nr; li[k] = ni; }
    ends[w * 64 + p] = (f32x2){lr[31], li[31]};
    float sr = alr, si = ali;
#pragma unroll
    for (int k = 0; k < 5; ++k) { const float t = sr * sr - si * si; si = 2.f * sr * si; sr = t; }
    __syncthreads();
    float cr = 0.f, ci = 0.f;
    for (int s2 = 0; s2 < w; ++s2) { const f32x2 e = ends[s2 * 64 + p]; const float t = sr * cr - si * ci + e.x; ci = sr * ci + si * cr + e.y; cr = t; }
    bf16* hp = (bf16*)(ws + WS_U2X) + ((size_t)g * NCR + b * 256 + w * 32) * U2P;
    float pr = cr, pi = ci;
#pragma unroll
    for (int k = 0; k < 32; ++k) { const float hr = (k ? lr[k - 1] : 0.f) + pr, hi = (k ? li[k - 1] : 0.f) + pi;
        hp[(size_t)k * U2P + p] = f2bf(hr); hp[(size_t)k * U2P + 64 + p] = f2bf(hi);
        const float t = alr * pr - ali * pi; pi = alr * pi + ali * pr; pr = t; }
    __syncthreads();
}
struct PhSsmY {
    static constexpr bool GATHER = false, HOOKS = false;
    unsigned lda, ldb; const char* U2Xp; const char* BTY; const bf16* U2X; const float* Dsk; bf16* Y1; int G, c;
    __device__ __forceinline__ bool next(int i, pg::Unit& u) const { const int L = i * G + c; if (L >= NG * 4) return false; const int g = L >> 2, mt = (L >> 1) & 1, nb = L & 1;
        u.A = U2Xp + (size_t)(g * NCR + mt * 256) * lda; u.B = BTY + (size_t)(g * 512 + nb * 256) * ldb; u.nt = nb ? 10 : 6; u.pm = mt; u.pn = nb; u.aux = g; return true; }
    __device__ __forceinline__ void offs(const pg::Unit&, const int (&R)[2], const int (&C)[2], unsigned (&vo)[2][2]) const { pg::offs_plain(lda, R, C, vo); }
    __device__ __forceinline__ void epi(const f32x4 (&acc)[2][2][4][2], const pg::Unit& u, int wr, int wc, int fr, int fq) const {
        const int g = u.aux;
#pragma unroll
        for (int bj = 0; bj < 2; ++bj) { const int n = u.pn * 256 + 128 * bj + 32 * wc + 8 * fq, j = n >> 4, c0 = n & 15;
            const f32x4 d0 = *(const f32x4*)(Dsk + g * GC + c0), d1 = *(const f32x4*)(Dsk + g * GC + c0 + 4);
#pragma unroll
            for (int ai = 0; ai < 2; ++ai)
#pragma unroll
                for (int m = 0; m < 4; ++m) { const int cr = u.pm * 256 + ai * 128 + wr * 64 + m * 16 + fr;
                    const u32x4 uv = *(const u32x4*)(U2X + ((size_t)g * NCR + cr) * U2P + 128 + j * GC + c0); f32x4 u0, u1; pg::unpack8(uv, u0, u1);
                    f32x4 a = acc[ai][bj][m][0] + d0 * u0, b = acc[ai][bj][m][1] + d1 * u1;
#pragma unroll
                    for (int q = 0; q < 4; ++q) { a[q] = gelu_fast(a[q]); b[q] = gelu_fast(b[q]); }
                    *(u32x4*)(Y1 + ((size_t)cr * LCH + j) * DS + g * GC + c0) = pg::pack8(a, b); } }
    }
};

__global__ void __launch_bounds__(NWAVES * 64, 2) mk_fwd(Args args) {
    extern __shared__ __attribute__((aligned(16))) unsigned char lds[];
    Frame F;
    F.lds = (LAS unsigned char*)lds; F.MISC = (volatile LAS unsigned*)(F.lds + MISC_OFF);
    F.tid = threadIdx.x; F.lane = F.tid & 63; F.wave = __builtin_amdgcn_readfirstlane(F.tid >> 6);
    F.G = gridDim.x; { const int bx = blockIdx.x; F.vcu = (F.G % 8 == 0) ? (bx % 8) * (F.G / 8) + bx / 8 : bx; }
    unsigned char* ws = args.ws; F.ctl = (gu32*)(ws + WS_CTL);
    for (int u = F.tid; u < (LDS_BYTES - LDSCTL_OFF) / 4; u += NWAVES * 64) ((LAS unsigned*)(F.lds + LDSCTL_OFF))[u] = 0u;
    __syncthreads();
    const int lo = args.ph_lo, hi = args.ph_hi;
    const bool multi = (hi - lo) > 1;
    XcdBarrier bar; bar.bar = (unsigned*)(F.ctl + CW_BAR); bar.x = 0; bar.st = nullptr;
    if (multi) bar = xcd_barrier_post((unsigned*)(F.ctl + CW_BAR), F.MISC + 8);
#define IN(k) (lo <= (k) && (k) < hi)
#define SEAM(k) do { if (IN(k) && IN((k) + 1)) xcd_barrier(bar); } while (0)
#define FRESH() do { int t_ = threadIdx.x; asm volatile("" : "+v"(t_)); F.tid = t_; F.lane = t_ & 63; } while (0)
    if (IN(0)) { FRESH(); p0_prologue(F, args); SEAM(0); }
    if (IN(1)) { FRESH();
        if (blockIdx.x < NBATCH * NH) p1_cumsum(F, (float*)(ws + WS_CUM), (int*)(ws + WS_T0), args.in[4], args.in[5]);
        PhInProj ph; ph.lda = D * 2; ph.ldb = D * 2; ph.A = (const char*)(ws + WS_XN); ph.B = (const char*)(ws + WS_WIN); ph.so.init(T / 256, 4096 / 256, F.G, (int)blockIdx.x);
        ph.Q = (bf16*)(ws + WS_Q); ph.K = (bf16*)(ws + WS_K); ph.V = (bf16*)(ws + WS_V); ph.U2X = (bf16*)(ws + WS_U2X); ph.GA = (bf16*)(ws + WS_GA); ph.GS = (bf16*)(ws + WS_GS);
        ph.gq = args.in[4]; ph.gk = args.in[5];
        pg::gemm_phase(F.lds + RING_OFF, ph);
        SEAM(1);
    }
    if (IN(2)) { FRESH();
        if (blockIdx.x < 2 * NG) {
            const int g = (int)blockIdx.x >> 1, b = (int)blockIdx.x & 1;
            PhSsmX ph; ph.lda = U2P * 2; ph.ldb = 512 * 2; ph.U2X = (const char*)(ws + WS_U2X); ph.M1T = (const char*)(ws + WS_M1T); ph.SLOC = (float*)(ws + WS_SLOC); ph.g = g; ph.b = b;
            if (args.sub & 1) pg::gemm_phase(F.lds + RING_OFF, ph);
            if (args.sub & 2) ssm_scan(F, ws, g, b);
            __syncthreads();
        } else if (F.G == 256) p2_side_work(F, args);
        p2_expert_weights(F, args); __syncthreads();
        if (IN(2) && !IN(3)) {}
    }
    if (IN(3)) {
        static_assert(attn_body::ATTN_LDS_BYTES + 2 * attn_body::MAX_ITEMS * 4 <= RING_BYTES, "attention LDS");
        const attn_body::AttnTensors AT{(const attn_body::bf16*)(ws + WS_Q), (const attn_body::bf16*)(ws + WS_K), (const attn_body::bf16*)(ws + WS_V), (attn_body::bf16*)(ws + WS_Q), (const float*)(ws + WS_CUM),
            (const int*)(ws + WS_T0), (attn_body::bf16*)(ws + WS_PO), (float*)(ws + WS_PS), (unsigned*)(F.ctl + CW_Q0)};
        attn_body::attn_phase<20>((char*)lds + RING_OFF, AT, F.vcu, F.G);
        SEAM(3);
    }
    if (IN(4)) { FRESH();
        if (F.vcu >= 128) {
            const attn_body::AttnTensors AT{(const attn_body::bf16*)(ws + WS_Q), (const attn_body::bf16*)(ws + WS_K), (const attn_body::bf16*)(ws + WS_V), (attn_body::bf16*)(ws + WS_Q), (const float*)(ws + WS_CUM),
                (const int*)(ws + WS_T0), (attn_body::bf16*)(ws + WS_PO), (float*)(ws + WS_PS), (unsigned*)(F.ctl + CW_Q0)};
            attn_body::attn_combine((char*)lds + RING_OFF, AT, F.vcu - 128, F.G - 128);
        }
        PhSsmY ph; ph.lda = U2P * 2; ph.ldb = U2P * 2; ph.U2Xp = (const char*)(ws + WS_U2X); ph.BTY = (const char*)(ws + WS_BTY); ph.U2X = (const bf16*)(ws + WS_U2X); ph.Dsk = args.in[13]; ph.Y1 = (bf16*)(ws + WS_Y1); ph.G = F.G; ph.c = F.vcu;
        pg::gemm_phase(F.lds + RING_OFF, ph);
        SEAM(4);
    }
    if (IN(5)) { FRESH();
        PhGlu ph; ph.lda = DS * 2; ph.ldb = DS * 2; ph.A = (const char*)(ws + WS_Y1); ph.B = (const char*)(ws + WS_WGLU); ph.so.init(T / 256, DS / 256, F.G, (int)blockIdx.x); ph.Y1 = (const bf16*)(ws + WS_Y1); ph.YS = (bf16*)(ws + WS_YS);
        pg::gemm_phase(F.lds + RING_OFF, ph);
        SEAM(5);
    }
    if (IN(6)) { FRESH();
        PhProj ph; ph.lda = DA * 2; ph.ldb = DA * 2; ph.O = (const char*)(ws + WS_Q); ph.YSp = (const char*)(ws + WS_YS); ph.WPA = (const char*)(ws + WS_WPA); ph.WPS = (const char*)(ws + WS_WPS);
        ph.so.init(T / 256, D / 256, F.G, (int)blockIdx.x); ph.GA = (bf16*)(ws + WS_GA); ph.GS = (const bf16*)(ws + WS_GS);
        pg::gemm_phase(F.lds + RING_OFF, ph);
        SEAM(6);
    }
    if (IN(7)) { FRESH();
        PhWout ph; ph.lda = D * 2; ph.ldb = D * 2; ph.A = (const char*)(ws + WS_GA); ph.B = (const char*)(ws + WS_WOUT); ph.so.init(T / 256, D / 256, F.G, (int)blockIdx.x);
        ph.x = args.in[0]; ph.out = args.out; ph.X2B = (bf16*)(ws + WS_X2B); ph.SSP = (float*)(ws + WS_SSP);
        pg::gemm_phase(F.lds + RING_OFF, ph);
        SEAM(7);
    }
    if (IN(8)) { FRESH(); p8_router(F, args); SEAM(8); }
    LAS int* tb = (LAS int*)(F.lds + LDSCTL_OFF + 512);
    if (IN(9)) { FRESH();
        moe_table(F, (const int*)(ws + WS_CTL) + CW_CNT, tb);
        PhMoeGU ph; ph.lda = D * 2; ph.ldb = D * 2; ph.X = (const char*)(ws + WS_X2B); ph.W = (const char*)(ws + WS_WGU); ph.tb = tb; ph.LIST = (const int*)(ws + WS_LIST); ph.RPOS = (const float*)(ws + WS_RPOS);
        ph.H = (bf16*)(ws + WS_H); ph.G = F.G; ph.c = F.vcu; ph.hcnt = (unsigned*)(F.ctl + CW_HCNT);
        pg::gemm_phase(F.lds + RING_OFF, ph);
    }
    if (IN(10)) { FRESH();
        if (!IN(9)) moe_table(F, (const int*)(ws + WS_CTL) + CW_CNT, tb);
        PhMoeDown ph; ph.lda = DE * 2; ph.ldb = DE * 2; ph.Hp = (const char*)(ws + WS_H); ph.W = (const char*)(ws + WS_WD); ph.tb = tb; ph.WPOS = (const float*)(ws + WS_WPOS); ph.Y = (bf16*)(ws + WS_Y); ph.hcnt = (unsigned*)(F.ctl + CW_HCNT); ph.qctr = (unsigned*)(F.ctl + CW_Q0 + 64); ph.slot = (volatile LAS int*)(F.lds + LDSCTL_OFF + 1024);
        pg::gemm_phase(F.lds + RING_OFF, ph);
        SEAM(10);
    }
    if (IN(11)) { FRESH();
        if (!IN(10)) moe_table(F, (const int*)(ws + WS_CTL) + CW_CNT, tb);
        p11_combine(F, args, tb);
    }
#undef IN
#undef SEAM
}

extern "C" void kernel_launch(void* const* d_in, const int* in_sizes, int n_in, void* d_out, int out_size, void* d_ws, size_t ws_size, hipStream_t stream) {
    static int grid = 0;
    if (grid == 0) {
        int dev = 0, cus = 0; (void)hipGetDevice(&dev); (void)hipDeviceGetAttribute(&cus, hipDeviceAttributeMultiprocessorCount, dev);
        (void)hipFuncSetAttribute((const void*)mk_fwd, hipFuncAttributeMaxDynamicSharedMemorySize, LDS_BYTES);
        grid = cus > 0 ? cus : 256;
    }
    (void)hipMemsetAsync((char*)d_ws + WS_CTL, 0, CTL_ZERO_BYTES, stream);
    Args a{}; for (int i = 0; i < 26; ++i) a.in[i] = (const float*)d_in[i]; a.out = (float*)d_out; a.ws = (unsigned char*)d_ws;
    a.ph_lo = 0; a.ph_hi = 12; a.sub = 7;
    hipLaunchKernelGGL(mk_fwd, dim3(grid), dim3(NWAVES * 64), LDS_BYTES, stream, a);
}
```

```cpp
#include <hip/hip_runtime.h>
#include <stdint.h>
#include <math.h>

typedef unsigned short bf16;
constexpr int T = 16384, D = 1024, SEQ = 8192, NBATCH = 2, NH = 8, HD = 64, DA = 512, DS = 512, NG = 32, GC = 16, NP = 64, NE = 32, DE = 256;
constexpr int DIN = 4104, OQ = 0, OK_ = 512, OV = 1024, OF = 1536, OU = 1544, OGA = 2056, OGS = 3080;
constexpr int LCH = 32, NCR = T / LCH;
constexpr int U2P = 640;
constexpr float EPS = 1e-6f;
constexpr float C2 = 0.125f * 1.4426950408889634f;
constexpr float LOG2E = 1.4426950408889634f;
constexpr int YROWS = 40960;

constexpr size_t MiB = 1u << 20;
constexpr size_t WS_CTL = 0, CTL_ZERO_BYTES = 1 * MiB;
constexpr size_t WS_CUM = 1 * MiB;
constexpr size_t WS_AL = 1 * MiB + 512 * 1024;
constexpr size_t WS_T0 = 1 * MiB + 768 * 1024;
constexpr size_t WS_PS = 252 * MiB;
constexpr size_t WS_PO = 229 * MiB;
constexpr size_t WS_RSTD = 2 * MiB;
constexpr size_t WS_ROUTE = 2 * MiB + 256 * 1024;
constexpr size_t WS_LIST = 3 * MiB;
constexpr size_t WS_WPOS = 5 * MiB;
constexpr size_t WS_SSP = 7 * MiB;
constexpr size_t WS_WIN = 8 * MiB;
constexpr size_t WS_SLOC = 8 * MiB;
constexpr size_t WS_WGLU = 16 * MiB, WS_WPA = 16 * MiB + 512 * 1024, WS_WPS = 17 * MiB + 512 * 1024, WS_WOUT = 18 * MiB + 512 * 1024, WS_WR = 20 * MiB + 512 * 1024;
constexpr size_t WS_M1T = 21 * MiB;
constexpr size_t WS_BTY = 29 * MiB;
constexpr size_t WS_XN = 49 * MiB;
constexpr size_t WS_WGU = 49 * MiB;
constexpr size_t WS_Q = 81 * MiB;
constexpr size_t WS_K = 97 * MiB;
constexpr size_t WS_V = 113 * MiB;
constexpr size_t WS_Y1 = 97 * MiB, WS_YS = 113 * MiB;
constexpr size_t WS_U2X = 129 * MiB;
constexpr size_t WS_GA = 149 * MiB;
constexpr size_t WS_GS = 181 * MiB;
constexpr size_t WS_X2B = 181 * MiB;
constexpr size_t WS_WD = 213 * MiB;
constexpr size_t WS_H = 229 * MiB;
constexpr size_t WS_RPOS = 249 * MiB;
constexpr size_t WS_KTG = 251 * MiB;
constexpr size_t WS_Y = 81 * MiB;
static_assert(WS_H + (size_t)YROWS * DE * 2 <= WS_RPOS && WS_RPOS + 2 * MiB <= WS_KTG && WS_KTG + MiB <= 256 * MiB && WS_Y + (size_t)YROWS * D * 2 <= WS_GS, "d_ws map");

__device__ __forceinline__ bf16 f2bf(float f) { unsigned u = __builtin_bit_cast(unsigned, f); return (bf16)((u + 0x7fffu + ((u >> 16) & 1u)) >> 16); }
__device__ __forceinline__ float bf2f(bf16 b) { return __builtin_bit_cast(float, (unsigned)b << 16); }
__device__ __forceinline__ float sigmoidf_(float x) { return 1.f / (1.f + __expf(-x)); }
__device__ __forceinline__ float gelu_tanh(float x) { const float z = 0.7978845608028654f * (x + 0.044715f * x * x * x); const float e = __expf(2.f * z); return 0.5f * x * (1.f + (1.f - 2.f / (e + 1.f))); }
__device__ __forceinline__ float log_sigmoid(float x) { return -(fmaxf(-x, 0.f) + log1pf(__expf(-fabsf(x)))); }
__device__ __forceinline__ size_t u2x_index(int g, int t, int c) { return ((size_t)g * NCR + (t / LCH)) * U2P + 128 + (t % LCH) * GC + c; }

#define LAS __attribute__((address_space(3)))
#define GAS __attribute__((address_space(1)))
typedef short bf16x8 __attribute__((ext_vector_type(8)));
typedef float f32x4 __attribute__((ext_vector_type(4)));
typedef float f32x2 __attribute__((ext_vector_type(2)));
typedef unsigned u32x4 __attribute__((ext_vector_type(4)));
typedef unsigned u32x2 __attribute__((ext_vector_type(2)));
namespace pg {
constexpr int BM = 256, BK = 64, HALF = 128, HTB = HALF * BK * 2, STAGE_BYTES = 8 * HTB, NXCD = 8, WGM = 8;
__host__ __device__ __forceinline__ int lds_byte(int r, int c) { const int st = (r >> 4) * 2 + (c >> 5), rr = r & 15, cc = c & 31, ob = rr * 64 + cc * 2; return st * 1024 + (ob ^ (((ob >> 9) & 1) << 5)); }
__host__ __device__ __forceinline__ void stage_rc(int b, int& R, int& C) { const int st = b / 1024, sb = b % 1024, swz = sb ^ (((sb >> 9) & 1) << 5); R = (st >> 1) * 16 + swz / 64; C = (st & 1) * 32 + (swz % 64) / 2; }
__host__ __device__ __forceinline__ int perm32(int rho) { const int n = rho >> 4, i = rho & 15; return 8 * (i >> 2) + 4 * n + (i & 3); }
typedef __bf16 bf16x2_t __attribute__((ext_vector_type(2)));
__device__ __forceinline__ unsigned cvt_pk_bf16(float lo, float hi) { const f32x2 v = {lo, hi}; const bf16x2_t b = __builtin_convertvector(v, bf16x2_t); return __builtin_bit_cast(unsigned, b); }
__device__ __forceinline__ u32x4 pack8(const f32x4& a, const f32x4& b) { u32x4 w; w.x = cvt_pk_bf16(a[0], a[1]); w.y = cvt_pk_bf16(a[2], a[3]); w.z = cvt_pk_bf16(b[0], b[1]); w.w = cvt_pk_bf16(b[2], b[3]); return w; }
__device__ __forceinline__ void unpack8(const u32x4& w, f32x4& a, f32x4& b) {
    a[0] = __builtin_bit_cast(float, w.x << 16); a[1] = __builtin_bit_cast(float, w.x & 0xffff0000u); a[2] = __builtin_bit_cast(float, w.y << 16); a[3] = __builtin_bit_cast(float, w.y & 0xffff0000u);
    b[0] = __builtin_bit_cast(float, w.z << 16); b[1] = __builtin_bit_cast(float, w.z & 0xffff0000u); b[2] = __builtin_bit_cast(float, w.w << 16); b[3] = __builtin_bit_cast(float, w.w & 0xffff0000u); }
__device__ __forceinline__ float fsigmoid(float x) { return __builtin_amdgcn_rcpf(1.f + __builtin_amdgcn_exp2f(-1.4426950408889634f * x)); }

__device__ __forceinline__ void store16_wt(void* p, const u32x4& v) {
    asm volatile("global_store_dwordx4 %0, %1, off sc1\n\ts_nop 1" :: "v"(p), "v"(v) : "memory"); }
struct Unit { const char* A; const char* B; int nt; int pm, pn, aux; };

struct StaticOrder {
    int nM, nN, nwg, G, c;
    __device__ void init(int nM_, int nN_, int G_, int c_) { nM = nM_; nN = nN_; nwg = nM * nN; G = G_; c = c_; }
    __device__ bool next(int i, int& pm, int& pn) const {
        const long L = (long)i * G + c; if (L >= nwg) return false;
        int wgid = (int)L; { const int q = nwg / NXCD, r = nwg % NXCD, xcd = wgid % NXCD, off = wgid / NXCD; wgid = (xcd < r ? xcd * (q + 1) : r * (q + 1) + (xcd - r) * q) + off; }
        const int nig = WGM * nN, gid = wgid / nig, fm = gid * WGM, gsz = (nM - fm) < WGM ? (nM - fm) : WGM;
        pm = fm + ((wgid % nig) % gsz); pn = (wgid % nig) / gsz; return true;
    }
};

template <class P>
__device__ __forceinline__ void gemm_phase(LAS unsigned char* lds, P& ph) {
    const int tid = threadIdx.x, wid = __builtin_amdgcn_readfirstlane(tid >> 6), lane = tid & 63, wr = wid >> 2, wc = wid & 3, fr = lane & 15, fq = lane >> 4;
    const unsigned lda = ph.lda, ldb = ph.ldb;
    int Rr[2], Cc[2]; unsigned voffB[2], vo[2][2], nvo[2][2];
#pragma unroll
    for (int i = 0; i < 2; ++i) { stage_rc(tid * 16 + i * 8192, Rr[i], Cc[i]); const int Rb = (Rr[i] & ~31) + perm32(Rr[i] & 31); voffB[i] = (unsigned)Rb * ldb + (unsigned)Cc[i] * 2u; }
    const size_t kstep = (size_t)(BK * 2);
    const size_t hstepB = (size_t)HALF * ldb;
    const unsigned ldsw = (unsigned)wid * 1024u;
    const int aoff = lds_byte(wr * 64 + fr, fq * 8), boff = lds_byte(wc * 32 + fr, fq * 8);
#define PG_SA(b, h) (((b) * 2 + (h)) * HTB)
#define PG_SB(b, h) ((4 + (b) * 2 + (h)) * HTB)
#define PG_STAGE_B(bufoff, gbase) do { _Pragma("unroll") for (int _i = 0; _i < 2; ++_i) \
        __builtin_amdgcn_global_load_lds((const unsigned*)((const char*)(gbase) + voffB[_i]), (LAS unsigned*)(lds + (bufoff) + ldsw + _i * 8192), 16, 0, 0); } while (0)
#define PG_STAGE_A(bufoff, gbase, VO, h) do { _Pragma("unroll") for (int _i = 0; _i < 2; ++_i) \
        __builtin_amdgcn_global_load_lds((const unsigned*)((const char*)(gbase) + (VO)[h][_i]), (LAS unsigned*)(lds + (bufoff) + ldsw + _i * 8192), 16, 0, 0); } while (0)
#define PG_LDA(dst, b, h) do { _Pragma("unroll") for (int m = 0; m < 4; ++m) _Pragma("unroll") for (int k = 0; k < 2; ++k) dst[m][k] = *(const LAS bf16x8*)(lds + PG_SA(b, h) + aoff + m * 2048 + k * 1024); } while (0)
#define PG_LDB(dst, b, h) do { _Pragma("unroll") for (int n = 0; n < 2; ++n) _Pragma("unroll") for (int k = 0; k < 2; ++k) dst[n][k] = *(const LAS bf16x8*)(lds + PG_SB(b, h) + boff + n * 2048 + k * 1024); } while (0)
#define PG_MMA(ai, bj, At, Bt) do { __builtin_amdgcn_s_setprio(1); _Pragma("unroll") for (int m = 0; m < 4; ++m) _Pragma("unroll") for (int n = 0; n < 2; ++n) _Pragma("unroll") for (int k = 0; k < 2; ++k) \
        acc[ai][bj][m][n] = __builtin_amdgcn_mfma_f32_16x16x32_bf16(Bt[n][k], At[m][k], acc[ai][bj][m][n], 0, 0, 0); __builtin_amdgcn_s_setprio(0); } while (0)
#define PG_WAIT_V(n) asm volatile("s_waitcnt vmcnt(" #n ")" ::: "memory")
#define PG_WAIT_L(n) asm volatile("s_waitcnt lgkmcnt(" #n ")" ::: "memory")
#define PG_BAR __builtin_amdgcn_s_barrier()
#define PG_SCHED __builtin_amdgcn_sched_barrier(0)
    Unit cur, nxt; int ui = 0;
    if (!ph.next(0, cur)) return;
    ph.offs(cur, Rr, Cc, vo);
    f32x4 acc[2][2][4][2];
#pragma unroll
    for (int a = 0; a < 2; ++a)
#pragma unroll
        for (int b = 0; b < 2; ++b)
#pragma unroll
            for (int m = 0; m < 4; ++m)
#pragma unroll
                for (int n = 0; n < 2; ++n) acc[a][b][m][n] = (f32x4){0.f, 0.f, 0.f, 0.f};
    bf16x8 At[4][2], B0[2][2], B1[2][2];
    const char* cA = cur.A; const char* cB = cur.B;
    if constexpr (P::HOOKS) ph.a_ready(cur);
    PG_STAGE_B(PG_SB(0, 0), cB); PG_STAGE_B(PG_SB(0, 1), cB + hstepB); PG_STAGE_A(PG_SA(0, 0), cA, vo, 0); PG_STAGE_A(PG_SA(0, 1), cA, vo, 1);
    if (wr == 1) PG_BAR;
    PG_WAIT_V(2); PG_BAR;
    PG_STAGE_B(PG_SB(1, 0), cB + kstep); PG_STAGE_A(PG_SA(1, 0), cA + kstep, vo, 0); PG_STAGE_B(PG_SB(1, 1), cB + hstepB + kstep);
    PG_WAIT_V(6); PG_BAR;
    for (;;) {
        const bool has_next = ph.next(ui + 1, nxt);
        if constexpr (P::HOOKS) { if (has_next) ph.a_ready(nxt); }
        const int nt = cur.nt;
        const char* nA = has_next ? nxt.A : cA; const char* nB = has_next ? nxt.B : cB;
        if (P::GATHER) { if (has_next) ph.offs(nxt, Rr, Cc, nvo); else {
#pragma unroll
            for (int h = 0; h < 2; ++h)
#pragma unroll
                for (int i = 0; i < 2; ++i) nvo[h][i] = vo[h][i]; } }
#pragma unroll 1
        for (int t = 0; t < nt; t += 2) {
            const bool last = (t == nt - 2);
            const char* a1 = cA + (size_t)(t + 1) * kstep;
            const char* a2 = last ? nA : cA + (size_t)(t + 2) * kstep; const char* b2 = last ? nB : cB + (size_t)(t + 2) * kstep;
            const char* a3 = a2 + kstep; const char* b3 = b2 + kstep;
            unsigned v2[2][2];
#pragma unroll
            for (int h = 0; h < 2; ++h)
#pragma unroll
                for (int i = 0; i < 2; ++i) v2[h][i] = (P::GATHER && last) ? nvo[h][i] : vo[h][i];
            PG_LDB(B0, 0, 0); PG_LDB(B1, 0, 1); PG_SCHED; PG_LDA(At, 0, 0); PG_STAGE_A(PG_SA(1, 1), a1, vo, 1);
            PG_WAIT_V(8); PG_WAIT_L(0); PG_BAR; PG_MMA(0, 0, At, B0); PG_MMA(0, 1, At, B1); PG_BAR; PG_SCHED;
            PG_LDA(At, 0, 1); PG_STAGE_B(PG_SB(0, 0), b2); PG_STAGE_B(PG_SB(0, 1), b2 + hstepB); PG_STAGE_A(PG_SA(0, 0), a2, v2, 0);
            PG_WAIT_V(8); PG_WAIT_L(0); PG_BAR; PG_MMA(1, 0, At, B0); PG_MMA(1, 1, At, B1); PG_BAR; PG_SCHED;
            PG_LDB(B0, 1, 0); PG_LDB(B1, 1, 1); PG_SCHED; PG_LDA(At, 1, 0); PG_STAGE_A(PG_SA(0, 1), a2, v2, 1);
            PG_WAIT_V(8); PG_WAIT_L(0); PG_BAR; PG_MMA(0, 0, At, B0); PG_MMA(0, 1, At, B1); PG_BAR; PG_SCHED;
            PG_LDA(At, 1, 1); PG_STAGE_B(PG_SB(1, 0), b3); PG_STAGE_B(PG_SB(1, 1), b3 + hstepB); PG_STAGE_A(PG_SA(1, 0), a3, v2, 0);
            PG_WAIT_V(8); PG_WAIT_L(0); PG_BAR; PG_MMA(1, 0, At, B0); PG_MMA(1, 1, At, B1); PG_BAR; PG_SCHED;
        }
        if (wr == 0) PG_BAR;
        ph.epi(acc, cur, wr, wc, fr, fq);
        if constexpr (P::HOOKS) ph.done(cur);
        if (!has_next) break;
#pragma unroll
        for (int a = 0; a < 2; ++a)
#pragma unroll
            for (int b = 0; b < 2; ++b)
#pragma unroll
                for (int m = 0; m < 4; ++m)
#pragma unroll
                    for (int n = 0; n < 2; ++n) acc[a][b][m][n] = (f32x4){0.f, 0.f, 0.f, 0.f};
        cur = nxt; cA = nA; cB = nB; ++ui;
        if (P::GATHER) {
#pragma unroll
            for (int h = 0; h < 2; ++h)
#pragma unroll
                for (int i = 0; i < 2; ++i) vo[h][i] = nvo[h][i]; }
        if (wr == 1) PG_BAR;
    }
    PG_WAIT_V(0);
    PG_BAR;
#undef PG_SA
#undef PG_SB
#undef PG_STAGE_A
#undef PG_STAGE_B
#undef PG_LDA
#undef PG_LDB
#undef PG_MMA
#undef PG_WAIT_V
#undef PG_WAIT_L
#undef PG_BAR
#undef PG_SCHED
}
__device__ __forceinline__ void offs_plain(unsigned lda, const int (&R)[2], const int (&C)[2], unsigned (&vo)[2][2]) {
#pragma unroll
    for (int h = 0; h < 2; ++h)
#pragma unroll
        for (int i = 0; i < 2; ++i) vo[h][i] = (unsigned)(h * HALF + R[i]) * lda + (unsigned)C[i] * 2u;
}
}

namespace attn_body {
using bf16=unsigned short;
using bf16x8=__attribute__((ext_vector_type(8)))short;
using s16x4=__attribute__((ext_vector_type(4)))short;
using f32x16=__attribute__((ext_vector_type(16)))float;
using u32x4=__attribute__((ext_vector_type(4)))unsigned;
constexpr int BATCH=2,NHEAD=8,SEQ=8192,D=64,DM=NHEAD*D;
constexpr int NW=8,QBLK=32,QB=QBLK*NW,KVBLK=64,NQB=SEQ/QB;
constexpr int ATTN_PITCH=DM, ATTN_UNIT_ROWS=QB;
__device__ __forceinline__ int crow(int r,int hi){return (r&3)+8*(r>>2)+4*hi;}
__device__ __forceinline__ unsigned short f2bf_a(float f){unsigned u=__builtin_bit_cast(unsigned,f);return (unsigned short)((u+0x7fffu+((u>>16)&1u))>>16);}
#define SBAR() __builtin_amdgcn_sched_barrier(0)
__device__ __forceinline__ void cmask(f32x16&p0,f32x16&p1,int jb,int qrel,int hi){
  const float NEG=-INFINITY; int kb=64*jb+4*hi;
  #pragma unroll
  for(int r=0;r<16;++r){int kv=kb+(r&3)+8*(r>>2); if(kv>qrel)p0[r]=NEG; if(kv+32>qrel)p1[r]=NEG;}
}

constexpr int NSLOT=3, SLOTB=8192;
constexpr int LDS_K=0, LDS_V=NSLOT*SLOTB, LDS_WS=2*NSLOT*SLOTB, LDS_OST=LDS_WS+NW*64*4, LDS_FK=LDS_OST+NW*4096, LDS_BYTES=LDS_FK+SEQ*4+1024;
constexpr float C2=0.125f*1.4426950408889634f;
__device__ __forceinline__ void glds16(const void*gsrc,unsigned lds_dst){unsigned keep;
  asm volatile("s_mov_b32 %0, m0\n\ts_mov_b32 m0, %2\n\ts_nop 0\n\tglobal_load_lds_dwordx4 %1, off\n\ts_mov_b32 m0, %0":"=&s"(keep):"v"(gsrc),"s"(lds_dst):"memory");}
__device__ __forceinline__ float max3f(float a,float b,float c){float r;asm("v_max3_f32 %0, %1, %2, %3":"=v"(r):"v"(a),"v"(b),"v"(c));return r;}
__device__ __forceinline__ float max2f(float a,float b){float r;asm("v_max_f32_e32 %0, %1, %2":"=v"(r):"v"(a),"v"(b));return r;}
__device__ __forceinline__ float fadd_s(float a,float b){float r;asm("v_add_f32_e32 %0, %1, %2":"=v"(r):"v"(a),"v"(b));return r;}
__device__ __forceinline__ float fsub_s(float a,float b){float r;asm("v_sub_f32_e32 %0, %1, %2":"=v"(r):"v"(a),"v"(b));return r;}
typedef float f32x4_t __attribute__((ext_vector_type(4)));
typedef float f32x2_t __attribute__((ext_vector_type(2))); typedef __bf16 bf16x2_t __attribute__((ext_vector_type(2)));
__device__ __forceinline__ unsigned cvtpk_s(float lo,float hi){f32x2_t v={lo,hi};bf16x2_t b=__builtin_convertvector(v,bf16x2_t);return __builtin_bit_cast(unsigned,b);}
#define WAIT_BAR(N) asm volatile("s_waitcnt vmcnt(" #N ") lgkmcnt(0)\n\ts_barrier":::"memory")

__device__ __forceinline__ void qkt(f32x16&p0,f32x16&p1,const char*Kslot,const bf16x8*qr,int r32,int hi){
  const char*kb=Kslot+hi*1024+r32*16;
  #pragma unroll
  for(int d0=0;d0<4;++d0){
    const bf16x8 b0=*reinterpret_cast<const bf16x8*>(kb+d0*2048);
    const bf16x8 b1=*reinterpret_cast<const bf16x8*>(kb+d0*2048+512);
    p0=__builtin_amdgcn_mfma_f32_32x32x16_bf16(b0,qr[d0],p0,0,0,0);p1=__builtin_amdgcn_mfma_f32_32x32x16_bf16(b1,qr[d0],p1,0,0,0);}
}
typedef __attribute__((address_space(3))) const char* lds_cptr;
typedef short v4i16_t __attribute__((ext_vector_type(4)));
__device__ __forceinline__ void kload8(bf16x8*kf,lds_cptr kp){
  kf[0]=*(const __attribute__((address_space(3))) bf16x8*)(kp);      kf[1]=*(const __attribute__((address_space(3))) bf16x8*)(kp+512);
  kf[2]=*(const __attribute__((address_space(3))) bf16x8*)(kp+2048); kf[3]=*(const __attribute__((address_space(3))) bf16x8*)(kp+2560);
  kf[4]=*(const __attribute__((address_space(3))) bf16x8*)(kp+4096); kf[5]=*(const __attribute__((address_space(3))) bf16x8*)(kp+4608);
  kf[6]=*(const __attribute__((address_space(3))) bf16x8*)(kp+6144); kf[7]=*(const __attribute__((address_space(3))) bf16x8*)(kp+6656);
}
__device__ __forceinline__ void kload2(bf16x8*kf,lds_cptr kp,int j){ kf[2*j]=*(const __attribute__((address_space(3))) bf16x8*)(kp+j*2048); kf[2*j+1]=*(const __attribute__((address_space(3))) bf16x8*)(kp+j*2048+512); }
__device__ __forceinline__ s16x4 vtr(lds_cptr p){ return __builtin_bit_cast(s16x4,__builtin_amdgcn_ds_read_tr16_b64_v4i16((__attribute__((address_space(3))) v4i16_t*)p)); }
__device__ __forceinline__ float rowmax(const f32x16&p0,const f32x16&p1){
  float a=max3f(p0[0],p0[1],p1[0]),b=max3f(p0[2],p0[3],p1[1]);a=max3f(a,p1[2],p1[3]);
  #pragma unroll
  for(int r=4;r<16;r+=4){a=max3f(a,p0[r],p0[r+1]);b=max3f(b,p0[r+2],p0[r+3]);a=max3f(a,p1[r],p1[r+1]);b=max3f(b,p1[r+2],p1[r+3]);}
  const float m=max2f(a,b);
  auto rr=__builtin_amdgcn_permlane32_swap(__float_as_uint(m),__float_as_uint(m),false,false);
  return max2f(__uint_as_float(rr[0]),__uint_as_float(rr[1]));
}
__device__ __forceinline__ void pv(f32x16*o,int vb,bf16x8 pa0,bf16x8 pa1,bf16x8 pa2,bf16x8 pa3){
  #pragma unroll
  for(int d0=0;d0<2;++d0){s16x4 lo[4],hi[4];
    #pragma unroll
    for(int ks=0;ks<4;++ks){
      asm volatile("ds_read_b64_tr_b16 %0,%1 offset:%c2":"=&v"(lo[ks]):"v"(vb),"i"(d0*4096+ks*1024):"memory");
      asm volatile("ds_read_b64_tr_b16 %0,%1 offset:%c2":"=&v"(hi[ks]):"v"(vb),"i"(d0*4096+ks*1024+512):"memory");}
    asm volatile("s_waitcnt lgkmcnt(0)":::"memory");SBAR();
    #define PK(k) (bf16x8){lo[k][0],lo[k][1],lo[k][2],lo[k][3],hi[k][0],hi[k][1],hi[k][2],hi[k][3]}
    o[d0]=__builtin_amdgcn_mfma_f32_32x32x16_bf16(pa0,PK(0),o[d0],0,0,0);
    o[d0]=__builtin_amdgcn_mfma_f32_32x32x16_bf16(pa1,PK(1),o[d0],0,0,0);
    o[d0]=__builtin_amdgcn_mfma_f32_32x32x16_bf16(pa2,PK(2),o[d0],0,0,0);
    o[d0]=__builtin_amdgcn_mfma_f32_32x32x16_bf16(pa3,PK(3),o[d0],0,0,0);
    #undef PK
  }
}

#ifndef ATTN_STORE16
#define ATTN_STORE16(p,v) (*(u32x4*)(p)=(v))
#endif
template<int THRL> __device__ __forceinline__ void attn_unit(int b,int h,int qb,int TB,int TE,int NTM,const bf16*Q,const bf16*__restrict__ K,const bf16*__restrict__ V,bf16*O,const float*__restrict__ CUM,bf16*PObase,float*PSbase,int slot,char*shm){
  const int tid=threadIdx.x,lane=tid&63,r32=lane&31,hi=lane>>5; const int wid=__builtin_amdgcn_readfirstlane(tid>>6);
  const long rowbase=(long)b*SEQ; const int q0=qb*QB;
  const bf16*Qw=Q+(rowbase+q0+wid*QBLK)*DM+h*D;
  const bf16*Kh=K+rowbase*DM+h*D,*Vh=V+rowbase*DM+h*D; const float*Fh=CUM+((long)b*NHEAD+h)*SEQ;
  const unsigned lds0=(unsigned)(uintptr_t)shm;
  float*wsf=(float*)(shm+LDS_WS)+wid*64;
  const unsigned koff=(unsigned)(lane*DM+wid*8)*2u;
  const unsigned voff=(unsigned)((16*(wid&3)+(lane>>2))*DM+(wid>>2)*32+(lane&3)*8)*2u;
  const unsigned kdst=lds0+LDS_K+wid*1024, vdst=lds0+LDS_V+wid*1024;
  #define DMA_K(t,slot) glds16((const char*)Kh+(long)(t)*(KVBLK*DM*2)+koff,(unsigned)__builtin_amdgcn_readfirstlane(kdst+(slot)))
  #define DMA_V(t,slot) glds16((const char*)Vh+(long)(t)*(KVBLK*DM*2)+voff,(unsigned)__builtin_amdgcn_readfirstlane(vdst+(slot)))
  const int vb0=(int)(lds0+LDS_V)+((lane>>4)&1)*32+(lane&3)*8+(4*hi+((lane&15)>>2))*64;
  const char*Kbase=shm+LDS_K; bf16x8 kf[8];
  const lds_cptr shm3=(lds_cptr)shm; const lds_cptr kp0=shm3+LDS_K+hi*1024+r32*16; const lds_cptr vp0=shm3+LDS_V+((lane>>4)&1)*32+(lane&3)*8+(4*hi+((lane&15)>>2))*64;
  const int NT=TE;
  for(int p_=wid+(TB>>2);p_<=((TE*KVBLK-1)>>8);p_+=NW) glds16(Fh+p_*256+lane*4,(unsigned)__builtin_amdgcn_readfirstlane(lds0+LDS_FK+p_*1024));
  DMA_K(TB,0);DMA_V(TB,0);DMA_K(TB+1,SLOTB);
  bf16x8 qr[4];
  #pragma unroll
  for(int d0=0;d0<4;++d0)qr[d0]=*reinterpret_cast<const bf16x8*>(&Qw[(long)r32*DM+d0*16+hi*8]);
  const float fq2=Fh[q0+wid*QBLK+r32];
  float mhat=0.f,l_reg=0.f;f32x16 o[2];o[0]=f32x16{};o[1]=f32x16{};float nb=fq2;
  const lds_cptr fkp=(lds_cptr)shm+LDS_FK+hi*16;
  const int qrel=wid*QBLK+r32;
  #define CMASK(P0,P1,t) do{int jb_=(t)-(NTM-4); if(jb_>=0)cmask(P0,P1,jb_,qrel,hi);}while(0)
  bool resc=false;
  #define START(P0,P1) do{ const float rm=rowmax(P0,P1); resc=false; \
    { const float dl=rm; mhat=fadd_s(mhat,dl); \
      _Pragma("unroll") for(int r=0;r<16;++r){P0[r]=fsub_s(P0[r],dl);P1[r]=fsub_s(P1[r],dl);} \
      nb=fsub_s(fq2,mhat); } \
    _Pragma("unroll") for(int r=0;r<16;++r)P0[r]=__builtin_amdgcn_exp2f(P0[r]); }while(0)
  #define RESC() do{ if(resc){ asm volatile("s_waitcnt lgkmcnt(0)":::"memory"); \
      _Pragma("unroll") for(int d_=0;d_<2;++d_) _Pragma("unroll") for(int r=0;r<16;++r)o[d_][r]*=wsf[crow(r,hi)]; } }while(0)
  #define FILLC(C0_,C1_,tt) do{ const lds_cptr f_=fkp+(tt)*256; _Pragma("unroll") for(int a_=0;a_<4;++a_){ const f32x4_t x0_=*(const __attribute__((address_space(3))) f32x4_t*)(f_+32*a_); const f32x4_t x1_=*(const __attribute__((address_space(3))) f32x4_t*)(f_+128+32*a_); \
      _Pragma("unroll") for(int i_=0;i_<4;++i_){ C0_[4*a_+i_]=nb-x0_[i_]; C1_[4*a_+i_]=nb-x1_[i_]; } } }while(0)
  f32x16 pA0,pA1,pB0,pB1;
  int sl_prev=0,sl_cur=0,sl_next=SLOTB;
  #define ROT() do{sl_prev=sl_cur;sl_cur=sl_next;sl_next=(sl_next==(NSLOT-1)*SLOTB)?0:sl_next+SLOTB;}while(0)
  DMA_K(TB+2,2*SLOTB);
  WAIT_BAR(3);
  FILLC(pA0,pA1,TB);
  qkt(pA0,pA1,Kbase,qr,r32,hi);asm volatile("s_nop 15\n\ts_nop 7":"+v"(pA0),"+v"(pA1));CMASK(pA0,pA1,TB);
  START(pA0,pA1);
  _Pragma("unroll") for(int r=0;r<16;++r)pA1[r]=__builtin_amdgcn_exp2f(pA1[r]);
  WAIT_BAR(0);
  DMA_K(TB+3,0);DMA_V(TB+1,SLOTB);
  ROT();
  FILLC(pB0,pB1,TB+1);
  kload8(kf,kp0+sl_cur);
  WAIT_BAR(2);
  s16x4 vlo[8],vhi[8]; u32x4 pw0,pw1,pw2,pw3;
  #define PKW(P,B) cvtpk_s(P[B],P[B+1])
  #define PAF(k) __builtin_bit_cast(bf16x8,pw##k)
  #define VFR(i) (bf16x8){vlo[i][0],vlo[i][1],vlo[i][2],vlo[i][3],vhi[i][0],vhi[i][1],vhi[i][2],vhi[i][3]}
  #define PIN(x) asm volatile("":"+v"(x))
  #define MX3(a,b,c) __builtin_fmaxf(__builtin_fmaxf((a),(b)),(c))
  #define GAPA(MF,A0,A1,A2,A3,W0,W1,PW) do{ MF; sacc+=A0; sacc+=A1; sacc+=A2; sacc+=A3; PIN(sacc); W0; W1; PIN(PW); SBAR(); }while(0)
  #define EX(v) __builtin_amdgcn_exp2f(v)
  #define FLD(off) (*(const __attribute__((address_space(3))) f32x4_t*)(fk_+(off)))
  #define GAPB(MF,X,B,PF,FC,FN,NOFF) do{ MF; X[B]=EX(X[B]); X[B+1]=EX(X[B+1]); X[B+2]=EX(X[B+2]); X[B+3]=EX(X[B+3]); PF[B]=nb-FC[0]; PF[B+1]=nb-FC[1]; PF[B+2]=nb-FC[2]; PF[B+3]=nb-FC[3]; FN=FLD(NOFF); PIN(X); PIN(PF); SBAR(); }while(0)
  #define VRD(i) do{ vlo[i]=vtr(vp_+(((i)>>2)*4096+((i)&3)*1024)); vhi[i]=vtr(vp_+(((i)>>2)*4096+((i)&3)*1024+512)); }while(0)
  #define KRD(G,j) do{ if(G){ kload2(kf,kp0+sl_next,j); SBAR(); } }while(0)
  #define STEP(C0,C1,P0,P1,t,GK,GV,GL) do{ SBAR(); \
    const lds_cptr vp_=vp0+sl_prev; \
    VRD(0); SBAR(); float sacc=(P0[0]+P0[1]); \
    GAPA(C0=__builtin_amdgcn_mfma_f32_32x32x16_bf16(kf[0],qr[0],C0,0,0,0), P0[2],P0[3],P0[4],P0[5],     pw0[0]=PKW(P0,0), pw0[1]=PKW(P0,2), pw0); \
    VRD(4); SBAR(); GAPA(C1=__builtin_amdgcn_mfma_f32_32x32x16_bf16(kf[1],qr[0],C1,0,0,0), P0[6],P0[7],P0[8],P0[9],     pw0[2]=PKW(P0,4), pw0[3]=PKW(P0,6), pw0); \
    VRD(1); SBAR(); GAPA(C0=__builtin_amdgcn_mfma_f32_32x32x16_bf16(kf[2],qr[1],C0,0,0,0),   P0[10],P0[11],P0[12],P0[13], pw1[0]=PKW(P0,8), pw1[1]=PKW(P0,10), pw1); \
    VRD(5); SBAR(); GAPA(C1=__builtin_amdgcn_mfma_f32_32x32x16_bf16(kf[3],qr[1],C1,0,0,0),   P0[14],P0[15],P1[0],P1[1],   pw1[2]=PKW(P0,12),pw1[3]=PKW(P0,14), pw1); \
    VRD(2); SBAR(); GAPA(C0=__builtin_amdgcn_mfma_f32_32x32x16_bf16(kf[4],qr[2],C0,0,0,0),   P1[2],P1[3],P1[4],P1[5],     pw2[0]=PKW(P1,0), pw2[1]=PKW(P1,2), pw2); \
    VRD(6); SBAR(); GAPA(C1=__builtin_amdgcn_mfma_f32_32x32x16_bf16(kf[5],qr[2],C1,0,0,0),   P1[6],P1[7],P1[8],P1[9],     pw2[2]=PKW(P1,4), pw2[3]=PKW(P1,6), pw2); \
    VRD(3); SBAR(); GAPA(C0=__builtin_amdgcn_mfma_f32_32x32x16_bf16(kf[6],qr[3],C0,0,0,0),   P1[10],P1[11],P1[12],P1[13], pw3[0]=PKW(P1,8), pw3[1]=PKW(P1,10), pw3); \
    VRD(7); SBAR(); GAPA(C1=__builtin_amdgcn_mfma_f32_32x32x16_bf16(kf[7],qr[3],C1,0,0,0),   P1[14],P1[15],0.f,0.f,       pw3[2]=PKW(P1,12),pw3[3]=PKW(P1,14), pw3); \
    l_reg+=sacc; \
    if(GK){DMA_K((t)+3,sl_cur);} if(GV){DMA_V((t)+1,sl_next);} \
    CMASK(C0,C1,t); \
    { float a=MX3(C0[0],C0[1],C1[0]),b=MX3(C0[2],C0[3],C1[1]); a=MX3(a,C1[2],C1[3]); \
      _Pragma("unroll") for(int r=4;r<16;r+=4){a=MX3(a,C0[r],C0[r+1]);b=MX3(b,C0[r+2],C0[r+3]);a=MX3(a,C1[r],C1[r+1]);b=MX3(b,C1[r+2],C1[r+3]);} \
      float rm=__builtin_fmaxf(a,b); { auto rr=__builtin_amdgcn_permlane32_swap(__float_as_uint(rm),__float_as_uint(rm),false,false); rm=__builtin_fmaxf(__uint_as_float(rr[0]),__uint_as_float(rr[1])); } \
      resc=false; \
      if(__builtin_expect(__any(rm>(float)THRL),0)){ const float dl=__builtin_fmaxf(rm,0.f); mhat+=dl; \
        _Pragma("unroll") for(int r=0;r<16;++r){C0[r]-=dl;C1[r]-=dl;} \
        nb=fq2-mhat; \
        const float f=__builtin_amdgcn_exp2f(-dl); l_reg*=f; if(hi==0)wsf[r32]=f; resc=true; } } \
    SBAR(); \
    const lds_cptr fk_=fkp+((t)+1)*256; f32x4_t fa_=FLD(0); SBAR(); \
    GAPB(o[0]=__builtin_amdgcn_mfma_f32_32x32x16_bf16(PAF(0),VFR(0),o[0],0,0,0), C0,0, P0,fa_,fa_,32); \
    GAPB(o[1]=__builtin_amdgcn_mfma_f32_32x32x16_bf16(PAF(0),VFR(4),o[1],0,0,0), C0,4, P0,fa_,fa_,64); \
    KRD(GL,0); GAPB(o[0]=__builtin_amdgcn_mfma_f32_32x32x16_bf16(PAF(1),VFR(1),o[0],0,0,0), C0,8, P0,fa_,fa_,96); \
    KRD(GL,1); GAPB(o[1]=__builtin_amdgcn_mfma_f32_32x32x16_bf16(PAF(1),VFR(5),o[1],0,0,0), C0,12, P0,fa_,fa_,128); \
    KRD(GL,2); GAPB(o[0]=__builtin_amdgcn_mfma_f32_32x32x16_bf16(PAF(2),VFR(2),o[0],0,0,0), C1,0, P1,fa_,fa_,160); \
    KRD(GL,3); GAPB(o[1]=__builtin_amdgcn_mfma_f32_32x32x16_bf16(PAF(2),VFR(6),o[1],0,0,0), C1,4, P1,fa_,fa_,192); \
    GAPB(o[0]=__builtin_amdgcn_mfma_f32_32x32x16_bf16(PAF(3),VFR(3),o[0],0,0,0), C1,8, P1,fa_,fa_,224); \
    GAPB(o[1]=__builtin_amdgcn_mfma_f32_32x32x16_bf16(PAF(3),VFR(7),o[1],0,0,0), C1,12, P1,fa_,fa_,224); \
    }while(0)
  int t=TB+1;
  #undef CMASK
  #define CMASK(P0,P1,t) do{}while(0)
  for(;t+5<NT;t+=2){
    STEP(pB0,pB1,pA0,pA1,t,true,true,true);     WAIT_BAR(2); RESC(); ROT();
    STEP(pA0,pA1,pB0,pB1,t+1,true,true,true);   WAIT_BAR(2); RESC(); ROT();
  }
  #undef CMASK
  #define CMASK(P0,P1,t) do{int jb_=(t)-(NTM-4); if(jb_>=0)cmask(P0,P1,jb_,qrel,hi);}while(0)
  #define ENDW(tt) do{ if((tt)+3<NT){WAIT_BAR(2);} else if((tt)+2<NT){WAIT_BAR(1);} else {WAIT_BAR(0);} }while(0)
  for(;t+1<NT;t+=2){
    STEP(pB0,pB1,pA0,pA1,t,(t+3<NT),(t+1<NT),(t+1<NT));       ENDW(t);   RESC(); ROT();
    STEP(pA0,pA1,pB0,pB1,t+1,(t+4<NT),(t+2<NT),(t+2<NT));     ENDW(t+1); RESC(); ROT();
  }
  STEP(pB0,pB1,pA0,pA1,NT-1,false,false,false); RESC();
  { float sacc=pB0[0]+pB0[1]; _Pragma("unroll") for(int r=2;r<16;++r)sacc+=pB0[r]; _Pragma("unroll") for(int r=0;r<16;++r)sacc+=pB1[r]; l_reg+=sacc;
    pw0=(u32x4){PKW(pB0,0),PKW(pB0,2),PKW(pB0,4),PKW(pB0,6)};pw1=(u32x4){PKW(pB0,8),PKW(pB0,10),PKW(pB0,12),PKW(pB0,14)};pw2=(u32x4){PKW(pB1,0),PKW(pB1,2),PKW(pB1,4),PKW(pB1,6)};pw3=(u32x4){PKW(pB1,8),PKW(pB1,10),PKW(pB1,12),PKW(pB1,14)};
    SBAR(); pv(o,vb0+sl_cur,PAF(0),PAF(1),PAF(2),PAF(3)); }
  #undef PKW
  #undef PAF
  #undef VFR
  #undef PIN
  #undef MX3
  #undef GAPA
  #undef GAPB
  #undef FLD
  #undef FILLC
  #undef EX
  #undef VRD
  #undef KRD
  #undef STEP
  #undef ENDW
  {auto rr=__builtin_amdgcn_permlane32_swap(__float_as_uint(l_reg),__float_as_uint(l_reg),false,false);l_reg=__uint_as_float(rr[0])+__uint_as_float(rr[1]);}
  const bool part=(slot!=1023); bf16*PO=PObase+(long)slot*(256*D); float*PS=PSbase+(long)slot*512;
  if(hi==0){wsf[32+r32]=part?1.f:l_reg; if(part){PS[(wid*QBLK+r32)*2]=mhat;PS[(wid*QBLK+r32)*2+1]=l_reg;}}asm volatile("s_waitcnt lgkmcnt(0)":::"memory");
  float rli[16];
  #pragma unroll
  for(int r=0;r<16;++r)rli[r]=__builtin_amdgcn_rcpf(wsf[32+crow(r,hi)]);
  bf16*Ow=part?PO+(long)(wid*QBLK)*D:O+(rowbase+q0+wid*QBLK)*DM+h*D; const long opitch=part?D:DM;
  { bf16*stg=(bf16*)(shm+LDS_OST)+wid*2048;
    #pragma unroll
    for(int r=0;r<16;++r){const int orow=crow(r,hi);
      #pragma unroll
      for(int d0=0;d0<2;++d0)stg[orow*64+d0*32+r32]=f2bf_a(o[d0][r]*rli[r]);}
    asm volatile("s_waitcnt lgkmcnt(0)":::"memory");
    #pragma unroll
    for(int i=0;i<4;++i){const int row=i*8+(lane>>3),ch=lane&7; const u32x4 v=*(const u32x4*)(stg+row*64+ch*8); ATTN_STORE16(Ow+(long)row*opitch+ch*8,v);} }
  asm volatile("s_waitcnt lgkmcnt(0)\n\ts_barrier":::"memory");
  #undef DMA_K
  #undef DMA_V
  #undef CMASK
  #undef START
  #undef RESC
  #undef ROT
}
constexpr int ATTN_LDS_BYTES=LDS_BYTES;
struct AttnTensors { const bf16* Q; const bf16* K; const bf16* V; bf16* O; const float* CUM; const int* T0; bf16* PO; float* PS; unsigned* qctr; };
constexpr int MAX_ITEMS=1408, PO_SLOTS=640;
__device__ __forceinline__ void unit_split(int Lt,int SEG,int&nseg,int&len){ nseg=(Lt+SEG-1)/SEG; len=2*(((Lt>>1)+nseg-1)/nseg); }
template<bool COMBINE> __device__ __forceinline__ int build_worklist(const int*T0,unsigned*wl,unsigned*tmp,int*sc){
  const int tid=threadIdx.x; const int qb=tid&31; const int t0=T0[tid]; const int Lt=4*qb+4-t0;
  __syncthreads();
  int SEG=40,nseg,len;
  for(int pass=0;pass<2;++pass){
    unit_split(Lt,SEG,nseg,len);
    sc[tid]=nseg; sc[512+tid]=nseg>1?nseg:0; sc[1024+tid]=nseg>1?1:0; __syncthreads();
    for(int o=1;o<512;o<<=1){ const int a=tid>=o?sc[tid-o]:0, c=tid>=o?sc[512+tid-o]:0, e=tid>=o?sc[1024+tid-o]:0; __syncthreads(); sc[tid]+=a; sc[512+tid]+=c; sc[1024+tid]+=e; __syncthreads(); }
    if(sc[1023]<=PO_SLOTS&&sc[511]<=MAX_ITEMS)break;
    __syncthreads(); SEG=64;
  }
  const int ioff=sc[tid]-nseg, poff=sc[512+tid]-(nseg>1?nseg:0), NI=sc[511], NS=sc[1535], sord=sc[1024+tid]-1;
  __syncthreads();
  if(COMBINE){ if(nseg>1)wl[sord]=(unsigned)tid|((unsigned)nseg<<9)|((unsigned)poff<<12); __syncthreads(); return NS; }
  for(int sgi=0;sgi<nseg;++sgi){ const int lb=t0+sgi*len, le=min(lb+len,4*qb+4); tmp[ioff+sgi]=(unsigned)tid|((unsigned)lb<<9)|((unsigned)((le-lb)>>1)<<16)|((unsigned)(nseg>1?poff+sgi:1023)<<22); }
  __syncthreads();
  { const int lane=tid&63,w=tid>>6,nch=(NI+63)>>6; int*hist=sc;
    for(int c=w;c<nch;c+=8){ const int i=c*64+lane; const int key=i<NI?(int)((tmp[i]>>16)&63u):0;
      for(int k=1;k<=32;++k){ const unsigned long long mk=__ballot(key==k); if(lane==0)hist[c*33+k]=__popcll(mk); } }
    __syncthreads();
    if(tid>=1&&tid<=32){ int run=0; for(int c=0;c<nch;++c){ const int v=hist[c*33+tid]; hist[c*33+tid]=run; run+=v; } sc[840+tid]=run; }
    __syncthreads();
    if(tid==0){ int run=0; for(int k=32;k>=1;--k){ sc[800+k]=run; run+=sc[840+k]; } }
    __syncthreads();
    for(int c=w;c<nch;c+=8){ const int i=c*64+lane; const int key=i<NI?(int)((tmp[i]>>16)&63u):0; int myr=0;
      for(int k=1;k<=32;++k){ const unsigned long long mk=__ballot(key==k); if(key==k)myr=__popcll(mk&((1ull<<lane)-1ull)); }
      if(i<NI)wl[sc[800+key]+hist[c*33+key]+myr]=tmp[i]; }
  }
  __syncthreads();
  return NI;
}
template<int THRL=8> __device__ __forceinline__ void attn_phase(char*lds,const AttnTensors&T,int vcu,int G){
  unsigned*wl=(unsigned*)(lds+LDS_BYTES); unsigned*tmp=wl+MAX_ITEMS; int*sc=(int*)lds;
  const int NI=build_worklist<false>(T.T0,wl,tmp,sc);
  volatile int*nxt=(volatile int*)(tmp);
  int idx=vcu;
  while(idx<NI){
    const unsigned it=wl[idx]; const int u=it&511,TB=(it>>9)&127,lenp=(it>>16)&63,slot=(it>>22)&1023;
    const int bh=u>>5,qb=u&31;
    attn_unit<THRL>(bh/NHEAD,bh%NHEAD,qb,TB,TB+2*lenp,4*qb+4,T.Q,T.K,T.V,T.O,T.CUM,T.PO,T.PS,slot,lds);
    if(threadIdx.x==0)*nxt=G+(int)__hip_atomic_fetch_add(T.qctr,1u,__ATOMIC_RELAXED,__HIP_MEMORY_SCOPE_AGENT);
    __syncthreads(); idx=*nxt; __syncthreads();
  }
}
__device__ __forceinline__ void attn_combine(char*lds,const AttnTensors&T,int wg,int nwg){
  unsigned*wl=(unsigned*)(lds+LDS_BYTES); unsigned*tmp=wl+MAX_ITEMS; int*sc=(int*)lds;
  const int NS=build_worklist<true>(T.T0,wl,tmp,sc);
  const int tid=threadIdx.x,row=tid>>1,ch=tid&1;
  for(int k=wg;k<NS;k+=nwg){ const unsigned it=wl[k]; const int u=it&511,nseg=(it>>9)&7,poff=(it>>12)&1023,bh=u>>5,qb=u&31,b=bh/NHEAD,h=bh%NHEAD;
    float m[4],l[4]; float M=-3.0e38f; u32x4 pv[4][4];
    #pragma unroll
    for(int sgi=0;sgi<4;++sgi){ m[sgi]=-3.0e38f; l[sgi]=0.f; const int sg=sgi<nseg?sgi:0;
      const float2 ml=*(const float2*)(T.PS+(long)(poff+sg)*512+row*2); if(sgi<nseg){m[sgi]=ml.x;l[sgi]=ml.y;} M=fmaxf(M,m[sgi]);
      const u32x4*p=(const u32x4*)(T.PO+(long)(poff+sg)*(256*D)+row*D+ch*32);
      #pragma unroll
      for(int q=0;q<4;++q)pv[sgi][q]=p[q]; }
    float acc[32]; float L=0.f;
    #pragma unroll
    for(int c=0;c<32;++c)acc[c]=0.f;
    #pragma unroll
    for(int sgi=0;sgi<4;++sgi){ const float w=sgi<nseg?__builtin_amdgcn_exp2f(m[sgi]-M):0.f; L+=w*l[sgi];
      #pragma unroll
      for(int q=0;q<4;++q){ const u32x4 v=pv[sgi][q];
        acc[8*q+0]+=w*__builtin_bit_cast(float,v.x<<16); acc[8*q+1]+=w*__builtin_bit_cast(float,v.x&0xffff0000u); acc[8*q+2]+=w*__builtin_bit_cast(float,v.y<<16); acc[8*q+3]+=w*__builtin_bit_cast(float,v.y&0xffff0000u);
        acc[8*q+4]+=w*__builtin_bit_cast(float,v.z<<16); acc[8*q+5]+=w*__builtin_bit_cast(float,v.z&0xffff0000u); acc[8*q+6]+=w*__builtin_bit_cast(float,v.w<<16); acc[8*q+7]+=w*__builtin_bit_cast(float,v.w&0xffff0000u); } }
    const float rl=1.f/L; bf16*op=T.O+((long)b*SEQ+qb*QB+row)*DM+h*D+ch*32;
    #pragma unroll
    for(int q=0;q<4;++q){ u32x4 w; w.x=cvtpk_s(acc[8*q]*rl,acc[8*q+1]*rl); w.y=cvtpk_s(acc[8*q+2]*rl,acc[8*q+3]*rl); w.z=cvtpk_s(acc[8*q+4]*rl,acc[8*q+5]*rl); w.w=cvtpk_s(acc[8*q+6]*rl,acc[8*q+7]*rl); *(u32x4*)(op+8*q)=w; }
  }
  __syncthreads();
}
#undef SBAR
#undef WAIT_BAR
}

constexpr int NWAVES = 8;
constexpr int RING_OFF = 0, RING_BYTES = 131072;
constexpr int LDSCTL_OFF = RING_BYTES, MISC_OFF = LDSCTL_OFF + 320;
constexpr int LDS_BYTES = 147456;
typedef GAS unsigned gu32;
#define RLX_AGENT __ATOMIC_RELAXED, __HIP_MEMORY_SCOPE_AGENT
#define LDS_WAIT() asm volatile("s_waitcnt lgkmcnt(0)" ::: "memory")
#define VM_WAIT() asm volatile("s_waitcnt vmcnt(0)" ::: "memory")
constexpr int CW_TMO = 0, CW_CODE = 1, CW_CNT = 64  , CW_Q0 = 128  , CW_BAR = 4096, CW_HCNT = 8192  , CW_PYS = 12288, CW_PMIX = 13312, CW_PX2 = 14336  ;

#define XB_TMO      128
#define XB_XCNT(j)  (256  + 64 * (j))
#define XB_XSUB(j)  (1280 + 64 * (j))
#define XB_XGEN(j)  (2304 + 64 * (j))
#define XB_TOP      3328
#define XB_TOPGEN   3392
#define XCD_BAR_WORDS 3456
#define XB_SPIN_CAP (1u << 18)
__device__ __forceinline__ unsigned xb_ld(unsigned* p)              { return __hip_atomic_load(p, __ATOMIC_RELAXED, __HIP_MEMORY_SCOPE_AGENT); }
__device__ __forceinline__ unsigned xb_add(unsigned* p, unsigned v) { return __hip_atomic_fetch_add(p, v, __ATOMIC_RELAXED, __HIP_MEMORY_SCOPE_AGENT); }
__device__ __forceinline__ unsigned xb_xcc_id() { return (unsigned)__builtin_amdgcn_s_getreg((3 << 11) | 20) & 0xFu; }
#define XB_SPIN(cond, bar) do { unsigned _sp = 0; while (cond) { __builtin_amdgcn_s_sleep(1); \
    if ((++_sp & 255u) == 0u) { if (xb_ld(&(bar)[XB_TMO])) break; if (_sp > XB_SPIN_CAP) { atomicAdd(&(bar)[XB_TMO], 1u); break; } } } } while (0)
struct XcdBarrier { unsigned* bar; unsigned x; volatile LAS unsigned* st; };
__device__ __forceinline__ XcdBarrier xcd_barrier_post(unsigned* bar, volatile LAS unsigned* st) {
    XcdBarrier b; b.bar = bar; b.x = xb_xcc_id(); b.st = st;
    if (threadIdx.x == 0) (void)xb_add(&bar[XB_XCNT(b.x)], 1u);
    return b;
}
__device__ __forceinline__ void xcd_barrier_complete(unsigned* bar, unsigned x, unsigned& nloc, unsigned& nx) {
    const unsigned G = gridDim.x * gridDim.y * gridDim.z;
    unsigned sum, cnt, mine, sp = 0u;
    for (;;) {
        sum = 0u; cnt = 0u; mine = 0u;
#pragma unroll
        for (unsigned j = 0; j < 16; ++j) { const unsigned c = xb_ld(&bar[XB_XCNT(j)]); sum += c; cnt += (c > 0u) ? 1u : 0u; mine = (j == x) ? c : mine; }
        if (sum == G) break;
        __builtin_amdgcn_s_sleep(1);
        if ((++sp & 255u) == 0u) { if (xb_ld(&bar[XB_TMO])) break; if (sp > XB_SPIN_CAP) { atomicAdd(&bar[XB_TMO], 1u); break; } }
    }
    nloc = mine > 0u ? mine : 1u; nx = cnt > 0u ? cnt : 1u;
}
__device__ __forceinline__ void xcd_barrier(const XcdBarrier& b) {
    asm volatile("s_waitcnt vmcnt(0)" ::: "memory");
    __syncthreads();
    if (threadIdx.x == 0) {
        unsigned* bar = b.bar;
        __builtin_amdgcn_s_waitcnt(0);
        unsigned nloc = b.st[0], nx = b.st[1];
        if (nloc == 0u) { xcd_barrier_complete(bar, b.x, nloc, nx); b.st[0] = nloc; b.st[1] = nx; }
        const unsigned old = xb_add(&bar[XB_XSUB(b.x)], 1u);
        const unsigned gen = old / nloc;
        if (old + 1u == (gen + 1u) * nloc) {
            __builtin_amdgcn_fence(__ATOMIC_RELEASE, "agent");
            asm volatile("s_waitcnt vmcnt(0)" ::: "memory");
            const unsigned og = xb_add(&bar[XB_TOP], 1u);
            const unsigned tg = og / nx;
            if (og + 1u == (tg + 1u) * nx) xb_add(&bar[XB_TOPGEN], 1u);
            else XB_SPIN(xb_ld(&bar[XB_TOPGEN]) == tg, bar);
            __builtin_amdgcn_fence(__ATOMIC_ACQUIRE, "agent");
            xb_add(&bar[XB_XGEN(b.x)], 1u);
            asm volatile("s_waitcnt vmcnt(0)" ::: "memory");
        } else {
            XB_SPIN(xb_ld(&bar[XB_XGEN(b.x)]) == gen, bar);
            __builtin_amdgcn_fence(__ATOMIC_ACQUIRE, "agent");
            asm volatile("s_waitcnt vmcnt(0)" ::: "memory");
        }
    }
    __syncthreads();
}

struct Args { const float* in[26]; float* out; unsigned char* ws; int ph_lo, ph_hi, sub, pad_; };
struct Frame {
    LAS unsigned char* lds; volatile LAS unsigned* MISC; gu32* ctl;
    int tid, lane, wave, vcu, G;
};
__device__ __forceinline__ float gelu_fast(float x) { const float z = 0.7978845608028654f * (x + 0.044715f * x * x * x); const float e = __builtin_amdgcn_exp2f(2.885390081777927f * z); return x - x * __builtin_amdgcn_rcpf(e + 1.f); }
__device__ __forceinline__ float wave_sum(float v) {
#pragma unroll
    for (int o = 1; o < 64; o <<= 1) v += __shfl_xor(v, o);
    return v;
}

struct ConvDesc { const float* W; int ldw, k0, scol; bf16* dst; int ldd; const float* kscale; };
__device__ __forceinline__ void conv_load(const ConvDesc& d, float (&v)[32], int lane) {
    const float* wp = d.W + (size_t)(d.k0 + (lane >> 5)) * d.ldw + d.scol + (lane & 31);
#pragma unroll
    for (int i = 0; i < 32; ++i) v[i] = wp[(size_t)(2 * i) * d.ldw];
}
__device__ __forceinline__ void conv_finish(const ConvDesc& d, float (&v)[32], LAS float* scr, int lane) {
    if (d.kscale) {
#pragma unroll
        for (int i = 0; i < 32; ++i) v[i] *= d.kscale[d.k0 + 2 * i + (lane >> 5)]; }
#pragma unroll
    for (int i = 0; i < 32; ++i) scr[(2 * i + (lane >> 5)) * 33 + (lane & 31)] = v[i];
    LDS_WAIT(); asm volatile("" ::: "memory");
    const int c = lane & 7;
#pragma unroll
    for (int j = 0; j < 4; ++j) { const int n = (lane >> 3) + 8 * j; const LAS float* s = scr + (8 * c) * 33 + n;
        u32x4 o; o.x = pg::cvt_pk_bf16(s[0 * 33], s[1 * 33]); o.y = pg::cvt_pk_bf16(s[2 * 33], s[3 * 33]); o.z = pg::cvt_pk_bf16(s[4 * 33], s[5 * 33]); o.w = pg::cvt_pk_bf16(s[6 * 33], s[7 * 33]);
        *(GAS u32x4*)(d.dst + (size_t)n * d.ldd + d.k0 + 8 * c) = o; }
    LDS_WAIT(); asm volatile("" ::: "memory");
}
__device__ __forceinline__ void conv_item(const float* W, int ldw, int k0, int scol, bf16* dst, int ldd, const float* kscale, LAS float* scr, int lane) {
    ConvDesc d{W, ldw, k0, scol, dst, ldd, kscale}; float v[32]; conv_load(d, v, lane); conv_finish(d, v, scr, lane);
}
__device__ __forceinline__ int inproj_src_col(int cp) { return cp < 1536 ? cp : (cp < 2048 ? cp + (OU - 1536) : (cp < 3072 ? cp + (OGA - 2048) : cp + (OGS - 3072))); }
__device__ __forceinline__ int inproj_dst_row(int cp) { const int t = cp & ~255, c = cp & 255, wc = c >> 6, bj = (c >> 5) & 1, j = c & 31; return t + 128 * bj + 32 * wc + j; }

__device__ __forceinline__ void p0_prologue(Frame& F, const Args& a) {
    unsigned char* ws = a.ws;
    LAS float* scr = (LAS float*)(F.lds + F.wave * 8704);
    LAS float* wf = (LAS float*)(F.lds + 73728);
    const int gw = F.vcu * NWAVES + F.wave, NGW = F.G * NWAVES;
    const float* w_in = a.in[2]; const int sub = a.sub;
    for (int i = F.tid; i < 8 * 1024; i += NWAVES * 64) { const int h = i >> 10, k = i & 1023; wf[i] = w_in[(size_t)k * DIN + OF + h]; }
    constexpr int I_IN = 16 * 128;
    for (int it = (sub & 1) ? gw : I_IN; it < I_IN; it += NGW) { const int kb = it >> 7, nb = it & 127, cp = nb * 32;
        conv_item(w_in, DIN, kb * 64, inproj_src_col(cp), (bf16*)(ws + WS_WIN) + (size_t)inproj_dst_row(cp) * D, D, nullptr, scr, F.lane); }
    __syncthreads();
    const float* x = a.in[0]; const float* g = a.in[1]; const float* bfg = a.in[3];
    bf16* XN = (bf16*)(ws + WS_XN); float* LOGF = (float*)(ws + WS_CUM);
    { int m = (sub & 2) ? gw : T; f32x4 v[4], v1[4], v2[4];
#define P0_LOADROW(dst, mm) do { const int mc_ = (mm) < T ? (mm) : T - 1; const GAS f32x4* xr_ = (const GAS f32x4*)(x + (size_t)mc_ * D) + F.lane; _Pragma("unroll") for (int j = 0; j < 4; ++j) dst[j] = xr_[64 * j]; } while (0)
      P0_LOADROW(v, m); P0_LOADROW(v1, m + NGW); P0_LOADROW(v2, m + 2 * NGW);
      while (m < T) {
        const int mn = m + NGW; f32x4 vn[4];
        P0_LOADROW(vn, m + 3 * NGW);
        float s = 0.f;
#pragma unroll
        for (int j = 0; j < 4; ++j) s += (v[j].x * v[j].x + v[j].y * v[j].y) + (v[j].z * v[j].z + v[j].w * v[j].w);
        float f[8];
#pragma unroll
        for (int h = 0; h < 8; ++h) f[h] = 0.f;
        f32x4 xg[4];
#pragma unroll
        for (int j = 0; j < 4; ++j) { const f32x4 gg = *((const GAS f32x4*)g + 64 * j + F.lane); xg[j] = v[j] * gg;
#pragma unroll
            for (int h = 0; h < 8; ++h) { const f32x4 ww = *((const LAS f32x4*)(wf + h * 1024) + 64 * j + F.lane); f[h] += (xg[j].x * ww.x + xg[j].y * ww.y) + (xg[j].z * ww.z + xg[j].w * ww.w); } }
        const float rstd = rsqrtf(wave_sum(s) * (1.f / D) + EPS);
        float f4[4], f2[2], f1;
        { const bool up = F.lane >= 32;
#pragma unroll
          for (int i = 0; i < 4; ++i) { const float snd = up ? f[i] : f[4 + i], kp = up ? f[4 + i] : f[i]; f4[i] = kp + __shfl_xor(snd, 32); } }
        { const bool up = (F.lane & 16) != 0;
#pragma unroll
          for (int i = 0; i < 2; ++i) { const float snd = up ? f4[i] : f4[2 + i], kp = up ? f4[2 + i] : f4[i]; f2[i] = kp + __shfl_xor(snd, 16); } }
        { const bool up = (F.lane & 8) != 0; const float snd = up ? f2[0] : f2[1], kp = up ? f2[1] : f2[0]; f1 = kp + __shfl_xor(snd, 8); }
        f1 += __shfl_xor(f1, 4); f1 += __shfl_xor(f1, 2); f1 += __shfl_xor(f1, 1);
        GAS u32x2* o8 = (GAS u32x2*)(XN + (size_t)m * D) + F.lane;
#pragma unroll
        for (int j = 0; j < 4; ++j) { const f32x4 xn = xg[j] * rstd; u32x2 w; w.x = pg::cvt_pk_bf16(xn.x, xn.y); w.y = pg::cvt_pk_bf16(xn.z, xn.w); o8[64 * j] = w; }
        if ((F.lane & 7) == 0) { const int hh = F.lane >> 3, b = m / SEQ, sidx = m % SEQ; LOGF[((size_t)b * NH + hh) * SEQ + sidx] = log_sigmoid(f1 * rstd + bfg[hh]); }
#pragma unroll
        for (int j = 0; j < 4; ++j) { v[j] = v1[j]; v1[j] = v2[j]; v2[j] = vn[j]; }
        m = mn;
      } }
    if ((sub & 4) && F.G == 256) {
        __syncthreads();
        const int g = F.vcu >> 3, q = F.vcu & 7;
        LAS f32x2* PW = (LAS f32x2*)(F.lds);
        LAS f32x2* BB = (LAS f32x2*)(F.lds + 16896);
        LAS f32x2* CT = (LAS f32x2*)(F.lds + 16896 + 8192);
        LAS float* KT = (LAS float*)(F.lds + 16896 + 16384);
        const float* A_re = a.in[6]; const float* A_im = a.in[7]; const float* log_dt = a.in[8]; const float* B_re = a.in[9]; const float* B_im = a.in[10]; const float* C_re = a.in[11]; const float* C_im = a.in[12];
        if (F.tid < NP) { const int p = F.tid;
            const double dt = exp((double)log_dt[g]), ar = A_re[g * NP + p], ai = A_im[g * NP + p];
            const double er = exp(ar * dt), abr = er * cos(ai * dt), abi = er * sin(ai * dt);
            const double nr = abr - 1.0, ni = abi, den = ar * ar + ai * ai, fr_ = (nr * ar + ni * ai) / den, fi_ = (ni * ar - nr * ai) / den;
            double pr = 1.0, pi = 0.0;
            for (int tau = 0; tau <= LCH; ++tau) { PW[tau * NP + p] = (f32x2){(float)pr, (float)pi}; const double t2 = pr * abr - pi * abi; pi = pr * abi + pi * abr; pr = t2; }
            if (q == 0) { ((float*)(ws + WS_AL))[(g * NP + p) * 2] = PW[LCH * NP + p].x; ((float*)(ws + WS_AL))[(g * NP + p) * 2 + 1] = PW[LCH * NP + p].y; }
            for (int c = 0; c < GC; ++c) { const double br = B_re[(g * NP + p) * GC + c], bi = B_im[(g * NP + p) * GC + c]; BB[p * GC + c] = (f32x2){(float)(fr_ * br - fi_ * bi), (float)(fr_ * bi + fi_ * br)}; } }
        for (int i = F.tid; i < GC * NP; i += NWAVES * 64) { const int c = i >> 6, p = i & 63; CT[p * GC + c] = (f32x2){C_re[g * GC * NP + i], C_im[g * GC * NP + i]}; }
        __syncthreads();
        { float* KTG = (float*)(ws + WS_KTG) + (size_t)g * LCH * GC * GC;
          for (int i = 4 * q * GC * GC + F.tid; i < (4 * q + 4) * GC * GC; i += NWAVES * 64) { const int tau = i >> 8, co = (i >> 4) & 15, ci = i & 15; float acc = 0.f;
#pragma unroll 4
              for (int p = 0; p < NP; ++p) { const f32x2 w = PW[tau * NP + p], b = BB[p * GC + ci], c = CT[p * GC + co]; const float wr_ = w.x * b.x - w.y * b.y, wi_ = w.x * b.y + w.y * b.x; acc += c.x * wr_ - c.y * wi_; }
              KTG[i] = acc; } }
        {
          const int n = 64 * q + (F.tid >> 3), part = F.tid & 7, j = n >> 4, co = n & 15; bf16* row = (bf16*)(ws + WS_BTY) + ((size_t)g * 512 + n) * U2P;
          auto bval = [&](int k) -> float { const int p = k & 63; const f32x2 w = PW[(j + 1) * NP + p], c = CT[p * GC + co]; return k < 64 ? (c.x * w.x - c.y * w.y) : -(c.x * w.y + c.y * w.x); };
#pragma unroll 1
          for (int it = 0; it < 2; ++it) { const int k = (it * 8 + part) * 8;
              u32x4 o; o.x = pg::cvt_pk_bf16(bval(k), bval(k + 1)); o.y = pg::cvt_pk_bf16(bval(k + 2), bval(k + 3)); o.z = pg::cvt_pk_bf16(bval(k + 4), bval(k + 5)); o.w = pg::cvt_pk_bf16(bval(k + 6), bval(k + 7)); *(GAS u32x4*)(row + k) = o; } }
        {
          const int n = 32 * q + (F.tid >> 4), part = F.tid & 15; bf16* row = (bf16*)(ws + WS_M1T) + ((size_t)g * 256 + n) * 512;
          auto mval = [&](int k) -> float { const int j = k >> 4, ci = k & 15; float x = 0.f;
              if (n < 128) { const int p = n & 63; const f32x2 w = PW[(LCH - 1 - j) * NP + p], b = BB[p * GC + ci]; x = n < 64 ? (w.x * b.x - w.y * b.y) : (w.x * b.y + w.y * b.x); }
              return x; };
#pragma unroll 1
          for (int it = 0; it < 4; ++it) { const int k = (it * 16 + part) * 8;
              u32x4 o; o.x = pg::cvt_pk_bf16(mval(k), mval(k + 1)); o.y = pg::cvt_pk_bf16(mval(k + 2), mval(k + 3)); o.z = pg::cvt_pk_bf16(mval(k + 4), mval(k + 5)); o.w = pg::cvt_pk_bf16(mval(k + 6), mval(k + 7)); *(GAS u32x4*)(row + k) = o; } }
    }
}

__device__ __forceinline__ void p1_cumsum(Frame& F, float* CUM, int* T0, const float* gq, const float* gk) {
    LAS double* part = (LAS double*)(F.lds);
    float* p = CUM + (size_t)blockIdx.x * SEQ + F.tid * 16;
    f32x4 v[4]; float run[16]; float a = 0.f;
#pragma unroll
    for (int j = 0; j < 4; ++j) v[j] = ((const GAS f32x4*)p)[j];
#pragma unroll
    for (int j = 0; j < 4; ++j) { a += v[j].x; run[4 * j] = a; a += v[j].y; run[4 * j + 1] = a; a += v[j].z; run[4 * j + 2] = a; a += v[j].w; run[4 * j + 3] = a; }
    part[F.tid] = (double)a;
    __syncthreads();
    if (F.tid < 64) { double loc[8]; double s = 0.0;
#pragma unroll
        for (int i = 0; i < 8; ++i) { loc[i] = s; s += part[F.tid * 8 + i]; }
        double incl = s;
#pragma unroll
        for (int o = 1; o < 64; o <<= 1) { const double t = __shfl_up(incl, o); if (F.lane >= o) incl += t; }
        const double excl = incl - s;
#pragma unroll
        for (int i = 0; i < 8; ++i) part[F.tid * 8 + i] = excl + loc[i]; }
    __syncthreads();
    const double base = part[F.tid];
#pragma unroll
    for (int j = 0; j < 4; ++j) { f32x4 o; o.x = (float)((base + (double)run[4 * j]) * 1.4426950408889634); o.y = (float)((base + (double)run[4 * j + 1]) * 1.4426950408889634);
        o.z = (float)((base + (double)run[4 * j + 2]) * 1.4426950408889634); o.w = (float)((base + (double)run[4 * j + 3]) * 1.4426950408889634); ((GAS f32x4*)p)[j] = o; }
    __syncthreads();
    asm volatile("s_waitcnt vmcnt(0)" ::: "memory"); __syncthreads();
    if (F.tid < 32) { float gqm = 0.f, gkm = 0.f; for (int i = 0; i < HD; ++i) { gqm = fmaxf(gqm, fabsf(gq[i])); gkm = fmaxf(gkm, fabsf(gk[i])); }
        const float thr = 2.f * 64.f * C2 * gqm * gkm + 37.f; const int qb = F.tid, NTu = 4 * qb + 4;
        const unsigned* cu = (const unsigned*)(CUM + (size_t)blockIdx.x * SEQ);
        const float fq0 = __builtin_bit_cast(float, __hip_atomic_load(cu + qb * 256, __ATOMIC_RELAXED, __HIP_MEMORY_SCOPE_AGENT));
        int lo = 0, hi = NTu - 1;
        while (lo < hi) { const int mid = (lo + hi) >> 1; const float fk = __builtin_bit_cast(float, __hip_atomic_load(cu + 64 * mid + 63, __ATOMIC_RELAXED, __HIP_MEMORY_SCOPE_AGENT)); if (fq0 - fk >= -thr) hi = mid; else lo = mid + 1; }
        int t0 = lo & ~1; t0 = t0 > NTu - 4 ? NTu - 4 : t0; T0[blockIdx.x * 32 + qb] = t0; }
    __syncthreads();
}
struct PhInProj {
    static constexpr bool GATHER = false, HOOKS = false;
    unsigned lda, ldb; const char* A; const char* B; pg::StaticOrder so;
    bf16 *Q, *K, *V, *U2X, *GA, *GS; const float *gq, *gk;
    __device__ __forceinline__ bool next(int i, pg::Unit& u) const { int pm, pn; if (!so.next(i, pm, pn)) return false; u.A = A + (size_t)pm * 256 * lda; u.B = B + (size_t)pn * 256 * ldb; u.nt = D / 64; u.pm = pm; u.pn = pn; u.aux = 0; return true; }
    __device__ __forceinline__ void offs(const pg::Unit&, const int (&R)[2], const int (&C)[2], unsigned (&vo)[2][2]) const { pg::offs_plain(lda, R, C, vo); }
    __device__ __forceinline__ void epi(const f32x4 (&acc)[2][2][4][2], const pg::Unit& u, int wr, int wc, int fr, int fq) const {
        const int pn = u.pn, row0 = u.pm * 256 + wr * 64 + fr;
        if (pn < 4) {
            const bool isq = pn < 2; const float* g = isq ? gq : gk; bf16* O = isq ? Q : K; const int cb = (pn & 1) * 256 + 64 * wc + 8 * fq; const float sc = isq ? C2 : 1.f;
            f32x4 gv[2][2];
#pragma unroll
            for (int bj = 0; bj < 2; ++bj)
#pragma unroll
                for (int n = 0; n < 2; ++n) gv[bj][n] = *(const f32x4*)(g + 32 * bj + 8 * fq + 4 * n) * sc;
#pragma unroll
            for (int ai = 0; ai < 2; ++ai)
#pragma unroll
                for (int m = 0; m < 4; ++m) { float ss = 0.f;
#pragma unroll
                    for (int bj = 0; bj < 2; ++bj)
#pragma unroll
                        for (int n = 0; n < 2; ++n) { const f32x4 v = acc[ai][bj][m][n]; ss += (v[0] * v[0] + v[1] * v[1]) + (v[2] * v[2] + v[3] * v[3]); }
                    ss += __shfl_xor(ss, 16); ss += __shfl_xor(ss, 32);
                    const float rstd = rsqrtf(ss * (1.f / 64.f) + EPS);
                    bf16* rowp = O + (size_t)(row0 + ai * 128 + m * 16) * DA + cb;
#pragma unroll
                    for (int bj = 0; bj < 2; ++bj) *(u32x4*)(rowp + 32 * bj) = pg::pack8(acc[ai][bj][m][0] * rstd * gv[bj][0], acc[ai][bj][m][1] * rstd * gv[bj][1]); }
        } else if (pn < 6) {
            const int cb = (pn - 4) * 256 + 64 * wc + 8 * fq;
#pragma unroll
            for (int ai = 0; ai < 2; ++ai)
#pragma unroll
                for (int m = 0; m < 4; ++m) { bf16* rowp = V + (size_t)(row0 + ai * 128 + m * 16) * DA + cb;
#pragma unroll
                    for (int bj = 0; bj < 2; ++bj) *(u32x4*)(rowp + 32 * bj) = pg::pack8(acc[ai][bj][m][0], acc[ai][bj][m][1]); }
        } else if (pn < 8) {
#pragma unroll
            for (int ai = 0; ai < 2; ++ai)
#pragma unroll
                for (int m = 0; m < 4; ++m) { const int row = row0 + ai * 128 + m * 16;
#pragma unroll
                    for (int bj = 0; bj < 2; ++bj) { const int cu = (pn - 6) * 256 + 64 * wc + 32 * bj + 8 * fq;
                        *(u32x4*)(U2X + u2x_index(cu >> 4, row, cu & 15)) = pg::pack8(acc[ai][bj][m][0], acc[ai][bj][m][1]); } }
        } else {
            bf16* G = pn < 12 ? GA : GS; const int cb = ((pn - 8) & 3) * 256 + 64 * wc + 8 * fq;
#pragma unroll
            for (int ai = 0; ai < 2; ++ai)
#pragma unroll
                for (int m = 0; m < 4; ++m) { bf16* rowp = G + (size_t)(row0 + ai * 128 + m * 16) * D + cb;
#pragma unroll
                    for (int bj = 0; bj < 2; ++bj) { f32x4 a = acc[ai][bj][m][0], b = acc[ai][bj][m][1];
#pragma unroll
                        for (int e = 0; e < 4; ++e) { a[e] = pg::fsigmoid(a[e]); b[e] = pg::fsigmoid(b[e]); }
                        *(u32x4*)(rowp + 32 * bj) = pg::pack8(a, b); } }
        }
    }
};

__device__ __forceinline__ void cnt_publish(unsigned* c) {
    asm volatile("s_waitcnt vmcnt(0)" ::: "memory");
    if ((threadIdx.x & 63) == 0) __hip_atomic_fetch_add(c, 1u, __ATOMIC_RELAXED, __HIP_MEMORY_SCOPE_AGENT);
}
__device__ __forceinline__ void cnt_wait_wave0(unsigned* c, unsigned want) {
    if (threadIdx.x < 64) { unsigned sp = 0;
        while ((unsigned)__builtin_amdgcn_readfirstlane(__hip_atomic_load(c, __ATOMIC_RELAXED, __HIP_MEMORY_SCOPE_AGENT)) < want) { __builtin_amdgcn_s_sleep(2); if (++sp > (1u << 22)) break; }
        __builtin_amdgcn_fence(__ATOMIC_ACQUIRE, "agent");
        asm volatile("s_waitcnt vmcnt(0)" ::: "memory"); }
}
struct PhGlu {
    static constexpr bool GATHER = false, HOOKS = true;
    unsigned lda, ldb; const char* A; const char* B; pg::StaticOrder so; const bf16* Y1; bf16* YS; unsigned* cYS;
    __device__ __forceinline__ void a_ready(const pg::Unit&) const {}
    __device__ __forceinline__ void done(const pg::Unit& u) const { cnt_publish(cYS + 16 * u.pm); }
    __device__ __forceinline__ bool next(int i, pg::Unit& u) const { int pm, pn; if (!so.next(i, pm, pn)) return false; u.A = A + (size_t)pm * 256 * lda; u.B = B + (size_t)pn * 256 * ldb; u.nt = DS / 64; u.pm = pm; u.pn = pn; u.aux = 0; return true; }
    __device__ __forceinline__ void offs(const pg::Unit&, const int (&R)[2], const int (&C)[2], unsigned (&vo)[2][2]) const { pg::offs_plain(lda, R, C, vo); }
    __device__ __forceinline__ void epi(const f32x4 (&acc)[2][2][4][2], const pg::Unit& u, int wr, int wc, int fr, int fq) const {
        const int row0 = u.pm * 256 + wr * 64 + fr, cb = u.pn * 256 + 32 * wc + 8 * fq;
#pragma unroll
        for (int ai = 0; ai < 2; ++ai)
#pragma unroll
            for (int m = 0; m < 4; ++m) { const size_t ro = (size_t)(row0 + ai * 128 + m * 16) * DS + cb;
#pragma unroll
                for (int bj = 0; bj < 2; ++bj) { const u32x4 yv = *(const u32x4*)(Y1 + ro + 128 * bj); f32x4 y0, y1; pg::unpack8(yv, y0, y1);
                    f32x4 a = acc[ai][bj][m][0], b = acc[ai][bj][m][1];
#pragma unroll
                    for (int e = 0; e < 4; ++e) { a[e] = y0[e] * pg::fsigmoid(a[e]); b[e] = y1[e] * pg::fsigmoid(b[e]); }
                    pg::store16_wt(YS + ro + 128 * bj, pg::pack8(a, b)); } }
    }
};
struct PhProj {
    static constexpr bool GATHER = false, HOOKS = true;
    unsigned lda, ldb; const char* O; const char* YSp; const char* WPA; const char* WPS; pg::StaticOrder so; bf16* GA; const bf16* GS; unsigned* cYS; unsigned* cMIX;
    __device__ __forceinline__ void a_ready(const pg::Unit& u) const { if (u.aux) { cnt_wait_wave0(cYS + 16 * u.pm, 16u); asm volatile("" ::: "memory"); __builtin_amdgcn_s_barrier(); asm volatile("" ::: "memory"); } }
    __device__ __forceinline__ void done(const pg::Unit& u) const { if (u.aux) cnt_publish(cMIX + 16 * u.pm); }
    __device__ __forceinline__ bool next(int i, pg::Unit& u) const { int pm, pn; if (!so.next(i >> 1, pm, pn)) return false; const int sub = i & 1;
        u.A = (sub ? YSp : O) + (size_t)pm * 256 * lda; u.B = (sub ? WPS : WPA) + (size_t)pn * 256 * ldb; u.nt = DA / 64; u.pm = pm; u.pn = pn; u.aux = sub; return true; }
    __device__ __forceinline__ void offs(const pg::Unit&, const int (&R)[2], const int (&C)[2], unsigned (&vo)[2][2]) const { pg::offs_plain(lda, R, C, vo); }
    __device__ __forceinline__ void epi(const f32x4 (&acc)[2][2][4][2], const pg::Unit& u, int wr, int wc, int fr, int fq) const {
        const int row0 = u.pm * 256 + wr * 64 + fr, cb = u.pn * 256 + 32 * wc + 8 * fq; const bool sub = u.aux != 0;
#pragma unroll
        for (int ai = 0; ai < 2; ++ai)
#pragma unroll
            for (int m = 0; m < 4; ++m) { const size_t ro = (size_t)(row0 + ai * 128 + m * 16) * D + cb;
#pragma unroll
                for (int bj = 0; bj < 2; ++bj) { const u32x4 gv = *(const u32x4*)(GA + ro + 128 * bj); f32x4 g0, g1; pg::unpack8(gv, g0, g1);
                    f32x4 a = acc[ai][bj][m][0], b = acc[ai][bj][m][1];
                    if (!sub) { a = a * g0; b = b * g1; }
                    else { const u32x4 sv = *(const u32x4*)(GS + ro + 128 * bj); f32x4 s0, s1; pg::unpack8(sv, s0, s1); a = g0 + s0 * a; b = g1 + s1 * b; }
                    if (sub) pg::store16_wt(GA + ro + 128 * bj, pg::pack8(a, b)); else *(u32x4*)(GA + ro + 128 * bj) = pg::pack8(a, b); } }
    }
};
struct PhWout {
    static constexpr bool GATHER = false, HOOKS = true;
    unsigned lda, ldb; const char* A; const char* B; pg::StaticOrder so; const float* x; float* out; bf16* X2B; float* SSP; unsigned* cMIX; unsigned* cX2;
    __device__ __forceinline__ void a_ready(const pg::Unit& u) const { cnt_wait_wave0(cMIX + 16 * u.pm, 32u); asm volatile("" ::: "memory"); __builtin_amdgcn_s_barrier(); asm volatile("" ::: "memory"); }
    __device__ __forceinline__ void done(const pg::Unit& u) const { cnt_publish(cX2 + 16 * u.pm); }
    __device__ __forceinline__ bool next(int i, pg::Unit& u) const { int pm, pn; if (!so.next(i, pm, pn)) return false; u.A = A + (size_t)pm * 256 * lda; u.B = B + (size_t)pn * 256 * ldb; u.nt = D / 64; u.pm = pm; u.pn = pn; u.aux = 0; return true; }
    __device__ __forceinline__ void offs(const pg::Unit&, const int (&R)[2], const int (&C)[2], unsigned (&vo)[2][2]) const { pg::offs_plain(lda, R, C, vo); }
    __device__ __forceinline__ void epi(const f32x4 (&acc)[2][2][4][2], const pg::Unit& u, int wr, int wc, int fr, int fq) const {
        const int row0 = u.pm * 256 + wr * 64 + fr, cb = u.pn * 256 + 32 * wc + 8 * fq;
#pragma unroll
        for (int ai = 0; ai < 2; ++ai)
#pragma unroll
            for (int m = 0; m < 4; ++m) { const int row = row0 + ai * 128 + m * 16; const size_t ro = (size_t)row * D + cb; float ss = 0.f;
#pragma unroll
                for (int bj = 0; bj < 2; ++bj) { const f32x4 x0 = *(const f32x4*)(x + ro + 128 * bj), x1 = *(const f32x4*)(x + ro + 128 * bj + 4);
                    const f32x4 a = acc[ai][bj][m][0] + x0, b = acc[ai][bj][m][1] + x1;
                    pg::store16_wt(X2B + ro + 128 * bj, pg::pack8(a, b));
                    ss += (a[0] * a[0] + a[1] * a[1]) + (a[2] * a[2] + a[3] * a[3]) + (b[0] * b[0] + b[1] * b[1]) + (b[2] * b[2] + b[3] * b[3]); }
                ss += __shfl_xor(ss, 16); ss += __shfl_xor(ss, 32);
                if (fq == 0) __hip_atomic_store((unsigned*)SSP + (size_t)row * 16 + u.pn * 4 + wc, __builtin_bit_cast(unsigned, ss), __ATOMIC_RELAXED, __HIP_MEMORY_SCOPE_AGENT);
                asm volatile("" ::: "memory"); }
    }
};

__device__ __forceinline__ void p2_side_work(Frame& F, const Args& a) {
    unsigned char* ws = a.ws; const int i0 = (int)blockIdx.x - 64;
    LAS float* KT = (LAS float*)F.lds;
    for (int sl = i0; sl < NG * 8; sl += 192) { const int g = sl >> 3, q = sl & 7;
        __syncthreads();
        { const GAS f32x4* src = (const GAS f32x4*)((const float*)(ws + WS_KTG) + (size_t)g * LCH * GC * GC);
          for (int i = F.tid; i < (4 * q + 4) * GC * GC / 4; i += NWAVES * 64) *(LAS f32x4*)(KT + 4 * i) = src[i]; }
        __syncthreads();
        const int n = 64 * q + (F.tid >> 3), part = F.tid & 7, j = n >> 4, co = n & 15; bf16* row = (bf16*)(ws + WS_BTY) + ((size_t)g * 512 + n) * U2P + 128;
#pragma unroll 1
        for (int it = 0; it < 8; ++it) { const int k = (it * 8 + part) * 8, sidx = k >> 4, ci = k & 15;
            u32x4 o = (u32x4){0u, 0u, 0u, 0u};
            if (sidx <= j) { const LAS float* kp = KT + ((j - sidx) * GC + co) * GC + ci; const f32x4 k0 = *(const LAS f32x4*)kp, k1 = *(const LAS f32x4*)(kp + 4); o = pg::pack8(k0, k1); }
            *(GAS u32x4*)(row + k) = o; } }
    __syncthreads();
    LAS float* scr = (LAS float*)(F.lds + F.wave * 8704);
    constexpr int I_GLU = 8 * 16, I_PA = 8 * 32, I_OUT = 16 * 32;
    for (int it = i0 * NWAVES + F.wave; it < I_GLU + 2 * I_PA + I_OUT; it += 192 * NWAVES) { int r = it;
        if (r < I_GLU) { const int kb = r >> 4, nb = r & 15; conv_item(a.in[14], DS, kb * 64, nb * 32, (bf16*)(ws + WS_WGLU) + (size_t)(nb * 32) * DS, DS, nullptr, scr, F.lane); continue; } r -= I_GLU;
        if (r < I_PA) { const int kb = r >> 5, nb = r & 31; conv_item(a.in[15], D, kb * 64, nb * 32, (bf16*)(ws + WS_WPA) + (size_t)(nb * 32) * DA, DA, nullptr, scr, F.lane); continue; } r -= I_PA;
        if (r < I_PA) { const int kb = r >> 5, nb = r & 31; conv_item(a.in[16], D, kb * 64, nb * 32, (bf16*)(ws + WS_WPS) + (size_t)(nb * 32) * DS, DS, nullptr, scr, F.lane); continue; } r -= I_PA;
        { const int kb = r >> 5, nb = r & 31; conv_item(a.in[17], D, kb * 64, nb * 32, (bf16*)(ws + WS_WOUT) + (size_t)(nb * 32) * D, D, nullptr, scr, F.lane); } }
    if (i0 < 48) { const int r = i0; const float* gf = a.in[18]; const float* wrg = a.in[19]; const float* wre = a.in[21]; bf16* WR = (bf16*)(ws + WS_WR) + (size_t)r * D;
        for (int k = F.tid; k < D; k += NWAVES * 64) { const float w = r < 4 ? wrg[k * 4 + r] : (r < 36 ? wre[k * NE + r - 4] : 0.f); WR[k] = f2bf(w * gf[k]); } }
    __syncthreads();
}
__device__ __forceinline__ void p2_expert_weights(Frame& F, const Args& a, int it0, int it1, int gw, int NGW) {
    unsigned char* ws = a.ws; LAS float* scr = (LAS float*)(F.lds + F.wave * 8704);
    const float* gf = a.in[18]; const float* wg = a.in[23]; const float* wu = a.in[24]; const float* wd = a.in[25];
    constexpr int I_G = 16 * 8, I_D = 4 * 32;
    constexpr int NITEMS = NE * (2 * I_G + I_D);
    auto desc = [&](int it) -> ConvDesc { const int e = it / (2 * I_G + I_D); int r = it % (2 * I_G + I_D);
        if (r < 2 * I_G) { const int up = r >= I_G; if (up) r -= I_G; const int kb = r >> 3, nb = r & 7, n0 = nb * 32;
            return ConvDesc{(up ? wu : wg) + (size_t)e * D * DE, DE, kb * 64, n0, (bf16*)(ws + WS_WGU) + ((size_t)e * 512 + 256 * (n0 >> 7) + 128 * up + (n0 & 127)) * D, D, gf}; }
        r -= 2 * I_G; const int kb = r >> 5, nb = r & 31; return ConvDesc{wd + (size_t)e * DE * D, D, kb * 64, nb * 32, (bf16*)(ws + WS_WD) + ((size_t)e * D + nb * 32) * DE, DE, nullptr}; };
    const int NITEMS_ALL = NITEMS; (void)NITEMS_ALL;
    int it = (a.sub & 4) ? it0 + gw : it1;
    float v[32], v1[32]; ConvDesc d{}, d1{};
    d = desc(it < it1 ? it : it1 - 1); conv_load(d, v, F.lane);
    d1 = desc(it + NGW < it1 ? it + NGW : it1 - 1); conv_load(d1, v1, F.lane);
    while (it < it1) {
        const int itn = it + 2 * NGW; float vn[32]; ConvDesc dn = desc(itn < it1 ? itn : it1 - 1); conv_load(dn, vn, F.lane);
        conv_finish(d, v, scr, F.lane);
#pragma unroll
        for (int i = 0; i < 32; ++i) { v[i] = v1[i]; v1[i] = vn[i]; }
        d = d1; d1 = dn; it += NGW;
    }
}
__device__ __forceinline__ void p8_router(Frame& F, const Args& a) {
    unsigned char* ws = a.ws;
    constexpr int WPITCH = 2064;
    LAS unsigned char* wl = F.lds;
    LAS float* lg = (LAS float*)(F.lds + 48 * WPITCH) + F.wave * 16 * 48;
    { const GAS u32x4* src = (const GAS u32x4*)(ws + WS_WR);
      for (int i = F.tid; i < 48 * 128; i += NWAVES * 64) { const int r = i >> 7, c = i & 127; *(LAS u32x4*)(wl + r * WPITCH + c * 16) = src[i]; } }
    __syncthreads();
    const bf16* X2B = (const bf16*)(ws + WS_X2B); const float* SSP = (const float*)(ws + WS_SSP);
    const float* b_rg = a.in[20]; const float* b_re = a.in[22];
    float* RSTD = (float*)(ws + WS_RSTD); int* ROUTE = (int*)(ws + WS_ROUTE); int* CNT = (int*)(ws + WS_CTL) + CW_CNT; int* LIST = (int*)(ws + WS_LIST); float* WPOS = (float*)(ws + WS_WPOS); float* RPOS = (float*)(ws + WS_RPOS);
    const int fr = F.lane & 15, fq = F.lane >> 4;
    LAS int* lcnt = (LAS int*)(F.lds + 48 * WPITCH + NWAVES * 16 * 48 * 4);
    LAS int* lbase = lcnt + 32;
    for (int t0 = F.vcu * 64; t0 < T; t0 += F.G * 64) {
        cnt_wait_wave0((unsigned*)(F.ctl + CW_PX2) + 16 * (t0 >> 8), 32u);
        if (F.tid < 32) lcnt[F.tid] = 0;
        __syncthreads();
        int e0 = 0, e1 = 0, lr0 = 0, lr1 = 0; float w0 = 0.f, w1 = 0.f, rstd = 0.f;
        if (F.wave < 4) {
            const int tok = t0 + F.wave * 16 + fr;
            const GAS bf16x8* xa = (const GAS bf16x8*)(X2B + (size_t)tok * D + 8 * fq);
            f32x4 acc[3]; acc[0] = acc[1] = acc[2] = (f32x4){0.f, 0.f, 0.f, 0.f};
            bf16x8 xf[32];
#pragma unroll
            for (int ks = 0; ks < 32; ++ks) xf[ks] = xa[ks * 4];
#pragma unroll
            for (int ks = 0; ks < 32; ++ks) {
#pragma unroll
                for (int n = 0; n < 3; ++n) { const bf16x8 wfr = *(const LAS bf16x8*)(wl + (n * 16 + fr) * WPITCH + ks * 64 + fq * 16);
                    acc[n] = __builtin_amdgcn_mfma_f32_16x16x32_bf16(wfr, xf[ks], acc[n], 0, 0, 0); } }
#pragma unroll
            for (int n = 0; n < 3; ++n) *(LAS f32x4*)(lg + fr * 48 + n * 16 + 4 * fq) = acc[n];
            LDS_WAIT(); asm volatile("" ::: "memory");
            if (F.lane < 16) {
                const int t = t0 + F.wave * 16 + F.lane; const LAS float* l = lg + F.lane * 48;
                float ss = 0.f; { const f32x4* sp = (const f32x4*)(SSP + (size_t)t * 16);
#pragma unroll
                    for (int i = 0; i < 4; ++i) { const f32x4 v = sp[i]; ss += (v[0] + v[1]) + (v[2] + v[3]); } }
                rstd = rsqrtf(ss * (1.f / D) + EPS);
                float gl[4]; int gs = 0;
#pragma unroll
                for (int i = 0; i < 4; ++i) gl[i] = l[i] * rstd + b_rg[i];
                float gm = gl[0];
#pragma unroll
                for (int i = 1; i < 4; ++i) if (gl[i] > gm) { gm = gl[i]; gs = i; }
                float gsum = 0.f;
#pragma unroll
                for (int i = 0; i < 4; ++i) gsum += __expf(gl[i] - gm);
                const float gtop = 1.f / gsum;
                float el[8];
#pragma unroll
                for (int i = 0; i < 8; ++i) el[i] = l[4 + gs * 8 + i] * rstd + b_re[gs * 8 + i];
                int i0 = 0; float m0 = el[0];
#pragma unroll
                for (int i = 1; i < 8; ++i) if (el[i] > m0) { m0 = el[i]; i0 = i; }
                int i1 = -1; float m1 = -3.0e38f;
#pragma unroll
                for (int i = 0; i < 8; ++i) if (i != i0 && el[i] > m1) { m1 = el[i]; i1 = i; }
                const float p1 = __expf(m1 - m0); w0 = gtop / (1.f + p1); w1 = gtop * p1 / (1.f + p1);
                e0 = gs * 8 + i0; e1 = gs * 8 + i1;
                lr0 = __hip_atomic_fetch_add(&lcnt[e0], 1, __ATOMIC_RELAXED, __HIP_MEMORY_SCOPE_WORKGROUP); lr1 = __hip_atomic_fetch_add(&lcnt[e1], 1, __ATOMIC_RELAXED, __HIP_MEMORY_SCOPE_WORKGROUP);
            }
        }
        __syncthreads();
        if (F.tid < 32) { const int c = lcnt[F.tid]; lbase[F.tid] = c ? atomicAdd(&CNT[F.tid], c) : 0; }
        __syncthreads();
        if (F.wave < 4 && F.lane < 16) {
            const int t = t0 + F.wave * 16 + F.lane; const int r0 = lbase[e0] + lr0, r1 = lbase[e1] + lr1;
            RSTD[t] = rstd; *(int4*)(ROUTE + t * 4) = make_int4(e0, e1, r0, r1);
            LIST[e0 * T + r0] = t; LIST[e1 * T + r1] = t; WPOS[e0 * T + r0] = w0; WPOS[e1 * T + r1] = w1; RPOS[e0 * T + r0] = rstd; RPOS[e1 * T + r1] = rstd;
        }
        __syncthreads();
    }
}
__device__ __forceinline__ void moe_table(Frame& F, const int* CNT, LAS int* tb) {
    if (F.tid < 64) { const int e = F.lane; int c = 0; if (e < NE) c = (int)__hip_atomic_load((const unsigned*)CNT + e, __ATOMIC_RELAXED, __HIP_MEMORY_SCOPE_AGENT);
        const int tl = (c + 255) >> 8; int incl = tl;
#pragma unroll
        for (int o = 1; o < 32; o <<= 1) { const int v = __shfl_up(incl, o); if (e >= o) incl += v; }
        if (e < NE) { tb[e] = incl - tl; tb[64 + e] = c; } if (e == NE - 1) tb[32] = incl; }
    __syncthreads();
}
__device__ __forceinline__ int moe_find(const LAS int* tb, int mt) { int e = 0;
#pragma unroll 1
    for (int i = 1; i < NE; ++i) if (mt >= tb[i]) e = i; return e; }
struct PhMoeGU {
    static constexpr bool GATHER = true, HOOKS = true;
    unsigned lda, ldb; const char* X; const char* W; const LAS int* tb; const int* LIST; const float* RPOS; bf16* H; int G, c; unsigned* hcnt;
    __device__ __forceinline__ void a_ready(const pg::Unit&) const {}
    __device__ __forceinline__ void done(const pg::Unit& u) const {
        asm volatile("s_waitcnt vmcnt(0)" ::: "memory");
        if ((threadIdx.x & 63) == 0) __hip_atomic_fetch_add(hcnt + 16 * u.pm, 1u, __ATOMIC_RELAXED, __HIP_MEMORY_SCOPE_AGENT); }
    __device__ __forceinline__ bool next(int i, pg::Unit& u) const { const int L = i * G + c; if (L >= 2 * tb[32]) return false; const int mt = L >> 1, n2 = L & 1, e = moe_find(tb, mt);
        u.A = X; u.B = W + ((size_t)e * 512 + n2 * 256) * ldb; u.nt = D / 64; u.pm = mt; u.pn = n2; u.aux = e; return true; }
    __device__ __forceinline__ void offs(const pg::Unit& u, const int (&R)[2], const int (&C)[2], unsigned (&vo)[2][2]) const {
        const int e = u.aux, cnt = tb[64 + e], r0 = (u.pm - tb[e]) * 256; const int* lp = LIST + (size_t)e * T;
#pragma unroll
        for (int h = 0; h < 2; ++h)
#pragma unroll
            for (int i = 0; i < 2; ++i) { int r = r0 + h * 128 + R[i]; r = r < cnt ? r : cnt - 1; vo[h][i] = (unsigned)lp[r] * lda + (unsigned)C[i] * 2u; }
    }
    __device__ __forceinline__ void epi(const f32x4 (&acc)[2][2][4][2], const pg::Unit& u, int wr, int wc, int fr, int fq) const {
        const int e = u.aux, r0 = (u.pm - tb[e]) * 256; const float* rp = RPOS + (size_t)e * T + r0;
#pragma unroll
        for (int ai = 0; ai < 2; ++ai)
#pragma unroll
            for (int m = 0; m < 4; ++m) { const int tr = ai * 128 + wr * 64 + m * 16 + fr; const float rs = rp[tr];
                f32x4 g0 = acc[ai][0][m][0] * rs, g1 = acc[ai][0][m][1] * rs; const f32x4 u0 = acc[ai][1][m][0] * rs, u1 = acc[ai][1][m][1] * rs;
#pragma unroll
                for (int q = 0; q < 4; ++q) { g0[q] = g0[q] * pg::fsigmoid(g0[q]) * u0[q]; g1[q] = g1[q] * pg::fsigmoid(g1[q]) * u1[q]; }
                pg::store16_wt(H + ((size_t)u.pm * 256 + tr) * DE + u.pn * 128 + 32 * wc + 8 * fq, pg::pack8(g0, g1)); }
    }
};
struct PhMoeDown {
    static constexpr bool GATHER = false, HOOKS = true;
    unsigned lda, ldb; const char* Hp; const char* W; const LAS int* tb; const float* WPOS; bf16* Y; unsigned* hcnt; unsigned* qctr; volatile LAS int* slot;
    int pend;
    __device__ __forceinline__ bool next(int i, pg::Unit& u) {
        if (threadIdx.x == 0) { if (i == 0) pend = (int)__hip_atomic_fetch_add(qctr, 1u, __ATOMIC_RELAXED, __HIP_MEMORY_SCOPE_AGENT);
            slot[i & 1] = pend; pend = (int)__hip_atomic_fetch_add(qctr, 1u, __ATOMIC_RELAXED, __HIP_MEMORY_SCOPE_AGENT); }
        asm volatile("s_waitcnt lgkmcnt(0)" ::: "memory"); __builtin_amdgcn_s_barrier(); asm volatile("" ::: "memory");
        const int L = slot[i & 1]; if (L >= 4 * tb[32]) return false; const int mt = L >> 2, n4 = L & 3, e = moe_find(tb, mt);
        u.A = Hp + (size_t)mt * 256 * lda; u.B = W + ((size_t)e * D + n4 * 256) * ldb; u.nt = DE / 64; u.pm = mt; u.pn = n4; u.aux = e; return true; }
    __device__ __forceinline__ void offs(const pg::Unit&, const int (&R)[2], const int (&C)[2], unsigned (&vo)[2][2]) const { pg::offs_plain(lda, R, C, vo); }
    __device__ __forceinline__ void a_ready(const pg::Unit& u) const {
        if (threadIdx.x < 64) { unsigned sp = 0;
            while ((unsigned)__builtin_amdgcn_readfirstlane(__hip_atomic_load(hcnt + 16 * u.pm, __ATOMIC_RELAXED, __HIP_MEMORY_SCOPE_AGENT)) < 16u) { __builtin_amdgcn_s_sleep(2); if (++sp > (1u << 22)) break; }
            __builtin_amdgcn_fence(__ATOMIC_ACQUIRE, "agent");
            asm volatile("s_waitcnt vmcnt(0)" ::: "memory"); }
        asm volatile("" ::: "memory"); __builtin_amdgcn_s_barrier(); asm volatile("" ::: "memory");
    }
    __device__ __forceinline__ void done(const pg::Unit&) const {}
    __device__ __forceinline__ void epi(const f32x4 (&acc)[2][2][4][2], const pg::Unit& u, int wr, int wc, int fr, int fq) const {
        const int e = u.aux, r0 = (u.pm - tb[e]) * 256; const float* wp = WPOS + (size_t)e * T + r0;
#pragma unroll
        for (int ai = 0; ai < 2; ++ai)
#pragma unroll
            for (int m = 0; m < 4; ++m) { int tr = ai * 128 + wr * 64 + m * 16 + fr; asm volatile("" : "+v"(tr));
                const float w = wp[tr]; bf16* yp = Y + (unsigned)((u.pm * 256 + tr) * D + u.pn * 256 + 32 * wc + 8 * fq);
#pragma unroll
                for (int bj = 0; bj < 2; ++bj) *(u32x4*)(yp + 128 * bj) = pg::pack8(acc[ai][bj][m][0] * w, acc[ai][bj][m][1] * w); }
    }
};
__device__ __forceinline__ void p11_combine(Frame& F, const Args& a, const LAS int* tb) {
    unsigned char* ws = a.ws; const int* ROUTE = (const int*)(ws + WS_ROUTE); const bf16* Y = (const bf16*)(ws + WS_Y); const bf16* X2B = (const bf16*)(ws + WS_X2B); float* out = a.out;
    for (int t = F.vcu * NWAVES + F.wave; t < T; t += F.G * NWAVES) {
        const int4 rt = *(const int4*)(ROUTE + t * 4);
        const GAS u32x2* y0 = (const GAS u32x2*)(Y + ((size_t)tb[rt.x] * 256 + rt.z) * D) + F.lane; const GAS u32x2* y1 = (const GAS u32x2*)(Y + ((size_t)tb[rt.y] * 256 + rt.w) * D) + F.lane;
        const GAS u32x2* xb = (const GAS u32x2*)(X2B + (size_t)t * D) + F.lane;
        GAS f32x4* o = (GAS f32x4*)(out + (size_t)t * D) + F.lane;
#pragma unroll
        for (int j = 0; j < 4; ++j) { const u32x2 a0 = y0[64 * j], a1 = y1[64 * j], xv = xb[64 * j]; f32x4 v;
            v[0] = __builtin_bit_cast(float, xv.x << 16) + (__builtin_bit_cast(float, a0.x << 16) + __builtin_bit_cast(float, a1.x << 16)); v[1] = __builtin_bit_cast(float, xv.x & 0xffff0000u) + (__builtin_bit_cast(float, a0.x & 0xffff0000u) + __builtin_bit_cast(float, a1.x & 0xffff0000u));
            v[2] = __builtin_bit_cast(float, xv.y << 16) + (__builtin_bit_cast(float, a0.y << 16) + __builtin_bit_cast(float, a1.y << 16)); v[3] = __builtin_bit_cast(float, xv.y & 0xffff0000u) + (__builtin_bit_cast(float, a0.y & 0xffff0000u) + __builtin_bit_cast(float, a1.y & 0xffff0000u));
            o[64 * j] = v; }
    }
}

struct PhSsmX {
    static constexpr bool GATHER = false, HOOKS = false;
    unsigned lda, ldb; const char* U2X; const char* M1T; float* SLOC; int g, b;
    __device__ __forceinline__ bool next(int i, pg::Unit& u) const { if (i >= 1) return false; u.A = U2X + ((size_t)(g * NCR + b * 256) * U2P + 128) * 2; u.B = M1T + (size_t)g * 256 * ldb; u.nt = 8; u.pm = b; u.pn = 0; u.aux = 0; return true; }
    __device__ __forceinline__ void offs(const pg::Unit&, const int (&R)[2], const int (&C)[2], unsigned (&vo)[2][2]) const { pg::offs_plain(lda, R, C, vo); }
    __device__ __forceinline__ void epi(const f32x4 (&acc)[2][2][4][2], const pg::Unit& u, int wr, int wc, int fr, int fq) const {
#pragma unroll
        for (int ai = 0; ai < 2; ++ai)
#pragma unroll
            for (int m = 0; m < 4; ++m) { float* p = SLOC + ((size_t)g * NCR + u.pm * 256 + ai * 128 + wr * 64 + m * 16 + fr) * 128 + 32 * wc + 8 * fq;
                *(f32x4*)p = acc[ai][0][m][0]; *(f32x4*)(p + 4) = acc[ai][0][m][1]; }
    }
};
__device__ __forceinline__ void ssm_scan(Frame& F, unsigned char* ws, int g, int b) {
    LAS f32x2* ends = (LAS f32x2*)F.lds;
    const int p = F.lane, w = F.wave;
    const float alr = ((const float*)(ws + WS_AL))[(g * NP + p) * 2], ali = ((const float*)(ws + WS_AL))[(g * NP + p) * 2 + 1];
    const float* sl = (const float*)(ws + WS_SLOC) + ((size_t)g * NCR + b * 256 + w * 32) * 128;
    float lr[32], li[32];
#pragma unroll
    for (int k = 0; k < 32; ++k) { lr[k] = __builtin_bit_cast(float, __hip_atomic_load((const unsigned*)sl + k * 128 + p, __ATOMIC_RELAXED, __HIP_MEMORY_SCOPE_AGENT)); li[k] = __builtin_bit_cast(float, __hip_atomic_load((const unsigned*)sl + k * 128 + 64 + p, __ATOMIC_RELAXED, __HIP_MEMORY_SCOPE_AGENT)); }
#pragma unroll
    for (int k = 1; k < 32; ++k) { const float nr = alr * lr[k - 1] - ali * li[k - 1] + lr[k], ni = alr * li[k - 1] + ali * lr[k - 1] + li[k]; lr[k] = nr; li[k] = ni; }
    ends[w * 64 + p] = (f32x2){lr[31], li[31]};
    float sr = alr, si = ali;
#pragma unroll
    for (int k = 0; k < 5; ++k) { const float t = sr * sr - si * si; si = 2.f * sr * si; sr = t; }
    __syncthreads();
    float cr = 0.f, ci = 0.f;
    for (int s2 = 0; s2 < w; ++s2) { const f32x2 e = ends[s2 * 64 + p]; const float t = sr * cr - si * ci + e.x; ci = sr * ci + si * cr + e.y; cr = t; }
    bf16* hp = (bf16*)(ws + WS_U2X) + ((size_t)g * NCR + b * 256 + w * 32) * U2P;
    float pr = cr, pi = ci;
#pragma unroll
    for (int k = 0; k < 32; ++k) { const float hr = (k ? lr[k - 1] : 0.f) + pr, hi = (k ? li[k - 1] : 0.f) + pi;
        hp[(size_t)k * U2P + p] = f2bf(hr); hp[(size_t)k * U2P + 64 + p] = f2bf(hi);
        const float t = alr * pr - ali * pi; pi = alr * pi + ali * pr; pr = t; }
    __syncthreads();
}
struct PhSsmY {
    static constexpr bool GATHER = false, HOOKS = false;
    unsigned lda, ldb; const char* U2Xp; const char* BTY; const bf16* U2X; const float* Dsk; bf16* Y1; int G, c;
    __device__ __forceinline__ bool next(int i, pg::Unit& u) const { const int L = i * G + c; if (L >= NG * 4) return false; const int g = L >> 2, mt = (L >> 1) & 1, nb = L & 1;
        u.A = U2Xp + (size_t)(g * NCR + mt * 256) * lda; u.B = BTY + (size_t)(g * 512 + nb * 256) * ldb; u.nt = nb ? 10 : 6; u.pm = mt; u.pn = nb; u.aux = g; return true; }
    __device__ __forceinline__ void offs(const pg::Unit&, const int (&R)[2], const int (&C)[2], unsigned (&vo)[2][2]) const { pg::offs_plain(lda, R, C, vo); }
    __device__ __forceinline__ void epi(const f32x4 (&acc)[2][2][4][2], const pg::Unit& u, int wr, int wc, int fr, int fq) const {
        const int g = u.aux;
#pragma unroll
        for (int bj = 0; bj < 2; ++bj) { const int n = u.pn * 256 + 128 * bj + 32 * wc + 8 * fq, j = n >> 4, c0 = n & 15;
            const f32x4 d0 = *(const f32x4*)(Dsk + g * GC + c0), d1 = *(const f32x4*)(Dsk + g * GC + c0 + 4);
#pragma unroll
            for (int ai = 0; ai < 2; ++ai)
#pragma unroll
                for (int m = 0; m < 4; ++m) { const int cr = u.pm * 256 + ai * 128 + wr * 64 + m * 16 + fr;
                    const u32x4 uv = *(const u32x4*)(U2X + ((size_t)g * NCR + cr) * U2P + 128 + j * GC + c0); f32x4 u0, u1; pg::unpack8(uv, u0, u1);
                    f32x4 a = acc[ai][bj][m][0] + d0 * u0, b = acc[ai][bj][m][1] + d1 * u1;
#pragma unroll
                    for (int q = 0; q < 4; ++q) { a[q] = gelu_fast(a[q]); b[q] = gelu_fast(b[q]); }
                    *(u32x4*)(Y1 + ((size_t)cr * LCH + j) * DS + g * GC + c0) = pg::pack8(a, b); } }
    }
};

__global__ void __launch_bounds__(NWAVES * 64, 2) mk_fwd(Args args) {
    extern __shared__ __attribute__((aligned(16))) unsigned char lds[];
    Frame F;
    F.lds = (LAS unsigned char*)lds; F.MISC = (volatile LAS unsigned*)(F.lds + MISC_OFF);
    F.tid = threadIdx.x; F.lane = F.tid & 63; F.wave = __builtin_amdgcn_readfirstlane(F.tid >> 6);
    F.G = gridDim.x; { const int bx = blockIdx.x; F.vcu = (F.G % 8 == 0) ? (bx % 8) * (F.G / 8) + bx / 8 : bx; }
    unsigned char* ws = args.ws; F.ctl = (gu32*)(ws + WS_CTL);
    for (int u = F.tid; u < (LDS_BYTES - LDSCTL_OFF) / 4; u += NWAVES * 64) ((LAS unsigned*)(F.lds + LDSCTL_OFF))[u] = 0u;
    __syncthreads();
    const int lo = args.ph_lo, hi = args.ph_hi;
    const bool multi = (hi - lo) > 1;
    XcdBarrier bar; bar.bar = (unsigned*)(F.ctl + CW_BAR); bar.x = 0; bar.st = nullptr;
    if (multi) bar = xcd_barrier_post((unsigned*)(F.ctl + CW_BAR), F.MISC + 8);
#define IN(k) (lo <= (k) && (k) < hi)
#define SEAM(k) do { if (IN(k) && IN((k) + 1)) xcd_barrier(bar); } while (0)
#define FRESH() do { int t_ = threadIdx.x; asm volatile("" : "+v"(t_)); F.tid = t_; F.lane = t_ & 63; } while (0)
    if (IN(0)) { FRESH(); p0_prologue(F, args); SEAM(0); }
    if (IN(1)) { FRESH();
        if (blockIdx.x < NBATCH * NH) p1_cumsum(F, (float*)(ws + WS_CUM), (int*)(ws + WS_T0), args.in[4], args.in[5]);
        PhInProj ph; ph.lda = D * 2; ph.ldb = D * 2; ph.A = (const char*)(ws + WS_XN); ph.B = (const char*)(ws + WS_WIN); ph.so.init(T / 256, 4096 / 256, F.G, (int)blockIdx.x);
        ph.Q = (bf16*)(ws + WS_Q); ph.K = (bf16*)(ws + WS_K); ph.V = (bf16*)(ws + WS_V); ph.U2X = (bf16*)(ws + WS_U2X); ph.GA = (bf16*)(ws + WS_GA); ph.GS = (bf16*)(ws + WS_GS);
        ph.gq = args.in[4]; ph.gk = args.in[5];
        pg::gemm_phase(F.lds + RING_OFF, ph);
        SEAM(1);
    }
    if (IN(2)) { FRESH();
        if (blockIdx.x < 2 * NG) {
            const int g = (int)blockIdx.x >> 1, b = (int)blockIdx.x & 1;
            PhSsmX ph; ph.lda = U2P * 2; ph.ldb = 512 * 2; ph.U2X = (const char*)(ws + WS_U2X); ph.M1T = (const char*)(ws + WS_M1T); ph.SLOC = (float*)(ws + WS_SLOC); ph.g = g; ph.b = b;
            if (args.sub & 1) pg::gemm_phase(F.lds + RING_OFF, ph);
            if (args.sub & 2) ssm_scan(F, ws, g, b);
            __syncthreads();
        } else if (F.G == 256) p2_side_work(F, args);
        p2_expert_weights(F, args, 0, 6144, F.vcu * NWAVES + F.wave, F.G * NWAVES); __syncthreads();
        if (IN(2) && !IN(3)) {}
    }
    if (IN(3)) {
        static_assert(attn_body::ATTN_LDS_BYTES + 2 * attn_body::MAX_ITEMS * 4 <= RING_BYTES, "attention LDS");
        const attn_body::AttnTensors AT{(const attn_body::bf16*)(ws + WS_Q), (const attn_body::bf16*)(ws + WS_K), (const attn_body::bf16*)(ws + WS_V), (attn_body::bf16*)(ws + WS_Q), (const float*)(ws + WS_CUM),
            (const int*)(ws + WS_T0), (attn_body::bf16*)(ws + WS_PO), (float*)(ws + WS_PS), (unsigned*)(F.ctl + CW_Q0)};
        attn_body::attn_phase<20>((char*)lds + RING_OFF, AT, F.vcu, F.G);
        SEAM(3);
    }
    if (IN(4)) { FRESH();
        if (F.vcu >= 128) {
            const attn_body::AttnTensors AT{(const attn_body::bf16*)(ws + WS_Q), (const attn_body::bf16*)(ws + WS_K), (const attn_body::bf16*)(ws + WS_V), (attn_body::bf16*)(ws + WS_Q), (const float*)(ws + WS_CUM),
                (const int*)(ws + WS_T0), (attn_body::bf16*)(ws + WS_PO), (float*)(ws + WS_PS), (unsigned*)(F.ctl + CW_Q0)};
            attn_body::attn_combine((char*)lds + RING_OFF, AT, F.vcu - 128, F.G - 128);
            p2_expert_weights(F, args, 6144, 9216, (F.vcu - 128) * NWAVES + F.wave, (F.G - 128) * NWAVES); __syncthreads();
        }
        PhSsmY ph; ph.lda = U2P * 2; ph.ldb = U2P * 2; ph.U2Xp = (const char*)(ws + WS_U2X); ph.BTY = (const char*)(ws + WS_BTY); ph.U2X = (const bf16*)(ws + WS_U2X); ph.Dsk = args.in[13]; ph.Y1 = (bf16*)(ws + WS_Y1); ph.G = F.G; ph.c = F.vcu;
        pg::gemm_phase(F.lds + RING_OFF, ph);
        SEAM(4);
    }
    if (IN(5)) { FRESH();
        if (blockIdx.x >= 128) { p2_expert_weights(F, args, 9216, 12288, ((int)blockIdx.x - 128) * NWAVES + F.wave, (F.G - 128) * NWAVES); __syncthreads(); }
        PhGlu ph; ph.lda = DS * 2; ph.ldb = DS * 2; ph.A = (const char*)(ws + WS_Y1); ph.B = (const char*)(ws + WS_WGLU); ph.so.init(T / 256, DS / 256, F.G, (int)blockIdx.x); ph.Y1 = (const bf16*)(ws + WS_Y1); ph.YS = (bf16*)(ws + WS_YS); ph.cYS = (unsigned*)(F.ctl + CW_PYS);
        pg::gemm_phase(F.lds + RING_OFF, ph);
    }
    if (IN(6)) { FRESH();
        PhProj ph; ph.lda = DA * 2; ph.ldb = DA * 2; ph.O = (const char*)(ws + WS_Q); ph.YSp = (const char*)(ws + WS_YS); ph.WPA = (const char*)(ws + WS_WPA); ph.WPS = (const char*)(ws + WS_WPS);
        ph.so.init(T / 256, D / 256, F.G, (int)blockIdx.x); ph.GA = (bf16*)(ws + WS_GA); ph.GS = (const bf16*)(ws + WS_GS); ph.cYS = (unsigned*)(F.ctl + CW_PYS); ph.cMIX = (unsigned*)(F.ctl + CW_PMIX);
        pg::gemm_phase(F.lds + RING_OFF, ph);
    }
    if (IN(7)) { FRESH();
        PhWout ph; ph.lda = D * 2; ph.ldb = D * 2; ph.A = (const char*)(ws + WS_GA); ph.B = (const char*)(ws + WS_WOUT); ph.so.init(T / 256, D / 256, F.G, (int)blockIdx.x);
        ph.x = args.in[0]; ph.out = args.out; ph.X2B = (bf16*)(ws + WS_X2B); ph.SSP = (float*)(ws + WS_SSP); ph.cMIX = (unsigned*)(F.ctl + CW_PMIX); ph.cX2 = (unsigned*)(F.ctl + CW_PX2);
        pg::gemm_phase(F.lds + RING_OFF, ph);
    }
    if (IN(8)) { FRESH(); p8_router(F, args); SEAM(8); }
    LAS int* tb = (LAS int*)(F.lds + LDSCTL_OFF + 512);
    if (IN(9)) { FRESH();
        moe_table(F, (const int*)(ws + WS_CTL) + CW_CNT, tb);
        PhMoeGU ph; ph.lda = D * 2; ph.ldb = D * 2; ph.X = (const char*)(ws + WS_X2B); ph.W = (const char*)(ws + WS_WGU); ph.tb = tb; ph.LIST = (const int*)(ws + WS_LIST); ph.RPOS = (const float*)(ws + WS_RPOS);
        ph.H = (bf16*)(ws + WS_H); ph.G = F.G; ph.c = F.vcu; ph.hcnt = (unsigned*)(F.ctl + CW_HCNT);
        pg::gemm_phase(F.lds + RING_OFF, ph);
    }
    if (IN(10)) { FRESH();
        if (!IN(9)) moe_table(F, (const int*)(ws + WS_CTL) + CW_CNT, tb);
        PhMoeDown ph; ph.lda = DE * 2; ph.ldb = DE * 2; ph.Hp = (const char*)(ws + WS_H); ph.W = (const char*)(ws + WS_WD); ph.tb = tb; ph.WPOS = (const float*)(ws + WS_WPOS); ph.Y = (bf16*)(ws + WS_Y); ph.hcnt = (unsigned*)(F.ctl + CW_HCNT); ph.qctr = (unsigned*)(F.ctl + CW_Q0 + 64); ph.slot = (volatile LAS int*)(F.lds + LDSCTL_OFF + 1024);
        pg::gemm_phase(F.lds + RING_OFF, ph);
        SEAM(10);
    }
    if (IN(11)) { FRESH();
        if (!IN(10)) moe_table(F, (const int*)(ws + WS_CTL) + CW_CNT, tb);
        p11_combine(F, args, tb);
    }
#undef IN
#undef SEAM
}

extern "C" void kernel_launch(void* const* d_in, const int* in_sizes, int n_in, void* d_out, int out_size, void* d_ws, size_t ws_size, hipStream_t stream) {
    static int grid = 0;
    if (grid == 0) {
        int dev = 0, cus = 0; (void)hipGetDevice(&dev); (void)hipDeviceGetAttribute(&cus, hipDeviceAttributeMultiprocessorCount, dev);
        (void)hipFuncSetAttribute((const void*)mk_fwd, hipFuncAttributeMaxDynamicSharedMemorySize, LDS_BYTES);
        grid = cus > 0 ? cus : 256;
    }
    (void)hipMemsetAsync((char*)d_ws + WS_CTL, 0, CTL_ZERO_BYTES, stream);
    Args a{}; for (int i = 0; i < 26; ++i) a.in[i] = (const float*)d_in[i]; a.out = (float*)d_out; a.ws = (unsigned char*)d_ws;
    a.ph_lo = 0; a.ph_hi = 12; a.sub = 7;
    hipLaunchKernelGGL(mk_fwd, dim3(grid), dim3(NWAVES * 64), LDS_BYTES, stream, a);
}
```

```cpp
#include <hip/hip_runtime.h>
#include <stdint.h>
#include <math.h>

typedef unsigned short bf16;
constexpr int T = 16384, D = 1024, SEQ = 8192, NBATCH = 2, NH = 8, HD = 64, DA = 512, DS = 512, NG = 32, GC = 16, NP = 64, NE = 32, DE = 256;
constexpr int DIN = 4104, OQ = 0, OK_ = 512, OV = 1024, OF = 1536, OU = 1544, OGA = 2056, OGS = 3080;
constexpr int LCH = 32, NCR = T / LCH;
constexpr int U2P = 640;
constexpr float EPS = 1e-6f;
constexpr float C2 = 0.125f * 1.4426950408889634f;
constexpr float LOG2E = 1.4426950408889634f;
constexpr int YROWS = 40960;

constexpr size_t MiB = 1u << 20;
constexpr size_t WS_CTL = 0, CTL_ZERO_BYTES = 1 * MiB;
constexpr size_t WS_CUM = 1 * MiB;
constexpr size_t WS_AL = 1 * MiB + 512 * 1024;
constexpr size_t WS_T0 = 1 * MiB + 768 * 1024;
constexpr size_t WS_PS = 252 * MiB;
constexpr size_t WS_PO = 229 * MiB;
constexpr size_t WS_RSTD = 2 * MiB;
constexpr size_t WS_ROUTE = 2 * MiB + 256 * 1024;
constexpr size_t WS_LIST = 3 * MiB;
constexpr size_t WS_WPOS = 5 * MiB;
constexpr size_t WS_SSP = 7 * MiB;
constexpr size_t WS_WIN = 8 * MiB;
constexpr size_t WS_SLOC = 8 * MiB;
constexpr size_t WS_WGLU = 16 * MiB, WS_WPA = 16 * MiB + 512 * 1024, WS_WPS = 17 * MiB + 512 * 1024, WS_WOUT = 18 * MiB + 512 * 1024, WS_WR = 20 * MiB + 512 * 1024;
constexpr size_t WS_M1T = 21 * MiB;
constexpr size_t WS_BTY = 29 * MiB;
constexpr size_t WS_XN = 49 * MiB;
constexpr size_t WS_WGU = 49 * MiB;
constexpr size_t WS_Q = 81 * MiB;
constexpr size_t WS_K = 97 * MiB;
constexpr size_t WS_V = 113 * MiB;
constexpr size_t WS_Y1 = 97 * MiB, WS_YS = 113 * MiB;
constexpr size_t WS_U2X = 129 * MiB;
constexpr size_t WS_GA = 149 * MiB;
constexpr size_t WS_GS = 181 * MiB;
constexpr size_t WS_X2B = 181 * MiB;
constexpr size_t WS_WD = 213 * MiB;
constexpr size_t WS_H = 229 * MiB;
constexpr size_t WS_RPOS = 249 * MiB;
constexpr size_t WS_KTG = 251 * MiB;
constexpr size_t WS_Y = 81 * MiB;
static_assert(WS_H + (size_t)YROWS * DE * 2 <= WS_RPOS && WS_RPOS + 2 * MiB <= WS_KTG && WS_KTG + MiB <= 256 * MiB && WS_Y + (size_t)YROWS * D * 2 <= WS_GS, "d_ws map");

__device__ __forceinline__ bf16 f2bf(float f) { unsigned u = __builtin_bit_cast(unsigned, f); return (bf16)((u + 0x7fffu + ((u >> 16) & 1u)) >> 16); }
__device__ __forceinline__ float bf2f(bf16 b) { return __builtin_bit_cast(float, (unsigned)b << 16); }
__device__ __forceinline__ float sigmoidf_(float x) { return 1.f / (1.f + __expf(-x)); }
__device__ __forceinline__ float gelu_tanh(float x) { const float z = 0.7978845608028654f * (x + 0.044715f * x * x * x); const float e = __expf(2.f * z); return 0.5f * x * (1.f + (1.f - 2.f / (e + 1.f))); }
__device__ __forceinline__ float log_sigmoid(float x) { return -(fmaxf(-x, 0.f) + log1pf(__expf(-fabsf(x)))); }
__device__ __forceinline__ size_t u2x_index(int g, int t, int c) { return ((size_t)g * NCR + (t / LCH)) * U2P + 128 + (t % LCH) * GC + c; }

#define LAS __attribute__((address_space(3)))
#define GAS __attribute__((address_space(1)))
typedef short bf16x8 __attribute__((ext_vector_type(8)));
typedef float f32x4 __attribute__((ext_vector_type(4)));
typedef float f32x2 __attribute__((ext_vector_type(2)));
typedef unsigned u32x4 __attribute__((ext_vector_type(4)));
typedef unsigned u32x2 __attribute__((ext_vector_type(2)));
namespace pg {
constexpr int BM = 256, BK = 64, HALF = 128, HTB = HALF * BK * 2, STAGE_BYTES = 8 * HTB, NXCD = 8, WGM = 8;
__host__ __device__ __forceinline__ int lds_byte(int r, int c) { const int st = (r >> 4) * 2 + (c >> 5), rr = r & 15, cc = c & 31, ob = rr * 64 + cc * 2; return st * 1024 + (ob ^ (((ob >> 9) & 1) << 5)); }
__host__ __device__ __forceinline__ void stage_rc(int b, int& R, int& C) { const int st = b / 1024, sb = b % 1024, swz = sb ^ (((sb >> 9) & 1) << 5); R = (st >> 1) * 16 + swz / 64; C = (st & 1) * 32 + (swz % 64) / 2; }
__host__ __device__ __forceinline__ int perm32(int rho) { const int n = rho >> 4, i = rho & 15; return 8 * (i >> 2) + 4 * n + (i & 3); }
typedef __bf16 bf16x2_t __attribute__((ext_vector_type(2)));
__device__ __forceinline__ unsigned cvt_pk_bf16(float lo, float hi) { const f32x2 v = {lo, hi}; const bf16x2_t b = __builtin_convertvector(v, bf16x2_t); return __builtin_bit_cast(unsigned, b); }
__device__ __forceinline__ u32x4 pack8(const f32x4& a, const f32x4& b) { u32x4 w; w.x = cvt_pk_bf16(a[0], a[1]); w.y = cvt_pk_bf16(a[2], a[3]); w.z = cvt_pk_bf16(b[0], b[1]); w.w = cvt_pk_bf16(b[2], b[3]); return w; }
__device__ __forceinline__ void unpack8(const u32x4& w, f32x4& a, f32x4& b) {
    a[0] = __builtin_bit_cast(float, w.x << 16); a[1] = __builtin_bit_cast(float, w.x & 0xffff0000u); a[2] = __builtin_bit_cast(float, w.y << 16); a[3] = __builtin_bit_cast(float, w.y & 0xffff0000u);
    b[0] = __builtin_bit_cast(float, w.z << 16); b[1] = __builtin_bit_cast(float, w.z & 0xffff0000u); b[2] = __builtin_bit_cast(float, w.w << 16); b[3] = __builtin_bit_cast(float, w.w & 0xffff0000u); }
__device__ __forceinline__ float fsigmoid(float x) { return __builtin_amdgcn_rcpf(1.f + __builtin_amdgcn_exp2f(-1.4426950408889634f * x)); }

__device__ __forceinline__ void store16_wt(void* p, const u32x4& v) {
    asm volatile("global_store_dwordx4 %0, %1, off sc1\n\ts_nop 1" :: "v"(p), "v"(v) : "memory"); }
struct Unit { const char* A; const char* B; int nt; int pm, pn, aux; };

struct StaticOrder {
    int nM, nN, nwg, G, c;
    __device__ void init(int nM_, int nN_, int G_, int c_) { nM = nM_; nN = nN_; nwg = nM * nN; G = G_; c = c_; }
    __device__ bool next(int i, int& pm, int& pn) const {
        const long L = (long)i * G + c; if (L >= nwg) return false;
        int wgid = (int)L; { const int q = nwg / NXCD, r = nwg % NXCD, xcd = wgid % NXCD, off = wgid / NXCD; wgid = (xcd < r ? xcd * (q + 1) : r * (q + 1) + (xcd - r) * q) + off; }
        const int nig = WGM * nN, gid = wgid / nig, fm = gid * WGM, gsz = (nM - fm) < WGM ? (nM - fm) : WGM;
        pm = fm + ((wgid % nig) % gsz); pn = (wgid % nig) / gsz; return true;
    }
};

template <class P>
__device__ __forceinline__ void gemm_phase(LAS unsigned char* lds, P& ph) {
    const int tid = threadIdx.x, wid = __builtin_amdgcn_readfirstlane(tid >> 6), lane = tid & 63, wr = wid >> 2, wc = wid & 3, fr = lane & 15, fq = lane >> 4;
    const unsigned lda = ph.lda, ldb = ph.ldb;
    int Rr[2], Cc[2]; unsigned voffB[2], vo[2][2], nvo[2][2];
#pragma unroll
    for (int i = 0; i < 2; ++i) { stage_rc(tid * 16 + i * 8192, Rr[i], Cc[i]); const int Rb = (Rr[i] & ~31) + perm32(Rr[i] & 31); voffB[i] = (unsigned)Rb * ldb + (unsigned)Cc[i] * 2u; }
    const size_t kstep = (size_t)(BK * 2);
    const size_t hstepB = (size_t)HALF * ldb;
    const unsigned ldsw = (unsigned)wid * 1024u;
    const int aoff = lds_byte(wr * 64 + fr, fq * 8), boff = lds_byte(wc * 32 + fr, fq * 8);
#define PG_SA(b, h) (((b) * 2 + (h)) * HTB)
#define PG_SB(b, h) ((4 + (b) * 2 + (h)) * HTB)
#define PG_STAGE_B(bufoff, gbase) do { _Pragma("unroll") for (int _i = 0; _i < 2; ++_i) \
        __builtin_amdgcn_global_load_lds((const unsigned*)((const char*)(gbase) + voffB[_i]), (LAS unsigned*)(lds + (bufoff) + ldsw + _i * 8192), 16, 0, 0); } while (0)
#define PG_STAGE_A(bufoff, gbase, VO, h) do { _Pragma("unroll") for (int _i = 0; _i < 2; ++_i) \
        __builtin_amdgcn_global_load_lds((const unsigned*)((const char*)(gbase) + (VO)[h][_i]), (LAS unsigned*)(lds + (bufoff) + ldsw + _i * 8192), 16, 0, 0); } while (0)
#define PG_LDA(dst, b, h) do { _Pragma("unroll") for (int m = 0; m < 4; ++m) _Pragma("unroll") for (int k = 0; k < 2; ++k) dst[m][k] = *(const LAS bf16x8*)(lds + PG_SA(b, h) + aoff + m * 2048 + k * 1024); } while (0)
#define PG_LDB(dst, b, h) do { _Pragma("unroll") for (int n = 0; n < 2; ++n) _Pragma("unroll") for (int k = 0; k < 2; ++k) dst[n][k] = *(const LAS bf16x8*)(lds + PG_SB(b, h) + boff + n * 2048 + k * 1024); } while (0)
#define PG_MMA(ai, bj, At, Bt) do { __builtin_amdgcn_s_setprio(1); _Pragma("unroll") for (int m = 0; m < 4; ++m) _Pragma("unroll") for (int n = 0; n < 2; ++n) _Pragma("unroll") for (int k = 0; k < 2; ++k) \
        acc[ai][bj][m][n] = __builtin_amdgcn_mfma_f32_16x16x32_bf16(Bt[n][k], At[m][k], acc[ai][bj][m][n], 0, 0, 0); __builtin_amdgcn_s_setprio(0); } while (0)
#define PG_WAIT_V(n) asm volatile("s_waitcnt vmcnt(" #n ")" ::: "memory")
#define PG_WAIT_L(n) asm volatile("s_waitcnt lgkmcnt(" #n ")" ::: "memory")
#define PG_BAR __builtin_amdgcn_s_barrier()
#define PG_SCHED __builtin_amdgcn_sched_barrier(0)
    Unit cur, nxt; int ui = 0;
    if (!ph.next(0, cur)) return;
    ph.offs(cur, Rr, Cc, vo);
    f32x4 acc[2][2][4][2];
#pragma unroll
    for (int a = 0; a < 2; ++a)
#pragma unroll
        for (int b = 0; b < 2; ++b)
#pragma unroll
            for (int m = 0; m < 4; ++m)
#pragma unroll
                for (int n = 0; n < 2; ++n) acc[a][b][m][n] = (f32x4){0.f, 0.f, 0.f, 0.f};
    bf16x8 At[4][2], B0[2][2], B1[2][2];
    const char* cA = cur.A; const char* cB = cur.B;
    if constexpr (P::HOOKS) ph.a_ready(cur);
    PG_STAGE_B(PG_SB(0, 0), cB); PG_STAGE_B(PG_SB(0, 1), cB + hstepB); PG_STAGE_A(PG_SA(0, 0), cA, vo, 0); PG_STAGE_A(PG_SA(0, 1), cA, vo, 1);
    if (wr == 1) PG_BAR;
    PG_WAIT_V(2); PG_BAR;
    PG_STAGE_B(PG_SB(1, 0), cB + kstep); PG_STAGE_A(PG_SA(1, 0), cA + kstep, vo, 0); PG_STAGE_B(PG_SB(1, 1), cB + hstepB + kstep);
    PG_WAIT_V(6); PG_BAR;
    for (;;) {
        const bool has_next = ph.next(ui + 1, nxt);
        if constexpr (P::HOOKS) { if (has_next) ph.a_ready(nxt); }
        const int nt = cur.nt;
        const char* nA = has_next ? nxt.A : cA; const char* nB = has_next ? nxt.B : cB;
        if (P::GATHER) { if (has_next) ph.offs(nxt, Rr, Cc, nvo); else {
#pragma unroll
            for (int h = 0; h < 2; ++h)
#pragma unroll
                for (int i = 0; i < 2; ++i) nvo[h][i] = vo[h][i]; } }
#pragma unroll 1
        for (int t = 0; t < nt; t += 2) {
            const bool last = (t == nt - 2);
            const char* a1 = cA + (size_t)(t + 1) * kstep;
            const char* a2 = last ? nA : cA + (size_t)(t + 2) * kstep; const char* b2 = last ? nB : cB + (size_t)(t + 2) * kstep;
            const char* a3 = a2 + kstep; const char* b3 = b2 + kstep;
            unsigned v2[2][2];
#pragma unroll
            for (int h = 0; h < 2; ++h)
#pragma unroll
                for (int i = 0; i < 2; ++i) v2[h][i] = (P::GATHER && last) ? nvo[h][i] : vo[h][i];
            PG_LDB(B0, 0, 0); PG_LDB(B1, 0, 1); PG_SCHED; PG_LDA(At, 0, 0); PG_STAGE_A(PG_SA(1, 1), a1, vo, 1);
            PG_WAIT_V(8); PG_WAIT_L(0); PG_BAR; PG_MMA(0, 0, At, B0); PG_MMA(0, 1, At, B1); PG_BAR; PG_SCHED;
            PG_LDA(At, 0, 1); PG_STAGE_B(PG_SB(0, 0), b2); PG_STAGE_B(PG_SB(0, 1), b2 + hstepB); PG_STAGE_A(PG_SA(0, 0), a2, v2, 0);
            PG_WAIT_V(8); PG_WAIT_L(0); PG_BAR; PG_MMA(1, 0, At, B0); PG_MMA(1, 1, At, B1); PG_BAR; PG_SCHED;
            PG_LDB(B0, 1, 0); PG_LDB(B1, 1, 1); PG_SCHED; PG_LDA(At, 1, 0); PG_STAGE_A(PG_SA(0, 1), a2, v2, 1);
            PG_WAIT_V(8); PG_WAIT_L(0); PG_BAR; PG_MMA(0, 0, At, B0); PG_MMA(0, 1, At, B1); PG_BAR; PG_SCHED;
            PG_LDA(At, 1, 1); PG_STAGE_B(PG_SB(1, 0), b3); PG_STAGE_B(PG_SB(1, 1), b3 + hstepB); PG_STAGE_A(PG_SA(1, 0), a3, v2, 0);
            PG_WAIT_V(8); PG_WAIT_L(0); PG_BAR; PG_MMA(1, 0, At, B0); PG_MMA(1, 1, At, B1); PG_BAR; PG_SCHED;
        }
        if (wr == 0) PG_BAR;
        ph.epi(acc, cur, wr, wc, fr, fq);
        if constexpr (P::HOOKS) ph.done(cur);
        if (!has_next) break;
#pragma unroll
        for (int a = 0; a < 2; ++a)
#pragma unroll
            for (int b = 0; b < 2; ++b)
#pragma unroll
                for (int m = 0; m < 4; ++m)
#pragma unroll
                    for (int n = 0; n < 2; ++n) acc[a][b][m][n] = (f32x4){0.f, 0.f, 0.f, 0.f};
        cur = nxt; cA = nA; cB = nB; ++ui;
        if (P::GATHER) {
#pragma unroll
            for (int h = 0; h < 2; ++h)
#pragma unroll
                for (int i = 0; i < 2; ++i) vo[h][i] = nvo[h][i]; }
        if (wr == 1) PG_BAR;
    }
    PG_WAIT_V(0);
    PG_BAR;
#undef PG_SA
#undef PG_SB
#undef PG_STAGE_A
#undef PG_STAGE_B
#undef PG_LDA
#undef PG_LDB
#undef PG_MMA
#undef PG_WAIT_V
#undef PG_WAIT_L
#undef PG_BAR
#undef PG_SCHED
}
__device__ __forceinline__ void offs_plain(unsigned lda, const int (&R)[2], const int (&C)[2], unsigned (&vo)[2][2]) {
#pragma unroll
    for (int h = 0; h < 2; ++h)
#pragma unroll
        for (int i = 0; i < 2; ++i) vo[h][i] = (unsigned)(h * HALF + R[i]) * lda + (unsigned)C[i] * 2u;
}
}

namespace attn_body {
using bf16=unsigned short;
using bf16x8=__attribute__((ext_vector_type(8)))short;
using s16x4=__attribute__((ext_vector_type(4)))short;
using f32x16=__attribute__((ext_vector_type(16)))float;
using u32x4=__attribute__((ext_vector_type(4)))unsigned;
constexpr int BATCH=2,NHEAD=8,SEQ=8192,D=64,DM=NHEAD*D;
constexpr int NW=8,QBLK=32,QB=QBLK*NW,KVBLK=64,NQB=SEQ/QB;
constexpr int ATTN_PITCH=DM, ATTN_UNIT_ROWS=QB;
__device__ __forceinline__ int crow(int r,int hi){return (r&3)+8*(r>>2)+4*hi;}
__device__ __forceinline__ unsigned short f2bf_a(float f){unsigned u=__builtin_bit_cast(unsigned,f);return (unsigned short)((u+0x7fffu+((u>>16)&1u))>>16);}
#define SBAR() __builtin_amdgcn_sched_barrier(0)
__device__ __forceinline__ void cmask(f32x16&p0,f32x16&p1,int jb,int qrel,int hi){
  const float NEG=-INFINITY; int kb=64*jb+4*hi;
  #pragma unroll
  for(int r=0;r<16;++r){int kv=kb+(r&3)+8*(r>>2); if(kv>qrel)p0[r]=NEG; if(kv+32>qrel)p1[r]=NEG;}
}

constexpr int NSLOT=3, SLOTB=8192;
constexpr int LDS_K=0, LDS_V=NSLOT*SLOTB, LDS_WS=2*NSLOT*SLOTB, LDS_OST=LDS_WS+NW*64*4, LDS_FK=LDS_OST+NW*4096, LDS_BYTES=LDS_FK+SEQ*4+1024;
constexpr float C2=0.125f*1.4426950408889634f;
__device__ __forceinline__ void glds16(const void*gsrc,unsigned lds_dst){unsigned keep;
  asm volatile("s_mov_b32 %0, m0\n\ts_mov_b32 m0, %2\n\ts_nop 0\n\tglobal_load_lds_dwordx4 %1, off\n\ts_mov_b32 m0, %0":"=&s"(keep):"v"(gsrc),"s"(lds_dst):"memory");}
__device__ __forceinline__ float max3f(float a,float b,float c){float r;asm("v_max3_f32 %0, %1, %2, %3":"=v"(r):"v"(a),"v"(b),"v"(c));return r;}
__device__ __forceinline__ float max2f(float a,float b){float r;asm("v_max_f32_e32 %0, %1, %2":"=v"(r):"v"(a),"v"(b));return r;}
__device__ __forceinline__ float fadd_s(float a,float b){float r;asm("v_add_f32_e32 %0, %1, %2":"=v"(r):"v"(a),"v"(b));return r;}
__device__ __forceinline__ float fsub_s(float a,float b){float r;asm("v_sub_f32_e32 %0, %1, %2":"=v"(r):"v"(a),"v"(b));return r;}
typedef float f32x4_t __attribute__((ext_vector_type(4)));
typedef float f32x2_t __attribute__((ext_vector_type(2))); typedef __bf16 bf16x2_t __attribute__((ext_vector_type(2)));
__device__ __forceinline__ unsigned cvtpk_s(float lo,float hi){f32x2_t v={lo,hi};bf16x2_t b=__builtin_convertvector(v,bf16x2_t);return __builtin_bit_cast(unsigned,b);}
#define WAIT_BAR(N) asm volatile("s_waitcnt vmcnt(" #N ") lgkmcnt(0)\n\ts_barrier":::"memory")

__device__ __forceinline__ void qkt(f32x16&p0,f32x16&p1,const char*Kslot,const bf16x8*qr,int r32,int hi){
  const char*kb=Kslot+hi*1024+r32*16;
  #pragma unroll
  for(int d0=0;d0<4;++d0){
    const bf16x8 b0=*reinterpret_cast<const bf16x8*>(kb+d0*2048);
    const bf16x8 b1=*reinterpret_cast<const bf16x8*>(kb+d0*2048+512);
    p0=__builtin_amdgcn_mfma_f32_32x32x16_bf16(b0,qr[d0],p0,0,0,0);p1=__builtin_amdgcn_mfma_f32_32x32x16_bf16(b1,qr[d0],p1,0,0,0);}
}
typedef __attribute__((address_space(3))) const char* lds_cptr;
typedef short v4i16_t __attribute__((ext_vector_type(4)));
__device__ __forceinline__ void kload8(bf16x8*kf,lds_cptr kp){
  kf[0]=*(const __attribute__((address_space(3))) bf16x8*)(kp);      kf[1]=*(const __attribute__((address_space(3))) bf16x8*)(kp+512);
  kf[2]=*(const __attribute__((address_space(3))) bf16x8*)(kp+2048); kf[3]=*(const __attribute__((address_space(3))) bf16x8*)(kp+2560);
  kf[4]=*(const __attribute__((address_space(3))) bf16x8*)(kp+4096); kf[5]=*(const __attribute__((address_space(3))) bf16x8*)(kp+4608);
  kf[6]=*(const __attribute__((address_space(3))) bf16x8*)(kp+6144); kf[7]=*(const __attribute__((address_space(3))) bf16x8*)(kp+6656);
}
__device__ __forceinline__ void kload2(bf16x8*kf,lds_cptr kp,int j){ kf[2*j]=*(const __attribute__((address_space(3))) bf16x8*)(kp+j*2048); kf[2*j+1]=*(const __attribute__((address_space(3))) bf16x8*)(kp+j*2048+512); }
__device__ __forceinline__ s16x4 vtr(lds_cptr p){ return __builtin_bit_cast(s16x4,__builtin_amdgcn_ds_read_tr16_b64_v4i16((__attribute__((address_space(3))) v4i16_t*)p)); }
__device__ __forceinline__ float rowmax(const f32x16&p0,const f32x16&p1){
  float a=max3f(p0[0],p0[1],p1[0]),b=max3f(p0[2],p0[3],p1[1]);a=max3f(a,p1[2],p1[3]);
  #pragma unroll
  for(int r=4;r<16;r+=4){a=max3f(a,p0[r],p0[r+1]);b=max3f(b,p0[r+2],p0[r+3]);a=max3f(a,p1[r],p1[r+1]);b=max3f(b,p1[r+2],p1[r+3]);}
  const float m=max2f(a,b);
  auto rr=__builtin_amdgcn_permlane32_swap(__float_as_uint(m),__float_as_uint(m),false,false);
  return max2f(__uint_as_float(rr[0]),__uint_as_float(rr[1]));
}
__device__ __forceinline__ void pv(f32x16*o,int vb,bf16x8 pa0,bf16x8 pa1,bf16x8 pa2,bf16x8 pa3){
  #pragma unroll
  for(int d0=0;d0<2;++d0){s16x4 lo[4],hi[4];
    #pragma unroll
    for(int ks=0;ks<4;++ks){
      asm volatile("ds_read_b64_tr_b16 %0,%1 offset:%c2":"=&v"(lo[ks]):"v"(vb),"i"(d0*4096+ks*1024):"memory");
      asm volatile("ds_read_b64_tr_b16 %0,%1 offset:%c2":"=&v"(hi[ks]):"v"(vb),"i"(d0*4096+ks*1024+512):"memory");}
    asm volatile("s_waitcnt lgkmcnt(0)":::"memory");SBAR();
    #define PK(k) (bf16x8){lo[k][0],lo[k][1],lo[k][2],lo[k][3],hi[k][0],hi[k][1],hi[k][2],hi[k][3]}
    o[d0]=__builtin_amdgcn_mfma_f32_32x32x16_bf16(pa0,PK(0),o[d0],0,0,0);
    o[d0]=__builtin_amdgcn_mfma_f32_32x32x16_bf16(pa1,PK(1),o[d0],0,0,0);
    o[d0]=__builtin_amdgcn_mfma_f32_32x32x16_bf16(pa2,PK(2),o[d0],0,0,0);
    o[d0]=__builtin_amdgcn_mfma_f32_32x32x16_bf16(pa3,PK(3),o[d0],0,0,0);
    #undef PK
  }
}

#ifndef ATTN_STORE16
#define ATTN_STORE16(p,v) (*(u32x4*)(p)=(v))
#endif
template<int THRL> __device__ __forceinline__ void attn_unit(int b,int h,int qb,int TB,int TE,int NTM,const bf16*Q,const bf16*__restrict__ K,const bf16*__restrict__ V,bf16*O,const float*__restrict__ CUM,bf16*PObase,float*PSbase,int slot,char*shm){
  const int tid=threadIdx.x,lane=tid&63,r32=lane&31,hi=lane>>5; const int wid=__builtin_amdgcn_readfirstlane(tid>>6);
  const long rowbase=(long)b*SEQ; const int q0=qb*QB;
  const bf16*Qw=Q+(rowbase+q0+wid*QBLK)*DM+h*D;
  const bf16*Kh=K+rowbase*DM+h*D,*Vh=V+rowbase*DM+h*D; const float*Fh=CUM+((long)b*NHEAD+h)*SEQ;
  const unsigned lds0=(unsigned)(uintptr_t)shm;
  float*wsf=(float*)(shm+LDS_WS)+wid*64;
  const unsigned koff=(unsigned)(lane*DM+wid*8)*2u;
  const unsigned voff=(unsigned)((16*(wid&3)+(lane>>2))*DM+(wid>>2)*32+(lane&3)*8)*2u;
  const unsigned kdst=lds0+LDS_K+wid*1024, vdst=lds0+LDS_V+wid*1024;
  #define DMA_K(t,slot) glds16((const char*)Kh+(long)(t)*(KVBLK*DM*2)+koff,(unsigned)__builtin_amdgcn_readfirstlane(kdst+(slot)))
  #define DMA_V(t,slot) glds16((const char*)Vh+(long)(t)*(KVBLK*DM*2)+voff,(unsigned)__builtin_amdgcn_readfirstlane(vdst+(slot)))
  const int vb0=(int)(lds0+LDS_V)+((lane>>4)&1)*32+(lane&3)*8+(4*hi+((lane&15)>>2))*64;
  const char*Kbase=shm+LDS_K; bf16x8 kf[8];
  const lds_cptr shm3=(lds_cptr)shm; const lds_cptr kp0=shm3+LDS_K+hi*1024+r32*16; const lds_cptr vp0=shm3+LDS_V+((lane>>4)&1)*32+(lane&3)*8+(4*hi+((lane&15)>>2))*64;
  const int NT=TE;
  for(int p_=wid+(TB>>2);p_<=((TE*KVBLK-1)>>8);p_+=NW) glds16(Fh+p_*256+lane*4,(unsigned)__builtin_amdgcn_readfirstlane(lds0+LDS_FK+p_*1024));
  DMA_K(TB,0);DMA_V(TB,0);DMA_K(TB+1,SLOTB);
  bf16x8 qr[4];
  #pragma unroll
  for(int d0=0;d0<4;++d0)qr[d0]=*reinterpret_cast<const bf16x8*>(&Qw[(long)r32*DM+d0*16+hi*8]);
  const float fq2=Fh[q0+wid*QBLK+r32];
  float mhat=0.f,l_reg=0.f;f32x16 o[2];o[0]=f32x16{};o[1]=f32x16{};float nb=fq2;
  const lds_cptr fkp=(lds_cptr)shm+LDS_FK+hi*16;
  const int qrel=wid*QBLK+r32;
  #define CMASK(P0,P1,t) do{int jb_=(t)-(NTM-4); if(jb_>=0)cmask(P0,P1,jb_,qrel,hi);}while(0)
  bool resc=false;
  #define START(P0,P1) do{ const float rm=rowmax(P0,P1); resc=false; \
    { const float dl=rm; mhat=fadd_s(mhat,dl); \
      _Pragma("unroll") for(int r=0;r<16;++r){P0[r]=fsub_s(P0[r],dl);P1[r]=fsub_s(P1[r],dl);} \
      nb=fsub_s(fq2,mhat); } \
    _Pragma("unroll") for(int r=0;r<16;++r)P0[r]=__builtin_amdgcn_exp2f(P0[r]); }while(0)
  #define RESC() do{ if(resc){ asm volatile("s_waitcnt lgkmcnt(0)":::"memory"); \
      _Pragma("unroll") for(int d_=0;d_<2;++d_) _Pragma("unroll") for(int r=0;r<16;++r)o[d_][r]*=wsf[crow(r,hi)]; } }while(0)
  #define FILLC(C0_,C1_,tt) do{ const lds_cptr f_=fkp+(tt)*256; _Pragma("unroll") for(int a_=0;a_<4;++a_){ const f32x4_t x0_=*(const __attribute__((address_space(3))) f32x4_t*)(f_+32*a_); const f32x4_t x1_=*(const __attribute__((address_space(3))) f32x4_t*)(f_+128+32*a_); \
      _Pragma("unroll") for(int i_=0;i_<4;++i_){ C0_[4*a_+i_]=nb-x0_[i_]; C1_[4*a_+i_]=nb-x1_[i_]; } } }while(0)
  f32x16 pA0,pA1,pB0,pB1;
  int sl_prev=0,sl_cur=0,sl_next=SLOTB;
  #define ROT() do{sl_prev=sl_cur;sl_cur=sl_next;sl_next=(sl_next==(NSLOT-1)*SLOTB)?0:sl_next+SLOTB;}while(0)
  DMA_K(TB+2,2*SLOTB);
  WAIT_BAR(3);
  FILLC(pA0,pA1,TB);
  qkt(pA0,pA1,Kbase,qr,r32,hi);asm volatile("s_nop 15\n\ts_nop 7":"+v"(pA0),"+v"(pA1));CMASK(pA0,pA1,TB);
  START(pA0,pA1);
  _Pragma("unroll") for(int r=0;r<16;++r)pA1[r]=__builtin_amdgcn_exp2f(pA1[r]);
  WAIT_BAR(0);
  DMA_K(TB+3,0);DMA_V(TB+1,SLOTB);
  ROT();
  FILLC(pB0,pB1,TB+1);
  kload8(kf,kp0+sl_cur);
  WAIT_BAR(2);
  s16x4 vlo[8],vhi[8]; u32x4 pw0,pw1,pw2,pw3;
  #define PKW(P,B) cvtpk_s(P[B],P[B+1])
  #define PAF(k) __builtin_bit_cast(bf16x8,pw##k)
  #define VFR(i) (bf16x8){vlo[i][0],vlo[i][1],vlo[i][2],vlo[i][3],vhi[i][0],vhi[i][1],vhi[i][2],vhi[i][3]}
  #define PIN(x) asm volatile("":"+v"(x))
  #define MX3(a,b,c) __builtin_fmaxf(__builtin_fmaxf((a),(b)),(c))
  #define GAPA(MF,A0,A1,A2,A3,W0,W1,PW) do{ MF; sacc+=A0; sacc+=A1; sacc+=A2; sacc+=A3; PIN(sacc); W0; W1; PIN(PW); SBAR(); }while(0)
  #define EX(v) __builtin_amdgcn_exp2f(v)
  #define FLD(off) (*(const __attribute__((address_space(3))) f32x4_t*)(fk_+(off)))
  #define GAPB(MF,X,B,PF,FC,FN,NOFF) do{ MF; X[B]=EX(X[B]); X[B+1]=EX(X[B+1]); X[B+2]=EX(X[B+2]); X[B+3]=EX(X[B+3]); PF[B]=nb-FC[0]; PF[B+1]=nb-FC[1]; PF[B+2]=nb-FC[2]; PF[B+3]=nb-FC[3]; FN=FLD(NOFF); PIN(X); PIN(PF); SBAR(); }while(0)
  #define VRD(i) do{ vlo[i]=vtr(vp_+(((i)>>2)*4096+((i)&3)*1024)); vhi[i]=vtr(vp_+(((i)>>2)*4096+((i)&3)*1024+512)); }while(0)
  #define KRD(G,j) do{ if(G){ kload2(kf,kp0+sl_next,j); SBAR(); } }while(0)
  #define STEP(C0,C1,P0,P1,t,GK,GV,GL) do{ SBAR(); \
    const lds_cptr vp_=vp0+sl_prev; \
    VRD(0); SBAR(); float sacc=(P0[0]+P0[1]); \
    GAPA(C0=__builtin_amdgcn_mfma_f32_32x32x16_bf16(kf[0],qr[0],C0,0,0,0), P0[2],P0[3],P0[4],P0[5],     pw0[0]=PKW(P0,0), pw0[1]=PKW(P0,2), pw0); \
    VRD(4); SBAR(); GAPA(C1=__builtin_amdgcn_mfma_f32_32x32x16_bf16(kf[1],qr[0],C1,0,0,0), P0[6],P0[7],P0[8],P0[9],     pw0[2]=PKW(P0,4), pw0[3]=PKW(P0,6), pw0); \
    VRD(1); SBAR(); GAPA(C0=__builtin_amdgcn_mfma_f32_32x32x16_bf16(kf[2],qr[1],C0,0,0,0),   P0[10],P0[11],P0[12],P0[13], pw1[0]=PKW(P0,8), pw1[1]=PKW(P0,10), pw1); \
    VRD(5); SBAR(); GAPA(C1=__builtin_amdgcn_mfma_f32_32x32x16_bf16(kf[3],qr[1],C1,0,0,0),   P0[14],P0[15],P1[0],P1[1],   pw1[2]=PKW(P0,12),pw1[3]=PKW(P0,14), pw1); \
    VRD(2); SBAR(); GAPA(C0=__builtin_amdgcn_mfma_f32_32x32x16_bf16(kf[4],qr[2],C0,0,0,0),   P1[2],P1[3],P1[4],P1[5],     pw2[0]=PKW(P1,0), pw2[1]=PKW(P1,2), pw2); \
    VRD(6); SBAR(); GAPA(C1=__builtin_amdgcn_mfma_f32_32x32x16_bf16(kf[5],qr[2],C1,0,0,0),   P1[6],P1[7],P1[8],P1[9],     pw2[2]=PKW(P1,4), pw2[3]=PKW(P1,6), pw2); \
    VRD(3); SBAR(); GAPA(C0=__builtin_amdgcn_mfma_f32_32x32x16_bf16(kf[6],qr[3],C0,0,0,0),   P1[10],P1[11],P1[12],P1[13], pw3[0]=PKW(P1,8), pw3[1]=PKW(P1,10), pw3); \
    VRD(7); SBAR(); GAPA(C1=__builtin_amdgcn_mfma_f32_32x32x16_bf16(kf[7],qr[3],C1,0,0,0),   P1[14],P1[15],0.f,0.f,       pw3[2]=PKW(P1,12),pw3[3]=PKW(P1,14), pw3); \
    l_reg+=sacc; \
    if(GK){DMA_K((t)+3,sl_cur);} if(GV){DMA_V((t)+1,sl_next);} \
    CMASK(C0,C1,t); \
    { float a=MX3(C0[0],C0[1],C1[0]),b=MX3(C0[2],C0[3],C1[1]); a=MX3(a,C1[2],C1[3]); \
      _Pragma("unroll") for(int r=4;r<16;r+=4){a=MX3(a,C0[r],C0[r+1]);b=MX3(b,C0[r+2],C0[r+3]);a=MX3(a,C1[r],C1[r+1]);b=MX3(b,C1[r+2],C1[r+3]);} \
      float rm=__builtin_fmaxf(a,b); { auto rr=__builtin_amdgcn_permlane32_swap(__float_as_uint(rm),__float_as_uint(rm),false,false); rm=__builtin_fmaxf(__uint_as_float(rr[0]),__uint_as_float(rr[1])); } \
      resc=false; \
      if(__builtin_expect(__any(rm>(float)THRL),0)){ const float dl=__builtin_fmaxf(rm,0.f); mhat+=dl; \
        _Pragma("unroll") for(int r=0;r<16;++r){C0[r]-=dl;C1[r]-=dl;} \
        nb=fq2-mhat; \
        const float f=__builtin_amdgcn_exp2f(-dl); l_reg*=f; if(hi==0)wsf[r32]=f; resc=true; } } \
    SBAR(); \
    const lds_cptr fk_=fkp+((t)+1)*256; f32x4_t fa_=FLD(0); SBAR(); \
    GAPB(o[0]=__builtin_amdgcn_mfma_f32_32x32x16_bf16(PAF(0),VFR(0),o[0],0,0,0), C0,0, P0,fa_,fa_,32); \
    GAPB(o[1]=__builtin_amdgcn_mfma_f32_32x32x16_bf16(PAF(0),VFR(4),o[1],0,0,0), C0,4, P0,fa_,fa_,64); \
    KRD(GL,0); GAPB(o[0]=__builtin_amdgcn_mfma_f32_32x32x16_bf16(PAF(1),VFR(1),o[0],0,0,0), C0,8, P0,fa_,fa_,96); \
    KRD(GL,1); GAPB(o[1]=__builtin_amdgcn_mfma_f32_32x32x16_bf16(PAF(1),VFR(5),o[1],0,0,0), C0,12, P0,fa_,fa_,128); \
    KRD(GL,2); GAPB(o[0]=__builtin_amdgcn_mfma_f32_32x32x16_bf16(PAF(2),VFR(2),o[0],0,0,0), C1,0, P1,fa_,fa_,160); \
    KRD(GL,3); GAPB(o[1]=__builtin_amdgcn_mfma_f32_32x32x16_bf16(PAF(2),VFR(6),o[1],0,0,0), C1,4, P1,fa_,fa_,192); \
    GAPB(o[0]=__builtin_amdgcn_mfma_f32_32x32x16_bf16(PAF(3),VFR(3),o[0],0,0,0), C1,8, P1,fa_,fa_,224); \
    GAPB(o[1]=__builtin_amdgcn_mfma_f32_32x32x16_bf16(PAF(3),VFR(7),o[1],0,0,0), C1,12, P1,fa_,fa_,224); \
    }while(0)
  int t=TB+1;
  #undef CMASK
  #define CMASK(P0,P1,t) do{}while(0)
  for(;t+5<NT;t+=2){
    STEP(pB0,pB1,pA0,pA1,t,true,true,true);     WAIT_BAR(2); RESC(); ROT();
    STEP(pA0,pA1,pB0,pB1,t+1,true,true,true);   WAIT_BAR(2); RESC(); ROT();
  }
  #undef CMASK
  #define CMASK(P0,P1,t) do{int jb_=(t)-(NTM-4); if(jb_>=0)cmask(P0,P1,jb_,qrel,hi);}while(0)
  #define ENDW(tt) do{ if((tt)+3<NT){WAIT_BAR(2);} else if((tt)+2<NT){WAIT_BAR(1);} else {WAIT_BAR(0);} }while(0)
  for(;t+1<NT;t+=2){
    STEP(pB0,pB1,pA0,pA1,t,(t+3<NT),(t+1<NT),(t+1<NT));       ENDW(t);   RESC(); ROT();
    STEP(pA0,pA1,pB0,pB1,t+1,(t+4<NT),(t+2<NT),(t+2<NT));     ENDW(t+1); RESC(); ROT();
  }
  STEP(pB0,pB1,pA0,pA1,NT-1,false,false,false); RESC();
  { float sacc=pB0[0]+pB0[1]; _Pragma("unroll") for(int r=2;r<16;++r)sacc+=pB0[r]; _Pragma("unroll") for(int r=0;r<16;++r)sacc+=pB1[r]; l_reg+=sacc;
    pw0=(u32x4){PKW(pB0,0),PKW(pB0,2),PKW(pB0,4),PKW(pB0,6)};pw1=(u32x4){PKW(pB0,8),PKW(pB0,10),PKW(pB0,12),PKW(pB0,14)};pw2=(u32x4){PKW(pB1,0),PKW(pB1,2),PKW(pB1,4),PKW(pB1,6)};pw3=(u32x4){PKW(pB1,8),PKW(pB1,10),PKW(pB1,12),PKW(pB1,14)};
    SBAR(); pv(o,vb0+sl_cur,PAF(0),PAF(1),PAF(2),PAF(3)); }
  #undef PKW
  #undef PAF
  #undef VFR
  #undef PIN
  #undef MX3
  #undef GAPA
  #undef GAPB
  #undef FLD
  #undef FILLC
  #undef EX
  #undef VRD
  #undef KRD
  #undef STEP
  #undef ENDW
  {auto rr=__builtin_amdgcn_permlane32_swap(__float_as_uint(l_reg),__float_as_uint(l_reg),false,false);l_reg=__uint_as_float(rr[0])+__uint_as_float(rr[1]);}
  const bool part=(slot!=1023); bf16*PO=PObase+(long)slot*(256*D); float*PS=PSbase+(long)slot*512;
  if(hi==0){wsf[32+r32]=part?1.f:l_reg; if(part){PS[(wid*QBLK+r32)*2]=mhat;PS[(wid*QBLK+r32)*2+1]=l_reg;}}asm volatile("s_waitcnt lgkmcnt(0)":::"memory");
  float rli[16];
  #pragma unroll
  for(int r=0;r<16;++r)rli[r]=__builtin_amdgcn_rcpf(wsf[32+crow(r,hi)]);
  bf16*Ow=part?PO+(long)(wid*QBLK)*D:O+(rowbase+q0+wid*QBLK)*DM+h*D; const long opitch=part?D:DM;
  { bf16*stg=(bf16*)(shm+LDS_OST)+wid*2048;
    #pragma unroll
    for(int r=0;r<16;++r){const int orow=crow(r,hi);
      #pragma unroll
      for(int d0=0;d0<2;++d0)stg[orow*64+d0*32+r32]=f2bf_a(o[d0][r]*rli[r]);}
    asm volatile("s_waitcnt lgkmcnt(0)":::"memory");
    #pragma unroll
    for(int i=0;i<4;++i){const int row=i*8+(lane>>3),ch=lane&7; const u32x4 v=*(const u32x4*)(stg+row*64+ch*8); ATTN_STORE16(Ow+(long)row*opitch+ch*8,v);} }
  asm volatile("s_waitcnt lgkmcnt(0)\n\ts_barrier":::"memory");
  #undef DMA_K
  #undef DMA_V
  #undef CMASK
  #undef START
  #undef RESC
  #undef ROT
}
constexpr int ATTN_LDS_BYTES=LDS_BYTES;
struct AttnTensors { const bf16* Q; const bf16* K; const bf16* V; bf16* O; const float* CUM; const int* T0; bf16* PO; float* PS; unsigned* qctr; };
constexpr int MAX_ITEMS=1408, PO_SLOTS=640;
__device__ __forceinline__ void unit_split(int Lt,int SEG,int&nseg,int&len){ nseg=(Lt+SEG-1)/SEG; len=2*(((Lt>>1)+nseg-1)/nseg); }
template<bool COMBINE> __device__ __forceinline__ int build_worklist(const int*T0,unsigned*wl,unsigned*tmp,int*sc){
  const int tid=threadIdx.x; const int qb=tid&31; const int t0=T0[tid]; const int Lt=4*qb+4-t0;
  __syncthreads();
  int SEG=40,nseg,len;
  for(int pass=0;pass<2;++pass){
    unit_split(Lt,SEG,nseg,len);
    sc[tid]=nseg; sc[512+tid]=nseg>1?nseg:0; sc[1024+tid]=nseg>1?1:0; __syncthreads();
    for(int o=1;o<512;o<<=1){ const int a=tid>=o?sc[tid-o]:0, c=tid>=o?sc[512+tid-o]:0, e=tid>=o?sc[1024+tid-o]:0; __syncthreads(); sc[tid]+=a; sc[512+tid]+=c; sc[1024+tid]+=e; __syncthreads(); }
    if(sc[1023]<=PO_SLOTS&&sc[511]<=MAX_ITEMS)break;
    __syncthreads(); SEG=64;
  }
  const int ioff=sc[tid]-nseg, poff=sc[512+tid]-(nseg>1?nseg:0), NI=sc[511], NS=sc[1535], sord=sc[1024+tid]-1;
  __syncthreads();
  if(COMBINE){ if(nseg>1)wl[sord]=(unsigned)tid|((unsigned)nseg<<9)|((unsigned)poff<<12); __syncthreads(); return NS; }
  for(int sgi=0;sgi<nseg;++sgi){ const int lb=t0+sgi*len, le=min(lb+len,4*qb+4); tmp[ioff+sgi]=(unsigned)tid|((unsigned)lb<<9)|((unsigned)((le-lb)>>1)<<16)|((unsigned)(nseg>1?poff+sgi:1023)<<22); }
  __syncthreads();
  { const int lane=tid&63,w=tid>>6,nch=(NI+63)>>6; int*hist=sc;
    for(int c=w;c<nch;c+=8){ const int i=c*64+lane; const int key=i<NI?(int)((tmp[i]>>16)&63u):0;
      for(int k=1;k<=32;++k){ const unsigned long long mk=__ballot(key==k); if(lane==0)hist[c*33+k]=__popcll(mk); } }
    __syncthreads();
    if(tid>=1&&tid<=32){ int run=0; for(int c=0;c<nch;++c){ const int v=hist[c*33+tid]; hist[c*33+tid]=run; run+=v; } sc[840+tid]=run; }
    __syncthreads();
    if(tid==0){ int run=0; for(int k=32;k>=1;--k){ sc[800+k]=run; run+=sc[840+k]; } }
    __syncthreads();
    for(int c=w;c<nch;c+=8){ const int i=c*64+lane; const int key=i<NI?(int)((tmp[i]>>16)&63u):0; int myr=0;
      for(int k=1;k<=32;++k){ const unsigned long long mk=__ballot(key==k); if(key==k)myr=__popcll(mk&((1ull<<lane)-1ull)); }
      if(i<NI)wl[sc[800+key]+hist[c*33+key]+myr]=tmp[i]; }
  }
  __syncthreads();
  return NI;
}
template<int THRL=8> __device__ __forceinline__ void attn_phase(char*lds,const AttnTensors&T,int vcu,int G){
  unsigned*wl=(unsigned*)(lds+LDS_BYTES); unsigned*tmp=wl+MAX_ITEMS; int*sc=(int*)lds;
  const int NI=build_worklist<false>(T.T0,wl,tmp,sc);
  volatile int*nxt=(volatile int*)(tmp);
  int idx=vcu;
  while(idx<NI){
    const unsigned it=wl[idx]; const int u=it&511,TB=(it>>9)&127,lenp=(it>>16)&63,slot=(it>>22)&1023;
    const int bh=u>>5,qb=u&31;
    attn_unit<THRL>(bh/NHEAD,bh%NHEAD,qb,TB,TB+2*lenp,4*qb+4,T.Q,T.K,T.V,T.O,T.CUM,T.PO,T.PS,slot,lds);
    if(threadIdx.x==0)*nxt=G+(int)__hip_atomic_fetch_add(T.qctr,1u,__ATOMIC_RELAXED,__HIP_MEMORY_SCOPE_AGENT);
    __syncthreads(); idx=*nxt; __syncthreads();
  }
}
__device__ __forceinline__ void attn_combine(char*lds,const AttnTensors&T,int wg,int nwg){
  unsigned*wl=(unsigned*)(lds+LDS_BYTES); unsigned*tmp=wl+MAX_ITEMS; int*sc=(int*)lds;
  const int NS=build_worklist<true>(T.T0,wl,tmp,sc);
  const int tid=threadIdx.x,row=tid>>1,ch=tid&1;
  for(int k=wg;k<NS;k+=nwg){ const unsigned it=wl[k]; const int u=it&511,nseg=(it>>9)&7,poff=(it>>12)&1023,bh=u>>5,qb=u&31,b=bh/NHEAD,h=bh%NHEAD;
    float m[4],l[4]; float M=-3.0e38f; u32x4 pv[4][4];
    #pragma unroll
    for(int sgi=0;sgi<4;++sgi){ m[sgi]=-3.0e38f; l[sgi]=0.f; const int sg=sgi<nseg?sgi:0;
      const float2 ml=*(const float2*)(T.PS+(long)(poff+sg)*512+row*2); if(sgi<nseg){m[sgi]=ml.x;l[sgi]=ml.y;} M=fmaxf(M,m[sgi]);
      const u32x4*p=(const u32x4*)(T.PO+(long)(poff+sg)*(256*D)+row*D+ch*32);
      #pragma unroll
      for(int q=0;q<4;++q)pv[sgi][q]=p[q]; }
    float acc[32]; float L=0.f;
    #pragma unroll
    for(int c=0;c<32;++c)acc[c]=0.f;
    #pragma unroll
    for(int sgi=0;sgi<4;++sgi){ const float w=sgi<nseg?__builtin_amdgcn_exp2f(m[sgi]-M):0.f; L+=w*l[sgi];
      #pragma unroll
      for(int q=0;q<4;++q){ const u32x4 v=pv[sgi][q];
        acc[8*q+0]+=w*__builtin_bit_cast(float,v.x<<16); acc[8*q+1]+=w*__builtin_bit_cast(float,v.x&0xffff0000u); acc[8*q+2]+=w*__builtin_bit_cast(float,v.y<<16); acc[8*q+3]+=w*__builtin_bit_cast(float,v.y&0xffff0000u);
        acc[8*q+4]+=w*__builtin_bit_cast(float,v.z<<16); acc[8*q+5]+=w*__builtin_bit_cast(float,v.z&0xffff0000u); acc[8*q+6]+=w*__builtin_bit_cast(float,v.w<<16); acc[8*q+7]+=w*__builtin_bit_cast(float,v.w&0xffff0000u); } }
    const float rl=1.f/L; bf16*op=T.O+((long)b*SEQ+qb*QB+row)*DM+h*D+ch*32;
    #pragma unroll
    for(int q=0;q<4;++q){ u32x4 w; w.x=cvtpk_s(acc[8*q]*rl,acc[8*q+1]*rl); w.y=cvtpk_s(acc[8*q+2]*rl,acc[8*q+3]*rl); w.z=cvtpk_s(acc[8*q+4]*rl,acc[8*q+5]*rl); w.w=cvtpk_s(acc[8*q+6]*rl,acc[8*q+7]*rl); *(u32x4*)(op+8*q)=w; }
  }
  __syncthreads();
}
#undef SBAR
#undef WAIT_BAR
}

constexpr int NWAVES = 8;
constexpr int RING_OFF = 0, RING_BYTES = 131072;
constexpr int LDSCTL_OFF = RING_BYTES, MISC_OFF = LDSCTL_OFF + 320;
constexpr int LDS_BYTES = 147456;
typedef GAS unsigned gu32;
#define RLX_AGENT __ATOMIC_RELAXED, __HIP_MEMORY_SCOPE_AGENT
#define LDS_WAIT() asm volatile("s_waitcnt lgkmcnt(0)" ::: "memory")
#define VM_WAIT() asm volatile("s_waitcnt vmcnt(0)" ::: "memory")
constexpr int CW_TMO = 0, CW_CODE = 1, CW_CNT = 64  , CW_Q0 = 128  , CW_BAR = 4096, CW_HCNT = 8192  , CW_PYS = 12288, CW_PMIX = 13312, CW_PX2 = 14336  ;

#define XB_TMO      128
#define XB_XCNT(j)  (256  + 64 * (j))
#define XB_XSUB(j)  (1280 + 64 * (j))
#define XB_XGEN(j)  (2304 + 64 * (j))
#define XB_TOP      3328
#define XB_TOPGEN   3392
#define XCD_BAR_WORDS 3456
#define XB_SPIN_CAP (1u << 18)
__device__ __forceinline__ unsigned xb_ld(unsigned* p)              { return __hip_atomic_load(p, __ATOMIC_RELAXED, __HIP_MEMORY_SCOPE_AGENT); }
__device__ __forceinline__ unsigned xb_add(unsigned* p, unsigned v) { return __hip_atomic_fetch_add(p, v, __ATOMIC_RELAXED, __HIP_MEMORY_SCOPE_AGENT); }
__device__ __forceinline__ unsigned xb_xcc_id() { return (unsigned)__builtin_amdgcn_s_getreg((3 << 11) | 20) & 0xFu; }
#define XB_SPIN(cond, bar) do { unsigned _sp = 0; while (cond) { __builtin_amdgcn_s_sleep(1); \
    if ((++_sp & 255u) == 0u) { if (xb_ld(&(bar)[XB_TMO])) break; if (_sp > XB_SPIN_CAP) { atomicAdd(&(bar)[XB_TMO], 1u); break; } } } } while (0)
struct XcdBarrier { unsigned* bar; unsigned x; volatile LAS unsigned* st; };
__device__ __forceinline__ XcdBarrier xcd_barrier_post(unsigned* bar, volatile LAS unsigned* st) {
    XcdBarrier b; b.bar = bar; b.x = xb_xcc_id(); b.st = st;
    if (threadIdx.x == 0) (void)xb_add(&bar[XB_XCNT(b.x)], 1u);
    return b;
}
__device__ __forceinline__ void xcd_barrier_complete(unsigned* bar, unsigned x, unsigned& nloc, unsigned& nx) {
    const unsigned G = gridDim.x * gridDim.y * gridDim.z;
    unsigned sum, cnt, mine, sp = 0u;
    for (;;) {
        sum = 0u; cnt = 0u; mine = 0u;
#pragma unroll
        for (unsigned j = 0; j < 16; ++j) { const unsigned c = xb_ld(&bar[XB_XCNT(j)]); sum += c; cnt += (c > 0u) ? 1u : 0u; mine = (j == x) ? c : mine; }
        if (sum == G) break;
        __builtin_amdgcn_s_sleep(1);
        if ((++sp & 255u) == 0u) { if (xb_ld(&bar[XB_TMO])) break; if (sp > XB_SPIN_CAP) { atomicAdd(&bar[XB_TMO], 1u); break; } }
    }
    nloc = mine > 0u ? mine : 1u; nx = cnt > 0u ? cnt : 1u;
}
__device__ __forceinline__ void xcd_barrier(const XcdBarrier& b) {
    asm volatile("s_waitcnt vmcnt(0)" ::: "memory");
    __syncthreads();
    if (threadIdx.x == 0) {
        unsigned* bar = b.bar;
        __builtin_amdgcn_s_waitcnt(0);
        unsigned nloc = b.st[0], nx = b.st[1];
        if (nloc == 0u) { xcd_barrier_complete(bar, b.x, nloc, nx); b.st[0] = nloc; b.st[1] = nx; }
        const unsigned old = xb_add(&bar[XB_XSUB(b.x)], 1u);
        const unsigned gen = old / nloc;
        if (old + 1u == (gen + 1u) * nloc) {
            __builtin_amdgcn_fence(__ATOMIC_RELEASE, "agent");
            asm volatile("s_waitcnt vmcnt(0)" ::: "memory");
            const unsigned og = xb_add(&bar[XB_TOP], 1u);
            const unsigned tg = og / nx;
            if (og + 1u == (tg + 1u) * nx) xb_add(&bar[XB_TOPGEN], 1u);
            else XB_SPIN(xb_ld(&bar[XB_TOPGEN]) == tg, bar);
            __builtin_amdgcn_fence(__ATOMIC_ACQUIRE, "agent");
            xb_add(&bar[XB_XGEN(b.x)], 1u);
            asm volatile("s_waitcnt vmcnt(0)" ::: "memory");
        } else {
            XB_SPIN(xb_ld(&bar[XB_XGEN(b.x)]) == gen, bar);
            __builtin_amdgcn_fence(__ATOMIC_ACQUIRE, "agent");
            asm volatile("s_waitcnt vmcnt(0)" ::: "memory");
        }
    }
    __syncthreads();
}

struct Args { const float* in[26]; float* out; unsigned char* ws; int ph_lo, ph_hi, sub, pad_; };
struct Frame {
    LAS unsigned char* lds; volatile LAS unsigned* MISC; gu32* ctl;
    int tid, lane, wave, vcu, G;
};
__device__ __forceinline__ float gelu_fast(float x) { const float z = 0.7978845608028654f * (x + 0.044715f * x * x * x); const float e = __builtin_amdgcn_exp2f(2.885390081777927f * z); return x - x * __builtin_amdgcn_rcpf(e + 1.f); }
__device__ __forceinline__ float wave_sum(float v) {
#pragma unroll
    for (int o = 1; o < 64; o <<= 1) v += __shfl_xor(v, o);
    return v;
}

struct ConvDesc { const float* W; int ldw, k0, scol; bf16* dst; int ldd; const float* kscale; };
__device__ __forceinline__ void conv_load(const ConvDesc& d, float (&v)[32], int lane) {
    const float* wp = d.W + (size_t)(d.k0 + (lane >> 5)) * d.ldw + d.scol + (lane & 31);
#pragma unroll
    for (int i = 0; i < 32; ++i) v[i] = wp[(size_t)(2 * i) * d.ldw];
}
__device__ __forceinline__ void conv_finish(const ConvDesc& d, float (&v)[32], LAS float* scr, int lane) {
    if (d.kscale) {
#pragma unroll
        for (int i = 0; i < 32; ++i) v[i] *= d.kscale[d.k0 + 2 * i + (lane >> 5)]; }
#pragma unroll
    for (int i = 0; i < 32; ++i) scr[(2 * i + (lane >> 5)) * 33 + (lane & 31)] = v[i];
    LDS_WAIT(); asm volatile("" ::: "memory");
    const int c = lane & 7;
#pragma unroll
    for (int j = 0; j < 4; ++j) { const int n = (lane >> 3) + 8 * j; const LAS float* s = scr + (8 * c) * 33 + n;
        u32x4 o; o.x = pg::cvt_pk_bf16(s[0 * 33], s[1 * 33]); o.y = pg::cvt_pk_bf16(s[2 * 33], s[3 * 33]); o.z = pg::cvt_pk_bf16(s[4 * 33], s[5 * 33]); o.w = pg::cvt_pk_bf16(s[6 * 33], s[7 * 33]);
        *(GAS u32x4*)(d.dst + (size_t)n * d.ldd + d.k0 + 8 * c) = o; }
    LDS_WAIT(); asm volatile("" ::: "memory");
}
__device__ __forceinline__ void conv_item(const float* W, int ldw, int k0, int scol, bf16* dst, int ldd, const float* kscale, LAS float* scr, int lane) {
    ConvDesc d{W, ldw, k0, scol, dst, ldd, kscale}; float v[32]; conv_load(d, v, lane); conv_finish(d, v, scr, lane);
}
__device__ __forceinline__ int inproj_src_col(int cp) { return cp < 1536 ? cp : (cp < 2048 ? cp + (OU - 1536) : (cp < 3072 ? cp + (OGA - 2048) : cp + (OGS - 3072))); }
__device__ __forceinline__ int inproj_dst_row(int cp) { const int t = cp & ~255, c = cp & 255, wc = c >> 6, bj = (c >> 5) & 1, j = c & 31; return t + 128 * bj + 32 * wc + j; }

__device__ __forceinline__ void p0_prologue(Frame& F, const Args& a) {
    unsigned char* ws = a.ws;
    LAS float* scr = (LAS float*)(F.lds + F.wave * 8704);
    LAS float* wf = (LAS float*)(F.lds + 73728);
    const int gw = F.vcu * NWAVES + F.wave, NGW = F.G * NWAVES;
    const float* w_in = a.in[2]; const int sub = a.sub;
    for (int i = F.tid; i < 2 * 1024; i += NWAVES * 64) { const int k = i >> 1, hh = (i & 1) * 4; const f32x4 v = *(const GAS f32x4*)(w_in + (size_t)k * DIN + OF + hh);
        wf[(hh + 0) * 1024 + k] = v.x; wf[(hh + 1) * 1024 + k] = v.y; wf[(hh + 2) * 1024 + k] = v.z; wf[(hh + 3) * 1024 + k] = v.w; }
    constexpr int I_IN = 16 * 128;
    for (int it = (sub & 1) ? gw : I_IN; it < I_IN; it += NGW) { const int kb = it >> 7, nb = it & 127, cp = nb * 32;
        conv_item(w_in, DIN, kb * 64, inproj_src_col(cp), (bf16*)(ws + WS_WIN) + (size_t)inproj_dst_row(cp) * D, D, nullptr, scr, F.lane); }
    __syncthreads();
    const float* x = a.in[0]; const float* g = a.in[1]; const float* bfg = a.in[3];
    bf16* XN = (bf16*)(ws + WS_XN); float* LOGF = (float*)(ws + WS_CUM);
    { int m = (sub & 2) ? gw : T; f32x4 v[4], v1[4], v2[4];
#define P0_LOADROW(dst, mm) do { const int mc_ = (mm) < T ? (mm) : T - 1; const GAS f32x4* xr_ = (const GAS f32x4*)(x + (size_t)mc_ * D) + F.lane; _Pragma("unroll") for (int j = 0; j < 4; ++j) dst[j] = xr_[64 * j]; } while (0)
      P0_LOADROW(v, m); P0_LOADROW(v1, m + NGW); P0_LOADROW(v2, m + 2 * NGW);
      constexpr int RPW = T / (256 * NWAVES);
#pragma unroll
      for (int it_ = 0; it_ < RPW; ++it_) {
        const int mn = m + NGW; f32x4 vn[4];
        P0_LOADROW(vn, m + 3 * NGW);
        float s = 0.f;
#pragma unroll
        for (int j = 0; j < 4; ++j) s += (v[j].x * v[j].x + v[j].y * v[j].y) + (v[j].z * v[j].z + v[j].w * v[j].w);
        float f[8];
#pragma unroll
        for (int h = 0; h < 8; ++h) f[h] = 0.f;
        f32x4 xg[4];
#pragma unroll
        for (int j = 0; j < 4; ++j) { const f32x4 gg = *((const GAS f32x4*)g + 64 * j + F.lane); xg[j] = v[j] * gg;
#pragma unroll
            for (int h = 0; h < 8; ++h) { const f32x4 ww = *((const LAS f32x4*)(wf + h * 1024) + 64 * j + F.lane); f[h] += (xg[j].x * ww.x + xg[j].y * ww.y) + (xg[j].z * ww.z + xg[j].w * ww.w); } }
        const float rstd = rsqrtf(wave_sum(s) * (1.f / D) + EPS);
        float f4[4], f2[2], f1;
        { const bool up = F.lane >= 32;
#pragma unroll
          for (int i = 0; i < 4; ++i) { const float snd = up ? f[i] : f[4 + i], kp = up ? f[4 + i] : f[i]; f4[i] = kp + __shfl_xor(snd, 32); } }
        { const bool up = (F.lane & 16) != 0;
#pragma unroll
          for (int i = 0; i < 2; ++i) { const float snd = up ? f4[i] : f4[2 + i], kp = up ? f4[2 + i] : f4[i]; f2[i] = kp + __shfl_xor(snd, 16); } }
        { const bool up = (F.lane & 8) != 0; const float snd = up ? f2[0] : f2[1], kp = up ? f2[1] : f2[0]; f1 = kp + __shfl_xor(snd, 8); }
        f1 += __shfl_xor(f1, 4); f1 += __shfl_xor(f1, 2); f1 += __shfl_xor(f1, 1);
        GAS u32x2* o8 = (GAS u32x2*)(XN + (size_t)m * D) + F.lane;
#pragma unroll
        for (int j = 0; j < 4; ++j) { const f32x4 xn = xg[j] * rstd; u32x2 w; w.x = pg::cvt_pk_bf16(xn.x, xn.y); w.y = pg::cvt_pk_bf16(xn.z, xn.w); if (m < T) o8[64 * j] = w; }
        if (m < T && (F.lane & 7) == 0) { const int hh = F.lane >> 3, b = m / SEQ, sidx = m % SEQ; LOGF[((size_t)b * NH + hh) * SEQ + sidx] = log_sigmoid(f1 * rstd + bfg[hh]); }
#pragma unroll
        for (int j = 0; j < 4; ++j) { v[j] = v1[j]; v1[j] = v2[j]; v2[j] = vn[j]; }
        m = mn;
      } }
    if ((sub & 4) && F.G == 256) {
        __syncthreads();
        const int g = F.vcu >> 3, q = F.vcu & 7;
        LAS f32x2* PW = (LAS f32x2*)(F.lds);
        LAS f32x2* BB = (LAS f32x2*)(F.lds + 16896);
        LAS f32x2* CT = (LAS f32x2*)(F.lds + 16896 + 8192);
        LAS float* KT = (LAS float*)(F.lds + 16896 + 16384);
        const float* A_re = a.in[6]; const float* A_im = a.in[7]; const float* log_dt = a.in[8]; const float* B_re = a.in[9]; const float* B_im = a.in[10]; const float* C_re = a.in[11]; const float* C_im = a.in[12];
        if (F.tid < NP) { const int p = F.tid;
            const double dt = exp((double)log_dt[g]), ar = A_re[g * NP + p], ai = A_im[g * NP + p];
            const double er = exp(ar * dt), abr = er * cos(ai * dt), abi = er * sin(ai * dt);
            const double nr = abr - 1.0, ni = abi, den = ar * ar + ai * ai, fr_ = (nr * ar + ni * ai) / den, fi_ = (ni * ar - nr * ai) / den;
            double pr = 1.0, pi = 0.0;
            for (int tau = 0; tau <= LCH; ++tau) { PW[tau * NP + p] = (f32x2){(float)pr, (float)pi}; const double t2 = pr * abr - pi * abi; pi = pr * abi + pi * abr; pr = t2; }
            if (q == 0) { ((float*)(ws + WS_AL))[(g * NP + p) * 2] = PW[LCH * NP + p].x; ((float*)(ws + WS_AL))[(g * NP + p) * 2 + 1] = PW[LCH * NP + p].y; }
            for (int c = 0; c < GC; ++c) { const double br = B_re[(g * NP + p) * GC + c], bi = B_im[(g * NP + p) * GC + c]; BB[p * GC + c] = (f32x2){(float)(fr_ * br - fi_ * bi), (float)(fr_ * bi + fi_ * br)}; } }
        for (int i = F.tid; i < GC * NP; i += NWAVES * 64) { const int c = i >> 6, p = i & 63; CT[p * GC + c] = (f32x2){C_re[g * GC * NP + i], C_im[g * GC * NP + i]}; }
        __syncthreads();
        { float* KTG = (float*)(ws + WS_KTG) + (size_t)g * LCH * GC * GC;
          for (int i = 4 * q * GC * GC + F.tid; i < (4 * q + 4) * GC * GC; i += NWAVES * 64) { const int tau = i >> 8, co = (i >> 4) & 15, ci = i & 15; float acc = 0.f;
#pragma unroll 4
              for (int p = 0; p < NP; ++p) { const f32x2 w = PW[tau * NP + p], b = BB[p * GC + ci], c = CT[p * GC + co]; const float wr_ = w.x * b.x - w.y * b.y, wi_ = w.x * b.y + w.y * b.x; acc += c.x * wr_ - c.y * wi_; }
              KTG[i] = acc; } }
        {
          const int n = 64 * q + (F.tid >> 3), part = F.tid & 7, j = n >> 4, co = n & 15; bf16* row = (bf16*)(ws + WS_BTY) + ((size_t)g * 512 + n) * U2P;
          auto bval = [&](int k) -> float { const int p = k & 63; const f32x2 w = PW[(j + 1) * NP + p], c = CT[p * GC + co]; return k < 64 ? (c.x * w.x - c.y * w.y) : -(c.x * w.y + c.y * w.x); };
#pragma unroll 1
          for (int it = 0; it < 2; ++it) { const int k = (it * 8 + part) * 8;
              u32x4 o; o.x = pg::cvt_pk_bf16(bval(k), bval(k + 1)); o.y = pg::cvt_pk_bf16(bval(k + 2), bval(k + 3)); o.z = pg::cvt_pk_bf16(bval(k + 4), bval(k + 5)); o.w = pg::cvt_pk_bf16(bval(k + 6), bval(k + 7)); *(GAS u32x4*)(row + k) = o; } }
        {
          const int n = 32 * q + (F.tid >> 4), part = F.tid & 15; bf16* row = (bf16*)(ws + WS_M1T) + ((size_t)g * 256 + n) * 512;
          auto mval = [&](int k) -> float { const int j = k >> 4, ci = k & 15; float x = 0.f;
              if (n < 128) { const int p = n & 63; const f32x2 w = PW[(LCH - 1 - j) * NP + p], b = BB[p * GC + ci]; x = n < 64 ? (w.x * b.x - w.y * b.y) : (w.x * b.y + w.y * b.x); }
              return x; };
#pragma unroll 1
          for (int it = 0; it < 4; ++it) { const int k = (it * 16 + part) * 8;
              u32x4 o; o.x = pg::cvt_pk_bf16(mval(k), mval(k + 1)); o.y = pg::cvt_pk_bf16(mval(k + 2), mval(k + 3)); o.z = pg::cvt_pk_bf16(mval(k + 4), mval(k + 5)); o.w = pg::cvt_pk_bf16(mval(k + 6), mval(k + 7)); *(GAS u32x4*)(row + k) = o; } }
    }
}

__device__ __forceinline__ void p1_cumsum(Frame& F, float* CUM, int* T0, const float* gq, const float* gk) {
    LAS double* part = (LAS double*)(F.lds);
    float* p = CUM + (size_t)blockIdx.x * SEQ + F.tid * 16;
    f32x4 v[4]; float run[16]; float a = 0.f;
#pragma unroll
    for (int j = 0; j < 4; ++j) v[j] = ((const GAS f32x4*)p)[j];
#pragma unroll
    for (int j = 0; j < 4; ++j) { a += v[j].x; run[4 * j] = a; a += v[j].y; run[4 * j + 1] = a; a += v[j].z; run[4 * j + 2] = a; a += v[j].w; run[4 * j + 3] = a; }
    part[F.tid] = (double)a;
    __syncthreads();
    if (F.tid < 64) { double loc[8]; double s = 0.0;
#pragma unroll
        for (int i = 0; i < 8; ++i) { loc[i] = s; s += part[F.tid * 8 + i]; }
        double incl = s;
#pragma unroll
        for (int o = 1; o < 64; o <<= 1) { const double t = __shfl_up(incl, o); if (F.lane >= o) incl += t; }
        const double excl = incl - s;
#pragma unroll
        for (int i = 0; i < 8; ++i) part[F.tid * 8 + i] = excl + loc[i]; }
    __syncthreads();
    const double base = part[F.tid];
#pragma unroll
    for (int j = 0; j < 4; ++j) { f32x4 o; o.x = (float)((base + (double)run[4 * j]) * 1.4426950408889634); o.y = (float)((base + (double)run[4 * j + 1]) * 1.4426950408889634);
        o.z = (float)((base + (double)run[4 * j + 2]) * 1.4426950408889634); o.w = (float)((base + (double)run[4 * j + 3]) * 1.4426950408889634); ((GAS f32x4*)p)[j] = o; }
    __syncthreads();
    asm volatile("s_waitcnt vmcnt(0)" ::: "memory"); __syncthreads();
    if (F.tid < 32) { float gqm = 0.f, gkm = 0.f; for (int i = 0; i < HD; ++i) { gqm = fmaxf(gqm, fabsf(gq[i])); gkm = fmaxf(gkm, fabsf(gk[i])); }
        const float thr = 2.f * 64.f * C2 * gqm * gkm + 37.f; const int qb = F.tid, NTu = 4 * qb + 4;
        const unsigned* cu = (const unsigned*)(CUM + (size_t)blockIdx.x * SEQ);
        const float fq0 = __builtin_bit_cast(float, __hip_atomic_load(cu + qb * 256, __ATOMIC_RELAXED, __HIP_MEMORY_SCOPE_AGENT));
        int lo = 0, hi = NTu - 1;
        while (lo < hi) { const int mid = (lo + hi) >> 1; const float fk = __builtin_bit_cast(float, __hip_atomic_load(cu + 64 * mid + 63, __ATOMIC_RELAXED, __HIP_MEMORY_SCOPE_AGENT)); if (fq0 - fk >= -thr) hi = mid; else lo = mid + 1; }
        int t0 = lo & ~1; t0 = t0 > NTu - 4 ? NTu - 4 : t0; T0[blockIdx.x * 32 + qb] = t0; }
    __syncthreads();
}
struct PhInProj {
    static constexpr bool GATHER = false, HOOKS = false;
    unsigned lda, ldb; const char* A; const char* B; pg::StaticOrder so;
    bf16 *Q, *K, *V, *U2X, *GA, *GS; const float *gq, *gk;
    __device__ __forceinline__ bool next(int i, pg::Unit& u) const { int pm, pn; if (!so.next(i, pm, pn)) return false; u.A = A + (size_t)pm * 256 * lda; u.B = B + (size_t)pn * 256 * ldb; u.nt = D / 64; u.pm = pm; u.pn = pn; u.aux = 0; return true; }
    __device__ __forceinline__ void offs(const pg::Unit&, const int (&R)[2], const int (&C)[2], unsigned (&vo)[2][2]) const { pg::offs_plain(lda, R, C, vo); }
    __device__ __forceinline__ void epi(const f32x4 (&acc)[2][2][4][2], const pg::Unit& u, int wr, int wc, int fr, int fq) const {
        const int pn = u.pn, row0 = u.pm * 256 + wr * 64 + fr;
        if (pn < 4) {
            const bool isq = pn < 2; const float* g = isq ? gq : gk; bf16* O = isq ? Q : K; const int cb = (pn & 1) * 256 + 64 * wc + 8 * fq; const float sc = isq ? C2 : 1.f;
            f32x4 gv[2][2];
#pragma unroll
            for (int bj = 0; bj < 2; ++bj)
#pragma unroll
                for (int n = 0; n < 2; ++n) gv[bj][n] = *(const f32x4*)(g + 32 * bj + 8 * fq + 4 * n) * sc;
#pragma unroll
            for (int ai = 0; ai < 2; ++ai)
#pragma unroll
                for (int m = 0; m < 4; ++m) { float ss = 0.f;
#pragma unroll
                    for (int bj = 0; bj < 2; ++bj)
#pragma unroll
                        for (int n = 0; n < 2; ++n) { const f32x4 v = acc[ai][bj][m][n]; ss += (v[0] * v[0] + v[1] * v[1]) + (v[2] * v[2] + v[3] * v[3]); }
                    ss += __shfl_xor(ss, 16); ss += __shfl_xor(ss, 32);
                    const float rstd = rsqrtf(ss * (1.f / 64.f) + EPS);
                    bf16* rowp = O + (size_t)(row0 + ai * 128 + m * 16) * DA + cb;
#pragma unroll
                    for (int bj = 0; bj < 2; ++bj) *(u32x4*)(rowp + 32 * bj) = pg::pack8(acc[ai][bj][m][0] * rstd * gv[bj][0], acc[ai][bj][m][1] * rstd * gv[bj][1]); }
        } else if (pn < 6) {
            const int cb = (pn - 4) * 256 + 64 * wc + 8 * fq;
#pragma unroll
            for (int ai = 0; ai < 2; ++ai)
#pragma unroll
                for (int m = 0; m < 4; ++m) { bf16* rowp = V + (size_t)(row0 + ai * 128 + m * 16) * DA + cb;
#pragma unroll
                    for (int bj = 0; bj < 2; ++bj) *(u32x4*)(rowp + 32 * bj) = pg::pack8(acc[ai][bj][m][0], acc[ai][bj][m][1]); }
        } else if (pn < 8) {
#pragma unroll
            for (int ai = 0; ai < 2; ++ai)
#pragma unroll
                for (int m = 0; m < 4; ++m) { const int row = row0 + ai * 128 + m * 16;
#pragma unroll
                    for (int bj = 0; bj < 2; ++bj) { const int cu = (pn - 6) * 256 + 64 * wc + 32 * bj + 8 * fq;
                        *(u32x4*)(U2X + u2x_index(cu >> 4, row, cu & 15)) = pg::pack8(acc[ai][bj][m][0], acc[ai][bj][m][1]); } }
        } else {
            bf16* G = pn < 12 ? GA : GS; const int cb = ((pn - 8) & 3) * 256 + 64 * wc + 8 * fq;
#pragma unroll
            for (int ai = 0; ai < 2; ++ai)
#pragma unroll
                for (int m = 0; m < 4; ++m) { bf16* rowp = G + (size_t)(row0 + ai * 128 + m * 16) * D + cb;
#pragma unroll
                    for (int bj = 0; bj < 2; ++bj) { f32x4 a = acc[ai][bj][m][0], b = acc[ai][bj][m][1];
#pragma unroll
                        for (int e = 0; e < 4; ++e) { a[e] = pg::fsigmoid(a[e]); b[e] = pg::fsigmoid(b[e]); }
                        *(u32x4*)(rowp + 32 * bj) = pg::pack8(a, b); } }
        }
    }
};

__device__ __forceinline__ void cnt_publish(unsigned* c) {
    asm volatile("s_waitcnt vmcnt(0)" ::: "memory");
    if ((threadIdx.x & 63) == 0) __hip_atomic_fetch_add(c, 1u, __ATOMIC_RELAXED, __HIP_MEMORY_SCOPE_AGENT);
}
__device__ __forceinline__ void cnt_wait_wave0(unsigned* c, unsigned want) {
    if (threadIdx.x < 64) { unsigned sp = 0;
        while ((unsigned)__builtin_amdgcn_readfirstlane(__hip_atomic_load(c, __ATOMIC_RELAXED, __HIP_MEMORY_SCOPE_AGENT)) < want) { __builtin_amdgcn_s_sleep(2); if (++sp > (1u << 22)) break; }
        __builtin_amdgcn_fence(__ATOMIC_ACQUIRE, "agent");
        asm volatile("s_waitcnt vmcnt(0)" ::: "memory"); }
}
struct PhGlu {
    static constexpr bool GATHER = false, HOOKS = true;
    unsigned lda, ldb; const char* A; const char* B; pg::StaticOrder so; const bf16* Y1; bf16* YS; unsigned* cYS;
    __device__ __forceinline__ void a_ready(const pg::Unit&) const {}
    __device__ __forceinline__ void done(const pg::Unit& u) const { cnt_publish(cYS + 16 * u.pm); }
    __device__ __forceinline__ bool next(int i, pg::Unit& u) const { int pm, pn; if (!so.next(i, pm, pn)) return false; u.A = A + (size_t)pm * 256 * lda; u.B = B + (size_t)pn * 256 * ldb; u.nt = DS / 64; u.pm = pm; u.pn = pn; u.aux = 0; return true; }
    __device__ __forceinline__ void offs(const pg::Unit&, const int (&R)[2], const int (&C)[2], unsigned (&vo)[2][2]) const { pg::offs_plain(lda, R, C, vo); }
    __device__ __forceinline__ void epi(const f32x4 (&acc)[2][2][4][2], const pg::Unit& u, int wr, int wc, int fr, int fq) const {
        const int row0 = u.pm * 256 + wr * 64 + fr, cb = u.pn * 256 + 32 * wc + 8 * fq;
#pragma unroll
        for (int ai = 0; ai < 2; ++ai)
#pragma unroll
            for (int m = 0; m < 4; ++m) { const size_t ro = (size_t)(row0 + ai * 128 + m * 16) * DS + cb;
#pragma unroll
                for (int bj = 0; bj < 2; ++bj) { const u32x4 yv = *(const u32x4*)(Y1 + ro + 128 * bj); f32x4 y0, y1; pg::unpack8(yv, y0, y1);
                    f32x4 a = acc[ai][bj][m][0], b = acc[ai][bj][m][1];
#pragma unroll
                    for (int e = 0; e < 4; ++e) { a[e] = y0[e] * pg::fsigmoid(a[e]); b[e] = y1[e] * pg::fsigmoid(b[e]); }
                    pg::store16_wt(YS + ro + 128 * bj, pg::pack8(a, b)); } }
    }
};
struct PhProj {
    static constexpr bool GATHER = false, HOOKS = true;
    unsigned lda, ldb; const char* O; const char* YSp; const char* WPA; const char* WPS; pg::StaticOrder so; bf16* GA; const bf16* GS; unsigned* cYS; unsigned* cMIX;
    __device__ __forceinline__ void a_ready(const pg::Unit& u) const { if (u.aux) { cnt_wait_wave0(cYS + 16 * u.pm, 16u); asm volatile("" ::: "memory"); __builtin_amdgcn_s_barrier(); asm volatile("" ::: "memory"); } }
    __device__ __forceinline__ void done(const pg::Unit& u) const { if (u.aux) cnt_publish(cMIX + 16 * u.pm); }
    __device__ __forceinline__ bool next(int i, pg::Unit& u) const { int pm, pn; if (!so.next(i >> 1, pm, pn)) return false; const int sub = i & 1;
        u.A = (sub ? YSp : O) + (size_t)pm * 256 * lda; u.B = (sub ? WPS : WPA) + (size_t)pn * 256 * ldb; u.nt = DA / 64; u.pm = pm; u.pn = pn; u.aux = sub; return true; }
    __device__ __forceinline__ void offs(const pg::Unit&, const int (&R)[2], const int (&C)[2], unsigned (&vo)[2][2]) const { pg::offs_plain(lda, R, C, vo); }
    __device__ __forceinline__ void epi(const f32x4 (&acc)[2][2][4][2], const pg::Unit& u, int wr, int wc, int fr, int fq) const {
        const int row0 = u.pm * 256 + wr * 64 + fr, cb = u.pn * 256 + 32 * wc + 8 * fq; const bool sub = u.aux != 0;
#pragma unroll
        for (int ai = 0; ai < 2; ++ai)
#pragma unroll
            for (int m = 0; m < 4; ++m) { const size_t ro = (size_t)(row0 + ai * 128 + m * 16) * D + cb;
#pragma unroll
                for (int bj = 0; bj < 2; ++bj) { const u32x4 gv = *(const u32x4*)(GA + ro + 128 * bj); f32x4 g0, g1; pg::unpack8(gv, g0, g1);
                    f32x4 a = acc[ai][bj][m][0], b = acc[ai][bj][m][1];
                    if (!sub) { a = a * g0; b = b * g1; }
                    else { const u32x4 sv = *(const u32x4*)(GS + ro + 128 * bj); f32x4 s0, s1; pg::unpack8(sv, s0, s1); a = g0 + s0 * a; b = g1 + s1 * b; }
                    if (sub) pg::store16_wt(GA + ro + 128 * bj, pg::pack8(a, b)); else *(u32x4*)(GA + ro + 128 * bj) = pg::pack8(a, b); } }
    }
};
struct PhWout {
    static constexpr bool GATHER = false, HOOKS = true;
    unsigned lda, ldb; const char* A; const char* B; pg::StaticOrder so; const float* x; float* out; bf16* X2B; float* SSP; unsigned* cMIX; unsigned* cX2;
    __device__ __forceinline__ void a_ready(const pg::Unit& u) const { cnt_wait_wave0(cMIX + 16 * u.pm, 32u); asm volatile("" ::: "memory"); __builtin_amdgcn_s_barrier(); asm volatile("" ::: "memory"); }
    __device__ __forceinline__ void done(const pg::Unit& u) const { cnt_publish(cX2 + 16 * u.pm); }
    __device__ __forceinline__ bool next(int i, pg::Unit& u) const { int pm, pn; if (!so.next(i, pm, pn)) return false; u.A = A + (size_t)pm * 256 * lda; u.B = B + (size_t)pn * 256 * ldb; u.nt = D / 64; u.pm = pm; u.pn = pn; u.aux = 0; return true; }
    __device__ __forceinline__ void offs(const pg::Unit&, const int (&R)[2], const int (&C)[2], unsigned (&vo)[2][2]) const { pg::offs_plain(lda, R, C, vo); }
    __device__ __forceinline__ void epi(const f32x4 (&acc)[2][2][4][2], const pg::Unit& u, int wr, int wc, int fr, int fq) const {
        const int row0 = u.pm * 256 + wr * 64 + fr, cb = u.pn * 256 + 32 * wc + 8 * fq;
#pragma unroll
        for (int ai = 0; ai < 2; ++ai)
#pragma unroll
            for (int m = 0; m < 4; ++m) { const int row = row0 + ai * 128 + m * 16; const size_t ro = (size_t)row * D + cb; float ss = 0.f;
#pragma unroll
                for (int bj = 0; bj < 2; ++bj) { const f32x4 x0 = *(const f32x4*)(x + ro + 128 * bj), x1 = *(const f32x4*)(x + ro + 128 * bj + 4);
                    const f32x4 a = acc[ai][bj][m][0] + x0, b = acc[ai][bj][m][1] + x1;
                    pg::store16_wt(X2B + ro + 128 * bj, pg::pack8(a, b));
                    ss += (a[0] * a[0] + a[1] * a[1]) + (a[2] * a[2] + a[3] * a[3]) + (b[0] * b[0] + b[1] * b[1]) + (b[2] * b[2] + b[3] * b[3]); }
                ss += __shfl_xor(ss, 16); ss += __shfl_xor(ss, 32);
                if (fq == 0) __hip_atomic_store((unsigned*)SSP + (size_t)row * 16 + u.pn * 4 + wc, __builtin_bit_cast(unsigned, ss), __ATOMIC_RELAXED, __HIP_MEMORY_SCOPE_AGENT);
                asm volatile("" ::: "memory"); }
    }
};

__device__ __forceinline__ void p2_side_work(Frame& F, const Args& a) {
    unsigned char* ws = a.ws; const int i0 = (int)blockIdx.x - 64;
    LAS float* KT = (LAS float*)F.lds;
    for (int sl = i0; sl < NG * 8; sl += 192) { const int g = sl >> 3, q = sl & 7;
        __syncthreads();
        { const GAS f32x4* src = (const GAS f32x4*)((const float*)(ws + WS_KTG) + (size_t)g * LCH * GC * GC);
          for (int i = F.tid; i < (4 * q + 4) * GC * GC / 4; i += NWAVES * 64) *(LAS f32x4*)(KT + 4 * i) = src[i]; }
        __syncthreads();
        const int n = 64 * q + (F.tid >> 3), part = F.tid & 7, j = n >> 4, co = n & 15; bf16* row = (bf16*)(ws + WS_BTY) + ((size_t)g * 512 + n) * U2P + 128;
#pragma unroll 1
        for (int it = 0; it < 8; ++it) { const int k = (it * 8 + part) * 8, sidx = k >> 4, ci = k & 15;
            u32x4 o = (u32x4){0u, 0u, 0u, 0u};
            if (sidx <= j) { const LAS float* kp = KT + ((j - sidx) * GC + co) * GC + ci; const f32x4 k0 = *(const LAS f32x4*)kp, k1 = *(const LAS f32x4*)(kp + 4); o = pg::pack8(k0, k1); }
            *(GAS u32x4*)(row + k) = o; } }
    __syncthreads();
    LAS float* scr = (LAS float*)(F.lds + F.wave * 8704);
    constexpr int I_GLU = 8 * 16, I_PA = 8 * 32, I_OUT = 16 * 32;
    for (int it = i0 * NWAVES + F.wave; it < I_GLU + 2 * I_PA + I_OUT; it += 192 * NWAVES) { int r = it;
        if (r < I_GLU) { const int kb = r >> 4, nb = r & 15; conv_item(a.in[14], DS, kb * 64, nb * 32, (bf16*)(ws + WS_WGLU) + (size_t)(nb * 32) * DS, DS, nullptr, scr, F.lane); continue; } r -= I_GLU;
        if (r < I_PA) { const int kb = r >> 5, nb = r & 31; conv_item(a.in[15], D, kb * 64, nb * 32, (bf16*)(ws + WS_WPA) + (size_t)(nb * 32) * DA, DA, nullptr, scr, F.lane); continue; } r -= I_PA;
        if (r < I_PA) { const int kb = r >> 5, nb = r & 31; conv_item(a.in[16], D, kb * 64, nb * 32, (bf16*)(ws + WS_WPS) + (size_t)(nb * 32) * DS, DS, nullptr, scr, F.lane); continue; } r -= I_PA;
        { const int kb = r >> 5, nb = r & 31; conv_item(a.in[17], D, kb * 64, nb * 32, (bf16*)(ws + WS_WOUT) + (size_t)(nb * 32) * D, D, nullptr, scr, F.lane); } }
    if (i0 < 48) { const int r = i0; const float* gf = a.in[18]; const float* wrg = a.in[19]; const float* wre = a.in[21]; bf16* WR = (bf16*)(ws + WS_WR) + (size_t)r * D;
        for (int k = F.tid; k < D; k += NWAVES * 64) { const float w = r < 4 ? wrg[k * 4 + r] : (r < 36 ? wre[k * NE + r - 4] : 0.f); WR[k] = f2bf(w * gf[k]); } }
    __syncthreads();
}
__device__ __forceinline__ void p2_expert_weights(Frame& F, const Args& a, int it0, int it1, int gw, int NGW) {
    unsigned char* ws = a.ws; LAS float* scr = (LAS float*)(F.lds + F.wave * 8704);
    const float* gf = a.in[18]; const float* wg = a.in[23]; const float* wu = a.in[24]; const float* wd = a.in[25];
    constexpr int I_G = 16 * 8, I_D = 4 * 32;
    constexpr int NITEMS = NE * (2 * I_G + I_D);
    auto desc = [&](int it) -> ConvDesc { const int e = it / (2 * I_G + I_D); int r = it % (2 * I_G + I_D);
        if (r < 2 * I_G) { const int up = r >= I_G; if (up) r -= I_G; const int kb = r >> 3, nb = r & 7, n0 = nb * 32;
            return ConvDesc{(up ? wu : wg) + (size_t)e * D * DE, DE, kb * 64, n0, (bf16*)(ws + WS_WGU) + ((size_t)e * 512 + 256 * (n0 >> 7) + 128 * up + (n0 & 127)) * D, D, gf}; }
        r -= 2 * I_G; const int kb = r >> 5, nb = r & 31; return ConvDesc{wd + (size_t)e * DE * D, D, kb * 64, nb * 32, (bf16*)(ws + WS_WD) + ((size_t)e * D + nb * 32) * DE, DE, nullptr}; };
    const int NITEMS_ALL = NITEMS; (void)NITEMS_ALL;
    int it = (a.sub & 4) ? it0 + gw : it1;
    float v[32], v1[32]; ConvDesc d{}, d1{};
    d = desc(it < it1 ? it : it1 - 1); conv_load(d, v, F.lane);
    d1 = desc(it + NGW < it1 ? it + NGW : it1 - 1); conv_load(d1, v1, F.lane);
    while (it < it1) {
        const int itn = it + 2 * NGW; float vn[32]; ConvDesc dn = desc(itn < it1 ? itn : it1 - 1); conv_load(dn, vn, F.lane);
        conv_finish(d, v, scr, F.lane);
#pragma unroll
        for (int i = 0; i < 32; ++i) { v[i] = v1[i]; v1[i] = vn[i]; }
        d = d1; d1 = dn; it += NGW;
    }
}
__device__ __forceinline__ void p8_router(Frame& F, const Args& a) {
    unsigned char* ws = a.ws;
    constexpr int WPITCH = 2064;
    LAS unsigned char* wl = F.lds;
    LAS float* lg = (LAS float*)(F.lds + 48 * WPITCH) + F.wave * 16 * 48;
    { const GAS u32x4* src = (const GAS u32x4*)(ws + WS_WR);
      for (int i = F.tid; i < 48 * 128; i += NWAVES * 64) { const int r = i >> 7, c = i & 127; *(LAS u32x4*)(wl + r * WPITCH + c * 16) = src[i]; } }
    __syncthreads();
    const bf16* X2B = (const bf16*)(ws + WS_X2B); const float* SSP = (const float*)(ws + WS_SSP);
    const float* b_rg = a.in[20]; const float* b_re = a.in[22];
    float* RSTD = (float*)(ws + WS_RSTD); int* ROUTE = (int*)(ws + WS_ROUTE); int* CNT = (int*)(ws + WS_CTL) + CW_CNT; int* LIST = (int*)(ws + WS_LIST); float* WPOS = (float*)(ws + WS_WPOS); float* RPOS = (float*)(ws + WS_RPOS);
    const int fr = F.lane & 15, fq = F.lane >> 4;
    LAS int* lcnt = (LAS int*)(F.lds + 48 * WPITCH + NWAVES * 16 * 48 * 4);
    LAS int* lbase = lcnt + 32;
    for (int t0 = F.vcu * 64; t0 < T; t0 += F.G * 64) {
        cnt_wait_wave0((unsigned*)(F.ctl + CW_PX2) + 16 * (t0 >> 8), 32u);
        if (F.tid < 32) lcnt[F.tid] = 0;
        __syncthreads();
        int e0 = 0, e1 = 0, lr0 = 0, lr1 = 0; float w0 = 0.f, w1 = 0.f, rstd = 0.f;
        if (F.wave < 4) {
            const int tok = t0 + F.wave * 16 + fr;
            const GAS bf16x8* xa = (const GAS bf16x8*)(X2B + (size_t)tok * D + 8 * fq);
            f32x4 acc[3]; acc[0] = acc[1] = acc[2] = (f32x4){0.f, 0.f, 0.f, 0.f};
            bf16x8 xf[32];
#pragma unroll
            for (int ks = 0; ks < 32; ++ks) xf[ks] = xa[ks * 4];
#pragma unroll
            for (int ks = 0; ks < 32; ++ks) {
#pragma unroll
                for (int n = 0; n < 3; ++n) { const bf16x8 wfr = *(const LAS bf16x8*)(wl + (n * 16 + fr) * WPITCH + ks * 64 + fq * 16);
                    acc[n] = __builtin_amdgcn_mfma_f32_16x16x32_bf16(wfr, xf[ks], acc[n], 0, 0, 0); } }
#pragma unroll
            for (int n = 0; n < 3; ++n) *(LAS f32x4*)(lg + fr * 48 + n * 16 + 4 * fq) = acc[n];
            LDS_WAIT(); asm volatile("" ::: "memory");
            if (F.lane < 16) {
                const int t = t0 + F.wave * 16 + F.lane; const LAS float* l = lg + F.lane * 48;
                float ss = 0.f; { const f32x4* sp = (const f32x4*)(SSP + (size_t)t * 16);
#pragma unroll
                    for (int i = 0; i < 4; ++i) { const f32x4 v = sp[i]; ss += (v[0] + v[1]) + (v[2] + v[3]); } }
                rstd = rsqrtf(ss * (1.f / D) + EPS);
                float gl[4]; int gs = 0;
#pragma unroll
                for (int i = 0; i < 4; ++i) gl[i] = l[i] * rstd + b_rg[i];
                float gm = gl[0];
#pragma unroll
                for (int i = 1; i < 4; ++i) if (gl[i] > gm) { gm = gl[i]; gs = i; }
                float gsum = 0.f;
#pragma unroll
                for (int i = 0; i < 4; ++i) gsum += __expf(gl[i] - gm);
                const float gtop = 1.f / gsum;
                float el[8];
#pragma unroll
                for (int i = 0; i < 8; ++i) el[i] = l[4 + gs * 8 + i] * rstd + b_re[gs * 8 + i];
                int i0 = 0; float m0 = el[0];
#pragma unroll
                for (int i = 1; i < 8; ++i) if (el[i] > m0) { m0 = el[i]; i0 = i; }
                int i1 = -1; float m1 = -3.0e38f;
#pragma unroll
                for (int i = 0; i < 8; ++i) if (i != i0 && el[i] > m1) { m1 = el[i]; i1 = i; }
                const float p1 = __expf(m1 - m0); w0 = gtop / (1.f + p1); w1 = gtop * p1 / (1.f + p1);
                e0 = gs * 8 + i0; e1 = gs * 8 + i1;
                lr0 = __hip_atomic_fetch_add(&lcnt[e0], 1, __ATOMIC_RELAXED, __HIP_MEMORY_SCOPE_WORKGROUP); lr1 = __hip_atomic_fetch_add(&lcnt[e1], 1, __ATOMIC_RELAXED, __HIP_MEMORY_SCOPE_WORKGROUP);
            }
        }
        __syncthreads();
        if (F.tid < 32) { const int c = lcnt[F.tid]; lbase[F.tid] = c ? atomicAdd(&CNT[F.tid], c) : 0; }
        __syncthreads();
        if (F.wave < 4 && F.lane < 16) {
            const int t = t0 + F.wave * 16 + F.lane; const int r0 = lbase[e0] + lr0, r1 = lbase[e1] + lr1;
            RSTD[t] = rstd; *(int4*)(ROUTE + t * 4) = make_int4(e0, e1, r0, r1);
            LIST[e0 * T + r0] = t; LIST[e1 * T + r1] = t; WPOS[e0 * T + r0] = w0; WPOS[e1 * T + r1] = w1; RPOS[e0 * T + r0] = rstd; RPOS[e1 * T + r1] = rstd;
        }
        __syncthreads();
    }
}
__device__ __forceinline__ void moe_table(Frame& F, const int* CNT, LAS int* tb) {
    if (F.tid < 64) { const int e = F.lane; int c = 0; if (e < NE) c = (int)__hip_atomic_load((const unsigned*)CNT + e, __ATOMIC_RELAXED, __HIP_MEMORY_SCOPE_AGENT);
        const int tl = (c + 255) >> 8; int incl = tl;
#pragma unroll
        for (int o = 1; o < 32; o <<= 1) { const int v = __shfl_up(incl, o); if (e >= o) incl += v; }
        if (e < NE) { tb[e] = incl - tl; tb[64 + e] = c; } if (e == NE - 1) tb[32] = incl; }
    __syncthreads();
}
__device__ __forceinline__ int moe_find(const LAS int* tb, int mt) { int e = 0;
#pragma unroll 1
    for (int i = 1; i < NE; ++i) if (mt >= tb[i]) e = i; return e; }
struct PhMoeGU {
    static constexpr bool GATHER = true, HOOKS = true;
    unsigned lda, ldb; const char* X; const char* W; const LAS int* tb; const int* LIST; const float* RPOS; bf16* H; int G, c; unsigned* hcnt;
    __device__ __forceinline__ void a_ready(const pg::Unit&) const {}
    __device__ __forceinline__ void done(const pg::Unit& u) const {
        asm volatile("s_waitcnt vmcnt(0)" ::: "memory");
        if ((threadIdx.x & 63) == 0) __hip_atomic_fetch_add(hcnt + 16 * u.pm, 1u, __ATOMIC_RELAXED, __HIP_MEMORY_SCOPE_AGENT); }
    __device__ __forceinline__ bool next(int i, pg::Unit& u) const { const int L = i * G + c; if (L >= 2 * tb[32]) return false; const int mt = L >> 1, n2 = L & 1, e = moe_find(tb, mt);
        u.A = X; u.B = W + ((size_t)e * 512 + n2 * 256) * ldb; u.nt = D / 64; u.pm = mt; u.pn = n2; u.aux = e; return true; }
    __device__ __forceinline__ void offs(const pg::Unit& u, const int (&R)[2], const int (&C)[2], unsigned (&vo)[2][2]) const {
        const int e = u.aux, cnt = tb[64 + e], r0 = (u.pm - tb[e]) * 256; const int* lp = LIST + (size_t)e * T;
#pragma unroll
        for (int h = 0; h < 2; ++h)
#pragma unroll
            for (int i = 0; i < 2; ++i) { int r = r0 + h * 128 + R[i]; r = r < cnt ? r : cnt - 1; vo[h][i] = (unsigned)lp[r] * lda + (unsigned)C[i] * 2u; }
    }
    __device__ __forceinline__ void epi(const f32x4 (&acc)[2][2][4][2], const pg::Unit& u, int wr, int wc, int fr, int fq) const {
        const int e = u.aux, r0 = (u.pm - tb[e]) * 256; const float* rp = RPOS + (size_t)e * T + r0;
#pragma unroll
        for (int ai = 0; ai < 2; ++ai)
#pragma unroll
            for (int m = 0; m < 4; ++m) { const int tr = ai * 128 + wr * 64 + m * 16 + fr; const float rs = rp[tr];
                f32x4 g0 = acc[ai][0][m][0] * rs, g1 = acc[ai][0][m][1] * rs; const f32x4 u0 = acc[ai][1][m][0] * rs, u1 = acc[ai][1][m][1] * rs;
#pragma unroll
                for (int q = 0; q < 4; ++q) { g0[q] = g0[q] * pg::fsigmoid(g0[q]) * u0[q]; g1[q] = g1[q] * pg::fsigmoid(g1[q]) * u1[q]; }
                pg::store16_wt(H + ((size_t)u.pm * 256 + tr) * DE + u.pn * 128 + 32 * wc + 8 * fq, pg::pack8(g0, g1)); }
    }
};
struct PhMoeDown {
    static constexpr bool GATHER = false, HOOKS = true;
    unsigned lda, ldb; const char* Hp; const char* W; const LAS int* tb; const float* WPOS; bf16* Y; unsigned* hcnt; unsigned* qctr; volatile LAS int* slot;
    int pend;
    __device__ __forceinline__ bool next(int i, pg::Unit& u) {
        if (threadIdx.x == 0) { if (i == 0) pend = (int)__hip_atomic_fetch_add(qctr, 1u, __ATOMIC_RELAXED, __HIP_MEMORY_SCOPE_AGENT);
            slot[i & 1] = pend; pend = (int)__hip_atomic_fetch_add(qctr, 1u, __ATOMIC_RELAXED, __HIP_MEMORY_SCOPE_AGENT); }
        asm volatile("s_waitcnt lgkmcnt(0)" ::: "memory"); __builtin_amdgcn_s_barrier(); asm volatile("" ::: "memory");
        const int L = slot[i & 1]; if (L >= 4 * tb[32]) return false; const int mt = L >> 2, n4 = L & 3, e = moe_find(tb, mt);
        u.A = Hp + (size_t)mt * 256 * lda; u.B = W + ((size_t)e * D + n4 * 256) * ldb; u.nt = DE / 64; u.pm = mt; u.pn = n4; u.aux = e; return true; }
    __device__ __forceinline__ void offs(const pg::Unit&, const int (&R)[2], const int (&C)[2], unsigned (&vo)[2][2]) const { pg::offs_plain(lda, R, C, vo); }
    __device__ __forceinline__ void a_ready(const pg::Unit& u) const {
        if (threadIdx.x < 64) { unsigned sp = 0;
            while ((unsigned)__builtin_amdgcn_readfirstlane(__hip_atomic_load(hcnt + 16 * u.pm, __ATOMIC_RELAXED, __HIP_MEMORY_SCOPE_AGENT)) < 16u) { __builtin_amdgcn_s_sleep(2); if (++sp > (1u << 22)) break; }
            __builtin_amdgcn_fence(__ATOMIC_ACQUIRE, "agent");
            asm volatile("s_waitcnt vmcnt(0)" ::: "memory"); }
        asm volatile("" ::: "memory"); __builtin_amdgcn_s_barrier(); asm volatile("" ::: "memory");
    }
    __device__ __forceinline__ void done(const pg::Unit&) const {}
    __device__ __forceinline__ void epi(const f32x4 (&acc)[2][2][4][2], const pg::Unit& u, int wr, int wc, int fr, int fq) const {
        const int e = u.aux, r0 = (u.pm - tb[e]) * 256; const float* wp = WPOS + (size_t)e * T + r0;
#pragma unroll
        for (int ai = 0; ai < 2; ++ai)
#pragma unroll
            for (int m = 0; m < 4; ++m) { int tr = ai * 128 + wr * 64 + m * 16 + fr; asm volatile("" : "+v"(tr));
                const float w = wp[tr]; bf16* yp = Y + (unsigned)((u.pm * 256 + tr) * D + u.pn * 256 + 32 * wc + 8 * fq);
#pragma unroll
                for (int bj = 0; bj < 2; ++bj) *(u32x4*)(yp + 128 * bj) = pg::pack8(acc[ai][bj][m][0] * w, acc[ai][bj][m][1] * w); }
    }
};
__device__ __forceinline__ void p11_combine(Frame& F, const Args& a, const LAS int* tb) {
    unsigned char* ws = a.ws; const int* ROUTE = (const int*)(ws + WS_ROUTE); const bf16* Y = (const bf16*)(ws + WS_Y); const bf16* X2B = (const bf16*)(ws + WS_X2B); float* out = a.out;
    for (int t = F.vcu * NWAVES + F.wave; t < T; t += F.G * NWAVES) {
        const int4 rt = *(const int4*)(ROUTE + t * 4);
        const GAS u32x2* y0 = (const GAS u32x2*)(Y + ((size_t)tb[rt.x] * 256 + rt.z) * D) + F.lane; const GAS u32x2* y1 = (const GAS u32x2*)(Y + ((size_t)tb[rt.y] * 256 + rt.w) * D) + F.lane;
        const GAS u32x2* xb = (const GAS u32x2*)(X2B + (size_t)t * D) + F.lane;
        GAS f32x4* o = (GAS f32x4*)(out + (size_t)t * D) + F.lane;
#pragma unroll
        for (int j = 0; j < 4; ++j) { const u32x2 a0 = y0[64 * j], a1 = y1[64 * j], xv = xb[64 * j]; f32x4 v;
            v[0] = __builtin_bit_cast(float, xv.x << 16) + (__builtin_bit_cast(float, a0.x << 16) + __builtin_bit_cast(float, a1.x << 16)); v[1] = __builtin_bit_cast(float, xv.x & 0xffff0000u) + (__builtin_bit_cast(float, a0.x & 0xffff0000u) + __builtin_bit_cast(float, a1.x & 0xffff0000u));
            v[2] = __builtin_bit_cast(float, xv.y << 16) + (__builtin_bit_cast(float, a0.y << 16) + __builtin_bit_cast(float, a1.y << 16)); v[3] = __builtin_bit_cast(float, xv.y & 0xffff0000u) + (__builtin_bit_cast(float, a0.y & 0xffff0000u) + __builtin_bit_cast(float, a1.y & 0xffff0000u));
            o[64 * j] = v; }
    }
}

struct PhSsmX {
    static constexpr bool GATHER = false, HOOKS = false;
    unsigned lda, ldb; const char* U2X; const char* M1T; float* SLOC; int g, b;
    __device__ __forceinline__ bool next(int i, pg::Unit& u) const { if (i >= 1) return false; u.A = U2X + ((size_t)(g * NCR + b * 256) * U2P + 128) * 2; u.B = M1T + (size_t)g * 256 * ldb; u.nt = 8; u.pm = b; u.pn = 0; u.aux = 0; return true; }
    __device__ __forceinline__ void offs(const pg::Unit&, const int (&R)[2], const int (&C)[2], unsigned (&vo)[2][2]) const { pg::offs_plain(lda, R, C, vo); }
    __device__ __forceinline__ void epi(const f32x4 (&acc)[2][2][4][2], const pg::Unit& u, int wr, int wc, int fr, int fq) const {
#pragma unroll
        for (int ai = 0; ai < 2; ++ai)
#pragma unroll
            for (int m = 0; m < 4; ++m) { float* p = SLOC + ((size_t)g * NCR + u.pm * 256 + ai * 128 + wr * 64 + m * 16 + fr) * 128 + 32 * wc + 8 * fq;
                *(f32x4*)p = acc[ai][0][m][0]; *(f32x4*)(p + 4) = acc[ai][0][m][1]; }
    }
};
__device__ __forceinline__ void ssm_scan(Frame& F, unsigned char* ws, int g, int b) {
    LAS f32x2* ends = (LAS f32x2*)F.lds;
    const int p = F.lane, w = F.wave;
    const float alr = ((const float*)(ws + WS_AL))[(g * NP + p) * 2], ali = ((const float*)(ws + WS_AL))[(g * NP + p) * 2 + 1];
    const float* sl = (const float*)(ws + WS_SLOC) + ((size_t)g * NCR + b * 256 + w * 32) * 128;
    float lr[32], li[32];
#pragma unroll
    for (int k = 0; k < 32; ++k) { lr[k] = __builtin_bit_cast(float, __hip_atomic_load((const unsigned*)sl + k * 128 + p, __ATOMIC_RELAXED, __HIP_MEMORY_SCOPE_AGENT)); li[k] = __builtin_bit_cast(float, __hip_atomic_load((const unsigned*)sl + k * 128 + 64 + p, __ATOMIC_RELAXED, __HIP_MEMORY_SCOPE_AGENT)); }
#pragma unroll
    for (int k = 1; k < 32; ++k) { const float nr = alr * lr[k - 1] - ali * li[k - 1] + lr[k], ni = alr * li[k - 1] + ali * lr[k - 1] + li[k]; lr[k] = nr; li[k] = ni; }
    ends[w * 64 + p] = (f32x2){lr[31], li[31]};
    float sr = alr, si = ali;
#pragma unroll
    for (int k = 0; k < 5; ++k) { const float t = sr * sr - si * si; si = 2.f * sr * si; sr = t; }
    __syncthreads();
    float cr = 0.f, ci = 0.f;
    for (int s2 = 0; s2 < w; ++s2) { const f32x2 e = ends[s2 * 64 + p]; const float t = sr * cr - si * ci + e.x; ci = sr * ci + si * cr + e.y; cr = t; }
    bf16* hp = (bf16*)(ws + WS_U2X) + ((size_t)g * NCR + b * 256 + w * 32) * U2P;
    float pr = cr, pi = ci;
#pragma unroll
    for (int k = 0; k < 32; ++k) { const float hr = (k ? lr[k - 1] : 0.f) + pr, hi = (k ? li[k - 1] : 0.f) + pi;
        hp[(size_t)k * U2P + p] = f2bf(hr); hp[(size_t)k * U2P + 64 + p] = f2bf(hi);
        const float t = alr * pr - ali * pi; pi = alr * pi + ali * pr; pr = t; }
    __syncthreads();
}
struct PhSsmY {
    static constexpr bool GATHER = false, HOOKS = false;
    unsigned lda, ldb; const char* U2Xp; const char* BTY; const bf16* U2X; const float* Dsk; bf16* Y1; int G, c;
    __device__ __forceinline__ bool next(int i, pg::Unit& u) const { const int L = i * G + c; if (L >= NG * 4) return false; const int g = L >> 2, mt = (L >> 1) & 1, nb = L & 1;
        u.A = U2Xp + (size_t)(g * NCR + mt * 256) * lda; u.B = BTY + (size_t)(g * 512 + nb * 256) * ldb; u.nt = nb ? 10 : 6; u.pm = mt; u.pn = nb; u.aux = g; return true; }
    __device__ __forceinline__ void offs(const pg::Unit&, const int (&R)[2], const int (&C)[2], unsigned (&vo)[2][2]) const { pg::offs_plain(lda, R, C, vo); }
    __device__ __forceinline__ void epi(const f32x4 (&acc)[2][2][4][2], const pg::Unit& u, int wr, int wc, int fr, int fq) const {
        const int g = u.aux;
#pragma unroll
        for (int bj = 0; bj < 2; ++bj) { const int n = u.pn * 256 + 128 * bj + 32 * wc + 8 * fq, j = n >> 4, c0 = n & 15;
            const f32x4 d0 = *(const f32x4*)(Dsk + g * GC + c0), d1 = *(const f32x4*)(Dsk + g * GC + c0 + 4);
#pragma unroll
            for (int ai = 0; ai < 2; ++ai)
#pragma unroll
                for (int m = 0; m < 4; ++m) { const int cr = u.pm * 256 + ai * 128 + wr * 64 + m * 16 + fr;
                    const u32x4 uv = *(const u32x4*)(U2X + ((size_t)g * NCR + cr) * U2P + 128 + j * GC + c0); f32x4 u0, u1; pg::unpack8(uv, u0, u1);
                    f32x4 a = acc[ai][bj][m][0] + d0 * u0, b = acc[ai][bj][m][1] + d1 * u1;
#pragma unroll
                    for (int q = 0; q < 4; ++q) { a[q] = gelu_fast(a[q]); b[q] = gelu_fast(b[q]); }
                    *(u32x4*)(Y1 + ((size_t)cr * LCH + j) * DS + g * GC + c0) = pg::pack8(a, b); } }
    }
};

__global__ void __launch_bounds__(NWAVES * 64, 2) mk_fwd(Args args) {
    extern __shared__ __attribute__((aligned(16))) unsigned char lds[];
    Frame F;
    F.lds = (LAS unsigned char*)lds; F.MISC = (volatile LAS unsigned*)(F.lds + MISC_OFF);
    F.tid = threadIdx.x; F.lane = F.tid & 63; F.wave = __builtin_amdgcn_readfirstlane(F.tid >> 6);
    F.G = gridDim.x; { const int bx = blockIdx.x; F.vcu = (F.G % 8 == 0) ? (bx % 8) * (F.G / 8) + bx / 8 : bx; }
    unsigned char* ws = args.ws; F.ctl = (gu32*)(ws + WS_CTL);
    for (int u = F.tid; u < (LDS_BYTES - LDSCTL_OFF) / 4; u += NWAVES * 64) ((LAS unsigned*)(F.lds + LDSCTL_OFF))[u] = 0u;
    __syncthreads();
    const int lo = args.ph_lo, hi = args.ph_hi;
    const bool multi = (hi - lo) > 1;
    XcdBarrier bar; bar.bar = (unsigned*)(F.ctl + CW_BAR); bar.x = 0; bar.st = nullptr;
    if (multi) bar = xcd_barrier_post((unsigned*)(F.ctl + CW_BAR), F.MISC + 8);
#define IN(k) (lo <= (k) && (k) < hi)
#define SEAM(k) do { if (IN(k) && IN((k) + 1)) xcd_barrier(bar); } while (0)
#define FRESH() do { int t_ = threadIdx.x; asm volatile("" : "+v"(t_)); F.tid = t_; F.lane = t_ & 63; } while (0)
    if (IN(0)) { FRESH(); p0_prologue(F, args); SEAM(0); }
    if (IN(1)) { FRESH();
        if (blockIdx.x < NBATCH * NH) p1_cumsum(F, (float*)(ws + WS_CUM), (int*)(ws + WS_T0), args.in[4], args.in[5]);
        PhInProj ph; ph.lda = D * 2; ph.ldb = D * 2; ph.A = (const char*)(ws + WS_XN); ph.B = (const char*)(ws + WS_WIN); ph.so.init(T / 256, 4096 / 256, F.G, (int)blockIdx.x);
        ph.Q = (bf16*)(ws + WS_Q); ph.K = (bf16*)(ws + WS_K); ph.V = (bf16*)(ws + WS_V); ph.U2X = (bf16*)(ws + WS_U2X); ph.GA = (bf16*)(ws + WS_GA); ph.GS = (bf16*)(ws + WS_GS);
        ph.gq = args.in[4]; ph.gk = args.in[5];
        pg::gemm_phase(F.lds + RING_OFF, ph);
        SEAM(1);
    }
    if (IN(2)) { FRESH();
        if (blockIdx.x < 2 * NG) {
            const int g = (int)blockIdx.x >> 1, b = (int)blockIdx.x & 1;
            PhSsmX ph; ph.lda = U2P * 2; ph.ldb = 512 * 2; ph.U2X = (const char*)(ws + WS_U2X); ph.M1T = (const char*)(ws + WS_M1T); ph.SLOC = (float*)(ws + WS_SLOC); ph.g = g; ph.b = b;
            if (args.sub & 1) pg::gemm_phase(F.lds + RING_OFF, ph);
            if (args.sub & 2) ssm_scan(F, ws, g, b);
            __syncthreads();
        } else if (F.G == 256) p2_side_work(F, args);
        p2_expert_weights(F, args, 0, 6144, F.vcu * NWAVES + F.wave, F.G * NWAVES); __syncthreads();
        if (IN(2) && !IN(3)) {}
    }
    if (IN(3)) {
        static_assert(attn_body::ATTN_LDS_BYTES + 2 * attn_body::MAX_ITEMS * 4 <= RING_BYTES, "attention LDS");
        const attn_body::AttnTensors AT{(const attn_body::bf16*)(ws + WS_Q), (const attn_body::bf16*)(ws + WS_K), (const attn_body::bf16*)(ws + WS_V), (attn_body::bf16*)(ws + WS_Q), (const float*)(ws + WS_CUM),
            (const int*)(ws + WS_T0), (attn_body::bf16*)(ws + WS_PO), (float*)(ws + WS_PS), (unsigned*)(F.ctl + CW_Q0)};
        attn_body::attn_phase<64>((char*)lds + RING_OFF, AT, F.vcu, F.G);
        SEAM(3);
    }
    if (IN(4)) { FRESH();
        if (F.vcu >= 128) {
            const attn_body::AttnTensors AT{(const attn_body::bf16*)(ws + WS_Q), (const attn_body::bf16*)(ws + WS_K), (const attn_body::bf16*)(ws + WS_V), (attn_body::bf16*)(ws + WS_Q), (const float*)(ws + WS_CUM),
                (const int*)(ws + WS_T0), (attn_body::bf16*)(ws + WS_PO), (float*)(ws + WS_PS), (unsigned*)(F.ctl + CW_Q0)};
            attn_body::attn_combine((char*)lds + RING_OFF, AT, F.vcu - 128, F.G - 128);
            p2_expert_weights(F, args, 6144, 9216, (F.vcu - 128) * NWAVES + F.wave, (F.G - 128) * NWAVES); __syncthreads();
        }
        PhSsmY ph; ph.lda = U2P * 2; ph.ldb = U2P * 2; ph.U2Xp = (const char*)(ws + WS_U2X); ph.BTY = (const char*)(ws + WS_BTY); ph.U2X = (const bf16*)(ws + WS_U2X); ph.Dsk = args.in[13]; ph.Y1 = (bf16*)(ws + WS_Y1); ph.G = F.G; ph.c = F.vcu;
        pg::gemm_phase(F.lds + RING_OFF, ph);
        SEAM(4);
    }
    if (IN(5)) { FRESH();
        if (blockIdx.x >= 128) { p2_expert_weights(F, args, 9216, 12288, ((int)blockIdx.x - 128) * NWAVES + F.wave, (F.G - 128) * NWAVES); __syncthreads(); }
        PhGlu ph; ph.lda = DS * 2; ph.ldb = DS * 2; ph.A = (const char*)(ws + WS_Y1); ph.B = (const char*)(ws + WS_WGLU); ph.so.init(T / 256, DS / 256, F.G, (int)blockIdx.x); ph.Y1 = (const bf16*)(ws + WS_Y1); ph.YS = (bf16*)(ws + WS_YS); ph.cYS = (unsigned*)(F.ctl + CW_PYS);
        pg::gemm_phase(F.lds + RING_OFF, ph);
    }
    if (IN(6)) { FRESH();
        PhProj ph; ph.lda = DA * 2; ph.ldb = DA * 2; ph.O = (const char*)(ws + WS_Q); ph.YSp = (const char*)(ws + WS_YS); ph.WPA = (const char*)(ws + WS_WPA); ph.WPS = (const char*)(ws + WS_WPS);
        ph.so.init(T / 256, D / 256, F.G, (int)blockIdx.x); ph.GA = (bf16*)(ws + WS_GA); ph.GS = (const bf16*)(ws + WS_GS); ph.cYS = (unsigned*)(F.ctl + CW_PYS); ph.cMIX = (unsigned*)(F.ctl + CW_PMIX);
        pg::gemm_phase(F.lds + RING_OFF, ph);
    }
    if (IN(7)) { FRESH();
        PhWout ph; ph.lda = D * 2; ph.ldb = D * 2; ph.A = (const char*)(ws + WS_GA); ph.B = (const char*)(ws + WS_WOUT); ph.so.init(T / 256, D / 256, F.G, (int)blockIdx.x);
        ph.x = args.in[0]; ph.out = args.out; ph.X2B = (bf16*)(ws + WS_X2B); ph.SSP = (float*)(ws + WS_SSP); ph.cMIX = (unsigned*)(F.ctl + CW_PMIX); ph.cX2 = (unsigned*)(F.ctl + CW_PX2);
        pg::gemm_phase(F.lds + RING_OFF, ph);
    }
    if (IN(8)) { FRESH(); p8_router(F, args); SEAM(8); }
    LAS int* tb = (LAS int*)(F.lds + LDSCTL_OFF + 512);
    if (IN(9)) { FRESH();
        moe_table(F, (const int*)(ws + WS_CTL) + CW_CNT, tb);
        PhMoeGU ph; ph.lda = D * 2; ph.ldb = D * 2; ph.X = (const char*)(ws + WS_X2B); ph.W = (const char*)(ws + WS_WGU); ph.tb = tb; ph.LIST = (const int*)(ws + WS_LIST); ph.RPOS = (const float*)(ws + WS_RPOS);
        ph.H = (bf16*)(ws + WS_H); ph.G = F.G; ph.c = F.vcu; ph.hcnt = (unsigned*)(F.ctl + CW_HCNT);
        pg::gemm_phase(F.lds + RING_OFF, ph);
    }
    if (IN(10)) { FRESH();
        if (!IN(9)) moe_table(F, (const int*)(ws + WS_CTL) + CW_CNT, tb);
        PhMoeDown ph; ph.lda = DE * 2; ph.ldb = DE * 2; ph.Hp = (const char*)(ws + WS_H); ph.W = (const char*)(ws + WS_WD); ph.tb = tb; ph.WPOS = (const float*)(ws + WS_WPOS); ph.Y = (bf16*)(ws + WS_Y); ph.hcnt = (unsigned*)(F.ctl + CW_HCNT); ph.qctr = (unsigned*)(F.ctl + CW_Q0 + 64); ph.slot = (volatile LAS int*)(F.lds + LDSCTL_OFF + 1024);
        pg::gemm_phase(F.lds + RING_OFF, ph);
        SEAM(10);
    }
    if (IN(11)) { FRESH();
        if (!IN(10)) moe_table(F, (const int*)(ws + WS_CTL) + CW_CNT, tb);
        p11_combine(F, args, tb);
    }
#undef IN
#undef SEAM
}

extern "C" void kernel_launch(void* const* d_in, const int* in_sizes, int n_in, void* d_out, int out_size, void* d_ws, size_t ws_size, hipStream_t stream) {
    static int grid = 0;
    if (grid == 0) {
        int dev = 0, cus = 0; (void)hipGetDevice(&dev); (void)hipDeviceGetAttribute(&cus, hipDeviceAttributeMultiprocessorCount, dev);
        (void)hipFuncSetAttribute((const void*)mk_fwd, hipFuncAttributeMaxDynamicSharedMemorySize, LDS_BYTES);
        grid = cus > 0 ? cus : 256;
    }
    (void)hipMemsetAsync((char*)d_ws + WS_CTL, 0, CTL_ZERO_BYTES, stream);
    Args a{}; for (int i = 0; i < 26; ++i) a.in[i] = (const float*)d_in[i]; a.out = (float*)d_out; a.ws = (unsigned char*)d_ws;
    a.ph_lo = 0; a.ph_hi = 12; a.sub = 7;
    hipLaunchKernelGGL(mk_fwd, dim3(grid), dim3(NWAVES * 64), LDS_BYTES, stream, a);
}
```

```cpp
#include <hip/hip_runtime.h>
#include <stdint.h>
#include <math.h>

typedef unsigned short bf16;
constexpr int T = 16384, D = 1024, SEQ = 8192, NBATCH = 2, NH = 8, HD = 64, DA = 512, DS = 512, NG = 32, GC = 16, NP = 64, NE = 32, DE = 256;
constexpr int DIN = 4104, OQ = 0, OK_ = 512, OV = 1024, OF = 1536, OU = 1544, OGA = 2056, OGS = 3080;
constexpr int LCH = 16, NCR = T / LCH;
constexpr int U2P = 384;
constexpr float EPS = 1e-6f;
constexpr float C2 = 0.125f * 1.4426950408889634f;
constexpr float LOG2E = 1.4426950408889634f;
constexpr int YROWS = 40960;

constexpr size_t MiB = 1u << 20;
constexpr size_t WS_CTL = 0, CTL_ZERO_BYTES = 64 * 1024;
constexpr size_t WS_CUM = 1 * MiB;
constexpr size_t WS_AL = 1 * MiB + 512 * 1024;
constexpr size_t WS_T0 = 1 * MiB + 768 * 1024;
constexpr size_t WS_PS = 36 * MiB;
constexpr size_t WS_PO = 233 * MiB;
constexpr size_t WS_RSTD = 2 * MiB;
constexpr size_t WS_ROUTE = 2 * MiB + 256 * 1024;
constexpr size_t WS_LIST = 3 * MiB;
constexpr size_t WS_WPOS = 5 * MiB;
constexpr size_t WS_SSP = 7 * MiB;
constexpr size_t WS_WIN = 8 * MiB;
constexpr size_t WS_SLOC = 8 * MiB;
constexpr size_t WS_WGLU = 16 * MiB, WS_WPA = 16 * MiB + 512 * 1024, WS_WPS = 17 * MiB + 512 * 1024, WS_WOUT = 18 * MiB + 512 * 1024, WS_WR = 20 * MiB + 512 * 1024;
constexpr size_t WS_M1T = 21 * MiB;
constexpr size_t WS_BTY = 29 * MiB;
constexpr size_t WS_XN = 49 * MiB;
constexpr size_t WS_WGU = 49 * MiB;
constexpr size_t WS_Q = 81 * MiB;
constexpr size_t WS_K = 97 * MiB;
constexpr size_t WS_V = 113 * MiB;
constexpr size_t WS_Y1 = 97 * MiB, WS_YS = 113 * MiB;
constexpr size_t WS_U2X = 129 * MiB;
constexpr size_t WS_GA = 153 * MiB;
constexpr size_t WS_GS = 185 * MiB;
constexpr size_t WS_X2B = 185 * MiB;
constexpr size_t WS_WD = 217 * MiB;
constexpr size_t WS_H = 233 * MiB;
constexpr size_t WS_RPOS = 253 * MiB;
constexpr size_t WS_KTG = 255 * MiB;
constexpr size_t WS_Y = 81 * MiB;
static_assert(WS_U2X + (size_t)NG * NCR * U2P * 2 <= WS_GA && WS_BTY + (size_t)NG * 256 * U2P * 2 <= WS_PS && WS_PS + 2 * MiB <= WS_XN, "d_ws map (S5)");
static_assert(WS_H + (size_t)YROWS * DE * 2 <= WS_RPOS && WS_RPOS + 2 * MiB <= WS_KTG && WS_KTG + MiB <= 256 * MiB && WS_Y + (size_t)YROWS * D * 2 <= WS_GS, "d_ws map");

__device__ __forceinline__ bf16 f2bf(float f) { unsigned u = __builtin_bit_cast(unsigned, f); return (bf16)((u + 0x7fffu + ((u >> 16) & 1u)) >> 16); }
__device__ __forceinline__ float bf2f(bf16 b) { return __builtin_bit_cast(float, (unsigned)b << 16); }
__device__ __forceinline__ float sigmoidf_(float x) { return 1.f / (1.f + __expf(-x)); }
__device__ __forceinline__ float gelu_tanh(float x) { const float z = 0.7978845608028654f * (x + 0.044715f * x * x * x); const float e = __expf(2.f * z); return 0.5f * x * (1.f + (1.f - 2.f / (e + 1.f))); }
__device__ __forceinline__ float log_sigmoid(float x) { return -(fmaxf(-x, 0.f) + log1pf(__expf(-fabsf(x)))); }
__device__ __forceinline__ size_t u2x_index(int g, int t, int c) { return ((size_t)g * NCR + (t / LCH)) * U2P + 128 + (t % LCH) * GC + c; }

#define LAS __attribute__((address_space(3)))
#define GAS __attribute__((address_space(1)))
typedef short bf16x8 __attribute__((ext_vector_type(8)));
typedef float f32x4 __attribute__((ext_vector_type(4)));
typedef float f32x2 __attribute__((ext_vector_type(2)));
typedef unsigned u32x4 __attribute__((ext_vector_type(4)));
typedef unsigned u32x2 __attribute__((ext_vector_type(2)));
namespace pg {
constexpr int BM = 256, BK = 64, HALF = 128, HTB = HALF * BK * 2, STAGE_BYTES = 8 * HTB, NXCD = 8, WGM = 8;
__host__ __device__ __forceinline__ int lds_byte(int r, int c) { const int st = (r >> 4) * 2 + (c >> 5), rr = r & 15, cc = c & 31, ob = rr * 64 + cc * 2; return st * 1024 + (ob ^ (((ob >> 9) & 1) << 5)); }
__host__ __device__ __forceinline__ void stage_rc(int b, int& R, int& C) { const int st = b / 1024, sb = b % 1024, swz = sb ^ (((sb >> 9) & 1) << 5); R = (st >> 1) * 16 + swz / 64; C = (st & 1) * 32 + (swz % 64) / 2; }
__host__ __device__ __forceinline__ int perm32(int rho) { const int n = rho >> 4, i = rho & 15; return 8 * (i >> 2) + 4 * n + (i & 3); }
typedef __bf16 bf16x2_t __attribute__((ext_vector_type(2)));
__device__ __forceinline__ unsigned cvt_pk_bf16(float lo, float hi) { const f32x2 v = {lo, hi}; const bf16x2_t b = __builtin_convertvector(v, bf16x2_t); return __builtin_bit_cast(unsigned, b); }
__device__ __forceinline__ u32x4 pack8(const f32x4& a, const f32x4& b) { u32x4 w; w.x = cvt_pk_bf16(a[0], a[1]); w.y = cvt_pk_bf16(a[2], a[3]); w.z = cvt_pk_bf16(b[0], b[1]); w.w = cvt_pk_bf16(b[2], b[3]); return w; }
__device__ __forceinline__ void unpack8(const u32x4& w, f32x4& a, f32x4& b) {
    a[0] = __builtin_bit_cast(float, w.x << 16); a[1] = __builtin_bit_cast(float, w.x & 0xffff0000u); a[2] = __builtin_bit_cast(float, w.y << 16); a[3] = __builtin_bit_cast(float, w.y & 0xffff0000u);
    b[0] = __builtin_bit_cast(float, w.z << 16); b[1] = __builtin_bit_cast(float, w.z & 0xffff0000u); b[2] = __builtin_bit_cast(float, w.w << 16); b[3] = __builtin_bit_cast(float, w.w & 0xffff0000u); }
__device__ __forceinline__ float fsigmoid(float x) { return __builtin_amdgcn_rcpf(1.f + __builtin_amdgcn_exp2f(-1.4426950408889634f * x)); }

__device__ __forceinline__ void store16_wt(void* p, const u32x4& v) {
    asm volatile("global_store_dwordx4 %0, %1, off sc1\n\ts_nop 1" :: "v"(p), "v"(v) : "memory"); }
struct Unit { const char* A; const char* B; int nt; int pm, pn, aux; };

struct StaticOrder {
    int nM, nN, nwg, G, c;
    __device__ void init(int nM_, int nN_, int G_, int c_) { nM = nM_; nN = nN_; nwg = nM * nN; G = G_; c = c_; }
    __device__ bool next(int i, int& pm, int& pn) const {
        const long L = (long)i * G + c; if (L >= nwg) return false;
        int wgid = (int)L; { const int q = nwg / NXCD, r = nwg % NXCD, xcd = wgid % NXCD, off = wgid / NXCD; wgid = (xcd < r ? xcd * (q + 1) : r * (q + 1) + (xcd - r) * q) + off; }
        const int nig = WGM * nN, gid = wgid / nig, fm = gid * WGM, gsz = (nM - fm) < WGM ? (nM - fm) : WGM;
        pm = fm + ((wgid % nig) % gsz); pn = (wgid % nig) / gsz; return true;
    }
};

template <class P>
__device__ __forceinline__ void gemm_phase(LAS unsigned char* lds, P& ph) {
    const int tid = threadIdx.x, wid = __builtin_amdgcn_readfirstlane(tid >> 6), lane = tid & 63, wr = wid >> 2, wc = wid & 3, fr = lane & 15, fq = lane >> 4;
    const unsigned lda = ph.lda, ldb = ph.ldb;
    int Rr[2], Cc[2]; unsigned voffB[2], vo[2][2], nvo[2][2];
#pragma unroll
    for (int i = 0; i < 2; ++i) { stage_rc(tid * 16 + i * 8192, Rr[i], Cc[i]); const int Rb = (Rr[i] & ~31) + perm32(Rr[i] & 31); voffB[i] = (unsigned)Rb * ldb + (unsigned)Cc[i] * 2u; }
    const size_t kstep = (size_t)(BK * 2);
    const size_t hstepB = (size_t)HALF * ldb;
    const unsigned ldsw = (unsigned)wid * 1024u;
    const int aoff = lds_byte(wr * 64 + fr, fq * 8), boff = lds_byte(wc * 32 + fr, fq * 8);
#define PG_SA(b, h) (((b) * 2 + (h)) * HTB)
#define PG_SB(b, h) ((4 + (b) * 2 + (h)) * HTB)
#define PG_STAGE_B(bufoff, gbase) do { _Pragma("unroll") for (int _i = 0; _i < 2; ++_i) \
        __builtin_amdgcn_global_load_lds((const unsigned*)((const char*)(gbase) + voffB[_i]), (LAS unsigned*)(lds + (bufoff) + ldsw + _i * 8192), 16, 0, 0); } while (0)
#define PG_STAGE_A(bufoff, gbase, VO, h) do { _Pragma("unroll") for (int _i = 0; _i < 2; ++_i) \
        __builtin_amdgcn_global_load_lds((const unsigned*)((const char*)(gbase) + (VO)[h][_i]), (LAS unsigned*)(lds + (bufoff) + ldsw + _i * 8192), 16, 0, 0); } while (0)
#define PG_LDA(dst, b, h) do { _Pragma("unroll") for (int m = 0; m < 4; ++m) _Pragma("unroll") for (int k = 0; k < 2; ++k) dst[m][k] = *(const LAS bf16x8*)(lds + PG_SA(b, h) + aoff + m * 2048 + k * 1024); } while (0)
#define PG_LDB(dst, b, h) do { _Pragma("unroll") for (int n = 0; n < 2; ++n) _Pragma("unroll") for (int k = 0; k < 2; ++k) dst[n][k] = *(const LAS bf16x8*)(lds + PG_SB(b, h) + boff + n * 2048 + k * 1024); } while (0)
#define PG_MMA(ai, bj, At, Bt) do { __builtin_amdgcn_s_setprio(1); _Pragma("unroll") for (int m = 0; m < 4; ++m) _Pragma("unroll") for (int n = 0; n < 2; ++n) _Pragma("unroll") for (int k = 0; k < 2; ++k) \
        acc[ai][bj][m][n] = __builtin_amdgcn_mfma_f32_16x16x32_bf16(Bt[n][k], At[m][k], acc[ai][bj][m][n], 0, 0, 0); __builtin_amdgcn_s_setprio(0); } while (0)
#define PG_WAIT_V(n) asm volatile("s_waitcnt vmcnt(" #n ")" ::: "memory")
#define PG_WAIT_L(n) asm volatile("s_waitcnt lgkmcnt(" #n ")" ::: "memory")
#define PG_BAR __builtin_amdgcn_s_barrier()
#define PG_SCHED __builtin_amdgcn_sched_barrier(0)
    Unit cur, nxt; int ui = 0;
    if (!ph.next(0, cur)) return;
    ph.offs(cur, Rr, Cc, vo);
    f32x4 acc[2][2][4][2];
    if constexpr (P::ACCINIT) ph.acc_init(acc, cur, wr, wc, fr, fq);
    else {
#pragma unroll
    for (int a = 0; a < 2; ++a)
#pragma unroll
        for (int b = 0; b < 2; ++b)
#pragma unroll
            for (int m = 0; m < 4; ++m)
#pragma unroll
                for (int n = 0; n < 2; ++n) acc[a][b][m][n] = (f32x4){0.f, 0.f, 0.f, 0.f};
    }
    bf16x8 At[4][2], B0[2][2], B1[2][2];
    const char* cA = cur.A; const char* cB = cur.B;
    if constexpr (P::HOOKS) ph.a_ready(cur);
#define PG_PROLOGUE do { PG_STAGE_B(PG_SB(0, 0), cB); PG_STAGE_B(PG_SB(0, 1), cB + hstepB); PG_STAGE_A(PG_SA(0, 0), cA, vo, 0); PG_STAGE_A(PG_SA(0, 1), cA, vo, 1); \
    if (wr == 1) PG_BAR; \
    PG_WAIT_V(2); PG_BAR; \
    PG_STAGE_B(PG_SB(1, 0), cB + kstep); PG_STAGE_A(PG_SA(1, 0), cA + kstep, vo, 0); PG_STAGE_B(PG_SB(1, 1), cB + hstepB + kstep); \
    PG_WAIT_V(6); PG_BAR; } while (0)
    PG_PROLOGUE;
    for (;;) {
        if constexpr (P::STAMPS) { if (ph.stp && threadIdx.x == 0) ph.stp[3 * ui] = (unsigned)__builtin_amdgcn_s_memrealtime(); }
        unsigned pf_ = 0u; if constexpr (P::PREFETCH) pf_ = ph.prefetch(cur);
        const bool has_next = ph.next(ui + 1, nxt);
        bool late = false;
        if constexpr (P::HOOKS) { if (has_next) { if constexpr (P::LATE) late = !ph.try_ready(nxt); else ph.a_ready(nxt); } }
        const int nt = cur.nt;
        bool sk = false; if constexpr (P::HALFSKIP) sk = __builtin_amdgcn_readfirstlane(ph.half(cur) ? 1 : 0) != 0;
        const bool pipe = has_next && !late;
        const char* nA = pipe ? nxt.A : cA; const char* nB = pipe ? nxt.B : cB;
        if (P::GATHER) { if (has_next) ph.offs(nxt, Rr, Cc, nvo); else {
#pragma unroll
            for (int h = 0; h < 2; ++h)
#pragma unroll
                for (int i = 0; i < 2; ++i) nvo[h][i] = vo[h][i]; } }
#pragma unroll 1
        for (int t = 0; t < nt; t += 2) {
            const bool last = (t == nt - 2);
            const char* a1 = cA + (size_t)(t + 1) * kstep;
            const char* a2 = last ? nA : cA + (size_t)(t + 2) * kstep; const char* b2 = last ? nB : cB + (size_t)(t + 2) * kstep;
            const char* a3 = a2 + kstep; const char* b3 = b2 + kstep;
            unsigned v2[2][2];
#pragma unroll
            for (int h = 0; h < 2; ++h)
#pragma unroll
                for (int i = 0; i < 2; ++i) v2[h][i] = (P::GATHER && last) ? nvo[h][i] : vo[h][i];
            PG_LDB(B0, 0, 0); PG_LDB(B1, 0, 1); PG_SCHED; PG_LDA(At, 0, 0); PG_STAGE_A(PG_SA(1, 1), a1, vo, 1);
            PG_WAIT_V(8); PG_WAIT_L(0); PG_BAR; PG_MMA(0, 0, At, B0); PG_MMA(0, 1, At, B1); PG_BAR; PG_SCHED;
            PG_LDA(At, 0, 1); PG_STAGE_B(PG_SB(0, 0), b2); PG_STAGE_B(PG_SB(0, 1), b2 + hstepB); PG_STAGE_A(PG_SA(0, 0), a2, v2, 0);
            PG_WAIT_V(8); PG_WAIT_L(0); PG_BAR; if (!sk) { PG_MMA(1, 0, At, B0); PG_MMA(1, 1, At, B1); } PG_BAR; PG_SCHED;
            PG_LDB(B0, 1, 0); PG_LDB(B1, 1, 1); PG_SCHED; PG_LDA(At, 1, 0); PG_STAGE_A(PG_SA(0, 1), a2, v2, 1);
            PG_WAIT_V(8); PG_WAIT_L(0); PG_BAR; PG_MMA(0, 0, At, B0); PG_MMA(0, 1, At, B1); PG_BAR; PG_SCHED;
            PG_LDA(At, 1, 1); PG_STAGE_B(PG_SB(1, 0), b3); PG_STAGE_B(PG_SB(1, 1), b3 + hstepB); PG_STAGE_A(PG_SA(1, 0), a3, v2, 0);
            PG_WAIT_V(8); PG_WAIT_L(0); PG_BAR; if (!sk) { PG_MMA(1, 0, At, B0); PG_MMA(1, 1, At, B1); } PG_BAR; PG_SCHED;
        }
        if constexpr (P::PREFETCH) asm volatile("" :: "v"(pf_));
        if (wr == 0) PG_BAR;
        if constexpr (P::STAMPS) { if (ph.stp && threadIdx.x == 0) ph.stp[3 * ui + 1] = (unsigned)__builtin_amdgcn_s_memrealtime(); }
        ph.epi(acc, cur, wr, wc, fr, fq);
        if constexpr (P::HOOKS) ph.done(cur);
        if constexpr (P::STAMPS) { if (ph.stp && threadIdx.x == 0) ph.stp[3 * ui + 2] = (unsigned)__builtin_amdgcn_s_memrealtime(); }
        if (!has_next) break;
        if constexpr (P::ACCINIT) ph.acc_init(acc, nxt, wr, wc, fr, fq);
        else if (!(P::KEEPACC && cur.aux == 0)) {
#pragma unroll
        for (int a = 0; a < 2; ++a)
#pragma unroll
            for (int b = 0; b < 2; ++b)
#pragma unroll
                for (int m = 0; m < 4; ++m)
#pragma unroll
                    for (int n = 0; n < 2; ++n) acc[a][b][m][n] = (f32x4){0.f, 0.f, 0.f, 0.f};
        }
        cur = nxt; cA = cur.A; cB = cur.B; ++ui;
        if (P::GATHER) {
#pragma unroll
            for (int h = 0; h < 2; ++h)
#pragma unroll
                for (int i = 0; i < 2; ++i) vo[h][i] = nvo[h][i]; }
        if constexpr (P::LATE) { if (late) { ph.a_ready(cur); PG_PROLOGUE; continue; } }
        if (wr == 1) PG_BAR;
    }
    PG_WAIT_V(0);
    PG_BAR;
#undef PG_SA
#undef PG_SB
#undef PG_STAGE_A
#undef PG_STAGE_B
#undef PG_LDA
#undef PG_LDB
#undef PG_MMA
#undef PG_WAIT_V
#undef PG_WAIT_L
#undef PG_BAR
#undef PG_SCHED
#undef PG_PROLOGUE
}
__device__ __forceinline__ void offs_plain(unsigned lda, const int (&R)[2], const int (&C)[2], unsigned (&vo)[2][2]) {
#pragma unroll
    for (int h = 0; h < 2; ++h)
#pragma unroll
        for (int i = 0; i < 2; ++i) vo[h][i] = (unsigned)(h * HALF + R[i]) * lda + (unsigned)C[i] * 2u;
}
}

namespace attn_body {
using bf16=unsigned short;
using bf16x8=__attribute__((ext_vector_type(8)))short;
using s16x4=__attribute__((ext_vector_type(4)))short;
using f32x16=__attribute__((ext_vector_type(16)))float;
using u32x4=__attribute__((ext_vector_type(4)))unsigned;
constexpr int BATCH=2,NHEAD=8,SEQ=8192,D=64,DM=NHEAD*D;
constexpr int NW=8,QBLK=32,QB=QBLK*NW,KVBLK=64,NQB=SEQ/QB;
constexpr int ATTN_PITCH=DM, ATTN_UNIT_ROWS=QB;
__device__ __forceinline__ int crow(int r,int hi){return (r&3)+8*(r>>2)+4*hi;}
__device__ __forceinline__ unsigned short f2bf_a(float f){unsigned u=__builtin_bit_cast(unsigned,f);return (unsigned short)((u+0x7fffu+((u>>16)&1u))>>16);}
#define SBAR() __builtin_amdgcn_sched_barrier(0)
__device__ __forceinline__ void cmask(f32x16&p0,f32x16&p1,int jb,int qrel,int hi){
  const float NEG=-INFINITY; int kb=64*jb+4*hi;
  #pragma unroll
  for(int r=0;r<16;++r){int kv=kb+(r&3)+8*(r>>2); if(kv>qrel)p0[r]=NEG; if(kv+32>qrel)p1[r]=NEG;}
}

constexpr int NSLOT=3, SLOTB=8192;
constexpr int LDS_K=0, LDS_V=NSLOT*SLOTB, LDS_WS=2*NSLOT*SLOTB, LDS_OST=LDS_WS+NW*64*4, LDS_FK=LDS_OST+NW*4096, LDS_BYTES=LDS_FK+SEQ*4+1024;
constexpr float C2=0.125f*1.4426950408889634f;
__device__ __forceinline__ void glds16(const void*gsrc,unsigned lds_dst){unsigned keep;
  asm volatile("s_mov_b32 %0, m0\n\ts_mov_b32 m0, %2\n\ts_nop 0\n\tglobal_load_lds_dwordx4 %1, off\n\ts_mov_b32 m0, %0":"=&s"(keep):"v"(gsrc),"s"(lds_dst):"memory");}
__device__ __forceinline__ float max3f(float a,float b,float c){float r;asm("v_max3_f32 %0, %1, %2, %3":"=v"(r):"v"(a),"v"(b),"v"(c));return r;}
__device__ __forceinline__ float max2f(float a,float b){float r;asm("v_max_f32_e32 %0, %1, %2":"=v"(r):"v"(a),"v"(b));return r;}
__device__ __forceinline__ float fadd_s(float a,float b){float r;asm("v_add_f32_e32 %0, %1, %2":"=v"(r):"v"(a),"v"(b));return r;}
__device__ __forceinline__ float fsub_s(float a,float b){float r;asm("v_sub_f32_e32 %0, %1, %2":"=v"(r):"v"(a),"v"(b));return r;}
typedef float f32x4_t __attribute__((ext_vector_type(4)));
typedef float f32x2_t __attribute__((ext_vector_type(2))); typedef __bf16 bf16x2_t __attribute__((ext_vector_type(2)));
__device__ __forceinline__ unsigned cvtpk_s(float lo,float hi){f32x2_t v={lo,hi};bf16x2_t b=__builtin_convertvector(v,bf16x2_t);return __builtin_bit_cast(unsigned,b);}
#define WAIT_BAR(N) asm volatile("s_waitcnt vmcnt(" #N ") lgkmcnt(0)\n\ts_barrier":::"memory")

__device__ __forceinline__ void qkt(f32x16&p0,f32x16&p1,const char*Kslot,const bf16x8*qr,int r32,int hi){
  const char*kb=Kslot+hi*1024+r32*16;
  #pragma unroll
  for(int d0=0;d0<4;++d0){
    const bf16x8 b0=*reinterpret_cast<const bf16x8*>(kb+d0*2048);
    const bf16x8 b1=*reinterpret_cast<const bf16x8*>(kb+d0*2048+512);
    p0=__builtin_amdgcn_mfma_f32_32x32x16_bf16(b0,qr[d0],p0,0,0,0);p1=__builtin_amdgcn_mfma_f32_32x32x16_bf16(b1,qr[d0],p1,0,0,0);}
}
typedef __attribute__((address_space(3))) const char* lds_cptr;
typedef short v4i16_t __attribute__((ext_vector_type(4)));
__device__ __forceinline__ void kload8(bf16x8*kf,lds_cptr kp){
  kf[0]=*(const __attribute__((address_space(3))) bf16x8*)(kp);      kf[1]=*(const __attribute__((address_space(3))) bf16x8*)(kp+512);
  kf[2]=*(const __attribute__((address_space(3))) bf16x8*)(kp+2048); kf[3]=*(const __attribute__((address_space(3))) bf16x8*)(kp+2560);
  kf[4]=*(const __attribute__((address_space(3))) bf16x8*)(kp+4096); kf[5]=*(const __attribute__((address_space(3))) bf16x8*)(kp+4608);
  kf[6]=*(const __attribute__((address_space(3))) bf16x8*)(kp+6144); kf[7]=*(const __attribute__((address_space(3))) bf16x8*)(kp+6656);
}
__device__ __forceinline__ void kload2(bf16x8*kf,lds_cptr kp,int j){ kf[2*j]=*(const __attribute__((address_space(3))) bf16x8*)(kp+j*2048); kf[2*j+1]=*(const __attribute__((address_space(3))) bf16x8*)(kp+j*2048+512); }
__device__ __forceinline__ s16x4 vtr(lds_cptr p){ return __builtin_bit_cast(s16x4,__builtin_amdgcn_ds_read_tr16_b64_v4i16((__attribute__((address_space(3))) v4i16_t*)p)); }
__device__ __forceinline__ float rowmax(const f32x16&p0,const f32x16&p1){
  float a=max3f(p0[0],p0[1],p1[0]),b=max3f(p0[2],p0[3],p1[1]);a=max3f(a,p1[2],p1[3]);
  #pragma unroll
  for(int r=4;r<16;r+=4){a=max3f(a,p0[r],p0[r+1]);b=max3f(b,p0[r+2],p0[r+3]);a=max3f(a,p1[r],p1[r+1]);b=max3f(b,p1[r+2],p1[r+3]);}
  const float m=max2f(a,b);
  auto rr=__builtin_amdgcn_permlane32_swap(__float_as_uint(m),__float_as_uint(m),false,false);
  return max2f(__uint_as_float(rr[0]),__uint_as_float(rr[1]));
}
__device__ __forceinline__ void pv(f32x16*o,int vb,bf16x8 pa0,bf16x8 pa1,bf16x8 pa2,bf16x8 pa3){
  #pragma unroll
  for(int d0=0;d0<2;++d0){s16x4 lo[4],hi[4];
    #pragma unroll
    for(int ks=0;ks<4;++ks){
      asm volatile("ds_read_b64_tr_b16 %0,%1 offset:%c2":"=&v"(lo[ks]):"v"(vb),"i"(d0*4096+ks*1024):"memory");
      asm volatile("ds_read_b64_tr_b16 %0,%1 offset:%c2":"=&v"(hi[ks]):"v"(vb),"i"(d0*4096+ks*1024+512):"memory");}
    asm volatile("s_waitcnt lgkmcnt(0)":::"memory");SBAR();
    #define PK(k) (bf16x8){lo[k][0],lo[k][1],lo[k][2],lo[k][3],hi[k][0],hi[k][1],hi[k][2],hi[k][3]}
    o[d0]=__builtin_amdgcn_mfma_f32_32x32x16_bf16(pa0,PK(0),o[d0],0,0,0);
    o[d0]=__builtin_amdgcn_mfma_f32_32x32x16_bf16(pa1,PK(1),o[d0],0,0,0);
    o[d0]=__builtin_amdgcn_mfma_f32_32x32x16_bf16(pa2,PK(2),o[d0],0,0,0);
    o[d0]=__builtin_amdgcn_mfma_f32_32x32x16_bf16(pa3,PK(3),o[d0],0,0,0);
    #undef PK
  }
}

#ifndef ATTN_STORE16
#define ATTN_STORE16(p,v) (*(u32x4*)(p)=(v))
#endif
template<int THRL> __device__ __forceinline__ void attn_unit(int b,int h,int qb,int TB,int TE,int NTM,const bf16*Q,const bf16*__restrict__ K,const bf16*__restrict__ V,bf16*O,const float*__restrict__ CUM,bf16*PObase,float*PSbase,int slot,char*shm){
  const int tid=threadIdx.x,lane=tid&63,r32=lane&31,hi=lane>>5; const int wid=__builtin_amdgcn_readfirstlane(tid>>6);
  const long rowbase=(long)b*SEQ; const int q0=qb*QB;
  const bf16*Qw=Q+(rowbase+q0+wid*QBLK)*DM+h*D;
  const bf16*Kh=K+rowbase*DM+h*D,*Vh=V+rowbase*DM+h*D; const float*Fh=CUM+((long)b*NHEAD+h)*SEQ;
  const unsigned lds0=(unsigned)(uintptr_t)shm;
  float*wsf=(float*)(shm+LDS_WS)+wid*64;
  const unsigned koff=(unsigned)(lane*DM+wid*8)*2u;
  const unsigned voff=(unsigned)((16*(wid&3)+(lane>>2))*DM+(wid>>2)*32+(lane&3)*8)*2u;
  const unsigned kdst=lds0+LDS_K+wid*1024, vdst=lds0+LDS_V+wid*1024;
  #define DMA_K(t,slot) glds16((const char*)Kh+(long)(t)*(KVBLK*DM*2)+koff,(unsigned)__builtin_amdgcn_readfirstlane(kdst+(slot)))
  #define DMA_V(t,slot) glds16((const char*)Vh+(long)(t)*(KVBLK*DM*2)+voff,(unsigned)__builtin_amdgcn_readfirstlane(vdst+(slot)))
  const int vb0=(int)(lds0+LDS_V)+((lane>>4)&1)*32+(lane&3)*8+(4*hi+((lane&15)>>2))*64;
  const char*Kbase=shm+LDS_K; bf16x8 kf[8];
  const lds_cptr shm3=(lds_cptr)shm; const lds_cptr kp0=shm3+LDS_K+hi*1024+r32*16; const lds_cptr vp0=shm3+LDS_V+((lane>>4)&1)*32+(lane&3)*8+(4*hi+((lane&15)>>2))*64;
  const int NT=TE;
  for(int p_=wid+(TB>>2);p_<=((TE*KVBLK-1)>>8);p_+=NW) glds16(Fh+p_*256+lane*4,(unsigned)__builtin_amdgcn_readfirstlane(lds0+LDS_FK+p_*1024));
  DMA_K(TB,0);DMA_V(TB,0);DMA_K(TB+1,SLOTB);
  bf16x8 qr[4];
  #pragma unroll
  for(int d0=0;d0<4;++d0)qr[d0]=*reinterpret_cast<const bf16x8*>(&Qw[(long)r32*DM+d0*16+hi*8]);
  const float fq2=Fh[q0+wid*QBLK+r32];
  float mhat=0.f,l_reg=0.f;f32x16 o[2];o[0]=f32x16{};o[1]=f32x16{};float nb=fq2;
  const lds_cptr fkp=(lds_cptr)shm+LDS_FK+hi*16;
  const int qrel=wid*QBLK+r32;
  #define CMASK(P0,P1,t) do{int jb_=(t)-(NTM-4); if(jb_>=0)cmask(P0,P1,jb_,qrel,hi);}while(0)
  bool resc=false;
  #define START(P0,P1) do{ const float rm=rowmax(P0,P1); resc=false; \
    { const float dl=rm; mhat=fadd_s(mhat,dl); \
      _Pragma("unroll") for(int r=0;r<16;++r){P0[r]=fsub_s(P0[r],dl);P1[r]=fsub_s(P1[r],dl);} \
      nb=fsub_s(fq2,mhat); } \
    _Pragma("unroll") for(int r=0;r<16;++r)P0[r]=__builtin_amdgcn_exp2f(P0[r]); }while(0)
  #define RESC() do{ if(resc){ asm volatile("s_waitcnt lgkmcnt(0)":::"memory"); \
      _Pragma("unroll") for(int d_=0;d_<2;++d_) _Pragma("unroll") for(int r=0;r<16;++r)o[d_][r]*=wsf[crow(r,hi)]; } }while(0)
  #define FILLC(C0_,C1_,tt) do{ const lds_cptr f_=fkp+(tt)*256; _Pragma("unroll") for(int a_=0;a_<4;++a_){ const f32x4_t x0_=*(const __attribute__((address_space(3))) f32x4_t*)(f_+32*a_); const f32x4_t x1_=*(const __attribute__((address_space(3))) f32x4_t*)(f_+128+32*a_); \
      _Pragma("unroll") for(int i_=0;i_<4;++i_){ C0_[4*a_+i_]=nb-x0_[i_]; C1_[4*a_+i_]=nb-x1_[i_]; } } }while(0)
  f32x16 pA0,pA1,pB0,pB1;
  int sl_prev=0,sl_cur=0,sl_next=SLOTB;
  #define ROT() do{sl_prev=sl_cur;sl_cur=sl_next;sl_next=(sl_next==(NSLOT-1)*SLOTB)?0:sl_next+SLOTB;}while(0)
  DMA_K(TB+2,2*SLOTB);
  WAIT_BAR(3);
  FILLC(pA0,pA1,TB);
  qkt(pA0,pA1,Kbase,qr,r32,hi);asm volatile("s_nop 15\n\ts_nop 7":"+v"(pA0),"+v"(pA1));CMASK(pA0,pA1,TB);
  START(pA0,pA1);
  _Pragma("unroll") for(int r=0;r<16;++r)pA1[r]=__builtin_amdgcn_exp2f(pA1[r]);
  WAIT_BAR(0);
  DMA_K(TB+3,0);DMA_V(TB+1,SLOTB);
  ROT();
  FILLC(pB0,pB1,TB+1);
  kload8(kf,kp0+sl_cur);
  WAIT_BAR(2);
  s16x4 vlo[8],vhi[8]; u32x4 pw0,pw1,pw2,pw3;
  #define PKW(P,B) cvtpk_s(P[B],P[B+1])
  #define PAF(k) __builtin_bit_cast(bf16x8,pw##k)
  #define VFR(i) (bf16x8){vlo[i][0],vlo[i][1],vlo[i][2],vlo[i][3],vhi[i][0],vhi[i][1],vhi[i][2],vhi[i][3]}
  #define PIN(x) asm volatile("":"+v"(x))
  #define MX3(a,b,c) __builtin_fmaxf(__builtin_fmaxf((a),(b)),(c))
  #define GAPA(MF,A0,A1,A2,A3,W0,W1,PW) do{ MF; sacc+=A0; sacc+=A1; sacc+=A2; sacc+=A3; PIN(sacc); W0; W1; PIN(PW); SBAR(); }while(0)
  #define EX(v) __builtin_amdgcn_exp2f(v)
  #define FLD(off) (*(const __attribute__((address_space(3))) f32x4_t*)(fk_+(off)))
  #define GAPB(MF,X,B,PF,FC,FN,NOFF) do{ MF; X[B]=EX(X[B]); X[B+1]=EX(X[B+1]); X[B+2]=EX(X[B+2]); X[B+3]=EX(X[B+3]); PF[B]=nb-FC[0]; PF[B+1]=nb-FC[1]; PF[B+2]=nb-FC[2]; PF[B+3]=nb-FC[3]; FN=FLD(NOFF); PIN(X); PIN(PF); SBAR(); }while(0)
  #define VRD(i) do{ vlo[i]=vtr(vp_+(((i)>>2)*4096+((i)&3)*1024)); vhi[i]=vtr(vp_+(((i)>>2)*4096+((i)&3)*1024+512)); }while(0)
  #define KRD(G,j) do{ if(G){ kload2(kf,kp0+sl_next,j); SBAR(); } }while(0)
  #define STEP(C0,C1,P0,P1,t,GK,GV,GL) do{ SBAR(); \
    const lds_cptr vp_=vp0+sl_prev; \
    VRD(0); SBAR(); float sacc=(P0[0]+P0[1]); \
    GAPA(C0=__builtin_amdgcn_mfma_f32_32x32x16_bf16(kf[0],qr[0],C0,0,0,0), P0[2],P0[3],P0[4],P0[5],     pw0[0]=PKW(P0,0), pw0[1]=PKW(P0,2), pw0); \
    VRD(4); SBAR(); GAPA(C1=__builtin_amdgcn_mfma_f32_32x32x16_bf16(kf[1],qr[0],C1,0,0,0), P0[6],P0[7],P0[8],P0[9],     pw0[2]=PKW(P0,4), pw0[3]=PKW(P0,6), pw0); \
    VRD(1); SBAR(); GAPA(C0=__builtin_amdgcn_mfma_f32_32x32x16_bf16(kf[2],qr[1],C0,0,0,0),   P0[10],P0[11],P0[12],P0[13], pw1[0]=PKW(P0,8), pw1[1]=PKW(P0,10), pw1); \
    VRD(5); SBAR(); GAPA(C1=__builtin_amdgcn_mfma_f32_32x32x16_bf16(kf[3],qr[1],C1,0,0,0),   P0[14],P0[15],P1[0],P1[1],   pw1[2]=PKW(P0,12),pw1[3]=PKW(P0,14), pw1); \
    VRD(2); SBAR(); GAPA(C0=__builtin_amdgcn_mfma_f32_32x32x16_bf16(kf[4],qr[2],C0,0,0,0),   P1[2],P1[3],P1[4],P1[5],     pw2[0]=PKW(P1,0), pw2[1]=PKW(P1,2), pw2); \
    VRD(6); SBAR(); GAPA(C1=__builtin_amdgcn_mfma_f32_32x32x16_bf16(kf[5],qr[2],C1,0,0,0),   P1[6],P1[7],P1[8],P1[9],     pw2[2]=PKW(P1,4), pw2[3]=PKW(P1,6), pw2); \
    VRD(3); SBAR(); GAPA(C0=__builtin_amdgcn_mfma_f32_32x32x16_bf16(kf[6],qr[3],C0,0,0,0),   P1[10],P1[11],P1[12],P1[13], pw3[0]=PKW(P1,8), pw3[1]=PKW(P1,10), pw3); \
    VRD(7); SBAR(); GAPA(C1=__builtin_amdgcn_mfma_f32_32x32x16_bf16(kf[7],qr[3],C1,0,0,0),   P1[14],P1[15],0.f,0.f,       pw3[2]=PKW(P1,12),pw3[3]=PKW(P1,14), pw3); \
    l_reg+=sacc; \
    if(GK){DMA_K((t)+3,sl_cur);} if(GV){DMA_V((t)+1,sl_next);} \
    CMASK(C0,C1,t); \
    { float a=MX3(C0[0],C0[1],C1[0]),b=MX3(C0[2],C0[3],C1[1]); a=MX3(a,C1[2],C1[3]); \
      _Pragma("unroll") for(int r=4;r<16;r+=4){a=MX3(a,C0[r],C0[r+1]);b=MX3(b,C0[r+2],C0[r+3]);a=MX3(a,C1[r],C1[r+1]);b=MX3(b,C1[r+2],C1[r+3]);} \
      float rm=__builtin_fmaxf(a,b); { auto rr=__builtin_amdgcn_permlane32_swap(__float_as_uint(rm),__float_as_uint(rm),false,false); rm=__builtin_fmaxf(__uint_as_float(rr[0]),__uint_as_float(rr[1])); } \
      resc=false; \
      if(__builtin_expect(__any(rm>(float)THRL),0)){ const float dl=__builtin_fmaxf(rm,0.f); mhat+=dl; \
        _Pragma("unroll") for(int r=0;r<16;++r){C0[r]-=dl;C1[r]-=dl;} \
        nb=fq2-mhat; \
        const float f=__builtin_amdgcn_exp2f(-dl); l_reg*=f; if(hi==0)wsf[r32]=f; resc=true; } } \
    SBAR(); \
    const lds_cptr fk_=fkp+((t)+1)*256; f32x4_t fa_=FLD(0); SBAR(); \
    GAPB(o[0]=__builtin_amdgcn_mfma_f32_32x32x16_bf16(PAF(0),VFR(0),o[0],0,0,0), C0,0, P0,fa_,fa_,32); \
    GAPB(o[1]=__builtin_amdgcn_mfma_f32_32x32x16_bf16(PAF(0),VFR(4),o[1],0,0,0), C0,4, P0,fa_,fa_,64); \
    KRD(GL,0); GAPB(o[0]=__builtin_amdgcn_mfma_f32_32x32x16_bf16(PAF(1),VFR(1),o[0],0,0,0), C0,8, P0,fa_,fa_,96); \
    KRD(GL,1); GAPB(o[1]=__builtin_amdgcn_mfma_f32_32x32x16_bf16(PAF(1),VFR(5),o[1],0,0,0), C0,12, P0,fa_,fa_,128); \
    KRD(GL,2); GAPB(o[0]=__builtin_amdgcn_mfma_f32_32x32x16_bf16(PAF(2),VFR(2),o[0],0,0,0), C1,0, P1,fa_,fa_,160); \
    KRD(GL,3); GAPB(o[1]=__builtin_amdgcn_mfma_f32_32x32x16_bf16(PAF(2),VFR(6),o[1],0,0,0), C1,4, P1,fa_,fa_,192); \
    GAPB(o[0]=__builtin_amdgcn_mfma_f32_32x32x16_bf16(PAF(3),VFR(3),o[0],0,0,0), C1,8, P1,fa_,fa_,224); \
    GAPB(o[1]=__builtin_amdgcn_mfma_f32_32x32x16_bf16(PAF(3),VFR(7),o[1],0,0,0), C1,12, P1,fa_,fa_,224); \
    }while(0)
  int t=TB+1;
  #undef CMASK
  #define CMASK(P0,P1,t) do{}while(0)
  for(;t+5<NT;t+=2){
    STEP(pB0,pB1,pA0,pA1,t,true,true,true);     WAIT_BAR(2); RESC(); ROT();
    STEP(pA0,pA1,pB0,pB1,t+1,true,true,true);   WAIT_BAR(2); RESC(); ROT();
  }
  #undef CMASK
  #define CMASK(P0,P1,t) do{int jb_=(t)-(NTM-4); if(jb_>=0)cmask(P0,P1,jb_,qrel,hi);}while(0)
  #define ENDW(tt) do{ if((tt)+3<NT){WAIT_BAR(2);} else if((tt)+2<NT){WAIT_BAR(1);} else {WAIT_BAR(0);} }while(0)
  for(;t+1<NT;t+=2){
    STEP(pB0,pB1,pA0,pA1,t,(t+3<NT),(t+1<NT),(t+1<NT));       ENDW(t);   RESC(); ROT();
    STEP(pA0,pA1,pB0,pB1,t+1,(t+4<NT),(t+2<NT),(t+2<NT));     ENDW(t+1); RESC(); ROT();
  }
  STEP(pB0,pB1,pA0,pA1,NT-1,false,false,false); RESC();
  { float sacc=pB0[0]+pB0[1]; _Pragma("unroll") for(int r=2;r<16;++r)sacc+=pB0[r]; _Pragma("unroll") for(int r=0;r<16;++r)sacc+=pB1[r]; l_reg+=sacc;
    pw0=(u32x4){PKW(pB0,0),PKW(pB0,2),PKW(pB0,4),PKW(pB0,6)};pw1=(u32x4){PKW(pB0,8),PKW(pB0,10),PKW(pB0,12),PKW(pB0,14)};pw2=(u32x4){PKW(pB1,0),PKW(pB1,2),PKW(pB1,4),PKW(pB1,6)};pw3=(u32x4){PKW(pB1,8),PKW(pB1,10),PKW(pB1,12),PKW(pB1,14)};
    SBAR(); pv(o,vb0+sl_cur,PAF(0),PAF(1),PAF(2),PAF(3)); }
  #undef PKW
  #undef PAF
  #undef VFR
  #undef PIN
  #undef MX3
  #undef GAPA
  #undef GAPB
  #undef FLD
  #undef FILLC
  #undef EX
  #undef VRD
  #undef KRD
  #undef STEP
  #undef ENDW
  {auto rr=__builtin_amdgcn_permlane32_swap(__float_as_uint(l_reg),__float_as_uint(l_reg),false,false);l_reg=__uint_as_float(rr[0])+__uint_as_float(rr[1]);}
  const bool part=(slot!=1023); bf16*PO=PObase+(long)slot*(256*D); float*PS=PSbase+(long)slot*512;
  if(hi==0){wsf[32+r32]=part?1.f:l_reg; if(part){PS[(wid*QBLK+r32)*2]=mhat;PS[(wid*QBLK+r32)*2+1]=l_reg;}}asm volatile("s_waitcnt lgkmcnt(0)":::"memory");
  float rli[16];
  #pragma unroll
  for(int r=0;r<16;++r)rli[r]=__builtin_amdgcn_rcpf(wsf[32+crow(r,hi)]);
  bf16*Ow=part?PO+(long)(wid*QBLK)*D:O+(rowbase+q0+wid*QBLK)*DM+h*D; const long opitch=part?D:DM;
  { bf16*stg=(bf16*)(shm+LDS_OST)+wid*2048;
    #pragma unroll
    for(int r=0;r<16;++r){const int orow=crow(r,hi);
      #pragma unroll
      for(int d0=0;d0<2;++d0)stg[orow*64+d0*32+r32]=f2bf_a(o[d0][r]*rli[r]);}
    asm volatile("s_waitcnt lgkmcnt(0)":::"memory");
    #pragma unroll
    for(int i=0;i<4;++i){const int row=i*8+(lane>>3),ch=lane&7; const u32x4 v=*(const u32x4*)(stg+row*64+ch*8); ATTN_STORE16(Ow+(long)row*opitch+ch*8,v);} }
  asm volatile("s_waitcnt lgkmcnt(0)\n\ts_barrier":::"memory");
  #undef DMA_K
  #undef DMA_V
  #undef CMASK
  #undef START
  #undef RESC
  #undef ROT
}
constexpr int ATTN_LDS_BYTES=LDS_BYTES;
struct AttnTensors { const bf16* Q; const bf16* K; const bf16* V; bf16* O; const float* CUM; const int* T0; bf16* PO; float* PS; unsigned* qctr; };
constexpr int MAX_ITEMS=1408, PO_SLOTS=640;
__device__ __forceinline__ void unit_split(int Lt,int SEG,int&nseg,int&len){ nseg=(Lt+SEG-1)/SEG; len=2*(((Lt>>1)+nseg-1)/nseg); }
template<bool COMBINE> __device__ __forceinline__ int build_worklist(const int*T0,unsigned*wl,unsigned*tmp,int*sc){
  const int tid=threadIdx.x; const int qb=tid&31; const int t0=T0[tid]; const int Lt=4*qb+4-t0;
  __syncthreads();
  int SEG=40,nseg,len;
  for(int pass=0;pass<2;++pass){
    unit_split(Lt,SEG,nseg,len);
    sc[tid]=nseg; sc[512+tid]=nseg>1?nseg:0; sc[1024+tid]=nseg>1?1:0; __syncthreads();
    for(int o=1;o<512;o<<=1){ const int a=tid>=o?sc[tid-o]:0, c=tid>=o?sc[512+tid-o]:0, e=tid>=o?sc[1024+tid-o]:0; __syncthreads(); sc[tid]+=a; sc[512+tid]+=c; sc[1024+tid]+=e; __syncthreads(); }
    if(sc[1023]<=PO_SLOTS&&sc[511]<=MAX_ITEMS)break;
    __syncthreads(); SEG=64;
  }
  const int ioff=sc[tid]-nseg, poff=sc[512+tid]-(nseg>1?nseg:0), NI=sc[511], NS=sc[1535], sord=sc[1024+tid]-1;
  __syncthreads();
  if(COMBINE){ if(nseg>1)wl[sord]=(unsigned)tid|((unsigned)nseg<<9)|((unsigned)poff<<12); __syncthreads(); return NS; }
  for(int sgi=0;sgi<nseg;++sgi){ const int lb=t0+sgi*len, le=min(lb+len,4*qb+4); tmp[ioff+sgi]=(unsigned)tid|((unsigned)lb<<9)|((unsigned)((le-lb)>>1)<<16)|((unsigned)(nseg>1?poff+sgi:1023)<<22); }
  __syncthreads();
  { const int lane=tid&63,w=tid>>6,nch=(NI+63)>>6; int*hist=sc;
    for(int c=w;c<nch;c+=8){ const int i=c*64+lane; const int key=i<NI?(int)((tmp[i]>>16)&63u):0;
      for(int k=1;k<=32;++k){ const unsigned long long mk=__ballot(key==k); if(lane==0)hist[c*33+k]=__popcll(mk); } }
    __syncthreads();
    if(tid>=1&&tid<=32){ int run=0; for(int c=0;c<nch;++c){ const int v=hist[c*33+tid]; hist[c*33+tid]=run; run+=v; } sc[840+tid]=run; }
    __syncthreads();
    if(tid==0){ int run=0; for(int k=32;k>=1;--k){ sc[800+k]=run; run+=sc[840+k]; } }
    __syncthreads();
    for(int c=w;c<nch;c+=8){ const int i=c*64+lane; const int key=i<NI?(int)((tmp[i]>>16)&63u):0; int myr=0;
      for(int k=1;k<=32;++k){ const unsigned long long mk=__ballot(key==k); if(key==k)myr=__popcll(mk&((1ull<<lane)-1ull)); }
      if(i<NI)wl[sc[800+key]+hist[c*33+key]+myr]=tmp[i]; }
  }
  __syncthreads();
  return NI;
}
template<int THRL=8> __device__ __forceinline__ void attn_phase(char*lds,const AttnTensors&T,int vcu,int G){
  unsigned*wl=(unsigned*)(lds+LDS_BYTES); unsigned*tmp=wl+MAX_ITEMS; int*sc=(int*)lds;
  const int NI=build_worklist<false>(T.T0,wl,tmp,sc);
  volatile int*nxt=(volatile int*)(tmp);
  int idx=vcu;
  while(idx<NI){
    const unsigned it=wl[idx]; const int u=it&511,TB=(it>>9)&127,lenp=(it>>16)&63,slot=(it>>22)&1023;
    const int bh=u>>5,qb=u&31;
    attn_unit<THRL>(bh/NHEAD,bh%NHEAD,qb,TB,TB+2*lenp,4*qb+4,T.Q,T.K,T.V,T.O,T.CUM,T.PO,T.PS,slot,lds);
    if(threadIdx.x==0)*nxt=G+(int)__hip_atomic_fetch_add(T.qctr,1u,__ATOMIC_RELAXED,__HIP_MEMORY_SCOPE_AGENT);
    __syncthreads(); idx=*nxt; __syncthreads();
  }
}
__device__ __forceinline__ int attn_combine(char*lds,const AttnTensors&T,int wg,int nwg){
  unsigned*wl=(unsigned*)(lds+LDS_BYTES); unsigned*tmp=wl+MAX_ITEMS; int*sc=(int*)lds;
  const int NS=build_worklist<true>(T.T0,wl,tmp,sc);
  const int tid=threadIdx.x,row=tid>>1,ch=tid&1;
  for(int k=wg;k<NS;k+=nwg){ const unsigned it=wl[k]; const int u=it&511,nseg=(it>>9)&7,poff=(it>>12)&1023,bh=u>>5,qb=u&31,b=bh/NHEAD,h=bh%NHEAD;
    float m[4],l[4]; float M=-3.0e38f; u32x4 pv[4][4];
    #pragma unroll
    for(int sgi=0;sgi<4;++sgi){ m[sgi]=-3.0e38f; l[sgi]=0.f; const int sg=sgi<nseg?sgi:0;
      const float2 ml=*(const float2*)(T.PS+(long)(poff+sg)*512+row*2); if(sgi<nseg){m[sgi]=ml.x;l[sgi]=ml.y;} M=fmaxf(M,m[sgi]);
      const u32x4*p=(const u32x4*)(T.PO+(long)(poff+sg)*(256*D)+row*D+ch*32);
      #pragma unroll
      for(int q=0;q<4;++q)pv[sgi][q]=p[q]; }
    float acc[32]; float L=0.f;
    #pragma unroll
    for(int c=0;c<32;++c)acc[c]=0.f;
    #pragma unroll
    for(int sgi=0;sgi<4;++sgi){ const float w=sgi<nseg?__builtin_amdgcn_exp2f(m[sgi]-M):0.f; L+=w*l[sgi];
      #pragma unroll
      for(int q=0;q<4;++q){ const u32x4 v=pv[sgi][q];
        acc[8*q+0]+=w*__builtin_bit_cast(float,v.x<<16); acc[8*q+1]+=w*__builtin_bit_cast(float,v.x&0xffff0000u); acc[8*q+2]+=w*__builtin_bit_cast(float,v.y<<16); acc[8*q+3]+=w*__builtin_bit_cast(float,v.y&0xffff0000u);
        acc[8*q+4]+=w*__builtin_bit_cast(float,v.z<<16); acc[8*q+5]+=w*__builtin_bit_cast(float,v.z&0xffff0000u); acc[8*q+6]+=w*__builtin_bit_cast(float,v.w<<16); acc[8*q+7]+=w*__builtin_bit_cast(float,v.w&0xffff0000u); } }
    const float rl=1.f/L; bf16*op=T.O+((long)b*SEQ+qb*QB+row)*DM+h*D+ch*32;
    #pragma unroll
    for(int q=0;q<4;++q){ u32x4 w; w.x=cvtpk_s(acc[8*q]*rl,acc[8*q+1]*rl); w.y=cvtpk_s(acc[8*q+2]*rl,acc[8*q+3]*rl); w.z=cvtpk_s(acc[8*q+4]*rl,acc[8*q+5]*rl); w.w=cvtpk_s(acc[8*q+6]*rl,acc[8*q+7]*rl); *(u32x4*)(op+8*q)=w; }
  }
  __syncthreads();
  return NS;
}
#undef SBAR
#undef WAIT_BAR
}

constexpr int NWAVES = 8;
constexpr int RING_OFF = 0, RING_BYTES = 131072;
constexpr int LDSCTL_OFF = RING_BYTES, MISC_OFF = LDSCTL_OFF + 320;
constexpr int LDS_BYTES = 147456;
typedef GAS unsigned gu32;
#define RLX_AGENT __ATOMIC_RELAXED, __HIP_MEMORY_SCOPE_AGENT
#define LDS_WAIT() asm volatile("s_waitcnt lgkmcnt(0)" ::: "memory")
#define VM_WAIT() asm volatile("s_waitcnt vmcnt(0)" ::: "memory")
constexpr int CW_TMO = 0, CW_CODE = 1, CW_CNT = 64  , CW_Q0 = 128  , CW_BAR = 4096, CW_HCNT = 8192  , CW_PYS = 12288, CW_PMIX = 13312, CW_PX2 = 14336  ;

#define XB_TMO      128
#define XB_XCNT(j)  (256  + 64 * (j))
#define XB_XSUB(j)  (1280 + 64 * (j))
#define XB_XGEN(j)  (2304 + 64 * (j))
#define XB_TOP      3328
#define XB_TOPGEN   3392
#define XCD_BAR_WORDS 3456
#define XB_SPIN_CAP (1u << 18)
__device__ __forceinline__ unsigned xb_ld(unsigned* p)              { return __hip_atomic_load(p, __ATOMIC_RELAXED, __HIP_MEMORY_SCOPE_AGENT); }
__device__ __forceinline__ unsigned xb_add(unsigned* p, unsigned v) { return __hip_atomic_fetch_add(p, v, __ATOMIC_RELAXED, __HIP_MEMORY_SCOPE_AGENT); }
__device__ __forceinline__ unsigned xb_xcc_id() { return (unsigned)__builtin_amdgcn_s_getreg((3 << 11) | 20) & 0xFu; }
#define XB_SPIN(cond, bar) do { unsigned _sp = 0; while (cond) { __builtin_amdgcn_s_sleep(1); \
    if ((++_sp & 255u) == 0u) { if (xb_ld(&(bar)[XB_TMO])) break; if (_sp > XB_SPIN_CAP) { atomicAdd(&(bar)[XB_TMO], 1u); break; } } } } while (0)
struct XcdBarrier { unsigned* bar; unsigned x; volatile LAS unsigned* st; };
__device__ __forceinline__ XcdBarrier xcd_barrier_post(unsigned* bar, volatile LAS unsigned* st) {
    XcdBarrier b; b.bar = bar; b.x = xb_xcc_id(); b.st = st;
    if (threadIdx.x == 0) (void)xb_add(&bar[XB_XCNT(b.x)], 1u);
    return b;
}
__device__ __forceinline__ void xcd_barrier_complete(unsigned* bar, unsigned x, unsigned& nloc, unsigned& nx) {
    const unsigned G = gridDim.x * gridDim.y * gridDim.z;
    unsigned sum, cnt, mine, sp = 0u;
    for (;;) {
        sum = 0u; cnt = 0u; mine = 0u;
#pragma unroll
        for (unsigned j = 0; j < 16; ++j) { const unsigned c = xb_ld(&bar[XB_XCNT(j)]); sum += c; cnt += (c > 0u) ? 1u : 0u; mine = (j == x) ? c : mine; }
        if (sum == G) break;
        __builtin_amdgcn_s_sleep(1);
        if ((++sp & 255u) == 0u) { if (xb_ld(&bar[XB_TMO])) break; if (sp > XB_SPIN_CAP) { atomicAdd(&bar[XB_TMO], 1u); break; } }
    }
    nloc = mine > 0u ? mine : 1u; nx = cnt > 0u ? cnt : 1u;
}
__device__ __forceinline__ void xcd_barrier(const XcdBarrier& b) {
    asm volatile("s_waitcnt vmcnt(0)" ::: "memory");
    __syncthreads();
    if (threadIdx.x == 0) {
        unsigned* bar = b.bar;
        __builtin_amdgcn_s_waitcnt(0);
        unsigned nloc = b.st[0], nx = b.st[1];
        if (nloc == 0u) { xcd_barrier_complete(bar, b.x, nloc, nx); b.st[0] = nloc; b.st[1] = nx; }
        const unsigned old = xb_add(&bar[XB_XSUB(b.x)], 1u);
        const unsigned gen = old / nloc;
        if (old + 1u == (gen + 1u) * nloc) {
            __builtin_amdgcn_fence(__ATOMIC_RELEASE, "agent");
            asm volatile("s_waitcnt vmcnt(0)" ::: "memory");
            const unsigned og = xb_add(&bar[XB_TOP], 1u);
            const unsigned tg = og / nx;
            if (og + 1u == (tg + 1u) * nx) xb_add(&bar[XB_TOPGEN], 1u);
            else XB_SPIN(xb_ld(&bar[XB_TOPGEN]) == tg, bar);
            __builtin_amdgcn_fence(__ATOMIC_ACQUIRE, "agent");
            xb_add(&bar[XB_XGEN(b.x)], 1u);
            asm volatile("s_waitcnt vmcnt(0)" ::: "memory");
        } else {
            XB_SPIN(xb_ld(&bar[XB_XGEN(b.x)]) == gen, bar);
            __builtin_amdgcn_fence(__ATOMIC_ACQUIRE, "agent");
            asm volatile("s_waitcnt vmcnt(0)" ::: "memory");
        }
    }
    __syncthreads();
}

struct Args { const float* in[26]; float* out; unsigned char* ws; int ph_lo, ph_hi, sub, pad_; };
struct Frame {
    LAS unsigned char* lds; volatile LAS unsigned* MISC; gu32* ctl;
    int tid, lane, wave, vcu, G; bool stamper;
};
#define FSTAMP(F, k) do { if ((F).stamper && threadIdx.x == 0) ((volatile LAS unsigned*)((F).lds + LDSCTL_OFF + 4096))[(k)] = (unsigned)__builtin_amdgcn_s_memrealtime(); } while (0)
__device__ __forceinline__ float gelu_fast(float x) { const float z = 0.7978845608028654f * (x + 0.044715f * x * x * x); const float e = __builtin_amdgcn_exp2f(2.885390081777927f * z); return x - x * __builtin_amdgcn_rcpf(e + 1.f); }
template <int CTRL> __device__ __forceinline__ float dpp_mov(float v) { return __builtin_bit_cast(float, __builtin_amdgcn_update_dpp(0, __builtin_bit_cast(int, v), CTRL, 0xf, 0xf, false)); }
__device__ __forceinline__ float swap16_sum(float a, float b) { const bool up = (threadIdx.x & 16) != 0; const float snd = up ? a : b, kp = up ? b : a; return kp + __shfl_xor(snd, 16); }
__device__ __forceinline__ float swap32_sum(float a, float b) { const bool up = (threadIdx.x & 32) != 0; const float snd = up ? a : b, kp = up ? b : a; return kp + __shfl_xor(snd, 32); }
__device__ __forceinline__ float wave_sum(float v) {
    v += dpp_mov<0xB1>(v); v += dpp_mov<0x4E>(v); v += dpp_mov<0x141>(v); v += dpp_mov<0x140>(v);
    v += __shfl_xor(v, 16); return v + __shfl_xor(v, 32);
}

struct ConvDesc { const float* W; int ldw, k0, scol; bf16* dst; int ldd; const LAS float* kscale; int scaled; };
__device__ __forceinline__ void conv_load(const ConvDesc& d, float (&v)[32], int lane) {
    const float* wp = d.W + (size_t)(d.k0 + (lane >> 5)) * d.ldw + d.scol + (lane & 31);
#pragma unroll
    for (int i = 0; i < 32; ++i) v[i] = wp[(size_t)(2 * i) * d.ldw];
}
__device__ __forceinline__ void conv_finish(const ConvDesc& d, float (&v)[32], LAS float* scr, int lane) {
    if (d.scaled) {
#pragma unroll
        for (int i = 0; i < 32; ++i) v[i] *= d.kscale[d.k0 + 2 * i + (lane >> 5)]; }
#pragma unroll
    for (int i = 0; i < 32; ++i) scr[(2 * i + (lane >> 5)) * 33 + (lane & 31)] = v[i];
    LDS_WAIT(); asm volatile("" ::: "memory");
    const int c = lane & 7;
#pragma unroll
    for (int j = 0; j < 4; ++j) { const int n = (lane >> 3) + 8 * j; const LAS float* s = scr + (8 * c) * 33 + n;
        u32x4 o; o.x = pg::cvt_pk_bf16(s[0 * 33], s[1 * 33]); o.y = pg::cvt_pk_bf16(s[2 * 33], s[3 * 33]); o.z = pg::cvt_pk_bf16(s[4 * 33], s[5 * 33]); o.w = pg::cvt_pk_bf16(s[6 * 33], s[7 * 33]);
        *(GAS u32x4*)(d.dst + (size_t)n * d.ldd + d.k0 + 8 * c) = o; }
    LDS_WAIT(); asm volatile("" ::: "memory");
}
__device__ __forceinline__ void conv_item(const float* W, int ldw, int k0, int scol, bf16* dst, int ldd, const float* kscale, LAS float* scr, int lane) {
    (void)kscale; ConvDesc d{W, ldw, k0, scol, dst, ldd, (const LAS float*)scr, 0}; float v[32]; conv_load(d, v, lane); conv_finish(d, v, scr, lane);
}
__device__ __forceinline__ int inproj_src_col(int cp) { if (cp < 1536) return cp; if (cp < 2048) return cp + (OU - 1536);
    const int c2 = cp - 2048, t = c2 >> 8, c = c2 & 255, wc = c >> 6, bj = (c >> 5) & 1, j = c & 31; return (bj ? OGS : OGA) + 128 * t + 32 * wc + j; }
__device__ __forceinline__ int inproj_dst_row(int cp) { const int t = cp & ~255, c = cp & 255, wc = c >> 6, bj = (c >> 5) & 1, j = c & 31; return t + 128 * bj + 32 * wc + j; }

__device__ __forceinline__ void p0_prologue(Frame& F, const Args& a) {
    unsigned char* ws = a.ws;
    LAS float* scr = (LAS float*)(F.lds + F.wave * 8704);
    LAS float* wf = (LAS float*)(F.lds + 73728);
    const int gw = F.vcu * NWAVES + F.wave, NGW = F.G * NWAVES;
    const float* w_in = a.in[2]; const int sub = a.sub;
    constexpr int I_IN = 16 * 128;
    const bool conv_on = (sub & 1) != 0;
    ConvDesc cd0; float cv0[32];
    { const int it = gw < I_IN ? gw : I_IN - 1, kb = it >> 7, nb = it & 127, cp = nb * 32;
      cd0 = ConvDesc{w_in, DIN, kb * 64, inproj_src_col(cp), (bf16*)(ws + WS_WIN) + (size_t)inproj_dst_row(cp) * D, D, (const LAS float*)scr, 0}; conv_load(cd0, cv0, F.lane); }
    for (int i = F.tid; i < 2 * 1024; i += NWAVES * 64) { const int k = i >> 1, hh = (i & 1) * 4; const f32x4 v = *(const GAS f32x4*)(w_in + (size_t)k * DIN + OF + hh);
        wf[(hh + 0) * 1024 + k] = v.x; wf[(hh + 1) * 1024 + k] = v.y; wf[(hh + 2) * 1024 + k] = v.z; wf[(hh + 3) * 1024 + k] = v.w; }
    if (conv_on && gw < I_IN) conv_finish(cd0, cv0, scr, F.lane);
    for (int it = conv_on ? gw + NGW : I_IN; it < I_IN; it += NGW) { const int kb = it >> 7, nb = it & 127, cp = nb * 32;
        conv_item(w_in, DIN, kb * 64, inproj_src_col(cp), (bf16*)(ws + WS_WIN) + (size_t)inproj_dst_row(cp) * D, D, nullptr, scr, F.lane); }
    __syncthreads();
    const float* x = a.in[0]; const float* g = a.in[1]; const float* bfg = a.in[3];
    bf16* XN = (bf16*)(ws + WS_XN); float* LOGF = (float*)(ws + WS_CUM);
    FSTAMP(F, 100);
    f32x4 gq4[4];
#pragma unroll
    for (int j = 0; j < 4; ++j) gq4[j] = *((const GAS f32x4*)g + 64 * j + F.lane);
    const float bfl = bfg[(F.lane >> 3) & 7];
    { int m = (sub & 2) ? gw : T; f32x4 v[4], v1[4], v2[4];
#define P0_LOADROW(dst, mm) do { const int mc_ = (mm) < T ? (mm) : T - 1; const GAS f32x4* xr_ = (const GAS f32x4*)(x + (size_t)mc_ * D) + F.lane; _Pragma("unroll") for (int j = 0; j < 4; ++j) dst[j] = xr_[64 * j]; } while (0)
      P0_LOADROW(v, m); P0_LOADROW(v1, m + NGW); P0_LOADROW(v2, m + 2 * NGW);
      constexpr int RPW = T / (256 * NWAVES);
#pragma unroll
      for (int it_ = 0; it_ < RPW; ++it_) {
        const int mn = m + NGW; f32x4 vn[4];
        P0_LOADROW(vn, m + 3 * NGW);
        f32x2 s2 = (f32x2){0.f, 0.f};
#pragma unroll
        for (int j = 0; j < 4; ++j) { const f32x2 lo = (f32x2){v[j].x, v[j].y}, hi = (f32x2){v[j].z, v[j].w}; s2 += lo * lo; s2 += hi * hi; }
        const float s = s2.x + s2.y;
        f32x2 fa[8];
#pragma unroll
        for (int h = 0; h < 8; ++h) fa[h] = (f32x2){0.f, 0.f};
        f32x4 xg[4];
#pragma unroll
        for (int j = 0; j < 4; ++j) { const f32x4 gg = gq4[j]; xg[j] = v[j] * gg; const f32x2 xlo = (f32x2){xg[j].x, xg[j].y}, xhi = (f32x2){xg[j].z, xg[j].w};
#pragma unroll
            for (int h = 0; h < 8; ++h) { const f32x4 ww = *((const LAS f32x4*)(wf + h * 1024) + 64 * j + F.lane); fa[h] += xlo * (f32x2){ww.x, ww.y}; fa[h] += xhi * (f32x2){ww.z, ww.w}; } }
        float f[8];
#pragma unroll
        for (int h = 0; h < 8; ++h) f[h] = fa[h].x + fa[h].y;
        const float rstd = rsqrtf(wave_sum(s) * (1.f / D) + EPS);
        float f4[4], f2[2], f1;
#pragma unroll
        for (int i = 0; i < 4; ++i) f4[i] = swap32_sum(f[i], f[4 + i]);
#pragma unroll
        for (int i = 0; i < 2; ++i) f2[i] = swap16_sum(f4[i], f4[2 + i]);
        { const bool up = (F.lane & 8) != 0; const float snd = up ? f2[0] : f2[1], kp = up ? f2[1] : f2[0]; f1 = kp + dpp_mov<0x128>(snd); }
        f1 += dpp_mov<0xB1>(f1); f1 += dpp_mov<0x4E>(f1); f1 += dpp_mov<0x141>(f1);
        { u32x2 w[4];
#pragma unroll
          for (int j = 0; j < 4; ++j) { const f32x4 xn = xg[j] * rstd; w[j].x = pg::cvt_pk_bf16(xn.x, xn.y); w[j].y = pg::cvt_pk_bf16(xn.z, xn.w); }
          const bool odd = (F.lane & 1) != 0; GAS u32x4* o16 = (GAS u32x4*)(XN + (size_t)m * D) + (odd ? 32 : 0) + (F.lane >> 1);
#pragma unroll
          for (int jp = 0; jp < 2; ++jp) { const u32x2 snd = odd ? w[2 * jp] : w[2 * jp + 1], own = odd ? w[2 * jp + 1] : w[2 * jp]; u32x2 rcv; rcv.x = (unsigned)__shfl_xor((int)snd.x, 1); rcv.y = (unsigned)__shfl_xor((int)snd.y, 1);
              const u32x4 o = odd ? (u32x4){rcv.x, rcv.y, own.x, own.y} : (u32x4){own.x, own.y, rcv.x, rcv.y}; if (m < T) o16[64 * jp] = o; } }
        if (m < T && (F.lane & 7) == 0) { const int hh = F.lane >> 3, b = m / SEQ, sidx = m % SEQ; LOGF[((size_t)b * NH + hh) * SEQ + sidx] = log_sigmoid(f1 * rstd + bfl); }
#pragma unroll
        for (int j = 0; j < 4; ++j) { v[j] = v1[j]; v1[j] = v2[j]; v2[j] = vn[j]; }
        m = mn;
      } }
    FSTAMP(F, 101);
    if ((sub & 4) && F.G == 256) {
        __syncthreads();
        const int g = F.vcu >> 3, q = F.vcu & 7;
        LAS f32x2* PW = (LAS f32x2*)(F.lds);
        LAS f32x2* BB = (LAS f32x2*)(F.lds + 16896);
        LAS f32x2* CT = (LAS f32x2*)(F.lds + 16896 + 8192);
        LAS float* KT = (LAS float*)(F.lds + 16896 + 16384);
        const float* A_re = a.in[6]; const float* A_im = a.in[7]; const float* log_dt = a.in[8]; const float* B_re = a.in[9]; const float* B_im = a.in[10]; const float* C_re = a.in[11]; const float* C_im = a.in[12];
        if (F.tid < NP) { const int p = F.tid;
            const float dt = expf(log_dt[g]), ar = A_re[g * NP + p], ai = A_im[g * NP + p];
            const float er = expf(ar * dt), abr = er * cosf(ai * dt), abi = er * sinf(ai * dt);
            const float nr = abr - 1.0f, ni = abi, den = ar * ar + ai * ai, fr_ = (nr * ar + ni * ai) / den, fi_ = (ni * ar - nr * ai) / den;
            float pr = 1.0f, pi = 0.0f;
            for (int tau = 0; tau <= LCH; ++tau) { PW[tau * NP + p] = (f32x2){pr, pi}; const float t2 = pr * abr - pi * abi; pi = pr * abi + pi * abr; pr = t2; }
            if (q == 0) { ((float*)(ws + WS_AL))[(g * NP + p) * 2] = PW[LCH * NP + p].x; ((float*)(ws + WS_AL))[(g * NP + p) * 2 + 1] = PW[LCH * NP + p].y; }
            float brv[GC], biv[GC];
#pragma unroll
            for (int c = 0; c < GC; ++c) { brv[c] = B_re[(g * NP + p) * GC + c]; biv[c] = B_im[(g * NP + p) * GC + c]; }
#pragma unroll
            for (int c = 0; c < GC; ++c) BB[p * GC + c] = (f32x2){fr_ * brv[c] - fi_ * biv[c], fr_ * biv[c] + fi_ * brv[c]}; }
        for (int i = F.tid; i < GC * NP; i += NWAVES * 64) { const int c = i >> 6, p = i & 63; CT[p * GC + c] = (f32x2){C_re[g * GC * NP + i], C_im[g * GC * NP + i]}; }
        __syncthreads();
        { float* KTG = (float*)(ws + WS_KTG) + (size_t)g * LCH * GC * GC;
          for (int i = 2 * q * GC * GC + F.tid; i < (2 * q + 2) * GC * GC; i += NWAVES * 64) { const int tau = i >> 8, co = (i >> 4) & 15, ci = i & 15; float acc = 0.f;
#pragma unroll 4
              for (int p = 0; p < NP; ++p) { const f32x2 w = PW[tau * NP + p], b = BB[p * GC + ci], c = CT[p * GC + co]; const float wr_ = w.x * b.x - w.y * b.y, wi_ = w.x * b.y + w.y * b.x; acc += c.x * wr_ - c.y * wi_; }
              KTG[i] = acc; } }
        {
          const int n = 32 * q + (F.tid >> 4), part = F.tid & 15, j = n >> 4, co = n & 15; bf16* row = (bf16*)(ws + WS_BTY) + ((size_t)g * 256 + n) * U2P;
          auto bval = [&](int k) -> float { const int p = k & 63; const f32x2 w = PW[(j + 1) * NP + p], c = CT[p * GC + co]; return k < 64 ? (c.x * w.x - c.y * w.y) : -(c.x * w.y + c.y * w.x); };
          { const int k = part * 8;
              u32x4 o; o.x = pg::cvt_pk_bf16(bval(k), bval(k + 1)); o.y = pg::cvt_pk_bf16(bval(k + 2), bval(k + 3)); o.z = pg::cvt_pk_bf16(bval(k + 4), bval(k + 5)); o.w = pg::cvt_pk_bf16(bval(k + 6), bval(k + 7)); *(GAS u32x4*)(row + k) = o; } }
        {
          const int n = 32 * q + (F.tid >> 4), part = F.tid & 15; bf16* row = (bf16*)(ws + WS_M1T) + ((size_t)g * 256 + n) * 256;
          auto mval = [&](int k) -> float { const int j = k >> 4, ci = k & 15; float x = 0.f;
              if (n < 128) { const int p = n & 63; const f32x2 w = PW[(LCH - 1 - j) * NP + p], b = BB[p * GC + ci]; x = n < 64 ? (w.x * b.x - w.y * b.y) : (w.x * b.y + w.y * b.x); }
              return x; };
#pragma unroll 1
          for (int it = 0; it < 2; ++it) { const int k = (it * 16 + part) * 8;
              u32x4 o; o.x = pg::cvt_pk_bf16(mval(k), mval(k + 1)); o.y = pg::cvt_pk_bf16(mval(k + 2), mval(k + 3)); o.z = pg::cvt_pk_bf16(mval(k + 4), mval(k + 5)); o.w = pg::cvt_pk_bf16(mval(k + 6), mval(k + 7)); *(GAS u32x4*)(row + k) = o; } }
    }
}

__device__ __forceinline__ void p1_cumsum(Frame& F, float* CUM, int* T0, const float* gq, const float* gk) {
    LAS double* part = (LAS double*)(F.lds);
    float* p = CUM + (size_t)blockIdx.x * SEQ + F.tid * 16;
    f32x4 v[4]; float run[16]; float a = 0.f;
#pragma unroll
    for (int j = 0; j < 4; ++j) v[j] = ((const GAS f32x4*)p)[j];
#pragma unroll
    for (int j = 0; j < 4; ++j) { a += v[j].x; run[4 * j] = a; a += v[j].y; run[4 * j + 1] = a; a += v[j].z; run[4 * j + 2] = a; a += v[j].w; run[4 * j + 3] = a; }
    part[F.tid] = (double)a;
    __syncthreads();
    if (F.tid < 64) { double loc[8]; double s = 0.0;
#pragma unroll
        for (int i = 0; i < 8; ++i) { loc[i] = s; s += part[F.tid * 8 + i]; }
        double incl = s;
#pragma unroll
        for (int o = 1; o < 64; o <<= 1) { const double t = __shfl_up(incl, o); if (F.lane >= o) incl += t; }
        const double excl = incl - s;
#pragma unroll
        for (int i = 0; i < 8; ++i) part[F.tid * 8 + i] = excl + loc[i]; }
    __syncthreads();
    const double base = part[F.tid];
#pragma unroll
    for (int j = 0; j < 4; ++j) { f32x4 o; o.x = (float)((base + (double)run[4 * j]) * 1.4426950408889634); o.y = (float)((base + (double)run[4 * j + 1]) * 1.4426950408889634);
        o.z = (float)((base + (double)run[4 * j + 2]) * 1.4426950408889634); o.w = (float)((base + (double)run[4 * j + 3]) * 1.4426950408889634); ((GAS f32x4*)p)[j] = o; }
    LAS float* ends = (LAS float*)(F.lds + 8192);
    if ((F.tid & 3) == 3) ends[F.tid >> 2] = (float)((base + (double)run[15]) * 1.4426950408889634);
    if ((F.tid & 15) == 0) ends[128 + (F.tid >> 4)] = (float)((base + (double)run[0]) * 1.4426950408889634);
    __syncthreads();
    if (F.tid < 32) { float gqm = 0.f, gkm = 0.f;
#pragma unroll 8
        for (int i = 0; i < HD; ++i) { gqm = fmaxf(gqm, fabsf(gq[i])); gkm = fmaxf(gkm, fabsf(gk[i])); }
        const float thr = 2.f * 64.f * C2 * gqm * gkm + 37.f; const int qb = F.tid, NTu = 4 * qb + 4;
        const float fq0 = ends[128 + qb];
        int lo = 0, hi = NTu - 1;
        while (lo < hi) { const int mid = (lo + hi) >> 1; if (fq0 - ends[mid] >= -thr) hi = mid; else lo = mid + 1; }
        int t0 = lo & ~1; t0 = t0 > NTu - 4 ? NTu - 4 : t0; T0[blockIdx.x * 32 + qb] = t0; }
    __syncthreads();
}
struct PhInProj {
    static constexpr bool GATHER = false, HOOKS = false, STAMPS = true, PREFETCH = false, LATE = false, KEEPACC = false, ACCINIT = false, HALFSKIP = false;
    volatile LAS unsigned* stp;
    unsigned lda, ldb; const char* A; const char* B; pg::StaticOrder so;
    bf16 *Q, *K, *V, *U2X, *GA, *GS; const float *gq, *gk;
    __device__ __forceinline__ bool next(int i, pg::Unit& u) const { int pm, pn; if (!so.next(i, pm, pn)) return false; u.A = A + (size_t)pm * 256 * lda; u.B = B + (size_t)pn * 256 * ldb; u.nt = D / 64; u.pm = pm; u.pn = pn; u.aux = 0; return true; }
    __device__ __forceinline__ void offs(const pg::Unit&, const int (&R)[2], const int (&C)[2], unsigned (&vo)[2][2]) const { pg::offs_plain(lda, R, C, vo); }
    __device__ __forceinline__ void epi(const f32x4 (&acc)[2][2][4][2], const pg::Unit& u, int wr, int wc, int fr, int fq) const {
        const int pn = u.pn, row0 = u.pm * 256 + wr * 64 + fr;
        if (pn < 4) {
            const bool isq = pn < 2; const float* g = isq ? gq : gk; bf16* O = isq ? Q : K; const int cb = (pn & 1) * 256 + 64 * wc + 8 * fq; const float sc = isq ? C2 : 1.f;
            f32x4 gv[2][2];
#pragma unroll
            for (int bj = 0; bj < 2; ++bj)
#pragma unroll
                for (int n = 0; n < 2; ++n) gv[bj][n] = *(const f32x4*)(g + 32 * bj + 8 * fq + 4 * n) * sc;
#pragma unroll
            for (int ai = 0; ai < 2; ++ai)
#pragma unroll
                for (int m = 0; m < 4; ++m) { float ss = 0.f;
#pragma unroll
                    for (int bj = 0; bj < 2; ++bj)
#pragma unroll
                        for (int n = 0; n < 2; ++n) { const f32x4 v = acc[ai][bj][m][n]; ss += (v[0] * v[0] + v[1] * v[1]) + (v[2] * v[2] + v[3] * v[3]); }
                    ss += __shfl_xor(ss, 16); ss += __shfl_xor(ss, 32);
                    const float rstd = rsqrtf(ss * (1.f / 64.f) + EPS);
                    bf16* rowp = O + (size_t)(row0 + ai * 128 + m * 16) * DA + cb;
#pragma unroll
                    for (int bj = 0; bj < 2; ++bj) *(u32x4*)(rowp + 32 * bj) = pg::pack8(acc[ai][bj][m][0] * rstd * gv[bj][0], acc[ai][bj][m][1] * rstd * gv[bj][1]); }
        } else if (pn < 6) {
            const int cb = (pn - 4) * 256 + 64 * wc + 8 * fq;
#pragma unroll
            for (int ai = 0; ai < 2; ++ai)
#pragma unroll
                for (int m = 0; m < 4; ++m) { bf16* rowp = V + (size_t)(row0 + ai * 128 + m * 16) * DA + cb;
#pragma unroll
                    for (int bj = 0; bj < 2; ++bj) *(u32x4*)(rowp + 32 * bj) = pg::pack8(acc[ai][bj][m][0], acc[ai][bj][m][1]); }
        } else if (pn < 8) {
#pragma unroll
            for (int ai = 0; ai < 2; ++ai)
#pragma unroll
                for (int m = 0; m < 4; ++m) { const int row = row0 + ai * 128 + m * 16;
#pragma unroll
                    for (int bj = 0; bj < 2; ++bj) { const int cu = (pn - 6) * 256 + 64 * wc + 32 * bj + 8 * fq;
                        *(u32x4*)(U2X + u2x_index(cu >> 4, row, cu & 15)) = pg::pack8(acc[ai][bj][m][0], acc[ai][bj][m][1]); } }
        } else {
            const int cb = (pn - 8) * 128 + 32 * wc + 8 * fq;
#pragma unroll
            for (int ai = 0; ai < 2; ++ai)
#pragma unroll
                for (int m = 0; m < 4; ++m) { const size_t ro = (size_t)(row0 + ai * 128 + m * 16) * D + cb;
                    f32x4 r[2], s[2];
#pragma unroll
                    for (int n = 0; n < 2; ++n)
#pragma unroll
                        for (int e = 0; e < 4; ++e) { const float ea = __builtin_amdgcn_exp2f(-LOG2E * acc[ai][0][m][n][e]), es = fminf(__builtin_amdgcn_exp2f(-LOG2E * acc[ai][1][m][n][e]), 1e30f);
                            s[n][e] = __builtin_amdgcn_rcpf(1.f + es); r[n][e] = (1.f + es) * __builtin_amdgcn_rcpf(1.f + ea); }
                    *(u32x4*)(GA + ro) = pg::pack8(r[0], r[1]); *(u32x4*)(GS + ro) = pg::pack8(s[0], s[1]); }
        }
    }
};

__device__ __forceinline__ void cnt_publish(unsigned* c) {
    asm volatile("s_waitcnt vmcnt(0)" ::: "memory");
    if ((threadIdx.x & 63) == 0) __hip_atomic_fetch_add(c, 1u, __ATOMIC_RELAXED, __HIP_MEMORY_SCOPE_AGENT);
}
__device__ __forceinline__ void cnt_wait_wave0(unsigned* c, unsigned want) {
    if (threadIdx.x < 64) { unsigned sp = 0;
        while ((unsigned)__builtin_amdgcn_readfirstlane(__hip_atomic_load(c, __ATOMIC_RELAXED, __HIP_MEMORY_SCOPE_AGENT)) < want) { __builtin_amdgcn_s_sleep(2); if (++sp > (1u << 22)) break; }
        __builtin_amdgcn_fence(__ATOMIC_ACQUIRE, "agent");
        asm volatile("s_waitcnt vmcnt(0)" ::: "memory"); }
}
struct PhGlu {
    static constexpr bool GATHER = false, HOOKS = true, STAMPS = true, PREFETCH = false, LATE = false, KEEPACC = false, ACCINIT = false, HALFSKIP = false;
    volatile LAS unsigned* stp;
    unsigned lda, ldb; const char* A; const char* B; pg::StaticOrder so; const bf16* Y1; bf16* YS; unsigned* cYS;
    __device__ __forceinline__ void a_ready(const pg::Unit&) const {}
    __device__ __forceinline__ void done(const pg::Unit& u) const { cnt_publish(cYS + 16 * u.pm); }
    __device__ __forceinline__ bool next(int i, pg::Unit& u) const { int pm, pn; if (!so.next(i, pm, pn)) return false; u.A = A + (size_t)pm * 256 * lda; u.B = B + (size_t)pn * 256 * ldb; u.nt = DS / 64; u.pm = pm; u.pn = pn; u.aux = 0; return true; }
    __device__ __forceinline__ void offs(const pg::Unit&, const int (&R)[2], const int (&C)[2], unsigned (&vo)[2][2]) const { pg::offs_plain(lda, R, C, vo); }
    __device__ __forceinline__ void epi(const f32x4 (&acc)[2][2][4][2], const pg::Unit& u, int wr, int wc, int fr, int fq) const {
        const int row0 = u.pm * 256 + wr * 64 + fr, cb = u.pn * 256 + 32 * wc + 8 * fq;
        u32x4 yv[2][4][2];
#pragma unroll
        for (int ai = 0; ai < 2; ++ai)
#pragma unroll
            for (int m = 0; m < 4; ++m)
#pragma unroll
                for (int bj = 0; bj < 2; ++bj) yv[ai][m][bj] = *(const u32x4*)(Y1 + (size_t)(row0 + ai * 128 + m * 16) * DS + cb + 128 * bj);
#pragma unroll
        for (int ai = 0; ai < 2; ++ai)
#pragma unroll
            for (int m = 0; m < 4; ++m) { const size_t ro = (size_t)(row0 + ai * 128 + m * 16) * DS + cb;
#pragma unroll
                for (int bj = 0; bj < 2; ++bj) { f32x4 y0, y1; pg::unpack8(yv[ai][m][bj], y0, y1);
                    f32x4 a = acc[ai][bj][m][0], b = acc[ai][bj][m][1];
#pragma unroll
                    for (int e = 0; e < 4; ++e) { a[e] = y0[e] * pg::fsigmoid(a[e]); b[e] = y1[e] * pg::fsigmoid(b[e]); }
                    pg::store16_wt(YS + ro + 128 * bj, pg::pack8(a, b)); } }
    }
};
struct PhProj {
    static constexpr bool GATHER = false, HOOKS = true, STAMPS = true, PREFETCH = false, LATE = false, KEEPACC = true, ACCINIT = false, HALFSKIP = false;
    __device__ __forceinline__ unsigned prefetch(const pg::Unit& u) const {
        const int t = threadIdx.x; unsigned a = 0u;
#pragma unroll
        for (int i = 0; i < 2; ++i) { const int ln = t + 512 * i, r = ln >> 2, c = (ln & 3) * 64; const size_t o = (size_t)(u.pm * 256 + r) * D + u.pn * 256 + c;
            a += *(const volatile unsigned*)(GA + o); if (u.aux) a += *(const volatile unsigned*)(GS + o); }
        return a; }
    volatile LAS unsigned* stp;
    unsigned lda, ldb; const char* O; const char* YSp; const char* WPA; const char* WPS; pg::StaticOrder so; bf16* GA; const bf16* GS; unsigned* cYS; unsigned* cMIX;
    __device__ __forceinline__ void a_ready(const pg::Unit& u) const { if (u.aux) { cnt_wait_wave0(cYS + 16 * u.pm, 16u); asm volatile("" ::: "memory"); __builtin_amdgcn_s_barrier(); asm volatile("" ::: "memory"); } }
    __device__ __forceinline__ void done(const pg::Unit& u) const { if (u.aux) cnt_publish(cMIX + 16 * u.pm); }
    __device__ __forceinline__ bool next(int i, pg::Unit& u) const { int pm, pn; if (!so.next(i >> 1, pm, pn)) return false; const int sub = i & 1;
        u.A = (sub ? YSp : O) + (size_t)pm * 256 * lda; u.B = (sub ? WPS : WPA) + (size_t)pn * 256 * ldb; u.nt = DA / 64; u.pm = pm; u.pn = pn; u.aux = sub; return true; }
    __device__ __forceinline__ void offs(const pg::Unit&, const int (&R)[2], const int (&C)[2], unsigned (&vo)[2][2]) const { pg::offs_plain(lda, R, C, vo); }
    __device__ __forceinline__ void epi(f32x4 (&acc)[2][2][4][2], const pg::Unit& u, int wr, int wc, int fr, int fq) const {
        const int row0 = u.pm * 256 + wr * 64 + fr, cb = u.pn * 256 + 32 * wc + 8 * fq; const bool sub = u.aux != 0;
        if (!sub) {
            u32x4 gv[2][4][2];
#pragma unroll
            for (int ai = 0; ai < 2; ++ai)
#pragma unroll
                for (int m = 0; m < 4; ++m) { const size_t ro = (size_t)(row0 + ai * 128 + m * 16) * D + cb;
#pragma unroll
                    for (int bj = 0; bj < 2; ++bj) gv[ai][m][bj] = *(const u32x4*)(GA + ro + 128 * bj); }
#pragma unroll
            for (int ai = 0; ai < 2; ++ai)
#pragma unroll
                for (int m = 0; m < 4; ++m)
#pragma unroll
                    for (int bj = 0; bj < 2; ++bj) { f32x4 g0, g1; pg::unpack8(gv[ai][m][bj], g0, g1); acc[ai][bj][m][0] = acc[ai][bj][m][0] * g0; acc[ai][bj][m][1] = acc[ai][bj][m][1] * g1; }
            return; }
        u32x4 sv[2][4][2];
#pragma unroll
        for (int ai = 0; ai < 2; ++ai)
#pragma unroll
            for (int m = 0; m < 4; ++m) { const size_t ro = (size_t)(row0 + ai * 128 + m * 16) * D + cb;
#pragma unroll
                for (int bj = 0; bj < 2; ++bj) sv[ai][m][bj] = *(const u32x4*)(GS + ro + 128 * bj); }
#pragma unroll
        for (int ai = 0; ai < 2; ++ai)
#pragma unroll
            for (int m = 0; m < 4; ++m) { const size_t ro = (size_t)(row0 + ai * 128 + m * 16) * D + cb;
#pragma unroll
                for (int bj = 0; bj < 2; ++bj) { f32x4 s0, s1; pg::unpack8(sv[ai][m][bj], s0, s1);
                    pg::store16_wt(GA + ro + 128 * bj, pg::pack8(acc[ai][bj][m][0] * s0, acc[ai][bj][m][1] * s1)); } }
    }
};
struct PhWout {
    static constexpr bool GATHER = false, HOOKS = true, STAMPS = true, PREFETCH = false, LATE = false, KEEPACC = false, ACCINIT = true, HALFSKIP = false;
    volatile LAS unsigned* stp;
    __device__ __forceinline__ unsigned prefetch(const pg::Unit& u) const {
        const int t = threadIdx.x; unsigned a = 0u;
#pragma unroll
        for (int i = 0; i < 4; ++i) { const int ln = t + 512 * i, r = ln >> 3, c = (ln & 7) * 32; a += *(const volatile unsigned*)(x + (size_t)(u.pm * 256 + r) * D + u.pn * 256 + c); }
        return a; }
    unsigned lda, ldb; const char* A; const char* B; pg::StaticOrder so; const float* x; float* out; bf16* X2B; float* SSP; unsigned* cMIX; unsigned* cX2;
    __device__ __forceinline__ void a_ready(const pg::Unit& u) const { cnt_wait_wave0(cMIX + 16 * u.pm, 32u); asm volatile("" ::: "memory"); __builtin_amdgcn_s_barrier(); asm volatile("" ::: "memory"); }
    __device__ __forceinline__ void done(const pg::Unit& u) const { cnt_publish(cX2 + 16 * u.pm); }
    __device__ __forceinline__ bool next(int i, pg::Unit& u) const { int pm, pn; if (!so.next(i, pm, pn)) return false; u.A = A + (size_t)pm * 256 * lda; u.B = B + (size_t)pn * 256 * ldb; u.nt = D / 64; u.pm = pm; u.pn = pn; u.aux = 0; return true; }
    __device__ __forceinline__ void offs(const pg::Unit&, const int (&R)[2], const int (&C)[2], unsigned (&vo)[2][2]) const { pg::offs_plain(lda, R, C, vo); }
    __device__ __forceinline__ void acc_init(f32x4 (&acc)[2][2][4][2], const pg::Unit& u, int wr, int wc, int fr, int fq) const {
        const int row0 = u.pm * 256 + wr * 64 + fr, cb = u.pn * 256 + 32 * wc + 8 * fq;
#pragma unroll
        for (int ai = 0; ai < 2; ++ai)
#pragma unroll
            for (int m = 0; m < 4; ++m)
#pragma unroll
                for (int bj = 0; bj < 2; ++bj) { const float* p = x + (size_t)(row0 + ai * 128 + m * 16) * D + cb + 128 * bj; acc[ai][bj][m][0] = *(const f32x4*)p; acc[ai][bj][m][1] = *(const f32x4*)(p + 4); }
    }
    __device__ __forceinline__ void epi(const f32x4 (&acc)[2][2][4][2], const pg::Unit& u, int wr, int wc, int fr, int fq) const {
        const int row0 = u.pm * 256 + wr * 64 + fr, cb = u.pn * 256 + 32 * wc + 8 * fq;
#pragma unroll
        for (int ai = 0; ai < 2; ++ai)
#pragma unroll
            for (int m = 0; m < 4; ++m) { const int row = row0 + ai * 128 + m * 16; const size_t ro = (size_t)row * D + cb; float ss = 0.f;
#pragma unroll
                for (int bj = 0; bj < 2; ++bj) { const f32x4 a = acc[ai][bj][m][0], b = acc[ai][bj][m][1];
                    pg::store16_wt(X2B + ro + 128 * bj, pg::pack8(a, b));
                    ss += (a[0] * a[0] + a[1] * a[1]) + (a[2] * a[2] + a[3] * a[3]) + (b[0] * b[0] + b[1] * b[1]) + (b[2] * b[2] + b[3] * b[3]); }
                ss += __shfl_xor(ss, 16); ss += __shfl_xor(ss, 32);
                if (fq == 0) __hip_atomic_store((unsigned*)SSP + (size_t)row * 16 + u.pn * 4 + wc, __builtin_bit_cast(unsigned, ss), __ATOMIC_RELAXED, __HIP_MEMORY_SCOPE_AGENT); }
    }
};

__device__ __forceinline__ void p2_side_work(Frame& F, const Args& a) {
    unsigned char* ws = a.ws; const int i0 = (int)blockIdx.x - 64;
    LAS float* KT = (LAS float*)F.lds;
    for (int sl = i0; sl < NG * 8; sl += 192) { const int g = sl >> 3, q = sl & 7;
        __syncthreads();
        { const GAS f32x4* src = (const GAS f32x4*)((const float*)(ws + WS_KTG) + (size_t)g * LCH * GC * GC);
          for (int i = F.tid; i < (2 * q + 2) * GC * GC / 4; i += NWAVES * 64) *(LAS f32x4*)(KT + 4 * i) = src[i]; }
        __syncthreads();
        const int n = 32 * q + (F.tid >> 4), part = F.tid & 15, j = n >> 4, co = n & 15; bf16* row = (bf16*)(ws + WS_BTY) + ((size_t)g * 256 + n) * U2P + 128;
#pragma unroll 1
        for (int it = 0; it < 2; ++it) { const int k = (it * 16 + part) * 8, sidx = k >> 4, ci = k & 15;
            u32x4 o = (u32x4){0u, 0u, 0u, 0u};
            if (sidx <= j) { const LAS float* kp = KT + ((j - sidx) * GC + co) * GC + ci; const f32x4 k0 = *(const LAS f32x4*)kp, k1 = *(const LAS f32x4*)(kp + 4); o = pg::pack8(k0, k1); }
            *(GAS u32x4*)(row + k) = o; } }
    __syncthreads();
    LAS float* scr = (LAS float*)(F.lds + F.wave * 8704);
    constexpr int I_GLU = 8 * 16, I_PA = 8 * 32, I_OUT = 16 * 32;
    for (int it = i0 * NWAVES + F.wave; it < I_GLU + 2 * I_PA + I_OUT; it += 192 * NWAVES) { int r = it;
        if (r < I_GLU) { const int kb = r >> 4, nb = r & 15; conv_item(a.in[14], DS, kb * 64, nb * 32, (bf16*)(ws + WS_WGLU) + (size_t)(nb * 32) * DS, DS, nullptr, scr, F.lane); continue; } r -= I_GLU;
        if (r < I_PA) { const int kb = r >> 5, nb = r & 31; conv_item(a.in[15], D, kb * 64, nb * 32, (bf16*)(ws + WS_WPA) + (size_t)(nb * 32) * DA, DA, nullptr, scr, F.lane); continue; } r -= I_PA;
        if (r < I_PA) { const int kb = r >> 5, nb = r & 31; conv_item(a.in[16], D, kb * 64, nb * 32, (bf16*)(ws + WS_WPS) + (size_t)(nb * 32) * DS, DS, nullptr, scr, F.lane); continue; } r -= I_PA;
        { const int kb = r >> 5, nb = r & 31; conv_item(a.in[17], D, kb * 64, nb * 32, (bf16*)(ws + WS_WOUT) + (size_t)(nb * 32) * D, D, nullptr, scr, F.lane); } }
    if (i0 < 48) { const int r = i0; const float* gf = a.in[18]; const float* wrg = a.in[19]; const float* wre = a.in[21]; bf16* WR = (bf16*)(ws + WS_WR) + (size_t)r * D;
        for (int k = F.tid; k < D; k += NWAVES * 64) { const float w = r < 4 ? wrg[k * 4 + r] : (r < 36 ? wre[k * NE + r - 4] : 0.f); WR[k] = f2bf(w * gf[k]); } }
    __syncthreads();
}
__device__ __forceinline__ void p2_expert_weights(Frame& F, const Args& a, int it0, int it1, int gw, int NGW) {
    unsigned char* ws = a.ws; LAS float* scr = (LAS float*)(F.lds + F.wave * 8704);
    LAS float* gfl = (LAS float*)(F.lds + NWAVES * 8704);
    { const float* gf = a.in[18]; __syncthreads(); for (int i = F.tid; i < D; i += NWAVES * 64) gfl[i] = gf[i]; __syncthreads(); }
    const LAS float* gf = gfl; const float* wg = a.in[23]; const float* wu = a.in[24]; const float* wd = a.in[25];
    constexpr int I_G = 16 * 8, I_D = 4 * 32;
    constexpr int NITEMS = NE * (2 * I_G + I_D);
    auto desc = [&](int it) -> ConvDesc { const int e = it / (2 * I_G + I_D); int r = it % (2 * I_G + I_D);
        if (r < 2 * I_G) { const int up = r >= I_G; if (up) r -= I_G; const int kb = r >> 3, nb = r & 7, n0 = nb * 32;
            return ConvDesc{(up ? wu : wg) + (size_t)e * D * DE, DE, kb * 64, n0, (bf16*)(ws + WS_WGU) + ((size_t)e * 512 + 256 * (n0 >> 7) + 128 * up + (n0 & 127)) * D, D, gf, 1}; }
        r -= 2 * I_G; const int kb = r >> 5, nb = r & 31; return ConvDesc{wd + (size_t)e * DE * D, D, kb * 64, nb * 32, (bf16*)(ws + WS_WD) + ((size_t)e * D + nb * 32) * DE, DE, gf, 0}; };
    const int NITEMS_ALL = NITEMS; (void)NITEMS_ALL;
    int it = (a.sub & 4) ? it0 + gw : it1;
    float v[32], v1[32]; ConvDesc d{}, d1{};
    d = desc(it < it1 ? it : it1 - 1); conv_load(d, v, F.lane);
    d1 = desc(it + NGW < it1 ? it + NGW : it1 - 1); conv_load(d1, v1, F.lane);
    while (it < it1) {
        const int itn = it + 2 * NGW; float vn[32]; ConvDesc dn = desc(itn < it1 ? itn : it1 - 1); conv_load(dn, vn, F.lane);
        conv_finish(d, v, scr, F.lane);
#pragma unroll
        for (int i = 0; i < 32; ++i) { v[i] = v1[i]; v1[i] = vn[i]; }
        d = d1; d1 = dn; it += NGW;
    }
}
__device__ __forceinline__ void p8_router(Frame& F, const Args& a) {
    unsigned char* ws = a.ws;
    constexpr int WPITCH = 2064;
    LAS unsigned char* wl = F.lds;
    LAS float* lg = (LAS float*)(F.lds + 48 * WPITCH) + F.wave * 16 * 48;
    { const GAS u32x4* src = (const GAS u32x4*)(ws + WS_WR);
      for (int i = F.tid; i < 48 * 128; i += NWAVES * 64) { const int r = i >> 7, c = i & 127; *(LAS u32x4*)(wl + r * WPITCH + c * 16) = src[i]; } }
    __syncthreads();
    const bf16* X2B = (const bf16*)(ws + WS_X2B); const float* SSP = (const float*)(ws + WS_SSP);
    const float* b_rg = a.in[20]; const float* b_re = a.in[22];
    float* RSTD = (float*)(ws + WS_RSTD); int* ROUTE = (int*)(ws + WS_ROUTE); int* CNT = (int*)(ws + WS_CTL) + CW_CNT; int* LIST = (int*)(ws + WS_LIST); float* WPOS = (float*)(ws + WS_WPOS); float* RPOS = (float*)(ws + WS_RPOS);
    const int fr = F.lane & 15, fq = F.lane >> 4;
    LAS int* lcnt = (LAS int*)(F.lds + 48 * WPITCH + NWAVES * 16 * 48 * 4);
    LAS int* lbase = lcnt + 32;
    for (int t0 = F.vcu * 64; t0 < T; t0 += F.G * 64) {
        cnt_wait_wave0((unsigned*)(F.ctl + CW_PX2) + 16 * (t0 >> 8), 32u);
        if (F.tid < 32) lcnt[F.tid] = 0;
        __syncthreads();
        int e0 = 0, e1 = 0, lr0 = 0, lr1 = 0; float w0 = 0.f, w1 = 0.f, rstd = 0.f;
        if (F.wave < 4) {
            const int tok = t0 + F.wave * 16 + fr;
            const GAS bf16x8* xa = (const GAS bf16x8*)(X2B + (size_t)tok * D + 8 * fq);
            f32x4 acc[3]; acc[0] = acc[1] = acc[2] = (f32x4){0.f, 0.f, 0.f, 0.f};
            f32x4 ssv[4];
            { const f32x4* sp = (const f32x4*)(SSP + (size_t)(t0 + F.wave * 16 + (F.lane & 15)) * 16);
#pragma unroll
              for (int i = 0; i < 4; ++i) ssv[i] = sp[i]; }
            bf16x8 xf[32];
#pragma unroll
            for (int ks = 0; ks < 32; ++ks) xf[ks] = xa[ks * 4];
#pragma unroll
            for (int ks = 0; ks < 32; ++ks) {
#pragma unroll
                for (int n = 0; n < 3; ++n) { const bf16x8 wfr = *(const LAS bf16x8*)(wl + (n * 16 + fr) * WPITCH + ks * 64 + fq * 16);
                    acc[n] = __builtin_amdgcn_mfma_f32_16x16x32_bf16(wfr, xf[ks], acc[n], 0, 0, 0); } }
#pragma unroll
            for (int n = 0; n < 3; ++n) *(LAS f32x4*)(lg + fr * 48 + n * 16 + 4 * fq) = acc[n];
            LDS_WAIT(); asm volatile("" ::: "memory");
            if (F.lane < 16) {
                const int t = t0 + F.wave * 16 + F.lane; const LAS float* l = lg + F.lane * 48;
                float ss = 0.f;
#pragma unroll
                for (int i = 0; i < 4; ++i) { const f32x4 v = ssv[i]; ss += (v[0] + v[1]) + (v[2] + v[3]); }
                rstd = rsqrtf(ss * (1.f / D) + EPS);
                float gl[4]; int gs = 0;
#pragma unroll
                for (int i = 0; i < 4; ++i) gl[i] = l[i] * rstd + b_rg[i];
                float gm = gl[0];
#pragma unroll
                for (int i = 1; i < 4; ++i) if (gl[i] > gm) { gm = gl[i]; gs = i; }
                float gsum = 0.f;
#pragma unroll
                for (int i = 0; i < 4; ++i) gsum += __expf(gl[i] - gm);
                const float gtop = 1.f / gsum;
                float el[8];
#pragma unroll
                for (int i = 0; i < 8; ++i) el[i] = l[4 + gs * 8 + i] * rstd + b_re[gs * 8 + i];
                int i0 = 0; float m0 = el[0];
#pragma unroll
                for (int i = 1; i < 8; ++i) if (el[i] > m0) { m0 = el[i]; i0 = i; }
                int i1 = -1; float m1 = -3.0e38f;
#pragma unroll
                for (int i = 0; i < 8; ++i) if (i != i0 && el[i] > m1) { m1 = el[i]; i1 = i; }
                const float p1 = __expf(m1 - m0); w0 = gtop / (1.f + p1); w1 = gtop * p1 / (1.f + p1);
                e0 = gs * 8 + i0; e1 = gs * 8 + i1;
                lr0 = __hip_atomic_fetch_add(&lcnt[e0], 1, __ATOMIC_RELAXED, __HIP_MEMORY_SCOPE_WORKGROUP); lr1 = __hip_atomic_fetch_add(&lcnt[e1], 1, __ATOMIC_RELAXED, __HIP_MEMORY_SCOPE_WORKGROUP);
            }
        }
        __syncthreads();
        if (F.tid < 32) { const int c = lcnt[F.tid]; lbase[F.tid] = c ? atomicAdd(&CNT[F.tid], c) : 0; }
        __syncthreads();
        if (F.wave < 4 && F.lane < 16) {
            const int t = t0 + F.wave * 16 + F.lane; const int r0 = lbase[e0] + lr0, r1 = lbase[e1] + lr1;
            RSTD[t] = rstd; *(int4*)(ROUTE + t * 4) = make_int4(e0, e1, r0, r1);
            LIST[e0 * T + r0] = t; LIST[e1 * T + r1] = t; WPOS[e0 * T + r0] = w0; WPOS[e1 * T + r1] = w1; RPOS[e0 * T + r0] = rstd; RPOS[e1 * T + r1] = rstd;
        }
        __syncthreads();
    }
}
constexpr int MOE_ORD = 384, MOE_TE = 384 + 160;
__device__ __forceinline__ void moe_table(Frame& F, const int* CNT, LAS int* tb) {
    if (F.tid < 64) { const int e = F.lane; int c = 0; if (e < NE) c = (int)__hip_atomic_load((const unsigned*)CNT + e, __ATOMIC_RELAXED, __HIP_MEMORY_SCOPE_AGENT);
        const int tl = (c + 255) >> 8; int incl = tl;
#pragma unroll
        for (int o = 1; o < 32; o <<= 1) { const int v = __shfl_up(incl, o); if (e >= o) incl += v; }
        if (e < NE) { tb[e] = incl - tl; tb[64 + e] = c; } if (e == NE - 1) tb[32] = incl;
        LAS int* ord = tb + MOE_ORD; const int nfull = c >> 8, rem = c & 255; int inf = nfull;
#pragma unroll
        for (int o = 1; o < 32; o <<= 1) { const int v = __shfl_up(inf, o); if (e >= o) inf += v; }
        const int NF = __shfl(inf, NE - 1), basef = inf - nfull, first = incl - tl;
        int rank = 0;
#pragma unroll 4
        for (int j = 0; j < NE; ++j) { const int rj = __shfl(rem, j); rank += (rj > rem || (rj == rem && j < e)) ? 1 : 0; }
        if (e < NE) { for (int j = 0; j < nfull; ++j) ord[basef + j] = first + j; if (rem) ord[NF + rank] = first + nfull; for (int j = 0; j < tl; ++j) tb[MOE_TE + first + j] = e; } }
    __syncthreads();
}
__device__ __forceinline__ int moe_find(const LAS int* tb, int mt) { return tb[MOE_TE + mt]; }
struct PhMoeGU {
    static constexpr bool GATHER = true, HOOKS = true, STAMPS = true, PREFETCH = false, LATE = false, KEEPACC = false, ACCINIT = false, HALFSKIP = true;
    volatile LAS unsigned* stp;
    unsigned lda, ldb; const char* X; const char* W; const LAS int* tb; const int* LIST; const float* RPOS; bf16* H; int G, c; unsigned* hcnt;
    unsigned* qctr; volatile LAS int* slot; bool last; int pend0;
    __device__ __forceinline__ bool half(const pg::Unit& u) const { return tb[64 + u.aux] - (u.pm - tb[u.aux]) * 256 <= 128; }
    __device__ __forceinline__ void a_ready(const pg::Unit&) const {}
    __device__ __forceinline__ void done(const pg::Unit& u) {
        asm volatile("s_waitcnt vmcnt(0)" ::: "memory");
        if ((threadIdx.x & 63) == 0) __hip_atomic_fetch_add(hcnt + 16 * u.pm, 1u, __ATOMIC_RELAXED, __HIP_MEMORY_SCOPE_AGENT);
        if (last && threadIdx.x == 0) slot[3] = pend0 + 1; }
    __device__ __forceinline__ bool next(int i, pg::Unit& u) { const int L = i == 0 ? c : i * G + (c & 31) * 8 + (c >> 5);
        if (L >= 2 * tb[32]) { last = i > 0; return false; } const int mt = tb[MOE_ORD + (L >> 1)], n2 = L & 1, e = moe_find(tb, mt);
        u.A = X; u.B = W + ((size_t)e * 512 + n2 * 256) * ldb; u.nt = D / 64; u.pm = mt; u.pn = n2; u.aux = e; return true; }
    __device__ __forceinline__ void offs(const pg::Unit& u, const int (&R)[2], const int (&C)[2], unsigned (&vo)[2][2]) const {
        const int e = u.aux, cnt = tb[64 + e], r0 = (u.pm - tb[e]) * 256; const int* lp = LIST + (size_t)e * T;
#pragma unroll
        for (int h = 0; h < 2; ++h)
#pragma unroll
            for (int i = 0; i < 2; ++i) { int r = r0 + h * 128 + R[i]; r = r < cnt ? r : cnt - 1; vo[h][i] = (unsigned)lp[r] * lda + (unsigned)C[i] * 2u; }
    }
    __device__ __forceinline__ void epi(const f32x4 (&acc)[2][2][4][2], const pg::Unit& u, int wr, int wc, int fr, int fq) {
        if (last && threadIdx.x == 0) pend0 = (int)__hip_atomic_fetch_add(qctr, 1u, __ATOMIC_RELAXED, __HIP_MEMORY_SCOPE_AGENT);
        const int e = u.aux, r0 = (u.pm - tb[e]) * 256; const float* rp = RPOS + (size_t)e * T + r0;
        float rsv[2][4];
#pragma unroll
        for (int ai = 0; ai < 2; ++ai)
#pragma unroll
            for (int m = 0; m < 4; ++m) rsv[ai][m] = rp[ai * 128 + wr * 64 + m * 16 + fr];
#pragma unroll
        for (int ai = 0; ai < 2; ++ai)
#pragma unroll
            for (int m = 0; m < 4; ++m) { const int tr = ai * 128 + wr * 64 + m * 16 + fr; const float rs = rsv[ai][m];
                f32x4 g0 = acc[ai][0][m][0] * rs, g1 = acc[ai][0][m][1] * rs; const f32x4 u0 = acc[ai][1][m][0] * rs, u1 = acc[ai][1][m][1] * rs;
#pragma unroll
                for (int q = 0; q < 4; ++q) { g0[q] = g0[q] * pg::fsigmoid(g0[q]) * u0[q]; g1[q] = g1[q] * pg::fsigmoid(g1[q]) * u1[q]; }
                pg::store16_wt(H + ((size_t)u.pm * 256 + tr) * DE + u.pn * 128 + 32 * wc + 8 * fq, pg::pack8(g0, g1)); }
    }
};
struct PhMoeDown {
    static constexpr bool GATHER = false, HOOKS = true, STAMPS = true, PREFETCH = false, LATE = true, KEEPACC = false, ACCINIT = false, HALFSKIP = true;
    volatile LAS unsigned* stp;
    unsigned lda, ldb; const char* Hp; const char* W; const LAS int* tb; const float* WPOS; bf16* Y; unsigned* hcnt; unsigned* qctr; volatile LAS int* slot;
    int pend;
    __device__ __forceinline__ bool next(int i, pg::Unit& u) {
        if (threadIdx.x == 0) { if (i == 0) { const int s3 = slot[3]; pend = s3 > 0 ? s3 - 1 : (int)__hip_atomic_fetch_add(qctr, 1u, __ATOMIC_RELAXED, __HIP_MEMORY_SCOPE_AGENT); }
            slot[i & 1] = pend; if (i == 0) pend = (int)__hip_atomic_fetch_add(qctr, 1u, __ATOMIC_RELAXED, __HIP_MEMORY_SCOPE_AGENT); }
        asm volatile("s_waitcnt lgkmcnt(0)" ::: "memory"); __builtin_amdgcn_s_barrier(); asm volatile("" ::: "memory");
        const int L = slot[i & 1]; if (L >= 4 * tb[32]) return false; const int mt = tb[MOE_ORD + (L >> 2)], n4 = L & 3, e = moe_find(tb, mt);
        u.A = Hp + (size_t)mt * 256 * lda; u.B = W + ((size_t)e * D + n4 * 256) * ldb; u.nt = DE / 64; u.pm = mt; u.pn = n4; u.aux = e; return true; }
    __device__ __forceinline__ void offs(const pg::Unit&, const int (&R)[2], const int (&C)[2], unsigned (&vo)[2][2]) const { pg::offs_plain(lda, R, C, vo); }
    __device__ __forceinline__ void a_ready(const pg::Unit& u) const {
        if (threadIdx.x < 64) { unsigned sp = 0;
            while ((unsigned)__builtin_amdgcn_readfirstlane(__hip_atomic_load(hcnt + 16 * u.pm, __ATOMIC_RELAXED, __HIP_MEMORY_SCOPE_AGENT)) < 16u) { __builtin_amdgcn_s_sleep(2); if (++sp > (1u << 22)) break; }
            __builtin_amdgcn_fence(__ATOMIC_ACQUIRE, "agent");
            asm volatile("s_waitcnt vmcnt(0)" ::: "memory"); }
        asm volatile("" ::: "memory"); __builtin_amdgcn_s_barrier(); asm volatile("" ::: "memory");
    }
    __device__ __forceinline__ bool try_ready(const pg::Unit& u) const {
        if (threadIdx.x < 64) {
            const bool ok = (unsigned)__builtin_amdgcn_readfirstlane(__hip_atomic_load(hcnt + 16 * u.pm, __ATOMIC_RELAXED, __HIP_MEMORY_SCOPE_AGENT)) >= 16u;
            if (ok) { __builtin_amdgcn_fence(__ATOMIC_ACQUIRE, "agent"); asm volatile("s_waitcnt vmcnt(0)" ::: "memory"); }
            if (threadIdx.x == 0) slot[2] = ok ? 1 : 0;
            asm volatile("s_waitcnt lgkmcnt(0)" ::: "memory"); }
        asm volatile("" ::: "memory"); __builtin_amdgcn_s_barrier(); asm volatile("" ::: "memory");
        return __builtin_amdgcn_readfirstlane(slot[2]) != 0; }
    __device__ __forceinline__ void done(const pg::Unit&) const {}
    __device__ __forceinline__ bool half(const pg::Unit& u) const { return tb[64 + u.aux] - (u.pm - tb[u.aux]) * 256 <= 128; }
    __device__ __forceinline__ void epi(const f32x4 (&acc)[2][2][4][2], const pg::Unit& u, int wr, int wc, int fr, int fq) {
        if (threadIdx.x == 0) pend = (int)__hip_atomic_fetch_add(qctr, 1u, __ATOMIC_RELAXED, __HIP_MEMORY_SCOPE_AGENT);
        const int e = u.aux, r0 = (u.pm - tb[e]) * 256; const float* wp = WPOS + (size_t)e * T + r0;
        float wv[2][4];
#pragma unroll
        for (int ai = 0; ai < 2; ++ai)
#pragma unroll
            for (int m = 0; m < 4; ++m) wv[ai][m] = wp[ai * 128 + wr * 64 + m * 16 + fr];
#pragma unroll
        for (int ai = 0; ai < 2; ++ai)
#pragma unroll
            for (int m = 0; m < 4; ++m) { int tr = ai * 128 + wr * 64 + m * 16 + fr; asm volatile("" : "+v"(tr));
                const float w = wv[ai][m]; bf16* yp = Y + (unsigned)((u.pm * 256 + tr) * D + u.pn * 256 + 32 * wc + 8 * fq);
#pragma unroll
                for (int bj = 0; bj < 2; ++bj) *(u32x4*)(yp + 128 * bj) = pg::pack8(acc[ai][bj][m][0] * w, acc[ai][bj][m][1] * w); }
    }
};
__device__ __forceinline__ void p11_combine(Frame& F, const Args& a, const LAS int* tb) {
    unsigned char* ws = a.ws; const int* ROUTE = (const int*)(ws + WS_ROUTE); const bf16* Y = (const bf16*)(ws + WS_Y); const bf16* X2B = (const bf16*)(ws + WS_X2B); float* out = a.out;
    constexpr int NT = 4; const int step = F.G * NWAVES;
    for (int t0 = F.vcu * NWAVES + F.wave; t0 < T; t0 += NT * step) {
        int4 rt[NT];
#pragma unroll
        for (int k = 0; k < NT; ++k) { const int t = t0 + k * step < T ? t0 + k * step : T - 1; rt[k] = *(const int4*)(ROUTE + t * 4); }
        u32x2 a0[NT][4], a1[NT][4], xv[NT][4];
#pragma unroll
        for (int k = 0; k < NT; ++k) { const int t = t0 + k * step < T ? t0 + k * step : T - 1;
            const GAS u32x2* y0 = (const GAS u32x2*)(Y + ((size_t)tb[rt[k].x] * 256 + rt[k].z) * D) + F.lane; const GAS u32x2* y1 = (const GAS u32x2*)(Y + ((size_t)tb[rt[k].y] * 256 + rt[k].w) * D) + F.lane;
            const GAS u32x2* xb = (const GAS u32x2*)(X2B + (size_t)t * D) + F.lane;
#pragma unroll
            for (int j = 0; j < 4; ++j) { a0[k][j] = y0[64 * j]; a1[k][j] = y1[64 * j]; xv[k][j] = xb[64 * j]; } }
#pragma unroll
        for (int k = 0; k < NT; ++k) { const int t = t0 + k * step; if (t < T) {
            GAS f32x4* o = (GAS f32x4*)(out + (size_t)t * D) + F.lane;
#pragma unroll
            for (int j = 0; j < 4; ++j) { const u32x2 p0 = a0[k][j], p1 = a1[k][j], px = xv[k][j]; f32x4 v;
                v[0] = __builtin_bit_cast(float, px.x << 16) + (__builtin_bit_cast(float, p0.x << 16) + __builtin_bit_cast(float, p1.x << 16)); v[1] = __builtin_bit_cast(float, px.x & 0xffff0000u) + (__builtin_bit_cast(float, p0.x & 0xffff0000u) + __builtin_bit_cast(float, p1.x & 0xffff0000u));
                v[2] = __builtin_bit_cast(float, px.y << 16) + (__builtin_bit_cast(float, p0.y << 16) + __builtin_bit_cast(float, p1.y << 16)); v[3] = __builtin_bit_cast(float, px.y & 0xffff0000u) + (__builtin_bit_cast(float, p0.y & 0xffff0000u) + __builtin_bit_cast(float, p1.y & 0xffff0000u));
                __builtin_nontemporal_store(v, &o[64 * j]); } } }
    }
}

struct PhSsmX {
    static constexpr bool GATHER = false, HOOKS = false, STAMPS = false, PREFETCH = false, LATE = false, KEEPACC = false, ACCINIT = false, HALFSKIP = false;
    unsigned lda, ldb; const char* U2X; const char* M1T; float* SLOC; int g, b, hf;
    __device__ __forceinline__ bool next(int i, pg::Unit& u) const { if (i >= 1) return false; u.A = U2X + ((size_t)(g * NCR + b * 512 + hf * 256) * U2P + 128) * 2; u.B = M1T + (size_t)g * 256 * ldb; u.nt = 4; u.pm = b; u.pn = 0; u.aux = 0; return true; }
    __device__ __forceinline__ void offs(const pg::Unit&, const int (&R)[2], const int (&C)[2], unsigned (&vo)[2][2]) const { pg::offs_plain(lda, R, C, vo); }
    __device__ __forceinline__ void epi(const f32x4 (&acc)[2][2][4][2], const pg::Unit& u, int wr, int wc, int fr, int fq) const {
#pragma unroll
        for (int ai = 0; ai < 2; ++ai)
#pragma unroll
            for (int m = 0; m < 4; ++m) { float* p = SLOC + ((size_t)(g * 2 + u.pm) * 256 + ai * 128 + wr * 64 + m * 16 + fr) * 128 + 32 * wc + 8 * fq;
                *(f32x4*)p = acc[ai][0][m][0]; *(f32x4*)(p + 4) = acc[ai][0][m][1]; }
    }
};
__device__ __forceinline__ void ssm_scan(Frame& F, unsigned char* ws, int g, int b, int hf) {
    LAS f32x2* ends = (LAS f32x2*)F.lds;
    int p = F.lane; asm volatile("" : "+v"(p));
    const int w = F.wave;
    const float alr = ((const float*)(ws + WS_AL))[(g * NP + p) * 2], ali = ((const float*)(ws + WS_AL))[(g * NP + p) * 2 + 1];
    const float* sl = (const float*)(ws + WS_SLOC) + ((size_t)(g * 2 + b) * 256 + w * 32) * 128;
    float lr[32], li[32];
#pragma unroll
    for (int k = 0; k < 32; ++k) { lr[k] = __builtin_bit_cast(float, __hip_atomic_load((const unsigned*)sl + k * 128 + p, __ATOMIC_RELAXED, __HIP_MEMORY_SCOPE_AGENT)); li[k] = __builtin_bit_cast(float, __hip_atomic_load((const unsigned*)sl + k * 128 + 64 + p, __ATOMIC_RELAXED, __HIP_MEMORY_SCOPE_AGENT)); }
#pragma unroll
    for (int k = 1; k < 32; ++k) { const float nr = alr * lr[k - 1] - ali * li[k - 1] + lr[k], ni = alr * li[k - 1] + ali * lr[k - 1] + li[k]; lr[k] = nr; li[k] = ni; }
    ends[w * 64 + p] = (f32x2){lr[31], li[31]};
    float sr = alr, si = ali;
#pragma unroll
    for (int k = 0; k < 5; ++k) { const float t = sr * sr - si * si; si = 2.f * sr * si; sr = t; }
    __syncthreads();
    LAS f32x2* EC = (LAS f32x2*)(F.lds + LDSCTL_OFF + 8192);
    float er = 0.f, ei = 0.f; if (hf) { const f32x2 e0 = EC[p]; er = e0.x; ei = e0.y; }
    float cr = er, ci = ei;
    for (int s2 = 0; s2 < w; ++s2) { const f32x2 e = ends[s2 * 64 + p]; const float t = sr * cr - si * ci + e.x; ci = sr * ci + si * cr + e.y; cr = t; }
    for (int s2 = 0; s2 < NWAVES; ++s2) { const f32x2 e = ends[s2 * 64 + p]; const float t = sr * er - si * ei + e.x; ei = sr * ei + si * er + e.y; er = t; }
    if (w == 0) EC[p] = (f32x2){er, ei};
    bf16* hp = (bf16*)(ws + WS_U2X) + ((size_t)g * NCR + b * 512 + hf * 256 + w * 32) * U2P;
    float pr = cr, pi = ci;
#pragma unroll
    for (int k = 0; k < 32; ++k) { const float hr = (k ? lr[k - 1] : 0.f) + pr, hi = (k ? li[k - 1] : 0.f) + pi;
        hp[(size_t)k * U2P + p] = f2bf(hr); hp[(size_t)k * U2P + 64 + p] = f2bf(hi);
        const float t = alr * pr - ali * pi; pi = alr * pi + ali * pr; pr = t; }
    __syncthreads();
}
struct PhSsmY {
    static constexpr bool GATHER = false, HOOKS = false, STAMPS = true, PREFETCH = false, LATE = false, KEEPACC = false, ACCINIT = false, HALFSKIP = false;
    volatile LAS unsigned* stp;
    unsigned lda, ldb; const char* U2Xp; const char* BTY; const bf16* U2X; const float* Dsk; bf16* Y1; int G, c;
    __device__ __forceinline__ bool next(int i, pg::Unit& u) const { const int L = i * G + c; if (L >= NG * 4) return false; const int g = L >> 2, mt = L & 3;
        u.A = U2Xp + (size_t)(g * NCR + mt * 256) * lda; u.B = BTY + (size_t)(g * 256) * ldb; u.nt = 6; u.pm = mt; u.pn = 0; u.aux = g; return true; }
    __device__ __forceinline__ void offs(const pg::Unit&, const int (&R)[2], const int (&C)[2], unsigned (&vo)[2][2]) const { pg::offs_plain(lda, R, C, vo); }
    __device__ __forceinline__ void epi(const f32x4 (&acc)[2][2][4][2], const pg::Unit& u, int wr, int wc, int fr, int fq) const {
        const int g = u.aux;
        u32x4 uv[2][2][4];
#pragma unroll
        for (int bj = 0; bj < 2; ++bj) { const int n = 128 * bj + 32 * wc + 8 * fq, j = n >> 4, c0 = n & 15;
#pragma unroll
            for (int ai = 0; ai < 2; ++ai)
#pragma unroll
                for (int m = 0; m < 4; ++m) { const int cr = u.pm * 256 + ai * 128 + wr * 64 + m * 16 + fr; uv[bj][ai][m] = *(const u32x4*)(U2X + ((size_t)g * NCR + cr) * U2P + 128 + j * GC + c0); } }
#pragma unroll
        for (int bj = 0; bj < 2; ++bj) { const int n = 128 * bj + 32 * wc + 8 * fq, j = n >> 4, c0 = n & 15;
            const f32x4 d0 = *(const f32x4*)(Dsk + g * GC + c0), d1 = *(const f32x4*)(Dsk + g * GC + c0 + 4);
#pragma unroll
            for (int ai = 0; ai < 2; ++ai)
#pragma unroll
                for (int m = 0; m < 4; ++m) { const int cr = u.pm * 256 + ai * 128 + wr * 64 + m * 16 + fr;
                    f32x4 u0, u1; pg::unpack8(uv[bj][ai][m], u0, u1);
                    f32x4 a = acc[ai][bj][m][0] + d0 * u0, b = acc[ai][bj][m][1] + d1 * u1;
#pragma unroll
                    for (int q = 0; q < 4; ++q) { a[q] = gelu_fast(a[q]); b[q] = gelu_fast(b[q]); }
                    *(u32x4*)(Y1 + ((size_t)cr * LCH + j) * DS + g * GC + c0) = pg::pack8(a, b); } }
    }
};

#define STAMP(k) do { if (stamper && threadIdx.x == 0) ((volatile LAS unsigned*)(F.lds + LDSCTL_OFF + 4096))[(k)] = (unsigned)__builtin_amdgcn_s_memrealtime(); } while (0)
__global__ void __launch_bounds__(NWAVES * 64, 2) mk_fwd(Args args) {
    extern __shared__ __attribute__((aligned(16))) unsigned char lds[];
    Frame F;
    F.lds = (LAS unsigned char*)lds; F.MISC = (volatile LAS unsigned*)(F.lds + MISC_OFF);
    F.tid = threadIdx.x; F.lane = F.tid & 63; F.wave = __builtin_amdgcn_readfirstlane(F.tid >> 6);
    F.G = gridDim.x; { const int bx = blockIdx.x; F.vcu = (F.G % 8 == 0) ? (bx % 8) * (F.G / 8) + bx / 8 : bx; }
    unsigned char* ws = args.ws; F.ctl = (gu32*)(ws + WS_CTL);
    for (int u = F.tid; u < (LDS_BYTES - LDSCTL_OFF) / 4; u += NWAVES * 64) ((LAS unsigned*)(F.lds + LDSCTL_OFF))[u] = 0u;
    __syncthreads();
    const int lo = args.ph_lo, hi = args.ph_hi;
#ifndef MK_PROFILE
#define MK_PROFILE 0
#endif
    const bool stamper = MK_PROFILE && args.pad_ != 0 && (int)blockIdx.x == (args.pad_ >> 16); F.stamper = stamper;
    STAMP(0);
    const bool multi = (hi - lo) > 1;
    XcdBarrier bar; bar.bar = (unsigned*)(F.ctl + CW_BAR); bar.x = 0; bar.st = nullptr;
    if (multi) bar = xcd_barrier_post((unsigned*)(F.ctl + CW_BAR), F.MISC + 8);
#define IN(k) (lo <= (k) && (k) < hi)
#define SEAM(k) do { STAMP(2 * (k) + 1); if (IN(k) && IN((k) + 1)) xcd_barrier(bar); STAMP(2 * (k) + 2); } while (0)
#define FRESH() do { int t_ = threadIdx.x; asm volatile("" : "+v"(t_)); F.tid = t_; F.lane = t_ & 63; } while (0)
    if (IN(0)) { FRESH(); p0_prologue(F, args); SEAM(0); }
    if (IN(1)) { FRESH();
        if (blockIdx.x < NBATCH * NH) p1_cumsum(F, (float*)(ws + WS_CUM), (int*)(ws + WS_T0), args.in[4], args.in[5]);
        PhInProj ph; ph.lda = D * 2; ph.ldb = D * 2; ph.A = (const char*)(ws + WS_XN); ph.B = (const char*)(ws + WS_WIN); ph.so.init(T / 256, 4096 / 256, F.G, (int)blockIdx.x);
        ph.Q = (bf16*)(ws + WS_Q); ph.K = (bf16*)(ws + WS_K); ph.V = (bf16*)(ws + WS_V); ph.U2X = (bf16*)(ws + WS_U2X); ph.GA = (bf16*)(ws + WS_GA); ph.GS = (bf16*)(ws + WS_GS);
        ph.gq = args.in[4]; ph.gk = args.in[5]; ph.stp = stamper ? (volatile LAS unsigned*)(F.lds + LDSCTL_OFF + 4096) + 48 : nullptr;
        pg::gemm_phase(F.lds + RING_OFF, ph);
        SEAM(1);
    }
    if (IN(2)) { FRESH();
        if (blockIdx.x < 2 * NG) {
            const int g = (int)blockIdx.x >> 1, b = (int)blockIdx.x & 1;
#pragma unroll 1
            for (int hf = 0; hf < 2; ++hf) { unsigned char* wl = ws; asm volatile("" : "+s"(wl));
                PhSsmX ph; ph.lda = U2P * 2; ph.ldb = 256 * 2; ph.U2X = (const char*)(wl + WS_U2X); ph.M1T = (const char*)(wl + WS_M1T); ph.SLOC = (float*)(wl + WS_SLOC); ph.g = g; ph.b = b;
                ph.hf = hf; pg::gemm_phase(F.lds + RING_OFF, ph); ssm_scan(F, wl, g, b, hf); }
            __syncthreads();
        } else if (F.G == 256) p2_side_work(F, args);
        p2_expert_weights(F, args, 0, 2304, F.vcu * NWAVES + F.wave, F.G * NWAVES); __syncthreads();
        STAMP(5); STAMP(6);
    }
    if (IN(3)) {
        static_assert(attn_body::ATTN_LDS_BYTES + 2 * attn_body::MAX_ITEMS * 4 <= RING_BYTES, "attention LDS");
        const attn_body::AttnTensors AT{(const attn_body::bf16*)(ws + WS_Q), (const attn_body::bf16*)(ws + WS_K), (const attn_body::bf16*)(ws + WS_V), (attn_body::bf16*)(ws + WS_Q), (const float*)(ws + WS_CUM),
            (const int*)(ws + WS_T0), (attn_body::bf16*)(ws + WS_PO), (float*)(ws + WS_PS), (unsigned*)(F.ctl + CW_Q0)};
        attn_body::attn_phase<64>((char*)lds + RING_OFF, AT, F.vcu, F.G);
        SEAM(3);
    }
    if (IN(4)) { FRESH();
        if (F.vcu >= 128) {
            const attn_body::AttnTensors AT{(const attn_body::bf16*)(ws + WS_Q), (const attn_body::bf16*)(ws + WS_K), (const attn_body::bf16*)(ws + WS_V), (attn_body::bf16*)(ws + WS_Q), (const float*)(ws + WS_CUM),
                (const int*)(ws + WS_T0), (attn_body::bf16*)(ws + WS_PO), (float*)(ws + WS_PS), (unsigned*)(F.ctl + CW_Q0)};
            const int NS = attn_body::attn_combine((char*)lds + RING_OFF, AT, F.vcu - 128, F.G - 128);
            { constexpr int IT0 = 2304, IT1 = 6048, TOT = IT1 - IT0, CU_ITEMS = 21; const int wg = F.vcu - 128, nwg = F.G - 128;
              const int q = NS / nwg, r = NS % nwg, W = (TOT + CU_ITEMS * NS + nwg - 1) / nwg;
              int nhi = W - CU_ITEMS * (q + 1); nhi = nhi > 0 ? nhi : 0; const int nlo = (TOT - r * nhi + (nwg - r) - 1) / (nwg - r);
              int s = wg < r ? wg * nhi : r * nhi + (wg - r) * nlo, e = s + (wg < r ? nhi : nlo); s = s < TOT ? s : TOT; e = e < TOT ? e : TOT;
              p2_expert_weights(F, args, IT0 + s, IT0 + e, F.wave, NWAVES); __syncthreads(); }
        }
        PhSsmY ph; ph.lda = U2P * 2; ph.ldb = U2P * 2; ph.U2Xp = (const char*)(ws + WS_U2X); ph.BTY = (const char*)(ws + WS_BTY); ph.U2X = (const bf16*)(ws + WS_U2X); ph.Dsk = args.in[13]; ph.Y1 = (bf16*)(ws + WS_Y1); ph.G = F.G; ph.c = F.vcu; ph.stp = stamper ? (volatile LAS unsigned*)(F.lds + LDSCTL_OFF + 4096) + 80 : nullptr;
        pg::gemm_phase(F.lds + RING_OFF, ph);
        FRESH(); SEAM(4);
    }
    if (IN(5)) { FRESH();
        if (blockIdx.x >= 128) { p2_expert_weights(F, args, 6048, 12288, ((int)blockIdx.x - 128) * NWAVES + F.wave, (F.G - 128) * NWAVES); __syncthreads(); }
        PhGlu ph; ph.lda = DS * 2; ph.ldb = DS * 2; ph.A = (const char*)(ws + WS_Y1); ph.B = (const char*)(ws + WS_WGLU); ph.so.init(T / 256, DS / 256, F.G, (int)blockIdx.x); ph.Y1 = (const bf16*)(ws + WS_Y1); ph.YS = (bf16*)(ws + WS_YS); ph.cYS = (unsigned*)(F.ctl + CW_PYS); ph.stp = stamper ? (volatile LAS unsigned*)(F.lds + LDSCTL_OFF + 4096) + 96 : nullptr;
        pg::gemm_phase(F.lds + RING_OFF, ph);
        STAMP(11); STAMP(12);
    }
    if (IN(6)) { FRESH();
        PhProj ph; ph.lda = DA * 2; ph.ldb = DA * 2; ph.O = (const char*)(ws + WS_Q); ph.YSp = (const char*)(ws + WS_YS); ph.WPA = (const char*)(ws + WS_WPA); ph.WPS = (const char*)(ws + WS_WPS);
        ph.so.init(T / 256, D / 256, F.G, (int)blockIdx.x); ph.GA = (bf16*)(ws + WS_GA); ph.GS = (const bf16*)(ws + WS_GS); ph.cYS = (unsigned*)(F.ctl + CW_PYS); ph.cMIX = (unsigned*)(F.ctl + CW_PMIX); ph.stp = stamper ? (volatile LAS unsigned*)(F.lds + LDSCTL_OFF + 4096) + 32 : nullptr;
        pg::gemm_phase(F.lds + RING_OFF, ph);
        STAMP(13); STAMP(14);
    }
    if (IN(7)) { FRESH();
        PhWout ph; ph.lda = D * 2; ph.ldb = D * 2; ph.A = (const char*)(ws + WS_GA); ph.B = (const char*)(ws + WS_WOUT); ph.so.init(T / 256, D / 256, F.G, (int)blockIdx.x);
        ph.x = args.in[0]; ph.out = args.out; ph.X2B = (bf16*)(ws + WS_X2B); ph.SSP = (float*)(ws + WS_SSP); ph.cMIX = (unsigned*)(F.ctl + CW_PMIX); ph.cX2 = (unsigned*)(F.ctl + CW_PX2); ph.stp = stamper ? (volatile LAS unsigned*)(F.lds + LDSCTL_OFF + 4096) + 64 : nullptr;
        pg::gemm_phase(F.lds + RING_OFF, ph);
        STAMP(15); STAMP(16);
    }
    if (IN(8)) { FRESH(); p8_router(F, args); SEAM(8); }
    LAS int* tb = (LAS int*)(F.lds + LDSCTL_OFF + 512);
    if (IN(9)) { FRESH();
        moe_table(F, (const int*)(ws + WS_CTL) + CW_CNT, tb);
        PhMoeGU ph; ph.lda = D * 2; ph.ldb = D * 2; ph.X = (const char*)(ws + WS_X2B); ph.W = (const char*)(ws + WS_WGU); ph.tb = tb; ph.LIST = (const int*)(ws + WS_LIST); ph.RPOS = (const float*)(ws + WS_RPOS);
        ph.H = (bf16*)(ws + WS_H); ph.G = F.G; ph.c = F.vcu; ph.hcnt = (unsigned*)(F.ctl + CW_HCNT); ph.qctr = (unsigned*)(F.ctl + CW_Q0 + 64); ph.slot = (volatile LAS int*)(F.lds + LDSCTL_OFF + 1024); ph.last = false; ph.pend0 = -1; ph.stp = stamper ? (volatile LAS unsigned*)(F.lds + LDSCTL_OFF + 4096) + 112 : nullptr;
        pg::gemm_phase(F.lds + RING_OFF, ph);
        STAMP(19); STAMP(20);
    }
    if (IN(10)) { FRESH();
        if (!IN(9)) moe_table(F, (const int*)(ws + WS_CTL) + CW_CNT, tb);
        PhMoeDown ph; ph.lda = DE * 2; ph.ldb = DE * 2; ph.Hp = (const char*)(ws + WS_H); ph.W = (const char*)(ws + WS_WD); ph.tb = tb; ph.WPOS = (const float*)(ws + WS_WPOS); ph.Y = (bf16*)(ws + WS_Y); ph.hcnt = (unsigned*)(F.ctl + CW_HCNT); ph.qctr = (unsigned*)(F.ctl + CW_Q0 + 64); ph.slot = (volatile LAS int*)(F.lds + LDSCTL_OFF + 1024); ph.stp = stamper ? (volatile LAS unsigned*)(F.lds + LDSCTL_OFF + 4096) + 128 : nullptr;
        pg::gemm_phase(F.lds + RING_OFF, ph);
        SEAM(10);
    }
    if (IN(11)) { FRESH();
        if (!IN(10)) moe_table(F, (const int*)(ws + WS_CTL) + CW_CNT, tb);
        p11_combine(F, args, tb);
    }
    STAMP(23);
    if (stamper && F.tid == 0) { const unsigned a_ = ((volatile LAS unsigned*)(F.lds + LDSCTL_OFF + 4096))[args.pad_ & 255], b_ = ((volatile LAS unsigned*)(F.lds + LDSCTL_OFF + 4096))[(args.pad_ >> 8) & 255]; const unsigned long long t0_ = __builtin_amdgcn_s_memrealtime(), wait_ = 9ull * (unsigned long long)(b_ - a_);
        while (__builtin_amdgcn_s_memrealtime() - t0_ < wait_) __builtin_amdgcn_s_sleep(8); }
#undef IN
#undef SEAM
}

extern "C" void kernel_launch(void* const* d_in, const int* in_sizes, int n_in, void* d_out, int out_size, void* d_ws, size_t ws_size, hipStream_t stream) {
    static int grid = 0;
    if (grid == 0) {
        int dev = 0, cus = 0; (void)hipGetDevice(&dev); (void)hipDeviceGetAttribute(&cus, hipDeviceAttributeMultiprocessorCount, dev);
        (void)hipFuncSetAttribute((const void*)mk_fwd, hipFuncAttributeMaxDynamicSharedMemorySize, LDS_BYTES);
        (void)cus; grid = 256;
    }
    (void)hipMemsetAsync((char*)d_ws + WS_CTL, 0, CTL_ZERO_BYTES, stream);
    Args a{}; for (int i = 0; i < 26; ++i) a.in[i] = (const float*)d_in[i]; a.out = (float*)d_out; a.ws = (unsigned char*)d_ws;
    a.ph_lo = 0; a.ph_hi = 12; a.sub = 7;
    hipLaunchKernelGGL(mk_fwd, dim3(grid), dim3(NWAVES * 64), LDS_BYTES, stream, a);
}
```
